# Optimizing an MI355X kernel written in HIP

```python
import jax, jax.numpy as jnp
from jax import lax
import numpy as np

D_MODEL = 1024
BATCH = 8
SEQ = 4096
DEPTH = 4

RW_HEADS = 16
RW_HEAD_DIM = 64
RW_WIDTH = RW_HEADS * RW_HEAD_DIM
RW_DECAY_LORA = 64
RW_AAA_LORA = 64
RW_MV_LORA = 32
RW_GATE_LORA = 128
RW_LN_EPS = 64e-5

GM_GROUPS = 8
GM_CHUNK = 128
GM_WIDTH = 1024
GM_GROUP_DIM = GM_WIDTH // GM_GROUPS
GM_LN_EPS = 1e-5

C_IN = 3 * RW_WIDTH + RW_DECAY_LORA + RW_AAA_LORA + RW_GATE_LORA + 2 * GM_WIDTH + 2 * D_MODEL

PEER_HEADS = 8
PEER_KEYS = 128
PEER_EXPERTS = PEER_KEYS * PEER_KEYS
PEER_DKEY = 256
PEER_HALF = PEER_DKEY // 2
PEER_TOPK = 16
PEER_TOKEN_BLOCK = 128

PLE_DIM = 256

RMS_EPS = 1e-6

kernel_name = "hybrid_rwkv7_gmlp_peer_trunk"


def _split_points():
    sizes = (RW_WIDTH, RW_WIDTH, RW_WIDTH, RW_DECAY_LORA, RW_AAA_LORA, RW_GATE_LORA,
             GM_WIDTH, GM_WIDTH, D_MODEL, D_MODEL)
    pts, acc = [], 0
    for s in sizes[:-1]:
        acc += s
        pts.append(acc)
    return tuple(pts)


def _rmsnorm(x, g):
    xf = x.astype(jnp.float32)
    y = xf * lax.rsqrt(jnp.mean(xf * xf, axis=-1, keepdims=True) + RMS_EPS)
    return (y * g.astype(jnp.float32)).astype(x.dtype)


def _layernorm(x, g, b, eps):
    xf = x.astype(jnp.float32)
    mu = jnp.mean(xf, axis=-1, keepdims=True)
    var = jnp.mean(jnp.square(xf - mu), axis=-1, keepdims=True)
    y = (xf - mu) * lax.rsqrt(var + eps) * g.astype(jnp.float32) + b.astype(jnp.float32)
    return y.astype(x.dtype)


def _token_shift(x):
    return jnp.pad(x, ((0, 0), (1, 0), (0, 0)))[:, :-1]


def _wkv7_scan(r, w, k, v, a, b):
    B, S, H, N = r.shape

    def step(state, inp):
        r_t, w_t, k_t, v_t, a_t, b_t = inp
        sa = jnp.einsum('bhvk,bhk->bhv', state, a_t)
        state = (state * w_t[:, :, None, :]
                 + sa[:, :, :, None] * b_t[:, :, None, :]
                 + v_t[:, :, :, None] * k_t[:, :, None, :])
        y_t = jnp.einsum('bhvk,bhk->bhv', state, r_t)
        return state, y_t

    xs = tuple(jnp.moveaxis(t, 1, 0) for t in (r, w, k, v, a, b))
    state0 = jnp.zeros((B, H, N, N), jnp.float32)
    _, ys = lax.scan(step, state0, xs)
    return jnp.moveaxis(ys, 0, 1)


def _rwkv7_branch(zr, zk, zv, zw, za, zg, w0, w2, a0, a2, g2, k_k, k_a, r_k, ln_g, ln_b):
    B, S, _ = zr.shape
    f32 = jnp.float32
    zw, za, zg = zw.astype(f32), za.astype(f32), zg.astype(f32)
    w_log = -jax.nn.softplus(-(w0.astype(f32) + jnp.tanh(zw) @ w2.astype(f32))) - 0.5
    decay = jnp.exp(-jnp.exp(w_log))
    a_rate = jax.nn.sigmoid(a0.astype(f32) + za @ a2.astype(f32))
    gate = jax.nn.sigmoid(zg) @ g2.astype(f32)
    kf = zk.astype(f32)
    kk = kf * k_k.astype(f32)
    k = kf * (1.0 + (a_rate - 1.0) * k_a.astype(f32))

    def heads(t):
        return t.astype(f32).reshape(B, S, RW_HEADS, RW_HEAD_DIM)

    r, k, v, kk, decay, a_rate = heads(zr), heads(k), heads(zv), heads(kk), heads(decay), heads(a_rate)
    kk = kk * lax.rsqrt(jnp.maximum(jnp.sum(kk * kk, axis=-1, keepdims=True), 1e-24))
    y = _wkv7_scan(r, decay, k, v, -kk, kk * a_rate)
    mu = jnp.mean(y, axis=-1, keepdims=True)
    var = jnp.mean(jnp.square(y - mu), axis=-1, keepdims=True)
    y = (y - mu) * lax.rsqrt(var + RW_LN_EPS)
    y = y * ln_g.astype(f32).reshape(RW_HEADS, RW_HEAD_DIM) + ln_b.astype(f32).reshape(RW_HEADS, RW_HEAD_DIM)
    y = y + jnp.sum(r * k * r_k.astype(f32), axis=-1, keepdims=True) * v
    return (y.reshape(B, S, RW_WIDTH) * gate).astype(zr.dtype)


def _gmlp_branch(zu, zv, ln_g, ln_b, ws, bs):
    B, S, _ = zu.shape
    u = jax.nn.gelu(zu)
    v = _layernorm(jax.nn.gelu(zv), ln_g, ln_b, GM_LN_EPS)
    vb = v.reshape(B, S // GM_CHUNK, GM_CHUNK, GM_GROUPS, GM_GROUP_DIM)
    mask = jnp.tril(jnp.ones((GM_CHUNK, GM_CHUNK), dtype=bool))
    w_c = jnp.where(mask[None], ws, jnp.zeros_like(ws))
    s = jnp.einsum('gtp,bnpgc->bntgc', w_c, vb) + bs.T[None, None, :, :, None]
    return u * s.reshape(B, S, GM_WIDTH)


def _peer(x, wq, keys, u_tab, v_tab):
    B, S, D = x.shape
    T = B * S
    xt = x.reshape(T // PEER_TOKEN_BLOCK, PEER_TOKEN_BLOCK, D)

    def block(xb):
        tb = xb.shape[0]
        q = (xb @ wq).reshape(tb, PEER_HEADS, 2, PEER_HALF).astype(jnp.float32)
        sc = jnp.einsum('thpc,hpkc->thpk', q, keys.astype(jnp.float32))
        s_top, i_top = lax.top_k(sc, PEER_TOPK)
        cand = s_top[:, :, 0, :, None] + s_top[:, :, 1, None, :]
        best, pos = lax.top_k(cand.reshape(tb, PEER_HEADS, PEER_TOPK * PEER_TOPK), PEER_TOPK)
        idx = (jnp.take_along_axis(i_top[:, :, 0, :], pos // PEER_TOPK, axis=-1) * PEER_KEYS
               + jnp.take_along_axis(i_top[:, :, 1, :], pos % PEER_TOPK, axis=-1))
        gw = jax.nn.softmax(best, axis=-1).astype(xb.dtype)
        u_sel = u_tab[idx]
        act = jax.nn.gelu(jnp.einsum('thkd,td->thk', u_sel, xb))
        v_sel = v_tab[idx]
        return jnp.einsum('thk,thkd->td', gw * act, v_sel)

    out = lax.map(block, xt)
    return out.reshape(B, S, D)


def setup_inputs(seed: int = 0) -> dict:
    key = jax.random.key(seed)
    ks = jax.random.split(key, 32)

    def nrm(j, shape, scale):
        return scale * jax.random.normal(ks[j], shape, jnp.float32)

    L = DEPTH
    D = D_MODEL
    return {
        "x": nrm(0, (BATCH, SEQ, D), 1.0),
        "p": nrm(1, (DEPTH, BATCH, SEQ, PLE_DIM), 1.0),
        "norm_mix": 1.0 + nrm(2, (L, D), 0.02),
        "norm_ffn": 1.0 + nrm(3, (L, D), 0.02),
        "norm_final": 1.0 + nrm(4, (D,), 0.02),
        "w_in": nrm(5, (L, 2 * D, C_IN), (2 * D) ** -0.5),
        "rw_w0": nrm(6, (L, RW_WIDTH), 0.5),
        "rw_w2": nrm(7, (L, RW_DECAY_LORA, RW_WIDTH), 0.5 * RW_DECAY_LORA ** -0.5),
        "rw_a0": nrm(8, (L, RW_WIDTH), 0.1),
        "rw_a2": nrm(9, (L, RW_AAA_LORA, RW_WIDTH), 0.5 * RW_AAA_LORA ** -0.5),
        "rw_g2": nrm(10, (L, RW_GATE_LORA, RW_WIDTH), RW_GATE_LORA ** -0.5),
        "rw_kk": 0.85 + nrm(11, (L, RW_WIDTH), 0.02),
        "rw_ka": 1.0 + nrm(12, (L, RW_WIDTH), 0.02),
        "rw_rk": nrm(13, (L, RW_HEADS, RW_HEAD_DIM), 0.1),
        "rw_ln_g": 1.0 + nrm(14, (L, RW_WIDTH), 0.02),
        "rw_ln_b": nrm(15, (L, RW_WIDTH), 0.02),
        "rw_mv_w1": nrm(16, (L - 1, 2 * D, RW_MV_LORA), (2 * D) ** -0.5),
        "rw_mv_w2": nrm(17, (L - 1, RW_MV_LORA, RW_WIDTH), RW_MV_LORA ** -0.5),
        "rw_mv_v0": nrm(18, (L - 1, RW_WIDTH), 0.1),
        "gm_ln_g": 1.0 + nrm(19, (L, GM_WIDTH), 0.02),
        "gm_ln_b": nrm(20, (L, GM_WIDTH), 0.02),
        "gm_ws": nrm(21, (L, GM_GROUPS, GM_CHUNK, GM_CHUNK), 0.5 * GM_CHUNK ** -0.5),
        "gm_bs": 1.0 + nrm(22, (L, GM_GROUPS, GM_CHUNK), 0.02),
        "w_proj_a": nrm(23, (L, RW_WIDTH, D), RW_WIDTH ** -0.5),
        "w_proj_b": nrm(24, (L, GM_WIDTH, D), GM_WIDTH ** -0.5),
        "w_out": nrm(25, (L, D, D), D ** -0.5),
        "peer_wq": nrm(26, (L, D, PEER_HEADS * PEER_DKEY), D ** -0.5),
        "peer_keys": nrm(27, (L, PEER_HEADS, 2, PEER_KEYS, PEER_HALF), PEER_HALF ** -0.5),
        "peer_u": nrm(28, (L, PEER_EXPERTS, D), D ** -0.5),
        "peer_v": nrm(29, (L, PEER_EXPERTS, D), 0.1),
        "ple_w": nrm(30, (L, PLE_DIM, D), 0.5 * PLE_DIM ** -0.5),
        "ple_gate": nrm(31, (L, D, D), D ** -0.5),
    }


def reference(x, p, norm_mix, norm_ffn, norm_final, w_in, rw_w0, rw_w2, rw_a0, rw_a2, rw_g2,
              rw_kk, rw_ka, rw_rk, rw_ln_g, rw_ln_b, rw_mv_w1, rw_mv_w2, rw_mv_v0,
              gm_ln_g, gm_ln_b, gm_ws, gm_bs, w_proj_a, w_proj_b, w_out,
              peer_wq, peer_keys, peer_u, peer_v, ple_w, ple_gate):
    split_pts = _split_points()
    h = x
    v_first = None
    for i in range(DEPTH):
        n = _rmsnorm(h, norm_mix[i])
        nx = jnp.concatenate([n, _token_shift(n)], axis=-1)
        z = nx @ w_in[i]
        zr, zk, zv, zw, za, zg, zu, zgv, zga, zgb = jnp.split(z, split_pts, axis=-1)
        if i == 0:
            v_first = zv
        else:
            vmix = jax.nn.sigmoid(rw_mv_v0[i - 1] + (nx @ rw_mv_w1[i - 1]) @ rw_mv_w2[i - 1])
            zv = zv + (v_first - zv) * vmix
        ya = _rwkv7_branch(zr, zk, zv, zw, za, zg, rw_w0[i], rw_w2[i], rw_a0[i], rw_a2[i], rw_g2[i],
                           rw_kk[i], rw_ka[i], rw_rk[i], rw_ln_g[i], rw_ln_b[i])
        yb = _gmlp_branch(zu, zgv, gm_ln_g[i], gm_ln_b[i], gm_ws[i], gm_bs[i])
        merged = (jax.nn.sigmoid(zga) * (ya @ w_proj_a[i])
                  + jax.nn.sigmoid(zgb) * (yb @ w_proj_b[i]))
        h = h + merged @ w_out[i]
        n2 = _rmsnorm(h, norm_ffn[i])
        h = h + _peer(n2, peer_wq[i], peer_keys[i], peer_u[i], peer_v[i])
        h = h + (p[i] @ ple_w[i]) * jax.nn.sigmoid(n2 @ ple_gate[i])
    return _rmsnorm(h, norm_final)
```

```cpp
#include <hip/hip_runtime.h>
#include <cstdio>
#include <cstdint>
namespace pg8 {
#define PG8_LAS __attribute__((address_space(3)))
typedef unsigned short bf16_t;
typedef short bf16x8 __attribute__((ext_vector_type(8)));
typedef float f32x4 __attribute__((ext_vector_type(4)));
typedef unsigned u32x4 __attribute__((ext_vector_type(4)));
constexpr int BM = 256, BK = 64, HALF = 128, HTB = HALF * BK * 2  , STAGE_BYTES = 8 * HTB, NXCD = 8, WGM = 8;

__host__ __device__ __forceinline__ int lds_byte(int r, int c) { const int st = (r >> 4) * 2 + (c >> 5), rr = r & 15, cc = c & 31, ob = rr * 64 + cc * 2; return st * 1024 + (ob ^ (((ob >> 9) & 1) << 5)); }
__host__ __device__ __forceinline__ void stage_rc(int b, int& R, int& C) { const int st = b / 1024, sb = b % 1024, swz = sb ^ (((sb >> 9) & 1) << 5); R = (st >> 1) * 16 + swz / 64; C = (st & 1) * 32 + (swz % 64) / 2; }
__host__ __device__ __forceinline__ int perm32(int rho) { const int n = rho >> 4, i = rho & 15; return 8 * (i >> 2) + 4 * n + (i & 3); }

struct Unit { int pm, pn; };
struct Gemm { const bf16_t* A; const bf16_t* Bt; int M, N, K, lda; };

struct StaticOrder {
    int nM, nN, nwg, G, c;
    __host__ __device__ void init(int M, int N, int G_, int c_) { nM = M / BM; nN = N / BM; nwg = nM * nN; G = G_; c = c_; }
    __host__ __device__ bool next(int i, Unit& u) const {
        const long L = (long)i * G + c; if (L >= nwg) return false;
        int wgid = (int)L; { const int q = nwg / NXCD, r = nwg % NXCD, xcd = wgid % NXCD, off = wgid / NXCD; wgid = (xcd < r ? xcd * (q + 1) : r * (q + 1) + (xcd - r) * q) + off; }
        const int nig = WGM * nN, gid = wgid / nig, fm = gid * WGM, gsz = (nM - fm) < WGM ? (nM - fm) : WGM;
        u.pm = fm + ((wgid % nig) % gsz); u.pn = (wgid % nig) / gsz; return true;
    }
    __device__ __forceinline__ void a_ready(const Unit&) const {}
    __device__ __forceinline__ void done(const Unit&) const {}
};
__device__ __forceinline__ unsigned cvt_pk_bf16(float lo, float hi) { unsigned r; asm volatile("v_cvt_pk_bf16_f32 %0, %1, %2" : "=v"(r) : "v"(lo), "v"(hi)); return r; }

__device__ __forceinline__ float fsig(float x) { return __builtin_amdgcn_rcpf(1.f + __builtin_amdgcn_exp2f(-1.44269504f * x)); }
__device__ __forceinline__ float fgelu(float x) { return x * fsig(1.5957691216f * (x + 0.044715f * x * x * x)); }
__device__ __forceinline__ float bflo(unsigned w) { return __builtin_bit_cast(float, w << 16); }
__device__ __forceinline__ float bfhi(unsigned w) { return __builtin_bit_cast(float, w & 0xffff0000u); }
__device__ __forceinline__ void unpk8(const u32x4 w, f32x4& a, f32x4& b) { a = (f32x4){bflo(w.x), bfhi(w.x), bflo(w.y), bfhi(w.y)}; b = (f32x4){bflo(w.z), bfhi(w.z), bflo(w.w), bfhi(w.w)}; }
__device__ __forceinline__ u32x4 pk8(const f32x4 a, const f32x4 b) { u32x4 w; w.x = cvt_pk_bf16(a[0], a[1]); w.y = cvt_pk_bf16(a[2], a[3]); w.z = cvt_pk_bf16(b[0], b[1]); w.w = cvt_pk_bf16(b[2], b[3]); return w; }
__device__ __forceinline__ f32x4 act4(f32x4 v, int kind) {
    if (kind == 1) { v = (f32x4){fgelu(v[0]), fgelu(v[1]), fgelu(v[2]), fgelu(v[3])}; }
    else if (kind == 2) { v = (f32x4){fsig(v[0]), fsig(v[1]), fsig(v[2]), fsig(v[3])}; }
    else if (kind == 3) { v = (f32x4){2.f * fsig(2.f * v[0]) - 1.f, 2.f * fsig(2.f * v[1]) - 1.f, 2.f * fsig(2.f * v[2]) - 1.f, 2.f * fsig(2.f * v[3]) - 1.f}; }
    return v;
}
#define EPI_ROWS_BEGIN _Pragma("unroll") for (int ai = 0; ai < 2; ++ai) _Pragma("unroll") for (int m = 0; m < 4; ++m) { const size_t row = (size_t)(row0 + ai * HALF + m * 16);
#define EPI_ROWS_END }

struct EpiZ {
    static constexpr bool PERM = true, AFTER_DRAIN = false;
    bf16_t *zrkv, *zl, *guv, *sg, *vf;
    __device__ __forceinline__ void operator()(const f32x4 (&acc)[2][2][4][2], const Unit& u, int wr, int wc, int fr, int fq) const {
        const int pn = u.pn, row0 = u.pm * BM + wr * 64 + fr;
        bf16_t* dst; int ld, colt, k0, k1;
        if (pn < 12)       { dst = zrkv; ld = 3072; colt = pn * 256;        k0 = 0; k1 = 0; }
        else if (pn == 12) { dst = zl;   ld = 512;  colt = 0;               k0 = (wc < 2) ? 3 : 0; k1 = 2; }
        else if (pn == 13) { dst = zl;   ld = 512;  colt = 256;             k0 = 0; k1 = 0; }
        else if (pn < 22)  { dst = guv;  ld = 2048; colt = (pn - 14) * 256; k0 = 1; k1 = 1; }
        else               { dst = sg;   ld = 2048; colt = (pn - 22) * 256; k0 = 2; k1 = 2; }
        const int col0 = colt + wc * 32 + 8 * fq;
        const bool dovf = (vf != nullptr) && pn >= 8 && pn < 12;
        const int vcol0 = (pn - 8) * 256 + wc * 32 + 8 * fq;
        EPI_ROWS_BEGIN
            bf16_t* rowp = dst + row * ld + col0;
#pragma unroll
            for (int bj = 0; bj < 2; ++bj) { const int kind = bj ? k1 : k0;
                const u32x4 w = pk8(act4(acc[ai][bj][m][0], kind), act4(acc[ai][bj][m][1], kind));
                *(u32x4*)(rowp + bj * HALF) = w;
                if (dovf) *(u32x4*)(vf + row * 1024 + vcol0 + bj * HALF) = w; }
        EPI_ROWS_END
    }
};
struct EpiLora {
    static constexpr bool PERM = true, AFTER_DRAIN = false;
    bf16_t* ew; size_t stride; const float *w0, *a0;
    __device__ __forceinline__ void operator()(const f32x4 (&acc)[2][2][4][2], const Unit& u, int wr, int wc, int fr, int fq) const {
        const int sel = u.pn >> 2, row0 = u.pm * BM + wr * 64 + fr, col0 = (u.pn & 3) * 256 + wc * 32 + 8 * fq;
        bf16_t* dst = ew + (size_t)sel * stride;
        const float* bp = sel == 0 ? w0 : a0;
        f32x4 bv[2][2];
#pragma unroll
        for (int bj = 0; bj < 2; ++bj)
#pragma unroll
            for (int n = 0; n < 2; ++n) bv[bj][n] = (sel < 2) ? *(const f32x4*)(bp + col0 + bj * HALF + 4 * n) : (f32x4){0.f, 0.f, 0.f, 0.f};
        EPI_ROWS_BEGIN
            bf16_t* rowp = dst + row * 1024 + col0;
#pragma unroll
            for (int bj = 0; bj < 2; ++bj) { f32x4 v0 = acc[ai][bj][m][0] + bv[bj][0], v1 = acc[ai][bj][m][1] + bv[bj][1];
                if (sel < 2) { v0 = act4(v0, 2); v1 = act4(v1, 2); }
                if (sel == 0) { v0 = v0 * 0.60653066f; v1 = v1 * 0.60653066f; }
                *(u32x4*)(rowp + bj * HALF) = pk8(v0, v1); }
        EPI_ROWS_END
    }
};
struct EpiMv {
    static constexpr bool PERM = true, AFTER_DRAIN = false;
    bf16_t* zrkv; const bf16_t* vf; const float* v0b;
    __device__ __forceinline__ void operator()(const f32x4 (&acc)[2][2][4][2], const Unit& u, int wr, int wc, int fr, int fq) const {
        const int row0 = u.pm * BM + wr * 64 + fr, col0 = u.pn * 256 + wc * 32 + 8 * fq;
        f32x4 bv[2][2];
#pragma unroll
        for (int bj = 0; bj < 2; ++bj)
#pragma unroll
            for (int n = 0; n < 2; ++n) bv[bj][n] = *(const f32x4*)(v0b + col0 + bj * HALF + 4 * n);
        EPI_ROWS_BEGIN
#pragma unroll
            for (int bj = 0; bj < 2; ++bj) { bf16_t* zp = zrkv + row * 3072 + 2048 + col0 + bj * HALF;
                f32x4 z0, z1, f0, f1; unpk8(*(const u32x4*)zp, z0, z1); unpk8(*(const u32x4*)(vf + row * 1024 + col0 + bj * HALF), f0, f1);
                const f32x4 m0 = act4(acc[ai][bj][m][0] + bv[bj][0], 2), m1 = act4(acc[ai][bj][m][1] + bv[bj][1], 2);
                *(u32x4*)zp = pk8(z0 + (f0 - z0) * m0, z1 + (f1 - z1) * m1); }
        EPI_ROWS_END
    }
};
struct EpiPlain {
    static constexpr bool PERM = true, AFTER_DRAIN = false;
    bf16_t* o; int ld;
    __device__ __forceinline__ void operator()(const f32x4 (&acc)[2][2][4][2], const Unit& u, int wr, int wc, int fr, int fq) const {
        const int row0 = u.pm * BM + wr * 64 + fr, col0 = u.pn * 256 + wc * 32 + 8 * fq;
        EPI_ROWS_BEGIN
#pragma unroll
            for (int bj = 0; bj < 2; ++bj) *(u32x4*)(o + row * ld + col0 + bj * HALF) = pk8(acc[ai][bj][m][0], acc[ai][bj][m][1]);
        EPI_ROWS_END
    }
};
template <bool FIRST> struct EpiMerge {
    static constexpr bool PERM = true, AFTER_DRAIN = false;
    const bf16_t* sg; const bf16_t* m1; bf16_t* o;
    __device__ __forceinline__ void operator()(const f32x4 (&acc)[2][2][4][2], const Unit& u, int wr, int wc, int fr, int fq) const {
        const int row0 = u.pm * BM + wr * 64 + fr, col0 = u.pn * 256 + wc * 32 + 8 * fq;
        EPI_ROWS_BEGIN
#pragma unroll
            for (int bj = 0; bj < 2; ++bj) { const int c = col0 + bj * HALF;
                f32x4 g0, g1; unpk8(*(const u32x4*)(sg + row * 2048 + (FIRST ? 0 : 1024) + c), g0, g1);
                f32x4 v0 = g0 * acc[ai][bj][m][0], v1 = g1 * acc[ai][bj][m][1];
                if (!FIRST) { f32x4 p0, p1; unpk8(*(const u32x4*)(m1 + row * 1024 + c), p0, p1); v0 = v0 + p0; v1 = v1 + p1; }
                *(u32x4*)(o + row * 1024 + c) = pk8(v0, v1); }
        EPI_ROWS_END
    }
};
struct EpiResid {
    static constexpr bool PERM = false, AFTER_DRAIN = false;
    float* h;
    __device__ __forceinline__ void operator()(const f32x4 (&acc)[2][2][4][2], const Unit& u, int wr, int wc, int fr, int fq) const {
        const int row0 = u.pm * BM + wr * 64 + fr, col0 = u.pn * 256 + wc * 32 + 4 * fq;
        EPI_ROWS_BEGIN
            float* rowp = h + row * 1024 + col0;
#pragma unroll
            for (int bj = 0; bj < 2; ++bj)
#pragma unroll
                for (int n = 0; n < 2; ++n) { f32x4* p = (f32x4*)(rowp + bj * HALF + n * 16); *p = *p + acc[ai][bj][m][n]; }
        EPI_ROWS_END
    }
};
struct EpiQG {
    static constexpr bool PERM = true, AFTER_DRAIN = false;
    bf16_t* q; const bf16_t* pw; float* h;
    __device__ __forceinline__ void operator()(const f32x4 (&acc)[2][2][4][2], const Unit& u, int wr, int wc, int fr, int fq) const {
        const int row0 = u.pm * BM + wr * 64 + fr;
        if (u.pn < 8) { const int col0 = u.pn * 256 + wc * 32 + 8 * fq;
            EPI_ROWS_BEGIN
#pragma unroll
                for (int bj = 0; bj < 2; ++bj) *(u32x4*)(q + row * 2048 + col0 + bj * HALF) = pk8(acc[ai][bj][m][0], acc[ai][bj][m][1]);
            EPI_ROWS_END
        } else { const int col0 = (u.pn - 8) * 256 + wc * 32 + 8 * fq;
            EPI_ROWS_BEGIN
#pragma unroll
                for (int bj = 0; bj < 2; ++bj) { const int c = col0 + bj * HALF;
                    f32x4 p0, p1; unpk8(*(const u32x4*)(pw + row * 1024 + c), p0, p1);
                    f32x4* hp = (f32x4*)(h + row * 1024 + c);
                    hp[0] = hp[0] + p0 * act4(acc[ai][bj][m][0], 2); hp[1] = hp[1] + p1 * act4(acc[ai][bj][m][1], 2); }
            EPI_ROWS_END
        }
    }
};
template <class Epi, class Sched, bool ALIGN_EPI = false, bool SP2 = false>
__device__ __forceinline__ void gemm_phase(PG8_LAS unsigned char* lds, const Gemm g, const Sched& S, const Epi& E) {
    int tidq = threadIdx.x; asm volatile("" : "+v"(tidq));
    const int tid = tidq, wid = __builtin_amdgcn_readfirstlane(tid >> 6), lane = tid & 63, wr = wid >> 2, wc = wid & 3, fr = lane & 15, fq = lane >> 4;
    int Kq = g.K, ldaq = g.lda; const bf16_t* gA = g.A; const bf16_t* gB = g.Bt; asm volatile("" : "+s"(Kq), "+s"(ldaq), "+s"(gA), "+s"(gB));
    const int K = Kq, nt = K / BK;
    unsigned voffA[2], voffB[2];
#pragma unroll
    for (int i = 0; i < 2; ++i) { int R, C; stage_rc(tid * 16 + i * 8192, R, C); const int Rb = Epi::PERM ? ((R & ~31) + perm32(R & 31)) : R;
        voffA[i] = (unsigned)(R * ldaq + C) * 2u; voffB[i] = (unsigned)(Rb * K + C) * 2u; }
    const size_t kstep = (size_t)(BK * 2);
    const size_t hstepA = (size_t)HALF * ldaq * 2, hstepB = (size_t)HALF * K * 2;
    const size_t tstepA = 2 * hstepA, tstepB = 2 * hstepB;
    const unsigned ldsw = (unsigned)wid * 1024u;
    const int aoff = lds_byte(wr * 64 + fr, fq * 8), boff = lds_byte(wc * 32 + fr, fq * 8);
#define PG8_SA(b, h) (((b) * 2 + (h)) * HTB)
#define PG8_SB(b, h) ((4 + (b) * 2 + (h)) * HTB)
#define PG8_STAGE(bufoff, gbase, voff) do { _Pragma("unroll") for (int _i = 0; _i < 2; ++_i) \
        __builtin_amdgcn_global_load_lds((const unsigned*)((const char*)(gbase) + (voff)[_i]), (PG8_LAS unsigned*)(lds + (bufoff) + ldsw + _i * 8192), 16, 0, 0); } while (0)
#define PG8_LDA(dst, b, h) do { _Pragma("unroll") for (int m = 0; m < 4; ++m) _Pragma("unroll") for (int k = 0; k < 2; ++k) dst[m][k] = *(const PG8_LAS bf16x8*)(lds + PG8_SA(b, h) + aoff + m * 2048 + k * 1024); } while (0)
#define PG8_LDB(dst, b, h) do { _Pragma("unroll") for (int n = 0; n < 2; ++n) _Pragma("unroll") for (int k = 0; k < 2; ++k) dst[n][k] = *(const PG8_LAS bf16x8*)(lds + PG8_SB(b, h) + boff + n * 2048 + k * 1024); } while (0)
#define PG8_MMA(ai, bj, At, Bt) do { __builtin_amdgcn_s_setprio(1); _Pragma("unroll") for (int m = 0; m < 4; ++m) _Pragma("unroll") for (int n = 0; n < 2; ++n) _Pragma("unroll") for (int k = 0; k < 2; ++k) \
        acc[ai][bj][m][n] = __builtin_amdgcn_mfma_f32_16x16x32_bf16(Bt[n][k], At[m][k], acc[ai][bj][m][n], 0, 0, 0); __builtin_amdgcn_s_setprio(0); } while (0)
#define PG8_WAIT_V(n) asm volatile("s_waitcnt vmcnt(" #n ")" ::: "memory")
#define PG8_WAIT_L(n) asm volatile("s_waitcnt lgkmcnt(" #n ")" ::: "memory")
#define PG8_BAR __builtin_amdgcn_s_barrier()
#define PG8_SCHED __builtin_amdgcn_sched_barrier(0)
    Unit cur, nxt; int ui = 0;
    if (!S.next(0, cur)) return;
    f32x4 acc[2][2][4][2];
#pragma unroll
    for (int a = 0; a < 2; ++a)
#pragma unroll
        for (int b = 0; b < 2; ++b)
#pragma unroll
            for (int m = 0; m < 4; ++m)
#pragma unroll
                for (int n = 0; n < 2; ++n) acc[a][b][m][n] = (f32x4){0.f, 0.f, 0.f, 0.f};
    bf16x8 At[4][2], B0[2][2], B1[2][2];
    const char* cA = (const char*)gA + (size_t)cur.pm * tstepA; const char* cB = (const char*)gB + (size_t)cur.pn * tstepB;
    S.a_ready(cur);
    if constexpr (SP2) {
        PG8_STAGE(PG8_SB(0, 0), cB, voffB); PG8_STAGE(PG8_SB(0, 1), cB + hstepB, voffB); PG8_STAGE(PG8_SA(0, 0), cA, voffA); PG8_STAGE(PG8_SA(0, 1), cA + hstepA, voffA);
        if (wr == 1) PG8_BAR;
        PG8_WAIT_V(2); PG8_BAR;
        PG8_STAGE(PG8_SB(1, 0), cB + kstep, voffB); PG8_STAGE(PG8_SA(1, 0), cA + kstep, voffA); PG8_STAGE(PG8_SB(1, 1), cB + hstepB + kstep, voffB);
        PG8_WAIT_V(6); PG8_BAR;
    } else {
        PG8_STAGE(PG8_SB(0, 0), cB, voffB); PG8_STAGE(PG8_SA(0, 0), cA, voffA); PG8_STAGE(PG8_SB(0, 1), cB + hstepB, voffB); PG8_STAGE(PG8_SA(0, 1), cA + hstepA, voffA);
        if (wr == 1) PG8_BAR;
        PG8_WAIT_V(4); PG8_BAR;
        PG8_STAGE(PG8_SB(1, 0), cB + kstep, voffB); PG8_STAGE(PG8_SA(1, 0), cA + kstep, voffA); PG8_STAGE(PG8_SB(1, 1), cB + hstepB + kstep, voffB);
        PG8_WAIT_V(6); PG8_BAR;
    }
    for (;;) {
        const bool has_next = S.next(ui + 1, nxt);
        const char* nA = has_next ? (const char*)gA + (size_t)nxt.pm * tstepA : cA; const char* nB = has_next ? (const char*)gB + (size_t)nxt.pn * tstepB : cB;
        for (int t = 0; t < nt; t += 2) {
            const bool last = (t == nt - 2);
            const char* a1 = cA + (size_t)(t + 1) * kstep;
            const char* a2 = last ? nA : cA + (size_t)(t + 2) * kstep; const char* b2 = last ? nB : cB + (size_t)(t + 2) * kstep;
            const char* a3 = a2 + kstep; const char* b3 = b2 + kstep;
            if (last && has_next) S.a_ready(nxt);
            if constexpr (SP2) {
            PG8_LDB(B0, 0, 0); PG8_LDB(B1, 0, 1); PG8_SCHED; PG8_LDA(At, 0, 0); PG8_STAGE(PG8_SA(1, 1), a1 + hstepA, voffA);
            PG8_WAIT_V(8); PG8_WAIT_L(0); PG8_BAR; PG8_MMA(0, 0, At, B0); PG8_MMA(0, 1, At, B1); PG8_BAR; PG8_SCHED;
            PG8_LDA(At, 0, 1); PG8_STAGE(PG8_SB(0, 0), b2, voffB); PG8_STAGE(PG8_SB(0, 1), b2 + hstepB, voffB); PG8_STAGE(PG8_SA(0, 0), a2, voffA);
            PG8_WAIT_V(8); PG8_WAIT_L(0); PG8_BAR; PG8_MMA(1, 0, At, B0); PG8_MMA(1, 1, At, B1); PG8_BAR; PG8_SCHED;
            PG8_LDB(B0, 1, 0); PG8_LDB(B1, 1, 1); PG8_SCHED; PG8_LDA(At, 1, 0); PG8_STAGE(PG8_SA(0, 1), a2 + hstepA, voffA);
            PG8_WAIT_V(8); PG8_WAIT_L(0); PG8_BAR; PG8_MMA(0, 0, At, B0); PG8_MMA(0, 1, At, B1); PG8_BAR; PG8_SCHED;
            PG8_LDA(At, 1, 1); PG8_STAGE(PG8_SB(1, 0), b3, voffB); PG8_STAGE(PG8_SB(1, 1), b3 + hstepB, voffB); PG8_STAGE(PG8_SA(1, 0), a3, voffA);
            PG8_WAIT_V(8); PG8_WAIT_L(0); PG8_BAR; PG8_MMA(1, 0, At, B0); PG8_MMA(1, 1, At, B1); PG8_BAR; PG8_SCHED;
            } else {
            PG8_LDB(B0, 0, 0); PG8_SCHED; PG8_LDA(At, 0, 0); PG8_STAGE(PG8_SA(1, 1), a1 + hstepA, voffA);
            PG8_WAIT_L(8); PG8_BAR; PG8_WAIT_L(0); PG8_MMA(0, 0, At, B0); PG8_BAR; PG8_SCHED;
            PG8_LDB(B1, 0, 1); PG8_STAGE(PG8_SB(0, 0), b2, voffB);
            PG8_BAR; PG8_WAIT_L(0); PG8_MMA(0, 1, At, B1); PG8_BAR;
            PG8_LDA(At, 0, 1); PG8_STAGE(PG8_SA(0, 0), a2, voffA);
            PG8_BAR; PG8_WAIT_L(0); PG8_MMA(1, 0, At, B0); PG8_BAR; PG8_SCHED;
            PG8_STAGE(PG8_SB(0, 1), b2 + hstepB, voffB);
            PG8_WAIT_V(6); PG8_BAR; PG8_MMA(1, 1, At, B1); PG8_BAR;
            PG8_LDB(B0, 1, 0); PG8_SCHED; PG8_LDA(At, 1, 0); PG8_STAGE(PG8_SA(0, 1), a2 + hstepA, voffA);
            PG8_WAIT_L(8); PG8_BAR; PG8_WAIT_L(0); PG8_MMA(0, 0, At, B0); PG8_BAR; PG8_SCHED;
            PG8_LDB(B1, 1, 1); PG8_STAGE(PG8_SB(1, 0), b3, voffB);
            PG8_BAR; PG8_WAIT_L(0); PG8_MMA(0, 1, At, B1); PG8_BAR;
            PG8_LDA(At, 1, 1); PG8_STAGE(PG8_SA(1, 0), a3, voffA);
            PG8_BAR; PG8_WAIT_L(0); PG8_MMA(1, 0, At, B0); PG8_BAR; PG8_SCHED;
            PG8_STAGE(PG8_SB(1, 1), b3 + hstepB, voffB);
            PG8_WAIT_V(6); PG8_BAR; PG8_MMA(1, 1, At, B1); PG8_BAR;
            }
        }
        if constexpr (ALIGN_EPI) { if (wr == 0) PG8_BAR; }
        if constexpr (!Epi::AFTER_DRAIN) { E(acc, cur, wr, wc, fr, fq); S.done(cur); }
        if (!has_next) break;
#pragma unroll
        for (int a = 0; a < 2; ++a)
#pragma unroll
            for (int b = 0; b < 2; ++b)
#pragma unroll
                for (int m = 0; m < 4; ++m)
#pragma unroll
                    for (int n = 0; n < 2; ++n) acc[a][b][m][n] = (f32x4){0.f, 0.f, 0.f, 0.f};
        cur = nxt; cA = nA; cB = nB; ++ui;
        if constexpr (ALIGN_EPI) { if (wr == 1) PG8_BAR; }
    }
    PG8_WAIT_V(0);
    if constexpr (!ALIGN_EPI) { if (wr == 0) PG8_BAR; }
    PG8_BAR;
    if constexpr (Epi::AFTER_DRAIN) { E.fused(acc, cur, wr, wc, fr, fq, lds, wid, lane); S.done(cur); }
#undef PG8_SA
#undef PG8_SB
#undef PG8_STAGE
#undef PG8_LDA
#undef PG8_LDB
#undef PG8_MMA
#undef PG8_WAIT_V
#undef PG8_WAIT_L
#undef PG8_BAR
#undef PG8_SCHED
}
}

constexpr int NB = 8, SEQ = 4096, T = NB * SEQ, D = 1024, DEPTH = 4, NZ = 7680, NWAVES = 8;
constexpr int CIN = 7424;
constexpr size_t MiB = 1u << 20;
constexpr size_t WS_CTL = 0, WS_LORA = 1 * MiB, WS_MV = 7 * MiB, ZERO_BYTES = 9 * MiB;
constexpr size_t LORA_BYTES = 3072 * 256 * 2, MV_BYTES = 1024 * 256 * 2;
constexpr size_t WS_WIN = 10 * MiB, WS_PA = 40 * MiB, WS_PBT = 42 * MiB, WS_POUT = 44 * MiB, WS_WQG = 46 * MiB, WS_PLEW = 52 * MiB, WS_KEYS = 52 * MiB + 512 * 1024, WS_GMW = 53 * MiB, WS_U = 54 * MiB, WS_V = 86 * MiB;
constexpr size_t WS_VF = 118 * MiB, WS_PW = 182 * MiB, WS_PB = 246 * MiB, WS_NX = 262 * MiB, WS_ZRKV = 390 * MiB, WS_ZL = 582 * MiB, WS_GUV = 614 * MiB, WS_SG = 742 * MiB;
constexpr size_t WS_EW = 870 * MiB, WS_AR = 934 * MiB, WS_G = 998 * MiB, WS_END = 1062 * MiB;
constexpr size_t WS_YAB = WS_NX, WS_Q = WS_ZRKV, WS_SEL = WS_ZRKV + 128 * MiB, WS_M1 = WS_EW, WS_MG = WS_AR, WS_N2 = WS_G;
constexpr size_t WIN_ZERO_OFF = WS_WIN + (size_t)3328 * 2048 * 2, WIN_ZERO_BYTES = (size_t)256 * 2048 * 2;
constexpr int CW_BAR = 4096;
constexpr int RING_BYTES = 131072, LDSCTL_OFF = RING_BYTES, MISC_OFF = LDSCTL_OFF + 320, LDS_BYTES = 147456;

#define LAS __attribute__((address_space(3)))
typedef unsigned short bf16;
typedef unsigned v4u __attribute__((ext_vector_type(4)));
typedef unsigned v2u __attribute__((ext_vector_type(2)));
typedef float f32x4 __attribute__((ext_vector_type(4)));
typedef float f32x2 __attribute__((ext_vector_type(2)));
typedef short bf16x8 __attribute__((ext_vector_type(8)));
using pg8::fsig; using pg8::fgelu; using pg8::bflo; using pg8::bfhi; using pg8::unpk8; using pg8::pk8; using pg8::cvt_pk_bf16;

#define XB_TMO      128
#define XB_XCNT(j)  (256  + 64 * (j))
#define XB_XSUB(j)  (1280 + 64 * (j))
#define XB_XGEN(j)  (2304 + 64 * (j))
#define XB_TOP      3328
#define XB_TOPGEN   3392
#define XCD_BAR_WORDS 3456
#define XB_SPIN_CAP (1u << 22)

__device__ __forceinline__ unsigned xb_ld(unsigned* p)              { return __hip_atomic_load(p, __ATOMIC_RELAXED, __HIP_MEMORY_SCOPE_AGENT); }
__device__ __forceinline__ unsigned xb_add(unsigned* p, unsigned v) { return __hip_atomic_fetch_add(p, v, __ATOMIC_RELAXED, __HIP_MEMORY_SCOPE_AGENT); }
__device__ __forceinline__ unsigned xb_xcc_id() { return (unsigned)__builtin_amdgcn_s_getreg((3 << 11) | 20) & 0xFu; }
#define XB_SPIN(cond, bar) do { unsigned _sp = 0; while (cond) { __builtin_amdgcn_s_sleep(1); \
    if ((++_sp & 255u) == 0u) { if (xb_ld(&(bar)[XB_TMO])) break; if (_sp > XB_SPIN_CAP) { atomicAdd(&(bar)[XB_TMO], 1u); break; } } } } while (0)

struct XcdBarrier { unsigned* bar; unsigned x; volatile LAS unsigned* st; };

__device__ __forceinline__ XcdBarrier xcd_barrier_post(unsigned* bar, volatile LAS unsigned* st) {
    XcdBarrier b; b.bar = bar; b.x = xb_xcc_id(); b.st = st;
    if (threadIdx.x == 0) (void)xb_add(&bar[XB_XCNT(b.x)], 1u);
    return b;
}
__device__ __forceinline__ void xcd_barrier_complete(unsigned* bar, unsigned x, unsigned& nloc, unsigned& nx) {
    const unsigned G = gridDim.x * gridDim.y * gridDim.z;
    unsigned sum, cnt, mine, sp = 0u;
    for (;;) {
        sum = 0u; cnt = 0u; mine = 0u;
#pragma unroll
        for (unsigned j = 0; j < 16; ++j) { const unsigned c = xb_ld(&bar[XB_XCNT(j)]); sum += c; cnt += (c > 0u) ? 1u : 0u; mine = (j == x) ? c : mine; }
        if (sum == G) break;
        __builtin_amdgcn_s_sleep(1);
        if ((++sp & 255u) == 0u) { if (xb_ld(&bar[XB_TMO])) break; if (sp > XB_SPIN_CAP) { atomicAdd(&bar[XB_TMO], 1u); break; } }
    }
    nloc = mine > 0u ? mine : 1u; nx = cnt > 0u ? cnt : 1u;
}
__device__ __forceinline__ void xcd_barrier(const XcdBarrier& b) {
    asm volatile("s_waitcnt vmcnt(0)" ::: "memory");
    __syncthreads();
    if (threadIdx.x == 0) {
        unsigned* bar = b.bar;
        __builtin_amdgcn_s_waitcnt(0);
        unsigned nloc = b.st[0], nx = b.st[1];
        if (nloc == 0u) { xcd_barrier_complete(bar, b.x, nloc, nx); b.st[0] = nloc; b.st[1] = nx; }
        const unsigned old = xb_add(&bar[XB_XSUB(b.x)], 1u);
        const unsigned gen = old / nloc;
        if (old + 1u == (gen + 1u) * nloc) {
            __builtin_amdgcn_fence(__ATOMIC_RELEASE, "agent");
            asm volatile("s_waitcnt vmcnt(0)" ::: "memory");
            const unsigned og = xb_add(&bar[XB_TOP], 1u);
            const unsigned tg = og / nx;
            if (og + 1u == (tg + 1u) * nx) xb_add(&bar[XB_TOPGEN], 1u);
            else XB_SPIN(xb_ld(&bar[XB_TOPGEN]) == tg, bar);
            __builtin_amdgcn_fence(__ATOMIC_ACQUIRE, "agent");
            xb_add(&bar[XB_XGEN(b.x)], 1u);
            asm volatile("s_waitcnt vmcnt(0)" ::: "memory");
        } else {
            XB_SPIN(xb_ld(&bar[XB_XGEN(b.x)]) == gen, bar);
            __builtin_amdgcn_fence(__ATOMIC_ACQUIRE, "agent");
            asm volatile("s_waitcnt vmcnt(0)" ::: "memory");
        }
    }
    __syncthreads();
}

struct Args { const float* in[32]; float* out; unsigned char* ws; };
struct Frame {
    LAS unsigned char* lds;
    int tid, lane, wave, G, bx;
    unsigned char* ws; float* h;
};
__device__ __forceinline__ void phase_ids(Frame& F) { int t = threadIdx.x; asm volatile("" : "+v"(t)); F.tid = t; F.lane = t & 63; F.wave = __builtin_amdgcn_readfirstlane(t >> 6); }
__device__ __forceinline__ float wave_sum(float v) {
#pragma unroll
    for (int o = 1; o < 64; o <<= 1) v += __shfl_xor(v, o);
    return v;
}
__device__ __forceinline__ float sum8(float v) { v += __shfl_xor(v, 1); v += __shfl_xor(v, 2); v += __shfl_xor(v, 4); return v; }

__device__ __forceinline__ void tr_item(const float* W, int ldw, int ncols, bf16* WT, int ldt, int koff, int row_off, LAS float* scr, int item, int lane) {
    const int nblk = ncols / 32, kb = item / nblk, nb = item % nblk, k0 = 64 * kb, n0 = 32 * nb;
#pragma unroll 8
    for (int i = 0; i < 32; ++i) { const int kk = 2 * i + (lane >> 5); scr[kk * 33 + (lane & 31)] = W[(size_t)(k0 + kk) * ldw + n0 + (lane & 31)]; }
    asm volatile("s_waitcnt lgkmcnt(0)" ::: "memory");
    const int c = lane & 7;
#pragma unroll
    for (int j = 0; j < 4; ++j) { const int n = (lane >> 3) + 8 * j; const LAS float* s = scr + (8 * c) * 33 + n;
        v4u o; o.x = cvt_pk_bf16(s[0 * 33], s[1 * 33]); o.y = cvt_pk_bf16(s[2 * 33], s[3 * 33]); o.z = cvt_pk_bf16(s[4 * 33], s[5 * 33]); o.w = cvt_pk_bf16(s[6 * 33], s[7 * 33]);
        *(v4u*)(WT + (size_t)(row_off + n0 + n) * ldt + koff + k0 + 8 * c) = o; }
    asm volatile("s_waitcnt lgkmcnt(0)" ::: "memory");
}
__device__ __forceinline__ void cvt_chunk(const float* src, bf16* dst, size_t chunk, int lane) {
    const f32x4* s = (const f32x4*)(src + chunk * 512) + lane * 2; const f32x4 a = s[0], b = s[1];
    *(v4u*)(dst + chunk * 512 + lane * 8) = pk8(a, b);
}
__device__ __forceinline__ void norm_row_nx(const float* hrow, float* hcopy, const float* g, bf16* NX, int t, int lane) {
    const f32x4* xr = (const f32x4*)hrow + lane; f32x4 v[4]; float s = 0.f;
#pragma unroll
    for (int j = 0; j < 4; ++j) { v[j] = xr[64 * j]; s += (v[j].x * v[j].x + v[j].y * v[j].y) + (v[j].z * v[j].z + v[j].w * v[j].w); }
    if (hcopy) {
#pragma unroll
        for (int j = 0; j < 4; ++j) ((f32x4*)hcopy)[lane + 64 * j] = v[j]; }
    const float rstd = 1.f / sqrtf(wave_sum(s) * (1.f / D) + 1e-6f);
    const int tt = t & (SEQ - 1);
#pragma unroll
    for (int j = 0; j < 4; ++j) { const f32x4 gv = ((const f32x4*)g)[lane + 64 * j]; const f32x4 o = v[j] * rstd * gv;
        v2u w; w.x = cvt_pk_bf16(o.x, o.y); w.y = cvt_pk_bf16(o.z, o.w);
        const int c = 4 * (lane + 64 * j);
        *(v2u*)(NX + (size_t)t * 2048 + c) = w;
        if (tt != SEQ - 1) *(v2u*)(NX + (size_t)(t + 1) * 2048 + 1024 + c) = w;
        if (tt == 0) *(v2u*)(NX + (size_t)t * 2048 + 1024 + c) = (v2u){0u, 0u}; }
}
__device__ __forceinline__ void norm_row_n2(const float* hrow, const float* g, bf16* N2row, int lane) {
    const f32x4* xr = (const f32x4*)hrow + lane; f32x4 v[4]; float s = 0.f;
#pragma unroll
    for (int j = 0; j < 4; ++j) { v[j] = xr[64 * j]; s += (v[j].x * v[j].x + v[j].y * v[j].y) + (v[j].z * v[j].z + v[j].w * v[j].w); }
    const float rstd = 1.f / sqrtf(wave_sum(s) * (1.f / D) + 1e-6f);
#pragma unroll
    for (int j = 0; j < 4; ++j) { const f32x4 gv = ((const f32x4*)g)[lane + 64 * j]; const f32x4 o = v[j] * rstd * gv;
        v2u w; w.x = cvt_pk_bf16(o.x, o.y); w.y = cvt_pk_bf16(o.z, o.w);
        *(v2u*)(N2row + 4 * (lane + 64 * j)) = w; }
}

__device__ __forceinline__ void prep_phase(Frame& F, const Args& a, int layer) {
    phase_ids(F);
    LAS float* scr = (LAS float*)(F.lds + F.wave * 16384);
    const int gw = F.bx * NWAVES + F.wave, NGW = F.G * NWAVES, lane = F.lane;
    unsigned char* ws = F.ws;
    bf16* WIN = (bf16*)(ws + WS_WIN); bf16* LORA = (bf16*)(ws + WS_LORA + (size_t)layer * LORA_BYTES); bf16* MVT = (bf16*)(ws + WS_MV + (size_t)(layer > 0 ? layer - 1 : 0) * MV_BYTES);
    const float* w_in = a.in[5] + (size_t)layer * 2048 * CIN;
    const int mvn = layer > 0 ? 32 : 0;
    const int c1 = 32 * 104, c2 = 32 * 128, c3 = mvn, c4 = 32, c5 = 32, c6 = 64, c7 = 512, c10 = 1024, c12 = 128;
    const int total = c1 + c2 + c3 + c4 + c5 + c6 + 3 * c7 + c10 + c7 + c12;
    for (int it = gw; it < total; it += NGW) {
        int r = it;
        if (r < c1) { tr_item(w_in, CIN, 3328, WIN, 2048, 0, 0, scr, r, lane); continue; } r -= c1;
        if (r < c2) { tr_item(w_in + 3328, CIN, 4096, WIN, 2048, 0, 3584, scr, r, lane); continue; } r -= c2;
        if (r < c3) { tr_item(a.in[16] + (size_t)(layer - 1) * 2048 * 32, 32, 32, WIN, 2048, 0, 3328, scr, r, lane); continue; } r -= c3;
        if (r < c4) { tr_item(a.in[7] + (size_t)layer * 64 * 1024, 1024, 1024, LORA, 256, 0, 0, scr, r, lane); continue; } r -= c4;
        if (r < c5) { tr_item(a.in[9] + (size_t)layer * 64 * 1024, 1024, 1024, LORA, 256, 64, 1024, scr, r, lane); continue; } r -= c5;
        if (r < c6) { tr_item(a.in[10] + (size_t)layer * 128 * 1024, 1024, 1024, LORA, 256, 128, 2048, scr, r, lane); continue; } r -= c6;
        if (r < c7) { tr_item(a.in[23] + (size_t)layer * D * D, D, D, (bf16*)(ws + WS_PA), D, 0, 0, scr, r, lane); continue; } r -= c7;
        if (r < c7) { tr_item(a.in[24] + (size_t)layer * D * D, D, D, (bf16*)(ws + WS_PBT), D, 0, 0, scr, r, lane); continue; } r -= c7;
        if (r < c7) { tr_item(a.in[25] + (size_t)layer * D * D, D, D, (bf16*)(ws + WS_POUT), D, 0, 0, scr, r, lane); continue; } r -= c7;
        if (r < c10) { tr_item(a.in[26] + (size_t)layer * D * 2048, 2048, 2048, (bf16*)(ws + WS_WQG), D, 0, 0, scr, r, lane); continue; } r -= c10;
        if (r < c7) { tr_item(a.in[31] + (size_t)layer * D * D, D, D, (bf16*)(ws + WS_WQG), D, 0, 2048, scr, r, lane); continue; } r -= c7;
        tr_item(a.in[30] + (size_t)layer * 256 * D, D, D, (bf16*)(ws + WS_PLEW), 256, 0, 0, scr, r, lane);
    }
    if (layer > 0) {
        const float* w2 = a.in[17] + (size_t)(layer - 1) * 32 * 1024;
        for (int it = gw; it < 512; it += NGW) { const int e = it * 64 + lane, n = e >> 5, k = e & 31; MVT[n * 256 + k] = (bf16)(cvt_pk_bf16(w2[k * 1024 + n], 0.f) & 0xffffu); }
    }
    {
        const float* keys = a.in[27] + (size_t)layer * 262144; const float* ut = a.in[28] + (size_t)layer * 16777216; const float* vt = a.in[29] + (size_t)layer * 16777216;
        const float* pin = a.in[1] + (size_t)layer * T * 256; const float* gws = a.in[21] + (size_t)layer * 131072;
        const int n1 = 512, n2 = 32768, n4 = 16384, n5 = 256, ntot = n1 + 2 * n2 + n4 + n5;
        for (int it = gw; it < ntot; it += NGW) {
            int r = it;
            if (r < n2) { cvt_chunk(ut, (bf16*)(ws + WS_U), r, lane); continue; } r -= n2;
            if (r < n2) { cvt_chunk(vt, (bf16*)(ws + WS_V), r, lane); continue; } r -= n2;
            if (r < n4) { cvt_chunk(pin, (bf16*)(ws + WS_PB), r, lane); continue; } r -= n4;
            if (r < n1) { cvt_chunk(keys, (bf16*)(ws + WS_KEYS), r, lane); continue; } r -= n1;
            {
                const int e0 = r * 512 + lane * 8, tq = (e0 >> 7) & 127, p0 = e0 & 127;
                const f32x4* s = (const f32x4*)(gws + e0); f32x4 x0 = s[0], x1 = s[1];
#pragma unroll
                for (int j = 0; j < 4; ++j) { if (p0 + j > tq) x0[j] = 0.f; if (p0 + 4 + j > tq) x1[j] = 0.f; }
                *(v4u*)((bf16*)(ws + WS_GMW) + e0) = pk8(x0, x1);
            }
        }
    }
    if (layer == 0) {
        for (int m = gw; m < T; m += NGW) norm_row_nx(a.in[0] + (size_t)m * D, F.h + (size_t)m * D, a.in[2], (bf16*)(ws + WS_NX), m, lane);
    }
}

__device__ __forceinline__ void scan_unit(Frame& F, const Args& a, int layer, int unit) {
    phase_ids(F);
    const int b = unit >> 4, hh = unit & 15, tid = F.tid, lane = F.lane, tl = tid >> 3, c8 = tid & 7, ch = hh * 64 + c8 * 8;
    LAS float* sW = (LAS float*)F.lds; LAS float* sK = sW + 4096; LAS float* sA = sK + 4096; LAS float* sB = sA + 4096; LAS float* sR = sB + 4096; LAS float* sV = sR + 4096; LAS float* sY = sV + 4096;
    const bf16* ZR = (const bf16*)(F.ws + WS_ZRKV); const bf16* EW = (const bf16*)(F.ws + WS_EW); const bf16* AR = (const bf16*)(F.ws + WS_AR); const bf16* GT = (const bf16*)(F.ws + WS_G);
    bf16* YAB = (bf16*)(F.ws + WS_YAB);
    f32x4 pkk[2], pka[2], prk[2], plg[2], plb[2];
    { const size_t po = (size_t)layer * 1024 + ch;
#pragma unroll
      for (int i = 0; i < 2; ++i) { pkk[i] = *(const f32x4*)(a.in[11] + po + 4 * i); pka[i] = *(const f32x4*)(a.in[12] + po + 4 * i); prk[i] = *(const f32x4*)(a.in[13] + po + 4 * i);
                                    plg[i] = *(const f32x4*)(a.in[14] + po + 4 * i); plb[i] = *(const f32x4*)(a.in[15] + po + 4 * i); } }
    f32x2 S[8];
#pragma unroll
    for (int i = 0; i < 8; ++i) S[i] = (f32x2){0.f, 0.f};
    const int cc = lane >> 4, rowi = (F.wave & 3) * 16 + (lane & 15);
    for (int chunk = 0; chunk < SEQ / 64; ++chunk) {
        const size_t row = (size_t)b * SEQ + chunk * 64 + tl;
        float bon;
        {
            f32x4 r_[2], k_[2], v_[2], e_[2], ar_[2];
            unpk8(*(const v4u*)(ZR + row * 3072 + ch), r_[0], r_[1]); unpk8(*(const v4u*)(ZR + row * 3072 + 1024 + ch), k_[0], k_[1]); unpk8(*(const v4u*)(ZR + row * 3072 + 2048 + ch), v_[0], v_[1]);
            unpk8(*(const v4u*)(EW + row * 1024 + ch), e_[0], e_[1]); unpk8(*(const v4u*)(AR + row * 1024 + ch), ar_[0], ar_[1]);
            f32x4 kkv[2], kp[2]; float ss = 0.f, bs = 0.f;
#pragma unroll
            for (int i = 0; i < 2; ++i) { kkv[i] = k_[i] * pkk[i]; kp[i] = k_[i] * (1.f + (ar_[i] - 1.f) * pka[i]);
                const f32x4 q = kkv[i] * kkv[i]; ss += (q.x + q.y) + (q.z + q.w); const f32x4 z = r_[i] * kp[i] * prk[i]; bs += (z.x + z.y) + (z.z + z.w); }
            ss = sum8(ss); bon = sum8(bs);
            const float inv = 1.f / sqrtf(fmaxf(ss, 1e-24f));
            const int o = tl * 64 + c8 * 8;
#pragma unroll
            for (int i = 0; i < 2; ++i) { const f32x4 kn = kkv[i] * inv;
                f32x4 w4; w4.x = __builtin_amdgcn_exp2f(-1.44269504f * e_[i].x); w4.y = __builtin_amdgcn_exp2f(-1.44269504f * e_[i].y); w4.z = __builtin_amdgcn_exp2f(-1.44269504f * e_[i].z); w4.w = __builtin_amdgcn_exp2f(-1.44269504f * e_[i].w);
                *(LAS f32x4*)(sW + o + 4 * i) = w4; *(LAS f32x4*)(sK + o + 4 * i) = kp[i]; *(LAS f32x4*)(sA + o + 4 * i) = -kn; *(LAS f32x4*)(sB + o + 4 * i) = kn * ar_[i];
                *(LAS f32x4*)(sR + o + 4 * i) = r_[i]; *(LAS f32x4*)(sV + o + 4 * i) = v_[i]; }
        }
        __syncthreads();
        if (F.wave < 4) {
            for (int s = 0; s < 64; ++s) {
                const int o = s * 64 + cc * 16;
                f32x4 q[4]; f32x2 ac;
#pragma unroll
                for (int i = 0; i < 4; ++i) q[i] = *(const LAS f32x4*)(sA + o + 4 * i);
                ac = S[0] * __builtin_shufflevector(q[0], q[0], 0, 1);
                ac += S[1] * __builtin_shufflevector(q[0], q[0], 2, 3);
#pragma unroll
                for (int i = 1; i < 4; ++i) { ac += S[2 * i] * __builtin_shufflevector(q[i], q[i], 0, 1); ac += S[2 * i + 1] * __builtin_shufflevector(q[i], q[i], 2, 3); }
                float sa = ac.x + ac.y; sa += __shfl_xor(sa, 16); sa += __shfl_xor(sa, 32);
                const float vv = sV[s * 64 + rowi];
                f32x4 w[4], bb[4], kx[4];
#pragma unroll
                for (int i = 0; i < 4; ++i) { w[i] = *(const LAS f32x4*)(sW + o + 4 * i); bb[i] = *(const LAS f32x4*)(sB + o + 4 * i); kx[i] = *(const LAS f32x4*)(sK + o + 4 * i); }
                const f32x2 sa2 = (f32x2){sa, sa}, vv2 = (f32x2){vv, vv};
#pragma unroll
                for (int i = 0; i < 4; ++i) {
                    S[2 * i]     = S[2 * i]     * __builtin_shufflevector(w[i], w[i], 0, 1) + sa2 * __builtin_shufflevector(bb[i], bb[i], 0, 1) + vv2 * __builtin_shufflevector(kx[i], kx[i], 0, 1);
                    S[2 * i + 1] = S[2 * i + 1] * __builtin_shufflevector(w[i], w[i], 2, 3) + sa2 * __builtin_shufflevector(bb[i], bb[i], 2, 3) + vv2 * __builtin_shufflevector(kx[i], kx[i], 2, 3); }
#pragma unroll
                for (int i = 0; i < 4; ++i) q[i] = *(const LAS f32x4*)(sR + o + 4 * i);
                ac = S[0] * __builtin_shufflevector(q[0], q[0], 0, 1);
                ac += S[1] * __builtin_shufflevector(q[0], q[0], 2, 3);
#pragma unroll
                for (int i = 1; i < 4; ++i) { ac += S[2 * i] * __builtin_shufflevector(q[i], q[i], 0, 1); ac += S[2 * i + 1] * __builtin_shufflevector(q[i], q[i], 2, 3); }
                float y = ac.x + ac.y; y += __shfl_xor(y, 16); y += __shfl_xor(y, 32);
                if (cc == 0) sY[s * 64 + rowi] = y;
            }
        }
        __syncthreads();
        {
            const int o = tl * 64 + c8 * 8;
            f32x4 y_[2], v_[2], g_[2];
#pragma unroll
            for (int i = 0; i < 2; ++i) { y_[i] = *(const LAS f32x4*)(sY + o + 4 * i); v_[i] = *(const LAS f32x4*)(sV + o + 4 * i); }
            unpk8(*(const v4u*)(GT + row * 1024 + ch), g_[0], g_[1]);
            float s1 = (y_[0].x + y_[0].y) + (y_[0].z + y_[0].w) + (y_[1].x + y_[1].y) + (y_[1].z + y_[1].w);
            const float mu = sum8(s1) * (1.f / 64.f);
            float s2 = 0.f;
#pragma unroll
            for (int i = 0; i < 2; ++i) { y_[i] = y_[i] - mu; const f32x4 q = y_[i] * y_[i]; s2 += (q.x + q.y) + (q.z + q.w); }
            const float rstd = 1.f / sqrtf(sum8(s2) * (1.f / 64.f) + 64e-5f);
            f32x4 o_[2];
#pragma unroll
            for (int i = 0; i < 2; ++i) o_[i] = (y_[i] * rstd * plg[i] + plb[i] + bon * v_[i]) * g_[i];
            *(v4u*)(YAB + row * 2048 + ch) = pk8(o_[0], o_[1]);
        }
        __syncthreads();
    }
}

constexpr int TP = 136;
__device__ __forceinline__ void mma_128(const LAS bf16* sA, const LAS bf16* sBt, int wave, int lane, f32x4 (&acc)[4][2]) {
    const int wm = wave >> 2, wn = wave & 3, fr = lane & 15, fq = lane >> 4;
#pragma unroll
    for (int kk = 0; kk < 4; ++kk) {
        bf16x8 af[4], bf_[2];
#pragma unroll
        for (int mt = 0; mt < 4; ++mt) af[mt] = *(const LAS bf16x8*)(sA + (64 * wm + 16 * mt + fr) * TP + 32 * kk + 8 * fq);
#pragma unroll
        for (int nt = 0; nt < 2; ++nt) bf_[nt] = *(const LAS bf16x8*)(sBt + (32 * wn + 16 * nt + fr) * TP + 32 * kk + 8 * fq);
#pragma unroll
        for (int mt = 0; mt < 4; ++mt)
#pragma unroll
            for (int nt = 0; nt < 2; ++nt) acc[mt][nt] = __builtin_amdgcn_mfma_f32_16x16x32_bf16(bf_[nt], af[mt], acc[mt][nt], 0, 0, 0);
    }
}
__device__ __forceinline__ void gmlp_unit(Frame& F, const Args& a, int layer, int unit) {
    phase_ids(F);
    const size_t t0 = (size_t)unit * 128; const int tid = F.tid, lane = F.lane, wave = F.wave;
    LAS float* st = (LAS float*)F.lds; LAS bf16* sA = (LAS bf16*)(F.lds + 1024); LAS bf16* sB = (LAS bf16*)(F.lds + 1024 + 128 * TP * 2);
    const bf16* GUV = (const bf16*)(F.ws + WS_GUV); const bf16* GMW = (const bf16*)(F.ws + WS_GMW); bf16* YAB = (bf16*)(F.ws + WS_YAB);
    const float* lng = a.in[19] + (size_t)layer * 1024; const float* lnb = a.in[20] + (size_t)layer * 1024; const float* bsp = a.in[22] + (size_t)layer * 1024;
    for (int r = 0; r < 16; ++r) { const int tok = wave * 16 + r; const bf16* rowp = GUV + (t0 + tok) * 2048 + 1024;
        f32x4 x0, x1, x2, x3; unpk8(*(const v4u*)(rowp + lane * 8), x0, x1); unpk8(*(const v4u*)(rowp + 512 + lane * 8), x2, x3);
        const f32x4 sv = (x0 + x1) + (x2 + x3), qv = (x0 * x0 + x1 * x1) + (x2 * x2 + x3 * x3);
        const float s = wave_sum((sv.x + sv.y) + (sv.z + sv.w)), q = wave_sum((qv.x + qv.y) + (qv.z + qv.w));
        const float mean = s * (1.f / 1024.f), var = fmaxf(q * (1.f / 1024.f) - mean * mean, 0.f);
        if (lane == 0) { st[tok * 2] = mean; st[tok * 2 + 1] = 1.f / sqrtf(var + 1e-5f); } }
    __syncthreads();
    for (int g = 0; g < 8; ++g) {
#pragma unroll
        for (int i = 0; i < 4; ++i) { const int pc = tid + 512 * i, rr = pc >> 4, c16 = pc & 15;
            *(LAS v4u*)(sA + rr * TP + c16 * 8) = *(const v4u*)(GMW + (size_t)g * 16384 + rr * 128 + c16 * 8); }
        { const int p = tid & 127, oc0 = tid >> 7; const float mean = st[p * 2], rstd = st[p * 2 + 1];
#pragma unroll
          for (int i = 0; i < 4; ++i) { const int oc = oc0 + 4 * i, c0 = g * 128 + oc * 8;
              f32x4 x0, x1; unpk8(*(const v4u*)(GUV + (t0 + p) * 2048 + 1024 + c0), x0, x1);
              const f32x4 g0 = *(const f32x4*)(lng + c0), g1 = *(const f32x4*)(lng + c0 + 4), b0 = *(const f32x4*)(lnb + c0), b1 = *(const f32x4*)(lnb + c0 + 4);
              x0 = (x0 - mean) * rstd * g0 + b0; x1 = (x1 - mean) * rstd * g1 + b1;
              const v4u w = pk8(x0, x1);
              LAS bf16* d = sB + (oc * 8) * TP + p;
              d[0 * TP] = (bf16)(w.x & 0xffffu); d[1 * TP] = (bf16)(w.x >> 16); d[2 * TP] = (bf16)(w.y & 0xffffu); d[3 * TP] = (bf16)(w.y >> 16);
              d[4 * TP] = (bf16)(w.z & 0xffffu); d[5 * TP] = (bf16)(w.z >> 16); d[6 * TP] = (bf16)(w.w & 0xffffu); d[7 * TP] = (bf16)(w.w >> 16); } }
        __syncthreads();
        f32x4 acc[4][2];
#pragma unroll
        for (int mt = 0; mt < 4; ++mt)
#pragma unroll
            for (int nt = 0; nt < 2; ++nt) acc[mt][nt] = (f32x4){0.f, 0.f, 0.f, 0.f};
        mma_128(sA, sB, wave, lane, acc);
        { const int wm = wave >> 2, wn = wave & 3, fr = lane & 15, fq = lane >> 4;
#pragma unroll
          for (int mt = 0; mt < 4; ++mt) { const int tt = 64 * wm + 16 * mt + fr; const float bsv = bsp[g * 128 + tt];
#pragma unroll
              for (int nt = 0; nt < 2; ++nt) { const int c = g * 128 + 32 * wn + 16 * nt + 4 * fq;
                  const v2u uw = *(const v2u*)(GUV + (t0 + tt) * 2048 + c);
                  const f32x4 u4 = (f32x4){bflo(uw.x), bfhi(uw.x), bflo(uw.y), bfhi(uw.y)};
                  const f32x4 yb = u4 * (acc[mt][nt] + bsv);
                  v2u ow; ow.x = cvt_pk_bf16(yb.x, yb.y); ow.y = cvt_pk_bf16(yb.z, yb.w);
                  *(v2u*)(YAB + (t0 + tt) * 2048 + 1024 + c) = ow; } } }
        __syncthreads();
    }
}

__device__ __forceinline__ unsigned fkey(float f) { const unsigned u = __builtin_bit_cast(unsigned, f); return (u & 0x80000000u) ? ~u : (u | 0x80000000u); }
__device__ __forceinline__ float kval(unsigned k, unsigned mask) { const unsigned u = k & mask; return __builtin_bit_cast(float, (u & 0x80000000u) ? (u ^ 0x80000000u) : ~u); }
#define TOP_INSERT(top, x) do { unsigned _x = (x); _Pragma("unroll") for (int _j = 0; _j < 16; ++_j) { const unsigned _h = max((top)[_j], _x); _x = min((top)[_j], _x); (top)[_j] = _h; } } while (0)
__device__ __forceinline__ void peer_unit(Frame& F, const Args& a, int layer, int unit, bool last) {
    phase_ids(F);
    const size_t t0 = (size_t)unit * 128; const int tid = F.tid, lane = F.lane, wave = F.wave, fr = lane & 15, fq = lane >> 4;
    LAS bf16* sKey = (LAS bf16*)F.lds;
    LAS unsigned* sLT = (LAS unsigned*)(F.lds + 128 * TP * 2) + wave * 512;
    const bf16* Q = (const bf16*)(F.ws + WS_Q); const bf16* KEYS = (const bf16*)(F.ws + WS_KEYS); v2u* SEL = (v2u*)(F.ws + WS_SEL);
    const size_t trow = t0 + wave * 16 + fr;
    for (int hd = 0; hd < 8; ++hd) {
        for (int p = 0; p < 2; ++p) {
            __syncthreads();
#pragma unroll
            for (int i = 0; i < 4; ++i) { const int pc = tid + 512 * i, rr = pc >> 4, c16 = pc & 15;
                *(LAS v4u*)(sKey + rr * TP + c16 * 8) = *(const v4u*)(KEYS + (size_t)(hd * 2 + p) * 16384 + rr * 128 + c16 * 8); }
            bf16x8 qf[4];
#pragma unroll
            for (int kk = 0; kk < 4; ++kk) qf[kk] = *(const bf16x8*)(Q + trow * 2048 + hd * 256 + p * 128 + 32 * kk + 8 * fq);
            __syncthreads();
            f32x4 sc[8];
#pragma unroll
            for (int nt = 0; nt < 8; ++nt) sc[nt] = (f32x4){0.f, 0.f, 0.f, 0.f};
#pragma unroll
            for (int kk = 0; kk < 4; ++kk)
#pragma unroll
                for (int nt = 0; nt < 8; ++nt) { const bf16x8 kf = *(const LAS bf16x8*)(sKey + (16 * nt + fr) * TP + 32 * kk + 8 * fq);
                    sc[nt] = __builtin_amdgcn_mfma_f32_16x16x32_bf16(kf, qf[kk], sc[nt], 0, 0, 0); }
            unsigned top[16];
#pragma unroll
            for (int j = 0; j < 16; ++j) top[j] = 0u;
#pragma unroll
            for (int nt = 0; nt < 8; ++nt)
#pragma unroll
                for (int rg = 0; rg < 4; ++rg) TOP_INSERT(top, (fkey(sc[nt][rg]) & 0xFFFFFF80u) | (unsigned)(16 * nt + 4 * fq + rg));
#pragma unroll
            for (int rnd = 0; rnd < 2; ++rnd) { unsigned oth[16];
#pragma unroll
                for (int j = 0; j < 16; ++j) oth[j] = (unsigned)__shfl_xor((int)top[j], 16 << rnd);
#pragma unroll
                for (int j = 0; j < 16; ++j) TOP_INSERT(top, oth[j]); }
#pragma unroll
            for (int j = 0; j < 16; ++j) sLT[fr * 32 + p * 16 + j] = top[j];
        }
        float v0[16], v1[16];
#pragma unroll
        for (int j = 0; j < 16; ++j) { v0[j] = kval(sLT[fr * 32 + j], 0xFFFFFF80u); v1[j] = kval(sLT[fr * 32 + 16 + j], 0xFFFFFF80u); }
        unsigned best[16];
#pragma unroll
        for (int j = 0; j < 16; ++j) best[j] = 0u;
#pragma unroll
        for (int i = 0; i < 16; ++i)
#pragma unroll
            for (int j = 0; j < 16; ++j) if ((i + 1) * (j + 1) <= 16) TOP_INSERT(best, (fkey(v0[i] + v1[j]) & 0xFFFFFF00u) | (unsigned)(i * 16 + j));
        float ev[16], esum = 0.f; const float mx = kval(best[0], 0xFFFFFF00u);
#pragma unroll
        for (int k = 0; k < 16; ++k) { ev[k] = __builtin_amdgcn_exp2f((kval(best[k], 0xFFFFFF00u) - mx) * 1.44269504f); esum += ev[k]; }
        const float einv = 1.f / esum;
#pragma unroll
        for (int k = 0; k < 16; ++k) { const unsigned pos = best[k] & 255u;
            const unsigned i0 = sLT[fr * 32 + (pos >> 4)] & 127u, i1 = sLT[fr * 32 + 16 + (pos & 15u)] & 127u;
            if ((k >> 2) == fq) SEL[trow * 128 + hd * 16 + k] = (v2u){i0 * 128u + i1, __builtin_bit_cast(unsigned, ev[k] * einv)}; }
    }
    asm volatile("s_waitcnt vmcnt(0)" ::: "memory");
    __syncthreads();
    const bf16* N2 = (const bf16*)(F.ws + WS_N2); const bf16* UT = (const bf16*)(F.ws + WS_U); const bf16* VT = (const bf16*)(F.ws + WS_V);
    for (int it = 0; it < 16; ++it) {
        const size_t tok = t0 + wave * 16 + it;
        f32x4 nf[4]; unpk8(*(const v4u*)(N2 + tok * 1024 + 8 * lane), nf[0], nf[1]); unpk8(*(const v4u*)(N2 + tok * 1024 + 512 + 8 * lane), nf[2], nf[3]);
        const v4u se = *(const v4u*)((const unsigned*)SEL + tok * 256 + 4 * lane);
        f32x4 out[4];
#pragma unroll
        for (int i = 0; i < 4; ++i) out[i] = (f32x4){0.f, 0.f, 0.f, 0.f};
        for (int eb = 0; eb < 128; eb += 4) {
            unsigned idx[4]; float gwv[4];
            idx[0] = __builtin_amdgcn_readlane(se.x, eb >> 1); gwv[0] = __builtin_bit_cast(float, __builtin_amdgcn_readlane(se.y, eb >> 1));
            idx[1] = __builtin_amdgcn_readlane(se.z, eb >> 1); gwv[1] = __builtin_bit_cast(float, __builtin_amdgcn_readlane(se.w, eb >> 1));
            idx[2] = __builtin_amdgcn_readlane(se.x, (eb >> 1) + 1); gwv[2] = __builtin_bit_cast(float, __builtin_amdgcn_readlane(se.y, (eb >> 1) + 1));
            idx[3] = __builtin_amdgcn_readlane(se.z, (eb >> 1) + 1); gwv[3] = __builtin_bit_cast(float, __builtin_amdgcn_readlane(se.w, (eb >> 1) + 1));
            v4u ur[4][2], vr[4][2];
#pragma unroll
            for (int q = 0; q < 4; ++q) { const bf16* up = UT + (size_t)idx[q] * 1024 + 8 * lane; ur[q][0] = *(const v4u*)up; ur[q][1] = *(const v4u*)(up + 512);
                                          const bf16* vp = VT + (size_t)idx[q] * 1024 + 8 * lane; vr[q][0] = *(const v4u*)vp; vr[q][1] = *(const v4u*)(vp + 512); }
            float coef[4];
#pragma unroll
            for (int q = 0; q < 4; ++q) { f32x4 x0, x1, x2, x3; unpk8(ur[q][0], x0, x1); unpk8(ur[q][1], x2, x3);
                const f32x4 d4 = (x0 * nf[0] + x1 * nf[1]) + (x2 * nf[2] + x3 * nf[3]);
                const float d = wave_sum((d4.x + d4.y) + (d4.z + d4.w));
                coef[q] = gwv[q] * fgelu(d); }
#pragma unroll
            for (int q = 0; q < 4; ++q) { f32x4 x0, x1, x2, x3; unpk8(vr[q][0], x0, x1); unpk8(vr[q][1], x2, x3);
                out[0] += coef[q] * x0; out[1] += coef[q] * x1; out[2] += coef[q] * x2; out[3] += coef[q] * x3; }
        }
        float* hp = F.h + tok * 1024;
        f32x4 hv[4]; hv[0] = *(const f32x4*)(hp + 8 * lane) + out[0]; hv[1] = *(const f32x4*)(hp + 8 * lane + 4) + out[1]; hv[2] = *(const f32x4*)(hp + 512 + 8 * lane) + out[2]; hv[3] = *(const f32x4*)(hp + 512 + 8 * lane + 4) + out[3];
        float s = 0.f;
#pragma unroll
        for (int i = 0; i < 4; ++i) s += (hv[i].x * hv[i].x + hv[i].y * hv[i].y) + (hv[i].z * hv[i].z + hv[i].w * hv[i].w);
        const float rstd = 1.f / sqrtf(wave_sum(s) * (1.f / D) + 1e-6f);
        const float* g = last ? a.in[4] : a.in[2] + (size_t)(layer + 1) * 1024;
        f32x4 o[4];
        o[0] = hv[0] * rstd * *(const f32x4*)(g + 8 * lane); o[1] = hv[1] * rstd * *(const f32x4*)(g + 8 * lane + 4); o[2] = hv[2] * rstd * *(const f32x4*)(g + 512 + 8 * lane); o[3] = hv[3] * rstd * *(const f32x4*)(g + 512 + 8 * lane + 4);
        if (last) { *(f32x4*)(hp + 8 * lane) = o[0]; *(f32x4*)(hp + 8 * lane + 4) = o[1]; *(f32x4*)(hp + 512 + 8 * lane) = o[2]; *(f32x4*)(hp + 512 + 8 * lane + 4) = o[3]; }
        else {
            *(f32x4*)(hp + 8 * lane) = hv[0]; *(f32x4*)(hp + 8 * lane + 4) = hv[1]; *(f32x4*)(hp + 512 + 8 * lane) = hv[2]; *(f32x4*)(hp + 512 + 8 * lane + 4) = hv[3];
            bf16* NX = (bf16*)(F.ws + WS_NX); const v4u w0 = pk8(o[0], o[1]), w1 = pk8(o[2], o[3]); const int tt = (int)(tok & (SEQ - 1));
            *(v4u*)(NX + tok * 2048 + 8 * lane) = w0; *(v4u*)(NX + tok * 2048 + 512 + 8 * lane) = w1;
            if (tt != SEQ - 1) { *(v4u*)(NX + (tok + 1) * 2048 + 1024 + 8 * lane) = w0; *(v4u*)(NX + (tok + 1) * 2048 + 1024 + 512 + 8 * lane) = w1; }
            if (tt == 0) { *(v4u*)(NX + tok * 2048 + 1024 + 8 * lane) = (v4u){0u, 0u, 0u, 0u}; *(v4u*)(NX + tok * 2048 + 1024 + 512 + 8 * lane) = (v4u){0u, 0u, 0u, 0u}; }
        }
    }
}

__global__ void __launch_bounds__(NWAVES * 64, 2) trunk_fwd(Args args) {
    extern __shared__ __attribute__((aligned(16))) unsigned char lds[];
    Frame F;
    F.lds = (LAS unsigned char*)lds;
    F.tid = threadIdx.x; F.lane = F.tid & 63; F.wave = __builtin_amdgcn_readfirstlane(F.tid >> 6);
    F.G = gridDim.x; F.bx = blockIdx.x; F.ws = args.ws; F.h = args.out;
    volatile LAS unsigned* MISC = (volatile LAS unsigned*)(F.lds + MISC_OFF);
    for (int u = F.tid; u < (LDS_BYTES - LDSCTL_OFF) / 4; u += NWAVES * 64) ((LAS unsigned*)(F.lds + LDSCTL_OFF))[u] = 0u;
    __syncthreads();
    unsigned* ctl = (unsigned*)(F.ws + WS_CTL);
    XcdBarrier bar = xcd_barrier_post(ctl + CW_BAR, MISC + 8);
    unsigned char* ws = F.ws;
    LAS unsigned char* ring = (LAS unsigned char*)F.lds;

    for (int layer = 0; layer < DEPTH; ++layer) {
        prep_phase(F, args, layer);
        xcd_barrier(bar);
        {   pg8::Gemm g{(const bf16*)(ws + WS_NX), (const bf16*)(ws + WS_WIN), T, NZ, 2048, 2048}; pg8::StaticOrder S; S.init(T, NZ, F.G, F.bx);
            pg8::EpiZ E{(bf16*)(ws + WS_ZRKV), (bf16*)(ws + WS_ZL), (bf16*)(ws + WS_GUV), (bf16*)(ws + WS_SG), layer == 0 ? (bf16*)(ws + WS_VF) : (bf16*)nullptr};
            pg8::gemm_phase<pg8::EpiZ, pg8::StaticOrder, true, true>(ring, g, S, E); }
        xcd_barrier(bar);
        {   pg8::Gemm g{(const bf16*)(ws + WS_ZL), (const bf16*)(ws + WS_LORA + (size_t)layer * LORA_BYTES), T, 3072, 256, 512}; pg8::StaticOrder S; S.init(T, 3072, F.G, F.bx);
            pg8::EpiLora E{(bf16*)(ws + WS_EW), (size_t)(WS_AR - WS_EW) / 2, args.in[6] + (size_t)layer * 1024, args.in[8] + (size_t)layer * 1024};
            pg8::gemm_phase<pg8::EpiLora, pg8::StaticOrder, true, true>(ring, g, S, E); }
        if (layer > 0) {
            pg8::Gemm g{(const bf16*)(ws + WS_ZL) + 256, (const bf16*)(ws + WS_MV + (size_t)(layer - 1) * MV_BYTES), T, 1024, 256, 512}; pg8::StaticOrder S; S.init(T, 1024, F.G, F.bx);
            pg8::EpiMv E{(bf16*)(ws + WS_ZRKV), (const bf16*)(ws + WS_VF), args.in[18] + (size_t)(layer - 1) * 1024};
            pg8::gemm_phase<pg8::EpiMv, pg8::StaticOrder, true, true>(ring, g, S, E); }
        {   pg8::Gemm g{(const bf16*)(ws + WS_PB), (const bf16*)(ws + WS_PLEW), T, 1024, 256, 256}; pg8::StaticOrder S; S.init(T, 1024, F.G, F.bx);
            pg8::EpiPlain E{(bf16*)(ws + WS_PW), 1024};
            pg8::gemm_phase<pg8::EpiPlain, pg8::StaticOrder, true, true>(ring, g, S, E); }
        xcd_barrier(bar);
        {   const int nsb = F.G >= 2 ? F.G / 2 : 1;
            if (F.G < 2) { for (int u = 0; u < NB * 16; ++u) scan_unit(F, args, layer, u); for (int u = 0; u < T / 128; ++u) gmlp_unit(F, args, layer, u); }
            else if (F.bx < nsb) { for (int u = F.bx; u < NB * 16; u += nsb) scan_unit(F, args, layer, u); }
            else { for (int u = F.bx - nsb; u < T / 128; u += F.G - nsb) gmlp_unit(F, args, layer, u); } }
        xcd_barrier(bar);
        {   pg8::Gemm g{(const bf16*)(ws + WS_YAB), (const bf16*)(ws + WS_PA), T, 1024, 1024, 2048}; pg8::StaticOrder S; S.init(T, 1024, F.G, F.bx);
            pg8::EpiMerge<true> E{(const bf16*)(ws + WS_SG), (const bf16*)nullptr, (bf16*)(ws + WS_M1)};
            pg8::gemm_phase<pg8::EpiMerge<true>, pg8::StaticOrder, true, true>(ring, g, S, E); }
        {   pg8::Gemm g{(const bf16*)(ws + WS_YAB) + 1024, (const bf16*)(ws + WS_PBT), T, 1024, 1024, 2048}; pg8::StaticOrder S; S.init(T, 1024, F.G, F.bx);
            pg8::EpiMerge<false> E{(const bf16*)(ws + WS_SG), (const bf16*)(ws + WS_M1), (bf16*)(ws + WS_MG)};
            pg8::gemm_phase<pg8::EpiMerge<false>, pg8::StaticOrder, true, true>(ring, g, S, E); }
        xcd_barrier(bar);
        {   pg8::Gemm g{(const bf16*)(ws + WS_MG), (const bf16*)(ws + WS_POUT), T, 1024, 1024, 1024}; pg8::StaticOrder S; S.init(T, 1024, F.G, F.bx);
            pg8::EpiResid E{F.h};
            pg8::gemm_phase<pg8::EpiResid, pg8::StaticOrder, true, true>(ring, g, S, E); }
        xcd_barrier(bar);
        {   phase_ids(F); const int gw = F.bx * NWAVES + F.wave, NGW = F.G * NWAVES; const float* g2 = args.in[3] + (size_t)layer * 1024;
            for (int m = gw; m < T; m += NGW) norm_row_n2(F.h + (size_t)m * D, g2, (bf16*)(ws + WS_N2) + (size_t)m * D, F.lane); }
        xcd_barrier(bar);
        {   pg8::Gemm g{(const bf16*)(ws + WS_N2), (const bf16*)(ws + WS_WQG), T, 3072, 1024, 1024}; pg8::StaticOrder S; S.init(T, 3072, F.G, F.bx);
            pg8::EpiQG E{(bf16*)(ws + WS_Q), (const bf16*)(ws + WS_PW), F.h};
            pg8::gemm_phase<pg8::EpiQG, pg8::StaticOrder, true, true>(ring, g, S, E); }
        xcd_barrier(bar);
        for (int u = F.bx; u < T / 128; u += F.G) peer_unit(F, args, layer, u, layer == DEPTH - 1);
        if (layer + 1 < DEPTH) xcd_barrier(bar);
    }
}

extern "C" void kernel_launch(void* const* d_in, const int* in_sizes, int n_in, void* d_out, int out_size, void* d_ws, size_t ws_size, hipStream_t stream) {
    static int grid = 0;
    if (grid == 0) {
        if (n_in != 32 || out_size != T * D || ws_size < WS_END) { fprintf(stderr, "kernel_launch: unexpected sizes n_in %d out %d ws %zu (need %zu); nothing launched\n", n_in, out_size, ws_size, (size_t)WS_END); grid = -1; return; }
        int dev = 0, cus = 0, per_cu = 0;
        if (hipGetDevice(&dev) != hipSuccess || hipDeviceGetAttribute(&cus, hipDeviceAttributeMultiprocessorCount, dev) != hipSuccess) { grid = -1; return; }
        if (hipFuncSetAttribute((const void*)trunk_fwd, hipFuncAttributeMaxDynamicSharedMemorySize, LDS_BYTES) != hipSuccess) { fprintf(stderr, "kernel_launch: hipFuncSetAttribute failed\n"); grid = -1; return; }
        if (hipOccupancyMaxActiveBlocksPerMultiprocessor(&per_cu, (const void*)trunk_fwd, NWAVES * 64, LDS_BYTES) != hipSuccess || per_cu < 1)
            fprintf(stderr, "kernel_launch: note: occupancy query reports %d workgroups per CU\n", per_cu);
        (void)hipGetLastError();
        grid = cus;
    }
    if (grid < 0) return;
    (void)hipMemsetAsync((char*)d_ws + WS_CTL, 0, ZERO_BYTES, stream);
    (void)hipMemsetAsync((char*)d_ws + WIN_ZERO_OFF, 0, WIN_ZERO_BYTES, stream);
    Args a{};
    for (int i = 0; i < 32; ++i) a.in[i] = (const float*)d_in[i];
    a.out = (float*)d_out; a.ws = (unsigned char*)d_ws;
    hipLaunchKernelGGL(trunk_fwd, dim3(grid), dim3(NWAVES * 64), LDS_BYTES, stream, a);
    const hipError_t le = hipPeekAtLastError();
    if (le != hipSuccess) fprintf(stderr, "kernel_launch: launch failed: %s\n", hipGetErrorName(le));
}
```

```cpp
#include <hip/hip_runtime.h>
#include <cstdio>
#include <cstdint>
namespace pg8 {
#define PG8_LAS __attribute__((address_space(3)))
typedef unsigned short bf16_t;
typedef short bf16x8 __attribute__((ext_vector_type(8)));
typedef float f32x4 __attribute__((ext_vector_type(4)));
typedef unsigned u32x4 __attribute__((ext_vector_type(4)));
constexpr int BM = 256, BK = 64, HALF = 128, HTB = HALF * BK * 2  , STAGE_BYTES = 8 * HTB, NXCD = 8, WGM = 8;

__host__ __device__ __forceinline__ int lds_byte(int r, int c) { const int st = (r >> 4) * 2 + (c >> 5), rr = r & 15, cc = c & 31, ob = rr * 64 + cc * 2; return st * 1024 + (ob ^ (((ob >> 9) & 1) << 5)); }
__host__ __device__ __forceinline__ void stage_rc(int b, int& R, int& C) { const int st = b / 1024, sb = b % 1024, swz = sb ^ (((sb >> 9) & 1) << 5); R = (st >> 1) * 16 + swz / 64; C = (st & 1) * 32 + (swz % 64) / 2; }
__host__ __device__ __forceinline__ int perm32(int rho) { const int n = rho >> 4, i = rho & 15; return 8 * (i >> 2) + 4 * n + (i & 3); }

struct Unit { int pm, pn; };
struct Gemm { const bf16_t* A; const bf16_t* Bt; int M, N, K, lda; };

struct StaticOrder {
    int nM, nN, nwg, G, c;
    __host__ __device__ void init(int M, int N, int G_, int c_) { nM = M / BM; nN = N / BM; nwg = nM * nN; G = G_; c = c_; }
    __host__ __device__ bool next(int i, Unit& u) const {
        const long L = (long)i * G + c; if (L >= nwg) return false;
        int wgid = (int)L; { const int q = nwg / NXCD, r = nwg % NXCD, xcd = wgid % NXCD, off = wgid / NXCD; wgid = (xcd < r ? xcd * (q + 1) : r * (q + 1) + (xcd - r) * q) + off; }
        const int nig = WGM * nN, gid = wgid / nig, fm = gid * WGM, gsz = (nM - fm) < WGM ? (nM - fm) : WGM;
        u.pm = fm + ((wgid % nig) % gsz); u.pn = (wgid % nig) / gsz; return true;
    }
    __device__ __forceinline__ void a_ready(const Unit&) const {}
    __device__ __forceinline__ void done(const Unit&) const {}
};
__device__ __forceinline__ unsigned cvt_pk_bf16(float lo, float hi) { unsigned r; asm volatile("v_cvt_pk_bf16_f32 %0, %1, %2" : "=v"(r) : "v"(lo), "v"(hi)); return r; }

__device__ __forceinline__ float fsig(float x) { return __builtin_amdgcn_rcpf(1.f + __builtin_amdgcn_exp2f(-1.44269504f * x)); }
__device__ __forceinline__ float fgelu(float x) { return x * fsig(1.5957691216f * (x + 0.044715f * x * x * x)); }
__device__ __forceinline__ float bflo(unsigned w) { return __builtin_bit_cast(float, w << 16); }
__device__ __forceinline__ float bfhi(unsigned w) { return __builtin_bit_cast(float, w & 0xffff0000u); }
__device__ __forceinline__ void unpk8(const u32x4 w, f32x4& a, f32x4& b) { a = (f32x4){bflo(w.x), bfhi(w.x), bflo(w.y), bfhi(w.y)}; b = (f32x4){bflo(w.z), bfhi(w.z), bflo(w.w), bfhi(w.w)}; }
__device__ __forceinline__ u32x4 pk8(const f32x4 a, const f32x4 b) { u32x4 w; w.x = cvt_pk_bf16(a[0], a[1]); w.y = cvt_pk_bf16(a[2], a[3]); w.z = cvt_pk_bf16(b[0], b[1]); w.w = cvt_pk_bf16(b[2], b[3]); return w; }
__device__ __forceinline__ f32x4 act4(f32x4 v, int kind) {
    if (kind == 1) { v = (f32x4){fgelu(v[0]), fgelu(v[1]), fgelu(v[2]), fgelu(v[3])}; }
    else if (kind == 2) { v = (f32x4){fsig(v[0]), fsig(v[1]), fsig(v[2]), fsig(v[3])}; }
    else if (kind == 3) { v = (f32x4){2.f * fsig(2.f * v[0]) - 1.f, 2.f * fsig(2.f * v[1]) - 1.f, 2.f * fsig(2.f * v[2]) - 1.f, 2.f * fsig(2.f * v[3]) - 1.f}; }
    return v;
}
#define EPI_ROWS_BEGIN _Pragma("unroll") for (int ai = 0; ai < 2; ++ai) _Pragma("unroll") for (int m = 0; m < 4; ++m) { const size_t row = (size_t)(row0 + ai * HALF + m * 16);
#define EPI_ROWS_END }

struct EpiZ {
    static constexpr bool PERM = true, AFTER_DRAIN = false;
    bf16_t *zrkv, *zl, *guv, *sg, *vf;
    __device__ __forceinline__ void operator()(const f32x4 (&acc)[2][2][4][2], const Unit& u, int wr, int wc, int fr, int fq) const {
        const int pn = u.pn, row0 = u.pm * BM + wr * 64 + fr;
        bf16_t* dst; int ld, colt, k0, k1;
        if (pn < 12)       { dst = zrkv; ld = 3072; colt = pn * 256;        k0 = 0; k1 = 0; }
        else if (pn == 12) { dst = zl;   ld = 512;  colt = 0;               k0 = (wc < 2) ? 3 : 0; k1 = 2; }
        else if (pn == 13) { dst = zl;   ld = 512;  colt = 256;             k0 = 0; k1 = 0; }
        else if (pn < 22)  { dst = guv;  ld = 2048; colt = (pn - 14) * 256; k0 = 1; k1 = 1; }
        else               { dst = sg;   ld = 2048; colt = (pn - 22) * 256; k0 = 2; k1 = 2; }
        const int col0 = colt + wc * 32 + 8 * fq;
        const bool dovf = (vf != nullptr) && pn >= 8 && pn < 12;
        const int vcol0 = (pn - 8) * 256 + wc * 32 + 8 * fq;
        EPI_ROWS_BEGIN
            bf16_t* rowp = dst + row * ld + col0;
#pragma unroll
            for (int bj = 0; bj < 2; ++bj) { const int kind = bj ? k1 : k0;
                const u32x4 w = pk8(act4(acc[ai][bj][m][0], kind), act4(acc[ai][bj][m][1], kind));
                *(u32x4*)(rowp + bj * HALF) = w;
                if (dovf) *(u32x4*)(vf + row * 1024 + vcol0 + bj * HALF) = w; }
        EPI_ROWS_END
    }
};
struct EpiLora {
    static constexpr bool PERM = true, AFTER_DRAIN = false;
    bf16_t* ew; size_t stride; const float *w0, *a0;
    __device__ __forceinline__ void operator()(const f32x4 (&acc)[2][2][4][2], const Unit& u, int wr, int wc, int fr, int fq) const {
        const int sel = u.pn >> 2, row0 = u.pm * BM + wr * 64 + fr, col0 = (u.pn & 3) * 256 + wc * 32 + 8 * fq;
        bf16_t* dst = ew + (size_t)sel * stride;
        const float* bp = sel == 0 ? w0 : a0;
        f32x4 bv[2][2];
#pragma unroll
        for (int bj = 0; bj < 2; ++bj)
#pragma unroll
            for (int n = 0; n < 2; ++n) bv[bj][n] = (sel < 2) ? *(const f32x4*)(bp + col0 + bj * HALF + 4 * n) : (f32x4){0.f, 0.f, 0.f, 0.f};
        EPI_ROWS_BEGIN
            bf16_t* rowp = dst + row * 1024 + col0;
#pragma unroll
            for (int bj = 0; bj < 2; ++bj) { f32x4 v0 = acc[ai][bj][m][0] + bv[bj][0], v1 = acc[ai][bj][m][1] + bv[bj][1];
                if (sel < 2) { v0 = act4(v0, 2); v1 = act4(v1, 2); }
                if (sel == 0) { v0 = v0 * 0.60653066f; v1 = v1 * 0.60653066f; }
                *(u32x4*)(rowp + bj * HALF) = pk8(v0, v1); }
        EPI_ROWS_END
    }
};
struct EpiMv {
    static constexpr bool PERM = true, AFTER_DRAIN = false;
    bf16_t* zrkv; const bf16_t* vf; const float* v0b;
    __device__ __forceinline__ void operator()(const f32x4 (&acc)[2][2][4][2], const Unit& u, int wr, int wc, int fr, int fq) const {
        const int row0 = u.pm * BM + wr * 64 + fr, col0 = u.pn * 256 + wc * 32 + 8 * fq;
        f32x4 bv[2][2];
#pragma unroll
        for (int bj = 0; bj < 2; ++bj)
#pragma unroll
            for (int n = 0; n < 2; ++n) bv[bj][n] = *(const f32x4*)(v0b + col0 + bj * HALF + 4 * n);
        EPI_ROWS_BEGIN
#pragma unroll
            for (int bj = 0; bj < 2; ++bj) { bf16_t* zp = zrkv + row * 3072 + 2048 + col0 + bj * HALF;
                f32x4 z0, z1, f0, f1; unpk8(*(const u32x4*)zp, z0, z1); unpk8(*(const u32x4*)(vf + row * 1024 + col0 + bj * HALF), f0, f1);
                const f32x4 m0 = act4(acc[ai][bj][m][0] + bv[bj][0], 2), m1 = act4(acc[ai][bj][m][1] + bv[bj][1], 2);
                *(u32x4*)zp = pk8(z0 + (f0 - z0) * m0, z1 + (f1 - z1) * m1); }
        EPI_ROWS_END
    }
};
struct EpiPlain {
    static constexpr bool PERM = true, AFTER_DRAIN = false;
    bf16_t* o; int ld;
    __device__ __forceinline__ void operator()(const f32x4 (&acc)[2][2][4][2], const Unit& u, int wr, int wc, int fr, int fq) const {
        const int row0 = u.pm * BM + wr * 64 + fr, col0 = u.pn * 256 + wc * 32 + 8 * fq;
        EPI_ROWS_BEGIN
#pragma unroll
            for (int bj = 0; bj < 2; ++bj) *(u32x4*)(o + row * ld + col0 + bj * HALF) = pk8(acc[ai][bj][m][0], acc[ai][bj][m][1]);
        EPI_ROWS_END
    }
};
template <bool FIRST> struct EpiMerge {
    static constexpr bool PERM = true, AFTER_DRAIN = false;
    const bf16_t* sg; const bf16_t* m1; bf16_t* o;
    __device__ __forceinline__ void operator()(const f32x4 (&acc)[2][2][4][2], const Unit& u, int wr, int wc, int fr, int fq) const {
        const int row0 = u.pm * BM + wr * 64 + fr, col0 = u.pn * 256 + wc * 32 + 8 * fq;
        EPI_ROWS_BEGIN
#pragma unroll
            for (int bj = 0; bj < 2; ++bj) { const int c = col0 + bj * HALF;
                f32x4 g0, g1; unpk8(*(const u32x4*)(sg + row * 2048 + (FIRST ? 0 : 1024) + c), g0, g1);
                f32x4 v0 = g0 * acc[ai][bj][m][0], v1 = g1 * acc[ai][bj][m][1];
                if (!FIRST) { f32x4 p0, p1; unpk8(*(const u32x4*)(m1 + row * 1024 + c), p0, p1); v0 = v0 + p0; v1 = v1 + p1; }
                *(u32x4*)(o + row * 1024 + c) = pk8(v0, v1); }
        EPI_ROWS_END
    }
};
struct EpiResid {
    static constexpr bool PERM = false, AFTER_DRAIN = false;
    float* h;
    __device__ __forceinline__ void operator()(const f32x4 (&acc)[2][2][4][2], const Unit& u, int wr, int wc, int fr, int fq) const {
        const int row0 = u.pm * BM + wr * 64 + fr, col0 = u.pn * 256 + wc * 32 + 4 * fq;
        EPI_ROWS_BEGIN
            float* rowp = h + row * 1024 + col0;
#pragma unroll
            for (int bj = 0; bj < 2; ++bj)
#pragma unroll
                for (int n = 0; n < 2; ++n) { f32x4* p = (f32x4*)(rowp + bj * HALF + n * 16); *p = *p + acc[ai][bj][m][n]; }
        EPI_ROWS_END
    }
};
struct EpiQG {
    static constexpr bool PERM = true, AFTER_DRAIN = false;
    bf16_t* q; const bf16_t* pw; float* h;
    __device__ __forceinline__ void operator()(const f32x4 (&acc)[2][2][4][2], const Unit& u, int wr, int wc, int fr, int fq) const {
        const int row0 = u.pm * BM + wr * 64 + fr;
        if (u.pn < 8) { const int col0 = u.pn * 256 + wc * 32 + 8 * fq;
            EPI_ROWS_BEGIN
#pragma unroll
                for (int bj = 0; bj < 2; ++bj) *(u32x4*)(q + row * 2048 + col0 + bj * HALF) = pk8(acc[ai][bj][m][0], acc[ai][bj][m][1]);
            EPI_ROWS_END
        } else { const int col0 = (u.pn - 8) * 256 + wc * 32 + 8 * fq;
            EPI_ROWS_BEGIN
#pragma unroll
                for (int bj = 0; bj < 2; ++bj) { const int c = col0 + bj * HALF;
                    f32x4 p0, p1; unpk8(*(const u32x4*)(pw + row * 1024 + c), p0, p1);
                    f32x4* hp = (f32x4*)(h + row * 1024 + c);
                    hp[0] = hp[0] + p0 * act4(acc[ai][bj][m][0], 2); hp[1] = hp[1] + p1 * act4(acc[ai][bj][m][1], 2); }
            EPI_ROWS_END
        }
    }
};
template <class Epi, class Sched, bool ALIGN_EPI = false, bool SP2 = false>
__device__ __forceinline__ void gemm_phase(PG8_LAS unsigned char* lds, const Gemm g, const Sched& S, const Epi& E) {
    int tidq = threadIdx.x; asm volatile("" : "+v"(tidq));
    const int tid = tidq, wid = __builtin_amdgcn_readfirstlane(tid >> 6), lane = tid & 63, wr = wid >> 2, wc = wid & 3, fr = lane & 15, fq = lane >> 4;
    int Kq = g.K, ldaq = g.lda; const bf16_t* gA = g.A; const bf16_t* gB = g.Bt; asm volatile("" : "+s"(Kq), "+s"(ldaq), "+s"(gA), "+s"(gB));
    const int K = Kq, nt = K / BK;
    unsigned voffA[2], voffB[2];
#pragma unroll
    for (int i = 0; i < 2; ++i) { int R, C; stage_rc(tid * 16 + i * 8192, R, C); const int Rb = Epi::PERM ? ((R & ~31) + perm32(R & 31)) : R;
        voffA[i] = (unsigned)(R * ldaq + C) * 2u; voffB[i] = (unsigned)(Rb * K + C) * 2u; }
    const size_t kstep = (size_t)(BK * 2);
    const size_t hstepA = (size_t)HALF * ldaq * 2, hstepB = (size_t)HALF * K * 2;
    const size_t tstepA = 2 * hstepA, tstepB = 2 * hstepB;
    const unsigned ldsw = (unsigned)wid * 1024u;
    const int aoff = lds_byte(wr * 64 + fr, fq * 8), boff = lds_byte(wc * 32 + fr, fq * 8);
#define PG8_SA(b, h) (((b) * 2 + (h)) * HTB)
#define PG8_SB(b, h) ((4 + (b) * 2 + (h)) * HTB)
#define PG8_STAGE(bufoff, gbase, voff) do { _Pragma("unroll") for (int _i = 0; _i < 2; ++_i) \
        __builtin_amdgcn_global_load_lds((const unsigned*)((const char*)(gbase) + (voff)[_i]), (PG8_LAS unsigned*)(lds + (bufoff) + ldsw + _i * 8192), 16, 0, 0); } while (0)
#define PG8_LDA(dst, b, h) do { _Pragma("unroll") for (int m = 0; m < 4; ++m) _Pragma("unroll") for (int k = 0; k < 2; ++k) dst[m][k] = *(const PG8_LAS bf16x8*)(lds + PG8_SA(b, h) + aoff + m * 2048 + k * 1024); } while (0)
#define PG8_LDB(dst, b, h) do { _Pragma("unroll") for (int n = 0; n < 2; ++n) _Pragma("unroll") for (int k = 0; k < 2; ++k) dst[n][k] = *(const PG8_LAS bf16x8*)(lds + PG8_SB(b, h) + boff + n * 2048 + k * 1024); } while (0)
#define PG8_MMA(ai, bj, At, Bt) do { __builtin_amdgcn_s_setprio(1); _Pragma("unroll") for (int m = 0; m < 4; ++m) _Pragma("unroll") for (int n = 0; n < 2; ++n) _Pragma("unroll") for (int k = 0; k < 2; ++k) \
        acc[ai][bj][m][n] = __builtin_amdgcn_mfma_f32_16x16x32_bf16(Bt[n][k], At[m][k], acc[ai][bj][m][n], 0, 0, 0); __builtin_amdgcn_s_setprio(0); } while (0)
#define PG8_WAIT_V(n) asm volatile("s_waitcnt vmcnt(" #n ")" ::: "memory")
#define PG8_WAIT_L(n) asm volatile("s_waitcnt lgkmcnt(" #n ")" ::: "memory")
#define PG8_BAR __builtin_amdgcn_s_barrier()
#define PG8_SCHED __builtin_amdgcn_sched_barrier(0)
    Unit cur, nxt; int ui = 0;
    if (!S.next(0, cur)) return;
    f32x4 acc[2][2][4][2];
#pragma unroll
    for (int a = 0; a < 2; ++a)
#pragma unroll
        for (int b = 0; b < 2; ++b)
#pragma unroll
            for (int m = 0; m < 4; ++m)
#pragma unroll
                for (int n = 0; n < 2; ++n) acc[a][b][m][n] = (f32x4){0.f, 0.f, 0.f, 0.f};
    bf16x8 At[4][2], B0[2][2], B1[2][2];
    const char* cA = (const char*)gA + (size_t)cur.pm * tstepA; const char* cB = (const char*)gB + (size_t)cur.pn * tstepB;
    S.a_ready(cur);
    if constexpr (SP2) {
        PG8_STAGE(PG8_SB(0, 0), cB, voffB); PG8_STAGE(PG8_SB(0, 1), cB + hstepB, voffB); PG8_STAGE(PG8_SA(0, 0), cA, voffA); PG8_STAGE(PG8_SA(0, 1), cA + hstepA, voffA);
        if (wr == 1) PG8_BAR;
        PG8_WAIT_V(2); PG8_BAR;
        PG8_STAGE(PG8_SB(1, 0), cB + kstep, voffB); PG8_STAGE(PG8_SA(1, 0), cA + kstep, voffA); PG8_STAGE(PG8_SB(1, 1), cB + hstepB + kstep, voffB);
        PG8_WAIT_V(6); PG8_BAR;
    } else {
        PG8_STAGE(PG8_SB(0, 0), cB, voffB); PG8_STAGE(PG8_SA(0, 0), cA, voffA); PG8_STAGE(PG8_SB(0, 1), cB + hstepB, voffB); PG8_STAGE(PG8_SA(0, 1), cA + hstepA, voffA);
        if (wr == 1) PG8_BAR;
        PG8_WAIT_V(4); PG8_BAR;
        PG8_STAGE(PG8_SB(1, 0), cB + kstep, voffB); PG8_STAGE(PG8_SA(1, 0), cA + kstep, voffA); PG8_STAGE(PG8_SB(1, 1), cB + hstepB + kstep, voffB);
        PG8_WAIT_V(6); PG8_BAR;
    }
    for (;;) {
        const bool has_next = S.next(ui + 1, nxt);
        const char* nA = has_next ? (const char*)gA + (size_t)nxt.pm * tstepA : cA; const char* nB = has_next ? (const char*)gB + (size_t)nxt.pn * tstepB : cB;
        for (int t = 0; t < nt; t += 2) {
            const bool last = (t == nt - 2);
            const char* a1 = cA + (size_t)(t + 1) * kstep;
            const char* a2 = last ? nA : cA + (size_t)(t + 2) * kstep; const char* b2 = last ? nB : cB + (size_t)(t + 2) * kstep;
            const char* a3 = a2 + kstep; const char* b3 = b2 + kstep;
            if (last && has_next) S.a_ready(nxt);
            if constexpr (SP2) {
            PG8_LDB(B0, 0, 0); PG8_LDB(B1, 0, 1); PG8_SCHED; PG8_LDA(At, 0, 0); PG8_STAGE(PG8_SA(1, 1), a1 + hstepA, voffA);
            PG8_WAIT_V(8); PG8_WAIT_L(0); PG8_BAR; PG8_MMA(0, 0, At, B0); PG8_MMA(0, 1, At, B1); PG8_BAR; PG8_SCHED;
            PG8_LDA(At, 0, 1); PG8_STAGE(PG8_SB(0, 0), b2, voffB); PG8_STAGE(PG8_SB(0, 1), b2 + hstepB, voffB); PG8_STAGE(PG8_SA(0, 0), a2, voffA);
            PG8_WAIT_V(8); PG8_WAIT_L(0); PG8_BAR; PG8_MMA(1, 0, At, B0); PG8_MMA(1, 1, At, B1); PG8_BAR; PG8_SCHED;
            PG8_LDB(B0, 1, 0); PG8_LDB(B1, 1, 1); PG8_SCHED; PG8_LDA(At, 1, 0); PG8_STAGE(PG8_SA(0, 1), a2 + hstepA, voffA);
            PG8_WAIT_V(8); PG8_WAIT_L(0); PG8_BAR; PG8_MMA(0, 0, At, B0); PG8_MMA(0, 1, At, B1); PG8_BAR; PG8_SCHED;
            PG8_LDA(At, 1, 1); PG8_STAGE(PG8_SB(1, 0), b3, voffB); PG8_STAGE(PG8_SB(1, 1), b3 + hstepB, voffB); PG8_STAGE(PG8_SA(1, 0), a3, voffA);
            PG8_WAIT_V(8); PG8_WAIT_L(0); PG8_BAR; PG8_MMA(1, 0, At, B0); PG8_MMA(1, 1, At, B1); PG8_BAR; PG8_SCHED;
            } else {
            PG8_LDB(B0, 0, 0); PG8_SCHED; PG8_LDA(At, 0, 0); PG8_STAGE(PG8_SA(1, 1), a1 + hstepA, voffA);
            PG8_WAIT_L(8); PG8_BAR; PG8_WAIT_L(0); PG8_MMA(0, 0, At, B0); PG8_BAR; PG8_SCHED;
            PG8_LDB(B1, 0, 1); PG8_STAGE(PG8_SB(0, 0), b2, voffB);
            PG8_BAR; PG8_WAIT_L(0); PG8_MMA(0, 1, At, B1); PG8_BAR;
            PG8_LDA(At, 0, 1); PG8_STAGE(PG8_SA(0, 0), a2, voffA);
            PG8_BAR; PG8_WAIT_L(0); PG8_MMA(1, 0, At, B0); PG8_BAR; PG8_SCHED;
            PG8_STAGE(PG8_SB(0, 1), b2 + hstepB, voffB);
            PG8_WAIT_V(6); PG8_BAR; PG8_MMA(1, 1, At, B1); PG8_BAR;
            PG8_LDB(B0, 1, 0); PG8_SCHED; PG8_LDA(At, 1, 0); PG8_STAGE(PG8_SA(0, 1), a2 + hstepA, voffA);
            PG8_WAIT_L(8); PG8_BAR; PG8_WAIT_L(0); PG8_MMA(0, 0, At, B0); PG8_BAR; PG8_SCHED;
            PG8_LDB(B1, 1, 1); PG8_STAGE(PG8_SB(1, 0), b3, voffB);
            PG8_BAR; PG8_WAIT_L(0); PG8_MMA(0, 1, At, B1); PG8_BAR;
            PG8_LDA(At, 1, 1); PG8_STAGE(PG8_SA(1, 0), a3, voffA);
            PG8_BAR; PG8_WAIT_L(0); PG8_MMA(1, 0, At, B0); PG8_BAR; PG8_SCHED;
            PG8_STAGE(PG8_SB(1, 1), b3 + hstepB, voffB);
            PG8_WAIT_V(6); PG8_BAR; PG8_MMA(1, 1, At, B1); PG8_BAR;
            }
        }
        if constexpr (ALIGN_EPI) { if (wr == 0) PG8_BAR; }
        if constexpr (!Epi::AFTER_DRAIN) { E(acc, cur, wr, wc, fr, fq); S.done(cur); }
        if (!has_next) break;
#pragma unroll
        for (int a = 0; a < 2; ++a)
#pragma unroll
            for (int b = 0; b < 2; ++b)
#pragma unroll
                for (int m = 0; m < 4; ++m)
#pragma unroll
                    for (int n = 0; n < 2; ++n) acc[a][b][m][n] = (f32x4){0.f, 0.f, 0.f, 0.f};
        cur = nxt; cA = nA; cB = nB; ++ui;
        if constexpr (ALIGN_EPI) { if (wr == 1) PG8_BAR; }
    }
    PG8_WAIT_V(0);
    if constexpr (!ALIGN_EPI) { if (wr == 0) PG8_BAR; }
    PG8_BAR;
    if constexpr (Epi::AFTER_DRAIN) { E.fused(acc, cur, wr, wc, fr, fq, lds, wid, lane); S.done(cur); }
#undef PG8_SA
#undef PG8_SB
#undef PG8_STAGE
#undef PG8_LDA
#undef PG8_LDB
#undef PG8_MMA
#undef PG8_WAIT_V
#undef PG8_WAIT_L
#undef PG8_BAR
#undef PG8_SCHED
}
}

constexpr int NB = 8, SEQ = 4096, T = NB * SEQ, D = 1024, DEPTH = 4, NZ = 7680, NWAVES = 8;
constexpr int CIN = 7424;
constexpr size_t MiB = 1u << 20;
constexpr size_t WS_CTL = 0, WS_LORA = 1 * MiB, WS_MV = 7 * MiB, ZERO_BYTES = 9 * MiB;
constexpr size_t LORA_BYTES = 3072 * 256 * 2, MV_BYTES = 1024 * 256 * 2;
constexpr size_t WS_WIN = 10 * MiB, WS_PA = 40 * MiB, WS_PBT = 42 * MiB, WS_POUT = 44 * MiB, WS_WQG = 46 * MiB, WS_PLEW = 52 * MiB, WS_KEYS = 52 * MiB + 512 * 1024, WS_GMW = 53 * MiB, WS_U = 54 * MiB, WS_V = 86 * MiB;
constexpr size_t WS_VF = 118 * MiB, WS_PW = 182 * MiB, WS_PB = 246 * MiB, WS_NX = 262 * MiB, WS_ZRKV = 390 * MiB, WS_ZL = 582 * MiB, WS_GUV = 614 * MiB, WS_SG = 742 * MiB;
constexpr size_t WS_EW = 870 * MiB, WS_AR = 934 * MiB, WS_G = 998 * MiB, WS_END = 1062 * MiB;
constexpr size_t WS_YAB = WS_NX, WS_Q = WS_ZRKV, WS_SEL = WS_ZRKV + 128 * MiB, WS_M1 = WS_EW, WS_MG = WS_AR, WS_N2 = WS_G;
constexpr size_t WIN_ZERO_OFF = WS_WIN + (size_t)3328 * 2048 * 2, WIN_ZERO_BYTES = (size_t)256 * 2048 * 2;
constexpr int CW_BAR = 4096;
constexpr int RING_BYTES = 131072, LDSCTL_OFF = RING_BYTES, MISC_OFF = LDSCTL_OFF + 320, LDS_BYTES = 147456;

#define LAS __attribute__((address_space(3)))
typedef unsigned short bf16;
typedef unsigned v4u __attribute__((ext_vector_type(4)));
typedef unsigned v2u __attribute__((ext_vector_type(2)));
typedef float f32x4 __attribute__((ext_vector_type(4)));
typedef float f32x2 __attribute__((ext_vector_type(2)));
typedef short bf16x8 __attribute__((ext_vector_type(8)));
using pg8::fsig; using pg8::fgelu; using pg8::bflo; using pg8::bfhi; using pg8::unpk8; using pg8::pk8; using pg8::cvt_pk_bf16;

#define XB_TMO      128
#define XB_XCNT(j)  (256  + 64 * (j))
#define XB_XSUB(j)  (1280 + 64 * (j))
#define XB_XGEN(j)  (2304 + 64 * (j))
#define XB_TOP      3328
#define XB_TOPGEN   3392
#define XCD_BAR_WORDS 3456
#define XB_SPIN_CAP (1u << 22)

__device__ __forceinline__ unsigned xb_ld(unsigned* p)              { return __hip_atomic_load(p, __ATOMIC_RELAXED, __HIP_MEMORY_SCOPE_AGENT); }
__device__ __forceinline__ unsigned xb_add(unsigned* p, unsigned v) { return __hip_atomic_fetch_add(p, v, __ATOMIC_RELAXED, __HIP_MEMORY_SCOPE_AGENT); }
__device__ __forceinline__ unsigned xb_xcc_id() { return (unsigned)__builtin_amdgcn_s_getreg((3 << 11) | 20) & 0xFu; }
#define XB_SPIN(cond, bar) do { unsigned _sp = 0; while (cond) { __builtin_amdgcn_s_sleep(1); \
    if ((++_sp & 255u) == 0u) { if (xb_ld(&(bar)[XB_TMO])) break; if (_sp > XB_SPIN_CAP) { atomicAdd(&(bar)[XB_TMO], 1u); break; } } } } while (0)

struct XcdBarrier { unsigned* bar; unsigned x; volatile LAS unsigned* st; };

__device__ __forceinline__ XcdBarrier xcd_barrier_post(unsigned* bar, volatile LAS unsigned* st) {
    XcdBarrier b; b.bar = bar; b.x = xb_xcc_id(); b.st = st;
    if (threadIdx.x == 0) (void)xb_add(&bar[XB_XCNT(b.x)], 1u);
    return b;
}
__device__ __forceinline__ void xcd_barrier_complete(unsigned* bar, unsigned x, unsigned& nloc, unsigned& nx) {
    const unsigned G = gridDim.x * gridDim.y * gridDim.z;
    unsigned sum, cnt, mine, sp = 0u;
    for (;;) {
        sum = 0u; cnt = 0u; mine = 0u;
#pragma unroll
        for (unsigned j = 0; j < 16; ++j) { const unsigned c = xb_ld(&bar[XB_XCNT(j)]); sum += c; cnt += (c > 0u) ? 1u : 0u; mine = (j == x) ? c : mine; }
        if (sum == G) break;
        __builtin_amdgcn_s_sleep(1);
        if ((++sp & 255u) == 0u) { if (xb_ld(&bar[XB_TMO])) break; if (sp > XB_SPIN_CAP) { atomicAdd(&bar[XB_TMO], 1u); break; } }
    }
    nloc = mine > 0u ? mine : 1u; nx = cnt > 0u ? cnt : 1u;
}
__device__ __forceinline__ void xcd_barrier(const XcdBarrier& b) {
    asm volatile("s_waitcnt vmcnt(0)" ::: "memory");
    __syncthreads();
    if (threadIdx.x == 0) {
        unsigned* bar = b.bar;
        __builtin_amdgcn_s_waitcnt(0);
        unsigned nloc = b.st[0], nx = b.st[1];
        if (nloc == 0u) { xcd_barrier_complete(bar, b.x, nloc, nx); b.st[0] = nloc; b.st[1] = nx; }
        const unsigned old = xb_add(&bar[XB_XSUB(b.x)], 1u);
        const unsigned gen = old / nloc;
        if (old + 1u == (gen + 1u) * nloc) {
            __builtin_amdgcn_fence(__ATOMIC_RELEASE, "agent");
            asm volatile("s_waitcnt vmcnt(0)" ::: "memory");
            const unsigned og = xb_add(&bar[XB_TOP], 1u);
            const unsigned tg = og / nx;
            if (og + 1u == (tg + 1u) * nx) xb_add(&bar[XB_TOPGEN], 1u);
            else XB_SPIN(xb_ld(&bar[XB_TOPGEN]) == tg, bar);
            __builtin_amdgcn_fence(__ATOMIC_ACQUIRE, "agent");
            xb_add(&bar[XB_XGEN(b.x)], 1u);
            asm volatile("s_waitcnt vmcnt(0)" ::: "memory");
        } else {
            XB_SPIN(xb_ld(&bar[XB_XGEN(b.x)]) == gen, bar);
            __builtin_amdgcn_fence(__ATOMIC_ACQUIRE, "agent");
            asm volatile("s_waitcnt vmcnt(0)" ::: "memory");
        }
    }
    __syncthreads();
}

struct Args { const float* in[32]; float* out; unsigned char* ws; };
struct Frame {
    LAS unsigned char* lds;
    int tid, lane, wave, G, bx;
    unsigned char* ws; float* h;
};
__device__ __forceinline__ void phase_ids(Frame& F) { int t = threadIdx.x; asm volatile("" : "+v"(t)); F.tid = t; F.lane = t & 63; F.wave = __builtin_amdgcn_readfirstlane(t >> 6); }
__device__ __forceinline__ float wave_sum(float v) {
#pragma unroll
    for (int o = 1; o < 64; o <<= 1) v += __shfl_xor(v, o);
    return v;
}
__device__ __forceinline__ float sum8(float v) { v += __shfl_xor(v, 1); v += __shfl_xor(v, 2); v += __shfl_xor(v, 4); return v; }

__device__ __forceinline__ void tr_item(const float* W, int ldw, int ncols, bf16* WT, int ldt, int koff, int row_off, LAS float* scr, int item, int lane) {
    const int nblk = ncols / 32, kb = item / nblk, nb = item % nblk, k0 = 64 * kb, n0 = 32 * nb;
#pragma unroll 8
    for (int i = 0; i < 32; ++i) { const int kk = 2 * i + (lane >> 5); scr[kk * 33 + (lane & 31)] = W[(size_t)(k0 + kk) * ldw + n0 + (lane & 31)]; }
    asm volatile("s_waitcnt lgkmcnt(0)" ::: "memory");
    const int c = lane & 7;
#pragma unroll
    for (int j = 0; j < 4; ++j) { const int n = (lane >> 3) + 8 * j; const LAS float* s = scr + (8 * c) * 33 + n;
        v4u o; o.x = cvt_pk_bf16(s[0 * 33], s[1 * 33]); o.y = cvt_pk_bf16(s[2 * 33], s[3 * 33]); o.z = cvt_pk_bf16(s[4 * 33], s[5 * 33]); o.w = cvt_pk_bf16(s[6 * 33], s[7 * 33]);
        *(v4u*)(WT + (size_t)(row_off + n0 + n) * ldt + koff + k0 + 8 * c) = o; }
    asm volatile("s_waitcnt lgkmcnt(0)" ::: "memory");
}
__device__ __forceinline__ void cvt_chunk(const float* src, bf16* dst, size_t chunk, int lane) {
    const f32x4* s = (const f32x4*)(src + chunk * 512) + lane * 2; const f32x4 a = s[0], b = s[1];
    *(v4u*)(dst + chunk * 512 + lane * 8) = pk8(a, b);
}
__device__ __forceinline__ void cvt8_chunk(const float* src, unsigned char* dst, size_t chunk, int lane, float sc) {
    const f32x4* s = (const f32x4*)(src + chunk * 512) + lane * 2; const f32x4 a = s[0] * sc, b = s[1] * sc;
    int w0 = 0, w1 = 0;
    w0 = __builtin_amdgcn_cvt_pk_fp8_f32(a.x, a.y, w0, false); w0 = __builtin_amdgcn_cvt_pk_fp8_f32(a.z, a.w, w0, true);
    w1 = __builtin_amdgcn_cvt_pk_fp8_f32(b.x, b.y, w1, false); w1 = __builtin_amdgcn_cvt_pk_fp8_f32(b.z, b.w, w1, true);
    *(v2u*)(dst + chunk * 512 + lane * 8) = (v2u){(unsigned)w0, (unsigned)w1};
}
__device__ __forceinline__ void norm_row_nx(const float* hrow, float* hcopy, const float* g, bf16* NX, int t, int lane) {
    const f32x4* xr = (const f32x4*)hrow + lane; f32x4 v[4]; float s = 0.f;
#pragma unroll
    for (int j = 0; j < 4; ++j) { v[j] = xr[64 * j]; s += (v[j].x * v[j].x + v[j].y * v[j].y) + (v[j].z * v[j].z + v[j].w * v[j].w); }
    if (hcopy) {
#pragma unroll
        for (int j = 0; j < 4; ++j) ((f32x4*)hcopy)[lane + 64 * j] = v[j]; }
    const float rstd = 1.f / sqrtf(wave_sum(s) * (1.f / D) + 1e-6f);
    const int tt = t & (SEQ - 1);
#pragma unroll
    for (int j = 0; j < 4; ++j) { const f32x4 gv = ((const f32x4*)g)[lane + 64 * j]; const f32x4 o = v[j] * rstd * gv;
        v2u w; w.x = cvt_pk_bf16(o.x, o.y); w.y = cvt_pk_bf16(o.z, o.w);
        const int c = 4 * (lane + 64 * j);
        *(v2u*)(NX + (size_t)t * 2048 + c) = w;
        if (tt != SEQ - 1) *(v2u*)(NX + (size_t)(t + 1) * 2048 + 1024 + c) = w;
        if (tt == 0) *(v2u*)(NX + (size_t)t * 2048 + 1024 + c) = (v2u){0u, 0u}; }
}
__device__ __forceinline__ void norm_row_n2(const float* hrow, const float* g, bf16* N2row, int lane) {
    const f32x4* xr = (const f32x4*)hrow + lane; f32x4 v[4]; float s = 0.f;
#pragma unroll
    for (int j = 0; j < 4; ++j) { v[j] = xr[64 * j]; s += (v[j].x * v[j].x + v[j].y * v[j].y) + (v[j].z * v[j].z + v[j].w * v[j].w); }
    const float rstd = 1.f / sqrtf(wave_sum(s) * (1.f / D) + 1e-6f);
#pragma unroll
    for (int j = 0; j < 4; ++j) { const f32x4 gv = ((const f32x4*)g)[lane + 64 * j]; const f32x4 o = v[j] * rstd * gv;
        v2u w; w.x = cvt_pk_bf16(o.x, o.y); w.y = cvt_pk_bf16(o.z, o.w);
        *(v2u*)(N2row + 4 * (lane + 64 * j)) = w; }
}

__device__ __forceinline__ void prep_phase(Frame& F, const Args& a, int layer) {
    phase_ids(F);
    LAS float* scr = (LAS float*)(F.lds + F.wave * 16384);
    const int gw = F.bx * NWAVES + F.wave, NGW = F.G * NWAVES, lane = F.lane;
    unsigned char* ws = F.ws;
    bf16* WIN = (bf16*)(ws + WS_WIN); bf16* LORA = (bf16*)(ws + WS_LORA + (size_t)layer * LORA_BYTES); bf16* MVT = (bf16*)(ws + WS_MV + (size_t)(layer > 0 ? layer - 1 : 0) * MV_BYTES);
    const float* w_in = a.in[5] + (size_t)layer * 2048 * CIN;
    const int mvn = layer > 0 ? 32 : 0;
    const int c1 = 32 * 104, c2 = 32 * 128, c3 = mvn, c4 = 32, c5 = 32, c6 = 64, c7 = 512, c10 = 1024, c12 = 128;
    const int total = c1 + c2 + c3 + c4 + c5 + c6 + 3 * c7 + c10 + c7 + c12;
    for (int it = gw; it < total; it += NGW) {
        int r = it;
        if (r < c1) { tr_item(w_in, CIN, 3328, WIN, 2048, 0, 0, scr, r, lane); continue; } r -= c1;
        if (r < c2) { tr_item(w_in + 3328, CIN, 4096, WIN, 2048, 0, 3584, scr, r, lane); continue; } r -= c2;
        if (r < c3) { tr_item(a.in[16] + (size_t)(layer - 1) * 2048 * 32, 32, 32, WIN, 2048, 0, 3328, scr, r, lane); continue; } r -= c3;
        if (r < c4) { tr_item(a.in[7] + (size_t)layer * 64 * 1024, 1024, 1024, LORA, 256, 0, 0, scr, r, lane); continue; } r -= c4;
        if (r < c5) { tr_item(a.in[9] + (size_t)layer * 64 * 1024, 1024, 1024, LORA, 256, 64, 1024, scr, r, lane); continue; } r -= c5;
        if (r < c6) { tr_item(a.in[10] + (size_t)layer * 128 * 1024, 1024, 1024, LORA, 256, 128, 2048, scr, r, lane); continue; } r -= c6;
        if (r < c7) { tr_item(a.in[23] + (size_t)layer * D * D, D, D, (bf16*)(ws + WS_PA), D, 0, 0, scr, r, lane); continue; } r -= c7;
        if (r < c7) { tr_item(a.in[24] + (size_t)layer * D * D, D, D, (bf16*)(ws + WS_PBT), D, 0, 0, scr, r, lane); continue; } r -= c7;
        if (r < c7) { tr_item(a.in[25] + (size_t)layer * D * D, D, D, (bf16*)(ws + WS_POUT), D, 0, 0, scr, r, lane); continue; } r -= c7;
        if (r < c10) { tr_item(a.in[26] + (size_t)layer * D * 2048, 2048, 2048, (bf16*)(ws + WS_WQG), D, 0, 0, scr, r, lane); continue; } r -= c10;
        if (r < c7) { tr_item(a.in[31] + (size_t)layer * D * D, D, D, (bf16*)(ws + WS_WQG), D, 0, 2048, scr, r, lane); continue; } r -= c7;
        tr_item(a.in[30] + (size_t)layer * 256 * D, D, D, (bf16*)(ws + WS_PLEW), 256, 0, 0, scr, r, lane);
    }
    if (layer > 0) {
        const float* w2 = a.in[17] + (size_t)(layer - 1) * 32 * 1024;
        for (int it = gw; it < 512; it += NGW) { const int e = it * 64 + lane, n = e >> 5, k = e & 31; MVT[n * 256 + k] = (bf16)(cvt_pk_bf16(w2[k * 1024 + n], 0.f) & 0xffffu); }
    }
    {
        const float* keys = a.in[27] + (size_t)layer * 262144; const float* ut = a.in[28] + (size_t)layer * 16777216; const float* vt = a.in[29] + (size_t)layer * 16777216;
        const float* pin = a.in[1] + (size_t)layer * T * 256; const float* gws = a.in[21] + (size_t)layer * 131072;
        const int n1 = 512, n2 = 32768, n4 = 16384, n5 = 256, ntot = n1 + 2 * n2 + n4 + n5;
        for (int it = gw; it < ntot; it += NGW) {
            int r = it;
            if (r < n2) { cvt8_chunk(ut, ws + WS_U, r, lane, 256.f); continue; } r -= n2;
            if (r < n2) { cvt8_chunk(vt, ws + WS_V, r, lane, 64.f); continue; } r -= n2;
            if (r < n4) { cvt_chunk(pin, (bf16*)(ws + WS_PB), r, lane); continue; } r -= n4;
            if (r < n1) { cvt_chunk(keys, (bf16*)(ws + WS_KEYS), r, lane); continue; } r -= n1;
            {
                const int e0 = r * 512 + lane * 8, tq = (e0 >> 7) & 127, p0 = e0 & 127;
                const f32x4* s = (const f32x4*)(gws + e0); f32x4 x0 = s[0], x1 = s[1];
#pragma unroll
                for (int j = 0; j < 4; ++j) { if (p0 + j > tq) x0[j] = 0.f; if (p0 + 4 + j > tq) x1[j] = 0.f; }
                *(v4u*)((bf16*)(ws + WS_GMW) + e0) = pk8(x0, x1);
            }
        }
    }
    if (layer == 0) {
        for (int m = gw; m < T; m += NGW) norm_row_nx(a.in[0] + (size_t)m * D, F.h + (size_t)m * D, a.in[2], (bf16*)(ws + WS_NX), m, lane);
    }
}

__device__ __forceinline__ void scan_unit(Frame& F, const Args& a, int layer, int unit) {
    phase_ids(F);
    const int b = unit >> 4, hh = unit & 15, tid = F.tid, lane = F.lane, tl = tid >> 3, c8 = tid & 7, ch = hh * 64 + c8 * 8;
    LAS float* sW = (LAS float*)F.lds; LAS float* sK = sW + 4096; LAS float* sA = sK + 4096; LAS float* sB = sA + 4096; LAS float* sR = sB + 4096; LAS float* sV = sR + 4096; LAS float* sY = sV + 4096;
    const bf16* ZR = (const bf16*)(F.ws + WS_ZRKV); const bf16* EW = (const bf16*)(F.ws + WS_EW); const bf16* AR = (const bf16*)(F.ws + WS_AR); const bf16* GT = (const bf16*)(F.ws + WS_G);
    bf16* YAB = (bf16*)(F.ws + WS_YAB);
    f32x4 pkk[2], pka[2], prk[2], plg[2], plb[2];
    { const size_t po = (size_t)layer * 1024 + ch;
#pragma unroll
      for (int i = 0; i < 2; ++i) { pkk[i] = *(const f32x4*)(a.in[11] + po + 4 * i); pka[i] = *(const f32x4*)(a.in[12] + po + 4 * i); prk[i] = *(const f32x4*)(a.in[13] + po + 4 * i);
                                    plg[i] = *(const f32x4*)(a.in[14] + po + 4 * i); plb[i] = *(const f32x4*)(a.in[15] + po + 4 * i); } }
    f32x2 S[8];
#pragma unroll
    for (int i = 0; i < 8; ++i) S[i] = (f32x2){0.f, 0.f};
    const int cc = lane >> 4, rowi = (F.wave & 3) * 16 + (lane & 15);
    for (int chunk = 0; chunk < SEQ / 64; ++chunk) {
        const size_t row = (size_t)b * SEQ + chunk * 64 + tl;
        float bon;
        {
            f32x4 r_[2], k_[2], v_[2], e_[2], ar_[2];
            unpk8(*(const v4u*)(ZR + row * 3072 + ch), r_[0], r_[1]); unpk8(*(const v4u*)(ZR + row * 3072 + 1024 + ch), k_[0], k_[1]); unpk8(*(const v4u*)(ZR + row * 3072 + 2048 + ch), v_[0], v_[1]);
            unpk8(*(const v4u*)(EW + row * 1024 + ch), e_[0], e_[1]); unpk8(*(const v4u*)(AR + row * 1024 + ch), ar_[0], ar_[1]);
            f32x4 kkv[2], kp[2]; float ss = 0.f, bs = 0.f;
#pragma unroll
            for (int i = 0; i < 2; ++i) { kkv[i] = k_[i] * pkk[i]; kp[i] = k_[i] * (1.f + (ar_[i] - 1.f) * pka[i]);
                const f32x4 q = kkv[i] * kkv[i]; ss += (q.x + q.y) + (q.z + q.w); const f32x4 z = r_[i] * kp[i] * prk[i]; bs += (z.x + z.y) + (z.z + z.w); }
            ss = sum8(ss); bon = sum8(bs);
            const float inv = 1.f / sqrtf(fmaxf(ss, 1e-24f));
            const int o = tl * 64 + c8 * 8;
#pragma unroll
            for (int i = 0; i < 2; ++i) { const f32x4 kn = kkv[i] * inv;
                f32x4 w4; w4.x = __builtin_amdgcn_exp2f(-1.44269504f * e_[i].x); w4.y = __builtin_amdgcn_exp2f(-1.44269504f * e_[i].y); w4.z = __builtin_amdgcn_exp2f(-1.44269504f * e_[i].z); w4.w = __builtin_amdgcn_exp2f(-1.44269504f * e_[i].w);
                *(LAS f32x4*)(sW + o + 4 * i) = w4; *(LAS f32x4*)(sK + o + 4 * i) = kp[i]; *(LAS f32x4*)(sA + o + 4 * i) = -kn; *(LAS f32x4*)(sB + o + 4 * i) = kn * ar_[i];
                *(LAS f32x4*)(sR + o + 4 * i) = r_[i]; *(LAS f32x4*)(sV + o + 4 * i) = v_[i]; }
        }
        __syncthreads();
        if (F.wave < 4) {
            for (int s = 0; s < 64; ++s) {
                const int o = s * 64 + cc * 16;
                f32x4 q[4]; f32x2 ac;
#pragma unroll
                for (int i = 0; i < 4; ++i) q[i] = *(const LAS f32x4*)(sA + o + 4 * i);
                ac = S[0] * __builtin_shufflevector(q[0], q[0], 0, 1);
                ac += S[1] * __builtin_shufflevector(q[0], q[0], 2, 3);
#pragma unroll
                for (int i = 1; i < 4; ++i) { ac += S[2 * i] * __builtin_shufflevector(q[i], q[i], 0, 1); ac += S[2 * i + 1] * __builtin_shufflevector(q[i], q[i], 2, 3); }
                float sa = ac.x + ac.y; sa += __shfl_xor(sa, 16); sa += __shfl_xor(sa, 32);
                const float vv = sV[s * 64 + rowi];
                f32x4 w[4], bb[4], kx[4];
#pragma unroll
                for (int i = 0; i < 4; ++i) { w[i] = *(const LAS f32x4*)(sW + o + 4 * i); bb[i] = *(const LAS f32x4*)(sB + o + 4 * i); kx[i] = *(const LAS f32x4*)(sK + o + 4 * i); }
                const f32x2 sa2 = (f32x2){sa, sa}, vv2 = (f32x2){vv, vv};
#pragma unroll
                for (int i = 0; i < 4; ++i) {
                    S[2 * i]     = S[2 * i]     * __builtin_shufflevector(w[i], w[i], 0, 1) + sa2 * __builtin_shufflevector(bb[i], bb[i], 0, 1) + vv2 * __builtin_shufflevector(kx[i], kx[i], 0, 1);
                    S[2 * i + 1] = S[2 * i + 1] * __builtin_shufflevector(w[i], w[i], 2, 3) + sa2 * __builtin_shufflevector(bb[i], bb[i], 2, 3) + vv2 * __builtin_shufflevector(kx[i], kx[i], 2, 3); }
#pragma unroll
                for (int i = 0; i < 4; ++i) q[i] = *(const LAS f32x4*)(sR + o + 4 * i);
                ac = S[0] * __builtin_shufflevector(q[0], q[0], 0, 1);
                ac += S[1] * __builtin_shufflevector(q[0], q[0], 2, 3);
#pragma unroll
                for (int i = 1; i < 4; ++i) { ac += S[2 * i] * __builtin_shufflevector(q[i], q[i], 0, 1); ac += S[2 * i + 1] * __builtin_shufflevector(q[i], q[i], 2, 3); }
                float y = ac.x + ac.y; y += __shfl_xor(y, 16); y += __shfl_xor(y, 32);
                if (cc == 0) sY[s * 64 + rowi] = y;
            }
        }
        __syncthreads();
        {
            const int o = tl * 64 + c8 * 8;
            f32x4 y_[2], v_[2], g_[2];
#pragma unroll
            for (int i = 0; i < 2; ++i) { y_[i] = *(const LAS f32x4*)(sY + o + 4 * i); v_[i] = *(const LAS f32x4*)(sV + o + 4 * i); }
            unpk8(*(const v4u*)(GT + row * 1024 + ch), g_[0], g_[1]);
            float s1 = (y_[0].x + y_[0].y) + (y_[0].z + y_[0].w) + (y_[1].x + y_[1].y) + (y_[1].z + y_[1].w);
            const float mu = sum8(s1) * (1.f / 64.f);
            float s2 = 0.f;
#pragma unroll
            for (int i = 0; i < 2; ++i) { y_[i] = y_[i] - mu; const f32x4 q = y_[i] * y_[i]; s2 += (q.x + q.y) + (q.z + q.w); }
            const float rstd = 1.f / sqrtf(sum8(s2) * (1.f / 64.f) + 64e-5f);
            f32x4 o_[2];
#pragma unroll
            for (int i = 0; i < 2; ++i) o_[i] = (y_[i] * rstd * plg[i] + plb[i] + bon * v_[i]) * g_[i];
            *(v4u*)(YAB + row * 2048 + ch) = pk8(o_[0], o_[1]);
        }
        __syncthreads();
    }
}

constexpr int TP = 136;
__device__ __forceinline__ void mma_128(const LAS bf16* sA, const LAS bf16* sBt, int wave, int lane, f32x4 (&acc)[4][2]) {
    const int wm = wave >> 2, wn = wave & 3, fr = lane & 15, fq = lane >> 4;
#pragma unroll
    for (int kk = 0; kk < 4; ++kk) {
        bf16x8 af[4], bf_[2];
#pragma unroll
        for (int mt = 0; mt < 4; ++mt) af[mt] = *(const LAS bf16x8*)(sA + (64 * wm + 16 * mt + fr) * TP + 32 * kk + 8 * fq);
#pragma unroll
        for (int nt = 0; nt < 2; ++nt) bf_[nt] = *(const LAS bf16x8*)(sBt + (32 * wn + 16 * nt + fr) * TP + 32 * kk + 8 * fq);
#pragma unroll
        for (int mt = 0; mt < 4; ++mt)
#pragma unroll
            for (int nt = 0; nt < 2; ++nt) acc[mt][nt] = __builtin_amdgcn_mfma_f32_16x16x32_bf16(bf_[nt], af[mt], acc[mt][nt], 0, 0, 0);
    }
}
__device__ __forceinline__ void gmlp_unit(Frame& F, const Args& a, int layer, int unit) {
    phase_ids(F);
    const size_t t0 = (size_t)unit * 128; const int tid = F.tid, lane = F.lane, wave = F.wave;
    LAS float* st = (LAS float*)F.lds; LAS bf16* sA = (LAS bf16*)(F.lds + 1024); LAS bf16* sB = (LAS bf16*)(F.lds + 1024 + 128 * TP * 2);
    const bf16* GUV = (const bf16*)(F.ws + WS_GUV); const bf16* GMW = (const bf16*)(F.ws + WS_GMW); bf16* YAB = (bf16*)(F.ws + WS_YAB);
    const float* lng = a.in[19] + (size_t)layer * 1024; const float* lnb = a.in[20] + (size_t)layer * 1024; const float* bsp = a.in[22] + (size_t)layer * 1024;
    for (int r = 0; r < 16; ++r) { const int tok = wave * 16 + r; const bf16* rowp = GUV + (t0 + tok) * 2048 + 1024;
        f32x4 x0, x1, x2, x3; unpk8(*(const v4u*)(rowp + lane * 8), x0, x1); unpk8(*(const v4u*)(rowp + 512 + lane * 8), x2, x3);
        const f32x4 sv = (x0 + x1) + (x2 + x3), qv = (x0 * x0 + x1 * x1) + (x2 * x2 + x3 * x3);
        const float s = wave_sum((sv.x + sv.y) + (sv.z + sv.w)), q = wave_sum((qv.x + qv.y) + (qv.z + qv.w));
        const float mean = s * (1.f / 1024.f), var = fmaxf(q * (1.f / 1024.f) - mean * mean, 0.f);
        if (lane == 0) { st[tok * 2] = mean; st[tok * 2 + 1] = 1.f / sqrtf(var + 1e-5f); } }
    __syncthreads();
    for (int g = 0; g < 8; ++g) {
#pragma unroll
        for (int i = 0; i < 4; ++i) { const int pc = tid + 512 * i, rr = pc >> 4, c16 = pc & 15;
            *(LAS v4u*)(sA + rr * TP + c16 * 8) = *(const v4u*)(GMW + (size_t)g * 16384 + rr * 128 + c16 * 8); }
        { const int p = tid & 127, oc0 = tid >> 7; const float mean = st[p * 2], rstd = st[p * 2 + 1];
#pragma unroll
          for (int i = 0; i < 4; ++i) { const int oc = oc0 + 4 * i, c0 = g * 128 + oc * 8;
              f32x4 x0, x1; unpk8(*(const v4u*)(GUV + (t0 + p) * 2048 + 1024 + c0), x0, x1);
              const f32x4 g0 = *(const f32x4*)(lng + c0), g1 = *(const f32x4*)(lng + c0 + 4), b0 = *(const f32x4*)(lnb + c0), b1 = *(const f32x4*)(lnb + c0 + 4);
              x0 = (x0 - mean) * rstd * g0 + b0; x1 = (x1 - mean) * rstd * g1 + b1;
              const v4u w = pk8(x0, x1);
              LAS bf16* d = sB + (oc * 8) * TP + p;
              d[0 * TP] = (bf16)(w.x & 0xffffu); d[1 * TP] = (bf16)(w.x >> 16); d[2 * TP] = (bf16)(w.y & 0xffffu); d[3 * TP] = (bf16)(w.y >> 16);
              d[4 * TP] = (bf16)(w.z & 0xffffu); d[5 * TP] = (bf16)(w.z >> 16); d[6 * TP] = (bf16)(w.w & 0xffffu); d[7 * TP] = (bf16)(w.w >> 16); } }
        __syncthreads();
        f32x4 acc[4][2];
#pragma unroll
        for (int mt = 0; mt < 4; ++mt)
#pragma unroll
            for (int nt = 0; nt < 2; ++nt) acc[mt][nt] = (f32x4){0.f, 0.f, 0.f, 0.f};
        mma_128(sA, sB, wave, lane, acc);
        { const int wm = wave >> 2, wn = wave & 3, fr = lane & 15, fq = lane >> 4;
#pragma unroll
          for (int mt = 0; mt < 4; ++mt) { const int tt = 64 * wm + 16 * mt + fr; const float bsv = bsp[g * 128 + tt];
#pragma unroll
              for (int nt = 0; nt < 2; ++nt) { const int c = g * 128 + 32 * wn + 16 * nt + 4 * fq;
                  const v2u uw = *(const v2u*)(GUV + (t0 + tt) * 2048 + c);
                  const f32x4 u4 = (f32x4){bflo(uw.x), bfhi(uw.x), bflo(uw.y), bfhi(uw.y)};
                  const f32x4 yb = u4 * (acc[mt][nt] + bsv);
                  v2u ow; ow.x = cvt_pk_bf16(yb.x, yb.y); ow.y = cvt_pk_bf16(yb.z, yb.w);
                  *(v2u*)(YAB + (t0 + tt) * 2048 + 1024 + c) = ow; } } }
        __syncthreads();
    }
}

__device__ __forceinline__ unsigned fkey(float f) { const unsigned u = __builtin_bit_cast(unsigned, f); return (u & 0x80000000u) ? ~u : (u | 0x80000000u); }
__device__ __forceinline__ float kval(unsigned k, unsigned mask) { const unsigned u = k & mask; return __builtin_bit_cast(float, (u & 0x80000000u) ? (u ^ 0x80000000u) : ~u); }
__device__ __forceinline__ float swap32_add(float a, float b) { const auto r = __builtin_amdgcn_permlane32_swap(__builtin_bit_cast(unsigned, a), __builtin_bit_cast(unsigned, b), false, false);
    return __builtin_bit_cast(float, (unsigned)r[0]) + __builtin_bit_cast(float, (unsigned)r[1]); }
__device__ __forceinline__ float swap16_add(float a, float b) { const auto r = __builtin_amdgcn_permlane16_swap(__builtin_bit_cast(unsigned, a), __builtin_bit_cast(unsigned, b), false, false);
    return __builtin_bit_cast(float, (unsigned)r[0]) + __builtin_bit_cast(float, (unsigned)r[1]); }
__device__ __forceinline__ float row_sum16(float x) {
    x += __builtin_bit_cast(float, __builtin_amdgcn_update_dpp(0, __builtin_bit_cast(int, x), 0x128, 0xf, 0xf, false));
    x += __builtin_bit_cast(float, __builtin_amdgcn_update_dpp(0, __builtin_bit_cast(int, x), 0x124, 0xf, 0xf, false));
    x += __builtin_bit_cast(float, __builtin_amdgcn_update_dpp(0, __builtin_bit_cast(int, x), 0x122, 0xf, 0xf, false));
    x += __builtin_bit_cast(float, __builtin_amdgcn_update_dpp(0, __builtin_bit_cast(int, x), 0x121, 0xf, 0xf, false));
    return x; }
#define TOP_INSERT(top, x) do { unsigned _x = (x); _Pragma("unroll") for (int _j = 0; _j < 16; ++_j) { const unsigned _h = max((top)[_j], _x); _x = min((top)[_j], _x); (top)[_j] = _h; } } while (0)
__device__ __forceinline__ void peer_unit(Frame& F, const Args& a, int layer, int unit, bool last) {
    phase_ids(F);
    const size_t t0 = (size_t)unit * 128; const int tid = F.tid, lane = F.lane, wave = F.wave, fr = lane & 15, fq = lane >> 4;
    LAS bf16* sKey = (LAS bf16*)F.lds;
    LAS unsigned* sLT = (LAS unsigned*)(F.lds + 128 * TP * 2) + wave * 512;
    const bf16* Q = (const bf16*)(F.ws + WS_Q); const bf16* KEYS = (const bf16*)(F.ws + WS_KEYS); v2u* SEL = (v2u*)(F.ws + WS_SEL);
    const size_t trow = t0 + wave * 16 + fr;
    for (int hd = 0; hd < 8; ++hd) {
        for (int p = 0; p < 2; ++p) {
            __syncthreads();
#pragma unroll
            for (int i = 0; i < 4; ++i) { const int pc = tid + 512 * i, rr = pc >> 4, c16 = pc & 15;
                *(LAS v4u*)(sKey + rr * TP + c16 * 8) = *(const v4u*)(KEYS + (size_t)(hd * 2 + p) * 16384 + rr * 128 + c16 * 8); }
            bf16x8 qf[4];
#pragma unroll
            for (int kk = 0; kk < 4; ++kk) qf[kk] = *(const bf16x8*)(Q + trow * 2048 + hd * 256 + p * 128 + 32 * kk + 8 * fq);
            __syncthreads();
            f32x4 sc[8];
#pragma unroll
            for (int nt = 0; nt < 8; ++nt) sc[nt] = (f32x4){0.f, 0.f, 0.f, 0.f};
#pragma unroll
            for (int kk = 0; kk < 4; ++kk)
#pragma unroll
                for (int nt = 0; nt < 8; ++nt) { const bf16x8 kf = *(const LAS bf16x8*)(sKey + (16 * nt + fr) * TP + 32 * kk + 8 * fq);
                    sc[nt] = __builtin_amdgcn_mfma_f32_16x16x32_bf16(kf, qf[kk], sc[nt], 0, 0, 0); }
            unsigned top[16];
#pragma unroll
            for (int j = 0; j < 16; ++j) top[j] = 0u;
#pragma unroll
            for (int nt = 0; nt < 8; ++nt)
#pragma unroll
                for (int rg = 0; rg < 4; ++rg) TOP_INSERT(top, (fkey(sc[nt][rg]) & 0xFFFFFF80u) | (unsigned)(16 * nt + 4 * fq + rg));
#pragma unroll
            for (int rnd = 0; rnd < 2; ++rnd) { unsigned oth[16];
#pragma unroll
                for (int j = 0; j < 16; ++j) oth[j] = (unsigned)__shfl_xor((int)top[j], 16 << rnd);
#pragma unroll
                for (int j = 0; j < 16; ++j) TOP_INSERT(top, oth[j]); }
#pragma unroll
            for (int j = 0; j < 16; ++j) sLT[fr * 32 + p * 16 + j] = top[j];
        }
        float v0[16], v1[16];
#pragma unroll
        for (int j = 0; j < 16; ++j) { v0[j] = kval(sLT[fr * 32 + j], 0xFFFFFF80u); v1[j] = kval(sLT[fr * 32 + 16 + j], 0xFFFFFF80u); }
        unsigned best[16];
#pragma unroll
        for (int j = 0; j < 16; ++j) best[j] = 0u;
#pragma unroll
        for (int i = 0; i < 16; ++i)
#pragma unroll
            for (int j = 0; j < 16; ++j) if ((i + 1) * (j + 1) <= 16) TOP_INSERT(best, (fkey(v0[i] + v1[j]) & 0xFFFFFF00u) | (unsigned)(i * 16 + j));
        float ev[16], esum = 0.f; const float mx = kval(best[0], 0xFFFFFF00u);
#pragma unroll
        for (int k = 0; k < 16; ++k) { ev[k] = __builtin_amdgcn_exp2f((kval(best[k], 0xFFFFFF00u) - mx) * 1.44269504f); esum += ev[k]; }
        const float einv = 1.f / esum;
#pragma unroll
        for (int k = 0; k < 16; ++k) { const unsigned pos = best[k] & 255u;
            const unsigned i0 = sLT[fr * 32 + (pos >> 4)] & 127u, i1 = sLT[fr * 32 + 16 + (pos & 15u)] & 127u;
            if ((k >> 2) == fq) SEL[trow * 128 + hd * 16 + k] = (v2u){i0 * 128u + i1, __builtin_bit_cast(unsigned, ev[k] * einv)}; }
    }
    asm volatile("s_waitcnt vmcnt(0)" ::: "memory");
    __syncthreads();
    const bf16* N2 = (const bf16*)(F.ws + WS_N2); const unsigned char* U8 = (const unsigned char*)(F.ws + WS_U); const unsigned char* V8 = (const unsigned char*)(F.ws + WS_V);
    const unsigned* SELU = (const unsigned*)SEL;
#define PL_LOAD(UB, VB, SE, BB) do { _Pragma("unroll") for (int _q = 0; _q < 8; ++_q) { \
        const unsigned _idx = (unsigned)__builtin_amdgcn_readlane((int)((_q & 1) ? (SE).z : (SE).x), (BB) * 4 + (_q >> 1)); \
        (UB)[_q] = *(const v4u*)(U8 + (size_t)_idx * 1024 + 16 * lane); (VB)[_q] = *(const v4u*)(V8 + (size_t)_idx * 1024 + 16 * lane); } } while (0)
#define PL_COMPUTE(UB, VB, SE, BB) do { float _p[8]; \
        _Pragma("unroll") for (int _q = 0; _q < 8; ++_q) { f32x2 _a = (f32x2){0.f, 0.f}; \
            _Pragma("unroll") for (int _j = 0; _j < 4; ++_j) { _a += __builtin_amdgcn_cvt_pk_f32_fp8((int)(UB)[_q][_j], false) * nf[2 * _j]; _a += __builtin_amdgcn_cvt_pk_f32_fp8((int)(UB)[_q][_j], true) * nf[2 * _j + 1]; } \
            _p[_q] = _a.x + _a.y; } \
        float _s0 = swap32_add(_p[0], _p[4]), _s1 = swap32_add(_p[1], _p[5]), _s2 = swap32_add(_p[2], _p[6]), _s3 = swap32_add(_p[3], _p[7]); \
        float _t0 = row_sum16(swap16_add(_s0, _s2)), _t1 = row_sum16(swap16_add(_s1, _s3)); \
        _t0 = fgelu(_t0 * (1.f / 256.f)) * (1.f / 64.f); _t1 = fgelu(_t1 * (1.f / 256.f)) * (1.f / 64.f); \
        _Pragma("unroll") for (int _q = 0; _q < 8; ++_q) { \
            const float _gd = __builtin_bit_cast(float, __builtin_amdgcn_readlane(__builtin_bit_cast(int, (_q & 1) ? _t1 : _t0), 16 * (((_q >> 1) & 1) | ((_q >> 2) << 1)))); \
            const float _gw = __builtin_bit_cast(float, __builtin_amdgcn_readlane((int)((_q & 1) ? (SE).w : (SE).y), (BB) * 4 + (_q >> 1))); \
            const float _c = _gd * _gw; const f32x2 _c2 = (f32x2){_c, _c}; \
            _Pragma("unroll") for (int _j = 0; _j < 4; ++_j) { out[2 * _j] += _c2 * __builtin_amdgcn_cvt_pk_f32_fp8((int)(VB)[_q][_j], false); out[2 * _j + 1] += _c2 * __builtin_amdgcn_cvt_pk_f32_fp8((int)(VB)[_q][_j], true); } } } while (0)
    {
        const size_t tokb = t0 + wave * 16;
        v4u se = *(const v4u*)(SELU + tokb * 256 + 4 * lane), se_n = se;
        v4u ua[8], va[8], ub[8], vb[8];
        PL_LOAD(ua, va, se, 0);
        for (int it = 0; it < 16; ++it) {
            const size_t tok = tokb + it;
            f32x2 nf[8], out[8];
            { f32x4 x0, x1, x2, x3; unpk8(*(const v4u*)(N2 + tok * 1024 + 16 * lane), x0, x1); unpk8(*(const v4u*)(N2 + tok * 1024 + 16 * lane + 8), x2, x3);
              nf[0] = __builtin_shufflevector(x0, x0, 0, 1); nf[1] = __builtin_shufflevector(x0, x0, 2, 3); nf[2] = __builtin_shufflevector(x1, x1, 0, 1); nf[3] = __builtin_shufflevector(x1, x1, 2, 3);
              nf[4] = __builtin_shufflevector(x2, x2, 0, 1); nf[5] = __builtin_shufflevector(x2, x2, 2, 3); nf[6] = __builtin_shufflevector(x3, x3, 0, 1); nf[7] = __builtin_shufflevector(x3, x3, 2, 3); }
#pragma unroll
            for (int i = 0; i < 8; ++i) out[i] = (f32x2){0.f, 0.f};
            if (it < 15) se_n = *(const v4u*)(SELU + (tok + 1) * 256 + 4 * lane);
#pragma unroll 1
            for (int bp = 0; bp < 8; ++bp) {
                PL_LOAD(ub, vb, se, 2 * bp + 1);
                PL_COMPUTE(ua, va, se, 2 * bp);
                if (bp < 7) PL_LOAD(ua, va, se, 2 * bp + 2); else if (it < 15) PL_LOAD(ua, va, se_n, 0);
                PL_COMPUTE(ub, vb, se, 2 * bp + 1);
            }
            se = se_n;
            float* hp = F.h + tok * 1024 + 16 * lane;
            f32x4 hv[4]; float s = 0.f;
#pragma unroll
            for (int i = 0; i < 4; ++i) { hv[i] = *(const f32x4*)(hp + 4 * i) + (f32x4){out[2 * i].x, out[2 * i].y, out[2 * i + 1].x, out[2 * i + 1].y};
                s += (hv[i].x * hv[i].x + hv[i].y * hv[i].y) + (hv[i].z * hv[i].z + hv[i].w * hv[i].w); }
            const float rstd = 1.f / sqrtf(wave_sum(s) * (1.f / D) + 1e-6f);
            const float* g = (last ? a.in[4] : a.in[2] + (size_t)(layer + 1) * 1024) + 16 * lane;
            f32x4 o[4];
#pragma unroll
            for (int i = 0; i < 4; ++i) o[i] = hv[i] * rstd * *(const f32x4*)(g + 4 * i);
            if (last) {
#pragma unroll
                for (int i = 0; i < 4; ++i) *(f32x4*)(hp + 4 * i) = o[i];
            } else {
#pragma unroll
                for (int i = 0; i < 4; ++i) *(f32x4*)(hp + 4 * i) = hv[i];
                bf16* NX = (bf16*)(F.ws + WS_NX); const v4u w0 = pk8(o[0], o[1]), w1 = pk8(o[2], o[3]); const int tt = (int)(tok & (SEQ - 1));
                *(v4u*)(NX + tok * 2048 + 16 * lane) = w0; *(v4u*)(NX + tok * 2048 + 16 * lane + 8) = w1;
                if (tt != SEQ - 1) { *(v4u*)(NX + (tok + 1) * 2048 + 1024 + 16 * lane) = w0; *(v4u*)(NX + (tok + 1) * 2048 + 1024 + 16 * lane + 8) = w1; }
                if (tt == 0) { *(v4u*)(NX + tok * 2048 + 1024 + 16 * lane) = (v4u){0u, 0u, 0u, 0u}; *(v4u*)(NX + tok * 2048 + 1024 + 16 * lane + 8) = (v4u){0u, 0u, 0u, 0u}; }
            }
        }
    }
#undef PL_LOAD
#undef PL_COMPUTE
}

__global__ void __launch_bounds__(NWAVES * 64, 2) trunk_fwd(Args args) {
    extern __shared__ __attribute__((aligned(16))) unsigned char lds[];
    Frame F;
    F.lds = (LAS unsigned char*)lds;
    F.tid = threadIdx.x; F.lane = F.tid & 63; F.wave = __builtin_amdgcn_readfirstlane(F.tid >> 6);
    F.G = gridDim.x; F.bx = blockIdx.x; F.ws = args.ws; F.h = args.out;
    volatile LAS unsigned* MISC = (volatile LAS unsigned*)(F.lds + MISC_OFF);
    for (int u = F.tid; u < (LDS_BYTES - LDSCTL_OFF) / 4; u += NWAVES * 64) ((LAS unsigned*)(F.lds + LDSCTL_OFF))[u] = 0u;
    __syncthreads();
    unsigned* ctl = (unsigned*)(F.ws + WS_CTL);
    XcdBarrier bar = xcd_barrier_post(ctl + CW_BAR, MISC + 8);
    unsigned char* ws = F.ws;
    LAS unsigned char* ring = (LAS unsigned char*)F.lds;

    for (int layer = 0; layer < DEPTH; ++layer) {
        prep_phase(F, args, layer);
        xcd_barrier(bar);
        {   pg8::Gemm g{(const bf16*)(ws + WS_NX), (const bf16*)(ws + WS_WIN), T, NZ, 2048, 2048}; pg8::StaticOrder S; S.init(T, NZ, F.G, F.bx);
            pg8::EpiZ E{(bf16*)(ws + WS_ZRKV), (bf16*)(ws + WS_ZL), (bf16*)(ws + WS_GUV), (bf16*)(ws + WS_SG), layer == 0 ? (bf16*)(ws + WS_VF) : (bf16*)nullptr};
            pg8::gemm_phase<pg8::EpiZ, pg8::StaticOrder, true, true>(ring, g, S, E); }
        xcd_barrier(bar);
        {   pg8::Gemm g{(const bf16*)(ws + WS_ZL), (const bf16*)(ws + WS_LORA + (size_t)layer * LORA_BYTES), T, 3072, 256, 512}; pg8::StaticOrder S; S.init(T, 3072, F.G, F.bx);
            pg8::EpiLora E{(bf16*)(ws + WS_EW), (size_t)(WS_AR - WS_EW) / 2, args.in[6] + (size_t)layer * 1024, args.in[8] + (size_t)layer * 1024};
            pg8::gemm_phase<pg8::EpiLora, pg8::StaticOrder, true, true>(ring, g, S, E); }
        if (layer > 0) {
            pg8::Gemm g{(const bf16*)(ws + WS_ZL) + 256, (const bf16*)(ws + WS_MV + (size_t)(layer - 1) * MV_BYTES), T, 1024, 256, 512}; pg8::StaticOrder S; S.init(T, 1024, F.G, F.bx);
            pg8::EpiMv E{(bf16*)(ws + WS_ZRKV), (const bf16*)(ws + WS_VF), args.in[18] + (size_t)(layer - 1) * 1024};
            pg8::gemm_phase<pg8::EpiMv, pg8::StaticOrder, true, true>(ring, g, S, E); }
        {   pg8::Gemm g{(const bf16*)(ws + WS_PB), (const bf16*)(ws + WS_PLEW), T, 1024, 256, 256}; pg8::StaticOrder S; S.init(T, 1024, F.G, F.bx);
            pg8::EpiPlain E{(bf16*)(ws + WS_PW), 1024};
            pg8::gemm_phase<pg8::EpiPlain, pg8::StaticOrder, true, true>(ring, g, S, E); }
        xcd_barrier(bar);
        {   const int nsb = F.G >= 2 ? F.G / 2 : 1;
            if (F.G < 2) { for (int u = 0; u < NB * 16; ++u) scan_unit(F, args, layer, u); for (int u = 0; u < T / 128; ++u) gmlp_unit(F, args, layer, u); }
            else if (F.bx < nsb) { for (int u = F.bx; u < NB * 16; u += nsb) scan_unit(F, args, layer, u); }
            else { for (int u = F.bx - nsb; u < T / 128; u += F.G - nsb) gmlp_unit(F, args, layer, u); } }
        xcd_barrier(bar);
        {   pg8::Gemm g{(const bf16*)(ws + WS_YAB), (const bf16*)(ws + WS_PA), T, 1024, 1024, 2048}; pg8::StaticOrder S; S.init(T, 1024, F.G, F.bx);
            pg8::EpiMerge<true> E{(const bf16*)(ws + WS_SG), (const bf16*)nullptr, (bf16*)(ws + WS_M1)};
            pg8::gemm_phase<pg8::EpiMerge<true>, pg8::StaticOrder, true, true>(ring, g, S, E); }
        {   pg8::Gemm g{(const bf16*)(ws + WS_YAB) + 1024, (const bf16*)(ws + WS_PBT), T, 1024, 1024, 2048}; pg8::StaticOrder S; S.init(T, 1024, F.G, F.bx);
            pg8::EpiMerge<false> E{(const bf16*)(ws + WS_SG), (const bf16*)(ws + WS_M1), (bf16*)(ws + WS_MG)};
            pg8::gemm_phase<pg8::EpiMerge<false>, pg8::StaticOrder, true, true>(ring, g, S, E); }
        xcd_barrier(bar);
        {   pg8::Gemm g{(const bf16*)(ws + WS_MG), (const bf16*)(ws + WS_POUT), T, 1024, 1024, 1024}; pg8::StaticOrder S; S.init(T, 1024, F.G, F.bx);
            pg8::EpiResid E{F.h};
            pg8::gemm_phase<pg8::EpiResid, pg8::StaticOrder, true, true>(ring, g, S, E); }
        xcd_barrier(bar);
        {   phase_ids(F); const int gw = F.bx * NWAVES + F.wave, NGW = F.G * NWAVES; const float* g2 = args.in[3] + (size_t)layer * 1024;
            for (int m = gw; m < T; m += NGW) norm_row_n2(F.h + (size_t)m * D, g2, (bf16*)(ws + WS_N2) + (size_t)m * D, F.lane); }
        xcd_barrier(bar);
        {   pg8::Gemm g{(const bf16*)(ws + WS_N2), (const bf16*)(ws + WS_WQG), T, 3072, 1024, 1024}; pg8::StaticOrder S; S.init(T, 3072, F.G, F.bx);
            pg8::EpiQG E{(bf16*)(ws + WS_Q), (const bf16*)(ws + WS_PW), F.h};
            pg8::gemm_phase<pg8::EpiQG, pg8::StaticOrder, true, true>(ring, g, S, E); }
        xcd_barrier(bar);
        for (int u = F.bx; u < T / 128; u += F.G) peer_unit(F, args, layer, u, layer == DEPTH - 1);
        if (layer + 1 < DEPTH) xcd_barrier(bar);
    }
}

extern "C" void kernel_launch(void* const* d_in, const int* in_sizes, int n_in, void* d_out, int out_size, void* d_ws, size_t ws_size, hipStream_t stream) {
    static int grid = 0;
    if (grid == 0) {
        if (n_in != 32 || out_size != T * D || ws_size < WS_END) { fprintf(stderr, "kernel_launch: unexpected sizes n_in %d out %d ws %zu (need %zu); nothing launched\n", n_in, out_size, ws_size, (size_t)WS_END); grid = -1; return; }
        int dev = 0, cus = 0, per_cu = 0;
        if (hipGetDevice(&dev) != hipSuccess || hipDeviceGetAttribute(&cus, hipDeviceAttributeMultiprocessorCount, dev) != hipSuccess) { grid = -1; return; }
        if (hipFuncSetAttribute((const void*)trunk_fwd, hipFuncAttributeMaxDynamicSharedMemorySize, LDS_BYTES) != hipSuccess) { fprintf(stderr, "kernel_launch: hipFuncSetAttribute failed\n"); grid = -1; return; }
        if (hipOccupancyMaxActiveBlocksPerMultiprocessor(&per_cu, (const void*)trunk_fwd, NWAVES * 64, LDS_BYTES) != hipSuccess || per_cu < 1)
            fprintf(stderr, "kernel_launch: note: occupancy query reports %d workgroups per CU\n", per_cu);
        (void)hipGetLastError();
        grid = cus;
    }
    if (grid < 0) return;
    (void)hipMemsetAsync((char*)d_ws + WS_CTL, 0, ZERO_BYTES, stream);
    (void)hipMemsetAsync((char*)d_ws + WIN_ZERO_OFF, 0, WIN_ZERO_BYTES, stream);
    Args a{};
    for (int i = 0; i < 32; ++i) a.in[i] = (const float*)d_in[i];
    a.out = (float*)d_out; a.ws = (unsigned char*)d_ws;
    hipLaunchKernelGGL(trunk_fwd, dim3(grid), dim3(NWAVES * 64), LDS_BYTES, stream, a);
    const hipError_t le = hipPeekAtLastError();
    if (le != hipSuccess) fprintf(stderr, "kernel_launch: launch failed: %s\n", hipGetErrorName(le));
}
```

```cpp
#include <hip/hip_runtime.h>
#include <cstdio>
#include <cstdint>
namespace pg8 {
#define PG8_LAS __attribute__((address_space(3)))
typedef unsigned short bf16_t;
typedef short bf16x8 __attribute__((ext_vector_type(8)));
typedef float f32x4 __attribute__((ext_vector_type(4)));
typedef unsigned u32x4 __attribute__((ext_vector_type(4)));
constexpr int BM = 256, BK = 64, HALF = 128, HTB = HALF * BK * 2  , STAGE_BYTES = 8 * HTB, NXCD = 8, WGM = 8;

__host__ __device__ __forceinline__ int lds_byte(int r, int c) { const int st = (r >> 4) * 2 + (c >> 5), rr = r & 15, cc = c & 31, ob = rr * 64 + cc * 2; return st * 1024 + (ob ^ (((ob >> 9) & 1) << 5)); }
__host__ __device__ __forceinline__ void stage_rc(int b, int& R, int& C) { const int st = b / 1024, sb = b % 1024, swz = sb ^ (((sb >> 9) & 1) << 5); R = (st >> 1) * 16 + swz / 64; C = (st & 1) * 32 + (swz % 64) / 2; }
__host__ __device__ __forceinline__ int perm32(int rho) { const int n = rho >> 4, i = rho & 15; return 8 * (i >> 2) + 4 * n + (i & 3); }

struct Unit { int pm, pn; };
struct Gemm { const bf16_t* A; const bf16_t* Bt; int M, N, K, lda; };

struct StaticOrder {
    int nM, nN, nwg, G, c;
    __host__ __device__ void init(int M, int N, int G_, int c_) { nM = M / BM; nN = N / BM; nwg = nM * nN; G = G_; c = c_; }
    __host__ __device__ bool next(int i, Unit& u) const {
        const long L = (long)i * G + c; if (L >= nwg) return false;
        int wgid = (int)L; { const int q = nwg / NXCD, r = nwg % NXCD, xcd = wgid % NXCD, off = wgid / NXCD; wgid = (xcd < r ? xcd * (q + 1) : r * (q + 1) + (xcd - r) * q) + off; }
        const int nig = WGM * nN, gid = wgid / nig, fm = gid * WGM, gsz = (nM - fm) < WGM ? (nM - fm) : WGM;
        u.pm = fm + ((wgid % nig) % gsz); u.pn = (wgid % nig) / gsz; return true;
    }
    __device__ __forceinline__ void a_ready(const Unit&) const {}
    __device__ __forceinline__ void done(const Unit&) const {}
};
struct PanelOrder {
    int first, stride, nM, nN;
    __host__ __device__ bool next(int i, Unit& u) const { const int p = first + (i / nN) * stride; if (p >= nM) return false; u.pm = p; u.pn = i % nN; return true; }
    __device__ __forceinline__ void a_ready(const Unit&) const {}
    __device__ __forceinline__ void done(const Unit&) const {}
};
__device__ __forceinline__ unsigned cvt_pk_bf16(float lo, float hi) { unsigned r; asm volatile("v_cvt_pk_bf16_f32 %0, %1, %2" : "=v"(r) : "v"(lo), "v"(hi)); return r; }

__device__ __forceinline__ float fsig(float x) { return __builtin_amdgcn_rcpf(1.f + __builtin_amdgcn_exp2f(-1.44269504f * x)); }
__device__ __forceinline__ float fgelu(float x) { return x * fsig(1.5957691216f * (x + 0.044715f * x * x * x)); }
__device__ __forceinline__ float bflo(unsigned w) { return __builtin_bit_cast(float, w << 16); }
__device__ __forceinline__ float bfhi(unsigned w) { return __builtin_bit_cast(float, w & 0xffff0000u); }
__device__ __forceinline__ void unpk8(const u32x4 w, f32x4& a, f32x4& b) { a = (f32x4){bflo(w.x), bfhi(w.x), bflo(w.y), bfhi(w.y)}; b = (f32x4){bflo(w.z), bfhi(w.z), bflo(w.w), bfhi(w.w)}; }
__device__ __forceinline__ u32x4 pk8(const f32x4 a, const f32x4 b) { u32x4 w; w.x = cvt_pk_bf16(a[0], a[1]); w.y = cvt_pk_bf16(a[2], a[3]); w.z = cvt_pk_bf16(b[0], b[1]); w.w = cvt_pk_bf16(b[2], b[3]); return w; }
__device__ __forceinline__ f32x4 act4(f32x4 v, int kind) {
    if (kind == 1) { v = (f32x4){fgelu(v[0]), fgelu(v[1]), fgelu(v[2]), fgelu(v[3])}; }
    else if (kind == 2) { v = (f32x4){fsig(v[0]), fsig(v[1]), fsig(v[2]), fsig(v[3])}; }
    else if (kind == 3) { v = (f32x4){2.f * fsig(2.f * v[0]) - 1.f, 2.f * fsig(2.f * v[1]) - 1.f, 2.f * fsig(2.f * v[2]) - 1.f, 2.f * fsig(2.f * v[3]) - 1.f}; }
    return v;
}
#define EPI_ROWS_BEGIN _Pragma("unroll") for (int ai = 0; ai < 2; ++ai) _Pragma("unroll") for (int m = 0; m < 4; ++m) { const size_t row = (size_t)(row0 + ai * HALF + m * 16);
#define EPI_ROWS_END }

struct EpiZ {
    static constexpr bool PERM = true, AFTER_DRAIN = false;
    bf16_t *zrkv, *zl, *guv, *sg, *vf;
    __device__ __forceinline__ void operator()(const f32x4 (&acc)[2][2][4][2], const Unit& u, int wr, int wc, int fr, int fq) const {
        const int pn = u.pn, row0 = u.pm * BM + wr * 64 + fr;
        bf16_t* dst; int ld, colt, k0, k1;
        if (pn < 12)       { dst = zrkv; ld = 3072; colt = pn * 256;        k0 = 0; k1 = 0; }
        else if (pn == 12) { dst = zl;   ld = 512;  colt = 0;               k0 = (wc < 2) ? 3 : 0; k1 = 2; }
        else if (pn == 13) { dst = zl;   ld = 512;  colt = 256;             k0 = 0; k1 = 0; }
        else if (pn < 22)  { dst = guv;  ld = 2048; colt = (pn - 14) * 256; k0 = 1; k1 = 1; }
        else               { dst = sg;   ld = 2048; colt = (pn - 22) * 256; k0 = 2; k1 = 2; }
        const int col0 = colt + wc * 32 + 8 * fq;
        const bool dovf = (vf != nullptr) && pn >= 8 && pn < 12;
        const int vcol0 = (pn - 8) * 256 + wc * 32 + 8 * fq;
        EPI_ROWS_BEGIN
            bf16_t* rowp = dst + row * ld + col0;
#pragma unroll
            for (int bj = 0; bj < 2; ++bj) { const int kind = bj ? k1 : k0;
                const u32x4 w = pk8(act4(acc[ai][bj][m][0], kind), act4(acc[ai][bj][m][1], kind));
                *(u32x4*)(rowp + bj * HALF) = w;
                if (dovf) *(u32x4*)(vf + row * 1024 + vcol0 + bj * HALF) = w; }
        EPI_ROWS_END
    }
};
struct EpiLora {
    static constexpr bool PERM = true, AFTER_DRAIN = false;
    bf16_t* ew; size_t stride; const float *w0, *a0;
    __device__ __forceinline__ void operator()(const f32x4 (&acc)[2][2][4][2], const Unit& u, int wr, int wc, int fr, int fq) const {
        const int sel = u.pn >> 2, row0 = u.pm * BM + wr * 64 + fr, col0 = (u.pn & 3) * 256 + wc * 32 + 8 * fq;
        bf16_t* dst = ew + (size_t)sel * stride;
        const float* bp = sel == 0 ? w0 : a0;
        f32x4 bv[2][2];
#pragma unroll
        for (int bj = 0; bj < 2; ++bj)
#pragma unroll
            for (int n = 0; n < 2; ++n) bv[bj][n] = (sel < 2) ? *(const f32x4*)(bp + col0 + bj * HALF + 4 * n) : (f32x4){0.f, 0.f, 0.f, 0.f};
        EPI_ROWS_BEGIN
            bf16_t* rowp = dst + row * 1024 + col0;
#pragma unroll
            for (int bj = 0; bj < 2; ++bj) { f32x4 v0 = acc[ai][bj][m][0] + bv[bj][0], v1 = acc[ai][bj][m][1] + bv[bj][1];
                if (sel < 2) { v0 = act4(v0, 2); v1 = act4(v1, 2); }
                if (sel == 0) { v0 = v0 * 0.60653066f; v1 = v1 * 0.60653066f; }
                *(u32x4*)(rowp + bj * HALF) = pk8(v0, v1); }
        EPI_ROWS_END
    }
};
struct EpiMv {
    static constexpr bool PERM = true, AFTER_DRAIN = false;
    bf16_t* zrkv; const bf16_t* vf; const float* v0b;
    __device__ __forceinline__ void operator()(const f32x4 (&acc)[2][2][4][2], const Unit& u, int wr, int wc, int fr, int fq) const {
        const int row0 = u.pm * BM + wr * 64 + fr, col0 = u.pn * 256 + wc * 32 + 8 * fq;
        f32x4 bv[2][2];
#pragma unroll
        for (int bj = 0; bj < 2; ++bj)
#pragma unroll
            for (int n = 0; n < 2; ++n) bv[bj][n] = *(const f32x4*)(v0b + col0 + bj * HALF + 4 * n);
        EPI_ROWS_BEGIN
#pragma unroll
            for (int bj = 0; bj < 2; ++bj) { bf16_t* zp = zrkv + row * 3072 + 2048 + col0 + bj * HALF;
                f32x4 z0, z1, f0, f1; unpk8(*(const u32x4*)zp, z0, z1); unpk8(*(const u32x4*)(vf + row * 1024 + col0 + bj * HALF), f0, f1);
                const f32x4 m0 = act4(acc[ai][bj][m][0] + bv[bj][0], 2), m1 = act4(acc[ai][bj][m][1] + bv[bj][1], 2);
                *(u32x4*)zp = pk8(z0 + (f0 - z0) * m0, z1 + (f1 - z1) * m1); }
        EPI_ROWS_END
    }
};
struct EpiPlain {
    static constexpr bool PERM = true, AFTER_DRAIN = false;
    bf16_t* o; int ld;
    __device__ __forceinline__ void operator()(const f32x4 (&acc)[2][2][4][2], const Unit& u, int wr, int wc, int fr, int fq) const {
        const int row0 = u.pm * BM + wr * 64 + fr, col0 = u.pn * 256 + wc * 32 + 8 * fq;
        EPI_ROWS_BEGIN
#pragma unroll
            for (int bj = 0; bj < 2; ++bj) *(u32x4*)(o + row * ld + col0 + bj * HALF) = pk8(acc[ai][bj][m][0], acc[ai][bj][m][1]);
        EPI_ROWS_END
    }
};
template <bool SECOND> struct EpiMerge {
    static constexpr bool PERM = true, AFTER_DRAIN = false;
    const bf16_t* sg; bf16_t* m2; bf16_t* o;
    __device__ __forceinline__ void operator()(const f32x4 (&acc)[2][2][4][2], const Unit& u, int wr, int wc, int fr, int fq) const {
        const int row0 = u.pm * BM + wr * 64 + fr, col0 = u.pn * 256 + wc * 32 + 8 * fq;
        EPI_ROWS_BEGIN
#pragma unroll
            for (int bj = 0; bj < 2; ++bj) { const int c = col0 + bj * HALF;
                f32x4 g0, g1; unpk8(*(const u32x4*)(sg + row * 2048 + (SECOND ? 0 : 1024) + c), g0, g1);
                f32x4 v0 = g0 * acc[ai][bj][m][0], v1 = g1 * acc[ai][bj][m][1];
                if (SECOND) { f32x4 p0, p1; unpk8(*(const u32x4*)(m2 + row * 2048 + c), p0, p1); v0 = v0 + p0; v1 = v1 + p1; *(u32x4*)(o + row * 1024 + c) = pk8(v0, v1); }
                else *(u32x4*)(m2 + row * 2048 + c) = pk8(v0, v1); }
        EPI_ROWS_END
    }
};
struct EpiResid {
    static constexpr bool PERM = false, AFTER_DRAIN = false;
    float* h;
    __device__ __forceinline__ void operator()(const f32x4 (&acc)[2][2][4][2], const Unit& u, int wr, int wc, int fr, int fq) const {
        const int row0 = u.pm * BM + wr * 64 + fr, col0 = u.pn * 256 + wc * 32 + 4 * fq;
        EPI_ROWS_BEGIN
            float* rowp = h + row * 1024 + col0;
#pragma unroll
            for (int bj = 0; bj < 2; ++bj)
#pragma unroll
                for (int n = 0; n < 2; ++n) { f32x4* p = (f32x4*)(rowp + bj * HALF + n * 16); *p = *p + acc[ai][bj][m][n]; }
        EPI_ROWS_END
    }
};
struct EpiQG {
    static constexpr bool PERM = true, AFTER_DRAIN = false;
    bf16_t* q; const bf16_t* pw; float* h;
    __device__ __forceinline__ void operator()(const f32x4 (&acc)[2][2][4][2], const Unit& u, int wr, int wc, int fr, int fq) const {
        const int row0 = u.pm * BM + wr * 64 + fr;
        if (u.pn < 8) { const int col0 = u.pn * 256 + wc * 32 + 8 * fq;
            EPI_ROWS_BEGIN
#pragma unroll
                for (int bj = 0; bj < 2; ++bj) *(u32x4*)(q + row * 2048 + col0 + bj * HALF) = pk8(acc[ai][bj][m][0], acc[ai][bj][m][1]);
            EPI_ROWS_END
        } else { const int col0 = (u.pn - 8) * 256 + wc * 32 + 8 * fq;
            EPI_ROWS_BEGIN
#pragma unroll
                for (int bj = 0; bj < 2; ++bj) { const int c = col0 + bj * HALF;
                    f32x4 p0, p1; unpk8(*(const u32x4*)(pw + row * 1024 + c), p0, p1);
                    f32x4* hp = (f32x4*)(h + row * 1024 + c);
                    hp[0] = hp[0] + p0 * act4(acc[ai][bj][m][0], 2); hp[1] = hp[1] + p1 * act4(acc[ai][bj][m][1], 2); }
            EPI_ROWS_END
        }
    }
};
template <class Epi, class Sched, bool ALIGN_EPI = false, bool SP2 = false>
__device__ __forceinline__ void gemm_phase(PG8_LAS unsigned char* lds, const Gemm g, const Sched& S, const Epi& E, const int wave0) {
    int tidq; asm volatile("v_mbcnt_lo_u32_b32 %0, -1, 0\n\tv_mbcnt_hi_u32_b32 %0, -1, %0" : "=v"(tidq)); tidq += wave0 * 64;
    const int tid = tidq, wid = __builtin_amdgcn_readfirstlane(tid >> 6), lane = tid & 63, wr = wid >> 2, wc = wid & 3, fr = lane & 15, fq = lane >> 4;
    int Kq = g.K, ldaq = g.lda; const bf16_t* gA = g.A; const bf16_t* gB = g.Bt; asm volatile("" : "+s"(Kq), "+s"(ldaq), "+s"(gA), "+s"(gB));
    const int K = Kq, nt = K / BK;
    unsigned voffA[2], voffB[2];
#pragma unroll
    for (int i = 0; i < 2; ++i) { int R, C; stage_rc(tid * 16 + i * 8192, R, C); const int Rb = Epi::PERM ? ((R & ~31) + perm32(R & 31)) : R;
        voffA[i] = (unsigned)(R * ldaq + C) * 2u; voffB[i] = (unsigned)(Rb * K + C) * 2u; }
    const size_t kstep = (size_t)(BK * 2);
    const size_t hstepA = (size_t)HALF * ldaq * 2, hstepB = (size_t)HALF * K * 2;
    const size_t tstepA = 2 * hstepA, tstepB = 2 * hstepB;
    const unsigned ldsw = (unsigned)wid * 1024u;
    const int aoff = lds_byte(wr * 64 + fr, fq * 8), boff = lds_byte(wc * 32 + fr, fq * 8);
#define PG8_SA(b, h) (((b) * 2 + (h)) * HTB)
#define PG8_SB(b, h) ((4 + (b) * 2 + (h)) * HTB)
#define PG8_STAGE(bufoff, gbase, voff) do { _Pragma("unroll") for (int _i = 0; _i < 2; ++_i) \
        __builtin_amdgcn_global_load_lds((const unsigned*)((const char*)(gbase) + (voff)[_i]), (PG8_LAS unsigned*)(lds + (bufoff) + ldsw + _i * 8192), 16, 0, 0); } while (0)
#define PG8_LDA(dst, b, h) do { _Pragma("unroll") for (int m = 0; m < 4; ++m) _Pragma("unroll") for (int k = 0; k < 2; ++k) dst[m][k] = *(const PG8_LAS bf16x8*)(lds + PG8_SA(b, h) + aoff + m * 2048 + k * 1024); } while (0)
#define PG8_LDB(dst, b, h) do { _Pragma("unroll") for (int n = 0; n < 2; ++n) _Pragma("unroll") for (int k = 0; k < 2; ++k) dst[n][k] = *(const PG8_LAS bf16x8*)(lds + PG8_SB(b, h) + boff + n * 2048 + k * 1024); } while (0)
#define PG8_MMA(ai, bj, At, Bt) do { __builtin_amdgcn_s_setprio(1); _Pragma("unroll") for (int m = 0; m < 4; ++m) _Pragma("unroll") for (int n = 0; n < 2; ++n) _Pragma("unroll") for (int k = 0; k < 2; ++k) \
        acc[ai][bj][m][n] = __builtin_amdgcn_mfma_f32_16x16x32_bf16(Bt[n][k], At[m][k], acc[ai][bj][m][n], 0, 0, 0); __builtin_amdgcn_s_setprio(0); } while (0)
#define PG8_WAIT_V(n) asm volatile("s_waitcnt vmcnt(" #n ")" ::: "memory")
#define PG8_WAIT_L(n) asm volatile("s_waitcnt lgkmcnt(" #n ")" ::: "memory")
#define PG8_BAR __builtin_amdgcn_s_barrier()
#define PG8_SCHED __builtin_amdgcn_sched_barrier(0)
    Unit cur, nxt; int ui = 0;
    if (!S.next(0, cur)) return;
    f32x4 acc[2][2][4][2];
#pragma unroll
    for (int a = 0; a < 2; ++a)
#pragma unroll
        for (int b = 0; b < 2; ++b)
#pragma unroll
            for (int m = 0; m < 4; ++m)
#pragma unroll
                for (int n = 0; n < 2; ++n) acc[a][b][m][n] = (f32x4){0.f, 0.f, 0.f, 0.f};
    bf16x8 At[4][2], B0[2][2], B1[2][2];
    const char* cA = (const char*)gA + (size_t)cur.pm * tstepA; const char* cB = (const char*)gB + (size_t)cur.pn * tstepB;
    S.a_ready(cur);
    if constexpr (SP2) {
        PG8_STAGE(PG8_SB(0, 0), cB, voffB); PG8_STAGE(PG8_SB(0, 1), cB + hstepB, voffB); PG8_STAGE(PG8_SA(0, 0), cA, voffA); PG8_STAGE(PG8_SA(0, 1), cA + hstepA, voffA);
        if (wr == 1) PG8_BAR;
        PG8_WAIT_V(2); PG8_BAR;
        PG8_STAGE(PG8_SB(1, 0), cB + kstep, voffB); PG8_STAGE(PG8_SA(1, 0), cA + kstep, voffA); PG8_STAGE(PG8_SB(1, 1), cB + hstepB + kstep, voffB);
        PG8_WAIT_V(6); PG8_BAR;
    } else {
        PG8_STAGE(PG8_SB(0, 0), cB, voffB); PG8_STAGE(PG8_SA(0, 0), cA, voffA); PG8_STAGE(PG8_SB(0, 1), cB + hstepB, voffB); PG8_STAGE(PG8_SA(0, 1), cA + hstepA, voffA);
        if (wr == 1) PG8_BAR;
        PG8_WAIT_V(4); PG8_BAR;
        PG8_STAGE(PG8_SB(1, 0), cB + kstep, voffB); PG8_STAGE(PG8_SA(1, 0), cA + kstep, voffA); PG8_STAGE(PG8_SB(1, 1), cB + hstepB + kstep, voffB);
        PG8_WAIT_V(6); PG8_BAR;
    }
    for (;;) {
        const bool has_next = S.next(ui + 1, nxt);
        const char* nA = has_next ? (const char*)gA + (size_t)nxt.pm * tstepA : cA; const char* nB = has_next ? (const char*)gB + (size_t)nxt.pn * tstepB : cB;
        for (int t = 0; t < nt; t += 2) {
            const bool last = (t == nt - 2);
            const char* a1 = cA + (size_t)(t + 1) * kstep;
            const char* a2 = last ? nA : cA + (size_t)(t + 2) * kstep; const char* b2 = last ? nB : cB + (size_t)(t + 2) * kstep;
            const char* a3 = a2 + kstep; const char* b3 = b2 + kstep;
            if (last && has_next) S.a_ready(nxt);
            if constexpr (SP2) {
            PG8_LDB(B0, 0, 0); PG8_LDB(B1, 0, 1); PG8_SCHED; PG8_LDA(At, 0, 0); PG8_STAGE(PG8_SA(1, 1), a1 + hstepA, voffA);
            PG8_WAIT_V(8); PG8_WAIT_L(0); PG8_BAR; PG8_MMA(0, 0, At, B0); PG8_MMA(0, 1, At, B1); PG8_BAR; PG8_SCHED;
            PG8_LDA(At, 0, 1); PG8_STAGE(PG8_SB(0, 0), b2, voffB); PG8_STAGE(PG8_SB(0, 1), b2 + hstepB, voffB); PG8_STAGE(PG8_SA(0, 0), a2, voffA);
            PG8_WAIT_V(8); PG8_WAIT_L(0); PG8_BAR; PG8_MMA(1, 0, At, B0); PG8_MMA(1, 1, At, B1); PG8_BAR; PG8_SCHED;
            PG8_LDB(B0, 1, 0); PG8_LDB(B1, 1, 1); PG8_SCHED; PG8_LDA(At, 1, 0); PG8_STAGE(PG8_SA(0, 1), a2 + hstepA, voffA);
            PG8_WAIT_V(8); PG8_WAIT_L(0); PG8_BAR; PG8_MMA(0, 0, At, B0); PG8_MMA(0, 1, At, B1); PG8_BAR; PG8_SCHED;
            PG8_LDA(At, 1, 1); PG8_STAGE(PG8_SB(1, 0), b3, voffB); PG8_STAGE(PG8_SB(1, 1), b3 + hstepB, voffB); PG8_STAGE(PG8_SA(1, 0), a3, voffA);
            PG8_WAIT_V(8); PG8_WAIT_L(0); PG8_BAR; PG8_MMA(1, 0, At, B0); PG8_MMA(1, 1, At, B1); PG8_BAR; PG8_SCHED;
            } else {
            PG8_LDB(B0, 0, 0); PG8_SCHED; PG8_LDA(At, 0, 0); PG8_STAGE(PG8_SA(1, 1), a1 + hstepA, voffA);
            PG8_WAIT_L(8); PG8_BAR; PG8_WAIT_L(0); PG8_MMA(0, 0, At, B0); PG8_BAR; PG8_SCHED;
            PG8_LDB(B1, 0, 1); PG8_STAGE(PG8_SB(0, 0), b2, voffB);
            PG8_BAR; PG8_WAIT_L(0); PG8_MMA(0, 1, At, B1); PG8_BAR;
            PG8_LDA(At, 0, 1); PG8_STAGE(PG8_SA(0, 0), a2, voffA);
            PG8_BAR; PG8_WAIT_L(0); PG8_MMA(1, 0, At, B0); PG8_BAR; PG8_SCHED;
            PG8_STAGE(PG8_SB(0, 1), b2 + hstepB, voffB);
            PG8_WAIT_V(6); PG8_BAR; PG8_MMA(1, 1, At, B1); PG8_BAR;
            PG8_LDB(B0, 1, 0); PG8_SCHED; PG8_LDA(At, 1, 0); PG8_STAGE(PG8_SA(0, 1), a2 + hstepA, voffA);
            PG8_WAIT_L(8); PG8_BAR; PG8_WAIT_L(0); PG8_MMA(0, 0, At, B0); PG8_BAR; PG8_SCHED;
            PG8_LDB(B1, 1, 1); PG8_STAGE(PG8_SB(1, 0), b3, voffB);
            PG8_BAR; PG8_WAIT_L(0); PG8_MMA(0, 1, At, B1); PG8_BAR;
            PG8_LDA(At, 1, 1); PG8_STAGE(PG8_SA(1, 0), a3, voffA);
            PG8_BAR; PG8_WAIT_L(0); PG8_MMA(1, 0, At, B0); PG8_BAR; PG8_SCHED;
            PG8_STAGE(PG8_SB(1, 1), b3 + hstepB, voffB);
            PG8_WAIT_V(6); PG8_BAR; PG8_MMA(1, 1, At, B1); PG8_BAR;
            }
        }
        if constexpr (ALIGN_EPI) { if (wr == 0) PG8_BAR; }
        if constexpr (!Epi::AFTER_DRAIN) { E(acc, cur, wr, wc, fr, fq); S.done(cur); }
        if (!has_next) break;
#pragma unroll
        for (int a = 0; a < 2; ++a)
#pragma unroll
            for (int b = 0; b < 2; ++b)
#pragma unroll
                for (int m = 0; m < 4; ++m)
#pragma unroll
                    for (int n = 0; n < 2; ++n) acc[a][b][m][n] = (f32x4){0.f, 0.f, 0.f, 0.f};
        cur = nxt; cA = nA; cB = nB; ++ui;
        if constexpr (ALIGN_EPI) { if (wr == 1) PG8_BAR; }
    }
    PG8_WAIT_V(0);
    if constexpr (!ALIGN_EPI) { if (wr == 0) PG8_BAR; }
    PG8_BAR;
    if constexpr (Epi::AFTER_DRAIN) { E.fused(acc, cur, wr, wc, fr, fq, lds, wid, lane); S.done(cur); }
#undef PG8_SA
#undef PG8_SB
#undef PG8_STAGE
#undef PG8_LDA
#undef PG8_LDB
#undef PG8_MMA
#undef PG8_WAIT_V
#undef PG8_WAIT_L
#undef PG8_BAR
#undef PG8_SCHED
}
}

constexpr int NB = 8, SEQ = 4096, T = NB * SEQ, D = 1024, DEPTH = 4, NZ = 7680, NWAVES = 8;
constexpr int CIN = 7424;
constexpr size_t MiB = 1u << 20;
constexpr size_t WS_CTL = 0, WS_LORA = 1 * MiB, WS_MV = 7 * MiB, ZERO_BYTES = 9 * MiB;
constexpr size_t LORA_BYTES = 3072 * 256 * 2, MV_BYTES = 1024 * 256 * 2;
constexpr size_t WS_WIN = 10 * MiB;
constexpr size_t WS_DB = 40 * MiB, DB_SET = 62 * MiB;
constexpr size_t DB_PA = 0, DB_PBT = 2 * MiB, DB_POUT = 4 * MiB, DB_WQG = 6 * MiB, DB_KEYS = 12 * MiB, DB_GMW = 12 * MiB + 512 * 1024, DB_PLEW = 13 * MiB, DB_U = 14 * MiB, DB_V = 30 * MiB, DB_PB = 46 * MiB;
constexpr size_t WS_VF = 164 * MiB, WS_PW = 228 * MiB, WS_NX = 292 * MiB, WS_ZRKV = 420 * MiB, WS_ZL = 612 * MiB, WS_GUV = 644 * MiB, WS_SG = 772 * MiB;
constexpr size_t WS_EW = 900 * MiB, WS_AR = 964 * MiB, WS_G = 1028 * MiB, WS_END = 1092 * MiB;
constexpr size_t WS_YAB = WS_NX, WS_Q = WS_ZRKV, WS_SEL = WS_ZRKV + 128 * MiB, WS_MG = WS_AR, WS_N2 = WS_G;
constexpr size_t WIN_ZERO_OFF = WS_WIN + (size_t)3328 * 2048 * 2, WIN_ZERO_BYTES = (size_t)256 * 2048 * 2;
constexpr int CW_BAR = 4096;
constexpr int RING_BYTES = 131072, LDSCTL_OFF = RING_BYTES, MISC_OFF = LDSCTL_OFF + 320, LDS_BYTES = 147456;

#define LAS __attribute__((address_space(3)))
typedef unsigned short bf16;
typedef unsigned v4u __attribute__((ext_vector_type(4)));
typedef unsigned v2u __attribute__((ext_vector_type(2)));
typedef float f32x4 __attribute__((ext_vector_type(4)));
typedef float f32x2 __attribute__((ext_vector_type(2)));
typedef short bf16x8 __attribute__((ext_vector_type(8)));
using pg8::fsig; using pg8::fgelu; using pg8::bflo; using pg8::bfhi; using pg8::unpk8; using pg8::pk8; using pg8::cvt_pk_bf16;

#define XB_TMO      128
#define XB_XCNT(j)  (256  + 64 * (j))
#define XB_XSUB(j)  (1280 + 64 * (j))
#define XB_XGEN(j)  (2304 + 64 * (j))
#define XB_TOP      3328
#define XB_TOPGEN   3392
#define XCD_BAR_WORDS 3456
#define XB_SPIN_CAP (1u << 22)

__device__ __forceinline__ unsigned xb_ld(unsigned* p)              { return __hip_atomic_load(p, __ATOMIC_RELAXED, __HIP_MEMORY_SCOPE_AGENT); }
__device__ __forceinline__ unsigned xb_add(unsigned* p, unsigned v) { return __hip_atomic_fetch_add(p, v, __ATOMIC_RELAXED, __HIP_MEMORY_SCOPE_AGENT); }
__device__ __forceinline__ unsigned xb_xcc_id() { return (unsigned)__builtin_amdgcn_s_getreg((3 << 11) | 20) & 0xFu; }
#define XB_SPIN(cond, bar) do { unsigned _sp = 0; while (cond) { __builtin_amdgcn_s_sleep(1); \
    if ((++_sp & 255u) == 0u) { if (xb_ld(&(bar)[XB_TMO])) break; if (_sp > XB_SPIN_CAP) { atomicAdd(&(bar)[XB_TMO], 1u); break; } } } } while (0)

struct XcdBarrier { unsigned* bar; unsigned x; volatile LAS unsigned* st; };

__device__ __forceinline__ XcdBarrier xcd_barrier_post(unsigned* bar, volatile LAS unsigned* st) {
    XcdBarrier b; b.bar = bar; b.x = xb_xcc_id(); b.st = st;
    if (threadIdx.x == 0) (void)xb_add(&bar[XB_XCNT(b.x)], 1u);
    return b;
}
__device__ __forceinline__ void xcd_barrier_complete(unsigned* bar, unsigned x, unsigned& nloc, unsigned& nx) {
    const unsigned G = gridDim.x * gridDim.y * gridDim.z;
    unsigned sum, cnt, mine, sp = 0u;
    for (;;) {
        sum = 0u; cnt = 0u; mine = 0u;
#pragma unroll
        for (unsigned j = 0; j < 16; ++j) { const unsigned c = xb_ld(&bar[XB_XCNT(j)]); sum += c; cnt += (c > 0u) ? 1u : 0u; mine = (j == x) ? c : mine; }
        if (sum == G) break;
        __builtin_amdgcn_s_sleep(1);
        if ((++sp & 255u) == 0u) { if (xb_ld(&bar[XB_TMO])) break; if (sp > XB_SPIN_CAP) { atomicAdd(&bar[XB_TMO], 1u); break; } }
    }
    nloc = mine > 0u ? mine : 1u; nx = cnt > 0u ? cnt : 1u;
}
__device__ __forceinline__ int lane_id_now();
__device__ __forceinline__ void xcd_barrier(const XcdBarrier& b, const int wave0) {
    asm volatile("s_waitcnt vmcnt(0)" ::: "memory");
    __syncthreads();
    if (wave0 == 0 && lane_id_now() == 0) {
        unsigned* bar = b.bar;
        __builtin_amdgcn_s_waitcnt(0);
        unsigned nloc = b.st[0], nx = b.st[1];
        if (nloc == 0u) { xcd_barrier_complete(bar, b.x, nloc, nx); b.st[0] = nloc; b.st[1] = nx; }
        const unsigned old = xb_add(&bar[XB_XSUB(b.x)], 1u);
        const unsigned gen = old / nloc;
        if (old + 1u == (gen + 1u) * nloc) {
            __builtin_amdgcn_fence(__ATOMIC_RELEASE, "agent");
            asm volatile("s_waitcnt vmcnt(0)" ::: "memory");
            const unsigned og = xb_add(&bar[XB_TOP], 1u);
            const unsigned tg = og / nx;
            if (og + 1u == (tg + 1u) * nx) xb_add(&bar[XB_TOPGEN], 1u);
            else XB_SPIN(xb_ld(&bar[XB_TOPGEN]) == tg, bar);
            __builtin_amdgcn_fence(__ATOMIC_ACQUIRE, "agent");
            xb_add(&bar[XB_XGEN(b.x)], 1u);
            asm volatile("s_waitcnt vmcnt(0)" ::: "memory");
        } else {
            XB_SPIN(xb_ld(&bar[XB_XGEN(b.x)]) == gen, bar);
            __builtin_amdgcn_fence(__ATOMIC_ACQUIRE, "agent");
            asm volatile("s_waitcnt vmcnt(0)" ::: "memory");
        }
    }
    __syncthreads();
}

struct Args { const float* in[32]; float* out; unsigned char* ws; };
struct Frame {
    LAS unsigned char* lds;
    int tid, lane, wave, G, bx, wave0;
    unsigned char* ws; float* h;
};
__device__ __forceinline__ int lane_id_now() { int l; asm volatile("v_mbcnt_lo_u32_b32 %0, -1, 0\n\tv_mbcnt_hi_u32_b32 %0, -1, %0" : "=v"(l)); return l; }
__device__ __forceinline__ void phase_ids(Frame& F) { const int l = lane_id_now(); F.lane = l; F.wave = F.wave0; F.tid = F.wave0 * 64 + l; unsigned char* w = F.ws; asm volatile("" : "+s"(w)); F.ws = w; }
#define DPP_ADD(x, ctrl) ((x) + __builtin_bit_cast(float, __builtin_amdgcn_update_dpp(0, __builtin_bit_cast(int, (x)), (ctrl), 0xf, 0xf, false)))
__device__ __forceinline__ float sum8(float v) {
    v = DPP_ADD(v, 0xB1);
    v = DPP_ADD(v, 0x4E);
    v = DPP_ADD(v, 0x141);
    return v;
}
__device__ __forceinline__ float wave_sum(float v) {
    v = sum8(v);
    v = DPP_ADD(v, 0x140);
    const auto r = __builtin_amdgcn_permlane16_swap(__builtin_bit_cast(unsigned, v), __builtin_bit_cast(unsigned, v), false, false);
    v = __builtin_bit_cast(float, (unsigned)r[0]) + __builtin_bit_cast(float, (unsigned)r[1]);
    const auto q = __builtin_amdgcn_permlane32_swap(__builtin_bit_cast(unsigned, v), __builtin_bit_cast(unsigned, v), false, false);
    return __builtin_bit_cast(float, (unsigned)q[0]) + __builtin_bit_cast(float, (unsigned)q[1]);
}
__device__ __forceinline__ unsigned xor16_u(unsigned x, int lane) { const auto r = __builtin_amdgcn_permlane16_swap(x, x, false, false); return (lane & 16) ? (unsigned)r[0] : (unsigned)r[1]; }
__device__ __forceinline__ unsigned xor32_u(unsigned x, int lane) { const auto r = __builtin_amdgcn_permlane32_swap(x, x, false, false); return (lane & 32) ? (unsigned)r[0] : (unsigned)r[1]; }
__device__ __forceinline__ void tr_item(const float* W, int ldw, int ncols, bf16* WT, int ldt, int koff, int row_off, LAS float* scr, int item, int lane) {
    const int nblk = ncols / 32, kb = item / nblk, nb = item % nblk, k0 = 64 * kb, n0 = 32 * nb;
#pragma unroll 8
    for (int i = 0; i < 32; ++i) { const int kk = 2 * i + (lane >> 5); scr[kk * 33 + (lane & 31)] = W[(size_t)(k0 + kk) * ldw + n0 + (lane & 31)]; }
    asm volatile("s_waitcnt lgkmcnt(0)" ::: "memory");
    const int c = lane & 7;
#pragma unroll
    for (int j = 0; j < 4; ++j) { const int n = (lane >> 3) + 8 * j; const LAS float* s = scr + (8 * c) * 33 + n;
        v4u o; o.x = cvt_pk_bf16(s[0 * 33], s[1 * 33]); o.y = cvt_pk_bf16(s[2 * 33], s[3 * 33]); o.z = cvt_pk_bf16(s[4 * 33], s[5 * 33]); o.w = cvt_pk_bf16(s[6 * 33], s[7 * 33]);
        *(v4u*)(WT + (size_t)(row_off + n0 + n) * ldt + koff + k0 + 8 * c) = o; }
    asm volatile("s_waitcnt lgkmcnt(0)" ::: "memory");
}
__device__ __forceinline__ void cvt_chunk(const float* src, bf16* dst, size_t chunk, int lane) {
    const f32x4* s = (const f32x4*)(src + chunk * 512) + lane * 2; const f32x4 a = s[0], b = s[1];
    *(v4u*)(dst + chunk * 512 + lane * 8) = pk8(a, b);
}
__device__ __forceinline__ void cvt8_chunk(const float* src, unsigned char* dst, size_t chunk, int lane, float sc) {
    const f32x4* s = (const f32x4*)(src + chunk * 512) + lane * 2; const f32x4 a = s[0] * sc, b = s[1] * sc;
    int w0 = 0, w1 = 0;
    w0 = __builtin_amdgcn_cvt_pk_fp8_f32(a.x, a.y, w0, false); w0 = __builtin_amdgcn_cvt_pk_fp8_f32(a.z, a.w, w0, true);
    w1 = __builtin_amdgcn_cvt_pk_fp8_f32(b.x, b.y, w1, false); w1 = __builtin_amdgcn_cvt_pk_fp8_f32(b.z, b.w, w1, true);
    *(v2u*)(dst + chunk * 512 + lane * 8) = (v2u){(unsigned)w0, (unsigned)w1};
}
__device__ __forceinline__ void norm_row_nx(const float* hrow, float* hcopy, const float* g, bf16* NX, int t, int lane) {
    const f32x4* xr = (const f32x4*)hrow + lane; f32x4 v[4]; float s = 0.f;
#pragma unroll
    for (int j = 0; j < 4; ++j) { v[j] = xr[64 * j]; s += (v[j].x * v[j].x + v[j].y * v[j].y) + (v[j].z * v[j].z + v[j].w * v[j].w); }
    if (hcopy) {
#pragma unroll
        for (int j = 0; j < 4; ++j) ((f32x4*)hcopy)[lane + 64 * j] = v[j]; }
    const float rstd = 1.f / sqrtf(wave_sum(s) * (1.f / D) + 1e-6f);
    const int tt = t & (SEQ - 1);
#pragma unroll
    for (int j = 0; j < 4; ++j) { const f32x4 gv = ((const f32x4*)g)[lane + 64 * j]; const f32x4 o = v[j] * rstd * gv;
        v2u w; w.x = cvt_pk_bf16(o.x, o.y); w.y = cvt_pk_bf16(o.z, o.w);
        const int c = 4 * (lane + 64 * j);
        *(v2u*)(NX + (size_t)t * 2048 + c) = w;
        if (tt != SEQ - 1) *(v2u*)(NX + (size_t)(t + 1) * 2048 + 1024 + c) = w;
        if (tt == 0) *(v2u*)(NX + (size_t)t * 2048 + 1024 + c) = (v2u){0u, 0u}; }
}
__device__ __forceinline__ void norm_row_n2(const float* hrow, const float* g, bf16* N2row, int lane) {
    const f32x4* xr = (const f32x4*)hrow + lane; f32x4 v[4]; float s = 0.f;
#pragma unroll
    for (int j = 0; j < 4; ++j) { v[j] = xr[64 * j]; s += (v[j].x * v[j].x + v[j].y * v[j].y) + (v[j].z * v[j].z + v[j].w * v[j].w); }
    const float rstd = 1.f / sqrtf(wave_sum(s) * (1.f / D) + 1e-6f);
#pragma unroll
    for (int j = 0; j < 4; ++j) { const f32x4 gv = ((const f32x4*)g)[lane + 64 * j]; const f32x4 o = v[j] * rstd * gv;
        v2u w; w.x = cvt_pk_bf16(o.x, o.y); w.y = cvt_pk_bf16(o.z, o.w);
        *(v2u*)(N2row + 4 * (lane + 64 * j)) = w; }
}

__device__ __forceinline__ void prep_phase(Frame& F, const Args& a, int layer, int blk, int nblk_) {
    phase_ids(F);
    LAS float* scr = (LAS float*)(F.lds + F.wave * 16384);
    const int gw = blk * NWAVES + F.wave, NGW = nblk_ * NWAVES, lane = F.lane;
    unsigned char* ws = F.ws; unsigned char* db = F.ws + WS_DB + (size_t)(layer & 1) * DB_SET;
    bf16* WIN = (bf16*)(ws + WS_WIN); bf16* LORA = (bf16*)(ws + WS_LORA + (size_t)layer * LORA_BYTES); bf16* MVT = (bf16*)(ws + WS_MV + (size_t)(layer > 0 ? layer - 1 : 0) * MV_BYTES);
    const float* w_in = a.in[5] + (size_t)layer * 2048 * CIN;
    const int mvn = layer > 0 ? 32 : 0;
    const int c1 = 32 * 104, c2 = 32 * 128, c3 = mvn, c4 = 32, c5 = 32, c6 = 64, c7 = 512, c10 = 1024, c12 = 128;
    const int total = c1 + c2 + c3 + c4 + c5 + c6 + 3 * c7 + c10 + c7 + c12;
    for (int it = gw; it < total; it += NGW) {
        int r = it;
        if (r < c1) { tr_item(w_in, CIN, 3328, WIN, 2048, 0, 0, scr, r, lane); continue; } r -= c1;
        if (r < c2) { tr_item(w_in + 3328, CIN, 4096, WIN, 2048, 0, 3584, scr, r, lane); continue; } r -= c2;
        if (r < c3) { tr_item(a.in[16] + (size_t)(layer - 1) * 2048 * 32, 32, 32, WIN, 2048, 0, 3328, scr, r, lane); continue; } r -= c3;
        if (r < c4) { tr_item(a.in[7] + (size_t)layer * 64 * 1024, 1024, 1024, LORA, 256, 0, 0, scr, r, lane); continue; } r -= c4;
        if (r < c5) { tr_item(a.in[9] + (size_t)layer * 64 * 1024, 1024, 1024, LORA, 256, 64, 1024, scr, r, lane); continue; } r -= c5;
        if (r < c6) { tr_item(a.in[10] + (size_t)layer * 128 * 1024, 1024, 1024, LORA, 256, 128, 2048, scr, r, lane); continue; } r -= c6;
        if (r < c7) { tr_item(a.in[23] + (size_t)layer * D * D, D, D, (bf16*)(db + DB_PA), D, 0, 0, scr, r, lane); continue; } r -= c7;
        if (r < c7) { tr_item(a.in[24] + (size_t)layer * D * D, D, D, (bf16*)(db + DB_PBT), D, 0, 0, scr, r, lane); continue; } r -= c7;
        if (r < c7) { tr_item(a.in[25] + (size_t)layer * D * D, D, D, (bf16*)(db + DB_POUT), D, 0, 0, scr, r, lane); continue; } r -= c7;
        if (r < c10) { tr_item(a.in[26] + (size_t)layer * D * 2048, 2048, 2048, (bf16*)(db + DB_WQG), D, 0, 0, scr, r, lane); continue; } r -= c10;
        if (r < c7) { tr_item(a.in[31] + (size_t)layer * D * D, D, D, (bf16*)(db + DB_WQG), D, 0, 2048, scr, r, lane); continue; } r -= c7;
        tr_item(a.in[30] + (size_t)layer * 256 * D, D, D, (bf16*)(db + DB_PLEW), 256, 0, 0, scr, r, lane);
    }
    if (layer > 0) {
        const float* w2 = a.in[17] + (size_t)(layer - 1) * 32 * 1024;
        for (int it = gw; it < 512; it += NGW) { const int e = it * 64 + lane, n = e >> 5, k = e & 31; MVT[n * 256 + k] = (bf16)(cvt_pk_bf16(w2[k * 1024 + n], 0.f) & 0xffffu); }
    }
    {
        const float* keys = a.in[27] + (size_t)layer * 262144; const float* ut = a.in[28] + (size_t)layer * 16777216; const float* vt = a.in[29] + (size_t)layer * 16777216;
        const float* pin = a.in[1] + (size_t)layer * T * 256; const float* gws = a.in[21] + (size_t)layer * 131072;
        const int n1 = 512, n2 = 32768, n4 = 16384, n5 = 256, ntot = n1 + 2 * n2 + n4 + n5;
        for (int it = gw; it < ntot; it += NGW) {
            int r = it;
            if (r < n2) { cvt8_chunk(ut, db + DB_U, r, lane, 256.f); continue; } r -= n2;
            if (r < n2) { cvt8_chunk(vt, db + DB_V, r, lane, 64.f); continue; } r -= n2;
            if (r < n4) { cvt_chunk(pin, (bf16*)(db + DB_PB), r, lane); continue; } r -= n4;
            if (r < n1) { cvt_chunk(keys, (bf16*)(db + DB_KEYS), r, lane); continue; } r -= n1;
            {
                const int e0 = r * 512 + lane * 8, tq = (e0 >> 7) & 127, p0 = e0 & 127;
                const f32x4* s = (const f32x4*)(gws + e0); f32x4 x0 = s[0], x1 = s[1];
#pragma unroll
                for (int j = 0; j < 4; ++j) { if (p0 + j > tq) x0[j] = 0.f; if (p0 + 4 + j > tq) x1[j] = 0.f; }
                *(v4u*)((bf16*)(db + DB_GMW) + e0) = pk8(x0, x1);
            }
        }
    }
    if (layer == 0) {
        for (int m = gw; m < T; m += NGW) norm_row_nx(a.in[0] + (size_t)m * D, F.h + (size_t)m * D, a.in[2], (bf16*)(ws + WS_NX), m, lane);
    }
}

constexpr int SC = 32;
constexpr int SC_VEC = SC * 64;
constexpr int SC_V = SC_VEC, SC_BK = 2 * SC_VEC, SC_XA = SC_BK + SC * 64, SC_C = SC_XA + SC * 64, SC_BON = SC_C + SC * 4, SC_BUF = SC_BON + SC * 8;
struct ScanOps { f32x4 w[4], c; v4u bk; bf16x8 x[2]; float v; };
__device__ __forceinline__ void scan_load2(ScanOps& o, const LAS float* buf, const LAS float* vbuf, const LAS unsigned char* bkp, int bkstep, int s, int lane) {
    const int q = lane >> 4;
    const LAS float* p = buf + s * 64 + q * 4;
#pragma unroll
    for (int i = 0; i < 4; ++i) o.w[i] = *(const LAS f32x4*)(p + 16 * i);
    o.v = vbuf[SC_V + s * 64 + (lane & 15)];
    o.bk = *(const LAS v4u*)(bkp + s * bkstep);
    const LAS unsigned char* xp = (const LAS unsigned char*)(buf + SC_XA) + s * 256 + (lane & 1) * 128 + q * 16;
    o.x[0] = *(const LAS bf16x8*)xp; o.x[1] = *(const LAS bf16x8*)(xp + 64);
    o.c = *(const LAS f32x4*)(buf + SC_C + s * 4);
}
__device__ __forceinline__ float smul(float a, float b) { float r; asm("v_mul_f32 %0, %1, %2" : "=v"(r) : "v"(a), "v"(b)); return r; }
__device__ __forceinline__ void scan_step(const ScanOps& o, f32x4 (&St)[4], float& sa, v4u (&am)[4], v4u& bm, LAS float* ypt, unsigned m16) {
    v4u s0, s1;
    s0.x = cvt_pk_bf16(St[0].x, St[0].y); s0.y = cvt_pk_bf16(St[0].z, St[0].w); s0.z = cvt_pk_bf16(St[1].x, St[1].y); s0.w = cvt_pk_bf16(St[1].z, St[1].w);
    s1.x = cvt_pk_bf16(St[2].x, St[2].y); s1.y = cvt_pk_bf16(St[2].z, St[2].w); s1.z = cvt_pk_bf16(St[3].x, St[3].y); s1.w = cvt_pk_bf16(St[3].z, St[3].w);
    f32x4 dv = (f32x4){0.f, 0.f, 0.f, 0.f};
    dv = __builtin_amdgcn_mfma_f32_16x16x32_bf16(o.x[0], __builtin_bit_cast(bf16x8, s0), dv, 0, 0, 0);
    dv = __builtin_amdgcn_mfma_f32_16x16x32_bf16(o.x[1], __builtin_bit_cast(bf16x8, s1), dv, 0, 0, 0);
    bm.x = cvt_pk_bf16(sa, o.v) & m16;
#pragma unroll
    for (int i = 0; i < 4; ++i) { am[i].x = o.bk[i];
        St[i] = __builtin_amdgcn_mfma_f32_16x16x32_bf16(__builtin_bit_cast(bf16x8, am[i]), __builtin_bit_cast(bf16x8, bm), (f32x4){smul(St[i].x, o.w[i].x), smul(St[i].y, o.w[i].y), smul(St[i].z, o.w[i].z), smul(St[i].w, o.w[i].w)}, 0, 0, 0); }
    *ypt = dv.y + sa * o.c.z + o.v * o.c.w;
    sa = dv.x + sa * o.c.x + o.v * o.c.y;
}
__device__ __forceinline__ void scan_unit(Frame& F, const Args& a, int layer, int unit) {
    phase_ids(F);
    const int b = unit >> 4, hh = unit & 15, tid = F.tid, lane = F.lane, wave = F.wave;
    LAS float* bufs = (LAS float*)F.lds;
    LAS float* sY = bufs + 2 * SC_BUF;
    const bf16* ZR = (const bf16*)(F.ws + WS_ZRKV); const bf16* EW = (const bf16*)(F.ws + WS_EW); const bf16* AR = (const bf16*)(F.ws + WS_AR); const bf16* GT = (const bf16*)(F.ws + WS_G);
    bf16* YAB = (bf16*)(F.ws + WS_YAB);
    constexpr int NCH = SEQ / SC;
    if (wave < 4) {
        f32x4 St[4]; v4u am[4], bm = (v4u){0u, 0u, 0u, 0u};
#pragma unroll
        for (int i = 0; i < 4; ++i) { St[i] = (f32x4){0.f, 0.f, 0.f, 0.f}; am[i] = (v4u){0u, 0u, 0u, 0u}; }
        float sa = 0.f;
        const unsigned m16 = lane < 16 ? 0xffffffffu : 0u;
        LAS unsigned char* zblk = (LAS unsigned char*)(sY + 2 * SC_VEC);
        if (tid < 4) ((LAS unsigned*)zblk)[tid] = 0u;
        const int bkstep = lane < 16 ? 256 : 0;
        for (int it = 0; it < NCH + 2; ++it) {
            if (it >= 1 && it <= NCH) {
                const LAS float* bufc = bufs + ((it - 1) & 1) * SC_BUF;
                const LAS float* vbuf = bufc + wave * 16;
                const LAS unsigned char* bkp = lane < 16 ? (const LAS unsigned char*)(bufc + SC_BK) + lane * 16 : (const LAS unsigned char*)zblk;
                LAS float* yb = lane < 16 ? sY + ((it - 1) & 1) * SC_VEC + wave * 16 + lane : (LAS float*)(zblk + 16) - 0;
                const int ystep = lane < 16 ? 64 : 0;
                ScanOps o0, o1;
                scan_load2(o0, bufc, vbuf, bkp, bkstep, 0, lane);
#pragma unroll 1
                for (int s = 0; s < SC; s += 2) {
                    scan_load2(o1, bufc, vbuf, bkp, bkstep, s + 1, lane);
                    scan_step(o0, St, sa, am, bm, yb + s * ystep, m16);
                    if (s + 2 < SC) scan_load2(o0, bufc, vbuf, bkp, bkstep, s + 2, lane);
                    scan_step(o1, St, sa, am, bm, yb + (s + 1) * ystep, m16);
                }
            }
            __syncthreads();
        }
    } else {
        const int ht = tid - 256, tl = ht >> 3, c8 = ht & 7, ch = hh * 64 + c8 * 8;
        const size_t po = (size_t)layer * 1024 + ch;
        struct HelpIn { v4u zr, zk, zv, ew, ar, zkn, gt; };
        HelpIn cur, nxt;
#define HELP_LOAD(H, PC, GC) do { \
            if ((PC) < NCH) { const int _t = (PC) * SC + tl; const size_t _row = (size_t)b * SEQ + _t; \
                (H).zr = *(const v4u*)(ZR + _row * 3072 + ch); (H).zk = *(const v4u*)(ZR + _row * 3072 + 1024 + ch); (H).zv = *(const v4u*)(ZR + _row * 3072 + 2048 + ch); \
                (H).ew = *(const v4u*)(EW + _row * 1024 + ch); (H).ar = *(const v4u*)(AR + _row * 1024 + ch); \
                (H).zkn = (_t + 1 < SEQ) ? *(const v4u*)(ZR + (_row + 1) * 3072 + 1024 + ch) : (v4u){0u, 0u, 0u, 0u}; } \
            if ((GC) >= 0 && (GC) < NCH) { const size_t _row = (size_t)b * SEQ + (size_t)(GC) * SC + tl; (H).gt = *(const v4u*)(GT + _row * 1024 + ch); } } while (0)
        HELP_LOAD(cur, 0, -2);
        for (int it = 0; it < NCH + 2; ++it) {
            HELP_LOAD(nxt, it + 1, it - 1);
            if (it >= 2) {
                const LAS float* buf = bufs + (it & 1) * SC_BUF; const LAS float* yb = sY + (it & 1) * SC_VEC;
                const size_t row = (size_t)b * SEQ + (size_t)(it - 2) * SC + tl; const int o = tl * 64 + c8 * 8;
                f32x4 y_[2], v_[2], g_[2];
#pragma unroll
                for (int i = 0; i < 2; ++i) { y_[i] = *(const LAS f32x4*)(yb + o + 4 * i); v_[i] = *(const LAS f32x4*)(buf + SC_V + o + 4 * i); }
                const float bon = buf[SC_BON + tl * 8 + c8];
                unpk8(cur.gt, g_[0], g_[1]);
                const float s1 = ((y_[0].x + y_[0].y) + (y_[0].z + y_[0].w)) + ((y_[1].x + y_[1].y) + (y_[1].z + y_[1].w));
                const float mu = sum8(s1) * (1.f / 64.f);
                float s2 = 0.f;
#pragma unroll
                for (int i = 0; i < 2; ++i) { y_[i] = y_[i] - mu; const f32x4 q = y_[i] * y_[i]; s2 += (q.x + q.y) + (q.z + q.w); }
                const float rstd = 1.f / sqrtf(sum8(s2) * (1.f / 64.f) + 64e-5f);
                f32x4 o_[2];
#pragma unroll
                for (int i = 0; i < 2; ++i) o_[i] = (y_[i] * rstd * *(const f32x4*)(a.in[14] + po + 4 * i) + *(const f32x4*)(a.in[15] + po + 4 * i) + bon * v_[i]) * g_[i];
                *(v4u*)(YAB + row * 2048 + ch) = pk8(o_[0], o_[1]);
            }
            if (it < NCH) {
                LAS float* buf = bufs + (it & 1) * SC_BUF;
                f32x4 r_[2], k_[2], v_[2], e_[2], ar_[2], kn_[2];
                unpk8(cur.zr, r_[0], r_[1]); unpk8(cur.zk, k_[0], k_[1]); unpk8(cur.zv, v_[0], v_[1]); unpk8(cur.ew, e_[0], e_[1]); unpk8(cur.ar, ar_[0], ar_[1]); unpk8(cur.zkn, kn_[0], kn_[1]);
                f32x4 kkv[2], kp[2]; float ss = 0.f, bs = 0.f, sn = 0.f;
#pragma unroll
                for (int i = 0; i < 2; ++i) { const f32x4 pkk_ = *(const f32x4*)(a.in[11] + po + 4 * i), pka_ = *(const f32x4*)(a.in[12] + po + 4 * i), prk_ = *(const f32x4*)(a.in[13] + po + 4 * i);
                    kkv[i] = k_[i] * pkk_; kp[i] = k_[i] * (1.f + (ar_[i] - 1.f) * pka_); kn_[i] = kn_[i] * pkk_;
                    const f32x4 q = kkv[i] * kkv[i]; ss += (q.x + q.y) + (q.z + q.w); const f32x4 z = r_[i] * kp[i] * prk_; bs += (z.x + z.y) + (z.z + z.w);
                    const f32x4 qn = kn_[i] * kn_[i]; sn += (qn.x + qn.y) + (qn.z + qn.w); }
                ss = sum8(ss); sn = sum8(sn); const float bon = sum8(bs);
                const float inv = 1.f / sqrtf(fmaxf(ss, 1e-24f)), invn = -1.f / sqrtf(fmaxf(sn, 1e-24f));
                const int o = tl * 64 + c8 * 8; float c1 = 0.f, c2 = 0.f, c3 = 0.f, c4 = 0.f;
                f32x4 xa_[2], xr_[2];
#pragma unroll
                for (int i = 0; i < 2; ++i) { const f32x4 kn = kkv[i] * inv, bq = kn * ar_[i], an = kn_[i] * invn;
                    f32x4 w4; w4.x = __builtin_amdgcn_exp2f(-1.44269504f * e_[i].x); w4.y = __builtin_amdgcn_exp2f(-1.44269504f * e_[i].y); w4.z = __builtin_amdgcn_exp2f(-1.44269504f * e_[i].z); w4.w = __builtin_amdgcn_exp2f(-1.44269504f * e_[i].w);
                    const f32x4 z1 = bq * an, z2 = kp[i] * an, z3 = bq * r_[i], z4 = kp[i] * r_[i];
                    c1 += (z1.x + z1.y) + (z1.z + z1.w); c2 += (z2.x + z2.y) + (z2.z + z2.w); c3 += (z3.x + z3.y) + (z3.z + z3.w); c4 += (z4.x + z4.y) + (z4.z + z4.w);
                    xa_[i] = w4 * an; xr_[i] = w4 * r_[i];
                    *(LAS f32x4*)(buf + o + 4 * i) = w4; *(LAS f32x4*)(buf + SC_V + o + 4 * i) = v_[i];
                    { LAS unsigned* bkp = (LAS unsigned*)(buf + SC_BK) + tl * 64 + (((c8 & 1) * 8 + 4 * i) * 4 + (c8 >> 1));
                      bkp[0] = cvt_pk_bf16(bq.x, kp[i].x); bkp[4] = cvt_pk_bf16(bq.y, kp[i].y); bkp[8] = cvt_pk_bf16(bq.z, kp[i].z); bkp[12] = cvt_pk_bf16(bq.w, kp[i].w); }
                    { LAS unsigned char* xp = (LAS unsigned char*)(buf + SC_XA) + tl * 256 + (c8 >> 2) * 64 + (2 * (c8 & 1) + i) * 16 + ((c8 >> 1) & 1) * 8;
                      *(LAS v2u*)xp = (v2u){cvt_pk_bf16(xa_[i].x, xa_[i].y), cvt_pk_bf16(xa_[i].z, xa_[i].w)};
                      *(LAS v2u*)(xp + 128) = (v2u){cvt_pk_bf16(xr_[i].x, xr_[i].y), cvt_pk_bf16(xr_[i].z, xr_[i].w)}; } }
                c1 = sum8(c1); c2 = sum8(c2); c3 = sum8(c3); c4 = sum8(c4);
                if (c8 == 0) *(LAS f32x4*)(buf + SC_C + tl * 4) = (f32x4){c1, c2, c3, c4};
                buf[SC_BON + tl * 8 + c8] = bon;
            }
            cur = nxt;
            __syncthreads();
        }
#undef HELP_LOAD
    }
}

constexpr int TP = 136;
__device__ __forceinline__ void mma_128(const LAS bf16* sA, const LAS bf16* sBt, int wave, int lane, f32x4 (&acc)[4][2]) {
    const int wm = wave >> 2, wn = wave & 3, fr = lane & 15, fq = lane >> 4;
#pragma unroll
    for (int kk = 0; kk < 4; ++kk) {
        bf16x8 af[4], bf_[2];
#pragma unroll
        for (int mt = 0; mt < 4; ++mt) af[mt] = *(const LAS bf16x8*)(sA + (64 * wm + 16 * mt + fr) * TP + 32 * kk + 8 * fq);
#pragma unroll
        for (int nt = 0; nt < 2; ++nt) bf_[nt] = *(const LAS bf16x8*)(sBt + (32 * wn + 16 * nt + fr) * TP + 32 * kk + 8 * fq);
#pragma unroll
        for (int mt = 0; mt < 4; ++mt)
#pragma unroll
            for (int nt = 0; nt < 2; ++nt) acc[mt][nt] = __builtin_amdgcn_mfma_f32_16x16x32_bf16(bf_[nt], af[mt], acc[mt][nt], 0, 0, 0);
    }
}
__device__ __forceinline__ void gmlp_unit(Frame& F, const Args& a, int layer, int unit) {
    phase_ids(F);
    const size_t t0 = (size_t)unit * 128; const int tid = F.tid, lane = F.lane, wave = F.wave;
    LAS float* st = (LAS float*)F.lds; LAS bf16* sA = (LAS bf16*)(F.lds + 1024); LAS bf16* sB = (LAS bf16*)(F.lds + 1024 + 128 * TP * 2);
    const bf16* GUV = (const bf16*)(F.ws + WS_GUV); const bf16* GMW = (const bf16*)(F.ws + WS_DB + (size_t)(layer & 1) * DB_SET + DB_GMW); bf16* YAB = (bf16*)(F.ws + WS_YAB);
    const float* lng = a.in[19] + (size_t)layer * 1024; const float* lnb = a.in[20] + (size_t)layer * 1024; const float* bsp = a.in[22] + (size_t)layer * 1024;
    for (int r = 0; r < 16; ++r) { const int tok = wave * 16 + r; const bf16* rowp = GUV + (t0 + tok) * 2048 + 1024;
        f32x4 x0, x1, x2, x3; unpk8(*(const v4u*)(rowp + lane * 8), x0, x1); unpk8(*(const v4u*)(rowp + 512 + lane * 8), x2, x3);
        const f32x4 sv = (x0 + x1) + (x2 + x3), qv = (x0 * x0 + x1 * x1) + (x2 * x2 + x3 * x3);
        const float s = wave_sum((sv.x + sv.y) + (sv.z + sv.w)), q = wave_sum((qv.x + qv.y) + (qv.z + qv.w));
        const float mean = s * (1.f / 1024.f), var = fmaxf(q * (1.f / 1024.f) - mean * mean, 0.f);
        if (lane == 0) { st[tok * 2] = mean; st[tok * 2 + 1] = 1.f / sqrtf(var + 1e-5f); } }
    __syncthreads();
    for (int g = 0; g < 8; ++g) {
#pragma unroll
        for (int i = 0; i < 4; ++i) { const int pc = tid + 512 * i, rr = pc >> 4, c16 = pc & 15;
            *(LAS v4u*)(sA + rr * TP + c16 * 8) = *(const v4u*)(GMW + (size_t)g * 16384 + rr * 128 + c16 * 8); }
        { const int p = tid & 127, oc0 = tid >> 7; const float mean = st[p * 2], rstd = st[p * 2 + 1];
#pragma unroll
          for (int i = 0; i < 4; ++i) { const int oc = oc0 + 4 * i, c0 = g * 128 + oc * 8;
              f32x4 x0, x1; unpk8(*(const v4u*)(GUV + (t0 + p) * 2048 + 1024 + c0), x0, x1);
              const f32x4 g0 = *(const f32x4*)(lng + c0), g1 = *(const f32x4*)(lng + c0 + 4), b0 = *(const f32x4*)(lnb + c0), b1 = *(const f32x4*)(lnb + c0 + 4);
              x0 = (x0 - mean) * rstd * g0 + b0; x1 = (x1 - mean) * rstd * g1 + b1;
              const v4u w = pk8(x0, x1);
              LAS bf16* d = sB + (oc * 8) * TP + p;
              d[0 * TP] = (bf16)(w.x & 0xffffu); d[1 * TP] = (bf16)(w.x >> 16); d[2 * TP] = (bf16)(w.y & 0xffffu); d[3 * TP] = (bf16)(w.y >> 16);
              d[4 * TP] = (bf16)(w.z & 0xffffu); d[5 * TP] = (bf16)(w.z >> 16); d[6 * TP] = (bf16)(w.w & 0xffffu); d[7 * TP] = (bf16)(w.w >> 16); } }
        __syncthreads();
        f32x4 acc[4][2];
#pragma unroll
        for (int mt = 0; mt < 4; ++mt)
#pragma unroll
            for (int nt = 0; nt < 2; ++nt) acc[mt][nt] = (f32x4){0.f, 0.f, 0.f, 0.f};
        mma_128(sA, sB, wave, lane, acc);
        { const int wm = wave >> 2, wn = wave & 3, fr = lane & 15, fq = lane >> 4;
#pragma unroll
          for (int mt = 0; mt < 4; ++mt) { const int tt = 64 * wm + 16 * mt + fr; const float bsv = bsp[g * 128 + tt];
#pragma unroll
              for (int nt = 0; nt < 2; ++nt) { const int c = g * 128 + 32 * wn + 16 * nt + 4 * fq;
                  const v2u uw = *(const v2u*)(GUV + (t0 + tt) * 2048 + c);
                  const f32x4 u4 = (f32x4){bflo(uw.x), bfhi(uw.x), bflo(uw.y), bfhi(uw.y)};
                  const f32x4 yb = u4 * (acc[mt][nt] + bsv);
                  v2u ow; ow.x = cvt_pk_bf16(yb.x, yb.y); ow.y = cvt_pk_bf16(yb.z, yb.w);
                  *(v2u*)(YAB + (t0 + tt) * 2048 + 1024 + c) = ow; } } }
        __syncthreads();
    }
}

__device__ __forceinline__ unsigned fkey(float f) { const unsigned u = __builtin_bit_cast(unsigned, f); return (u & 0x80000000u) ? ~u : (u | 0x80000000u); }
__device__ __forceinline__ float kval(unsigned k, unsigned mask) { const unsigned u = k & mask; return __builtin_bit_cast(float, (u & 0x80000000u) ? (u ^ 0x80000000u) : ~u); }
__device__ __forceinline__ float swap32_add(float a, float b) { const auto r = __builtin_amdgcn_permlane32_swap(__builtin_bit_cast(unsigned, a), __builtin_bit_cast(unsigned, b), false, false);
    return __builtin_bit_cast(float, (unsigned)r[0]) + __builtin_bit_cast(float, (unsigned)r[1]); }
__device__ __forceinline__ float swap16_add(float a, float b) { const auto r = __builtin_amdgcn_permlane16_swap(__builtin_bit_cast(unsigned, a), __builtin_bit_cast(unsigned, b), false, false);
    return __builtin_bit_cast(float, (unsigned)r[0]) + __builtin_bit_cast(float, (unsigned)r[1]); }
__device__ __forceinline__ float row_sum16(float x) {
    x += __builtin_bit_cast(float, __builtin_amdgcn_update_dpp(0, __builtin_bit_cast(int, x), 0x128, 0xf, 0xf, false));
    x += __builtin_bit_cast(float, __builtin_amdgcn_update_dpp(0, __builtin_bit_cast(int, x), 0x124, 0xf, 0xf, false));
    x += __builtin_bit_cast(float, __builtin_amdgcn_update_dpp(0, __builtin_bit_cast(int, x), 0x122, 0xf, 0xf, false));
    x += __builtin_bit_cast(float, __builtin_amdgcn_update_dpp(0, __builtin_bit_cast(int, x), 0x121, 0xf, 0xf, false));
    return x; }
#ifndef REP_K
#define REP_K 1
#endif
#define TOP_INSERT(top, x) do { unsigned _x = (x); _Pragma("unroll") for (int _j = 0; _j < 16; ++_j) { const unsigned _h = max((top)[_j], _x); _x = min((top)[_j], _x); (top)[_j] = _h; } } while (0)
__device__ __forceinline__ void peer_unit(Frame& F, const Args& a, int layer, int unit, bool last) {
    phase_ids(F);
    const size_t t0 = (size_t)unit * 128; const int tid = F.tid, lane = F.lane, wave = F.wave, fr = lane & 15, fq = lane >> 4;
    LAS bf16* sKey = (LAS bf16*)F.lds;
    LAS unsigned* sLT = (LAS unsigned*)(F.lds + 128 * TP * 2) + wave * 512;
    const bf16* Q = (const bf16*)(F.ws + WS_Q); const bf16* KEYS = (const bf16*)(F.ws + WS_DB + (size_t)(layer & 1) * DB_SET + DB_KEYS); v2u* SEL = (v2u*)(F.ws + WS_SEL);
    const size_t trow = t0 + wave * 16 + fr;
    for (int krep = 0; krep < REP_K; ++krep)
    for (int hd = 0; hd < 8; ++hd) {
        for (int p = 0; p < 2; ++p) {
            __syncthreads();
#pragma unroll
            for (int i = 0; i < 4; ++i) { const int pc = tid + 512 * i, rr = pc >> 4, c16 = pc & 15;
                *(LAS v4u*)(sKey + rr * TP + c16 * 8) = *(const v4u*)(KEYS + (size_t)(hd * 2 + p) * 16384 + rr * 128 + c16 * 8); }
            bf16x8 qf[4];
#pragma unroll
            for (int kk = 0; kk < 4; ++kk) qf[kk] = *(const bf16x8*)(Q + trow * 2048 + hd * 256 + p * 128 + 32 * kk + 8 * fq);
            __syncthreads();
            f32x4 sc[8];
#pragma unroll
            for (int nt = 0; nt < 8; ++nt) sc[nt] = (f32x4){0.f, 0.f, 0.f, 0.f};
#pragma unroll
            for (int kk = 0; kk < 4; ++kk)
#pragma unroll
                for (int nt = 0; nt < 8; ++nt) { const bf16x8 kf = *(const LAS bf16x8*)(sKey + (16 * nt + fr) * TP + 32 * kk + 8 * fq);
                    sc[nt] = __builtin_amdgcn_mfma_f32_16x16x32_bf16(kf, qf[kk], sc[nt], 0, 0, 0); }
            unsigned top[16];
#pragma unroll
            for (int j = 0; j < 16; ++j) top[j] = 0u;
#pragma unroll
            for (int nt = 0; nt < 8; ++nt)
#pragma unroll
                for (int rg = 0; rg < 4; ++rg) TOP_INSERT(top, (fkey(sc[nt][rg]) & 0xFFFFFF80u) | (unsigned)(16 * nt + 4 * fq + rg));
#pragma unroll
            for (int rnd = 0; rnd < 2; ++rnd) { unsigned oth[16];
#pragma unroll
                for (int j = 0; j < 16; ++j) oth[j] = rnd ? xor32_u(top[j], lane) : xor16_u(top[j], lane);
#pragma unroll
                for (int j = 0; j < 16; ++j) TOP_INSERT(top, oth[j]); }
#pragma unroll
            for (int j = 0; j < 16; ++j) sLT[fr * 32 + p * 16 + j] = top[j];
        }
        float v0[16], v1[16];
#pragma unroll
        for (int j = 0; j < 16; ++j) { v0[j] = kval(sLT[fr * 32 + j], 0xFFFFFF80u); v1[j] = kval(sLT[fr * 32 + 16 + j], 0xFFFFFF80u); }
        unsigned best[16];
#pragma unroll
        for (int j = 0; j < 16; ++j) best[j] = 0u;
#pragma unroll
        for (int i = 0; i < 16; ++i)
#pragma unroll
            for (int j = 0; j < 16; ++j) if ((i + 1) * (j + 1) <= 16) TOP_INSERT(best, (fkey(v0[i] + v1[j]) & 0xFFFFFF00u) | (unsigned)(i * 16 + j));
        float ev[16], esum = 0.f; const float mx = kval(best[0], 0xFFFFFF00u);
#pragma unroll
        for (int k = 0; k < 16; ++k) { ev[k] = __builtin_amdgcn_exp2f((kval(best[k], 0xFFFFFF00u) - mx) * 1.44269504f); esum += ev[k]; }
        const float einv = 1.f / esum;
#pragma unroll
        for (int k = 0; k < 16; ++k) { const unsigned pos = best[k] & 255u;
            const unsigned i0 = sLT[fr * 32 + (pos >> 4)] & 127u, i1 = sLT[fr * 32 + 16 + (pos & 15u)] & 127u;
            if ((k >> 2) == fq) SEL[trow * 128 + hd * 16 + k] = (v2u){i0 * 128u + i1, __builtin_bit_cast(unsigned, ev[k] * einv)}; }
    }
    asm volatile("s_waitcnt vmcnt(0)" ::: "memory");
    __syncthreads();
    const bf16* N2 = (const bf16*)(F.ws + WS_N2); const unsigned char* U8 = F.ws + WS_DB + (size_t)(layer & 1) * DB_SET + DB_U; const unsigned char* V8 = F.ws + WS_DB + (size_t)(layer & 1) * DB_SET + DB_V;
    const unsigned* SELU = (const unsigned*)SEL;
#define PL_LOAD(UB, VB, SE, BB) do { _Pragma("unroll") for (int _q = 0; _q < 8; ++_q) { \
        const unsigned _idx = (unsigned)__builtin_amdgcn_readlane((int)((_q & 1) ? (SE).z : (SE).x), (BB) * 4 + (_q >> 1)); \
        (UB)[_q] = *(const v4u*)(U8 + (size_t)_idx * 1024 + 16 * lane); (VB)[_q] = *(const v4u*)(V8 + (size_t)_idx * 1024 + 16 * lane); } } while (0)
#define PL_COMPUTE(UB, VB, SE, BB) do { float _p[8]; \
        _Pragma("unroll") for (int _q = 0; _q < 8; ++_q) { f32x2 _a = (f32x2){0.f, 0.f}; \
            _Pragma("unroll") for (int _j = 0; _j < 4; ++_j) { _a += __builtin_amdgcn_cvt_pk_f32_fp8((int)(UB)[_q][_j], false) * nf[2 * _j]; _a += __builtin_amdgcn_cvt_pk_f32_fp8((int)(UB)[_q][_j], true) * nf[2 * _j + 1]; } \
            _p[_q] = _a.x + _a.y; } \
        float _s0 = swap32_add(_p[0], _p[4]), _s1 = swap32_add(_p[1], _p[5]), _s2 = swap32_add(_p[2], _p[6]), _s3 = swap32_add(_p[3], _p[7]); \
        float _t0 = row_sum16(swap16_add(_s0, _s2)), _t1 = row_sum16(swap16_add(_s1, _s3)); \
        _t0 = fgelu(_t0 * (1.f / 256.f)) * (1.f / 64.f); _t1 = fgelu(_t1 * (1.f / 256.f)) * (1.f / 64.f); \
        _Pragma("unroll") for (int _q = 0; _q < 8; ++_q) { \
            const float _gd = __builtin_bit_cast(float, __builtin_amdgcn_readlane(__builtin_bit_cast(int, (_q & 1) ? _t1 : _t0), 16 * (((_q >> 1) & 1) | ((_q >> 2) << 1)))); \
            const float _gw = __builtin_bit_cast(float, __builtin_amdgcn_readlane((int)((_q & 1) ? (SE).w : (SE).y), (BB) * 4 + (_q >> 1))); \
            const float _c = _gd * _gw; const f32x2 _c2 = (f32x2){_c, _c}; \
            _Pragma("unroll") for (int _j = 0; _j < 4; ++_j) { out[2 * _j] += _c2 * __builtin_amdgcn_cvt_pk_f32_fp8((int)(VB)[_q][_j], false); out[2 * _j + 1] += _c2 * __builtin_amdgcn_cvt_pk_f32_fp8((int)(VB)[_q][_j], true); } } } while (0)
    {
        const size_t tokb = t0 + wave * 16;
        v4u se = *(const v4u*)(SELU + tokb * 256 + 4 * lane), se_n = se;
        v4u ua[8], va[8], ub[8], vb[8];
        PL_LOAD(ua, va, se, 0);
        for (int it = 0; it < 16; ++it) {
            const size_t tok = tokb + it;
            f32x2 nf[8], out[8];
            { f32x4 x0, x1, x2, x3; unpk8(*(const v4u*)(N2 + tok * 1024 + 16 * lane), x0, x1); unpk8(*(const v4u*)(N2 + tok * 1024 + 16 * lane + 8), x2, x3);
              nf[0] = __builtin_shufflevector(x0, x0, 0, 1); nf[1] = __builtin_shufflevector(x0, x0, 2, 3); nf[2] = __builtin_shufflevector(x1, x1, 0, 1); nf[3] = __builtin_shufflevector(x1, x1, 2, 3);
              nf[4] = __builtin_shufflevector(x2, x2, 0, 1); nf[5] = __builtin_shufflevector(x2, x2, 2, 3); nf[6] = __builtin_shufflevector(x3, x3, 0, 1); nf[7] = __builtin_shufflevector(x3, x3, 2, 3); }
#pragma unroll
            for (int i = 0; i < 8; ++i) out[i] = (f32x2){0.f, 0.f};
            if (it < 15) se_n = *(const v4u*)(SELU + (tok + 1) * 256 + 4 * lane);
#pragma unroll 1
            for (int bp = 0; bp < 8; ++bp) {
                PL_LOAD(ub, vb, se, 2 * bp + 1);
                PL_COMPUTE(ua, va, se, 2 * bp);
                if (bp < 7) PL_LOAD(ua, va, se, 2 * bp + 2); else if (it < 15) PL_LOAD(ua, va, se_n, 0);
                PL_COMPUTE(ub, vb, se, 2 * bp + 1);
            }
            se = se_n;
            float* hp = F.h + tok * 1024 + 16 * lane;
            f32x4 hv[4]; float s = 0.f;
#pragma unroll
            for (int i = 0; i < 4; ++i) { hv[i] = *(const f32x4*)(hp + 4 * i) + (f32x4){out[2 * i].x, out[2 * i].y, out[2 * i + 1].x, out[2 * i + 1].y};
                s += (hv[i].x * hv[i].x + hv[i].y * hv[i].y) + (hv[i].z * hv[i].z + hv[i].w * hv[i].w); }
            const float rstd = 1.f / sqrtf(wave_sum(s) * (1.f / D) + 1e-6f);
            const float* g = (last ? a.in[4] : a.in[2] + (size_t)(layer + 1) * 1024) + 16 * lane;
            f32x4 o[4];
#pragma unroll
            for (int i = 0; i < 4; ++i) o[i] = hv[i] * rstd * *(const f32x4*)(g + 4 * i);
            if (last) {
#ifdef PROBE_SCAN
                { const float pv = ((const float*)(F.ws + WS_CTL))[2048 + PROBE_SCAN - 1];
#pragma unroll
                  for (int i = 0; i < 4; ++i) o[i] = o[i] + pv; }
#endif
#pragma unroll
                for (int i = 0; i < 4; ++i) *(f32x4*)(hp + 4 * i) = o[i];
            } else {
#pragma unroll
                for (int i = 0; i < 4; ++i) *(f32x4*)(hp + 4 * i) = hv[i];
                bf16* NX = (bf16*)(F.ws + WS_NX); const v4u w0 = pk8(o[0], o[1]), w1 = pk8(o[2], o[3]); const int tt = (int)(tok & (SEQ - 1));
                *(v4u*)(NX + tok * 2048 + 16 * lane) = w0; *(v4u*)(NX + tok * 2048 + 16 * lane + 8) = w1;
                if (tt != SEQ - 1) { *(v4u*)(NX + (tok + 1) * 2048 + 1024 + 16 * lane) = w0; *(v4u*)(NX + (tok + 1) * 2048 + 1024 + 16 * lane + 8) = w1; }
                if (tt == 0) { *(v4u*)(NX + tok * 2048 + 1024 + 16 * lane) = (v4u){0u, 0u, 0u, 0u}; *(v4u*)(NX + tok * 2048 + 1024 + 16 * lane + 8) = (v4u){0u, 0u, 0u, 0u}; }
            }
        }
    }
#undef PL_LOAD
#undef PL_COMPUTE
}

#ifndef REP_E
#define REP_E 1
#endif
#ifndef REP_A
#define REP_A 1
#endif
#ifndef REP_B
#define REP_B 1
#endif
#ifndef REP_C
#define REP_C 1
#endif
#ifndef REP_D
#define REP_D 1
#endif
#ifndef REP_G
#define REP_G 1
#endif
#ifndef REP_I
#define REP_I 1
#endif
#ifndef REP_K
#define REP_K 1
#endif
__global__ void __launch_bounds__(NWAVES * 64, 2) trunk_fwd(Args args) {
    extern __shared__ __attribute__((aligned(16))) unsigned char lds[];
    Frame F;
    F.lds = (LAS unsigned char*)lds;
    F.tid = threadIdx.x; F.lane = F.tid & 63; F.wave = __builtin_amdgcn_readfirstlane(F.tid >> 6); F.wave0 = F.wave;
    F.G = gridDim.x; F.bx = blockIdx.x; F.ws = args.ws; F.h = args.out;
    volatile LAS unsigned* MISC = (volatile LAS unsigned*)(F.lds + MISC_OFF);
    for (int u = F.tid; u < (LDS_BYTES - LDSCTL_OFF) / 4; u += NWAVES * 64) ((LAS unsigned*)(F.lds + LDSCTL_OFF))[u] = 0u;
    __syncthreads();
    unsigned* ctl = (unsigned*)(F.ws + WS_CTL);
    XcdBarrier bar = xcd_barrier_post(ctl + CW_BAR, MISC + 8);
    unsigned char* ws = F.ws;
    LAS unsigned char* ring = (LAS unsigned char*)F.lds;

    for (int rep = 0; rep < REP_A; ++rep) { prep_phase(F, args, 0, F.bx, F.G);
    xcd_barrier(bar, F.wave0); }
#define OPQ() unsigned char* ws = F.ws; asm volatile("" : "+s"(ws)); unsigned char* db = ws + WS_DB + (size_t)(layer & 1) * DB_SET; (void)db
    for (int layer = 0; layer < DEPTH; ++layer) {
        {   OPQ();
        for (int rep = 0; rep < REP_B; ++rep) {   if (rep) xcd_barrier(bar, F.wave0); pg8::Gemm g{(const bf16*)(ws + WS_NX), (const bf16*)(ws + WS_WIN), T, NZ, 2048, 2048}; pg8::StaticOrder S; S.init(T, NZ, F.G, F.bx);
            pg8::EpiZ E{(bf16*)(ws + WS_ZRKV), (bf16*)(ws + WS_ZL), (bf16*)(ws + WS_GUV), (bf16*)(ws + WS_SG), layer == 0 ? (bf16*)(ws + WS_VF) : (bf16*)nullptr};
            pg8::gemm_phase<pg8::EpiZ, pg8::StaticOrder, true, true>(ring, g, S, E, F.wave0); }
        }
        xcd_barrier(bar, F.wave0);
        {   OPQ();
        for (int rep = 0; rep < REP_C; ++rep) {   if (rep) xcd_barrier(bar, F.wave0); pg8::Gemm g{(const bf16*)(ws + WS_ZL), (const bf16*)(ws + WS_LORA + (size_t)layer * LORA_BYTES), T, 3072, 256, 512}; pg8::StaticOrder S; S.init(T, 3072, F.G, F.bx);
            pg8::EpiLora E{(bf16*)(ws + WS_EW), (size_t)(WS_AR - WS_EW) / 2, args.in[6] + (size_t)layer * 1024, args.in[8] + (size_t)layer * 1024};
            pg8::gemm_phase<pg8::EpiLora, pg8::StaticOrder, true, true>(ring, g, S, E, F.wave0); }
        if (layer > 0) {
            pg8::Gemm g{(const bf16*)(ws + WS_ZL) + 256, (const bf16*)(ws + WS_MV + (size_t)(layer - 1) * MV_BYTES), T, 1024, 256, 512}; pg8::StaticOrder S; S.init(T, 1024, F.G, F.bx);
            pg8::EpiMv E{(bf16*)(ws + WS_ZRKV), (const bf16*)(ws + WS_VF), args.in[18] + (size_t)(layer - 1) * 1024};
            pg8::gemm_phase<pg8::EpiMv, pg8::StaticOrder, true, true>(ring, g, S, E, F.wave0); }
        }
        xcd_barrier(bar, F.wave0);
        {   OPQ();
        for (int rep = 0; rep < REP_D; ++rep) {   if (rep) xcd_barrier(bar, F.wave0); const int nsb = F.G / 2, nob = F.G - nsb;
            if (F.bx < nsb) { for (int u = F.bx; u < NB * 16; u += nsb) scan_unit(F, args, layer, u); }
            else { const int ob = F.bx - nsb;
                for (int pm = ob; pm < T / 256; pm += nob)
                    for (int rep2 = 0; rep2 < REP_E; ++rep2) { gmlp_unit(F, args, layer, 2 * pm); gmlp_unit(F, args, layer, 2 * pm + 1); }
                asm volatile("s_waitcnt vmcnt(0)" ::: "memory"); __syncthreads();
                {
                    pg8::Gemm g{(const bf16*)(ws + WS_YAB) + 1024, (const bf16*)(db + DB_PBT), T, 1024, 1024, 2048}; pg8::PanelOrder S{ob, nob, T / 256, 4};
                    pg8::EpiMerge<false> E{(const bf16*)(ws + WS_SG), (bf16*)(ws + WS_GUV) + 1024, (bf16*)nullptr};
                    pg8::gemm_phase<pg8::EpiMerge<false>, pg8::PanelOrder, true, true>(ring, g, S, E, F.wave0); }
                {   pg8::Gemm g{(const bf16*)(db + DB_PB), (const bf16*)(db + DB_PLEW), T, 1024, 256, 256}; pg8::StaticOrder S; S.init(T, 1024, nob, ob);
                    pg8::EpiPlain E{(bf16*)(ws + WS_PW), 1024};
                    pg8::gemm_phase<pg8::EpiPlain, pg8::StaticOrder, true, true>(ring, g, S, E, F.wave0); }
                if (layer + 1 < DEPTH) prep_phase(F, args, layer + 1, ob, nob); } }
        }
        xcd_barrier(bar, F.wave0);
        {   OPQ();
        for (int rep = 0; rep < REP_G; ++rep) {   if (rep) xcd_barrier(bar, F.wave0); pg8::Gemm g{(const bf16*)(ws + WS_YAB), (const bf16*)(db + DB_PA), T, 1024, 1024, 2048}; pg8::StaticOrder S; S.init(T, 1024, F.G, F.bx);
            pg8::EpiMerge<true> E{(const bf16*)(ws + WS_SG), (bf16*)(ws + WS_GUV) + 1024, (bf16*)(ws + WS_MG)};
            pg8::gemm_phase<pg8::EpiMerge<true>, pg8::StaticOrder, true, true>(ring, g, S, E, F.wave0); }
        }
        xcd_barrier(bar, F.wave0);
        {   OPQ();
        {   pg8::Gemm g{(const bf16*)(ws + WS_MG), (const bf16*)(db + DB_POUT), T, 1024, 1024, 1024}; pg8::StaticOrder S; S.init(T, 1024, F.G, F.bx);
            pg8::EpiResid E{F.h};
            pg8::gemm_phase<pg8::EpiResid, pg8::StaticOrder, true, true>(ring, g, S, E, F.wave0); }
        }
        xcd_barrier(bar, F.wave0);
        {   OPQ();
        for (int rep = 0; rep < REP_I; ++rep) {   if (rep) xcd_barrier(bar, F.wave0); phase_ids(F); const int gw = F.bx * NWAVES + F.wave, NGW = F.G * NWAVES; const float* g2 = args.in[3] + (size_t)layer * 1024;
            for (int m = gw; m < T; m += NGW) norm_row_n2(F.h + (size_t)m * D, g2, (bf16*)(ws + WS_N2) + (size_t)m * D, F.lane); }
        }
        xcd_barrier(bar, F.wave0);
        {   OPQ();
        {   pg8::Gemm g{(const bf16*)(ws + WS_N2), (const bf16*)(db + DB_WQG), T, 3072, 1024, 1024}; pg8::StaticOrder S; S.init(T, 3072, F.G, F.bx);
            pg8::EpiQG E{(bf16*)(ws + WS_Q), (const bf16*)(ws + WS_PW), F.h};
            pg8::gemm_phase<pg8::EpiQG, pg8::StaticOrder, true, true>(ring, g, S, E, F.wave0); }
        }
        xcd_barrier(bar, F.wave0);
        {   OPQ();
        for (int u = F.bx; u < T / 128; u += F.G) peer_unit(F, args, layer, u, layer == DEPTH - 1);
        }
        if (layer + 1 < DEPTH) xcd_barrier(bar, F.wave0);
    }
}

extern "C" void kernel_launch(void* const* d_in, const int* in_sizes, int n_in, void* d_out, int out_size, void* d_ws, size_t ws_size, hipStream_t stream) {
    static int grid = 0;
    if (grid == 0) {
        if (n_in != 32 || out_size != T * D || ws_size < WS_END) { fprintf(stderr, "kernel_launch: unexpected sizes n_in %d out %d ws %zu (need %zu); nothing launched\n", n_in, out_size, ws_size, (size_t)WS_END); grid = -1; return; }
        int dev = 0, cus = 0, per_cu = 0;
        if (hipGetDevice(&dev) != hipSuccess || hipDeviceGetAttribute(&cus, hipDeviceAttributeMultiprocessorCount, dev) != hipSuccess) { grid = -1; return; }
        if (hipFuncSetAttribute((const void*)trunk_fwd, hipFuncAttributeMaxDynamicSharedMemorySize, LDS_BYTES) != hipSuccess) { fprintf(stderr, "kernel_launch: hipFuncSetAttribute failed\n"); grid = -1; return; }
        if (hipOccupancyMaxActiveBlocksPerMultiprocessor(&per_cu, (const void*)trunk_fwd, NWAVES * 64, LDS_BYTES) != hipSuccess || per_cu < 1)
            fprintf(stderr, "kernel_launch: note: occupancy query reports %d workgroups per CU\n", per_cu);
        (void)hipGetLastError();
        grid = cus;
    }
    if (grid < 0) return;
    (void)hipMemsetAsync((char*)d_ws + WS_CTL, 0, ZERO_BYTES, stream);
    (void)hipMemsetAsync((char*)d_ws + WIN_ZERO_OFF, 0, WIN_ZERO_BYTES, stream);
    Args a{};
    for (int i = 0; i < 32; ++i) a.in[i] = (const float*)d_in[i];
    a.out = (float*)d_out; a.ws = (unsigned char*)d_ws;
    hipLaunchKernelGGL(trunk_fwd, dim3(grid), dim3(NWAVES * 64), LDS_BYTES, stream, a);
    const hipError_t le = hipPeekAtLastError();
    if (le != hipSuccess) fprintf(stderr, "kernel_launch: launch failed: %s\n", hipGetErrorName(le));
}
```

```cpp
#include <hip/hip_runtime.h>
#include <cstdio>
#include <cstdint>
namespace pg8 {
#define PG8_LAS __attribute__((address_space(3)))
typedef unsigned short bf16_t;
typedef short bf16x8 __attribute__((ext_vector_type(8)));
typedef float f32x4 __attribute__((ext_vector_type(4)));
typedef unsigned u32x4 __attribute__((ext_vector_type(4)));
constexpr int BM = 256, BK = 64, HALF = 128, HTB = HALF * BK * 2  , STAGE_BYTES = 8 * HTB, NXCD = 8, WGM = 8;

__host__ __device__ __forceinline__ int lds_byte(int r, int c) { const int st = (r >> 4) * 2 + (c >> 5), rr = r & 15, cc = c & 31, ob = rr * 64 + cc * 2; return st * 1024 + (ob ^ (((ob >> 9) & 1) << 5)); }
__host__ __device__ __forceinline__ void stage_rc(int b, int& R, int& C) { const int st = b / 1024, sb = b % 1024, swz = sb ^ (((sb >> 9) & 1) << 5); R = (st >> 1) * 16 + swz / 64; C = (st & 1) * 32 + (swz % 64) / 2; }
__host__ __device__ __forceinline__ int perm32(int rho) { const int n = rho >> 4, i = rho & 15; return 8 * (i >> 2) + 4 * n + (i & 3); }

struct Unit { int pm, pn; };
struct Gemm { const bf16_t* A; const bf16_t* Bt; int M, N, K, lda; };

struct StaticOrder {
    int nM, nN, nwg, G, c;
    __host__ __device__ void init(int M, int N, int G_, int c_) { nM = M / BM; nN = N / BM; nwg = nM * nN; G = G_; c = c_; }
    __host__ __device__ bool next(int i, Unit& u) const {
        const long L = (long)i * G + c; if (L >= nwg) return false;
        int wgid = (int)L; { const int q = nwg / NXCD, r = nwg % NXCD, xcd = wgid % NXCD, off = wgid / NXCD; wgid = (xcd < r ? xcd * (q + 1) : r * (q + 1) + (xcd - r) * q) + off; }
        const int nig = WGM * nN, gid = wgid / nig, fm = gid * WGM, gsz = (nM - fm) < WGM ? (nM - fm) : WGM;
        u.pm = fm + ((wgid % nig) % gsz); u.pn = (wgid % nig) / gsz; return true;
    }
    __device__ __forceinline__ void a_ready(const Unit&) const {}
    __device__ __forceinline__ void done(const Unit&) const {}
};
struct PanelOrder {
    int first, stride, nM, nN;
    __host__ __device__ bool next(int i, Unit& u) const { const int p = first + (i / nN) * stride; if (p >= nM) return false; u.pm = p; u.pn = i % nN; return true; }
    __device__ __forceinline__ void a_ready(const Unit&) const {}
    __device__ __forceinline__ void done(const Unit&) const {}
};
__device__ __forceinline__ unsigned cvt_pk_bf16(float lo, float hi) { unsigned r; asm volatile("v_cvt_pk_bf16_f32 %0, %1, %2" : "=v"(r) : "v"(lo), "v"(hi)); return r; }

__device__ __forceinline__ float fsig(float x) { return __builtin_amdgcn_rcpf(1.f + __builtin_amdgcn_exp2f(-1.44269504f * x)); }
__device__ __forceinline__ float fgelu(float x) { return x * fsig(1.5957691216f * (x + 0.044715f * x * x * x)); }
__device__ __forceinline__ float bflo(unsigned w) { return __builtin_bit_cast(float, w << 16); }
__device__ __forceinline__ float bfhi(unsigned w) { return __builtin_bit_cast(float, w & 0xffff0000u); }
__device__ __forceinline__ void unpk8(const u32x4 w, f32x4& a, f32x4& b) { a = (f32x4){bflo(w.x), bfhi(w.x), bflo(w.y), bfhi(w.y)}; b = (f32x4){bflo(w.z), bfhi(w.z), bflo(w.w), bfhi(w.w)}; }
__device__ __forceinline__ u32x4 pk8(const f32x4 a, const f32x4 b) { u32x4 w; w.x = cvt_pk_bf16(a[0], a[1]); w.y = cvt_pk_bf16(a[2], a[3]); w.z = cvt_pk_bf16(b[0], b[1]); w.w = cvt_pk_bf16(b[2], b[3]); return w; }
__device__ __forceinline__ f32x4 act4(f32x4 v, int kind) {
    if (kind == 1) { v = (f32x4){fgelu(v[0]), fgelu(v[1]), fgelu(v[2]), fgelu(v[3])}; }
    else if (kind == 2) { v = (f32x4){fsig(v[0]), fsig(v[1]), fsig(v[2]), fsig(v[3])}; }
    else if (kind == 3) { v = (f32x4){2.f * fsig(2.f * v[0]) - 1.f, 2.f * fsig(2.f * v[1]) - 1.f, 2.f * fsig(2.f * v[2]) - 1.f, 2.f * fsig(2.f * v[3]) - 1.f}; }
    return v;
}
#define EPI_ROWS_BEGIN _Pragma("unroll") for (int ai = 0; ai < 2; ++ai) _Pragma("unroll") for (int m = 0; m < 4; ++m) { const size_t row = (size_t)(row0 + ai * HALF + m * 16);
#define EPI_ROWS_END }

struct EpiZ {
    static constexpr bool PERM = true, AFTER_DRAIN = false;
    bf16_t *zrkv, *zl, *guv, *sg, *vf;
    __device__ __forceinline__ void operator()(const f32x4 (&acc)[2][2][4][2], const Unit& u, int wr, int wc, int fr, int fq) const {
        const int pn = u.pn, row0 = u.pm * BM + wr * 64 + fr;
        bf16_t* dst; int ld, colt, k0, k1;
        if (pn < 12)       { dst = zrkv; ld = 3072; colt = pn * 256;        k0 = 0; k1 = 0; }
        else if (pn == 12) { dst = zl;   ld = 512;  colt = 0;               k0 = (wc < 2) ? 3 : 0; k1 = 2; }
        else if (pn == 13) { dst = zl;   ld = 512;  colt = 256;             k0 = 0; k1 = 0; }
        else if (pn < 22)  { dst = guv;  ld = 2048; colt = (pn - 14) * 256; k0 = 1; k1 = 1; }
        else               { dst = sg;   ld = 2048; colt = (pn - 22) * 256; k0 = 2; k1 = 2; }
        const int col0 = colt + wc * 32 + 8 * fq;
        const bool dovf = (vf != nullptr) && pn >= 8 && pn < 12;
        const int vcol0 = (pn - 8) * 256 + wc * 32 + 8 * fq;
        EPI_ROWS_BEGIN
            bf16_t* rowp = dst + row * ld + col0;
#pragma unroll
            for (int bj = 0; bj < 2; ++bj) { const int kind = bj ? k1 : k0;
                const u32x4 w = pk8(act4(acc[ai][bj][m][0], kind), act4(acc[ai][bj][m][1], kind));
                *(u32x4*)(rowp + bj * HALF) = w;
                if (dovf) *(u32x4*)(vf + row * 1024 + vcol0 + bj * HALF) = w; }
        EPI_ROWS_END
    }
};
struct EpiLora {
    static constexpr bool PERM = true, AFTER_DRAIN = false;
    bf16_t* ew; size_t stride; const float *w0, *a0;
    __device__ __forceinline__ void operator()(const f32x4 (&acc)[2][2][4][2], const Unit& u, int wr, int wc, int fr, int fq) const {
        const int sel = u.pn >> 2, row0 = u.pm * BM + wr * 64 + fr, col0 = (u.pn & 3) * 256 + wc * 32 + 8 * fq;
        bf16_t* dst = ew + (size_t)sel * stride;
        const float* bp = sel == 0 ? w0 : a0;
        f32x4 bv[2][2];
#pragma unroll
        for (int bj = 0; bj < 2; ++bj)
#pragma unroll
            for (int n = 0; n < 2; ++n) bv[bj][n] = (sel < 2) ? *(const f32x4*)(bp + col0 + bj * HALF + 4 * n) : (f32x4){0.f, 0.f, 0.f, 0.f};
        EPI_ROWS_BEGIN
            bf16_t* rowp = dst + row * 1024 + col0;
#pragma unroll
            for (int bj = 0; bj < 2; ++bj) { f32x4 v0 = acc[ai][bj][m][0] + bv[bj][0], v1 = acc[ai][bj][m][1] + bv[bj][1];
                if (sel < 2) { v0 = act4(v0, 2); v1 = act4(v1, 2); }
                if (sel == 0) { v0 = v0 * 0.60653066f; v1 = v1 * 0.60653066f; }
                *(u32x4*)(rowp + bj * HALF) = pk8(v0, v1); }
        EPI_ROWS_END
    }
};
struct EpiMv {
    static constexpr bool PERM = true, AFTER_DRAIN = false;
    bf16_t* zrkv; const bf16_t* vf; const float* v0b;
    __device__ __forceinline__ void operator()(const f32x4 (&acc)[2][2][4][2], const Unit& u, int wr, int wc, int fr, int fq) const {
        const int row0 = u.pm * BM + wr * 64 + fr, col0 = u.pn * 256 + wc * 32 + 8 * fq;
        f32x4 bv[2][2];
#pragma unroll
        for (int bj = 0; bj < 2; ++bj)
#pragma unroll
            for (int n = 0; n < 2; ++n) bv[bj][n] = *(const f32x4*)(v0b + col0 + bj * HALF + 4 * n);
        EPI_ROWS_BEGIN
#pragma unroll
            for (int bj = 0; bj < 2; ++bj) { bf16_t* zp = zrkv + row * 3072 + 2048 + col0 + bj * HALF;
                f32x4 z0, z1, f0, f1; unpk8(*(const u32x4*)zp, z0, z1); unpk8(*(const u32x4*)(vf + row * 1024 + col0 + bj * HALF), f0, f1);
                const f32x4 m0 = act4(acc[ai][bj][m][0] + bv[bj][0], 2), m1 = act4(acc[ai][bj][m][1] + bv[bj][1], 2);
                *(u32x4*)zp = pk8(z0 + (f0 - z0) * m0, z1 + (f1 - z1) * m1); }
        EPI_ROWS_END
    }
};
struct EpiPlain {
    static constexpr bool PERM = true, AFTER_DRAIN = false;
    bf16_t* o; int ld;
    __device__ __forceinline__ void operator()(const f32x4 (&acc)[2][2][4][2], const Unit& u, int wr, int wc, int fr, int fq) const {
        const int row0 = u.pm * BM + wr * 64 + fr, col0 = u.pn * 256 + wc * 32 + 8 * fq;
        EPI_ROWS_BEGIN
#pragma unroll
            for (int bj = 0; bj < 2; ++bj) *(u32x4*)(o + row * ld + col0 + bj * HALF) = pk8(acc[ai][bj][m][0], acc[ai][bj][m][1]);
        EPI_ROWS_END
    }
};
template <bool SECOND> struct EpiMerge {
    static constexpr bool PERM = true, AFTER_DRAIN = false;
    const bf16_t* sg; bf16_t* m2; bf16_t* o;
    __device__ __forceinline__ void operator()(const f32x4 (&acc)[2][2][4][2], const Unit& u, int wr, int wc, int fr, int fq) const {
        const int row0 = u.pm * BM + wr * 64 + fr, col0 = u.pn * 256 + wc * 32 + 8 * fq;
        EPI_ROWS_BEGIN
#pragma unroll
            for (int bj = 0; bj < 2; ++bj) { const int c = col0 + bj * HALF;
                f32x4 g0, g1; unpk8(*(const u32x4*)(sg + row * 2048 + (SECOND ? 0 : 1024) + c), g0, g1);
                f32x4 v0 = g0 * acc[ai][bj][m][0], v1 = g1 * acc[ai][bj][m][1];
                if (SECOND) { f32x4 p0, p1; unpk8(*(const u32x4*)(m2 + row * 2048 + c), p0, p1); v0 = v0 + p0; v1 = v1 + p1; *(u32x4*)(o + row * 1024 + c) = pk8(v0, v1); }
                else *(u32x4*)(m2 + row * 2048 + c) = pk8(v0, v1); }
        EPI_ROWS_END
    }
};
struct EpiResid {
    static constexpr bool PERM = false, AFTER_DRAIN = false;
    float* h;
    __device__ __forceinline__ void operator()(const f32x4 (&acc)[2][2][4][2], const Unit& u, int wr, int wc, int fr, int fq) const {
        const int row0 = u.pm * BM + wr * 64 + fr, col0 = u.pn * 256 + wc * 32 + 4 * fq;
        EPI_ROWS_BEGIN
            float* rowp = h + row * 1024 + col0;
#pragma unroll
            for (int bj = 0; bj < 2; ++bj)
#pragma unroll
                for (int n = 0; n < 2; ++n) { f32x4* p = (f32x4*)(rowp + bj * HALF + n * 16); *p = *p + acc[ai][bj][m][n]; }
        EPI_ROWS_END
    }
};
struct EpiQG {
    static constexpr bool PERM = true, AFTER_DRAIN = false;
    bf16_t* q; const bf16_t* pw; float* h;
    __device__ __forceinline__ void operator()(const f32x4 (&acc)[2][2][4][2], const Unit& u, int wr, int wc, int fr, int fq) const {
        const int row0 = u.pm * BM + wr * 64 + fr;
        if (u.pn < 8) { const int col0 = u.pn * 256 + wc * 32 + 8 * fq;
            EPI_ROWS_BEGIN
#pragma unroll
                for (int bj = 0; bj < 2; ++bj) *(u32x4*)(q + row * 2048 + col0 + bj * HALF) = pk8(acc[ai][bj][m][0], acc[ai][bj][m][1]);
            EPI_ROWS_END
        } else { const int col0 = (u.pn - 8) * 256 + wc * 32 + 8 * fq;
            EPI_ROWS_BEGIN
#pragma unroll
                for (int bj = 0; bj < 2; ++bj) { const int c = col0 + bj * HALF;
                    f32x4 p0, p1; unpk8(*(const u32x4*)(pw + row * 1024 + c), p0, p1);
                    f32x4* hp = (f32x4*)(h + row * 1024 + c);
                    hp[0] = hp[0] + p0 * act4(acc[ai][bj][m][0], 2); hp[1] = hp[1] + p1 * act4(acc[ai][bj][m][1], 2); }
            EPI_ROWS_END
        }
    }
};
template <class Epi, class Sched, bool ALIGN_EPI = false, bool SP2 = false>
__device__ __forceinline__ void gemm_phase(PG8_LAS unsigned char* lds, const Gemm g, const Sched& S, const Epi& E, const int wave0) {
    int tidq; asm volatile("v_mbcnt_lo_u32_b32 %0, -1, 0\n\tv_mbcnt_hi_u32_b32 %0, -1, %0" : "=v"(tidq)); tidq += wave0 * 64;
    const int tid = tidq, wid = __builtin_amdgcn_readfirstlane(tid >> 6), lane = tid & 63, wr = wid >> 2, wc = wid & 3, fr = lane & 15, fq = lane >> 4;
    int Kq = g.K, ldaq = g.lda; const bf16_t* gA = g.A; const bf16_t* gB = g.Bt; asm volatile("" : "+s"(Kq), "+s"(ldaq), "+s"(gA), "+s"(gB));
    const int K = Kq, nt = K / BK;
    unsigned voffA[2], voffB[2];
#pragma unroll
    for (int i = 0; i < 2; ++i) { int R, C; stage_rc(tid * 16 + i * 8192, R, C); const int Rb = Epi::PERM ? ((R & ~31) + perm32(R & 31)) : R;
        voffA[i] = (unsigned)(R * ldaq + C) * 2u; voffB[i] = (unsigned)(Rb * K + C) * 2u; }
    const size_t kstep = (size_t)(BK * 2);
    const size_t hstepA = (size_t)HALF * ldaq * 2, hstepB = (size_t)HALF * K * 2;
    const size_t tstepA = 2 * hstepA, tstepB = 2 * hstepB;
    const unsigned ldsw = (unsigned)wid * 1024u;
    const int aoff = lds_byte(wr * 64 + fr, fq * 8), boff = lds_byte(wc * 32 + fr, fq * 8);
#define PG8_SA(b, h) (((b) * 2 + (h)) * HTB)
#define PG8_SB(b, h) ((4 + (b) * 2 + (h)) * HTB)
#define PG8_STAGE(bufoff, gbase, voff) do { _Pragma("unroll") for (int _i = 0; _i < 2; ++_i) \
        __builtin_amdgcn_global_load_lds((const unsigned*)((const char*)(gbase) + (voff)[_i]), (PG8_LAS unsigned*)(lds + (bufoff) + ldsw + _i * 8192), 16, 0, 0); } while (0)
#define PG8_LDA(dst, b, h) do { _Pragma("unroll") for (int m = 0; m < 4; ++m) _Pragma("unroll") for (int k = 0; k < 2; ++k) dst[m][k] = *(const PG8_LAS bf16x8*)(lds + PG8_SA(b, h) + aoff + m * 2048 + k * 1024); } while (0)
#define PG8_LDB(dst, b, h) do { _Pragma("unroll") for (int n = 0; n < 2; ++n) _Pragma("unroll") for (int k = 0; k < 2; ++k) dst[n][k] = *(const PG8_LAS bf16x8*)(lds + PG8_SB(b, h) + boff + n * 2048 + k * 1024); } while (0)
#define PG8_MMA(ai, bj, At, Bt) do { __builtin_amdgcn_s_setprio(1); _Pragma("unroll") for (int m = 0; m < 4; ++m) _Pragma("unroll") for (int n = 0; n < 2; ++n) _Pragma("unroll") for (int k = 0; k < 2; ++k) \
        acc[ai][bj][m][n] = __builtin_amdgcn_mfma_f32_16x16x32_bf16(Bt[n][k], At[m][k], acc[ai][bj][m][n], 0, 0, 0); __builtin_amdgcn_s_setprio(0); } while (0)
#define PG8_WAIT_V(n) asm volatile("s_waitcnt vmcnt(" #n ")" ::: "memory")
#define PG8_WAIT_L(n) asm volatile("s_waitcnt lgkmcnt(" #n ")" ::: "memory")
#define PG8_BAR __builtin_amdgcn_s_barrier()
#define PG8_SCHED __builtin_amdgcn_sched_barrier(0)
    Unit cur, nxt; int ui = 0;
    if (!S.next(0, cur)) return;
    f32x4 acc[2][2][4][2];
#pragma unroll
    for (int a = 0; a < 2; ++a)
#pragma unroll
        for (int b = 0; b < 2; ++b)
#pragma unroll
            for (int m = 0; m < 4; ++m)
#pragma unroll
                for (int n = 0; n < 2; ++n) acc[a][b][m][n] = (f32x4){0.f, 0.f, 0.f, 0.f};
    bf16x8 At[4][2], B0[2][2], B1[2][2];
    const char* cA = (const char*)gA + (size_t)cur.pm * tstepA; const char* cB = (const char*)gB + (size_t)cur.pn * tstepB;
    S.a_ready(cur);
    if constexpr (SP2) {
        PG8_STAGE(PG8_SB(0, 0), cB, voffB); PG8_STAGE(PG8_SB(0, 1), cB + hstepB, voffB); PG8_STAGE(PG8_SA(0, 0), cA, voffA); PG8_STAGE(PG8_SA(0, 1), cA + hstepA, voffA);
        if (wr == 1) PG8_BAR;
        PG8_WAIT_V(2); PG8_BAR;
        PG8_STAGE(PG8_SB(1, 0), cB + kstep, voffB); PG8_STAGE(PG8_SA(1, 0), cA + kstep, voffA); PG8_STAGE(PG8_SB(1, 1), cB + hstepB + kstep, voffB);
        PG8_WAIT_V(6); PG8_BAR;
    } else {
        PG8_STAGE(PG8_SB(0, 0), cB, voffB); PG8_STAGE(PG8_SA(0, 0), cA, voffA); PG8_STAGE(PG8_SB(0, 1), cB + hstepB, voffB); PG8_STAGE(PG8_SA(0, 1), cA + hstepA, voffA);
        if (wr == 1) PG8_BAR;
        PG8_WAIT_V(4); PG8_BAR;
        PG8_STAGE(PG8_SB(1, 0), cB + kstep, voffB); PG8_STAGE(PG8_SA(1, 0), cA + kstep, voffA); PG8_STAGE(PG8_SB(1, 1), cB + hstepB + kstep, voffB);
        PG8_WAIT_V(6); PG8_BAR;
    }
    for (;;) {
        const bool has_next = S.next(ui + 1, nxt);
        const char* nA = has_next ? (const char*)gA + (size_t)nxt.pm * tstepA : cA; const char* nB = has_next ? (const char*)gB + (size_t)nxt.pn * tstepB : cB;
        for (int t = 0; t < nt; t += 2) {
            const bool last = (t == nt - 2);
            const char* a1 = cA + (size_t)(t + 1) * kstep;
            const char* a2 = last ? nA : cA + (size_t)(t + 2) * kstep; const char* b2 = last ? nB : cB + (size_t)(t + 2) * kstep;
            const char* a3 = a2 + kstep; const char* b3 = b2 + kstep;
            if (last && has_next) S.a_ready(nxt);
            if constexpr (SP2) {
            PG8_LDB(B0, 0, 0); PG8_LDB(B1, 0, 1); PG8_SCHED; PG8_LDA(At, 0, 0); PG8_STAGE(PG8_SA(1, 1), a1 + hstepA, voffA);
            PG8_WAIT_V(8); PG8_WAIT_L(0); PG8_BAR; PG8_MMA(0, 0, At, B0); PG8_MMA(0, 1, At, B1); PG8_BAR; PG8_SCHED;
            PG8_LDA(At, 0, 1); PG8_STAGE(PG8_SB(0, 0), b2, voffB); PG8_STAGE(PG8_SB(0, 1), b2 + hstepB, voffB); PG8_STAGE(PG8_SA(0, 0), a2, voffA);
            PG8_WAIT_V(8); PG8_WAIT_L(0); PG8_BAR; PG8_MMA(1, 0, At, B0); PG8_MMA(1, 1, At, B1); PG8_BAR; PG8_SCHED;
            PG8_LDB(B0, 1, 0); PG8_LDB(B1, 1, 1); PG8_SCHED; PG8_LDA(At, 1, 0); PG8_STAGE(PG8_SA(0, 1), a2 + hstepA, voffA);
            PG8_WAIT_V(8); PG8_WAIT_L(0); PG8_BAR; PG8_MMA(0, 0, At, B0); PG8_MMA(0, 1, At, B1); PG8_BAR; PG8_SCHED;
            PG8_LDA(At, 1, 1); PG8_STAGE(PG8_SB(1, 0), b3, voffB); PG8_STAGE(PG8_SB(1, 1), b3 + hstepB, voffB); PG8_STAGE(PG8_SA(1, 0), a3, voffA);
            PG8_WAIT_V(8); PG8_WAIT_L(0); PG8_BAR; PG8_MMA(1, 0, At, B0); PG8_MMA(1, 1, At, B1); PG8_BAR; PG8_SCHED;
            } else {
            PG8_LDB(B0, 0, 0); PG8_SCHED; PG8_LDA(At, 0, 0); PG8_STAGE(PG8_SA(1, 1), a1 + hstepA, voffA);
            PG8_WAIT_L(8); PG8_BAR; PG8_WAIT_L(0); PG8_MMA(0, 0, At, B0); PG8_BAR; PG8_SCHED;
            PG8_LDB(B1, 0, 1); PG8_STAGE(PG8_SB(0, 0), b2, voffB);
            PG8_BAR; PG8_WAIT_L(0); PG8_MMA(0, 1, At, B1); PG8_BAR;
            PG8_LDA(At, 0, 1); PG8_STAGE(PG8_SA(0, 0), a2, voffA);
            PG8_BAR; PG8_WAIT_L(0); PG8_MMA(1, 0, At, B0); PG8_BAR; PG8_SCHED;
            PG8_STAGE(PG8_SB(0, 1), b2 + hstepB, voffB);
            PG8_WAIT_V(6); PG8_BAR; PG8_MMA(1, 1, At, B1); PG8_BAR;
            PG8_LDB(B0, 1, 0); PG8_SCHED; PG8_LDA(At, 1, 0); PG8_STAGE(PG8_SA(0, 1), a2 + hstepA, voffA);
            PG8_WAIT_L(8); PG8_BAR; PG8_WAIT_L(0); PG8_MMA(0, 0, At, B0); PG8_BAR; PG8_SCHED;
            PG8_LDB(B1, 1, 1); PG8_STAGE(PG8_SB(1, 0), b3, voffB);
            PG8_BAR; PG8_WAIT_L(0); PG8_MMA(0, 1, At, B1); PG8_BAR;
            PG8_LDA(At, 1, 1); PG8_STAGE(PG8_SA(1, 0), a3, voffA);
            PG8_BAR; PG8_WAIT_L(0); PG8_MMA(1, 0, At, B0); PG8_BAR; PG8_SCHED;
            PG8_STAGE(PG8_SB(1, 1), b3 + hstepB, voffB);
            PG8_WAIT_V(6); PG8_BAR; PG8_MMA(1, 1, At, B1); PG8_BAR;
            }
        }
        if constexpr (ALIGN_EPI) { if (wr == 0) PG8_BAR; }
        if constexpr (!Epi::AFTER_DRAIN) { E(acc, cur, wr, wc, fr, fq); S.done(cur); }
        if (!has_next) break;
#pragma unroll
        for (int a = 0; a < 2; ++a)
#pragma unroll
            for (int b = 0; b < 2; ++b)
#pragma unroll
                for (int m = 0; m < 4; ++m)
#pragma unroll
                    for (int n = 0; n < 2; ++n) acc[a][b][m][n] = (f32x4){0.f, 0.f, 0.f, 0.f};
        cur = nxt; cA = nA; cB = nB; ++ui;
        if constexpr (ALIGN_EPI) { if (wr == 1) PG8_BAR; }
    }
    PG8_WAIT_V(0);
    if constexpr (!ALIGN_EPI) { if (wr == 0) PG8_BAR; }
    PG8_BAR;
    if constexpr (Epi::AFTER_DRAIN) { E.fused(acc, cur, wr, wc, fr, fq, lds, wid, lane); S.done(cur); }
#undef PG8_SA
#undef PG8_SB
#undef PG8_STAGE
#undef PG8_LDA
#undef PG8_LDB
#undef PG8_MMA
#undef PG8_WAIT_V
#undef PG8_WAIT_L
#undef PG8_BAR
#undef PG8_SCHED
}
}

constexpr int NB = 8, SEQ = 4096, T = NB * SEQ, D = 1024, DEPTH = 4, NZ = 7680, NWAVES = 8;
constexpr int CIN = 7424;
constexpr size_t MiB = 1u << 20;
constexpr size_t WS_CTL = 0, WS_LORA = 1 * MiB, WS_MV = 7 * MiB, ZERO_BYTES = 9 * MiB;
constexpr size_t LORA_BYTES = 3072 * 256 * 2, MV_BYTES = 1024 * 256 * 2;
constexpr size_t WS_WIN = 10 * MiB;
constexpr size_t WS_DB = 40 * MiB, DB_SET = 62 * MiB;
constexpr size_t DB_PA = 0, DB_PBT = 2 * MiB, DB_POUT = 4 * MiB, DB_WQG = 6 * MiB, DB_KEYS = 12 * MiB, DB_GMW = 12 * MiB + 512 * 1024, DB_PLEW = 13 * MiB, DB_U = 14 * MiB, DB_V = 30 * MiB, DB_PB = 46 * MiB;
constexpr size_t WS_VF = 164 * MiB, WS_PW = 228 * MiB, WS_NX = 292 * MiB, WS_ZRKV = 420 * MiB, WS_ZL = 612 * MiB, WS_GUV = 644 * MiB, WS_SG = 772 * MiB;
constexpr size_t WS_EW = 900 * MiB, WS_AR = 964 * MiB, WS_G = 1028 * MiB, WS_END = 1092 * MiB;
constexpr size_t WS_YAB = WS_NX, WS_Q = WS_ZRKV, WS_SEL = WS_ZRKV + 128 * MiB, WS_MG = WS_AR, WS_N2 = WS_G;
constexpr size_t WIN_ZERO_OFF = WS_WIN + (size_t)3328 * 2048 * 2, WIN_ZERO_BYTES = (size_t)256 * 2048 * 2;
constexpr int CW_BAR = 4096;
constexpr int RING_BYTES = 131072, LDSCTL_OFF = RING_BYTES, MISC_OFF = LDSCTL_OFF + 320, LDS_BYTES = 147456;

#define LAS __attribute__((address_space(3)))
#define GAS __attribute__((address_space(1)))
typedef unsigned short bf16;
typedef unsigned v4u __attribute__((ext_vector_type(4)));
typedef unsigned v2u __attribute__((ext_vector_type(2)));
typedef float f32x4 __attribute__((ext_vector_type(4)));
typedef float f32x2 __attribute__((ext_vector_type(2)));
typedef short bf16x8 __attribute__((ext_vector_type(8)));
using pg8::fsig; using pg8::fgelu; using pg8::bflo; using pg8::bfhi; using pg8::unpk8; using pg8::pk8; using pg8::cvt_pk_bf16;

#define XB_TMO      128
#define XB_XCNT(j)  (256  + 64 * (j))
#define XB_XSUB(j)  (1280 + 64 * (j))
#define XB_XGEN(j)  (2304 + 64 * (j))
#define XB_TOP      3328
#define XB_TOPGEN   3392
#define XCD_BAR_WORDS 3456
#define XB_SPIN_CAP (1u << 22)

__device__ __forceinline__ unsigned xb_ld(unsigned* p)              { return __hip_atomic_load(p, __ATOMIC_RELAXED, __HIP_MEMORY_SCOPE_AGENT); }
__device__ __forceinline__ unsigned xb_add(unsigned* p, unsigned v) { return __hip_atomic_fetch_add(p, v, __ATOMIC_RELAXED, __HIP_MEMORY_SCOPE_AGENT); }
__device__ __forceinline__ unsigned xb_xcc_id() { return (unsigned)__builtin_amdgcn_s_getreg((3 << 11) | 20) & 0xFu; }
#define XB_SPIN(cond, bar) do { unsigned _sp = 0; while (cond) { __builtin_amdgcn_s_sleep(1); \
    if ((++_sp & 255u) == 0u) { if (xb_ld(&(bar)[XB_TMO])) break; if (_sp > XB_SPIN_CAP) { atomicAdd(&(bar)[XB_TMO], 1u); break; } } } } while (0)

struct XcdBarrier { unsigned* bar; unsigned x; volatile LAS unsigned* st; };

__device__ __forceinline__ XcdBarrier xcd_barrier_post(unsigned* bar, volatile LAS unsigned* st) {
    XcdBarrier b; b.bar = bar; b.x = xb_xcc_id(); b.st = st;
    if (threadIdx.x == 0) (void)xb_add(&bar[XB_XCNT(b.x)], 1u);
    return b;
}
__device__ __forceinline__ void xcd_barrier_complete(unsigned* bar, unsigned x, unsigned& nloc, unsigned& nx) {
    const unsigned G = gridDim.x * gridDim.y * gridDim.z;
    unsigned sum, cnt, mine, sp = 0u;
    for (;;) {
        sum = 0u; cnt = 0u; mine = 0u;
#pragma unroll
        for (unsigned j = 0; j < 16; ++j) { const unsigned c = xb_ld(&bar[XB_XCNT(j)]); sum += c; cnt += (c > 0u) ? 1u : 0u; mine = (j == x) ? c : mine; }
        if (sum == G) break;
        __builtin_amdgcn_s_sleep(1);
        if ((++sp & 255u) == 0u) { if (xb_ld(&bar[XB_TMO])) break; if (sp > XB_SPIN_CAP) { atomicAdd(&bar[XB_TMO], 1u); break; } }
    }
    nloc = mine > 0u ? mine : 1u; nx = cnt > 0u ? cnt : 1u;
}
__device__ __forceinline__ int lane_id_now();
__device__ __forceinline__ void xcd_barrier(const XcdBarrier& b, const int wave0) {
    asm volatile("s_waitcnt vmcnt(0)" ::: "memory");
    __syncthreads();
    if (wave0 == 0 && lane_id_now() == 0) {
        unsigned* bar = b.bar;
        __builtin_amdgcn_s_waitcnt(0);
        unsigned nloc = b.st[0], nx = b.st[1];
        if (nloc == 0u) { xcd_barrier_complete(bar, b.x, nloc, nx); b.st[0] = nloc; b.st[1] = nx; }
        const unsigned old = xb_add(&bar[XB_XSUB(b.x)], 1u);
        const unsigned gen = old / nloc;
        if (old + 1u == (gen + 1u) * nloc) {
            __builtin_amdgcn_fence(__ATOMIC_RELEASE, "agent");
            asm volatile("s_waitcnt vmcnt(0)" ::: "memory");
            const unsigned og = xb_add(&bar[XB_TOP], 1u);
            const unsigned tg = og / nx;
            if (og + 1u == (tg + 1u) * nx) xb_add(&bar[XB_TOPGEN], 1u);
            else XB_SPIN(xb_ld(&bar[XB_TOPGEN]) == tg, bar);
            __builtin_amdgcn_fence(__ATOMIC_ACQUIRE, "agent");
            xb_add(&bar[XB_XGEN(b.x)], 1u);
            asm volatile("s_waitcnt vmcnt(0)" ::: "memory");
        } else {
            XB_SPIN(xb_ld(&bar[XB_XGEN(b.x)]) == gen, bar);
            __builtin_amdgcn_fence(__ATOMIC_ACQUIRE, "agent");
            asm volatile("s_waitcnt vmcnt(0)" ::: "memory");
        }
    }
    __syncthreads();
}

struct Args { const float* in[32]; float* out; unsigned char* ws; };
struct Frame {
    LAS unsigned char* lds;
    int tid, lane, wave, G, bx, wave0;
    GAS unsigned char* ws; float* h;
};
__device__ __forceinline__ int lane_id_now() { int l; asm volatile("v_mbcnt_lo_u32_b32 %0, -1, 0\n\tv_mbcnt_hi_u32_b32 %0, -1, %0" : "=v"(l)); return l; }
__device__ __forceinline__ void phase_ids(Frame& F) { const int l = lane_id_now(); F.lane = l; F.wave = F.wave0; F.tid = F.wave0 * 64 + l; GAS unsigned char* w = F.ws; asm volatile("" : "+s"(w)); F.ws = w; }
#define DPP_ADD(x, ctrl) ((x) + __builtin_bit_cast(float, __builtin_amdgcn_update_dpp(0, __builtin_bit_cast(int, (x)), (ctrl), 0xf, 0xf, false)))
__device__ __forceinline__ float sum8(float v) {
    v = DPP_ADD(v, 0xB1);
    v = DPP_ADD(v, 0x4E);
    v = DPP_ADD(v, 0x141);
    return v;
}
__device__ __forceinline__ float wave_sum(float v) {
    v = sum8(v);
    v = DPP_ADD(v, 0x140);
    const auto r = __builtin_amdgcn_permlane16_swap(__builtin_bit_cast(unsigned, v), __builtin_bit_cast(unsigned, v), false, false);
    v = __builtin_bit_cast(float, (unsigned)r[0]) + __builtin_bit_cast(float, (unsigned)r[1]);
    const auto q = __builtin_amdgcn_permlane32_swap(__builtin_bit_cast(unsigned, v), __builtin_bit_cast(unsigned, v), false, false);
    return __builtin_bit_cast(float, (unsigned)q[0]) + __builtin_bit_cast(float, (unsigned)q[1]);
}
__device__ __forceinline__ unsigned xor16_u(unsigned x, int lane) { const auto r = __builtin_amdgcn_permlane16_swap(x, x, false, false); return (lane & 16) ? (unsigned)r[0] : (unsigned)r[1]; }
__device__ __forceinline__ unsigned xor32_u(unsigned x, int lane) { const auto r = __builtin_amdgcn_permlane32_swap(x, x, false, false); return (lane & 32) ? (unsigned)r[0] : (unsigned)r[1]; }
__device__ __forceinline__ void tr_item(const float* W, int ldw, int ncols, bf16* WT, int ldt, int koff, int row_off, LAS float* scr, int item, int lane) {
    const int nblk = ncols / 32, kb = item / nblk, nb = item % nblk, k0 = 64 * kb, n0 = 32 * nb;
#pragma unroll 8
    for (int i = 0; i < 32; ++i) { const int kk = 2 * i + (lane >> 5); scr[kk * 33 + (lane & 31)] = W[(size_t)(k0 + kk) * ldw + n0 + (lane & 31)]; }
    asm volatile("s_waitcnt lgkmcnt(0)" ::: "memory");
    const int c = lane & 7;
#pragma unroll
    for (int j = 0; j < 4; ++j) { const int n = (lane >> 3) + 8 * j; const LAS float* s = scr + (8 * c) * 33 + n;
        v4u o; o.x = cvt_pk_bf16(s[0 * 33], s[1 * 33]); o.y = cvt_pk_bf16(s[2 * 33], s[3 * 33]); o.z = cvt_pk_bf16(s[4 * 33], s[5 * 33]); o.w = cvt_pk_bf16(s[6 * 33], s[7 * 33]);
        *(v4u*)(WT + (size_t)(row_off + n0 + n) * ldt + koff + k0 + 8 * c) = o; }
    asm volatile("s_waitcnt lgkmcnt(0)" ::: "memory");
}
__device__ __forceinline__ void cvt_chunk(const float* src, bf16* dst, size_t chunk, int lane) {
    const f32x4* s = (const f32x4*)(src + chunk * 512) + lane * 2; const f32x4 a = s[0], b = s[1];
    *(v4u*)(dst + chunk * 512 + lane * 8) = pk8(a, b);
}
__device__ __forceinline__ void cvt8_chunk(const float* src, unsigned char* dst, size_t chunk, int lane, float sc) {
    const f32x4* s = (const f32x4*)(src + chunk * 512) + lane * 2; const f32x4 a = s[0] * sc, b = s[1] * sc;
    int w0 = 0, w1 = 0;
    w0 = __builtin_amdgcn_cvt_pk_fp8_f32(a.x, a.y, w0, false); w0 = __builtin_amdgcn_cvt_pk_fp8_f32(a.z, a.w, w0, true);
    w1 = __builtin_amdgcn_cvt_pk_fp8_f32(b.x, b.y, w1, false); w1 = __builtin_amdgcn_cvt_pk_fp8_f32(b.z, b.w, w1, true);
    *(v2u*)(dst + chunk * 512 + lane * 8) = (v2u){(unsigned)w0, (unsigned)w1};
}
__device__ __forceinline__ void norm_row_nx(const float* hrow, float* hcopy, const float* g, bf16* NX, int t, int lane) {
    const f32x4* xr = (const f32x4*)hrow + lane; f32x4 v[4]; float s = 0.f;
#pragma unroll
    for (int j = 0; j < 4; ++j) { v[j] = xr[64 * j]; s += (v[j].x * v[j].x + v[j].y * v[j].y) + (v[j].z * v[j].z + v[j].w * v[j].w); }
    if (hcopy) {
#pragma unroll
        for (int j = 0; j < 4; ++j) ((f32x4*)hcopy)[lane + 64 * j] = v[j]; }
    const float rstd = 1.f / sqrtf(wave_sum(s) * (1.f / D) + 1e-6f);
    const int tt = t & (SEQ - 1);
#pragma unroll
    for (int j = 0; j < 4; ++j) { const f32x4 gv = ((const f32x4*)g)[lane + 64 * j]; const f32x4 o = v[j] * rstd * gv;
        v2u w; w.x = cvt_pk_bf16(o.x, o.y); w.y = cvt_pk_bf16(o.z, o.w);
        const int c = 4 * (lane + 64 * j);
        *(v2u*)(NX + (size_t)t * 2048 + c) = w;
        if (tt != SEQ - 1) *(v2u*)(NX + (size_t)(t + 1) * 2048 + 1024 + c) = w;
        if (tt == 0) *(v2u*)(NX + (size_t)t * 2048 + 1024 + c) = (v2u){0u, 0u}; }
}
__device__ __forceinline__ void norm_row_n2(const float* hrow, const float* g, bf16* N2row, int lane) {
    const f32x4* xr = (const f32x4*)hrow + lane; f32x4 v[4]; float s = 0.f;
#pragma unroll
    for (int j = 0; j < 4; ++j) { v[j] = xr[64 * j]; s += (v[j].x * v[j].x + v[j].y * v[j].y) + (v[j].z * v[j].z + v[j].w * v[j].w); }
    const float rstd = 1.f / sqrtf(wave_sum(s) * (1.f / D) + 1e-6f);
#pragma unroll
    for (int j = 0; j < 4; ++j) { const f32x4 gv = ((const f32x4*)g)[lane + 64 * j]; const f32x4 o = v[j] * rstd * gv;
        v2u w; w.x = cvt_pk_bf16(o.x, o.y); w.y = cvt_pk_bf16(o.z, o.w);
        *(v2u*)(N2row + 4 * (lane + 64 * j)) = w; }
}

__device__ __forceinline__ void prep_phase(Frame& F, const Args& a, int layer, int blk, int nblk_) {
    phase_ids(F);
    LAS float* scr = (LAS float*)(F.lds + F.wave * 16384);
    const int gw = blk * NWAVES + F.wave, NGW = nblk_ * NWAVES, lane = F.lane;
    GAS unsigned char* ws = F.ws; GAS unsigned char* db = F.ws + WS_DB + (size_t)(layer & 1) * DB_SET;
    bf16* WIN = (bf16*)(ws + WS_WIN); bf16* LORA = (bf16*)(ws + WS_LORA + (size_t)layer * LORA_BYTES); bf16* MVT = (bf16*)(ws + WS_MV + (size_t)(layer > 0 ? layer - 1 : 0) * MV_BYTES);
    const float* w_in = a.in[5] + (size_t)layer * 2048 * CIN;
    const int mvn = layer > 0 ? 32 : 0;
    const int c1 = 32 * 104, c2 = 32 * 128, c3 = mvn, c4 = 32, c5 = 32, c6 = 64, c7 = 512, c10 = 1024, c12 = 128;
    const int total = c1 + c2 + c3 + c4 + c5 + c6 + 3 * c7 + c10 + c7 + c12;
    for (int it = gw; it < total; it += NGW) {
        int r = it;
        if (r < c1) { tr_item(w_in, CIN, 3328, WIN, 2048, 0, 0, scr, r, lane); continue; } r -= c1;
        if (r < c2) { tr_item(w_in + 3328, CIN, 4096, WIN, 2048, 0, 3584, scr, r, lane); continue; } r -= c2;
        if (r < c3) { tr_item(a.in[16] + (size_t)(layer - 1) * 2048 * 32, 32, 32, WIN, 2048, 0, 3328, scr, r, lane); continue; } r -= c3;
        if (r < c4) { tr_item(a.in[7] + (size_t)layer * 64 * 1024, 1024, 1024, LORA, 256, 0, 0, scr, r, lane); continue; } r -= c4;
        if (r < c5) { tr_item(a.in[9] + (size_t)layer * 64 * 1024, 1024, 1024, LORA, 256, 64, 1024, scr, r, lane); continue; } r -= c5;
        if (r < c6) { tr_item(a.in[10] + (size_t)layer * 128 * 1024, 1024, 1024, LORA, 256, 128, 2048, scr, r, lane); continue; } r -= c6;
        if (r < c7) { tr_item(a.in[23] + (size_t)layer * D * D, D, D, (bf16*)(db + DB_PA), D, 0, 0, scr, r, lane); continue; } r -= c7;
        if (r < c7) { tr_item(a.in[24] + (size_t)layer * D * D, D, D, (bf16*)(db + DB_PBT), D, 0, 0, scr, r, lane); continue; } r -= c7;
        if (r < c7) { tr_item(a.in[25] + (size_t)layer * D * D, D, D, (bf16*)(db + DB_POUT), D, 0, 0, scr, r, lane); continue; } r -= c7;
        if (r < c10) { tr_item(a.in[26] + (size_t)layer * D * 2048, 2048, 2048, (bf16*)(db + DB_WQG), D, 0, 0, scr, r, lane); continue; } r -= c10;
        if (r < c7) { tr_item(a.in[31] + (size_t)layer * D * D, D, D, (bf16*)(db + DB_WQG), D, 0, 2048, scr, r, lane); continue; } r -= c7;
        tr_item(a.in[30] + (size_t)layer * 256 * D, D, D, (bf16*)(db + DB_PLEW), 256, 0, 0, scr, r, lane);
    }
    if (layer > 0) {
        const float* w2 = a.in[17] + (size_t)(layer - 1) * 32 * 1024;
        for (int it = gw; it < 512; it += NGW) { const int e = it * 64 + lane, n = e >> 5, k = e & 31; MVT[n * 256 + k] = (bf16)(cvt_pk_bf16(w2[k * 1024 + n], 0.f) & 0xffffu); }
    }
    {
        const float* keys = a.in[27] + (size_t)layer * 262144; const float* ut = a.in[28] + (size_t)layer * 16777216; const float* vt = a.in[29] + (size_t)layer * 16777216;
        const float* pin = a.in[1] + (size_t)layer * T * 256; const float* gws = a.in[21] + (size_t)layer * 131072;
        const int n1 = 512, n2 = 32768, n4 = 16384, n5 = 256, ntot = n1 + 2 * n2 + n4 + n5;
        for (int it = gw; it < ntot; it += NGW) {
            int r = it;
            if (r < n2) { cvt8_chunk(ut, (unsigned char*)(db + DB_U), r, lane, 256.f); continue; } r -= n2;
            if (r < n2) { cvt8_chunk(vt, (unsigned char*)(db + DB_V), r, lane, 64.f); continue; } r -= n2;
            if (r < n4) { cvt_chunk(pin, (bf16*)(db + DB_PB), r, lane); continue; } r -= n4;
            if (r < n1) { cvt_chunk(keys, (bf16*)(db + DB_KEYS), r, lane); continue; } r -= n1;
            {
                const int e0 = r * 512 + lane * 8, tq = (e0 >> 7) & 127, p0 = e0 & 127;
                const f32x4* s = (const f32x4*)(gws + e0); f32x4 x0 = s[0], x1 = s[1];
#pragma unroll
                for (int j = 0; j < 4; ++j) { if (p0 + j > tq) x0[j] = 0.f; if (p0 + 4 + j > tq) x1[j] = 0.f; }
                *(v4u*)((bf16*)(db + DB_GMW) + e0) = pk8(x0, x1);
            }
        }
    }
    if (layer == 0) {
        for (int m = gw; m < T; m += NGW) norm_row_nx(a.in[0] + (size_t)m * D, F.h + (size_t)m * D, a.in[2], (bf16*)(ws + WS_NX), m, lane);
    }
}

constexpr int SC = 32;
constexpr int SC_VEC = SC * 64;
constexpr int SC_V = SC_VEC, SC_BK = 2 * SC_VEC, SC_XA = SC_BK + SC * 64, SC_C = SC_XA + SC * 64, SC_BON = SC_C + SC * 4, SC_BUF = SC_BON + SC * 8;
struct ScanOps { f32x4 w[4], c; v4u bk; bf16x8 x[2]; float v; };
__device__ __forceinline__ void scan_load2(ScanOps& o, const LAS float* buf, const LAS float* vbuf, const LAS unsigned char* bkp, int bkstep, int s, int lane) {
    const int q = lane >> 4;
    const LAS float* p = buf + s * 64 + q * 4;
#pragma unroll
    for (int i = 0; i < 4; ++i) o.w[i] = *(const LAS f32x4*)(p + 16 * i);
    o.v = vbuf[SC_V + s * 64 + (lane & 15)];
    o.bk = *(const LAS v4u*)(bkp + s * bkstep);
    const LAS unsigned char* xp = (const LAS unsigned char*)(buf + SC_XA) + s * 256 + (lane & 1) * 128 + q * 16;
    o.x[0] = *(const LAS bf16x8*)xp; o.x[1] = *(const LAS bf16x8*)(xp + 64);
    o.c = *(const LAS f32x4*)(buf + SC_C + s * 4);
}
__device__ __forceinline__ float smul(float a, float b) { float r; asm("v_mul_f32 %0, %1, %2" : "=v"(r) : "v"(a), "v"(b)); return r; }
__device__ __forceinline__ void scan_step(const ScanOps& o, f32x4 (&St)[4], float& sa, v4u (&am)[4], v4u& bm, LAS float* ypt, unsigned m16) {
    v4u s0, s1;
    s0.x = cvt_pk_bf16(St[0].x, St[0].y); s0.y = cvt_pk_bf16(St[0].z, St[0].w); s0.z = cvt_pk_bf16(St[1].x, St[1].y); s0.w = cvt_pk_bf16(St[1].z, St[1].w);
    s1.x = cvt_pk_bf16(St[2].x, St[2].y); s1.y = cvt_pk_bf16(St[2].z, St[2].w); s1.z = cvt_pk_bf16(St[3].x, St[3].y); s1.w = cvt_pk_bf16(St[3].z, St[3].w);
    f32x4 dv = (f32x4){0.f, 0.f, 0.f, 0.f};
    dv = __builtin_amdgcn_mfma_f32_16x16x32_bf16(o.x[0], __builtin_bit_cast(bf16x8, s0), dv, 0, 0, 0);
    dv = __builtin_amdgcn_mfma_f32_16x16x32_bf16(o.x[1], __builtin_bit_cast(bf16x8, s1), dv, 0, 0, 0);
    bm.x = cvt_pk_bf16(sa, o.v) & m16;
#pragma unroll
    for (int i = 0; i < 4; ++i) { am[i].x = o.bk[i];
        St[i] = __builtin_amdgcn_mfma_f32_16x16x32_bf16(__builtin_bit_cast(bf16x8, am[i]), __builtin_bit_cast(bf16x8, bm), (f32x4){smul(St[i].x, o.w[i].x), smul(St[i].y, o.w[i].y), smul(St[i].z, o.w[i].z), smul(St[i].w, o.w[i].w)}, 0, 0, 0); }
    *ypt = dv.y + sa * o.c.z + o.v * o.c.w;
    sa = dv.x + sa * o.c.x + o.v * o.c.y;
}
__device__ __forceinline__ void scan_unit(Frame& F, const Args& a, int layer, int unit) {
    phase_ids(F);
    const int b = unit >> 4, hh = unit & 15, tid = F.tid, lane = F.lane, wave = F.wave;
    LAS float* bufs = (LAS float*)F.lds;
    LAS float* sY = bufs + 2 * SC_BUF;
    const bf16* ZR = (const bf16*)(F.ws + WS_ZRKV); const bf16* EW = (const bf16*)(F.ws + WS_EW); const bf16* AR = (const bf16*)(F.ws + WS_AR); const bf16* GT = (const bf16*)(F.ws + WS_G);
    bf16* YAB = (bf16*)(F.ws + WS_YAB);
    constexpr int NCH = SEQ / SC;
    if (wave < 4) {
        f32x4 St[4]; v4u am[4], bm = (v4u){0u, 0u, 0u, 0u};
#pragma unroll
        for (int i = 0; i < 4; ++i) { St[i] = (f32x4){0.f, 0.f, 0.f, 0.f}; am[i] = (v4u){0u, 0u, 0u, 0u}; }
        float sa = 0.f;
        const unsigned m16 = lane < 16 ? 0xffffffffu : 0u;
        LAS unsigned char* zblk = (LAS unsigned char*)(sY + 2 * SC_VEC);
        if (tid < 4) ((LAS unsigned*)zblk)[tid] = 0u;
        const int bkstep = lane < 16 ? 256 : 0;
        for (int it = 0; it < NCH + 2; ++it) {
            if (it >= 1 && it <= NCH) {
                const LAS float* bufc = bufs + ((it - 1) & 1) * SC_BUF;
                const LAS float* vbuf = bufc + wave * 16;
                const LAS unsigned char* bkp = lane < 16 ? (const LAS unsigned char*)(bufc + SC_BK) + lane * 16 : (const LAS unsigned char*)zblk;
                LAS float* yb = lane < 16 ? sY + ((it - 1) & 1) * SC_VEC + wave * 16 + lane : (LAS float*)(zblk + 16) - 0;
                const int ystep = lane < 16 ? 64 : 0;
                ScanOps o0, o1;
                scan_load2(o0, bufc, vbuf, bkp, bkstep, 0, lane);
#pragma unroll 1
                for (int s = 0; s < SC; s += 2) {
                    scan_load2(o1, bufc, vbuf, bkp, bkstep, s + 1, lane);
                    scan_step(o0, St, sa, am, bm, yb + s * ystep, m16);
                    if (s + 2 < SC) scan_load2(o0, bufc, vbuf, bkp, bkstep, s + 2, lane);
                    scan_step(o1, St, sa, am, bm, yb + (s + 1) * ystep, m16);
                }
            }
            __syncthreads();
        }
    } else {
        const int ht = tid - 256, tl = ht >> 3, c8 = ht & 7, ch = hh * 64 + c8 * 8;
        const size_t po = (size_t)layer * 1024 + ch;
        struct HelpIn { v4u zr, zk, zv, ew, ar, zkn, gt; };
        HelpIn cur, nxt;
#define HELP_LOAD(H, PC, GC) do { \
            if ((PC) < NCH) { const int _t = (PC) * SC + tl; const size_t _row = (size_t)b * SEQ + _t; \
                (H).zr = *(const v4u*)(ZR + _row * 3072 + ch); (H).zk = *(const v4u*)(ZR + _row * 3072 + 1024 + ch); (H).zv = *(const v4u*)(ZR + _row * 3072 + 2048 + ch); \
                (H).ew = *(const v4u*)(EW + _row * 1024 + ch); (H).ar = *(const v4u*)(AR + _row * 1024 + ch); \
                (H).zkn = (_t + 1 < SEQ) ? *(const v4u*)(ZR + (_row + 1) * 3072 + 1024 + ch) : (v4u){0u, 0u, 0u, 0u}; } \
            if ((GC) >= 0 && (GC) < NCH) { const size_t _row = (size_t)b * SEQ + (size_t)(GC) * SC + tl; (H).gt = *(const v4u*)(GT + _row * 1024 + ch); } } while (0)
        HELP_LOAD(cur, 0, -2);
        for (int it = 0; it < NCH + 2; ++it) {
            HELP_LOAD(nxt, it + 1, it - 1);
            if (it >= 2) {
                const LAS float* buf = bufs + (it & 1) * SC_BUF; const LAS float* yb = sY + (it & 1) * SC_VEC;
                const size_t row = (size_t)b * SEQ + (size_t)(it - 2) * SC + tl; const int o = tl * 64 + c8 * 8;
                f32x4 y_[2], v_[2], g_[2];
#pragma unroll
                for (int i = 0; i < 2; ++i) { y_[i] = *(const LAS f32x4*)(yb + o + 4 * i); v_[i] = *(const LAS f32x4*)(buf + SC_V + o + 4 * i); }
                const float bon = buf[SC_BON + tl * 8 + c8];
                unpk8(cur.gt, g_[0], g_[1]);
                const float s1 = ((y_[0].x + y_[0].y) + (y_[0].z + y_[0].w)) + ((y_[1].x + y_[1].y) + (y_[1].z + y_[1].w));
                const float mu = sum8(s1) * (1.f / 64.f);
                float s2 = 0.f;
#pragma unroll
                for (int i = 0; i < 2; ++i) { y_[i] = y_[i] - mu; const f32x4 q = y_[i] * y_[i]; s2 += (q.x + q.y) + (q.z + q.w); }
                const float rstd = 1.f / sqrtf(sum8(s2) * (1.f / 64.f) + 64e-5f);
                f32x4 o_[2];
#pragma unroll
                for (int i = 0; i < 2; ++i) o_[i] = (y_[i] * rstd * *(const f32x4*)(a.in[14] + po + 4 * i) + *(const f32x4*)(a.in[15] + po + 4 * i) + bon * v_[i]) * g_[i];
                *(v4u*)(YAB + row * 2048 + ch) = pk8(o_[0], o_[1]);
            }
            if (it < NCH) {
                LAS float* buf = bufs + (it & 1) * SC_BUF;
                f32x4 r_[2], k_[2], v_[2], e_[2], ar_[2], kn_[2];
                unpk8(cur.zr, r_[0], r_[1]); unpk8(cur.zk, k_[0], k_[1]); unpk8(cur.zv, v_[0], v_[1]); unpk8(cur.ew, e_[0], e_[1]); unpk8(cur.ar, ar_[0], ar_[1]); unpk8(cur.zkn, kn_[0], kn_[1]);
                f32x4 kkv[2], kp[2]; float ss = 0.f, bs = 0.f, sn = 0.f;
#pragma unroll
                for (int i = 0; i < 2; ++i) { const f32x4 pkk_ = *(const f32x4*)(a.in[11] + po + 4 * i), pka_ = *(const f32x4*)(a.in[12] + po + 4 * i), prk_ = *(const f32x4*)(a.in[13] + po + 4 * i);
                    kkv[i] = k_[i] * pkk_; kp[i] = k_[i] * (1.f + (ar_[i] - 1.f) * pka_); kn_[i] = kn_[i] * pkk_;
                    const f32x4 q = kkv[i] * kkv[i]; ss += (q.x + q.y) + (q.z + q.w); const f32x4 z = r_[i] * kp[i] * prk_; bs += (z.x + z.y) + (z.z + z.w);
                    const f32x4 qn = kn_[i] * kn_[i]; sn += (qn.x + qn.y) + (qn.z + qn.w); }
                ss = sum8(ss); sn = sum8(sn); const float bon = sum8(bs);
                const float inv = 1.f / sqrtf(fmaxf(ss, 1e-24f)), invn = -1.f / sqrtf(fmaxf(sn, 1e-24f));
                const int o = tl * 64 + c8 * 8; float c1 = 0.f, c2 = 0.f, c3 = 0.f, c4 = 0.f;
                f32x4 xa_[2], xr_[2];
#pragma unroll
                for (int i = 0; i < 2; ++i) { const f32x4 kn = kkv[i] * inv, bq = kn * ar_[i], an = kn_[i] * invn;
                    f32x4 w4; w4.x = __builtin_amdgcn_exp2f(-1.44269504f * e_[i].x); w4.y = __builtin_amdgcn_exp2f(-1.44269504f * e_[i].y); w4.z = __builtin_amdgcn_exp2f(-1.44269504f * e_[i].z); w4.w = __builtin_amdgcn_exp2f(-1.44269504f * e_[i].w);
                    const f32x4 z1 = bq * an, z2 = kp[i] * an, z3 = bq * r_[i], z4 = kp[i] * r_[i];
                    c1 += (z1.x + z1.y) + (z1.z + z1.w); c2 += (z2.x + z2.y) + (z2.z + z2.w); c3 += (z3.x + z3.y) + (z3.z + z3.w); c4 += (z4.x + z4.y) + (z4.z + z4.w);
                    xa_[i] = w4 * an; xr_[i] = w4 * r_[i];
                    *(LAS f32x4*)(buf + o + 4 * i) = w4; *(LAS f32x4*)(buf + SC_V + o + 4 * i) = v_[i];
                    { LAS unsigned* bkp = (LAS unsigned*)(buf + SC_BK) + tl * 64 + (((c8 & 1) * 8 + 4 * i) * 4 + (c8 >> 1));
                      bkp[0] = cvt_pk_bf16(bq.x, kp[i].x); bkp[4] = cvt_pk_bf16(bq.y, kp[i].y); bkp[8] = cvt_pk_bf16(bq.z, kp[i].z); bkp[12] = cvt_pk_bf16(bq.w, kp[i].w); }
                    { LAS unsigned char* xp = (LAS unsigned char*)(buf + SC_XA) + tl * 256 + (c8 >> 2) * 64 + (2 * (c8 & 1) + i) * 16 + ((c8 >> 1) & 1) * 8;
                      *(LAS v2u*)xp = (v2u){cvt_pk_bf16(xa_[i].x, xa_[i].y), cvt_pk_bf16(xa_[i].z, xa_[i].w)};
                      *(LAS v2u*)(xp + 128) = (v2u){cvt_pk_bf16(xr_[i].x, xr_[i].y), cvt_pk_bf16(xr_[i].z, xr_[i].w)}; } }
                c1 = sum8(c1); c2 = sum8(c2); c3 = sum8(c3); c4 = sum8(c4);
                if (c8 == 0) *(LAS f32x4*)(buf + SC_C + tl * 4) = (f32x4){c1, c2, c3, c4};
                buf[SC_BON + tl * 8 + c8] = bon;
            }
            cur = nxt;
            __syncthreads();
        }
#undef HELP_LOAD
    }
}

constexpr int TP = 136;
__device__ __forceinline__ void mma_128(const LAS bf16* sA, const LAS bf16* sBt, int wave, int lane, f32x4 (&acc)[4][2]) {
    const int wm = wave >> 2, wn = wave & 3, fr = lane & 15, fq = lane >> 4;
#pragma unroll
    for (int kk = 0; kk < 4; ++kk) {
        bf16x8 af[4], bf_[2];
#pragma unroll
        for (int mt = 0; mt < 4; ++mt) af[mt] = *(const LAS bf16x8*)(sA + (64 * wm + 16 * mt + fr) * TP + 32 * kk + 8 * fq);
#pragma unroll
        for (int nt = 0; nt < 2; ++nt) bf_[nt] = *(const LAS bf16x8*)(sBt + (32 * wn + 16 * nt + fr) * TP + 32 * kk + 8 * fq);
#pragma unroll
        for (int mt = 0; mt < 4; ++mt)
#pragma unroll
            for (int nt = 0; nt < 2; ++nt) acc[mt][nt] = __builtin_amdgcn_mfma_f32_16x16x32_bf16(bf_[nt], af[mt], acc[mt][nt], 0, 0, 0);
    }
}
__device__ __forceinline__ void gmlp_unit(Frame& F, const Args& a, int layer, int unit) {
    phase_ids(F);
    const size_t t0 = (size_t)unit * 128; const int tid = F.tid, lane = F.lane, wave = F.wave;
    LAS float* st = (LAS float*)F.lds; LAS bf16* sA = (LAS bf16*)(F.lds + 1024); LAS bf16* sB = (LAS bf16*)(F.lds + 1024 + 128 * TP * 2);
    const bf16* GUV = (const bf16*)(F.ws + WS_GUV); const bf16* GMW = (const bf16*)(F.ws + WS_DB + (size_t)(layer & 1) * DB_SET + DB_GMW); bf16* YAB = (bf16*)(F.ws + WS_YAB);
    const float* lng = a.in[19] + (size_t)layer * 1024; const float* lnb = a.in[20] + (size_t)layer * 1024; const float* bsp = a.in[22] + (size_t)layer * 1024;
    for (int r = 0; r < 16; ++r) { const int tok = wave * 16 + r; const bf16* rowp = GUV + (t0 + tok) * 2048 + 1024;
        f32x4 x0, x1, x2, x3; unpk8(*(const v4u*)(rowp + lane * 8), x0, x1); unpk8(*(const v4u*)(rowp + 512 + lane * 8), x2, x3);
        const f32x4 sv = (x0 + x1) + (x2 + x3), qv = (x0 * x0 + x1 * x1) + (x2 * x2 + x3 * x3);
        const float s = wave_sum((sv.x + sv.y) + (sv.z + sv.w)), q = wave_sum((qv.x + qv.y) + (qv.z + qv.w));
        const float mean = s * (1.f / 1024.f), var = fmaxf(q * (1.f / 1024.f) - mean * mean, 0.f);
        if (lane == 0) { st[tok * 2] = mean; st[tok * 2 + 1] = 1.f / sqrtf(var + 1e-5f); } }
    __syncthreads();
    for (int g = 0; g < 8; ++g) {
#pragma unroll
        for (int i = 0; i < 4; ++i) { const int pc = tid + 512 * i, rr = pc >> 4, c16 = pc & 15;
            *(LAS v4u*)(sA + rr * TP + c16 * 8) = *(const v4u*)(GMW + (size_t)g * 16384 + rr * 128 + c16 * 8); }
        { const int p = tid & 127, oc0 = tid >> 7; const float mean = st[p * 2], rstd = st[p * 2 + 1];
#pragma unroll
          for (int i = 0; i < 4; ++i) { const int oc = oc0 + 4 * i, c0 = g * 128 + oc * 8;
              f32x4 x0, x1; unpk8(*(const v4u*)(GUV + (t0 + p) * 2048 + 1024 + c0), x0, x1);
              const f32x4 g0 = *(const f32x4*)(lng + c0), g1 = *(const f32x4*)(lng + c0 + 4), b0 = *(const f32x4*)(lnb + c0), b1 = *(const f32x4*)(lnb + c0 + 4);
              x0 = (x0 - mean) * rstd * g0 + b0; x1 = (x1 - mean) * rstd * g1 + b1;
              const v4u w = pk8(x0, x1);
              LAS bf16* d = sB + (oc * 8) * TP + p;
              d[0 * TP] = (bf16)(w.x & 0xffffu); d[1 * TP] = (bf16)(w.x >> 16); d[2 * TP] = (bf16)(w.y & 0xffffu); d[3 * TP] = (bf16)(w.y >> 16);
              d[4 * TP] = (bf16)(w.z & 0xffffu); d[5 * TP] = (bf16)(w.z >> 16); d[6 * TP] = (bf16)(w.w & 0xffffu); d[7 * TP] = (bf16)(w.w >> 16); } }
        __syncthreads();
        f32x4 acc[4][2];
#pragma unroll
        for (int mt = 0; mt < 4; ++mt)
#pragma unroll
            for (int nt = 0; nt < 2; ++nt) acc[mt][nt] = (f32x4){0.f, 0.f, 0.f, 0.f};
        mma_128(sA, sB, wave, lane, acc);
        { const int wm = wave >> 2, wn = wave & 3, fr = lane & 15, fq = lane >> 4;
#pragma unroll
          for (int mt = 0; mt < 4; ++mt) { const int tt = 64 * wm + 16 * mt + fr; const float bsv = bsp[g * 128 + tt];
#pragma unroll
              for (int nt = 0; nt < 2; ++nt) { const int c = g * 128 + 32 * wn + 16 * nt + 4 * fq;
                  const v2u uw = *(const v2u*)(GUV + (t0 + tt) * 2048 + c);
                  const f32x4 u4 = (f32x4){bflo(uw.x), bfhi(uw.x), bflo(uw.y), bfhi(uw.y)};
                  const f32x4 yb = u4 * (acc[mt][nt] + bsv);
                  v2u ow; ow.x = cvt_pk_bf16(yb.x, yb.y); ow.y = cvt_pk_bf16(yb.z, yb.w);
                  *(v2u*)(YAB + (t0 + tt) * 2048 + 1024 + c) = ow; } } }
        __syncthreads();
    }
}

__device__ __forceinline__ unsigned fkey(float f) { const unsigned u = __builtin_bit_cast(unsigned, f); return (u & 0x80000000u) ? ~u : (u | 0x80000000u); }
__device__ __forceinline__ float kval(unsigned k, unsigned mask) { const unsigned u = k & mask; return __builtin_bit_cast(float, (u & 0x80000000u) ? (u ^ 0x80000000u) : ~u); }
__device__ __forceinline__ float swap32_add(float a, float b) { const auto r = __builtin_amdgcn_permlane32_swap(__builtin_bit_cast(unsigned, a), __builtin_bit_cast(unsigned, b), false, false);
    return __builtin_bit_cast(float, (unsigned)r[0]) + __builtin_bit_cast(float, (unsigned)r[1]); }
__device__ __forceinline__ float swap16_add(float a, float b) { const auto r = __builtin_amdgcn_permlane16_swap(__builtin_bit_cast(unsigned, a), __builtin_bit_cast(unsigned, b), false, false);
    return __builtin_bit_cast(float, (unsigned)r[0]) + __builtin_bit_cast(float, (unsigned)r[1]); }
__device__ __forceinline__ float row_sum16(float x) {
    x += __builtin_bit_cast(float, __builtin_amdgcn_update_dpp(0, __builtin_bit_cast(int, x), 0x128, 0xf, 0xf, false));
    x += __builtin_bit_cast(float, __builtin_amdgcn_update_dpp(0, __builtin_bit_cast(int, x), 0x124, 0xf, 0xf, false));
    x += __builtin_bit_cast(float, __builtin_amdgcn_update_dpp(0, __builtin_bit_cast(int, x), 0x122, 0xf, 0xf, false));
    x += __builtin_bit_cast(float, __builtin_amdgcn_update_dpp(0, __builtin_bit_cast(int, x), 0x121, 0xf, 0xf, false));
    return x; }
#define CE_DESC(a, b) do { const unsigned _h = max((a), (b)), _l = min((a), (b)); (a) = _h; (b) = _l; } while (0)
template <int OFF> __device__ __forceinline__ void bitonic_merge16(unsigned (&x)[32]) {
#pragma unroll
    for (int j = 8; j >= 1; j >>= 1)
#pragma unroll
        for (int i = 0; i < 16; ++i) { const int l = i ^ j; if (l > i) CE_DESC(x[OFF + i], x[OFF + l]); }
}
template <int OFF> __device__ __forceinline__ void bitonic_sort16(unsigned (&x)[32]) {
#pragma unroll
    for (int k = 2; k <= 16; k <<= 1)
#pragma unroll
        for (int j = k >> 1; j >= 1; j >>= 1)
#pragma unroll
            for (int i = 0; i < 16; ++i) { const int l = i ^ j; if (l > i) { if ((i & k) == 0 || k == 16) CE_DESC(x[OFF + i], x[OFF + l]); else CE_DESC(x[OFF + l], x[OFF + i]); } }
}
#ifndef REP_K
#define REP_K 1
#endif
#define TOP_INSERT(top, x) do { unsigned _x = (x); _Pragma("unroll") for (int _j = 0; _j < 16; ++_j) { const unsigned _h = max((top)[_j], _x); _x = min((top)[_j], _x); (top)[_j] = _h; } } while (0)
__device__ __forceinline__ void peer_unit(Frame& F, const Args& a, int layer, int unit, bool last) {
    phase_ids(F);
    const size_t t0 = (size_t)unit * 128; const int tid = F.tid, lane = F.lane, wave = F.wave, fr = lane & 15, fq = lane >> 4;
    LAS bf16* sKey = (LAS bf16*)F.lds;
    LAS unsigned* sLT = (LAS unsigned*)(F.lds + 128 * TP * 2) + wave * 512;
    const bf16* Q = (const bf16*)(F.ws + WS_Q); const bf16* KEYS = (const bf16*)(F.ws + WS_DB + (size_t)(layer & 1) * DB_SET + DB_KEYS); v2u* SEL = (v2u*)(F.ws + WS_SEL);
    const size_t trow = t0 + wave * 16 + fr;
    for (int krep = 0; krep < REP_K; ++krep)
    for (int hd = 0; hd < 8; ++hd) {
        for (int p = 0; p < 2; ++p) {
            __syncthreads();
#pragma unroll
            for (int i = 0; i < 4; ++i) { const int pc = tid + 512 * i, rr = pc >> 4, c16 = pc & 15;
                *(LAS v4u*)(sKey + rr * TP + c16 * 8) = *(const v4u*)(KEYS + (size_t)(hd * 2 + p) * 16384 + rr * 128 + c16 * 8); }
            bf16x8 qf[4];
#pragma unroll
            for (int kk = 0; kk < 4; ++kk) qf[kk] = *(const bf16x8*)(Q + trow * 2048 + hd * 256 + p * 128 + 32 * kk + 8 * fq);
            __syncthreads();
            f32x4 sc[8];
#pragma unroll
            for (int nt = 0; nt < 8; ++nt) sc[nt] = (f32x4){0.f, 0.f, 0.f, 0.f};
#pragma unroll
            for (int kk = 0; kk < 4; ++kk)
#pragma unroll
                for (int nt = 0; nt < 8; ++nt) { const bf16x8 kf = *(const LAS bf16x8*)(sKey + (16 * nt + fr) * TP + 32 * kk + 8 * fq);
                    sc[nt] = __builtin_amdgcn_mfma_f32_16x16x32_bf16(kf, qf[kk], sc[nt], 0, 0, 0); }
            unsigned t[32];
#pragma unroll
            for (int nt = 0; nt < 8; ++nt)
#pragma unroll
                for (int rg = 0; rg < 4; ++rg) t[4 * nt + rg] = (fkey(sc[nt][rg]) & 0xFFFFFF80u) | (unsigned)(16 * nt + 4 * fq + rg);
            bitonic_sort16<0>(t); bitonic_sort16<16>(t);
#pragma unroll
            for (int j = 0; j < 16; ++j) t[j] = max(t[j], t[31 - j]);
            bitonic_merge16<0>(t);
#pragma unroll
            for (int rnd = 0; rnd < 2; ++rnd) {
#pragma unroll
                for (int j = 0; j < 16; ++j) t[16 + j] = rnd ? xor32_u(t[j], lane) : xor16_u(t[j], lane);
#pragma unroll
                for (int j = 0; j < 16; ++j) t[j] = max(t[j], t[31 - j]);
                bitonic_merge16<0>(t); }
#pragma unroll
            for (int j = 0; j < 16; ++j) sLT[fr * 32 + p * 16 + j] = t[j];
        }
        float v0[16], v1[16];
#pragma unroll
        for (int j = 0; j < 16; ++j) { v0[j] = kval(sLT[fr * 32 + j], 0xFFFFFF80u); v1[j] = kval(sLT[fr * 32 + 16 + j], 0xFFFFFF80u); }
        unsigned best[32];
#define CKEY(i, j) ((fkey(v0[i] + v1[j]) & 0xFFFFFF00u) | (unsigned)((i) * 16 + (j)))
#pragma unroll
        for (int j = 0; j < 16; ++j) best[j] = CKEY(0, j);
#pragma unroll
        for (int i = 1; i < 8; ++i) {
#pragma unroll
            for (int j = 0; j < 16; ++j) if ((i + 1) * (j + 1) <= 16) best[15 - j] = max(best[15 - j], CKEY(i, j));
            bitonic_merge16<0>(best); }
#pragma unroll
        for (int i = 8; i < 16; ++i) best[15 - (i - 8)] = max(best[15 - (i - 8)], CKEY(i, 0));
        bitonic_merge16<0>(best);
#undef CKEY
        float ev[16], esum = 0.f; const float mx = kval(best[0], 0xFFFFFF00u);
#pragma unroll
        for (int k = 0; k < 16; ++k) { ev[k] = __builtin_amdgcn_exp2f((kval(best[k], 0xFFFFFF00u) - mx) * 1.44269504f); esum += ev[k]; }
        const float einv = 1.f / esum;
#pragma unroll
        for (int k = 0; k < 16; ++k) { const unsigned pos = best[k] & 255u;
            const unsigned i0 = sLT[fr * 32 + (pos >> 4)] & 127u, i1 = sLT[fr * 32 + 16 + (pos & 15u)] & 127u;
            if ((k >> 2) == fq) SEL[trow * 128 + hd * 16 + k] = (v2u){i0 * 128u + i1, __builtin_bit_cast(unsigned, ev[k] * einv)}; }
    }
    asm volatile("s_waitcnt vmcnt(0)" ::: "memory");
    __syncthreads();
    const bf16* N2 = (const bf16*)(F.ws + WS_N2); const unsigned char* U8 = (const unsigned char*)(F.ws + WS_DB + (size_t)(layer & 1) * DB_SET + DB_U); const unsigned char* V8 = (const unsigned char*)(F.ws + WS_DB + (size_t)(layer & 1) * DB_SET + DB_V);
    const unsigned* SELU = (const unsigned*)SEL;
    LAS float* sCoef = (LAS float*)(F.lds + 128 * TP * 2 + 8 * 2048) + wave * 2048;
#define PL_LOAD(RB, TAB, SE, BB) do { _Pragma("unroll") for (int _q = 0; _q < 16; ++_q) { \
        const unsigned _idx = (unsigned)__builtin_amdgcn_readlane((int)((_q & 1) ? (SE).z : (SE).x), (BB) * 8 + (_q >> 1)); \
        (RB)[_q] = *(const v4u*)((TAB) + (size_t)_idx * 1024 + 16 * lane); } } while (0)
#define PL_DOT8(RB, O, T0, T1) do { float _p[8]; \
        _Pragma("unroll") for (int _q = 0; _q < 8; ++_q) { f32x2 _a = (f32x2){0.f, 0.f}; \
            _Pragma("unroll") for (int _j = 0; _j < 4; ++_j) { _a += __builtin_amdgcn_cvt_pk_f32_fp8((int)(RB)[(O) + _q][_j], false) * nf[2 * _j]; _a += __builtin_amdgcn_cvt_pk_f32_fp8((int)(RB)[(O) + _q][_j], true) * nf[2 * _j + 1]; } \
            _p[_q] = _a.x + _a.y; } \
        const float _s0 = swap32_add(_p[0], _p[4]), _s1 = swap32_add(_p[1], _p[5]), _s2 = swap32_add(_p[2], _p[6]), _s3 = swap32_add(_p[3], _p[7]); \
        T0 = row_sum16(swap16_add(_s0, _s2)); T1 = row_sum16(swap16_add(_s1, _s3)); } while (0)
#define PL_U(RB, BB) do { float _t0, _t1, _t2, _t3; PL_DOT8(RB, 0, _t0, _t1); PL_DOT8(RB, 8, _t2, _t3); \
        _t0 = fgelu(_t0 * (1.f / 256.f)) * (1.f / 64.f); _t1 = fgelu(_t1 * (1.f / 256.f)) * (1.f / 64.f); _t2 = fgelu(_t2 * (1.f / 256.f)) * (1.f / 64.f); _t3 = fgelu(_t3 * (1.f / 256.f)) * (1.f / 64.f); \
        if ((lane & 15) == 0) { const int _r = lane >> 4, _qb = 2 * (_r & 1) + 4 * (_r >> 1); LAS float* _c = crow + (BB) * 16 + _qb; _c[0] = _t0; _c[1] = _t1; _c[8] = _t2; _c[9] = _t3; } } while (0)
#define PL_V(RB, SE, BB) do { _Pragma("unroll") for (int _q = 0; _q < 16; ++_q) { \
            const float _gw = __builtin_bit_cast(float, __builtin_amdgcn_readlane((int)((_q & 1) ? (SE).w : (SE).y), (BB) * 8 + (_q >> 1))); \
            const float _c = crow[(BB) * 16 + _q] * _gw; const f32x2 _c2 = (f32x2){_c, _c}; \
            _Pragma("unroll") for (int _j = 0; _j < 4; ++_j) { out[2 * _j] += _c2 * __builtin_amdgcn_cvt_pk_f32_fp8((int)(RB)[_q][_j], false); out[2 * _j + 1] += _c2 * __builtin_amdgcn_cvt_pk_f32_fp8((int)(RB)[_q][_j], true); } } } while (0)
    {
        const size_t tokb = t0 + wave * 16;
        v4u ra[16], rb[16];
        {   v4u se = *(const v4u*)(SELU + tokb * 256 + 4 * lane), se_n = se;
            PL_LOAD(ra, U8, se, 0);
            for (int it = 0; it < 16; ++it) {
                const size_t tok = tokb + it; LAS float* crow = sCoef + it * 128;
                f32x2 nf[8];
                { f32x4 x0, x1, x2, x3; unpk8(*(const v4u*)(N2 + tok * 1024 + 16 * lane), x0, x1); unpk8(*(const v4u*)(N2 + tok * 1024 + 16 * lane + 8), x2, x3);
                  nf[0] = __builtin_shufflevector(x0, x0, 0, 1); nf[1] = __builtin_shufflevector(x0, x0, 2, 3); nf[2] = __builtin_shufflevector(x1, x1, 0, 1); nf[3] = __builtin_shufflevector(x1, x1, 2, 3);
                  nf[4] = __builtin_shufflevector(x2, x2, 0, 1); nf[5] = __builtin_shufflevector(x2, x2, 2, 3); nf[6] = __builtin_shufflevector(x3, x3, 0, 1); nf[7] = __builtin_shufflevector(x3, x3, 2, 3); }
                if (it < 15) se_n = *(const v4u*)(SELU + (tok + 1) * 256 + 4 * lane);
#pragma unroll 1
                for (int bp = 0; bp < 4; ++bp) {
                    PL_LOAD(rb, U8, se, 2 * bp + 1);
                    PL_U(ra, 2 * bp);
                    if (bp < 3) PL_LOAD(ra, U8, se, 2 * bp + 2); else if (it < 15) PL_LOAD(ra, U8, se_n, 0);
                    PL_U(rb, 2 * bp + 1);
                }
                se = se_n;
            } }
        asm volatile("s_waitcnt lgkmcnt(0)" ::: "memory");
        __syncthreads();
        v4u se = *(const v4u*)(SELU + tokb * 256 + 4 * lane), se_n = se;
        PL_LOAD(ra, V8, se, 0);
        for (int it = 0; it < 16; ++it) {
            const size_t tok = tokb + it; const LAS float* crow = sCoef + it * 128;
            f32x2 out[8];
#pragma unroll
            for (int i = 0; i < 8; ++i) out[i] = (f32x2){0.f, 0.f};
            if (it < 15) se_n = *(const v4u*)(SELU + (tok + 1) * 256 + 4 * lane);
#pragma unroll 1
            for (int bp = 0; bp < 4; ++bp) {
                PL_LOAD(rb, V8, se, 2 * bp + 1);
                PL_V(ra, se, 2 * bp);
                if (bp < 3) PL_LOAD(ra, V8, se, 2 * bp + 2); else if (it < 15) PL_LOAD(ra, V8, se_n, 0);
                PL_V(rb, se, 2 * bp + 1);
            }
            se = se_n;
            float* hp = F.h + tok * 1024 + 16 * lane;
            f32x4 hv[4]; float s = 0.f;
#pragma unroll
            for (int i = 0; i < 4; ++i) { hv[i] = *(const f32x4*)(hp + 4 * i) + (f32x4){out[2 * i].x, out[2 * i].y, out[2 * i + 1].x, out[2 * i + 1].y};
                s += (hv[i].x * hv[i].x + hv[i].y * hv[i].y) + (hv[i].z * hv[i].z + hv[i].w * hv[i].w); }
            const float rstd = 1.f / sqrtf(wave_sum(s) * (1.f / D) + 1e-6f);
            const float* g = (last ? a.in[4] : a.in[2] + (size_t)(layer + 1) * 1024) + 16 * lane;
            f32x4 o[4];
#pragma unroll
            for (int i = 0; i < 4; ++i) o[i] = hv[i] * rstd * *(const f32x4*)(g + 4 * i);
            if (last) {
#ifdef PROBE_SCAN
                { const float pv = ((const float*)(F.ws + WS_CTL))[2048 + PROBE_SCAN - 1];
#pragma unroll
                  for (int i = 0; i < 4; ++i) o[i] = o[i] + pv; }
#endif
#pragma unroll
                for (int i = 0; i < 4; ++i) *(f32x4*)(hp + 4 * i) = o[i];
            } else {
#pragma unroll
                for (int i = 0; i < 4; ++i) *(f32x4*)(hp + 4 * i) = hv[i];
                bf16* NX = (bf16*)(F.ws + WS_NX); const v4u w0 = pk8(o[0], o[1]), w1 = pk8(o[2], o[3]); const int tt = (int)(tok & (SEQ - 1));
                *(v4u*)(NX + tok * 2048 + 16 * lane) = w0; *(v4u*)(NX + tok * 2048 + 16 * lane + 8) = w1;
                if (tt != SEQ - 1) { *(v4u*)(NX + (tok + 1) * 2048 + 1024 + 16 * lane) = w0; *(v4u*)(NX + (tok + 1) * 2048 + 1024 + 16 * lane + 8) = w1; }
                if (tt == 0) { *(v4u*)(NX + tok * 2048 + 1024 + 16 * lane) = (v4u){0u, 0u, 0u, 0u}; *(v4u*)(NX + tok * 2048 + 1024 + 16 * lane + 8) = (v4u){0u, 0u, 0u, 0u}; }
            }
        }
    }
#undef PL_LOAD
#undef PL_DOT8
#undef PL_U
#undef PL_V
}

#ifndef REP_E
#define REP_E 1
#endif
#ifndef REP_A
#define REP_A 1
#endif
#ifndef REP_B
#define REP_B 1
#endif
#ifndef REP_C
#define REP_C 1
#endif
#ifndef REP_D
#define REP_D 1
#endif
#ifndef REP_G
#define REP_G 1
#endif
#ifndef REP_I
#define REP_I 1
#endif
#ifndef REP_K
#define REP_K 1
#endif
__global__ void __launch_bounds__(NWAVES * 64, 2) trunk_fwd(Args args) {
    extern __shared__ __attribute__((aligned(16))) unsigned char lds[];
    Frame F;
    F.lds = (LAS unsigned char*)lds;
    F.tid = threadIdx.x; F.lane = F.tid & 63; F.wave = __builtin_amdgcn_readfirstlane(F.tid >> 6); F.wave0 = F.wave;
    F.G = gridDim.x; F.bx = blockIdx.x; F.ws = (GAS unsigned char*)args.ws; F.h = args.out;
    volatile LAS unsigned* MISC = (volatile LAS unsigned*)(F.lds + MISC_OFF);
    for (int u = F.tid; u < (LDS_BYTES - LDSCTL_OFF) / 4; u += NWAVES * 64) ((LAS unsigned*)(F.lds + LDSCTL_OFF))[u] = 0u;
    __syncthreads();
    unsigned* ctl = (unsigned*)(F.ws + WS_CTL);
    XcdBarrier bar = xcd_barrier_post(ctl + CW_BAR, MISC + 8);
    GAS unsigned char* ws = F.ws;
    LAS unsigned char* ring = (LAS unsigned char*)F.lds;

    for (int rep = 0; rep < REP_A; ++rep) { prep_phase(F, args, 0, F.bx, F.G);
    xcd_barrier(bar, F.wave0); }
#define OPQ() GAS unsigned char* ws = F.ws; asm volatile("" : "+s"(ws)); GAS unsigned char* db = ws + WS_DB + (size_t)(layer & 1) * DB_SET; (void)db
    for (int layer = 0; layer < DEPTH; ++layer) {
        {   OPQ();
        for (int rep = 0; rep < REP_B; ++rep) {   if (rep) xcd_barrier(bar, F.wave0); pg8::Gemm g{(const bf16*)(ws + WS_NX), (const bf16*)(ws + WS_WIN), T, NZ, 2048, 2048}; pg8::StaticOrder S; S.init(T, NZ, F.G, F.bx);
            pg8::EpiZ E{(bf16*)(ws + WS_ZRKV), (bf16*)(ws + WS_ZL), (bf16*)(ws + WS_GUV), (bf16*)(ws + WS_SG), layer == 0 ? (bf16*)(ws + WS_VF) : (bf16*)nullptr};
            pg8::gemm_phase<pg8::EpiZ, pg8::StaticOrder, true, true>(ring, g, S, E, F.wave0); }
        }
        xcd_barrier(bar, F.wave0);
        {   OPQ();
        for (int rep = 0; rep < REP_C; ++rep) {   if (rep) xcd_barrier(bar, F.wave0); pg8::Gemm g{(const bf16*)(ws + WS_ZL), (const bf16*)(ws + WS_LORA + (size_t)layer * LORA_BYTES), T, 3072, 256, 512}; pg8::StaticOrder S; S.init(T, 3072, F.G, F.bx);
            pg8::EpiLora E{(bf16*)(ws + WS_EW), (size_t)(WS_AR - WS_EW) / 2, args.in[6] + (size_t)layer * 1024, args.in[8] + (size_t)layer * 1024};
            pg8::gemm_phase<pg8::EpiLora, pg8::StaticOrder, true, true>(ring, g, S, E, F.wave0); }
        if (layer > 0) {
            pg8::Gemm g{(const bf16*)(ws + WS_ZL) + 256, (const bf16*)(ws + WS_MV + (size_t)(layer - 1) * MV_BYTES), T, 1024, 256, 512}; pg8::StaticOrder S; S.init(T, 1024, F.G, F.bx);
            pg8::EpiMv E{(bf16*)(ws + WS_ZRKV), (const bf16*)(ws + WS_VF), args.in[18] + (size_t)(layer - 1) * 1024};
            pg8::gemm_phase<pg8::EpiMv, pg8::StaticOrder, true, true>(ring, g, S, E, F.wave0); }
        }
        xcd_barrier(bar, F.wave0);
        {   OPQ();
        for (int rep = 0; rep < REP_D; ++rep) {   if (rep) xcd_barrier(bar, F.wave0); const int nsb = F.G / 2, nob = F.G - nsb;
            if (F.bx < nsb) { for (int u = F.bx; u < NB * 16; u += nsb) scan_unit(F, args, layer, u); }
            else { const int ob = F.bx - nsb;
                for (int pm = ob; pm < T / 256; pm += nob)
                    for (int rep2 = 0; rep2 < REP_E; ++rep2) { gmlp_unit(F, args, layer, 2 * pm); gmlp_unit(F, args, layer, 2 * pm + 1); }
                asm volatile("s_waitcnt vmcnt(0)" ::: "memory"); __syncthreads();
                {
                    pg8::Gemm g{(const bf16*)(ws + WS_YAB) + 1024, (const bf16*)(db + DB_PBT), T, 1024, 1024, 2048}; pg8::PanelOrder S{ob, nob, T / 256, 4};
                    pg8::EpiMerge<false> E{(const bf16*)(ws + WS_SG), (bf16*)(ws + WS_GUV) + 1024, (bf16*)nullptr};
                    pg8::gemm_phase<pg8::EpiMerge<false>, pg8::PanelOrder, true, true>(ring, g, S, E, F.wave0); }
                {   pg8::Gemm g{(const bf16*)(db + DB_PB), (const bf16*)(db + DB_PLEW), T, 1024, 256, 256}; pg8::StaticOrder S; S.init(T, 1024, nob, ob);
                    pg8::EpiPlain E{(bf16*)(ws + WS_PW), 1024};
                    pg8::gemm_phase<pg8::EpiPlain, pg8::StaticOrder, true, true>(ring, g, S, E, F.wave0); }
                if (layer + 1 < DEPTH) prep_phase(F, args, layer + 1, ob, nob); } }
        }
        xcd_barrier(bar, F.wave0);
        {   OPQ();
        for (int rep = 0; rep < REP_G; ++rep) {   if (rep) xcd_barrier(bar, F.wave0); pg8::Gemm g{(const bf16*)(ws + WS_YAB), (const bf16*)(db + DB_PA), T, 1024, 1024, 2048}; pg8::StaticOrder S; S.init(T, 1024, F.G, F.bx);
            pg8::EpiMerge<true> E{(const bf16*)(ws + WS_SG), (bf16*)(ws + WS_GUV) + 1024, (bf16*)(ws + WS_MG)};
            pg8::gemm_phase<pg8::EpiMerge<true>, pg8::StaticOrder, true, true>(ring, g, S, E, F.wave0); }
        }
        xcd_barrier(bar, F.wave0);
        {   OPQ();
        {   pg8::Gemm g{(const bf16*)(ws + WS_MG), (const bf16*)(db + DB_POUT), T, 1024, 1024, 1024}; pg8::StaticOrder S; S.init(T, 1024, F.G, F.bx);
            pg8::EpiResid E{F.h};
            pg8::gemm_phase<pg8::EpiResid, pg8::StaticOrder, true, true>(ring, g, S, E, F.wave0); }
        }
        xcd_barrier(bar, F.wave0);
        {   OPQ();
        for (int rep = 0; rep < REP_I; ++rep) {   if (rep) xcd_barrier(bar, F.wave0); phase_ids(F); const int gw = F.bx * NWAVES + F.wave, NGW = F.G * NWAVES; const float* g2 = args.in[3] + (size_t)layer * 1024;
            for (int m = gw; m < T; m += NGW) norm_row_n2(F.h + (size_t)m * D, g2, (bf16*)(ws + WS_N2) + (size_t)m * D, F.lane); }
        }
        xcd_barrier(bar, F.wave0);
        {   OPQ();
        {   pg8::Gemm g{(const bf16*)(ws + WS_N2), (const bf16*)(db + DB_WQG), T, 3072, 1024, 1024}; pg8::StaticOrder S; S.init(T, 3072, F.G, F.bx);
            pg8::EpiQG E{(bf16*)(ws + WS_Q), (const bf16*)(ws + WS_PW), F.h};
            pg8::gemm_phase<pg8::EpiQG, pg8::StaticOrder, true, true>(ring, g, S, E, F.wave0); }
        }
        xcd_barrier(bar, F.wave0);
        {   OPQ();
        for (int u = F.bx; u < T / 128; u += F.G) peer_unit(F, args, layer, u, layer == DEPTH - 1);
        }
        if (layer + 1 < DEPTH) xcd_barrier(bar, F.wave0);
    }
}

extern "C" void kernel_launch(void* const* d_in, const int* in_sizes, int n_in, void* d_out, int out_size, void* d_ws, size_t ws_size, hipStream_t stream) {
    static int grid = 0;
    if (grid == 0) {
        if (n_in != 32 || out_size != T * D || ws_size < WS_END) { fprintf(stderr, "kernel_launch: unexpected sizes n_in %d out %d ws %zu (need %zu); nothing launched\n", n_in, out_size, ws_size, (size_t)WS_END); grid = -1; return; }
        int dev = 0, cus = 0, per_cu = 0;
        if (hipGetDevice(&dev) != hipSuccess || hipDeviceGetAttribute(&cus, hipDeviceAttributeMultiprocessorCount, dev) != hipSuccess) { grid = -1; return; }
        if (hipFuncSetAttribute((const void*)trunk_fwd, hipFuncAttributeMaxDynamicSharedMemorySize, LDS_BYTES) != hipSuccess) { fprintf(stderr, "kernel_launch: hipFuncSetAttribute failed\n"); grid = -1; return; }
        if (hipOccupancyMaxActiveBlocksPerMultiprocessor(&per_cu, (const void*)trunk_fwd, NWAVES * 64, LDS_BYTES) != hipSuccess || per_cu < 1)
            fprintf(stderr, "kernel_launch: note: occupancy query reports %d workgroups per CU\n", per_cu);
        (void)hipGetLastError();
        grid = cus;
    }
    if (grid < 0) return;
    (void)hipMemsetAsync((char*)d_ws + WS_CTL, 0, ZERO_BYTES, stream);
    (void)hipMemsetAsync((char*)d_ws + WIN_ZERO_OFF, 0, WIN_ZERO_BYTES, stream);
    Args a{};
    for (int i = 0; i < 32; ++i) a.in[i] = (const float*)d_in[i];
    a.out = (float*)d_out; a.ws = (unsigned char*)d_ws;
    hipLaunchKernelGGL(trunk_fwd, dim3(grid), dim3(NWAVES * 64), LDS_BYTES, stream, a);
    const hipError_t le = hipPeekAtLastError();
    if (le != hipSuccess) fprintf(stderr, "kernel_launch: launch failed: %s\n", hipGetErrorName(le));
}
```

```cpp
#include <hip/hip_runtime.h>
#include <cstdio>
#include <cstdint>
namespace pg8 {
#define PG8_LAS __attribute__((address_space(3)))
typedef unsigned short bf16_t;
typedef short bf16x8 __attribute__((ext_vector_type(8)));
typedef float f32x4 __attribute__((ext_vector_type(4)));
typedef unsigned u32x4 __attribute__((ext_vector_type(4)));
constexpr int BM = 256, BK = 64, HALF = 128, HTB = HALF * BK * 2  , STAGE_BYTES = 8 * HTB, NXCD = 8, WGM = 8;

__host__ __device__ __forceinline__ int lds_byte(int r, int c) { const int st = (r >> 4) * 2 + (c >> 5), rr = r & 15, cc = c & 31, ob = rr * 64 + cc * 2; return st * 1024 + (ob ^ (((ob >> 9) & 1) << 5)); }
__host__ __device__ __forceinline__ void stage_rc(int b, int& R, int& C) { const int st = b / 1024, sb = b % 1024, swz = sb ^ (((sb >> 9) & 1) << 5); R = (st >> 1) * 16 + swz / 64; C = (st & 1) * 32 + (swz % 64) / 2; }
__host__ __device__ __forceinline__ int perm32(int rho) { const int n = rho >> 4, i = rho & 15; return 8 * (i >> 2) + 4 * n + (i & 3); }

struct Unit { int pm, pn; };
struct Gemm { const bf16_t* A; const bf16_t* Bt; int M, N, K, lda; };

struct StaticOrder {
    int nM, nN, nwg, G, c;
    __host__ __device__ void init(int M, int N, int G_, int c_) { nM = M / BM; nN = N / BM; nwg = nM * nN; G = G_; c = c_; }
    __host__ __device__ bool next(int i, Unit& u) const {
        const long L = (long)i * G + c; if (L >= nwg) return false;
        int wgid = (int)L; { const int q = nwg / NXCD, r = nwg % NXCD, xcd = wgid % NXCD, off = wgid / NXCD; wgid = (xcd < r ? xcd * (q + 1) : r * (q + 1) + (xcd - r) * q) + off; }
        const int nig = WGM * nN, gid = wgid / nig, fm = gid * WGM, gsz = (nM - fm) < WGM ? (nM - fm) : WGM;
        u.pm = fm + ((wgid % nig) % gsz); u.pn = (wgid % nig) / gsz; return true;
    }
    __device__ __forceinline__ void a_ready(const Unit&) const {}
    __device__ __forceinline__ void done(const Unit&) const {}
};
struct PanelOrder {
    int first, stride, nM, nN;
    __host__ __device__ bool next(int i, Unit& u) const { const int p = first + (i / nN) * stride; if (p >= nM) return false; u.pm = p; u.pn = i % nN; return true; }
    __device__ __forceinline__ void a_ready(const Unit&) const {}
    __device__ __forceinline__ void done(const Unit&) const {}
};
__device__ __forceinline__ unsigned cvt_pk_bf16(float lo, float hi) { unsigned r; asm volatile("v_cvt_pk_bf16_f32 %0, %1, %2" : "=v"(r) : "v"(lo), "v"(hi)); return r; }

__device__ __forceinline__ float fsig(float x) { return __builtin_amdgcn_rcpf(1.f + __builtin_amdgcn_exp2f(-1.44269504f * x)); }
__device__ __forceinline__ float fgelu(float x) { return x * fsig(1.5957691216f * (x + 0.044715f * x * x * x)); }
__device__ __forceinline__ float bflo(unsigned w) { return __builtin_bit_cast(float, w << 16); }
__device__ __forceinline__ float bfhi(unsigned w) { return __builtin_bit_cast(float, w & 0xffff0000u); }
__device__ __forceinline__ void unpk8(const u32x4 w, f32x4& a, f32x4& b) { a = (f32x4){bflo(w.x), bfhi(w.x), bflo(w.y), bfhi(w.y)}; b = (f32x4){bflo(w.z), bfhi(w.z), bflo(w.w), bfhi(w.w)}; }
__device__ __forceinline__ u32x4 pk8(const f32x4 a, const f32x4 b) { u32x4 w; w.x = cvt_pk_bf16(a[0], a[1]); w.y = cvt_pk_bf16(a[2], a[3]); w.z = cvt_pk_bf16(b[0], b[1]); w.w = cvt_pk_bf16(b[2], b[3]); return w; }
__device__ __forceinline__ f32x4 act4(f32x4 v, int kind) {
    if (kind == 1) { v = (f32x4){fgelu(v[0]), fgelu(v[1]), fgelu(v[2]), fgelu(v[3])}; }
    else if (kind == 2) { v = (f32x4){fsig(v[0]), fsig(v[1]), fsig(v[2]), fsig(v[3])}; }
    else if (kind == 3) { v = (f32x4){2.f * fsig(2.f * v[0]) - 1.f, 2.f * fsig(2.f * v[1]) - 1.f, 2.f * fsig(2.f * v[2]) - 1.f, 2.f * fsig(2.f * v[3]) - 1.f}; }
    return v;
}
#define EPI_ROWS_BEGIN _Pragma("unroll") for (int ai = 0; ai < 2; ++ai) _Pragma("unroll") for (int m = 0; m < 4; ++m) { const size_t row = (size_t)(row0 + ai * HALF + m * 16);
#define EPI_ROWS_END }

struct EpiZ {
    static constexpr bool PERM = true, AFTER_DRAIN = false;
    bf16_t *zrkv, *zl, *guv, *sg, *vf;
    __device__ __forceinline__ void operator()(const f32x4 (&acc)[2][2][4][2], const Unit& u, int wr, int wc, int fr, int fq) const {
        const int pn = u.pn, row0 = u.pm * BM + wr * 64 + fr;
        bf16_t* dst; int ld, colt, k0, k1;
        if (pn < 12)       { dst = zrkv; ld = 3072; colt = pn * 256;        k0 = 0; k1 = 0; }
        else if (pn == 12) { dst = zl;   ld = 512;  colt = 0;               k0 = (wc < 2) ? 3 : 0; k1 = 2; }
        else if (pn == 13) { dst = zl;   ld = 512;  colt = 256;             k0 = 0; k1 = 0; }
        else if (pn < 22)  { dst = guv;  ld = 2048; colt = (pn - 14) * 256; k0 = 1; k1 = 1; }
        else               { dst = sg;   ld = 2048; colt = (pn - 22) * 256; k0 = 2; k1 = 2; }
        const int col0 = colt + wc * 32 + 8 * fq;
        const bool dovf = (vf != nullptr) && pn >= 8 && pn < 12;
        const int vcol0 = (pn - 8) * 256 + wc * 32 + 8 * fq;
        EPI_ROWS_BEGIN
            bf16_t* rowp = dst + row * ld + col0;
#pragma unroll
            for (int bj = 0; bj < 2; ++bj) { const int kind = bj ? k1 : k0;
                const u32x4 w = pk8(act4(acc[ai][bj][m][0], kind), act4(acc[ai][bj][m][1], kind));
                *(u32x4*)(rowp + bj * HALF) = w;
                if (dovf) *(u32x4*)(vf + row * 1024 + vcol0 + bj * HALF) = w; }
        EPI_ROWS_END
    }
};
struct EpiLora {
    static constexpr bool PERM = true, AFTER_DRAIN = false;
    bf16_t* ew; size_t stride; const float *w0, *a0;
    __device__ __forceinline__ void operator()(const f32x4 (&acc)[2][2][4][2], const Unit& u, int wr, int wc, int fr, int fq) const {
        const int sel = u.pn >> 2, row0 = u.pm * BM + wr * 64 + fr, col0 = (u.pn & 3) * 256 + wc * 32 + 8 * fq;
        bf16_t* dst = ew + (size_t)sel * stride;
        const float* bp = sel == 0 ? w0 : a0;
        f32x4 bv[2][2];
#pragma unroll
        for (int bj = 0; bj < 2; ++bj)
#pragma unroll
            for (int n = 0; n < 2; ++n) bv[bj][n] = (sel < 2) ? *(const f32x4*)(bp + col0 + bj * HALF + 4 * n) : (f32x4){0.f, 0.f, 0.f, 0.f};
        EPI_ROWS_BEGIN
            bf16_t* rowp = dst + row * 1024 + col0;
#pragma unroll
            for (int bj = 0; bj < 2; ++bj) { f32x4 v0 = acc[ai][bj][m][0] + bv[bj][0], v1 = acc[ai][bj][m][1] + bv[bj][1];
                if (sel < 2) { v0 = act4(v0, 2); v1 = act4(v1, 2); }
                if (sel == 0) { v0 = v0 * 0.60653066f; v1 = v1 * 0.60653066f; }
                *(u32x4*)(rowp + bj * HALF) = pk8(v0, v1); }
        EPI_ROWS_END
    }
};
struct EpiMv {
    static constexpr bool PERM = true, AFTER_DRAIN = false;
    bf16_t* zrkv; const bf16_t* vf; const float* v0b;
    __device__ __forceinline__ void operator()(const f32x4 (&acc)[2][2][4][2], const Unit& u, int wr, int wc, int fr, int fq) const {
        const int row0 = u.pm * BM + wr * 64 + fr, col0 = u.pn * 256 + wc * 32 + 8 * fq;
        f32x4 bv[2][2];
#pragma unroll
        for (int bj = 0; bj < 2; ++bj)
#pragma unroll
            for (int n = 0; n < 2; ++n) bv[bj][n] = *(const f32x4*)(v0b + col0 + bj * HALF + 4 * n);
        EPI_ROWS_BEGIN
#pragma unroll
            for (int bj = 0; bj < 2; ++bj) { bf16_t* zp = zrkv + row * 3072 + 2048 + col0 + bj * HALF;
                f32x4 z0, z1, f0, f1; unpk8(*(const u32x4*)zp, z0, z1); unpk8(*(const u32x4*)(vf + row * 1024 + col0 + bj * HALF), f0, f1);
                const f32x4 m0 = act4(acc[ai][bj][m][0] + bv[bj][0], 2), m1 = act4(acc[ai][bj][m][1] + bv[bj][1], 2);
                *(u32x4*)zp = pk8(z0 + (f0 - z0) * m0, z1 + (f1 - z1) * m1); }
        EPI_ROWS_END
    }
};
struct EpiPlain {
    static constexpr bool PERM = true, AFTER_DRAIN = false;
    bf16_t* o; int ld;
    __device__ __forceinline__ void operator()(const f32x4 (&acc)[2][2][4][2], const Unit& u, int wr, int wc, int fr, int fq) const {
        const int row0 = u.pm * BM + wr * 64 + fr, col0 = u.pn * 256 + wc * 32 + 8 * fq;
        EPI_ROWS_BEGIN
#pragma unroll
            for (int bj = 0; bj < 2; ++bj) *(u32x4*)(o + row * ld + col0 + bj * HALF) = pk8(acc[ai][bj][m][0], acc[ai][bj][m][1]);
        EPI_ROWS_END
    }
};
template <bool SECOND> struct EpiMerge {
    static constexpr bool PERM = true, AFTER_DRAIN = false;
    const bf16_t* sg; bf16_t* m2; bf16_t* o;
    __device__ __forceinline__ void operator()(const f32x4 (&acc)[2][2][4][2], const Unit& u, int wr, int wc, int fr, int fq) const {
        const int row0 = u.pm * BM + wr * 64 + fr, col0 = u.pn * 256 + wc * 32 + 8 * fq;
        EPI_ROWS_BEGIN
#pragma unroll
            for (int bj = 0; bj < 2; ++bj) { const int c = col0 + bj * HALF;
                f32x4 g0, g1; unpk8(*(const u32x4*)(sg + row * 2048 + (SECOND ? 0 : 1024) + c), g0, g1);
                f32x4 v0 = g0 * acc[ai][bj][m][0], v1 = g1 * acc[ai][bj][m][1];
                if (SECOND) { f32x4 p0, p1; unpk8(*(const u32x4*)(m2 + row * 2048 + c), p0, p1); v0 = v0 + p0; v1 = v1 + p1; *(u32x4*)(o + row * 1024 + c) = pk8(v0, v1); }
                else *(u32x4*)(m2 + row * 2048 + c) = pk8(v0, v1); }
        EPI_ROWS_END
    }
};
struct EpiResid {
    static constexpr bool PERM = false, AFTER_DRAIN = false;
    float* h;
    __device__ __forceinline__ void operator()(const f32x4 (&acc)[2][2][4][2], const Unit& u, int wr, int wc, int fr, int fq) const {
        const int row0 = u.pm * BM + wr * 64 + fr, col0 = u.pn * 256 + wc * 32 + 4 * fq;
        EPI_ROWS_BEGIN
            float* rowp = h + row * 1024 + col0;
#pragma unroll
            for (int bj = 0; bj < 2; ++bj)
#pragma unroll
                for (int n = 0; n < 2; ++n) { f32x4* p = (f32x4*)(rowp + bj * HALF + n * 16); *p = *p + acc[ai][bj][m][n]; }
        EPI_ROWS_END
    }
};
struct EpiQG {
    static constexpr bool PERM = true, AFTER_DRAIN = false;
    bf16_t* q; const bf16_t* pw; float* h;
    __device__ __forceinline__ void operator()(const f32x4 (&acc)[2][2][4][2], const Unit& u, int wr, int wc, int fr, int fq) const {
        const int row0 = u.pm * BM + wr * 64 + fr;
        if (u.pn < 8) { const int col0 = u.pn * 256 + wc * 32 + 8 * fq;
            EPI_ROWS_BEGIN
#pragma unroll
                for (int bj = 0; bj < 2; ++bj) *(u32x4*)(q + row * 2048 + col0 + bj * HALF) = pk8(acc[ai][bj][m][0], acc[ai][bj][m][1]);
            EPI_ROWS_END
        } else { const int col0 = (u.pn - 8) * 256 + wc * 32 + 8 * fq;
            EPI_ROWS_BEGIN
#pragma unroll
                for (int bj = 0; bj < 2; ++bj) { const int c = col0 + bj * HALF;
                    f32x4 p0, p1; unpk8(*(const u32x4*)(pw + row * 1024 + c), p0, p1);
                    f32x4* hp = (f32x4*)(h + row * 1024 + c);
                    hp[0] = hp[0] + p0 * act4(acc[ai][bj][m][0], 2); hp[1] = hp[1] + p1 * act4(acc[ai][bj][m][1], 2); }
            EPI_ROWS_END
        }
    }
};
template <class Epi, class Sched, bool ALIGN_EPI = false, bool SP2 = false>
__device__ __forceinline__ void gemm_phase(PG8_LAS unsigned char* lds, const Gemm g, const Sched& S, const Epi& E, const int wave0) {
    int tidq; asm volatile("v_mbcnt_lo_u32_b32 %0, -1, 0\n\tv_mbcnt_hi_u32_b32 %0, -1, %0" : "=v"(tidq)); tidq += wave0 * 64;
    const int tid = tidq, wid = __builtin_amdgcn_readfirstlane(tid >> 6), lane = tid & 63, wr = wid >> 2, wc = wid & 3, fr = lane & 15, fq = lane >> 4;
    int Kq = g.K, ldaq = g.lda; const bf16_t* gA = g.A; const bf16_t* gB = g.Bt; asm volatile("" : "+s"(Kq), "+s"(ldaq), "+s"(gA), "+s"(gB));
    const int K = Kq, nt = K / BK;
    unsigned voffA[2], voffB[2];
#pragma unroll
    for (int i = 0; i < 2; ++i) { int R, C; stage_rc(tid * 16 + i * 8192, R, C); const int Rb = Epi::PERM ? ((R & ~31) + perm32(R & 31)) : R;
        voffA[i] = (unsigned)(R * ldaq + C) * 2u; voffB[i] = (unsigned)(Rb * K + C) * 2u; }
    const size_t kstep = (size_t)(BK * 2);
    const size_t hstepA = (size_t)HALF * ldaq * 2, hstepB = (size_t)HALF * K * 2;
    const size_t tstepA = 2 * hstepA, tstepB = 2 * hstepB;
    const unsigned ldsw = (unsigned)wid * 1024u;
    const int aoff = lds_byte(wr * 64 + fr, fq * 8), boff = lds_byte(wc * 32 + fr, fq * 8);
#define PG8_SA(b, h) (((b) * 2 + (h)) * HTB)
#define PG8_SB(b, h) ((4 + (b) * 2 + (h)) * HTB)
#define PG8_STAGE(bufoff, gbase, voff) do { _Pragma("unroll") for (int _i = 0; _i < 2; ++_i) \
        __builtin_amdgcn_global_load_lds((const unsigned*)((const char*)(gbase) + (voff)[_i]), (PG8_LAS unsigned*)(lds + (bufoff) + ldsw + _i * 8192), 16, 0, 0); } while (0)
#define PG8_LDA(dst, b, h) do { _Pragma("unroll") for (int m = 0; m < 4; ++m) _Pragma("unroll") for (int k = 0; k < 2; ++k) dst[m][k] = *(const PG8_LAS bf16x8*)(lds + PG8_SA(b, h) + aoff + m * 2048 + k * 1024); } while (0)
#define PG8_LDB(dst, b, h) do { _Pragma("unroll") for (int n = 0; n < 2; ++n) _Pragma("unroll") for (int k = 0; k < 2; ++k) dst[n][k] = *(const PG8_LAS bf16x8*)(lds + PG8_SB(b, h) + boff + n * 2048 + k * 1024); } while (0)
#define PG8_MMA(ai, bj, At, Bt) do { __builtin_amdgcn_s_setprio(1); _Pragma("unroll") for (int m = 0; m < 4; ++m) _Pragma("unroll") for (int n = 0; n < 2; ++n) _Pragma("unroll") for (int k = 0; k < 2; ++k) \
        acc[ai][bj][m][n] = __builtin_amdgcn_mfma_f32_16x16x32_bf16(Bt[n][k], At[m][k], acc[ai][bj][m][n], 0, 0, 0); __builtin_amdgcn_s_setprio(0); } while (0)
#define PG8_WAIT_V(n) asm volatile("s_waitcnt vmcnt(" #n ")" ::: "memory")
#define PG8_WAIT_L(n) asm volatile("s_waitcnt lgkmcnt(" #n ")" ::: "memory")
#define PG8_BAR __builtin_amdgcn_s_barrier()
#define PG8_SCHED __builtin_amdgcn_sched_barrier(0)
    Unit cur, nxt; int ui = 0;
    if (!S.next(0, cur)) return;
    f32x4 acc[2][2][4][2];
#pragma unroll
    for (int a = 0; a < 2; ++a)
#pragma unroll
        for (int b = 0; b < 2; ++b)
#pragma unroll
            for (int m = 0; m < 4; ++m)
#pragma unroll
                for (int n = 0; n < 2; ++n) acc[a][b][m][n] = (f32x4){0.f, 0.f, 0.f, 0.f};
    bf16x8 At[4][2], B0[2][2], B1[2][2];
    const char* cA = (const char*)gA + (size_t)cur.pm * tstepA; const char* cB = (const char*)gB + (size_t)cur.pn * tstepB;
    S.a_ready(cur);
    if constexpr (SP2) {
        PG8_STAGE(PG8_SB(0, 0), cB, voffB); PG8_STAGE(PG8_SB(0, 1), cB + hstepB, voffB); PG8_STAGE(PG8_SA(0, 0), cA, voffA); PG8_STAGE(PG8_SA(0, 1), cA + hstepA, voffA);
        if (wr == 1) PG8_BAR;
        PG8_WAIT_V(2); PG8_BAR;
        PG8_STAGE(PG8_SB(1, 0), cB + kstep, voffB); PG8_STAGE(PG8_SA(1, 0), cA + kstep, voffA); PG8_STAGE(PG8_SB(1, 1), cB + hstepB + kstep, voffB);
        PG8_WAIT_V(6); PG8_BAR;
    } else {
        PG8_STAGE(PG8_SB(0, 0), cB, voffB); PG8_STAGE(PG8_SA(0, 0), cA, voffA); PG8_STAGE(PG8_SB(0, 1), cB + hstepB, voffB); PG8_STAGE(PG8_SA(0, 1), cA + hstepA, voffA);
        if (wr == 1) PG8_BAR;
        PG8_WAIT_V(4); PG8_BAR;
        PG8_STAGE(PG8_SB(1, 0), cB + kstep, voffB); PG8_STAGE(PG8_SA(1, 0), cA + kstep, voffA); PG8_STAGE(PG8_SB(1, 1), cB + hstepB + kstep, voffB);
        PG8_WAIT_V(6); PG8_BAR;
    }
    for (;;) {
        const bool has_next = S.next(ui + 1, nxt);
        const char* nA = has_next ? (const char*)gA + (size_t)nxt.pm * tstepA : cA; const char* nB = has_next ? (const char*)gB + (size_t)nxt.pn * tstepB : cB;
        for (int t = 0; t < nt; t += 2) {
            const bool last = (t == nt - 2);
            const char* a1 = cA + (size_t)(t + 1) * kstep;
            const char* a2 = last ? nA : cA + (size_t)(t + 2) * kstep; const char* b2 = last ? nB : cB + (size_t)(t + 2) * kstep;
            const char* a3 = a2 + kstep; const char* b3 = b2 + kstep;
            if (last && has_next) S.a_ready(nxt);
            if constexpr (SP2) {
            PG8_LDB(B0, 0, 0); PG8_LDB(B1, 0, 1); PG8_SCHED; PG8_LDA(At, 0, 0); PG8_STAGE(PG8_SA(1, 1), a1 + hstepA, voffA);
            PG8_WAIT_V(8); PG8_WAIT_L(0); PG8_BAR; PG8_MMA(0, 0, At, B0); PG8_MMA(0, 1, At, B1); PG8_BAR; PG8_SCHED;
            PG8_LDA(At, 0, 1); PG8_STAGE(PG8_SB(0, 0), b2, voffB); PG8_STAGE(PG8_SB(0, 1), b2 + hstepB, voffB); PG8_STAGE(PG8_SA(0, 0), a2, voffA);
            PG8_WAIT_V(8); PG8_WAIT_L(0); PG8_BAR; PG8_MMA(1, 0, At, B0); PG8_MMA(1, 1, At, B1); PG8_BAR; PG8_SCHED;
            PG8_LDB(B0, 1, 0); PG8_LDB(B1, 1, 1); PG8_SCHED; PG8_LDA(At, 1, 0); PG8_STAGE(PG8_SA(0, 1), a2 + hstepA, voffA);
            PG8_WAIT_V(8); PG8_WAIT_L(0); PG8_BAR; PG8_MMA(0, 0, At, B0); PG8_MMA(0, 1, At, B1); PG8_BAR; PG8_SCHED;
            PG8_LDA(At, 1, 1); PG8_STAGE(PG8_SB(1, 0), b3, voffB); PG8_STAGE(PG8_SB(1, 1), b3 + hstepB, voffB); PG8_STAGE(PG8_SA(1, 0), a3, voffA);
            PG8_WAIT_V(8); PG8_WAIT_L(0); PG8_BAR; PG8_MMA(1, 0, At, B0); PG8_MMA(1, 1, At, B1); PG8_BAR; PG8_SCHED;
            } else {
            PG8_LDB(B0, 0, 0); PG8_SCHED; PG8_LDA(At, 0, 0); PG8_STAGE(PG8_SA(1, 1), a1 + hstepA, voffA);
            PG8_WAIT_L(8); PG8_BAR; PG8_WAIT_L(0); PG8_MMA(0, 0, At, B0); PG8_BAR; PG8_SCHED;
            PG8_LDB(B1, 0, 1); PG8_STAGE(PG8_SB(0, 0), b2, voffB);
            PG8_BAR; PG8_WAIT_L(0); PG8_MMA(0, 1, At, B1); PG8_BAR;
            PG8_LDA(At, 0, 1); PG8_STAGE(PG8_SA(0, 0), a2, voffA);
            PG8_BAR; PG8_WAIT_L(0); PG8_MMA(1, 0, At, B0); PG8_BAR; PG8_SCHED;
            PG8_STAGE(PG8_SB(0, 1), b2 + hstepB, voffB);
            PG8_WAIT_V(6); PG8_BAR; PG8_MMA(1, 1, At, B1); PG8_BAR;
            PG8_LDB(B0, 1, 0); PG8_SCHED; PG8_LDA(At, 1, 0); PG8_STAGE(PG8_SA(0, 1), a2 + hstepA, voffA);
            PG8_WAIT_L(8); PG8_BAR; PG8_WAIT_L(0); PG8_MMA(0, 0, At, B0); PG8_BAR; PG8_SCHED;
            PG8_LDB(B1, 1, 1); PG8_STAGE(PG8_SB(1, 0), b3, voffB);
            PG8_BAR; PG8_WAIT_L(0); PG8_MMA(0, 1, At, B1); PG8_BAR;
            PG8_LDA(At, 1, 1); PG8_STAGE(PG8_SA(1, 0), a3, voffA);
            PG8_BAR; PG8_WAIT_L(0); PG8_MMA(1, 0, At, B0); PG8_BAR; PG8_SCHED;
            PG8_STAGE(PG8_SB(1, 1), b3 + hstepB, voffB);
            PG8_WAIT_V(6); PG8_BAR; PG8_MMA(1, 1, At, B1); PG8_BAR;
            }
        }
        if constexpr (ALIGN_EPI) { if (wr == 0) PG8_BAR; }
        if constexpr (!Epi::AFTER_DRAIN) { E(acc, cur, wr, wc, fr, fq); S.done(cur); }
        if (!has_next) break;
#pragma unroll
        for (int a = 0; a < 2; ++a)
#pragma unroll
            for (int b = 0; b < 2; ++b)
#pragma unroll
                for (int m = 0; m < 4; ++m)
#pragma unroll
                    for (int n = 0; n < 2; ++n) acc[a][b][m][n] = (f32x4){0.f, 0.f, 0.f, 0.f};
        cur = nxt; cA = nA; cB = nB; ++ui;
        if constexpr (ALIGN_EPI) { if (wr == 1) PG8_BAR; }
    }
    PG8_WAIT_V(0);
    if constexpr (!ALIGN_EPI) { if (wr == 0) PG8_BAR; }
    PG8_BAR;
    if constexpr (Epi::AFTER_DRAIN) { E.fused(acc, cur, wr, wc, fr, fq, lds, wid, lane); S.done(cur); }
#undef PG8_SA
#undef PG8_SB
#undef PG8_STAGE
#undef PG8_LDA
#undef PG8_LDB
#undef PG8_MMA
#undef PG8_WAIT_V
#undef PG8_WAIT_L
#undef PG8_BAR
#undef PG8_SCHED
}
}

constexpr int NB = 8, SEQ = 4096, T = NB * SEQ, D = 1024, DEPTH = 4, NZ = 7680, NWAVES = 8;
constexpr int CIN = 7424;
constexpr size_t MiB = 1u << 20;
constexpr size_t WS_CTL = 0, WS_LORA = 1 * MiB, WS_MV = 7 * MiB, ZERO_BYTES = 9 * MiB;
constexpr size_t LORA_BYTES = 3072 * 256 * 2, MV_BYTES = 1024 * 256 * 2;
constexpr size_t WS_WIN = 10 * MiB;
constexpr size_t WS_DB = 40 * MiB, DB_SET = 62 * MiB;
constexpr size_t DB_PA = 0, DB_PBT = 2 * MiB, DB_POUT = 4 * MiB, DB_WQG = 6 * MiB, DB_KEYS = 12 * MiB, DB_GMW = 12 * MiB + 512 * 1024, DB_PLEW = 13 * MiB, DB_U = 14 * MiB, DB_V = 30 * MiB, DB_PB = 46 * MiB;
constexpr size_t WS_VF = 164 * MiB, WS_PW = 228 * MiB, WS_NX = 292 * MiB, WS_ZRKV = 420 * MiB, WS_ZL = 612 * MiB, WS_GUV = 644 * MiB, WS_SG = 772 * MiB;
constexpr size_t WS_EW = 900 * MiB, WS_AR = 964 * MiB, WS_G = 1028 * MiB, WS_END = 1092 * MiB;
constexpr size_t WS_YAB = WS_NX, WS_Q = WS_ZRKV, WS_SEL = WS_ZRKV + 128 * MiB, WS_MG = WS_AR, WS_N2 = WS_G;
constexpr size_t WIN_ZERO_OFF = WS_WIN + (size_t)3328 * 2048 * 2, WIN_ZERO_BYTES = (size_t)256 * 2048 * 2;
constexpr int CW_BAR = 4096;
constexpr int RING_BYTES = 131072, LDSCTL_OFF = RING_BYTES, MISC_OFF = LDSCTL_OFF + 320, LDS_BYTES = 147456;

#define LAS __attribute__((address_space(3)))
#define GAS __attribute__((address_space(1)))
typedef unsigned short bf16;
typedef unsigned v4u __attribute__((ext_vector_type(4)));
typedef unsigned v2u __attribute__((ext_vector_type(2)));
typedef float f32x4 __attribute__((ext_vector_type(4)));
typedef float f32x2 __attribute__((ext_vector_type(2)));
typedef short bf16x8 __attribute__((ext_vector_type(8)));
using pg8::fsig; using pg8::fgelu; using pg8::bflo; using pg8::bfhi; using pg8::unpk8; using pg8::pk8; using pg8::cvt_pk_bf16;

#define XB_TMO      128
#define XB_XCNT(j)  (256  + 64 * (j))
#define XB_XSUB(j)  (1280 + 64 * (j))
#define XB_XGEN(j)  (2304 + 64 * (j))
#define XB_TOP      3328
#define XB_TOPGEN   3392
#define XCD_BAR_WORDS 3456
#define XB_SPIN_CAP (1u << 22)

__device__ __forceinline__ unsigned xb_ld(unsigned* p)              { return __hip_atomic_load(p, __ATOMIC_RELAXED, __HIP_MEMORY_SCOPE_AGENT); }
__device__ __forceinline__ unsigned xb_add(unsigned* p, unsigned v) { return __hip_atomic_fetch_add(p, v, __ATOMIC_RELAXED, __HIP_MEMORY_SCOPE_AGENT); }
__device__ __forceinline__ unsigned xb_xcc_id() { return (unsigned)__builtin_amdgcn_s_getreg((3 << 11) | 20) & 0xFu; }
#define XB_SPIN(cond, bar) do { unsigned _sp = 0; while (cond) { __builtin_amdgcn_s_sleep(1); \
    if ((++_sp & 255u) == 0u) { if (xb_ld(&(bar)[XB_TMO])) break; if (_sp > XB_SPIN_CAP) { atomicAdd(&(bar)[XB_TMO], 1u); break; } } } } while (0)

struct XcdBarrier { unsigned* bar; unsigned x; volatile LAS unsigned* st; };

__device__ __forceinline__ XcdBarrier xcd_barrier_post(unsigned* bar, volatile LAS unsigned* st) {
    XcdBarrier b; b.bar = bar; b.x = xb_xcc_id(); b.st = st;
    if (threadIdx.x == 0) (void)xb_add(&bar[XB_XCNT(b.x)], 1u);
    return b;
}
__device__ __forceinline__ void xcd_barrier_complete(unsigned* bar, unsigned x, unsigned& nloc, unsigned& nx) {
    const unsigned G = gridDim.x * gridDim.y * gridDim.z;
    unsigned sum, cnt, mine, sp = 0u;
    for (;;) {
        sum = 0u; cnt = 0u; mine = 0u;
#pragma unroll
        for (unsigned j = 0; j < 16; ++j) { const unsigned c = xb_ld(&bar[XB_XCNT(j)]); sum += c; cnt += (c > 0u) ? 1u : 0u; mine = (j == x) ? c : mine; }
        if (sum == G) break;
        __builtin_amdgcn_s_sleep(1);
        if ((++sp & 255u) == 0u) { if (xb_ld(&bar[XB_TMO])) break; if (sp > XB_SPIN_CAP) { atomicAdd(&bar[XB_TMO], 1u); break; } }
    }
    nloc = mine > 0u ? mine : 1u; nx = cnt > 0u ? cnt : 1u;
}
__device__ __forceinline__ int lane_id_now();
__device__ __forceinline__ void xcd_barrier(const XcdBarrier& b, const int wave0) {
    asm volatile("s_waitcnt vmcnt(0)" ::: "memory");
    __syncthreads();
    if (wave0 == 0 && lane_id_now() == 0) {
        unsigned* bar = b.bar;
        __builtin_amdgcn_s_waitcnt(0);
        unsigned nloc = b.st[0], nx = b.st[1];
        if (nloc == 0u) { xcd_barrier_complete(bar, b.x, nloc, nx); b.st[0] = nloc; b.st[1] = nx; }
        const unsigned old = xb_add(&bar[XB_XSUB(b.x)], 1u);
        const unsigned gen = old / nloc;
        if (old + 1u == (gen + 1u) * nloc) {
            __builtin_amdgcn_fence(__ATOMIC_RELEASE, "agent");
            asm volatile("s_waitcnt vmcnt(0)" ::: "memory");
            const unsigned og = xb_add(&bar[XB_TOP], 1u);
            const unsigned tg = og / nx;
            if (og + 1u == (tg + 1u) * nx) xb_add(&bar[XB_TOPGEN], 1u);
            else XB_SPIN(xb_ld(&bar[XB_TOPGEN]) == tg, bar);
            __builtin_amdgcn_fence(__ATOMIC_ACQUIRE, "agent");
            xb_add(&bar[XB_XGEN(b.x)], 1u);
            asm volatile("s_waitcnt vmcnt(0)" ::: "memory");
        } else {
            XB_SPIN(xb_ld(&bar[XB_XGEN(b.x)]) == gen, bar);
            __builtin_amdgcn_fence(__ATOMIC_ACQUIRE, "agent");
            asm volatile("s_waitcnt vmcnt(0)" ::: "memory");
        }
    }
    __syncthreads();
}

struct Args { const float* in[32]; float* out; unsigned char* ws; };
struct Frame {
    LAS unsigned char* lds;
    int tid, lane, wave, G, bx, wave0;
    GAS unsigned char* ws; float* h;
};
__device__ __forceinline__ int lane_id_now() { int l; asm volatile("v_mbcnt_lo_u32_b32 %0, -1, 0\n\tv_mbcnt_hi_u32_b32 %0, -1, %0" : "=v"(l)); return l; }
__device__ __forceinline__ void phase_ids(Frame& F) { const int l = lane_id_now(); F.lane = l; F.wave = F.wave0; F.tid = F.wave0 * 64 + l; GAS unsigned char* w = F.ws; asm volatile("" : "+s"(w)); F.ws = w; }
#define DPP_ADD(x, ctrl) ((x) + __builtin_bit_cast(float, __builtin_amdgcn_update_dpp(0, __builtin_bit_cast(int, (x)), (ctrl), 0xf, 0xf, false)))
__device__ __forceinline__ float sum8(float v) {
    v = DPP_ADD(v, 0xB1);
    v = DPP_ADD(v, 0x4E);
    v = DPP_ADD(v, 0x141);
    return v;
}
__device__ __forceinline__ float wave_sum(float v) {
    v = sum8(v);
    v = DPP_ADD(v, 0x140);
    const auto r = __builtin_amdgcn_permlane16_swap(__builtin_bit_cast(unsigned, v), __builtin_bit_cast(unsigned, v), false, false);
    v = __builtin_bit_cast(float, (unsigned)r[0]) + __builtin_bit_cast(float, (unsigned)r[1]);
    const auto q = __builtin_amdgcn_permlane32_swap(__builtin_bit_cast(unsigned, v), __builtin_bit_cast(unsigned, v), false, false);
    return __builtin_bit_cast(float, (unsigned)q[0]) + __builtin_bit_cast(float, (unsigned)q[1]);
}
__device__ __forceinline__ unsigned xor16_u(unsigned x, int lane) { const auto r = __builtin_amdgcn_permlane16_swap(x, x, false, false); return (lane & 16) ? (unsigned)r[0] : (unsigned)r[1]; }
__device__ __forceinline__ unsigned xor32_u(unsigned x, int lane) { const auto r = __builtin_amdgcn_permlane32_swap(x, x, false, false); return (lane & 32) ? (unsigned)r[0] : (unsigned)r[1]; }
__device__ __forceinline__ void tr_item(const float* W, int ldw, int ncols, bf16* WT, int ldt, int koff, int row_off, LAS float* scr, int item, int lane) {
    const int nblk = ncols / 32, kb = item / nblk, nb = item % nblk, k0 = 64 * kb, n0 = 32 * nb;
#pragma unroll 8
    for (int i = 0; i < 32; ++i) { const int kk = 2 * i + (lane >> 5); scr[kk * 33 + (lane & 31)] = W[(size_t)(k0 + kk) * ldw + n0 + (lane & 31)]; }
    asm volatile("s_waitcnt lgkmcnt(0)" ::: "memory");
    const int c = lane & 7;
#pragma unroll
    for (int j = 0; j < 4; ++j) { const int n = (lane >> 3) + 8 * j; const LAS float* s = scr + (8 * c) * 33 + n;
        v4u o; o.x = cvt_pk_bf16(s[0 * 33], s[1 * 33]); o.y = cvt_pk_bf16(s[2 * 33], s[3 * 33]); o.z = cvt_pk_bf16(s[4 * 33], s[5 * 33]); o.w = cvt_pk_bf16(s[6 * 33], s[7 * 33]);
        *(v4u*)(WT + (size_t)(row_off + n0 + n) * ldt + koff + k0 + 8 * c) = o; }
    asm volatile("s_waitcnt lgkmcnt(0)" ::: "memory");
}
__device__ __forceinline__ void cvt_chunk(const float* src, bf16* dst, size_t chunk, int lane) {
    const f32x4* s = (const f32x4*)(src + chunk * 512) + lane * 2; const f32x4 a = s[0], b = s[1];
    *(v4u*)(dst + chunk * 512 + lane * 8) = pk8(a, b);
}
__device__ __forceinline__ void cvt8_chunk(const float* src, unsigned char* dst, size_t chunk, int lane, float sc) {
    const f32x4* s = (const f32x4*)(src + chunk * 512) + lane * 2; const f32x4 a = s[0] * sc, b = s[1] * sc;
    int w0 = 0, w1 = 0;
    w0 = __builtin_amdgcn_cvt_pk_fp8_f32(a.x, a.y, w0, false); w0 = __builtin_amdgcn_cvt_pk_fp8_f32(a.z, a.w, w0, true);
    w1 = __builtin_amdgcn_cvt_pk_fp8_f32(b.x, b.y, w1, false); w1 = __builtin_amdgcn_cvt_pk_fp8_f32(b.z, b.w, w1, true);
    *(v2u*)(dst + chunk * 512 + lane * 8) = (v2u){(unsigned)w0, (unsigned)w1};
}
__device__ __forceinline__ void norm_row_nx(const float* hrow, float* hcopy, const float* g, bf16* NX, int t, int lane) {
    const f32x4* xr = (const f32x4*)hrow + lane; f32x4 v[4]; float s = 0.f;
#pragma unroll
    for (int j = 0; j < 4; ++j) { v[j] = xr[64 * j]; s += (v[j].x * v[j].x + v[j].y * v[j].y) + (v[j].z * v[j].z + v[j].w * v[j].w); }
    if (hcopy) {
#pragma unroll
        for (int j = 0; j < 4; ++j) ((f32x4*)hcopy)[lane + 64 * j] = v[j]; }
    const float rstd = 1.f / sqrtf(wave_sum(s) * (1.f / D) + 1e-6f);
    const int tt = t & (SEQ - 1);
#pragma unroll
    for (int j = 0; j < 4; ++j) { const f32x4 gv = ((const f32x4*)g)[lane + 64 * j]; const f32x4 o = v[j] * rstd * gv;
        v2u w; w.x = cvt_pk_bf16(o.x, o.y); w.y = cvt_pk_bf16(o.z, o.w);
        const int c = 4 * (lane + 64 * j);
        *(v2u*)(NX + (size_t)t * 2048 + c) = w;
        if (tt != SEQ - 1) *(v2u*)(NX + (size_t)(t + 1) * 2048 + 1024 + c) = w;
        if (tt == 0) *(v2u*)(NX + (size_t)t * 2048 + 1024 + c) = (v2u){0u, 0u}; }
}
__device__ __forceinline__ void norm_row_n2(const float* hrow, const float* g, bf16* N2row, int lane) {
    const f32x4* xr = (const f32x4*)hrow + lane; f32x4 v[4]; float s = 0.f;
#pragma unroll
    for (int j = 0; j < 4; ++j) { v[j] = xr[64 * j]; s += (v[j].x * v[j].x + v[j].y * v[j].y) + (v[j].z * v[j].z + v[j].w * v[j].w); }
    const float rstd = 1.f / sqrtf(wave_sum(s) * (1.f / D) + 1e-6f);
#pragma unroll
    for (int j = 0; j < 4; ++j) { const f32x4 gv = ((const f32x4*)g)[lane + 64 * j]; const f32x4 o = v[j] * rstd * gv;
        v2u w; w.x = cvt_pk_bf16(o.x, o.y); w.y = cvt_pk_bf16(o.z, o.w);
        *(v2u*)(N2row + 4 * (lane + 64 * j)) = w; }
}

__device__ __forceinline__ void prep_phase(Frame& F, const Args& a, int layer, int blk, int nblk_) {
    phase_ids(F);
    LAS float* scr = (LAS float*)(F.lds + F.wave * 16384);
    const int gw = blk * NWAVES + F.wave, NGW = nblk_ * NWAVES, lane = F.lane;
    GAS unsigned char* ws = F.ws; GAS unsigned char* db = F.ws + WS_DB + (size_t)(layer & 1) * DB_SET;
    bf16* WIN = (bf16*)(ws + WS_WIN); bf16* LORA = (bf16*)(ws + WS_LORA + (size_t)layer * LORA_BYTES); bf16* MVT = (bf16*)(ws + WS_MV + (size_t)(layer > 0 ? layer - 1 : 0) * MV_BYTES);
    const float* w_in = a.in[5] + (size_t)layer * 2048 * CIN;
    const int mvn = layer > 0 ? 32 : 0;
    const int c1 = 32 * 104, c2 = 32 * 128, c3 = mvn, c4 = 32, c5 = 32, c6 = 64, c7 = 512, c10 = 1024, c12 = 128;
    const int total = c1 + c2 + c3 + c4 + c5 + c6 + 3 * c7 + c10 + c7 + c12;
    for (int it = gw; it < total; it += NGW) {
        int r = it;
        if (r < c1) { tr_item(w_in, CIN, 3328, WIN, 2048, 0, 0, scr, r, lane); continue; } r -= c1;
        if (r < c2) { tr_item(w_in + 3328, CIN, 4096, WIN, 2048, 0, 3584, scr, r, lane); continue; } r -= c2;
        if (r < c3) { tr_item(a.in[16] + (size_t)(layer - 1) * 2048 * 32, 32, 32, WIN, 2048, 0, 3328, scr, r, lane); continue; } r -= c3;
        if (r < c4) { tr_item(a.in[7] + (size_t)layer * 64 * 1024, 1024, 1024, LORA, 256, 0, 0, scr, r, lane); continue; } r -= c4;
        if (r < c5) { tr_item(a.in[9] + (size_t)layer * 64 * 1024, 1024, 1024, LORA, 256, 64, 1024, scr, r, lane); continue; } r -= c5;
        if (r < c6) { tr_item(a.in[10] + (size_t)layer * 128 * 1024, 1024, 1024, LORA, 256, 128, 2048, scr, r, lane); continue; } r -= c6;
        if (r < c7) { tr_item(a.in[23] + (size_t)layer * D * D, D, D, (bf16*)(db + DB_PA), D, 0, 0, scr, r, lane); continue; } r -= c7;
        if (r < c7) { tr_item(a.in[24] + (size_t)layer * D * D, D, D, (bf16*)(db + DB_PBT), D, 0, 0, scr, r, lane); continue; } r -= c7;
        if (r < c7) { tr_item(a.in[25] + (size_t)layer * D * D, D, D, (bf16*)(db + DB_POUT), D, 0, 0, scr, r, lane); continue; } r -= c7;
        if (r < c10) { tr_item(a.in[26] + (size_t)layer * D * 2048, 2048, 2048, (bf16*)(db + DB_WQG), D, 0, 0, scr, r, lane); continue; } r -= c10;
        if (r < c7) { tr_item(a.in[31] + (size_t)layer * D * D, D, D, (bf16*)(db + DB_WQG), D, 0, 2048, scr, r, lane); continue; } r -= c7;
        tr_item(a.in[30] + (size_t)layer * 256 * D, D, D, (bf16*)(db + DB_PLEW), 256, 0, 0, scr, r, lane);
    }
    if (layer > 0) {
        const float* w2 = a.in[17] + (size_t)(layer - 1) * 32 * 1024;
        for (int it = gw; it < 512; it += NGW) { const int e = it * 64 + lane, n = e >> 5, k = e & 31; MVT[n * 256 + k] = (bf16)(cvt_pk_bf16(w2[k * 1024 + n], 0.f) & 0xffffu); }
    }
    {
        const float* keys = a.in[27] + (size_t)layer * 262144; const float* ut = a.in[28] + (size_t)layer * 16777216; const float* vt = a.in[29] + (size_t)layer * 16777216;
        const float* pin = a.in[1] + (size_t)layer * T * 256; const float* gws = a.in[21] + (size_t)layer * 131072;
        const int n1 = 512, n2 = 32768, n4 = 16384, n5 = 256, ntot = n1 + 2 * n2 + n4 + n5;
        for (int it = gw; it < ntot; it += NGW) {
            int r = it;
            if (r < n2) { cvt8_chunk(ut, (unsigned char*)(db + DB_U), r, lane, 256.f); continue; } r -= n2;
            if (r < n2) { cvt8_chunk(vt, (unsigned char*)(db + DB_V), r, lane, 64.f); continue; } r -= n2;
            if (r < n4) { cvt_chunk(pin, (bf16*)(db + DB_PB), r, lane); continue; } r -= n4;
            if (r < n1) { cvt_chunk(keys, (bf16*)(db + DB_KEYS), r, lane); continue; } r -= n1;
            {
                const int e0 = r * 512 + lane * 8, tq = (e0 >> 7) & 127, p0 = e0 & 127;
                const f32x4* s = (const f32x4*)(gws + e0); f32x4 x0 = s[0], x1 = s[1];
#pragma unroll
                for (int j = 0; j < 4; ++j) { if (p0 + j > tq) x0[j] = 0.f; if (p0 + 4 + j > tq) x1[j] = 0.f; }
                *(v4u*)((bf16*)(db + DB_GMW) + e0) = pk8(x0, x1);
            }
        }
    }
    if (layer == 0) {
        for (int m = gw; m < T; m += NGW) norm_row_nx(a.in[0] + (size_t)m * D, F.h + (size_t)m * D, a.in[2], (bf16*)(ws + WS_NX), m, lane);
    }
}

constexpr int SC = 32;
constexpr int SC_VEC = SC * 64;
constexpr int SC_V = SC_VEC, SC_BK = 2 * SC_VEC, SC_XA = SC_BK + SC * 64, SC_C = SC_XA + SC * 64, SC_BON = SC_C + SC * 4, SC_BUF = SC_BON + SC * 8;
struct ScanOps { f32x4 w[4], c; v4u bk; bf16x8 x[2]; float v; };
__device__ __forceinline__ void scan_load2(ScanOps& o, const LAS float* buf, const LAS float* vbuf, const LAS unsigned char* bkp, int bkstep, int s, int lane) {
    const int q = lane >> 4;
    const LAS float* p = buf + s * 64 + q * 4;
#pragma unroll
    for (int i = 0; i < 4; ++i) o.w[i] = *(const LAS f32x4*)(p + 16 * i);
    o.v = vbuf[SC_V + s * 64 + (lane & 15)];
    o.bk = *(const LAS v4u*)(bkp + s * bkstep);
    const LAS unsigned char* xp = (const LAS unsigned char*)(buf + SC_XA) + s * 256 + (lane & 1) * 128 + q * 16;
    o.x[0] = *(const LAS bf16x8*)xp; o.x[1] = *(const LAS bf16x8*)(xp + 64);
    o.c = *(const LAS f32x4*)(buf + SC_C + s * 4);
}
__device__ __forceinline__ float smul(float a, float b) { float r; asm("v_mul_f32 %0, %1, %2" : "=v"(r) : "v"(a), "v"(b)); return r; }
__device__ __forceinline__ void scan_step(const ScanOps& o, f32x4 (&St)[4], float& sa, v4u (&am)[4], v4u& bm, LAS float* ypt, unsigned m16) {
    v4u s0, s1;
    s0.x = cvt_pk_bf16(St[0].x, St[0].y); s0.y = cvt_pk_bf16(St[0].z, St[0].w); s0.z = cvt_pk_bf16(St[1].x, St[1].y); s0.w = cvt_pk_bf16(St[1].z, St[1].w);
    s1.x = cvt_pk_bf16(St[2].x, St[2].y); s1.y = cvt_pk_bf16(St[2].z, St[2].w); s1.z = cvt_pk_bf16(St[3].x, St[3].y); s1.w = cvt_pk_bf16(St[3].z, St[3].w);
    f32x4 dv = (f32x4){0.f, 0.f, 0.f, 0.f};
    dv = __builtin_amdgcn_mfma_f32_16x16x32_bf16(o.x[0], __builtin_bit_cast(bf16x8, s0), dv, 0, 0, 0);
    dv = __builtin_amdgcn_mfma_f32_16x16x32_bf16(o.x[1], __builtin_bit_cast(bf16x8, s1), dv, 0, 0, 0);
    bm.x = cvt_pk_bf16(sa, o.v) & m16;
#pragma unroll
    for (int i = 0; i < 4; ++i) { am[i].x = o.bk[i];
        St[i] = __builtin_amdgcn_mfma_f32_16x16x32_bf16(__builtin_bit_cast(bf16x8, am[i]), __builtin_bit_cast(bf16x8, bm), (f32x4){smul(St[i].x, o.w[i].x), smul(St[i].y, o.w[i].y), smul(St[i].z, o.w[i].z), smul(St[i].w, o.w[i].w)}, 0, 0, 0); }
    *ypt = dv.y + sa * o.c.z + o.v * o.c.w;
    sa = dv.x + sa * o.c.x + o.v * o.c.y;
}
__device__ __forceinline__ void scan_unit(Frame& F, const Args& a, int layer, int unit) {
    phase_ids(F);
    const int b = unit >> 4, hh = unit & 15, tid = F.tid, lane = F.lane, wave = F.wave;
    LAS float* bufs = (LAS float*)F.lds;
    LAS float* sY = bufs + 2 * SC_BUF;
    const bf16* ZR = (const bf16*)(F.ws + WS_ZRKV); const bf16* EW = (const bf16*)(F.ws + WS_EW); const bf16* AR = (const bf16*)(F.ws + WS_AR); const bf16* GT = (const bf16*)(F.ws + WS_G);
    bf16* YAB = (bf16*)(F.ws + WS_YAB);
    constexpr int NCH = SEQ / SC;
    if (wave < 4) {
        f32x4 St[4]; v4u am[4], bm = (v4u){0u, 0u, 0u, 0u};
#pragma unroll
        for (int i = 0; i < 4; ++i) { St[i] = (f32x4){0.f, 0.f, 0.f, 0.f}; am[i] = (v4u){0u, 0u, 0u, 0u}; }
        float sa = 0.f;
        const unsigned m16 = lane < 16 ? 0xffffffffu : 0u;
        LAS unsigned char* zblk = (LAS unsigned char*)(sY + 2 * SC_VEC);
        if (tid < 4) ((LAS unsigned*)zblk)[tid] = 0u;
        const int bkstep = lane < 16 ? 256 : 0;
        for (int it = 0; it < NCH + 2; ++it) {
            if (it >= 1 && it <= NCH) {
                const LAS float* bufc = bufs + ((it - 1) & 1) * SC_BUF;
                const LAS float* vbuf = bufc + wave * 16;
                const LAS unsigned char* bkp = lane < 16 ? (const LAS unsigned char*)(bufc + SC_BK) + lane * 16 : (const LAS unsigned char*)zblk;
                LAS float* yb = lane < 16 ? sY + ((it - 1) & 1) * SC_VEC + wave * 16 + lane : (LAS float*)(zblk + 16) - 0;
                const int ystep = lane < 16 ? 64 : 0;
                ScanOps o0, o1;
                scan_load2(o0, bufc, vbuf, bkp, bkstep, 0, lane);
#pragma unroll 1
                for (int s = 0; s < SC; s += 2) {
                    scan_load2(o1, bufc, vbuf, bkp, bkstep, s + 1, lane);
                    scan_step(o0, St, sa, am, bm, yb + s * ystep, m16);
                    if (s + 2 < SC) scan_load2(o0, bufc, vbuf, bkp, bkstep, s + 2, lane);
                    scan_step(o1, St, sa, am, bm, yb + (s + 1) * ystep, m16);
                }
            }
            __syncthreads();
        }
    } else {
        const int ht = tid - 256, tl = ht >> 3, c8 = ht & 7, ch = hh * 64 + c8 * 8;
        const size_t po = (size_t)layer * 1024 + ch;
        struct HelpIn { v4u zr, zk, zv, ew, ar, zkn, gt; };
        HelpIn cur, nxt;
#define HELP_LOAD(H, PC, GC) do { \
            if ((PC) < NCH) { const int _t = (PC) * SC + tl; const size_t _row = (size_t)b * SEQ + _t; \
                (H).zr = *(const v4u*)(ZR + _row * 3072 + ch); (H).zk = *(const v4u*)(ZR + _row * 3072 + 1024 + ch); (H).zv = *(const v4u*)(ZR + _row * 3072 + 2048 + ch); \
                (H).ew = *(const v4u*)(EW + _row * 1024 + ch); (H).ar = *(const v4u*)(AR + _row * 1024 + ch); \
                (H).zkn = (_t + 1 < SEQ) ? *(const v4u*)(ZR + (_row + 1) * 3072 + 1024 + ch) : (v4u){0u, 0u, 0u, 0u}; } \
            if ((GC) >= 0 && (GC) < NCH) { const size_t _row = (size_t)b * SEQ + (size_t)(GC) * SC + tl; (H).gt = *(const v4u*)(GT + _row * 1024 + ch); } } while (0)
        HELP_LOAD(cur, 0, -2);
        for (int it = 0; it < NCH + 2; ++it) {
            HELP_LOAD(nxt, it + 1, it - 1);
            if (it >= 2) {
                const LAS float* buf = bufs + (it & 1) * SC_BUF; const LAS float* yb = sY + (it & 1) * SC_VEC;
                const size_t row = (size_t)b * SEQ + (size_t)(it - 2) * SC + tl; const int o = tl * 64 + c8 * 8;
                f32x4 y_[2], v_[2], g_[2];
#pragma unroll
                for (int i = 0; i < 2; ++i) { y_[i] = *(const LAS f32x4*)(yb + o + 4 * i); v_[i] = *(const LAS f32x4*)(buf + SC_V + o + 4 * i); }
                const float bon = buf[SC_BON + tl * 8 + c8];
                unpk8(cur.gt, g_[0], g_[1]);
                const float s1 = ((y_[0].x + y_[0].y) + (y_[0].z + y_[0].w)) + ((y_[1].x + y_[1].y) + (y_[1].z + y_[1].w));
                const float mu = sum8(s1) * (1.f / 64.f);
                float s2 = 0.f;
#pragma unroll
                for (int i = 0; i < 2; ++i) { y_[i] = y_[i] - mu; const f32x4 q = y_[i] * y_[i]; s2 += (q.x + q.y) + (q.z + q.w); }
                const float rstd = 1.f / sqrtf(sum8(s2) * (1.f / 64.f) + 64e-5f);
                f32x4 o_[2];
#pragma unroll
                for (int i = 0; i < 2; ++i) o_[i] = (y_[i] * rstd * *(const f32x4*)(a.in[14] + po + 4 * i) + *(const f32x4*)(a.in[15] + po + 4 * i) + bon * v_[i]) * g_[i];
                *(v4u*)(YAB + row * 2048 + ch) = pk8(o_[0], o_[1]);
            }
            if (it < NCH) {
                LAS float* buf = bufs + (it & 1) * SC_BUF;
                f32x4 r_[2], k_[2], v_[2], e_[2], ar_[2], kn_[2];
                unpk8(cur.zr, r_[0], r_[1]); unpk8(cur.zk, k_[0], k_[1]); unpk8(cur.zv, v_[0], v_[1]); unpk8(cur.ew, e_[0], e_[1]); unpk8(cur.ar, ar_[0], ar_[1]); unpk8(cur.zkn, kn_[0], kn_[1]);
                f32x4 kkv[2], kp[2]; float ss = 0.f, bs = 0.f, sn = 0.f;
#pragma unroll
                for (int i = 0; i < 2; ++i) { const f32x4 pkk_ = *(const f32x4*)(a.in[11] + po + 4 * i), pka_ = *(const f32x4*)(a.in[12] + po + 4 * i), prk_ = *(const f32x4*)(a.in[13] + po + 4 * i);
                    kkv[i] = k_[i] * pkk_; kp[i] = k_[i] * (1.f + (ar_[i] - 1.f) * pka_); kn_[i] = kn_[i] * pkk_;
                    const f32x4 q = kkv[i] * kkv[i]; ss += (q.x + q.y) + (q.z + q.w); const f32x4 z = r_[i] * kp[i] * prk_; bs += (z.x + z.y) + (z.z + z.w);
                    const f32x4 qn = kn_[i] * kn_[i]; sn += (qn.x + qn.y) + (qn.z + qn.w); }
                ss = sum8(ss); sn = sum8(sn); const float bon = sum8(bs);
                const float inv = 1.f / sqrtf(fmaxf(ss, 1e-24f)), invn = -1.f / sqrtf(fmaxf(sn, 1e-24f));
                const int o = tl * 64 + c8 * 8; float c1 = 0.f, c2 = 0.f, c3 = 0.f, c4 = 0.f;
                f32x4 xa_[2], xr_[2];
#pragma unroll
                for (int i = 0; i < 2; ++i) { const f32x4 kn = kkv[i] * inv, bq = kn * ar_[i], an = kn_[i] * invn;
                    f32x4 w4; w4.x = __builtin_amdgcn_exp2f(-1.44269504f * e_[i].x); w4.y = __builtin_amdgcn_exp2f(-1.44269504f * e_[i].y); w4.z = __builtin_amdgcn_exp2f(-1.44269504f * e_[i].z); w4.w = __builtin_amdgcn_exp2f(-1.44269504f * e_[i].w);
                    const f32x4 z1 = bq * an, z2 = kp[i] * an, z3 = bq * r_[i], z4 = kp[i] * r_[i];
                    c1 += (z1.x + z1.y) + (z1.z + z1.w); c2 += (z2.x + z2.y) + (z2.z + z2.w); c3 += (z3.x + z3.y) + (z3.z + z3.w); c4 += (z4.x + z4.y) + (z4.z + z4.w);
                    xa_[i] = w4 * an; xr_[i] = w4 * r_[i];
                    *(LAS f32x4*)(buf + o + 4 * i) = w4; *(LAS f32x4*)(buf + SC_V + o + 4 * i) = v_[i];
                    { LAS unsigned* bkp = (LAS unsigned*)(buf + SC_BK) + tl * 64 + (((c8 & 1) * 8 + 4 * i) * 4 + (c8 >> 1));
                      bkp[0] = cvt_pk_bf16(bq.x, kp[i].x); bkp[4] = cvt_pk_bf16(bq.y, kp[i].y); bkp[8] = cvt_pk_bf16(bq.z, kp[i].z); bkp[12] = cvt_pk_bf16(bq.w, kp[i].w); }
                    { LAS unsigned char* xp = (LAS unsigned char*)(buf + SC_XA) + tl * 256 + (c8 >> 2) * 64 + (2 * (c8 & 1) + i) * 16 + ((c8 >> 1) & 1) * 8;
                      *(LAS v2u*)xp = (v2u){cvt_pk_bf16(xa_[i].x, xa_[i].y), cvt_pk_bf16(xa_[i].z, xa_[i].w)};
                      *(LAS v2u*)(xp + 128) = (v2u){cvt_pk_bf16(xr_[i].x, xr_[i].y), cvt_pk_bf16(xr_[i].z, xr_[i].w)}; } }
                c1 = sum8(c1); c2 = sum8(c2); c3 = sum8(c3); c4 = sum8(c4);
                if (c8 == 0) *(LAS f32x4*)(buf + SC_C + tl * 4) = (f32x4){c1, c2, c3, c4};
                buf[SC_BON + tl * 8 + c8] = bon;
            }
            cur = nxt;
            __syncthreads();
        }
#undef HELP_LOAD
    }
}

constexpr int TP = 136;
__device__ __forceinline__ void mma_128(const LAS bf16* sA, const LAS bf16* sBt, int wave, int lane, f32x4 (&acc)[4][2]) {
    const int wm = wave >> 2, wn = wave & 3, fr = lane & 15, fq = lane >> 4;
#pragma unroll
    for (int kk = 0; kk < 4; ++kk) {
        bf16x8 af[4], bf_[2];
#pragma unroll
        for (int mt = 0; mt < 4; ++mt) af[mt] = *(const LAS bf16x8*)(sA + (64 * wm + 16 * mt + fr) * TP + 32 * kk + 8 * fq);
#pragma unroll
        for (int nt = 0; nt < 2; ++nt) bf_[nt] = *(const LAS bf16x8*)(sBt + (32 * wn + 16 * nt + fr) * TP + 32 * kk + 8 * fq);
#pragma unroll
        for (int mt = 0; mt < 4; ++mt)
#pragma unroll
            for (int nt = 0; nt < 2; ++nt) acc[mt][nt] = __builtin_amdgcn_mfma_f32_16x16x32_bf16(bf_[nt], af[mt], acc[mt][nt], 0, 0, 0);
    }
}
__device__ __forceinline__ void gmlp_unit(Frame& F, const Args& a, int layer, int unit) {
    phase_ids(F);
    const size_t t0 = (size_t)unit * 128; const int tid = F.tid, lane = F.lane, wave = F.wave;
    LAS float* st = (LAS float*)F.lds; LAS bf16* sA = (LAS bf16*)(F.lds + 1024); LAS bf16* sB = (LAS bf16*)(F.lds + 1024 + 128 * TP * 2);
    const bf16* GUV = (const bf16*)(F.ws + WS_GUV); const bf16* GMW = (const bf16*)(F.ws + WS_DB + (size_t)(layer & 1) * DB_SET + DB_GMW); bf16* YAB = (bf16*)(F.ws + WS_YAB);
    const float* lng = a.in[19] + (size_t)layer * 1024; const float* lnb = a.in[20] + (size_t)layer * 1024; const float* bsp = a.in[22] + (size_t)layer * 1024;
    for (int r = 0; r < 16; ++r) { const int tok = wave * 16 + r; const bf16* rowp = GUV + (t0 + tok) * 2048 + 1024;
        f32x4 x0, x1, x2, x3; unpk8(*(const v4u*)(rowp + lane * 8), x0, x1); unpk8(*(const v4u*)(rowp + 512 + lane * 8), x2, x3);
        const f32x4 sv = (x0 + x1) + (x2 + x3), qv = (x0 * x0 + x1 * x1) + (x2 * x2 + x3 * x3);
        const float s = wave_sum((sv.x + sv.y) + (sv.z + sv.w)), q = wave_sum((qv.x + qv.y) + (qv.z + qv.w));
        const float mean = s * (1.f / 1024.f), var = fmaxf(q * (1.f / 1024.f) - mean * mean, 0.f);
        if (lane == 0) { st[tok * 2] = mean; st[tok * 2 + 1] = 1.f / sqrtf(var + 1e-5f); } }
    __syncthreads();
    for (int g = 0; g < 8; ++g) {
#pragma unroll
        for (int i = 0; i < 4; ++i) { const int pc = tid + 512 * i, rr = pc >> 4, c16 = pc & 15;
            *(LAS v4u*)(sA + rr * TP + c16 * 8) = *(const v4u*)(GMW + (size_t)g * 16384 + rr * 128 + c16 * 8); }
        { const int p = tid & 127, oc0 = tid >> 7; const float mean = st[p * 2], rstd = st[p * 2 + 1];
#pragma unroll
          for (int i = 0; i < 4; ++i) { const int oc = oc0 + 4 * i, c0 = g * 128 + oc * 8;
              f32x4 x0, x1; unpk8(*(const v4u*)(GUV + (t0 + p) * 2048 + 1024 + c0), x0, x1);
              const f32x4 g0 = *(const f32x4*)(lng + c0), g1 = *(const f32x4*)(lng + c0 + 4), b0 = *(const f32x4*)(lnb + c0), b1 = *(const f32x4*)(lnb + c0 + 4);
              x0 = (x0 - mean) * rstd * g0 + b0; x1 = (x1 - mean) * rstd * g1 + b1;
              const v4u w = pk8(x0, x1);
              LAS bf16* d = sB + (oc * 8) * TP + p;
              d[0 * TP] = (bf16)(w.x & 0xffffu); d[1 * TP] = (bf16)(w.x >> 16); d[2 * TP] = (bf16)(w.y & 0xffffu); d[3 * TP] = (bf16)(w.y >> 16);
              d[4 * TP] = (bf16)(w.z & 0xffffu); d[5 * TP] = (bf16)(w.z >> 16); d[6 * TP] = (bf16)(w.w & 0xffffu); d[7 * TP] = (bf16)(w.w >> 16); } }
        __syncthreads();
        f32x4 acc[4][2];
#pragma unroll
        for (int mt = 0; mt < 4; ++mt)
#pragma unroll
            for (int nt = 0; nt < 2; ++nt) acc[mt][nt] = (f32x4){0.f, 0.f, 0.f, 0.f};
        mma_128(sA, sB, wave, lane, acc);
        { const int wm = wave >> 2, wn = wave & 3, fr = lane & 15, fq = lane >> 4;
#pragma unroll
          for (int mt = 0; mt < 4; ++mt) { const int tt = 64 * wm + 16 * mt + fr; const float bsv = bsp[g * 128 + tt];
#pragma unroll
              for (int nt = 0; nt < 2; ++nt) { const int c = g * 128 + 32 * wn + 16 * nt + 4 * fq;
                  const v2u uw = *(const v2u*)(GUV + (t0 + tt) * 2048 + c);
                  const f32x4 u4 = (f32x4){bflo(uw.x), bfhi(uw.x), bflo(uw.y), bfhi(uw.y)};
                  const f32x4 yb = u4 * (acc[mt][nt] + bsv);
                  v2u ow; ow.x = cvt_pk_bf16(yb.x, yb.y); ow.y = cvt_pk_bf16(yb.z, yb.w);
                  *(v2u*)(YAB + (t0 + tt) * 2048 + 1024 + c) = ow; } } }
        __syncthreads();
    }
}

__device__ __forceinline__ unsigned fkey(float f) { const unsigned u = __builtin_bit_cast(unsigned, f); return (u & 0x80000000u) ? ~u : (u | 0x80000000u); }
__device__ __forceinline__ float kval(unsigned k, unsigned mask) { const unsigned u = k & mask; return __builtin_bit_cast(float, (u & 0x80000000u) ? (u ^ 0x80000000u) : ~u); }
__device__ __forceinline__ float swap32_add(float a, float b) { const auto r = __builtin_amdgcn_permlane32_swap(__builtin_bit_cast(unsigned, a), __builtin_bit_cast(unsigned, b), false, false);
    return __builtin_bit_cast(float, (unsigned)r[0]) + __builtin_bit_cast(float, (unsigned)r[1]); }
__device__ __forceinline__ float swap16_add(float a, float b) { const auto r = __builtin_amdgcn_permlane16_swap(__builtin_bit_cast(unsigned, a), __builtin_bit_cast(unsigned, b), false, false);
    return __builtin_bit_cast(float, (unsigned)r[0]) + __builtin_bit_cast(float, (unsigned)r[1]); }
__device__ __forceinline__ float row_sum16(float x) {
    x += __builtin_bit_cast(float, __builtin_amdgcn_update_dpp(0, __builtin_bit_cast(int, x), 0x128, 0xf, 0xf, false));
    x += __builtin_bit_cast(float, __builtin_amdgcn_update_dpp(0, __builtin_bit_cast(int, x), 0x124, 0xf, 0xf, false));
    x += __builtin_bit_cast(float, __builtin_amdgcn_update_dpp(0, __builtin_bit_cast(int, x), 0x122, 0xf, 0xf, false));
    x += __builtin_bit_cast(float, __builtin_amdgcn_update_dpp(0, __builtin_bit_cast(int, x), 0x121, 0xf, 0xf, false));
    return x; }
#define CE_DESC(a, b) do { const unsigned _h = max((a), (b)), _l = min((a), (b)); (a) = _h; (b) = _l; } while (0)
template <int OFF> __device__ __forceinline__ void bitonic_merge16(unsigned (&x)[32]) {
#pragma unroll
    for (int j = 8; j >= 1; j >>= 1)
#pragma unroll
        for (int i = 0; i < 16; ++i) { const int l = i ^ j; if (l > i) CE_DESC(x[OFF + i], x[OFF + l]); }
}
template <int OFF> __device__ __forceinline__ void bitonic_sort16(unsigned (&x)[32]) {
#pragma unroll
    for (int k = 2; k <= 16; k <<= 1)
#pragma unroll
        for (int j = k >> 1; j >= 1; j >>= 1)
#pragma unroll
            for (int i = 0; i < 16; ++i) { const int l = i ^ j; if (l > i) { if ((i & k) == 0 || k == 16) CE_DESC(x[OFF + i], x[OFF + l]); else CE_DESC(x[OFF + l], x[OFF + i]); } }
}
#ifndef REP_K
#define REP_K 1
#endif
#define TOP_INSERT(top, x) do { unsigned _x = (x); _Pragma("unroll") for (int _j = 0; _j < 16; ++_j) { const unsigned _h = max((top)[_j], _x); _x = min((top)[_j], _x); (top)[_j] = _h; } } while (0)
__device__ __forceinline__ void peer_token_end(Frame& F, const Args& a, int layer, bool last, bool final_half, size_t tok, int lane, const f32x2 (&out)[8], const f32x4 (&hpre)[4]) {
    float* hp = F.h + tok * 1024 + 16 * lane;
    f32x4 hv[4]; float s = 0.f;
#pragma unroll
    for (int i = 0; i < 4; ++i) { hv[i] = hpre[i] + (f32x4){out[2 * i].x, out[2 * i].y, out[2 * i + 1].x, out[2 * i + 1].y};
        s += (hv[i].x * hv[i].x + hv[i].y * hv[i].y) + (hv[i].z * hv[i].z + hv[i].w * hv[i].w); }
    if (!final_half) {
#pragma unroll
        for (int i = 0; i < 4; ++i) *(f32x4*)(hp + 4 * i) = hv[i];
        return; }
    const float rstd = 1.f / sqrtf(wave_sum(s) * (1.f / D) + 1e-6f);
    const float* g = (last ? a.in[4] : a.in[2] + (size_t)(layer + 1) * 1024) + 16 * lane;
    f32x4 o[4];
#pragma unroll
    for (int i = 0; i < 4; ++i) o[i] = hv[i] * rstd * *(const f32x4*)(g + 4 * i);
    if (last) {
#pragma unroll
        for (int i = 0; i < 4; ++i) *(f32x4*)(hp + 4 * i) = o[i];
    } else {
#pragma unroll
        for (int i = 0; i < 4; ++i) *(f32x4*)(hp + 4 * i) = hv[i];
        bf16* NX = (bf16*)(F.ws + WS_NX); const v4u w0 = pk8(o[0], o[1]), w1 = pk8(o[2], o[3]); const int tt = (int)(tok & (SEQ - 1));
        *(v4u*)(NX + tok * 2048 + 16 * lane) = w0; *(v4u*)(NX + tok * 2048 + 16 * lane + 8) = w1;
        if (tt != SEQ - 1) { *(v4u*)(NX + (tok + 1) * 2048 + 1024 + 16 * lane) = w0; *(v4u*)(NX + (tok + 1) * 2048 + 1024 + 16 * lane + 8) = w1; }
        if (tt == 0) { *(v4u*)(NX + tok * 2048 + 1024 + 16 * lane) = (v4u){0u, 0u, 0u, 0u}; *(v4u*)(NX + tok * 2048 + 1024 + 16 * lane + 8) = (v4u){0u, 0u, 0u, 0u}; }
    }
}
__device__ __forceinline__ void peer_unit(Frame& F, const Args& a, int layer, int unit, bool last) {
    phase_ids(F);
    const size_t t0 = (size_t)unit * 128; const int tid = F.tid, lane = F.lane, wave = F.wave, fr = lane & 15, fq = lane >> 4;
    LAS bf16* sKey = (LAS bf16*)F.lds;
    LAS unsigned* sLT = (LAS unsigned*)(F.lds + 128 * TP * 2) + wave * 512;
    const bf16* Q = (const bf16*)(F.ws + WS_Q); const bf16* KEYS = (const bf16*)(F.ws + WS_DB + (size_t)(layer & 1) * DB_SET + DB_KEYS); v2u* SEL = (v2u*)(F.ws + WS_SEL);
    const size_t trow = t0 + wave * 16 + fr;
    for (int krep = 0; krep < REP_K; ++krep)
    for (int hd = 0; hd < 8; ++hd) {
        for (int p = 0; p < 2; ++p) {
            __syncthreads();
#pragma unroll
            for (int i = 0; i < 4; ++i) { const int pc = tid + 512 * i, rr = pc >> 4, c16 = pc & 15;
                *(LAS v4u*)(sKey + rr * TP + c16 * 8) = *(const v4u*)(KEYS + (size_t)(hd * 2 + p) * 16384 + rr * 128 + c16 * 8); }
            bf16x8 qf[4];
#pragma unroll
            for (int kk = 0; kk < 4; ++kk) qf[kk] = *(const bf16x8*)(Q + trow * 2048 + hd * 256 + p * 128 + 32 * kk + 8 * fq);
            __syncthreads();
            f32x4 sc[8];
#pragma unroll
            for (int nt = 0; nt < 8; ++nt) sc[nt] = (f32x4){0.f, 0.f, 0.f, 0.f};
#pragma unroll
            for (int kk = 0; kk < 4; ++kk)
#pragma unroll
                for (int nt = 0; nt < 8; ++nt) { const bf16x8 kf = *(const LAS bf16x8*)(sKey + (16 * nt + fr) * TP + 32 * kk + 8 * fq);
                    sc[nt] = __builtin_amdgcn_mfma_f32_16x16x32_bf16(kf, qf[kk], sc[nt], 0, 0, 0); }
            unsigned t[32];
#pragma unroll
            for (int nt = 0; nt < 8; ++nt)
#pragma unroll
                for (int rg = 0; rg < 4; ++rg) t[4 * nt + rg] = (fkey(sc[nt][rg]) & 0xFFFFFF80u) | (unsigned)(16 * nt + 4 * fq + rg);
            bitonic_sort16<0>(t); bitonic_sort16<16>(t);
#pragma unroll
            for (int j = 0; j < 16; ++j) t[j] = max(t[j], t[31 - j]);
            bitonic_merge16<0>(t);
#pragma unroll
            for (int rnd = 0; rnd < 2; ++rnd) {
#pragma unroll
                for (int j = 0; j < 16; ++j) t[16 + j] = rnd ? xor32_u(t[j], lane) : xor16_u(t[j], lane);
#pragma unroll
                for (int j = 0; j < 16; ++j) t[j] = max(t[j], t[31 - j]);
                bitonic_merge16<0>(t); }
#pragma unroll
            for (int j = 0; j < 16; ++j) sLT[fr * 32 + p * 16 + j] = t[j];
        }
        float v0[16], v1[16];
#pragma unroll
        for (int j = 0; j < 16; ++j) { v0[j] = kval(sLT[fr * 32 + j], 0xFFFFFF80u); v1[j] = kval(sLT[fr * 32 + 16 + j], 0xFFFFFF80u); }
        unsigned best[32];
#define CKEY(i, j) ((fkey(v0[i] + v1[j]) & 0xFFFFFF00u) | (unsigned)((i) * 16 + (j)))
#pragma unroll
        for (int j = 0; j < 16; ++j) best[j] = CKEY(0, j);
#pragma unroll
        for (int i = 1; i < 8; ++i) {
#pragma unroll
            for (int j = 0; j < 16; ++j) if ((i + 1) * (j + 1) <= 16) best[15 - j] = max(best[15 - j], CKEY(i, j));
            bitonic_merge16<0>(best); }
#pragma unroll
        for (int i = 8; i < 16; ++i) best[15 - (i - 8)] = max(best[15 - (i - 8)], CKEY(i, 0));
        bitonic_merge16<0>(best);
#undef CKEY
        float ev[16], esum = 0.f; const float mx = kval(best[0], 0xFFFFFF00u);
#pragma unroll
        for (int k = 0; k < 16; ++k) { ev[k] = __builtin_amdgcn_exp2f((kval(best[k], 0xFFFFFF00u) - mx) * 1.44269504f); esum += ev[k]; }
        const float einv = 1.f / esum;
#pragma unroll
        for (int k = 0; k < 16; ++k) { const unsigned pos = best[k] & 255u;
            const unsigned i0 = sLT[fr * 32 + (pos >> 4)] & 127u, i1 = sLT[fr * 32 + 16 + (pos & 15u)] & 127u;
            if ((k >> 2) == fq) SEL[trow * 128 + hd * 16 + k] = (v2u){i0 * 128u + i1, __builtin_bit_cast(unsigned, ev[k] * einv)}; }
    }
    asm volatile("s_waitcnt vmcnt(0)" ::: "memory");
    __syncthreads();
    const bf16* N2 = (const bf16*)(F.ws + WS_N2); const unsigned char* U8 = (const unsigned char*)(F.ws + WS_DB + (size_t)(layer & 1) * DB_SET + DB_U); const unsigned char* V8 = (const unsigned char*)(F.ws + WS_DB + (size_t)(layer & 1) * DB_SET + DB_V);
    unsigned* SELW = (unsigned*)SEL;
    LAS float* sCoef = (LAS float*)(F.lds + 128 * TP * 2 + 8 * 2048) + wave * 2048;
    LAS unsigned* sSort = sLT;
    const size_t tokb = t0 + wave * 16;
    unsigned cnts = 0u;
    v4u se_pf = *(const v4u*)(SELW + tokb * 256 + 4 * lane);
    for (int it = 0; it < 16; ++it) {
        const v4u se = se_pf;
        if (it < 15) se_pf = *(const v4u*)(SELW + (tokb + it + 1) * 256 + 4 * lane);
        const unsigned b0 = se.x >> 12, b1 = se.z >> 12;
        unsigned pos0 = 0u, pos1 = 0u, base = 0u, pk = 0u;
#pragma unroll
        for (unsigned k = 0; k < 4; ++k) {
            const unsigned long long m0 = __builtin_amdgcn_ballot_w64(b0 == k), m1 = __builtin_amdgcn_ballot_w64(b1 == k);
            const unsigned below = __builtin_amdgcn_mbcnt_hi((unsigned)(m0 >> 32), __builtin_amdgcn_mbcnt_lo((unsigned)m0, 0u)) + __builtin_amdgcn_mbcnt_hi((unsigned)(m1 >> 32), __builtin_amdgcn_mbcnt_lo((unsigned)m1, 0u));
            if (b0 == k) pos0 = base + below;
            if (b1 == k) pos1 = base + below + (b0 == k ? 1u : 0u);
            base += (unsigned)__builtin_popcountll(m0) + (unsigned)__builtin_popcountll(m1);
            if (k < 3) pk |= base << (8 * k);
        }
#ifdef DBG_NOSORT
        pos0 = 2 * lane; pos1 = 2 * lane + 1;
#endif
        *(LAS v2u*)(sSort + 2 * pos0) = (v2u){se.x, se.y}; *(LAS v2u*)(sSort + 2 * pos1) = (v2u){se.z, se.w};
        asm volatile("" ::: "memory");
        const v2u so0 = *(const LAS v2u*)(sSort + 4 * lane), so1 = *(const LAS v2u*)(sSort + 4 * lane + 2); const v4u so = (v4u){so0.x, so0.y, so1.x, so1.y};
        asm volatile("" ::: "memory");
#ifndef DBG_NOSTORE
        *(v4u*)(SELW + (tokb + it) * 256 + 4 * lane) = so;
#endif
        { const unsigned g0 = so0.y, g1 = so1.y; sCoef[it * 128 + 2 * lane] = __uint_as_float(g0); sCoef[it * 128 + 2 * lane + 1] = __uint_as_float(g1); }
        if (lane == it) cnts = pk;
    }
    asm volatile("s_waitcnt vmcnt(0) lgkmcnt(0)" ::: "memory");
#ifdef DBG_NOBUCKET
    cnts = 0u;
#endif
#define PL_LOAD(RB, TAB, SE, BB) do { _Pragma("unroll") for (int _q = 0; _q < 16; ++_q) { \
        const unsigned _idx = (unsigned)__builtin_amdgcn_readlane((int)((_q & 1) ? (SE).z : (SE).x), (BB) * 8 + (_q >> 1)); \
        (RB)[_q] = *(const v4u*)((TAB) + (size_t)_idx * 1024 + 16 * lane); } } while (0)
#define PL_RANGE(T, P, NP, RLO, RHI, BLO, BHI) const unsigned _pk##T = (unsigned)__builtin_amdgcn_readlane((int)cnts, (T)); \
        const int _sp##T = min((int)((((_pk##T >> 8) & 255u) + 15u) & ~15u), 128);     \
        const int RLO = (P) == 0 ? 0 : _sp##T, RHI = (P) == 0 ? _sp##T : 128; \
        const int BLO = min(RLO >> 4, 7), BHI = max((RHI + 15) >> 4, BLO + 1)
    v4u ra[16], rb[16];
#ifndef DBG_U0
#define DBG_U0 0
#define DBG_V0 0
#endif
    for (int ps = DBG_U0; ps < 2; ++ps) {
        int lt = 0, lb, lbh; { PL_RANGE(lt, ps, 2, r0, r1, b0_, b1_); lb = b0_; lbh = b1_; (void)r0; (void)r1; }
        v4u seL = *(const v4u*)(SELW + tokb * 256 + 4 * lane), seN = *(const v4u*)(SELW + (tokb + 1) * 256 + 4 * lane);
        f32x2 nf[8]; v4u nraw0, nraw1, nnx0 = *(const v4u*)(N2 + tokb * 1024 + 16 * lane), nnx1 = *(const v4u*)(N2 + tokb * 1024 + 16 * lane + 8);
        int ct, cb, crl = 0, crh = 0, cbl = 0;
#define U_ADV() do { ++lb; if (lb >= lbh) { ++lt; if (lt < 16) { PL_RANGE(lt, ps, 2, _r0, _r1, _b0, _b1); lb = _b0; lbh = _b1; (void)_r0; (void)_r1; seL = seN; if (lt + 1 < 16) seN = *(const v4u*)(SELW + (tokb + lt + 1) * 256 + 4 * lane); } } } while (0)
#define U_COMPUTE(RB) do { \
            if (cb == cbl) { nraw0 = nnx0; nraw1 = nnx1; if (ct + 1 < 16) { nnx0 = *(const v4u*)(N2 + (tokb + ct + 1) * 1024 + 16 * lane); nnx1 = *(const v4u*)(N2 + (tokb + ct + 1) * 1024 + 16 * lane + 8); } \
                f32x4 x0, x1, x2, x3; unpk8(nraw0, x0, x1); unpk8(nraw1, x2, x3); \
                nf[0] = __builtin_shufflevector(x0, x0, 0, 1); nf[1] = __builtin_shufflevector(x0, x0, 2, 3); nf[2] = __builtin_shufflevector(x1, x1, 0, 1); nf[3] = __builtin_shufflevector(x1, x1, 2, 3); \
                nf[4] = __builtin_shufflevector(x2, x2, 0, 1); nf[5] = __builtin_shufflevector(x2, x2, 2, 3); nf[6] = __builtin_shufflevector(x3, x3, 0, 1); nf[7] = __builtin_shufflevector(x3, x3, 2, 3); } \
            _Pragma("unroll") for (int _g = 0; _g < 2; ++_g) { float _p[8]; \
                _Pragma("unroll") for (int _q = 0; _q < 8; ++_q) { f32x2 _a = (f32x2){0.f, 0.f}; \
                    _Pragma("unroll") for (int _j = 0; _j < 4; ++_j) { _a += __builtin_amdgcn_cvt_pk_f32_fp8((int)(RB)[8 * _g + _q][_j], false) * nf[2 * _j]; _a += __builtin_amdgcn_cvt_pk_f32_fp8((int)(RB)[8 * _g + _q][_j], true) * nf[2 * _j + 1]; } \
                    _p[_q] = _a.x + _a.y; } \
                const float _s0 = swap32_add(_p[0], _p[4]), _s1 = swap32_add(_p[1], _p[5]), _s2 = swap32_add(_p[2], _p[6]), _s3 = swap32_add(_p[3], _p[7]); \
                float _t0 = row_sum16(swap16_add(_s0, _s2)), _t1 = row_sum16(swap16_add(_s1, _s3)); \
                _t0 = fgelu(_t0 * (1.f / 256.f)) * (1.f / 64.f); _t1 = fgelu(_t1 * (1.f / 256.f)) * (1.f / 64.f); \
                if ((lane & 15) == 0) { const int _r = lane >> 4, _e = cb * 16 + 8 * _g + 2 * (_r & 1) + 4 * (_r >> 1); LAS float* _c = sCoef + ct * 128 + _e; \
                    if (_e >= crl && _e < crh) _c[0] *= _t0; if (_e + 1 >= crl && _e + 1 < crh) _c[1] *= _t1; } } } while (0)
#define U_SETC() do { ct = lt; cb = lb; { PL_RANGE(ct, ps, 2, _r0, _r1, _b0, _b1); crl = _r0; crh = _r1; cbl = _b0; (void)_b1; } } while (0)
        PL_LOAD(ra, U8, seL, lb);
        U_SETC(); U_ADV();
        for (;;) {
            if (lt < 16) PL_LOAD(rb, U8, seL, lb);
            U_COMPUTE(ra);
            if (lt >= 16) break;
            U_SETC(); U_ADV();
            if (lt < 16) PL_LOAD(ra, U8, seL, lb);
            U_COMPUTE(rb);
            if (lt >= 16) break;
            U_SETC(); U_ADV();
        }
        asm volatile("s_waitcnt lgkmcnt(0)" ::: "memory");
        __syncthreads();
    }
#undef U_ADV
#undef U_COMPUTE
#undef U_SETC
    for (int ps = DBG_V0; ps < 2; ++ps) {
        int lt = 0, lb, lbh; { PL_RANGE(lt, ps, 2, r0, r1, b0_, b1_); lb = b0_; lbh = b1_; (void)r0; (void)r1; }
        v4u seL = *(const v4u*)(SELW + tokb * 256 + 4 * lane), seN = *(const v4u*)(SELW + (tokb + 1) * 256 + 4 * lane);
        f32x2 out[8]; f32x4 hpre[4];
        int ct, cb, crl = 0, crh = 0, cbl = 0, cbh = 0;
#define V_ADV() do { ++lb; if (lb >= lbh) { ++lt; if (lt < 16) { PL_RANGE(lt, ps, 2, _r0, _r1, _b0, _b1); lb = _b0; lbh = _b1; (void)_r0; (void)_r1; seL = seN; if (lt + 1 < 16) seN = *(const v4u*)(SELW + (tokb + lt + 1) * 256 + 4 * lane); } } } while (0)
#define V_SETC() do { ct = lt; cb = lb; { PL_RANGE(ct, ps, 2, _r0, _r1, _b0, _b1); crl = _r0; crh = _r1; cbl = _b0; cbh = _b1; } } while (0)
#define V_COMPUTE(RB) do { \
            if (cb == cbl) { _Pragma("unroll") for (int _i = 0; _i < 8; ++_i) out[_i] = (f32x2){0.f, 0.f}; \
                _Pragma("unroll") for (int _i = 0; _i < 4; ++_i) hpre[_i] = *(const f32x4*)(F.h + (tokb + ct) * 1024 + 16 * lane + 4 * _i); }     \
            _Pragma("unroll") for (int _q = 0; _q < 16; ++_q) { const int _e = cb * 16 + _q; \
                float _c = sCoef[ct * 128 + _e]; _c = (_e >= crl && _e < crh) ? _c : 0.f; const f32x2 _c2 = (f32x2){_c, _c}; \
                _Pragma("unroll") for (int _j = 0; _j < 4; ++_j) { out[2 * _j] += _c2 * __builtin_amdgcn_cvt_pk_f32_fp8((int)(RB)[_q][_j], false); out[2 * _j + 1] += _c2 * __builtin_amdgcn_cvt_pk_f32_fp8((int)(RB)[_q][_j], true); } } \
            if (cb == cbh - 1) peer_token_end(F, a, layer, last, ps == 1, tokb + ct, lane, out, hpre); } while (0)
        PL_LOAD(ra, V8, seL, lb);
        V_SETC(); V_ADV();
        for (;;) {
            if (lt < 16) PL_LOAD(rb, V8, seL, lb);
            V_COMPUTE(ra);
            if (lt >= 16) break;
            V_SETC(); V_ADV();
            if (lt < 16) PL_LOAD(ra, V8, seL, lb);
            V_COMPUTE(rb);
            if (lt >= 16) break;
            V_SETC(); V_ADV();
        }
        asm volatile("s_waitcnt vmcnt(0)" ::: "memory");
        __syncthreads();
    }
#undef V_ADV
#undef V_SETC
#undef V_COMPUTE
#undef PL_LOAD
#undef PL_RANGE
}

#ifndef REP_E
#define REP_E 1
#endif
#ifndef REP_A
#define REP_A 1
#endif
#ifndef REP_B
#define REP_B 1
#endif
#ifndef REP_C
#define REP_C 1
#endif
#ifndef REP_D
#define REP_D 1
#endif
#ifndef REP_G
#define REP_G 1
#endif
#ifndef REP_I
#define REP_I 1
#endif
#ifndef REP_K
#define REP_K 1
#endif
__global__ void __launch_bounds__(NWAVES * 64, 2) trunk_fwd(Args args) {
    extern __shared__ __attribute__((aligned(16))) unsigned char lds[];
    Frame F;
    F.lds = (LAS unsigned char*)lds;
    F.tid = threadIdx.x; F.lane = F.tid & 63; F.wave = __builtin_amdgcn_readfirstlane(F.tid >> 6); F.wave0 = F.wave;
    F.G = gridDim.x; F.bx = blockIdx.x; F.ws = (GAS unsigned char*)args.ws; F.h = args.out;
    volatile LAS unsigned* MISC = (volatile LAS unsigned*)(F.lds + MISC_OFF);
    for (int u = F.tid; u < (LDS_BYTES - LDSCTL_OFF) / 4; u += NWAVES * 64) ((LAS unsigned*)(F.lds + LDSCTL_OFF))[u] = 0u;
    __syncthreads();
    unsigned* ctl = (unsigned*)(F.ws + WS_CTL);
    XcdBarrier bar = xcd_barrier_post(ctl + CW_BAR, MISC + 8);
    GAS unsigned char* ws = F.ws;
    LAS unsigned char* ring = (LAS unsigned char*)F.lds;

    for (int rep = 0; rep < REP_A; ++rep) { prep_phase(F, args, 0, F.bx, F.G);
    xcd_barrier(bar, F.wave0); }
#define OPQ() GAS unsigned char* ws = F.ws; asm volatile("" : "+s"(ws)); GAS unsigned char* db = ws + WS_DB + (size_t)(layer & 1) * DB_SET; (void)db
    for (int layer = 0; layer < DEPTH; ++layer) {
        {   OPQ();
        for (int rep = 0; rep < REP_B; ++rep) {   if (rep) xcd_barrier(bar, F.wave0); pg8::Gemm g{(const bf16*)(ws + WS_NX), (const bf16*)(ws + WS_WIN), T, NZ, 2048, 2048}; pg8::StaticOrder S; S.init(T, NZ, F.G, F.bx);
            pg8::EpiZ E{(bf16*)(ws + WS_ZRKV), (bf16*)(ws + WS_ZL), (bf16*)(ws + WS_GUV), (bf16*)(ws + WS_SG), layer == 0 ? (bf16*)(ws + WS_VF) : (bf16*)nullptr};
            pg8::gemm_phase<pg8::EpiZ, pg8::StaticOrder, true, true>(ring, g, S, E, F.wave0); }
        }
        xcd_barrier(bar, F.wave0);
        {   OPQ();
        for (int rep = 0; rep < REP_C; ++rep) {   if (rep) xcd_barrier(bar, F.wave0); pg8::Gemm g{(const bf16*)(ws + WS_ZL), (const bf16*)(ws + WS_LORA + (size_t)layer * LORA_BYTES), T, 3072, 256, 512}; pg8::StaticOrder S; S.init(T, 3072, F.G, F.bx);
            pg8::EpiLora E{(bf16*)(ws + WS_EW), (size_t)(WS_AR - WS_EW) / 2, args.in[6] + (size_t)layer * 1024, args.in[8] + (size_t)layer * 1024};
            pg8::gemm_phase<pg8::EpiLora, pg8::StaticOrder, true, true>(ring, g, S, E, F.wave0); }
        if (layer > 0) {
            pg8::Gemm g{(const bf16*)(ws + WS_ZL) + 256, (const bf16*)(ws + WS_MV + (size_t)(layer - 1) * MV_BYTES), T, 1024, 256, 512}; pg8::StaticOrder S; S.init(T, 1024, F.G, F.bx);
            pg8::EpiMv E{(bf16*)(ws + WS_ZRKV), (const bf16*)(ws + WS_VF), args.in[18] + (size_t)(layer - 1) * 1024};
            pg8::gemm_phase<pg8::EpiMv, pg8::StaticOrder, true, true>(ring, g, S, E, F.wave0); }
        }
        xcd_barrier(bar, F.wave0);
        {   OPQ();
        for (int rep = 0; rep < REP_D; ++rep) {   if (rep) xcd_barrier(bar, F.wave0); const int nsb = F.G / 2, nob = F.G - nsb;
            if (F.bx < nsb) { for (int u = F.bx; u < NB * 16; u += nsb) scan_unit(F, args, layer, u); }
            else { const int ob = F.bx - nsb;
                for (int pm = ob; pm < T / 256; pm += nob)
                    for (int rep2 = 0; rep2 < REP_E; ++rep2) { gmlp_unit(F, args, layer, 2 * pm); gmlp_unit(F, args, layer, 2 * pm + 1); }
                asm volatile("s_waitcnt vmcnt(0)" ::: "memory"); __syncthreads();
                {
                    pg8::Gemm g{(const bf16*)(ws + WS_YAB) + 1024, (const bf16*)(db + DB_PBT), T, 1024, 1024, 2048}; pg8::PanelOrder S{ob, nob, T / 256, 4};
                    pg8::EpiMerge<false> E{(const bf16*)(ws + WS_SG), (bf16*)(ws + WS_GUV) + 1024, (bf16*)nullptr};
                    pg8::gemm_phase<pg8::EpiMerge<false>, pg8::PanelOrder, true, true>(ring, g, S, E, F.wave0); }
                {   pg8::Gemm g{(const bf16*)(db + DB_PB), (const bf16*)(db + DB_PLEW), T, 1024, 256, 256}; pg8::StaticOrder S; S.init(T, 1024, nob, ob);
                    pg8::EpiPlain E{(bf16*)(ws + WS_PW), 1024};
                    pg8::gemm_phase<pg8::EpiPlain, pg8::StaticOrder, true, true>(ring, g, S, E, F.wave0); }
                if (layer + 1 < DEPTH) prep_phase(F, args, layer + 1, ob, nob); } }
        }
        xcd_barrier(bar, F.wave0);
        {   OPQ();
        for (int rep = 0; rep < REP_G; ++rep) {   if (rep) xcd_barrier(bar, F.wave0); pg8::Gemm g{(const bf16*)(ws + WS_YAB), (const bf16*)(db + DB_PA), T, 1024, 1024, 2048}; pg8::StaticOrder S; S.init(T, 1024, F.G, F.bx);
            pg8::EpiMerge<true> E{(const bf16*)(ws + WS_SG), (bf16*)(ws + WS_GUV) + 1024, (bf16*)(ws + WS_MG)};
            pg8::gemm_phase<pg8::EpiMerge<true>, pg8::StaticOrder, true, true>(ring, g, S, E, F.wave0); }
        }
        xcd_barrier(bar, F.wave0);
        {   OPQ();
        {   pg8::Gemm g{(const bf16*)(ws + WS_MG), (const bf16*)(db + DB_POUT), T, 1024, 1024, 1024}; pg8::StaticOrder S; S.init(T, 1024, F.G, F.bx);
            pg8::EpiResid E{F.h};
            pg8::gemm_phase<pg8::EpiResid, pg8::StaticOrder, true, true>(ring, g, S, E, F.wave0); }
        }
        xcd_barrier(bar, F.wave0);
        {   OPQ();
        for (int rep = 0; rep < REP_I; ++rep) {   if (rep) xcd_barrier(bar, F.wave0); phase_ids(F); const int gw = F.bx * NWAVES + F.wave, NGW = F.G * NWAVES; const float* g2 = args.in[3] + (size_t)layer * 1024;
            for (int m = gw; m < T; m += NGW) norm_row_n2(F.h + (size_t)m * D, g2, (bf16*)(ws + WS_N2) + (size_t)m * D, F.lane); }
        }
        xcd_barrier(bar, F.wave0);
        {   OPQ();
        {   pg8::Gemm g{(const bf16*)(ws + WS_N2), (const bf16*)(db + DB_WQG), T, 3072, 1024, 1024}; pg8::StaticOrder S; S.init(T, 3072, F.G, F.bx);
            pg8::EpiQG E{(bf16*)(ws + WS_Q), (const bf16*)(ws + WS_PW), F.h};
            pg8::gemm_phase<pg8::EpiQG, pg8::StaticOrder, true, true>(ring, g, S, E, F.wave0); }
        }
        xcd_barrier(bar, F.wave0);
        {   OPQ();
        for (int u = F.bx; u < T / 128; u += F.G) peer_unit(F, args, layer, u, layer == DEPTH - 1);
        }
        if (layer + 1 < DEPTH) xcd_barrier(bar, F.wave0);
    }
}

extern "C" void kernel_launch(void* const* d_in, const int* in_sizes, int n_in, void* d_out, int out_size, void* d_ws, size_t ws_size, hipStream_t stream) {
    static int grid = 0;
    if (grid == 0) {
        if (n_in != 32 || out_size != T * D || ws_size < WS_END) { fprintf(stderr, "kernel_launch: unexpected sizes n_in %d out %d ws %zu (need %zu); nothing launched\n", n_in, out_size, ws_size, (size_t)WS_END); grid = -1; return; }
        int dev = 0, cus = 0, per_cu = 0;
        if (hipGetDevice(&dev) != hipSuccess || hipDeviceGetAttribute(&cus, hipDeviceAttributeMultiprocessorCount, dev) != hipSuccess) { grid = -1; return; }
        if (hipFuncSetAttribute((const void*)trunk_fwd, hipFuncAttributeMaxDynamicSharedMemorySize, LDS_BYTES) != hipSuccess) { fprintf(stderr, "kernel_launch: hipFuncSetAttribute failed\n"); grid = -1; return; }
        if (hipOccupancyMaxActiveBlocksPerMultiprocessor(&per_cu, (const void*)trunk_fwd, NWAVES * 64, LDS_BYTES) != hipSuccess || per_cu < 1)
            fprintf(stderr, "kernel_launch: note: occupancy query reports %d workgroups per CU\n", per_cu);
        (void)hipGetLastError();
        grid = cus;
    }
    if (grid < 0) return;
    (void)hipMemsetAsync((char*)d_ws + WS_CTL, 0, ZERO_BYTES, stream);
    (void)hipMemsetAsync((char*)d_ws + WIN_ZERO_OFF, 0, WIN_ZERO_BYTES, stream);
    Args a{};
    for (int i = 0; i < 32; ++i) a.in[i] = (const float*)d_in[i];
    a.out = (float*)d_out; a.ws = (unsigned char*)d_ws;
    hipLaunchKernelGGL(trunk_fwd, dim3(grid), dim3(NWAVES * 64), LDS_BYTES, stream, a);
    const hipError_t le = hipPeekAtLastError();
    if (le != hipSuccess) fprintf(stderr, "kernel_launch: launch failed: %s\n", hipGetErrorName(le));
}
```

```cpp
#include <hip/hip_runtime.h>
#include <cstdio>
#include <cstdint>
namespace pg8 {
#define PG8_LAS __attribute__((address_space(3)))
typedef unsigned short bf16_t;
typedef short bf16x8 __attribute__((ext_vector_type(8)));
typedef float f32x4 __attribute__((ext_vector_type(4)));
typedef unsigned u32x4 __attribute__((ext_vector_type(4)));
constexpr int BM = 256, BK = 64, HALF = 128, HTB = HALF * BK * 2  , STAGE_BYTES = 8 * HTB, NXCD = 8, WGM = 8;

__host__ __device__ __forceinline__ int lds_byte(int r, int c) { const int st = (r >> 4) * 2 + (c >> 5), rr = r & 15, cc = c & 31, ob = rr * 64 + cc * 2; return st * 1024 + (ob ^ (((ob >> 9) & 1) << 5)); }
__host__ __device__ __forceinline__ void stage_rc(int b, int& R, int& C) { const int st = b / 1024, sb = b % 1024, swz = sb ^ (((sb >> 9) & 1) << 5); R = (st >> 1) * 16 + swz / 64; C = (st & 1) * 32 + (swz % 64) / 2; }
__host__ __device__ __forceinline__ int perm32(int rho) { const int n = rho >> 4, i = rho & 15; return 8 * (i >> 2) + 4 * n + (i & 3); }

struct Unit { int pm, pn; };
struct Gemm { const bf16_t* A; const bf16_t* Bt; int M, N, K, lda; };

struct StaticOrder {
    int nM, nN, nwg, G, c;
    __host__ __device__ void init(int M, int N, int G_, int c_) { nM = M / BM; nN = N / BM; nwg = nM * nN; G = G_; c = c_; }
    __host__ __device__ bool next(int i, Unit& u) const {
        const long L = (long)i * G + c; if (L >= nwg) return false;
        int wgid = (int)L; { const int q = nwg / NXCD, r = nwg % NXCD, xcd = wgid % NXCD, off = wgid / NXCD; wgid = (xcd < r ? xcd * (q + 1) : r * (q + 1) + (xcd - r) * q) + off; }
        const int nig = WGM * nN, gid = wgid / nig, fm = gid * WGM, gsz = (nM - fm) < WGM ? (nM - fm) : WGM;
        u.pm = fm + ((wgid % nig) % gsz); u.pn = (wgid % nig) / gsz; return true;
    }
    __device__ __forceinline__ void a_ready(const Unit&) const {}
    __device__ __forceinline__ void done(const Unit&) const {}
};
struct PanelOrder {
    int first, stride, nM, nN;
    __host__ __device__ bool next(int i, Unit& u) const { const int p = first + (i / nN) * stride; if (p >= nM) return false; u.pm = p; u.pn = i % nN; return true; }
    __device__ __forceinline__ void a_ready(const Unit&) const {}
    __device__ __forceinline__ void done(const Unit&) const {}
};
__device__ __forceinline__ unsigned cvt_pk_bf16(float lo, float hi) { unsigned r; asm volatile("v_cvt_pk_bf16_f32 %0, %1, %2" : "=v"(r) : "v"(lo), "v"(hi)); return r; }

__device__ __forceinline__ float fsig(float x) { return __builtin_amdgcn_rcpf(1.f + __builtin_amdgcn_exp2f(-1.44269504f * x)); }
__device__ __forceinline__ float fgelu(float x) { return x * fsig(1.5957691216f * (x + 0.044715f * x * x * x)); }
__device__ __forceinline__ float bflo(unsigned w) { return __builtin_bit_cast(float, w << 16); }
__device__ __forceinline__ float bfhi(unsigned w) { return __builtin_bit_cast(float, w & 0xffff0000u); }
__device__ __forceinline__ void unpk8(const u32x4 w, f32x4& a, f32x4& b) { a = (f32x4){bflo(w.x), bfhi(w.x), bflo(w.y), bfhi(w.y)}; b = (f32x4){bflo(w.z), bfhi(w.z), bflo(w.w), bfhi(w.w)}; }
__device__ __forceinline__ u32x4 pk8(const f32x4 a, const f32x4 b) { u32x4 w; w.x = cvt_pk_bf16(a[0], a[1]); w.y = cvt_pk_bf16(a[2], a[3]); w.z = cvt_pk_bf16(b[0], b[1]); w.w = cvt_pk_bf16(b[2], b[3]); return w; }
__device__ __forceinline__ f32x4 act4(f32x4 v, int kind) {
    if (kind == 1) { v = (f32x4){fgelu(v[0]), fgelu(v[1]), fgelu(v[2]), fgelu(v[3])}; }
    else if (kind == 2) { v = (f32x4){fsig(v[0]), fsig(v[1]), fsig(v[2]), fsig(v[3])}; }
    else if (kind == 3) { v = (f32x4){2.f * fsig(2.f * v[0]) - 1.f, 2.f * fsig(2.f * v[1]) - 1.f, 2.f * fsig(2.f * v[2]) - 1.f, 2.f * fsig(2.f * v[3]) - 1.f}; }
    return v;
}
#define EPI_ROWS_BEGIN _Pragma("unroll") for (int ai = 0; ai < 2; ++ai) _Pragma("unroll") for (int m = 0; m < 4; ++m) { const size_t row = (size_t)(row0 + ai * HALF + m * 16);
#define EPI_ROWS_END }

struct EpiZ {
    static constexpr bool PERM = true, AFTER_DRAIN = false;
    bf16_t *zrkv, *zl, *guv, *sg, *vf;
    __device__ __forceinline__ void operator()(const f32x4 (&acc)[2][2][4][2], const Unit& u, int wr, int wc, int fr, int fq) const {
        const int pn = u.pn, row0 = u.pm * BM + wr * 64 + fr;
        bf16_t* dst; int ld, colt, k0, k1;
        if (pn < 12)       { dst = zrkv; ld = 3072; colt = pn * 256;        k0 = 0; k1 = 0; }
        else if (pn == 12) { dst = zl;   ld = 512;  colt = 0;               k0 = (wc < 2) ? 3 : 0; k1 = 2; }
        else if (pn == 13) { dst = zl;   ld = 512;  colt = 256;             k0 = 0; k1 = 0; }
        else if (pn < 22)  { dst = guv;  ld = 2048; colt = (pn - 14) * 256; k0 = 1; k1 = 1; }
        else               { dst = sg;   ld = 2048; colt = (pn - 22) * 256; k0 = 2; k1 = 2; }
        const int col0 = colt + wc * 32 + 8 * fq;
        const bool dovf = (vf != nullptr) && pn >= 8 && pn < 12;
        const int vcol0 = (pn - 8) * 256 + wc * 32 + 8 * fq;
        EPI_ROWS_BEGIN
            bf16_t* rowp = dst + row * ld + col0;
#pragma unroll
            for (int bj = 0; bj < 2; ++bj) { const int kind = bj ? k1 : k0;
                const u32x4 w = pk8(act4(acc[ai][bj][m][0], kind), act4(acc[ai][bj][m][1], kind));
                *(u32x4*)(rowp + bj * HALF) = w;
                if (dovf) *(u32x4*)(vf + row * 1024 + vcol0 + bj * HALF) = w; }
        EPI_ROWS_END
    }
};
struct EpiLora {
    static constexpr bool PERM = true, AFTER_DRAIN = false;
    bf16_t* ew; size_t stride; const float *w0, *a0;
    __device__ __forceinline__ void operator()(const f32x4 (&acc)[2][2][4][2], const Unit& u, int wr, int wc, int fr, int fq) const {
        const int sel = u.pn >> 2, row0 = u.pm * BM + wr * 64 + fr, col0 = (u.pn & 3) * 256 + wc * 32 + 8 * fq;
        bf16_t* dst = ew + (size_t)sel * stride;
        const float* bp = sel == 0 ? w0 : a0;
        f32x4 bv[2][2];
#pragma unroll
        for (int bj = 0; bj < 2; ++bj)
#pragma unroll
            for (int n = 0; n < 2; ++n) bv[bj][n] = (sel < 2) ? *(const f32x4*)(bp + col0 + bj * HALF + 4 * n) : (f32x4){0.f, 0.f, 0.f, 0.f};
        EPI_ROWS_BEGIN
            bf16_t* rowp = dst + row * 1024 + col0;
#pragma unroll
            for (int bj = 0; bj < 2; ++bj) { f32x4 v0 = acc[ai][bj][m][0] + bv[bj][0], v1 = acc[ai][bj][m][1] + bv[bj][1];
                if (sel < 2) { v0 = act4(v0, 2); v1 = act4(v1, 2); }
                if (sel == 0) { v0 = v0 * 0.60653066f; v1 = v1 * 0.60653066f; }
                *(u32x4*)(rowp + bj * HALF) = pk8(v0, v1); }
        EPI_ROWS_END
    }
};
struct EpiMv {
    static constexpr bool PERM = true, AFTER_DRAIN = false;
    bf16_t* zrkv; const bf16_t* vf; const float* v0b;
    __device__ __forceinline__ void operator()(const f32x4 (&acc)[2][2][4][2], const Unit& u, int wr, int wc, int fr, int fq) const {
        const int row0 = u.pm * BM + wr * 64 + fr, col0 = u.pn * 256 + wc * 32 + 8 * fq;
        f32x4 bv[2][2];
#pragma unroll
        for (int bj = 0; bj < 2; ++bj)
#pragma unroll
            for (int n = 0; n < 2; ++n) bv[bj][n] = *(const f32x4*)(v0b + col0 + bj * HALF + 4 * n);
        EPI_ROWS_BEGIN
#pragma unroll
            for (int bj = 0; bj < 2; ++bj) { bf16_t* zp = zrkv + row * 3072 + 2048 + col0 + bj * HALF;
                f32x4 z0, z1, f0, f1; unpk8(*(const u32x4*)zp, z0, z1); unpk8(*(const u32x4*)(vf + row * 1024 + col0 + bj * HALF), f0, f1);
                const f32x4 m0 = act4(acc[ai][bj][m][0] + bv[bj][0], 2), m1 = act4(acc[ai][bj][m][1] + bv[bj][1], 2);
                *(u32x4*)zp = pk8(z0 + (f0 - z0) * m0, z1 + (f1 - z1) * m1); }
        EPI_ROWS_END
    }
};
struct EpiPlain {
    static constexpr bool PERM = true, AFTER_DRAIN = false;
    bf16_t* o; int ld;
    __device__ __forceinline__ void operator()(const f32x4 (&acc)[2][2][4][2], const Unit& u, int wr, int wc, int fr, int fq) const {
        const int row0 = u.pm * BM + wr * 64 + fr, col0 = u.pn * 256 + wc * 32 + 8 * fq;
        EPI_ROWS_BEGIN
#pragma unroll
            for (int bj = 0; bj < 2; ++bj) *(u32x4*)(o + row * ld + col0 + bj * HALF) = pk8(acc[ai][bj][m][0], acc[ai][bj][m][1]);
        EPI_ROWS_END
    }
};
template <bool SECOND> struct EpiMerge {
    static constexpr bool PERM = true, AFTER_DRAIN = false;
    const bf16_t* sg; bf16_t* m2; bf16_t* o;
    __device__ __forceinline__ void operator()(const f32x4 (&acc)[2][2][4][2], const Unit& u, int wr, int wc, int fr, int fq) const {
        const int row0 = u.pm * BM + wr * 64 + fr, col0 = u.pn * 256 + wc * 32 + 8 * fq;
        EPI_ROWS_BEGIN
#pragma unroll
            for (int bj = 0; bj < 2; ++bj) { const int c = col0 + bj * HALF;
                f32x4 g0, g1; unpk8(*(const u32x4*)(sg + row * 2048 + (SECOND ? 0 : 1024) + c), g0, g1);
                f32x4 v0 = g0 * acc[ai][bj][m][0], v1 = g1 * acc[ai][bj][m][1];
                if (SECOND) { f32x4 p0, p1; unpk8(*(const u32x4*)(m2 + row * 2048 + c), p0, p1); v0 = v0 + p0; v1 = v1 + p1; *(u32x4*)(o + row * 1024 + c) = pk8(v0, v1); }
                else *(u32x4*)(m2 + row * 2048 + c) = pk8(v0, v1); }
        EPI_ROWS_END
    }
};
struct EpiResid {
    static constexpr bool PERM = false, AFTER_DRAIN = false;
    float* h;
    __device__ __forceinline__ void operator()(const f32x4 (&acc)[2][2][4][2], const Unit& u, int wr, int wc, int fr, int fq) const {
        const int row0 = u.pm * BM + wr * 64 + fr, col0 = u.pn * 256 + wc * 32 + 4 * fq;
        EPI_ROWS_BEGIN
            float* rowp = h + row * 1024 + col0;
#pragma unroll
            for (int bj = 0; bj < 2; ++bj)
#pragma unroll
                for (int n = 0; n < 2; ++n) { f32x4* p = (f32x4*)(rowp + bj * HALF + n * 16); *p = *p + acc[ai][bj][m][n]; }
        EPI_ROWS_END
    }
};
struct EpiQG {
    static constexpr bool PERM = true, AFTER_DRAIN = false;
    bf16_t* q; const bf16_t* pw; float* h;
    __device__ __forceinline__ void operator()(const f32x4 (&acc)[2][2][4][2], const Unit& u, int wr, int wc, int fr, int fq) const {
        const int row0 = u.pm * BM + wr * 64 + fr;
        if (u.pn < 8) { const int col0 = u.pn * 256 + wc * 32 + 8 * fq;
            EPI_ROWS_BEGIN
#pragma unroll
                for (int bj = 0; bj < 2; ++bj) *(u32x4*)(q + row * 2048 + col0 + bj * HALF) = pk8(acc[ai][bj][m][0], acc[ai][bj][m][1]);
            EPI_ROWS_END
        } else { const int col0 = (u.pn - 8) * 256 + wc * 32 + 8 * fq;
            EPI_ROWS_BEGIN
#pragma unroll
                for (int bj = 0; bj < 2; ++bj) { const int c = col0 + bj * HALF;
                    f32x4 p0, p1; unpk8(*(const u32x4*)(pw + row * 1024 + c), p0, p1);
                    f32x4* hp = (f32x4*)(h + row * 1024 + c);
                    hp[0] = hp[0] + p0 * act4(acc[ai][bj][m][0], 2); hp[1] = hp[1] + p1 * act4(acc[ai][bj][m][1], 2); }
            EPI_ROWS_END
        }
    }
};
template <class Epi, class Sched, bool ALIGN_EPI = false, bool SP2 = false>
__device__ __forceinline__ void gemm_phase(PG8_LAS unsigned char* lds, const Gemm g, const Sched& S, const Epi& E, const int wave0) {
    int tidq; asm volatile("v_mbcnt_lo_u32_b32 %0, -1, 0\n\tv_mbcnt_hi_u32_b32 %0, -1, %0" : "=v"(tidq)); tidq += wave0 * 64;
    const int tid = tidq, wid = __builtin_amdgcn_readfirstlane(tid >> 6), lane = tid & 63, wr = wid >> 2, wc = wid & 3, fr = lane & 15, fq = lane >> 4;
    int Kq = g.K, ldaq = g.lda; const bf16_t* gA = g.A; const bf16_t* gB = g.Bt; asm volatile("" : "+s"(Kq), "+s"(ldaq), "+s"(gA), "+s"(gB));
    const int K = Kq, nt = K / BK;
    unsigned voffA[2], voffB[2];
#pragma unroll
    for (int i = 0; i < 2; ++i) { int R, C; stage_rc(tid * 16 + i * 8192, R, C); const int Rb = Epi::PERM ? ((R & ~31) + perm32(R & 31)) : R;
        voffA[i] = (unsigned)(R * ldaq + C) * 2u; voffB[i] = (unsigned)(Rb * K + C) * 2u; }
    const size_t kstep = (size_t)(BK * 2);
    const size_t hstepA = (size_t)HALF * ldaq * 2, hstepB = (size_t)HALF * K * 2;
    const size_t tstepA = 2 * hstepA, tstepB = 2 * hstepB;
    const unsigned ldsw = (unsigned)wid * 1024u;
    const int aoff = lds_byte(wr * 64 + fr, fq * 8), boff = lds_byte(wc * 32 + fr, fq * 8);
#define PG8_SA(b, h) (((b) * 2 + (h)) * HTB)
#define PG8_SB(b, h) ((4 + (b) * 2 + (h)) * HTB)
#define PG8_STAGE(bufoff, gbase, voff) do { _Pragma("unroll") for (int _i = 0; _i < 2; ++_i) \
        __builtin_amdgcn_global_load_lds((const unsigned*)((const char*)(gbase) + (voff)[_i]), (PG8_LAS unsigned*)(lds + (bufoff) + ldsw + _i * 8192), 16, 0, 0); } while (0)
#define PG8_LDA(dst, b, h) do { _Pragma("unroll") for (int m = 0; m < 4; ++m) _Pragma("unroll") for (int k = 0; k < 2; ++k) dst[m][k] = *(const PG8_LAS bf16x8*)(lds + PG8_SA(b, h) + aoff + m * 2048 + k * 1024); } while (0)
#define PG8_LDB(dst, b, h) do { _Pragma("unroll") for (int n = 0; n < 2; ++n) _Pragma("unroll") for (int k = 0; k < 2; ++k) dst[n][k] = *(const PG8_LAS bf16x8*)(lds + PG8_SB(b, h) + boff + n * 2048 + k * 1024); } while (0)
#define PG8_MMA(ai, bj, At, Bt) do { __builtin_amdgcn_s_setprio(1); _Pragma("unroll") for (int m = 0; m < 4; ++m) _Pragma("unroll") for (int n = 0; n < 2; ++n) _Pragma("unroll") for (int k = 0; k < 2; ++k) \
        acc[ai][bj][m][n] = __builtin_amdgcn_mfma_f32_16x16x32_bf16(Bt[n][k], At[m][k], acc[ai][bj][m][n], 0, 0, 0); __builtin_amdgcn_s_setprio(0); } while (0)
#define PG8_WAIT_V(n) asm volatile("s_waitcnt vmcnt(" #n ")" ::: "memory")
#define PG8_WAIT_L(n) asm volatile("s_waitcnt lgkmcnt(" #n ")" ::: "memory")
#define PG8_BAR __builtin_amdgcn_s_barrier()
#define PG8_SCHED __builtin_amdgcn_sched_barrier(0)
    Unit cur, nxt; int ui = 0;
    if (!S.next(0, cur)) return;
    f32x4 acc[2][2][4][2];
#pragma unroll
    for (int a = 0; a < 2; ++a)
#pragma unroll
        for (int b = 0; b < 2; ++b)
#pragma unroll
            for (int m = 0; m < 4; ++m)
#pragma unroll
                for (int n = 0; n < 2; ++n) acc[a][b][m][n] = (f32x4){0.f, 0.f, 0.f, 0.f};
    bf16x8 At[4][2], B0[2][2], B1[2][2];
    const char* cA = (const char*)gA + (size_t)cur.pm * tstepA; const char* cB = (const char*)gB + (size_t)cur.pn * tstepB;
    S.a_ready(cur);
    if constexpr (SP2) {
        PG8_STAGE(PG8_SB(0, 0), cB, voffB); PG8_STAGE(PG8_SB(0, 1), cB + hstepB, voffB); PG8_STAGE(PG8_SA(0, 0), cA, voffA); PG8_STAGE(PG8_SA(0, 1), cA + hstepA, voffA);
        if (wr == 1) PG8_BAR;
        PG8_WAIT_V(2); PG8_BAR;
        PG8_STAGE(PG8_SB(1, 0), cB + kstep, voffB); PG8_STAGE(PG8_SA(1, 0), cA + kstep, voffA); PG8_STAGE(PG8_SB(1, 1), cB + hstepB + kstep, voffB);
        PG8_WAIT_V(6); PG8_BAR;
    } else {
        PG8_STAGE(PG8_SB(0, 0), cB, voffB); PG8_STAGE(PG8_SA(0, 0), cA, voffA); PG8_STAGE(PG8_SB(0, 1), cB + hstepB, voffB); PG8_STAGE(PG8_SA(0, 1), cA + hstepA, voffA);
        if (wr == 1) PG8_BAR;
        PG8_WAIT_V(4); PG8_BAR;
        PG8_STAGE(PG8_SB(1, 0), cB + kstep, voffB); PG8_STAGE(PG8_SA(1, 0), cA + kstep, voffA); PG8_STAGE(PG8_SB(1, 1), cB + hstepB + kstep, voffB);
        PG8_WAIT_V(6); PG8_BAR;
    }
    for (;;) {
        const bool has_next = S.next(ui + 1, nxt);
        const char* nA = has_next ? (const char*)gA + (size_t)nxt.pm * tstepA : cA; const char* nB = has_next ? (const char*)gB + (size_t)nxt.pn * tstepB : cB;
        for (int t = 0; t < nt; t += 2) {
            const bool last = (t == nt - 2);
            const char* a1 = cA + (size_t)(t + 1) * kstep;
            const char* a2 = last ? nA : cA + (size_t)(t + 2) * kstep; const char* b2 = last ? nB : cB + (size_t)(t + 2) * kstep;
            const char* a3 = a2 + kstep; const char* b3 = b2 + kstep;
            if (last && has_next) S.a_ready(nxt);
            if constexpr (SP2) {
            PG8_LDB(B0, 0, 0); PG8_LDB(B1, 0, 1); PG8_SCHED; PG8_LDA(At, 0, 0); PG8_STAGE(PG8_SA(1, 1), a1 + hstepA, voffA);
            PG8_WAIT_V(8); PG8_WAIT_L(0); PG8_BAR; PG8_MMA(0, 0, At, B0); PG8_MMA(0, 1, At, B1); PG8_BAR; PG8_SCHED;
            PG8_LDA(At, 0, 1); PG8_STAGE(PG8_SB(0, 0), b2, voffB); PG8_STAGE(PG8_SB(0, 1), b2 + hstepB, voffB); PG8_STAGE(PG8_SA(0, 0), a2, voffA);
            PG8_WAIT_V(8); PG8_WAIT_L(0); PG8_BAR; PG8_MMA(1, 0, At, B0); PG8_MMA(1, 1, At, B1); PG8_BAR; PG8_SCHED;
            PG8_LDB(B0, 1, 0); PG8_LDB(B1, 1, 1); PG8_SCHED; PG8_LDA(At, 1, 0); PG8_STAGE(PG8_SA(0, 1), a2 + hstepA, voffA);
            PG8_WAIT_V(8); PG8_WAIT_L(0); PG8_BAR; PG8_MMA(0, 0, At, B0); PG8_MMA(0, 1, At, B1); PG8_BAR; PG8_SCHED;
            PG8_LDA(At, 1, 1); PG8_STAGE(PG8_SB(1, 0), b3, voffB); PG8_STAGE(PG8_SB(1, 1), b3 + hstepB, voffB); PG8_STAGE(PG8_SA(1, 0), a3, voffA);
            PG8_WAIT_V(8); PG8_WAIT_L(0); PG8_BAR; PG8_MMA(1, 0, At, B0); PG8_MMA(1, 1, At, B1); PG8_BAR; PG8_SCHED;
            } else {
            PG8_LDB(B0, 0, 0); PG8_SCHED; PG8_LDA(At, 0, 0); PG8_STAGE(PG8_SA(1, 1), a1 + hstepA, voffA);
            PG8_WAIT_L(8); PG8_BAR; PG8_WAIT_L(0); PG8_MMA(0, 0, At, B0); PG8_BAR; PG8_SCHED;
            PG8_LDB(B1, 0, 1); PG8_STAGE(PG8_SB(0, 0), b2, voffB);
            PG8_BAR; PG8_WAIT_L(0); PG8_MMA(0, 1, At, B1); PG8_BAR;
            PG8_LDA(At, 0, 1); PG8_STAGE(PG8_SA(0, 0), a2, voffA);
            PG8_BAR; PG8_WAIT_L(0); PG8_MMA(1, 0, At, B0); PG8_BAR; PG8_SCHED;
            PG8_STAGE(PG8_SB(0, 1), b2 + hstepB, voffB);
            PG8_WAIT_V(6); PG8_BAR; PG8_MMA(1, 1, At, B1); PG8_BAR;
            PG8_LDB(B0, 1, 0); PG8_SCHED; PG8_LDA(At, 1, 0); PG8_STAGE(PG8_SA(0, 1), a2 + hstepA, voffA);
            PG8_WAIT_L(8); PG8_BAR; PG8_WAIT_L(0); PG8_MMA(0, 0, At, B0); PG8_BAR; PG8_SCHED;
            PG8_LDB(B1, 1, 1); PG8_STAGE(PG8_SB(1, 0), b3, voffB);
            PG8_BAR; PG8_WAIT_L(0); PG8_MMA(0, 1, At, B1); PG8_BAR;
            PG8_LDA(At, 1, 1); PG8_STAGE(PG8_SA(1, 0), a3, voffA);
            PG8_BAR; PG8_WAIT_L(0); PG8_MMA(1, 0, At, B0); PG8_BAR; PG8_SCHED;
            PG8_STAGE(PG8_SB(1, 1), b3 + hstepB, voffB);
            PG8_WAIT_V(6); PG8_BAR; PG8_MMA(1, 1, At, B1); PG8_BAR;
            }
        }
        if constexpr (ALIGN_EPI) { if (wr == 0) PG8_BAR; }
        if constexpr (!Epi::AFTER_DRAIN) { E(acc, cur, wr, wc, fr, fq); S.done(cur); }
        if (!has_next) break;
#pragma unroll
        for (int a = 0; a < 2; ++a)
#pragma unroll
            for (int b = 0; b < 2; ++b)
#pragma unroll
                for (int m = 0; m < 4; ++m)
#pragma unroll
                    for (int n = 0; n < 2; ++n) acc[a][b][m][n] = (f32x4){0.f, 0.f, 0.f, 0.f};
        cur = nxt; cA = nA; cB = nB; ++ui;
        if constexpr (ALIGN_EPI) { if (wr == 1) PG8_BAR; }
    }
    PG8_WAIT_V(0);
    if constexpr (!ALIGN_EPI) { if (wr == 0) PG8_BAR; }
    PG8_BAR;
    if constexpr (Epi::AFTER_DRAIN) { E.fused(acc, cur, wr, wc, fr, fq, lds, wid, lane); S.done(cur); }
#undef PG8_SA
#undef PG8_SB
#undef PG8_STAGE
#undef PG8_LDA
#undef PG8_LDB
#undef PG8_MMA
#undef PG8_WAIT_V
#undef PG8_WAIT_L
#undef PG8_BAR
#undef PG8_SCHED
}
}

constexpr int NB = 8, SEQ = 4096, T = NB * SEQ, D = 1024, DEPTH = 4, NZ = 7680, NWAVES = 8;
constexpr int CIN = 7424;
constexpr size_t MiB = 1u << 20;
constexpr size_t WS_CTL = 0, WS_LORA = 1 * MiB, WS_MV = 7 * MiB, ZERO_BYTES = 9 * MiB;
constexpr size_t LORA_BYTES = 3072 * 256 * 2, MV_BYTES = 1024 * 256 * 2;
constexpr size_t WS_WIN = 10 * MiB;
constexpr size_t WS_DB = 40 * MiB, DB_SET = 62 * MiB;
constexpr size_t DB_PA = 0, DB_PBT = 2 * MiB, DB_POUT = 4 * MiB, DB_WQG = 6 * MiB, DB_KEYS = 12 * MiB, DB_GMW = 12 * MiB + 512 * 1024, DB_PLEW = 13 * MiB, DB_U = 14 * MiB, DB_V = 30 * MiB, DB_PB = 46 * MiB;
constexpr size_t WS_VF = 164 * MiB, WS_PW = 228 * MiB, WS_NX = 292 * MiB, WS_ZRKV = 420 * MiB, WS_ZL = 612 * MiB, WS_GUV = 644 * MiB, WS_SG = 772 * MiB;
constexpr size_t WS_EW = 900 * MiB, WS_AR = 964 * MiB, WS_G = 1028 * MiB, WS_END = 1092 * MiB;
constexpr size_t WS_YAB = WS_NX, WS_Q = WS_ZRKV, WS_SEL = WS_ZRKV + 128 * MiB, WS_MG = WS_AR, WS_N2 = WS_G;
constexpr size_t WIN_ZERO_OFF = WS_WIN + (size_t)3328 * 2048 * 2, WIN_ZERO_BYTES = (size_t)256 * 2048 * 2;
constexpr int CW_BAR = 4096;
constexpr int RING_BYTES = 131072, LDSCTL_OFF = RING_BYTES, MISC_OFF = LDSCTL_OFF + 320, LDS_BYTES = 147456;

#define LAS __attribute__((address_space(3)))
#define GAS __attribute__((address_space(1)))
typedef unsigned short bf16;
typedef unsigned v4u __attribute__((ext_vector_type(4)));
typedef unsigned v2u __attribute__((ext_vector_type(2)));
typedef float f32x4 __attribute__((ext_vector_type(4)));
typedef float f32x2 __attribute__((ext_vector_type(2)));
typedef short bf16x8 __attribute__((ext_vector_type(8)));
using pg8::fsig; using pg8::fgelu; using pg8::bflo; using pg8::bfhi; using pg8::unpk8; using pg8::pk8; using pg8::cvt_pk_bf16;

#define XB_TMO      128
#define XB_XCNT(j)  (256  + 64 * (j))
#define XB_XSUB(j)  (1280 + 64 * (j))
#define XB_XGEN(j)  (2304 + 64 * (j))
#define XB_TOP      3328
#define XB_TOPGEN   3392
#define XCD_BAR_WORDS 3456
#define XB_SPIN_CAP (1u << 22)

__device__ __forceinline__ unsigned xb_ld(unsigned* p)              { return __hip_atomic_load(p, __ATOMIC_RELAXED, __HIP_MEMORY_SCOPE_AGENT); }
__device__ __forceinline__ unsigned xb_add(unsigned* p, unsigned v) { return __hip_atomic_fetch_add(p, v, __ATOMIC_RELAXED, __HIP_MEMORY_SCOPE_AGENT); }
__device__ __forceinline__ unsigned xb_xcc_id() { return (unsigned)__builtin_amdgcn_s_getreg((3 << 11) | 20) & 0xFu; }
#define XB_SPIN(cond, bar) do { unsigned _sp = 0; while (cond) { __builtin_amdgcn_s_sleep(1); \
    if ((++_sp & 255u) == 0u) { if (xb_ld(&(bar)[XB_TMO])) break; if (_sp > XB_SPIN_CAP) { atomicAdd(&(bar)[XB_TMO], 1u); break; } } } } while (0)

struct XcdBarrier { unsigned* bar; unsigned x; volatile LAS unsigned* st; };

__device__ __forceinline__ XcdBarrier xcd_barrier_post(unsigned* bar, volatile LAS unsigned* st) {
    XcdBarrier b; b.bar = bar; b.x = xb_xcc_id(); b.st = st;
    if (threadIdx.x == 0) (void)xb_add(&bar[XB_XCNT(b.x)], 1u);
    return b;
}
__device__ __forceinline__ void xcd_barrier_complete(unsigned* bar, unsigned x, unsigned& nloc, unsigned& nx) {
    const unsigned G = gridDim.x * gridDim.y * gridDim.z;
    unsigned sum, cnt, mine, sp = 0u;
    for (;;) {
        sum = 0u; cnt = 0u; mine = 0u;
#pragma unroll
        for (unsigned j = 0; j < 16; ++j) { const unsigned c = xb_ld(&bar[XB_XCNT(j)]); sum += c; cnt += (c > 0u) ? 1u : 0u; mine = (j == x) ? c : mine; }
        if (sum == G) break;
        __builtin_amdgcn_s_sleep(1);
        if ((++sp & 255u) == 0u) { if (xb_ld(&bar[XB_TMO])) break; if (sp > XB_SPIN_CAP) { atomicAdd(&bar[XB_TMO], 1u); break; } }
    }
    nloc = mine > 0u ? mine : 1u; nx = cnt > 0u ? cnt : 1u;
}
__device__ __forceinline__ int lane_id_now();
__device__ __forceinline__ void xcd_barrier(const XcdBarrier& b, const int wave0) {
    asm volatile("s_waitcnt vmcnt(0)" ::: "memory");
    __syncthreads();
    if (wave0 == 0 && lane_id_now() == 0) {
        unsigned* bar = b.bar;
        __builtin_amdgcn_s_waitcnt(0);
        unsigned nloc = b.st[0], nx = b.st[1];
        if (nloc == 0u) { xcd_barrier_complete(bar, b.x, nloc, nx); b.st[0] = nloc; b.st[1] = nx; }
        const unsigned old = xb_add(&bar[XB_XSUB(b.x)], 1u);
        const unsigned gen = old / nloc;
        if (old + 1u == (gen + 1u) * nloc) {
            __builtin_amdgcn_fence(__ATOMIC_RELEASE, "agent");
            asm volatile("s_waitcnt vmcnt(0)" ::: "memory");
            const unsigned og = xb_add(&bar[XB_TOP], 1u);
            const unsigned tg = og / nx;
            if (og + 1u == (tg + 1u) * nx) xb_add(&bar[XB_TOPGEN], 1u);
            else XB_SPIN(xb_ld(&bar[XB_TOPGEN]) == tg, bar);
            __builtin_amdgcn_fence(__ATOMIC_ACQUIRE, "agent");
            xb_add(&bar[XB_XGEN(b.x)], 1u);
            asm volatile("s_waitcnt vmcnt(0)" ::: "memory");
        } else {
            XB_SPIN(xb_ld(&bar[XB_XGEN(b.x)]) == gen, bar);
            __builtin_amdgcn_fence(__ATOMIC_ACQUIRE, "agent");
            asm volatile("s_waitcnt vmcnt(0)" ::: "memory");
        }
    }
    __syncthreads();
}

struct Args { const float* in[32]; float* out; unsigned char* ws; };
struct Frame {
    LAS unsigned char* lds;
    int tid, lane, wave, G, bx, wave0;
    GAS unsigned char* ws; float* h;
};
__device__ __forceinline__ int lane_id_now() { int l; asm volatile("v_mbcnt_lo_u32_b32 %0, -1, 0\n\tv_mbcnt_hi_u32_b32 %0, -1, %0" : "=v"(l)); return l; }
__device__ __forceinline__ void phase_ids(Frame& F) { const int l = lane_id_now(); F.lane = l; F.wave = F.wave0; F.tid = F.wave0 * 64 + l; GAS unsigned char* w = F.ws; asm volatile("" : "+s"(w)); F.ws = w; }
#define DPP_ADD(x, ctrl) ((x) + __builtin_bit_cast(float, __builtin_amdgcn_update_dpp(0, __builtin_bit_cast(int, (x)), (ctrl), 0xf, 0xf, false)))
__device__ __forceinline__ float sum8(float v) {
    v = DPP_ADD(v, 0xB1);
    v = DPP_ADD(v, 0x4E);
    v = DPP_ADD(v, 0x141);
    return v;
}
__device__ __forceinline__ float sum16(float v) { v = sum8(v); v = DPP_ADD(v, 0x140); return v; }
__device__ __forceinline__ float wave_sum(float v) {
    v = sum8(v);
    v = DPP_ADD(v, 0x140);
    const auto r = __builtin_amdgcn_permlane16_swap(__builtin_bit_cast(unsigned, v), __builtin_bit_cast(unsigned, v), false, false);
    v = __builtin_bit_cast(float, (unsigned)r[0]) + __builtin_bit_cast(float, (unsigned)r[1]);
    const auto q = __builtin_amdgcn_permlane32_swap(__builtin_bit_cast(unsigned, v), __builtin_bit_cast(unsigned, v), false, false);
    return __builtin_bit_cast(float, (unsigned)q[0]) + __builtin_bit_cast(float, (unsigned)q[1]);
}
__device__ __forceinline__ unsigned xor16_u(unsigned x, int lane) { const auto r = __builtin_amdgcn_permlane16_swap(x, x, false, false); return (lane & 16) ? (unsigned)r[0] : (unsigned)r[1]; }
__device__ __forceinline__ unsigned xor32_u(unsigned x, int lane) { const auto r = __builtin_amdgcn_permlane32_swap(x, x, false, false); return (lane & 32) ? (unsigned)r[0] : (unsigned)r[1]; }
__device__ __forceinline__ void tr_item(const float* W, int ldw, int ncols, bf16* WT, int ldt, int koff, int row_off, LAS float* scr, int item, int lane) {
    const int nblk = ncols / 32, kb = item / nblk, nb = item % nblk, k0 = 64 * kb, n0 = 32 * nb;
#pragma unroll 8
    for (int i = 0; i < 32; ++i) { const int kk = 2 * i + (lane >> 5); scr[kk * 33 + (lane & 31)] = W[(size_t)(k0 + kk) * ldw + n0 + (lane & 31)]; }
    asm volatile("s_waitcnt lgkmcnt(0)" ::: "memory");
    const int c = lane & 7;
#pragma unroll
    for (int j = 0; j < 4; ++j) { const int n = (lane >> 3) + 8 * j; const LAS float* s = scr + (8 * c) * 33 + n;
        v4u o; o.x = cvt_pk_bf16(s[0 * 33], s[1 * 33]); o.y = cvt_pk_bf16(s[2 * 33], s[3 * 33]); o.z = cvt_pk_bf16(s[4 * 33], s[5 * 33]); o.w = cvt_pk_bf16(s[6 * 33], s[7 * 33]);
        *(v4u*)(WT + (size_t)(row_off + n0 + n) * ldt + koff + k0 + 8 * c) = o; }
    asm volatile("s_waitcnt lgkmcnt(0)" ::: "memory");
}
__device__ __forceinline__ void cvt_chunk(const float* src, bf16* dst, size_t chunk, int lane) {
    const f32x4* s = (const f32x4*)(src + chunk * 512) + lane * 2; const f32x4 a = s[0], b = s[1];
    *(v4u*)(dst + chunk * 512 + lane * 8) = pk8(a, b);
}
__device__ __forceinline__ void cvt8_chunk(const float* src, unsigned char* dst, size_t chunk, int lane, float sc) {
    const f32x4* s = (const f32x4*)(src + chunk * 512) + lane * 2; const f32x4 a = s[0] * sc, b = s[1] * sc;
    int w0 = 0, w1 = 0;
    w0 = __builtin_amdgcn_cvt_pk_fp8_f32(a.x, a.y, w0, false); w0 = __builtin_amdgcn_cvt_pk_fp8_f32(a.z, a.w, w0, true);
    w1 = __builtin_amdgcn_cvt_pk_fp8_f32(b.x, b.y, w1, false); w1 = __builtin_amdgcn_cvt_pk_fp8_f32(b.z, b.w, w1, true);
    *(v2u*)(dst + chunk * 512 + lane * 8) = (v2u){(unsigned)w0, (unsigned)w1};
}
__device__ __forceinline__ void norm_row_nx(const float* hrow, float* hcopy, const float* g, bf16* NX, int t, int lane) {
    const f32x4* xr = (const f32x4*)hrow + lane; f32x4 v[4]; float s = 0.f;
#pragma unroll
    for (int j = 0; j < 4; ++j) { v[j] = xr[64 * j]; s += (v[j].x * v[j].x + v[j].y * v[j].y) + (v[j].z * v[j].z + v[j].w * v[j].w); }
    if (hcopy) {
#pragma unroll
        for (int j = 0; j < 4; ++j) ((f32x4*)hcopy)[lane + 64 * j] = v[j]; }
    const float rstd = 1.f / sqrtf(wave_sum(s) * (1.f / D) + 1e-6f);
    const int tt = t & (SEQ - 1);
#pragma unroll
    for (int j = 0; j < 4; ++j) { const f32x4 gv = ((const f32x4*)g)[lane + 64 * j]; const f32x4 o = v[j] * rstd * gv;
        v2u w; w.x = cvt_pk_bf16(o.x, o.y); w.y = cvt_pk_bf16(o.z, o.w);
        const int c = 4 * (lane + 64 * j);
        *(v2u*)(NX + (size_t)t * 2048 + c) = w;
        if (tt != SEQ - 1) *(v2u*)(NX + (size_t)(t + 1) * 2048 + 1024 + c) = w;
        if (tt == 0) *(v2u*)(NX + (size_t)t * 2048 + 1024 + c) = (v2u){0u, 0u}; }
}
__device__ __forceinline__ void norm_row_n2(const float* hrow, const float* g, bf16* N2row, int lane) {
    const f32x4* xr = (const f32x4*)hrow + lane; f32x4 v[4]; float s = 0.f;
#pragma unroll
    for (int j = 0; j < 4; ++j) { v[j] = xr[64 * j]; s += (v[j].x * v[j].x + v[j].y * v[j].y) + (v[j].z * v[j].z + v[j].w * v[j].w); }
    const float rstd = 1.f / sqrtf(wave_sum(s) * (1.f / D) + 1e-6f);
#pragma unroll
    for (int j = 0; j < 4; ++j) { const f32x4 gv = ((const f32x4*)g)[lane + 64 * j]; const f32x4 o = v[j] * rstd * gv;
        v2u w; w.x = cvt_pk_bf16(o.x, o.y); w.y = cvt_pk_bf16(o.z, o.w);
        *(v2u*)(N2row + 4 * (lane + 64 * j)) = w; }
}

__device__ __forceinline__ void prep_phase(Frame& F, const Args& a, int layer, int blk, int nblk_) {
    phase_ids(F);
    LAS float* scr = (LAS float*)(F.lds + F.wave * 16384);
    const int gw = blk * NWAVES + F.wave, NGW = nblk_ * NWAVES, lane = F.lane;
    GAS unsigned char* ws = F.ws; GAS unsigned char* db = F.ws + WS_DB + (size_t)(layer & 1) * DB_SET;
    bf16* WIN = (bf16*)(ws + WS_WIN); bf16* LORA = (bf16*)(ws + WS_LORA + (size_t)layer * LORA_BYTES); bf16* MVT = (bf16*)(ws + WS_MV + (size_t)(layer > 0 ? layer - 1 : 0) * MV_BYTES);
    const float* w_in = a.in[5] + (size_t)layer * 2048 * CIN;
    const int mvn = layer > 0 ? 32 : 0;
    const int c1 = 32 * 104, c2 = 32 * 128, c3 = mvn, c4 = 32, c5 = 32, c6 = 64, c7 = 512, c10 = 1024, c12 = 128;
    const int total = c1 + c2 + c3 + c4 + c5 + c6 + 3 * c7 + c10 + c7 + c12;
    for (int it = gw; it < total; it += NGW) {
        int r = it;
        if (r < c1) { tr_item(w_in, CIN, 3328, WIN, 2048, 0, 0, scr, r, lane); continue; } r -= c1;
        if (r < c2) { tr_item(w_in + 3328, CIN, 4096, WIN, 2048, 0, 3584, scr, r, lane); continue; } r -= c2;
        if (r < c3) { tr_item(a.in[16] + (size_t)(layer - 1) * 2048 * 32, 32, 32, WIN, 2048, 0, 3328, scr, r, lane); continue; } r -= c3;
        if (r < c4) { tr_item(a.in[7] + (size_t)layer * 64 * 1024, 1024, 1024, LORA, 256, 0, 0, scr, r, lane); continue; } r -= c4;
        if (r < c5) { tr_item(a.in[9] + (size_t)layer * 64 * 1024, 1024, 1024, LORA, 256, 64, 1024, scr, r, lane); continue; } r -= c5;
        if (r < c6) { tr_item(a.in[10] + (size_t)layer * 128 * 1024, 1024, 1024, LORA, 256, 128, 2048, scr, r, lane); continue; } r -= c6;
        if (r < c7) { tr_item(a.in[23] + (size_t)layer * D * D, D, D, (bf16*)(db + DB_PA), D, 0, 0, scr, r, lane); continue; } r -= c7;
        if (r < c7) { tr_item(a.in[24] + (size_t)layer * D * D, D, D, (bf16*)(db + DB_PBT), D, 0, 0, scr, r, lane); continue; } r -= c7;
        if (r < c7) { tr_item(a.in[25] + (size_t)layer * D * D, D, D, (bf16*)(db + DB_POUT), D, 0, 0, scr, r, lane); continue; } r -= c7;
        if (r < c10) { tr_item(a.in[26] + (size_t)layer * D * 2048, 2048, 2048, (bf16*)(db + DB_WQG), D, 0, 0, scr, r, lane); continue; } r -= c10;
        if (r < c7) { tr_item(a.in[31] + (size_t)layer * D * D, D, D, (bf16*)(db + DB_WQG), D, 0, 2048, scr, r, lane); continue; } r -= c7;
        tr_item(a.in[30] + (size_t)layer * 256 * D, D, D, (bf16*)(db + DB_PLEW), 256, 0, 0, scr, r, lane);
    }
    if (layer > 0) {
        const float* w2 = a.in[17] + (size_t)(layer - 1) * 32 * 1024;
        for (int it = gw; it < 512; it += NGW) { const int e = it * 64 + lane, n = e >> 5, k = e & 31; MVT[n * 256 + k] = (bf16)(cvt_pk_bf16(w2[k * 1024 + n], 0.f) & 0xffffu); }
    }
    {
        const float* keys = a.in[27] + (size_t)layer * 262144; const float* ut = a.in[28] + (size_t)layer * 16777216; const float* vt = a.in[29] + (size_t)layer * 16777216;
        const float* pin = a.in[1] + (size_t)layer * T * 256; const float* gws = a.in[21] + (size_t)layer * 131072;
        const int n1 = 512, n2 = 32768, n4 = 16384, n5 = 256, ntot = n1 + 2 * n2 + n4 + n5;
        for (int it = gw; it < ntot; it += NGW) {
            int r = it;
            if (r < n2) { cvt8_chunk(ut, (unsigned char*)(db + DB_U), r, lane, 256.f); continue; } r -= n2;
            if (r < n2) { cvt8_chunk(vt, (unsigned char*)(db + DB_V), r, lane, 64.f); continue; } r -= n2;
            if (r < n4) { cvt_chunk(pin, (bf16*)(db + DB_PB), r, lane); continue; } r -= n4;
            if (r < n1) { cvt_chunk(keys, (bf16*)(db + DB_KEYS), r, lane); continue; } r -= n1;
            {
                const int e0 = r * 512 + lane * 8, tq = (e0 >> 7) & 127, p0 = e0 & 127;
                const f32x4* s = (const f32x4*)(gws + e0); f32x4 x0 = s[0], x1 = s[1];
#pragma unroll
                for (int j = 0; j < 4; ++j) { if (p0 + j > tq) x0[j] = 0.f; if (p0 + 4 + j > tq) x1[j] = 0.f; }
                *(v4u*)((bf16*)(db + DB_GMW) + e0) = pk8(x0, x1);
            }
        }
    }
    if (layer == 0) {
        for (int m = gw; m < T; m += NGW) norm_row_nx(a.in[0] + (size_t)m * D, F.h + (size_t)m * D, a.in[2], (bf16*)(ws + WS_NX), m, lane);
    }
}

constexpr int SC = 32, NPR = SC / 2;
constexpr int SC_VEC = SC * 64;
constexpr int SC_WW = 0, SC_VQ = NPR * 64, SC_BK = SC_VQ + NPR * 256, SC_XA = SC_BK + NPR * 128, SC_C = SC_XA + NPR * 128, SC_VP = SC_C + NPR * 20, SC_BON = SC_VP + SC * 64, SC_BUF = SC_BON + SC * 8;
static_assert(SC_BUF % 4 == 0 && SC_C % 4 == 0 && (2 * SC_BUF + 2 * SC_VEC) * 4 + 64 <= 131072, "scan LDS map");
struct ScanOps { f32x4 w[4], vq, c[4]; v4u bk[2]; bf16x8 x[2]; };
__device__ __forceinline__ void scan_load2(ScanOps& o, const LAS float* buf, const LAS float* vqp, const LAS unsigned char* bkp, int bkstep, int p, int lane) {
    const int q = lane >> 4;
    const LAS float* wp = buf + SC_WW + p * 64 + q * 4;
#pragma unroll
    for (int i = 0; i < 4; ++i) o.w[i] = *(const LAS f32x4*)(wp + 16 * i);
    o.vq = *(const LAS f32x4*)(vqp + p * 256);
    o.bk[0] = *(const LAS v4u*)(bkp + p * bkstep); o.bk[1] = *(const LAS v4u*)(bkp + p * bkstep + 16);
    const LAS unsigned char* xp = (const LAS unsigned char*)(buf + SC_XA) + p * 512 + (lane & 3) * 128 + q * 16;
    o.x[0] = *(const LAS bf16x8*)xp; o.x[1] = *(const LAS bf16x8*)(xp + 64);
#pragma unroll
    for (int i = 0; i < 4; ++i) o.c[i] = *(const LAS f32x4*)(buf + SC_C + p * 20 + 4 * i);
}
__device__ __forceinline__ const char* uni_ptr(const char* p) { const unsigned long long a = (unsigned long long)p;
    const unsigned lo = (unsigned)__builtin_amdgcn_readfirstlane((int)(unsigned)a), hi = (unsigned)__builtin_amdgcn_readfirstlane((int)(unsigned)(a >> 32));
    return (const char*)(((unsigned long long)hi << 32) | lo); }
__device__ __forceinline__ float smul(float a, float b) { float r; asm("v_mul_f32 %0, %1, %2" : "=v"(r) : "v"(a), "v"(b)); return r; }
__device__ __forceinline__ void scan_pair(const ScanOps& o, f32x4 (&St)[4], float& sa0, float& sa1, v4u (&am)[4], v4u& bm, LAS float* ypt, int ystep, unsigned m16) {
    v4u s0, s1;
    s0.x = cvt_pk_bf16(St[0].x, St[0].y); s0.y = cvt_pk_bf16(St[0].z, St[0].w); s0.z = cvt_pk_bf16(St[1].x, St[1].y); s0.w = cvt_pk_bf16(St[1].z, St[1].w);
    s1.x = cvt_pk_bf16(St[2].x, St[2].y); s1.y = cvt_pk_bf16(St[2].z, St[2].w); s1.z = cvt_pk_bf16(St[3].x, St[3].y); s1.w = cvt_pk_bf16(St[3].z, St[3].w);
    f32x4 dv = (f32x4){0.f, 0.f, 0.f, 0.f};
    dv = __builtin_amdgcn_mfma_f32_16x16x32_bf16(o.x[0], __builtin_bit_cast(bf16x8, s0), dv, 0, 0, 0);
    dv = __builtin_amdgcn_mfma_f32_16x16x32_bf16(o.x[1], __builtin_bit_cast(bf16x8, s1), dv, 0, 0, 0);
    const float v0 = o.vq.x, v1 = o.vq.y, v2 = o.vq.z;
    bm.x = cvt_pk_bf16(sa0, v0) & m16; bm.y = cvt_pk_bf16(sa1, v1) & m16;
#pragma unroll
    for (int i = 0; i < 4; ++i) { am[i].x = o.bk[i >> 1][(i & 1) * 2]; am[i].y = o.bk[i >> 1][(i & 1) * 2 + 1];
        St[i] = __builtin_amdgcn_mfma_f32_16x16x32_bf16(__builtin_bit_cast(bf16x8, am[i]), __builtin_bit_cast(bf16x8, bm),
                                                        (f32x4){smul(St[i].x, o.w[i].x), smul(St[i].y, o.w[i].y), smul(St[i].z, o.w[i].z), smul(St[i].w, o.w[i].w)}, 0, 0, 0); }
    ypt[0]     = dv.z + sa0 * o.c[2].z + v0 * o.c[2].w;
    ypt[ystep] = dv.w + sa0 * o.c[3].x + v0 * o.c[3].y + sa1 * o.c[3].z + v1 * o.c[3].w;
    const float n0 = dv.x + sa0 * o.c[0].x + v0 * o.c[0].y + sa1 * o.c[0].z + v1 * o.c[0].w;
    const float n1 = dv.y + sa0 * o.c[1].x + v0 * o.c[1].y + sa1 * o.c[1].z + v1 * o.c[1].w + n0 * o.c[2].x + v2 * o.c[2].y;
    sa0 = n0; sa1 = n1;
}
__device__ __forceinline__ void scan_unit(Frame& F, const Args& a, int layer, int unit) {
    phase_ids(F);
    const int b = unit >> 4, hh = unit & 15, tid = F.tid, lane = F.lane, wave = F.wave;
    LAS float* bufs = (LAS float*)F.lds;
    LAS float* sY = bufs + 2 * SC_BUF;
    const bf16* ZR = (const bf16*)(F.ws + WS_ZRKV); const bf16* EW = (const bf16*)(F.ws + WS_EW); const bf16* AR = (const bf16*)(F.ws + WS_AR); const bf16* GT = (const bf16*)(F.ws + WS_G);
    bf16* YAB = (bf16*)(F.ws + WS_YAB);
    constexpr int NCH = SEQ / SC;
    if (wave < 4) {
        f32x4 St[4]; v4u am[4], bm = (v4u){0u, 0u, 0u, 0u};
#pragma unroll
        for (int i = 0; i < 4; ++i) { St[i] = (f32x4){0.f, 0.f, 0.f, 0.f}; am[i] = (v4u){0u, 0u, 0u, 0u}; }
        float sa0 = 0.f, sa1 = 0.f;
        const unsigned m16 = lane < 16 ? 0xffffffffu : 0u;
        LAS unsigned char* zblk = (LAS unsigned char*)(sY + 2 * SC_VEC);
        if (tid < 8) ((LAS unsigned*)zblk)[tid] = 0u;
        const int bkstep = lane < 16 ? 512 : 0;
        for (int it = 0; it < NCH + 2; ++it) {
            if (it >= 1 && it <= NCH) {
                const LAS float* bufc = bufs + ((it - 1) & 1) * SC_BUF;
                const LAS float* vqp = bufc + SC_VQ + 4 * (wave * 16 + (lane & 15));
                const LAS unsigned char* bkp = lane < 16 ? (const LAS unsigned char*)(bufc + SC_BK) + lane * 32 : (const LAS unsigned char*)zblk;
                LAS float* yb = lane < 16 ? sY + ((it - 1) & 1) * SC_VEC + wave * 16 + lane : (LAS float*)(zblk + 32);
                const int ystep = lane < 16 ? 64 : 0;
                if (it == 1) { sa0 = 0.f; sa1 = vqp[0] * bufc[SC_C + 16]; }
                ScanOps o0, o1;
                scan_load2(o0, bufc, vqp, bkp, bkstep, 0, lane);
#pragma unroll 1
                for (int p = 0; p < NPR; p += 2) {
                    scan_load2(o1, bufc, vqp, bkp, bkstep, p + 1, lane);
                    scan_pair(o0, St, sa0, sa1, am, bm, yb + (2 * p) * ystep, ystep, m16);
                    if (p + 2 < NPR) scan_load2(o0, bufc, vqp, bkp, bkstep, p + 2, lane);
                    scan_pair(o1, St, sa0, sa1, am, bm, yb + (2 * p + 2) * ystep, ystep, m16);
                }
            }
            __syncthreads();
        }
    } else {
        const int ht = tid - 256, tl = ht >> 3, c8 = ht & 7, ch = hh * 64 + c8 * 8;
        const int pr = ht >> 4, c4 = ht & 15, chp = hh * 64 + c4 * 4;
        const size_t po = (size_t)layer * 1024 + ch, pop = (size_t)layer * 1024 + chp;
        struct HelpIn { v2u r0, k0, v0, e0, a0, r1, k1, v1, e1, a1, k2, v2, e2, a2, k3; v4u gt; };
        HelpIn cur, nxt;
#define HELP_ROW(H, F_, RR, OFF, ARR, PITCH) (H).F_ = ((RR) < SEQ) ? *(const v2u*)((ARR) + ((size_t)b * SEQ + (RR)) * (PITCH) + (OFF) + chp) : (v2u){0u, 0u}
#define HELP_LOAD(H, PC, GC) do { \
            if ((PC) < NCH) { const int _t = (PC) * SC + 2 * pr; \
                HELP_ROW(H, r0, _t, 0, ZR, 3072); HELP_ROW(H, k0, _t, 1024, ZR, 3072); HELP_ROW(H, v0, _t, 2048, ZR, 3072); HELP_ROW(H, e0, _t, 0, EW, 1024); HELP_ROW(H, a0, _t, 0, AR, 1024); \
                HELP_ROW(H, r1, _t + 1, 0, ZR, 3072); HELP_ROW(H, k1, _t + 1, 1024, ZR, 3072); HELP_ROW(H, v1, _t + 1, 2048, ZR, 3072); HELP_ROW(H, e1, _t + 1, 0, EW, 1024); HELP_ROW(H, a1, _t + 1, 0, AR, 1024); \
                HELP_ROW(H, k2, _t + 2, 1024, ZR, 3072); HELP_ROW(H, v2, _t + 2, 2048, ZR, 3072); HELP_ROW(H, e2, _t + 2, 0, EW, 1024); HELP_ROW(H, a2, _t + 2, 0, AR, 1024); \
                HELP_ROW(H, k3, _t + 3, 1024, ZR, 3072); } \
            if ((GC) >= 0 && (GC) < NCH) { const size_t _row = (size_t)b * SEQ + (size_t)(GC) * SC + tl; (H).gt = *(const v4u*)(GT + _row * 1024 + ch); } } while (0)
#define UNP4(W) ((f32x4){bflo((W).x), bfhi((W).x), bflo((W).y), bfhi((W).y)})
#define EXP4(E) ((f32x4){__builtin_amdgcn_exp2f(-1.44269504f * (E).x), __builtin_amdgcn_exp2f(-1.44269504f * (E).y), __builtin_amdgcn_exp2f(-1.44269504f * (E).z), __builtin_amdgcn_exp2f(-1.44269504f * (E).w)})
#define DOT4(A, B) (((A).x * (B).x + (A).y * (B).y) + ((A).z * (B).z + (A).w * (B).w))
#define SUM16(X) sum16(X)
        HELP_LOAD(cur, 0, -2);
        for (int it = 0; it < NCH + 2; ++it) {
            HELP_LOAD(nxt, it + 1, it - 1);
            if (it >= 2) {
                const LAS float* buf = bufs + (it & 1) * SC_BUF; const LAS float* yb = sY + (it & 1) * SC_VEC;
                const size_t row = (size_t)b * SEQ + (size_t)(it - 2) * SC + tl; const int o = tl * 64 + c8 * 8;
                f32x4 y_[2], v_[2], g_[2];
#pragma unroll
                for (int i = 0; i < 2; ++i) { y_[i] = *(const LAS f32x4*)(yb + o + 4 * i); v_[i] = *(const LAS f32x4*)(buf + SC_VP + o + 4 * i); }
                const float bon = buf[SC_BON + tl * 8 + c8];
                unpk8(cur.gt, g_[0], g_[1]);
                const float s1 = ((y_[0].x + y_[0].y) + (y_[0].z + y_[0].w)) + ((y_[1].x + y_[1].y) + (y_[1].z + y_[1].w));
                const float mu = sum8(s1) * (1.f / 64.f);
                float s2 = 0.f;
#pragma unroll
                for (int i = 0; i < 2; ++i) { y_[i] = y_[i] - mu; const f32x4 q = y_[i] * y_[i]; s2 += (q.x + q.y) + (q.z + q.w); }
                const float rstd = 1.f / sqrtf(sum8(s2) * (1.f / 64.f) + 64e-5f);
                f32x4 o_[2];
#pragma unroll
                for (int i = 0; i < 2; ++i) o_[i] = (y_[i] * rstd * *(const f32x4*)(a.in[14] + po + 4 * i) + *(const f32x4*)(a.in[15] + po + 4 * i) + bon * v_[i]) * g_[i];
                *(v4u*)(YAB + row * 2048 + ch) = pk8(o_[0], o_[1]);
            }
            if (it < NCH) {
                LAS float* buf = bufs + (it & 1) * SC_BUF;
                const f32x4 pkk_ = *(const f32x4*)(a.in[11] + pop), pka_ = *(const f32x4*)(a.in[12] + pop), prk_ = *(const f32x4*)(a.in[13] + pop);
                const f32x4 zk0 = UNP4(cur.k0), zk1 = UNP4(cur.k1), zk2 = UNP4(cur.k2), zk3 = UNP4(cur.k3);
                f32x4 kn0 = zk0 * pkk_, kn1 = zk1 * pkk_, kn2 = zk2 * pkk_, kn3 = zk3 * pkk_;
                kn0 = kn0 * (1.f / sqrtf(fmaxf(SUM16(DOT4(kn0, kn0)), 1e-24f))); kn1 = kn1 * (1.f / sqrtf(fmaxf(SUM16(DOT4(kn1, kn1)), 1e-24f)));
                kn2 = kn2 * (1.f / sqrtf(fmaxf(SUM16(DOT4(kn2, kn2)), 1e-24f))); kn3 = kn3 * (1.f / sqrtf(fmaxf(SUM16(DOT4(kn3, kn3)), 1e-24f)));
                const f32x4 r0 = UNP4(cur.r0), r1 = UNP4(cur.r1), v0 = UNP4(cur.v0), v1 = UNP4(cur.v1), v2 = UNP4(cur.v2);
                const f32x4 ar0 = UNP4(cur.a0), ar1 = UNP4(cur.a1), ar2 = UNP4(cur.a2);
                const f32x4 e0 = UNP4(cur.e0), e1 = UNP4(cur.e1), e2 = UNP4(cur.e2);
                const f32x4 w0 = EXP4(e0), w1 = EXP4(e1), w2 = EXP4(e2);
                const f32x4 a1v = -kn1, a2v = -kn2, a3v = -kn3;
                const f32x4 b0 = kn0 * ar0, b1 = kn1 * ar1, b2 = kn2 * ar2;
                const f32x4 kp0 = zk0 * (1.f + (ar0 - 1.f) * pka_), kp1 = zk1 * (1.f + (ar1 - 1.f) * pka_), kp2 = zk2 * (1.f + (ar2 - 1.f) * pka_);
                const f32x4 W2 = w0 * w1, Bt = b0 * w1, Kt = kp0 * w1, x0v = a2v, x1v = w2 * a3v;
                const f32x4 X0 = W2 * x0v, X1 = W2 * x1v, X2 = w0 * r0, X3 = W2 * r1;
                *(LAS f32x4*)(buf + SC_WW + pr * 64 + c4 * 4) = W2;
                *(LAS f32x4*)(buf + SC_VP + (2 * pr) * 64 + c4 * 4) = v0; *(LAS f32x4*)(buf + SC_VP + (2 * pr + 1) * 64 + c4 * 4) = v1;
                { LAS f32x4* vq = (LAS f32x4*)(buf + SC_VQ + pr * 256 + c4 * 16);
                  vq[0] = (f32x4){v0.x, v1.x, v2.x, 0.f}; vq[1] = (f32x4){v0.y, v1.y, v2.y, 0.f}; vq[2] = (f32x4){v0.z, v1.z, v2.z, 0.f}; vq[3] = (f32x4){v0.w, v1.w, v2.w, 0.f}; }
                { LAS v2u* bkp = (LAS v2u*)(buf + SC_BK + pr * 128) + (((c4 & 3) * 4) * 4 + (c4 >> 2));
                  bkp[0] = (v2u){cvt_pk_bf16(Bt.x, Kt.x), cvt_pk_bf16(b1.x, kp1.x)}; bkp[4] = (v2u){cvt_pk_bf16(Bt.y, Kt.y), cvt_pk_bf16(b1.y, kp1.y)};
                  bkp[8] = (v2u){cvt_pk_bf16(Bt.z, Kt.z), cvt_pk_bf16(b1.z, kp1.z)}; bkp[12] = (v2u){cvt_pk_bf16(Bt.w, Kt.w), cvt_pk_bf16(b1.w, kp1.w)}; }
                { LAS unsigned char* xp = (LAS unsigned char*)(buf + SC_XA) + pr * 512 + (c4 >> 3) * 64 + (c4 & 3) * 16 + ((c4 >> 2) & 1) * 8;
                  *(LAS v2u*)xp = (v2u){cvt_pk_bf16(X0.x, X0.y), cvt_pk_bf16(X0.z, X0.w)}; *(LAS v2u*)(xp + 128) = (v2u){cvt_pk_bf16(X1.x, X1.y), cvt_pk_bf16(X1.z, X1.w)};
                  *(LAS v2u*)(xp + 256) = (v2u){cvt_pk_bf16(X2.x, X2.y), cvt_pk_bf16(X2.z, X2.w)}; *(LAS v2u*)(xp + 384) = (v2u){cvt_pk_bf16(X3.x, X3.y), cvt_pk_bf16(X3.z, X3.w)}; }
                const f32x4 ca = (f32x4){SUM16(DOT4(Bt, x0v)), SUM16(DOT4(Kt, x0v)), SUM16(DOT4(b1, x0v)), SUM16(DOT4(kp1, x0v))};
                const f32x4 cb = (f32x4){SUM16(DOT4(Bt, x1v)), SUM16(DOT4(Kt, x1v)), SUM16(DOT4(b1, x1v)), SUM16(DOT4(kp1, x1v))};
                const f32x4 cc = (f32x4){SUM16(DOT4(b2, a3v)), SUM16(DOT4(kp2, a3v)), SUM16(DOT4(b0, r0)), SUM16(DOT4(kp0, r0))};
                const f32x4 cd = (f32x4){SUM16(DOT4(Bt, r1)), SUM16(DOT4(Kt, r1)), SUM16(DOT4(b1, r1)), SUM16(DOT4(kp1, r1))};
                const float ci = SUM16(DOT4(kp0, a1v));
                const f32x4 z0 = r0 * kp0 * prk_, z1 = r1 * kp1 * prk_;
                const float bon0 = SUM16((z0.x + z0.y) + (z0.z + z0.w)), bon1 = SUM16((z1.x + z1.y) + (z1.z + z1.w));
                if (c4 == 0) { LAS f32x4* cp = (LAS f32x4*)(buf + SC_C + pr * 20); cp[0] = ca; cp[1] = cb; cp[2] = cc; cp[3] = cd; cp[4] = (f32x4){ci, 0.f, 0.f, 0.f}; }
                buf[SC_BON + (2 * pr) * 8 + (c4 >> 1)] = bon0; buf[SC_BON + (2 * pr + 1) * 8 + (c4 >> 1)] = bon1;
            }
            cur = nxt;
            __syncthreads();
        }
#undef HELP_LOAD
#undef HELP_ROW
#undef UNP4
#undef EXP4
#undef DOT4
#undef SUM16
    }
}

constexpr int TP = 136;
__device__ __forceinline__ void mma_128(const LAS bf16* sA, const LAS bf16* sBt, int wave, int lane, f32x4 (&acc)[4][2]) {
    const int wm = wave >> 2, wn = wave & 3, fr = lane & 15, fq = lane >> 4;
#pragma unroll
    for (int kk = 0; kk < 4; ++kk) {
        bf16x8 af[4], bf_[2];
#pragma unroll
        for (int mt = 0; mt < 4; ++mt) af[mt] = *(const LAS bf16x8*)(sA + (64 * wm + 16 * mt + fr) * TP + 32 * kk + 8 * fq);
#pragma unroll
        for (int nt = 0; nt < 2; ++nt) bf_[nt] = *(const LAS bf16x8*)(sBt + (32 * wn + 16 * nt + fr) * TP + 32 * kk + 8 * fq);
#pragma unroll
        for (int mt = 0; mt < 4; ++mt)
#pragma unroll
            for (int nt = 0; nt < 2; ++nt) acc[mt][nt] = __builtin_amdgcn_mfma_f32_16x16x32_bf16(bf_[nt], af[mt], acc[mt][nt], 0, 0, 0);
    }
}
__device__ __forceinline__ void gmlp_unit(Frame& F, const Args& a, int layer, int unit) {
    phase_ids(F);
    const size_t t0 = (size_t)unit * 128; const int tid = F.tid, lane = F.lane, wave = F.wave;
    LAS float* st = (LAS float*)F.lds; LAS bf16* sA = (LAS bf16*)(F.lds + 1024); LAS bf16* sB = (LAS bf16*)(F.lds + 1024 + 128 * TP * 2);
    const bf16* GUV = (const bf16*)(F.ws + WS_GUV); const bf16* GMW = (const bf16*)(F.ws + WS_DB + (size_t)(layer & 1) * DB_SET + DB_GMW); bf16* YAB = (bf16*)(F.ws + WS_YAB);
    const float* lng = a.in[19] + (size_t)layer * 1024; const float* lnb = a.in[20] + (size_t)layer * 1024; const float* bsp = a.in[22] + (size_t)layer * 1024;
    for (int r = 0; r < 16; ++r) { const int tok = wave * 16 + r; const bf16* rowp = GUV + (t0 + tok) * 2048 + 1024;
        f32x4 x0, x1, x2, x3; unpk8(*(const v4u*)(rowp + lane * 8), x0, x1); unpk8(*(const v4u*)(rowp + 512 + lane * 8), x2, x3);
        const f32x4 sv = (x0 + x1) + (x2 + x3), qv = (x0 * x0 + x1 * x1) + (x2 * x2 + x3 * x3);
        const float s = wave_sum((sv.x + sv.y) + (sv.z + sv.w)), q = wave_sum((qv.x + qv.y) + (qv.z + qv.w));
        const float mean = s * (1.f / 1024.f), var = fmaxf(q * (1.f / 1024.f) - mean * mean, 0.f);
        if (lane == 0) { st[tok * 2] = mean; st[tok * 2 + 1] = 1.f / sqrtf(var + 1e-5f); } }
    __syncthreads();
    for (int g = 0; g < 8; ++g) {
#pragma unroll
        for (int i = 0; i < 4; ++i) { const int pc = tid + 512 * i, rr = pc >> 4, c16 = pc & 15;
            *(LAS v4u*)(sA + rr * TP + c16 * 8) = *(const v4u*)(GMW + (size_t)g * 16384 + rr * 128 + c16 * 8); }
        { const int p = tid & 127, oc0 = tid >> 7; const float mean = st[p * 2], rstd = st[p * 2 + 1];
#pragma unroll
          for (int i = 0; i < 4; ++i) { const int oc = oc0 + 4 * i, c0 = g * 128 + oc * 8;
              f32x4 x0, x1; unpk8(*(const v4u*)(GUV + (t0 + p) * 2048 + 1024 + c0), x0, x1);
              const f32x4 g0 = *(const f32x4*)(lng + c0), g1 = *(const f32x4*)(lng + c0 + 4), b0 = *(const f32x4*)(lnb + c0), b1 = *(const f32x4*)(lnb + c0 + 4);
              x0 = (x0 - mean) * rstd * g0 + b0; x1 = (x1 - mean) * rstd * g1 + b1;
              const v4u w = pk8(x0, x1);
              LAS bf16* d = sB + (oc * 8) * TP + p;
              d[0 * TP] = (bf16)(w.x & 0xffffu); d[1 * TP] = (bf16)(w.x >> 16); d[2 * TP] = (bf16)(w.y & 0xffffu); d[3 * TP] = (bf16)(w.y >> 16);
              d[4 * TP] = (bf16)(w.z & 0xffffu); d[5 * TP] = (bf16)(w.z >> 16); d[6 * TP] = (bf16)(w.w & 0xffffu); d[7 * TP] = (bf16)(w.w >> 16); } }
        __syncthreads();
        f32x4 acc[4][2];
#pragma unroll
        for (int mt = 0; mt < 4; ++mt)
#pragma unroll
            for (int nt = 0; nt < 2; ++nt) acc[mt][nt] = (f32x4){0.f, 0.f, 0.f, 0.f};
        mma_128(sA, sB, wave, lane, acc);
        { const int wm = wave >> 2, wn = wave & 3, fr = lane & 15, fq = lane >> 4;
#pragma unroll
          for (int mt = 0; mt < 4; ++mt) { const int tt = 64 * wm + 16 * mt + fr; const float bsv = bsp[g * 128 + tt];
#pragma unroll
              for (int nt = 0; nt < 2; ++nt) { const int c = g * 128 + 32 * wn + 16 * nt + 4 * fq;
                  const v2u uw = *(const v2u*)(GUV + (t0 + tt) * 2048 + c);
                  const f32x4 u4 = (f32x4){bflo(uw.x), bfhi(uw.x), bflo(uw.y), bfhi(uw.y)};
                  const f32x4 yb = u4 * (acc[mt][nt] + bsv);
                  v2u ow; ow.x = cvt_pk_bf16(yb.x, yb.y); ow.y = cvt_pk_bf16(yb.z, yb.w);
                  *(v2u*)(YAB + (t0 + tt) * 2048 + 1024 + c) = ow; } } }
        __syncthreads();
    }
}

__device__ __forceinline__ unsigned fkey(float f) { const unsigned u = __builtin_bit_cast(unsigned, f); return (u & 0x80000000u) ? ~u : (u | 0x80000000u); }
__device__ __forceinline__ float kval(unsigned k, unsigned mask) { const unsigned u = k & mask; return __builtin_bit_cast(float, (u & 0x80000000u) ? (u ^ 0x80000000u) : ~u); }
__device__ __forceinline__ float swap32_add(float a, float b) { const auto r = __builtin_amdgcn_permlane32_swap(__builtin_bit_cast(unsigned, a), __builtin_bit_cast(unsigned, b), false, false);
    return __builtin_bit_cast(float, (unsigned)r[0]) + __builtin_bit_cast(float, (unsigned)r[1]); }
__device__ __forceinline__ float swap16_add(float a, float b) { const auto r = __builtin_amdgcn_permlane16_swap(__builtin_bit_cast(unsigned, a), __builtin_bit_cast(unsigned, b), false, false);
    return __builtin_bit_cast(float, (unsigned)r[0]) + __builtin_bit_cast(float, (unsigned)r[1]); }
__device__ __forceinline__ float row_sum16(float x) {
    x += __builtin_bit_cast(float, __builtin_amdgcn_update_dpp(0, __builtin_bit_cast(int, x), 0x128, 0xf, 0xf, false));
    x += __builtin_bit_cast(float, __builtin_amdgcn_update_dpp(0, __builtin_bit_cast(int, x), 0x124, 0xf, 0xf, false));
    x += __builtin_bit_cast(float, __builtin_amdgcn_update_dpp(0, __builtin_bit_cast(int, x), 0x122, 0xf, 0xf, false));
    x += __builtin_bit_cast(float, __builtin_amdgcn_update_dpp(0, __builtin_bit_cast(int, x), 0x121, 0xf, 0xf, false));
    return x; }
#define CE_DESC(a, b) do { const unsigned _h = max((a), (b)), _l = min((a), (b)); (a) = _h; (b) = _l; } while (0)
template <int OFF> __device__ __forceinline__ void bitonic_merge16(unsigned (&x)[32]) {
#pragma unroll
    for (int j = 8; j >= 1; j >>= 1)
#pragma unroll
        for (int i = 0; i < 16; ++i) { const int l = i ^ j; if (l > i) CE_DESC(x[OFF + i], x[OFF + l]); }
}
template <int OFF> __device__ __forceinline__ void bitonic_sort16(unsigned (&x)[32]) {
#pragma unroll
    for (int k = 2; k <= 16; k <<= 1)
#pragma unroll
        for (int j = k >> 1; j >= 1; j >>= 1)
#pragma unroll
            for (int i = 0; i < 16; ++i) { const int l = i ^ j; if (l > i) { if ((i & k) == 0 || k == 16) CE_DESC(x[OFF + i], x[OFF + l]); else CE_DESC(x[OFF + l], x[OFF + i]); } }
}
#ifndef REP_K
#define REP_K 1
#endif
#define TOP_INSERT(top, x) do { unsigned _x = (x); _Pragma("unroll") for (int _j = 0; _j < 16; ++_j) { const unsigned _h = max((top)[_j], _x); _x = min((top)[_j], _x); (top)[_j] = _h; } } while (0)
__device__ __forceinline__ void peer_token_end(Frame& F, const Args& a, int layer, bool last, bool final_half, size_t tok, int lane, const f32x2 (&out)[8], const f32x4 (&hpre)[4]) {
    float* hp = F.h + tok * 1024 + 16 * lane;
    f32x4 hv[4]; float s = 0.f;
#pragma unroll
    for (int i = 0; i < 4; ++i) { hv[i] = hpre[i] + (f32x4){out[2 * i].x, out[2 * i].y, out[2 * i + 1].x, out[2 * i + 1].y};
        s += (hv[i].x * hv[i].x + hv[i].y * hv[i].y) + (hv[i].z * hv[i].z + hv[i].w * hv[i].w); }
    if (!final_half) {
#pragma unroll
        for (int i = 0; i < 4; ++i) *(f32x4*)(hp + 4 * i) = hv[i];
        return; }
    const float rstd = 1.f / sqrtf(wave_sum(s) * (1.f / D) + 1e-6f);
    const float* g = (last ? a.in[4] : a.in[2] + (size_t)(layer + 1) * 1024) + 16 * lane;
    f32x4 o[4];
#pragma unroll
    for (int i = 0; i < 4; ++i) o[i] = hv[i] * rstd * *(const f32x4*)(g + 4 * i);
    if (last) {
#pragma unroll
        for (int i = 0; i < 4; ++i) *(f32x4*)(hp + 4 * i) = o[i];
    } else {
#pragma unroll
        for (int i = 0; i < 4; ++i) *(f32x4*)(hp + 4 * i) = hv[i];
        bf16* NX = (bf16*)(F.ws + WS_NX); const v4u w0 = pk8(o[0], o[1]), w1 = pk8(o[2], o[3]); const int tt = (int)(tok & (SEQ - 1));
        *(v4u*)(NX + tok * 2048 + 16 * lane) = w0; *(v4u*)(NX + tok * 2048 + 16 * lane + 8) = w1;
        if (tt != SEQ - 1) { *(v4u*)(NX + (tok + 1) * 2048 + 1024 + 16 * lane) = w0; *(v4u*)(NX + (tok + 1) * 2048 + 1024 + 16 * lane + 8) = w1; }
        if (tt == 0) { *(v4u*)(NX + tok * 2048 + 1024 + 16 * lane) = (v4u){0u, 0u, 0u, 0u}; *(v4u*)(NX + tok * 2048 + 1024 + 16 * lane + 8) = (v4u){0u, 0u, 0u, 0u}; }
    }
}
__device__ __forceinline__ void peer_unit(Frame& F, const Args& a, int layer, int unit, bool last) {
    phase_ids(F);
    const size_t t0 = (size_t)unit * 128; const int tid = F.tid, lane = F.lane, wave = F.wave, fr = lane & 15, fq = lane >> 4;
    LAS bf16* sKey = (LAS bf16*)F.lds;
    LAS unsigned* sLT = (LAS unsigned*)(F.lds + 128 * TP * 2) + wave * 512;
    const bf16* Q = (const bf16*)(F.ws + WS_Q); const bf16* KEYS = (const bf16*)(F.ws + WS_DB + (size_t)(layer & 1) * DB_SET + DB_KEYS); v2u* SEL = (v2u*)(F.ws + WS_SEL);
    const size_t trow = t0 + wave * 16 + fr;
    for (int krep = 0; krep < REP_K; ++krep)
    for (int hd = 0; hd < 8; ++hd) {
        for (int p = 0; p < 2; ++p) {
            __syncthreads();
#pragma unroll
            for (int i = 0; i < 4; ++i) { const int pc = tid + 512 * i, rr = pc >> 4, c16 = pc & 15;
                *(LAS v4u*)(sKey + rr * TP + c16 * 8) = *(const v4u*)(KEYS + (size_t)(hd * 2 + p) * 16384 + rr * 128 + c16 * 8); }
            bf16x8 qf[4];
#pragma unroll
            for (int kk = 0; kk < 4; ++kk) qf[kk] = *(const bf16x8*)(Q + trow * 2048 + hd * 256 + p * 128 + 32 * kk + 8 * fq);
            __syncthreads();
            f32x4 sc[8];
#pragma unroll
            for (int nt = 0; nt < 8; ++nt) sc[nt] = (f32x4){0.f, 0.f, 0.f, 0.f};
#pragma unroll
            for (int kk = 0; kk < 4; ++kk)
#pragma unroll
                for (int nt = 0; nt < 8; ++nt) { const bf16x8 kf = *(const LAS bf16x8*)(sKey + (16 * nt + fr) * TP + 32 * kk + 8 * fq);
                    sc[nt] = __builtin_amdgcn_mfma_f32_16x16x32_bf16(kf, qf[kk], sc[nt], 0, 0, 0); }
            unsigned t[32];
#pragma unroll
            for (int nt = 0; nt < 8; ++nt)
#pragma unroll
                for (int rg = 0; rg < 4; ++rg) t[4 * nt + rg] = (fkey(sc[nt][rg]) & 0xFFFFFF80u) | (unsigned)(16 * nt + 4 * fq + rg);
            bitonic_sort16<0>(t); bitonic_sort16<16>(t);
#pragma unroll
            for (int j = 0; j < 16; ++j) t[j] = max(t[j], t[31 - j]);
            bitonic_merge16<0>(t);
#pragma unroll
            for (int rnd = 0; rnd < 2; ++rnd) {
#pragma unroll
                for (int j = 0; j < 16; ++j) t[16 + j] = rnd ? xor32_u(t[j], lane) : xor16_u(t[j], lane);
#pragma unroll
                for (int j = 0; j < 16; ++j) t[j] = max(t[j], t[31 - j]);
                bitonic_merge16<0>(t); }
#pragma unroll
            for (int j = 0; j < 16; ++j) sLT[fr * 32 + p * 16 + j] = t[j];
        }
        float v0[16], v1[16];
#pragma unroll
        for (int j = 0; j < 16; ++j) { v0[j] = kval(sLT[fr * 32 + j], 0xFFFFFF80u); v1[j] = kval(sLT[fr * 32 + 16 + j], 0xFFFFFF80u); }
        unsigned best[32];
#define CKEY(i, j) ((fkey(v0[i] + v1[j]) & 0xFFFFFF00u) | (unsigned)((i) * 16 + (j)))
#pragma unroll
        for (int j = 0; j < 16; ++j) best[j] = CKEY(0, j);
#pragma unroll
        for (int i = 1; i < 8; ++i) {
#pragma unroll
            for (int j = 0; j < 16; ++j) if ((i + 1) * (j + 1) <= 16) best[15 - j] = max(best[15 - j], CKEY(i, j));
            bitonic_merge16<0>(best); }
#pragma unroll
        for (int i = 8; i < 16; ++i) best[15 - (i - 8)] = max(best[15 - (i - 8)], CKEY(i, 0));
        bitonic_merge16<0>(best);
#undef CKEY
        float ev[16], esum = 0.f; const float mx = kval(best[0], 0xFFFFFF00u);
#pragma unroll
        for (int k = 0; k < 16; ++k) { ev[k] = __builtin_amdgcn_exp2f((kval(best[k], 0xFFFFFF00u) - mx) * 1.44269504f); esum += ev[k]; }
        const float einv = 1.f / esum;
#pragma unroll
        for (int k = 0; k < 16; ++k) { const unsigned pos = best[k] & 255u;
            const unsigned i0 = sLT[fr * 32 + (pos >> 4)] & 127u, i1 = sLT[fr * 32 + 16 + (pos & 15u)] & 127u;
            if ((k >> 2) == fq) SEL[trow * 128 + hd * 16 + k] = (v2u){i0 * 128u + i1, __builtin_bit_cast(unsigned, ev[k] * einv)}; }
    }
    asm volatile("s_waitcnt vmcnt(0)" ::: "memory");
    __syncthreads();
    const bf16* N2 = (const bf16*)(F.ws + WS_N2); const unsigned char* U8 = (const unsigned char*)(F.ws + WS_DB + (size_t)(layer & 1) * DB_SET + DB_U); const unsigned char* V8 = (const unsigned char*)(F.ws + WS_DB + (size_t)(layer & 1) * DB_SET + DB_V);
    unsigned* SELW = (unsigned*)SEL;
    LAS float* sCoef = (LAS float*)(F.lds + 128 * TP * 2 + 8 * 2048) + wave * 2048;
    LAS unsigned* sSort = sLT;
    const size_t tokb = t0 + wave * 16;
    unsigned cnts = 0u;
    v4u se_pf = *(const v4u*)(SELW + tokb * 256 + 4 * lane);
    for (int it = 0; it < 16; ++it) {
        const v4u se = se_pf;
        if (it < 15) se_pf = *(const v4u*)(SELW + (tokb + it + 1) * 256 + 4 * lane);
        const unsigned b0 = se.x >> 12, b1 = se.z >> 12;
        unsigned pos0 = 0u, pos1 = 0u, base = 0u, pk = 0u;
#pragma unroll
        for (unsigned k = 0; k < 4; ++k) {
            const unsigned long long m0 = __builtin_amdgcn_ballot_w64(b0 == k), m1 = __builtin_amdgcn_ballot_w64(b1 == k);
            const unsigned below = __builtin_amdgcn_mbcnt_hi((unsigned)(m0 >> 32), __builtin_amdgcn_mbcnt_lo((unsigned)m0, 0u)) + __builtin_amdgcn_mbcnt_hi((unsigned)(m1 >> 32), __builtin_amdgcn_mbcnt_lo((unsigned)m1, 0u));
            if (b0 == k) pos0 = base + below;
            if (b1 == k) pos1 = base + below + (b0 == k ? 1u : 0u);
            base += (unsigned)__builtin_popcountll(m0) + (unsigned)__builtin_popcountll(m1);
            if (k < 3) pk |= base << (8 * k);
        }
#ifdef DBG_NOSORT
        pos0 = 2 * lane; pos1 = 2 * lane + 1;
#endif
        *(LAS v2u*)(sSort + 2 * pos0) = (v2u){se.x, se.y}; *(LAS v2u*)(sSort + 2 * pos1) = (v2u){se.z, se.w};
        asm volatile("" ::: "memory");
        const v2u so0 = *(const LAS v2u*)(sSort + 4 * lane), so1 = *(const LAS v2u*)(sSort + 4 * lane + 2); const v4u so = (v4u){so0.x, so0.y, so1.x, so1.y};
        asm volatile("" ::: "memory");
#ifndef DBG_NOSTORE
        *(v4u*)(SELW + (tokb + it) * 256 + 4 * lane) = so;
#endif
        { const unsigned g0 = so0.y, g1 = so1.y; sCoef[it * 128 + 2 * lane] = __uint_as_float(g0); sCoef[it * 128 + 2 * lane + 1] = __uint_as_float(g1); }
        if (lane == it) cnts = pk;
    }
    asm volatile("s_waitcnt vmcnt(0) lgkmcnt(0)" ::: "memory");
#ifdef DBG_NOBUCKET
    cnts = 0u;
#endif
#define PL_LOAD(RB, TAB, SE, BB) do { _Pragma("unroll") for (int _q = 0; _q < 16; ++_q) { \
        const unsigned _idx = (unsigned)__builtin_amdgcn_readlane((int)((_q & 1) ? (SE).z : (SE).x), (BB) * 8 + (_q >> 1)); \
        (RB)[_q] = *(const v4u*)((TAB) + (size_t)_idx * 1024 + 16 * lane); } } while (0)
#define PL_RANGE(T, P, NP, RLO, RHI, BLO, BHI) const unsigned _pk##T = (unsigned)__builtin_amdgcn_readlane((int)cnts, (T)); \
        const int _sp##T = min((int)((((_pk##T >> 8) & 255u) + 15u) & ~15u), 128);     \
        const int RLO = (P) == 0 ? 0 : _sp##T, RHI = (P) == 0 ? _sp##T : 128; \
        const int BLO = min(RLO >> 4, 7), BHI = max((RHI + 15) >> 4, BLO + 1)
    v4u ra[16], rb[16];
#ifndef DBG_U0
#define DBG_U0 0
#define DBG_V0 0
#endif
    for (int ps = DBG_U0; ps < 2; ++ps) {
        int lt = 0, lb, lbh; { PL_RANGE(lt, ps, 2, r0, r1, b0_, b1_); lb = b0_; lbh = b1_; (void)r0; (void)r1; }
        v4u seL = *(const v4u*)(SELW + tokb * 256 + 4 * lane), seN = *(const v4u*)(SELW + (tokb + 1) * 256 + 4 * lane);
        f32x2 nf[8]; v4u nraw0, nraw1, nnx0 = *(const v4u*)(N2 + tokb * 1024 + 16 * lane), nnx1 = *(const v4u*)(N2 + tokb * 1024 + 16 * lane + 8);
        int ct, cb, crl = 0, crh = 0, cbl = 0;
#define U_ADV() do { ++lb; if (lb >= lbh) { ++lt; if (lt < 16) { PL_RANGE(lt, ps, 2, _r0, _r1, _b0, _b1); lb = _b0; lbh = _b1; (void)_r0; (void)_r1; seL = seN; if (lt + 1 < 16) seN = *(const v4u*)(SELW + (tokb + lt + 1) * 256 + 4 * lane); } } } while (0)
#define U_COMPUTE(RB) do { \
            if (cb == cbl) { nraw0 = nnx0; nraw1 = nnx1; if (ct + 1 < 16) { nnx0 = *(const v4u*)(N2 + (tokb + ct + 1) * 1024 + 16 * lane); nnx1 = *(const v4u*)(N2 + (tokb + ct + 1) * 1024 + 16 * lane + 8); } \
                f32x4 x0, x1, x2, x3; unpk8(nraw0, x0, x1); unpk8(nraw1, x2, x3); \
                nf[0] = __builtin_shufflevector(x0, x0, 0, 1); nf[1] = __builtin_shufflevector(x0, x0, 2, 3); nf[2] = __builtin_shufflevector(x1, x1, 0, 1); nf[3] = __builtin_shufflevector(x1, x1, 2, 3); \
                nf[4] = __builtin_shufflevector(x2, x2, 0, 1); nf[5] = __builtin_shufflevector(x2, x2, 2, 3); nf[6] = __builtin_shufflevector(x3, x3, 0, 1); nf[7] = __builtin_shufflevector(x3, x3, 2, 3); } \
            _Pragma("unroll") for (int _g = 0; _g < 2; ++_g) { float _p[8]; \
                _Pragma("unroll") for (int _q = 0; _q < 8; ++_q) { f32x2 _a = (f32x2){0.f, 0.f}; \
                    _Pragma("unroll") for (int _j = 0; _j < 4; ++_j) { _a += __builtin_amdgcn_cvt_pk_f32_fp8((int)(RB)[8 * _g + _q][_j], false) * nf[2 * _j]; _a += __builtin_amdgcn_cvt_pk_f32_fp8((int)(RB)[8 * _g + _q][_j], true) * nf[2 * _j + 1]; } \
                    _p[_q] = _a.x + _a.y; } \
                const float _s0 = swap32_add(_p[0], _p[4]), _s1 = swap32_add(_p[1], _p[5]), _s2 = swap32_add(_p[2], _p[6]), _s3 = swap32_add(_p[3], _p[7]); \
                float _t0 = row_sum16(swap16_add(_s0, _s2)), _t1 = row_sum16(swap16_add(_s1, _s3)); \
                _t0 = fgelu(_t0 * (1.f / 256.f)) * (1.f / 64.f); _t1 = fgelu(_t1 * (1.f / 256.f)) * (1.f / 64.f); \
                if ((lane & 15) == 0) { const int _r = lane >> 4, _e = cb * 16 + 8 * _g + 2 * (_r & 1) + 4 * (_r >> 1); LAS float* _c = sCoef + ct * 128 + _e; \
                    if (_e >= crl && _e < crh) _c[0] *= _t0; if (_e + 1 >= crl && _e + 1 < crh) _c[1] *= _t1; } } } while (0)
#define U_SETC() do { ct = lt; cb = lb; { PL_RANGE(ct, ps, 2, _r0, _r1, _b0, _b1); crl = _r0; crh = _r1; cbl = _b0; (void)_b1; } } while (0)
        PL_LOAD(ra, U8, seL, lb);
        U_SETC(); U_ADV();
        for (;;) {
            if (lt < 16) PL_LOAD(rb, U8, seL, lb);
            U_COMPUTE(ra);
            if (lt >= 16) break;
            U_SETC(); U_ADV();
            if (lt < 16) PL_LOAD(ra, U8, seL, lb);
            U_COMPUTE(rb);
            if (lt >= 16) break;
            U_SETC(); U_ADV();
        }
        asm volatile("s_waitcnt lgkmcnt(0)" ::: "memory");
        __syncthreads();
    }
#undef U_ADV
#undef U_COMPUTE
#undef U_SETC
    for (int ps = DBG_V0; ps < 2; ++ps) {
        int lt = 0, lb, lbh; { PL_RANGE(lt, ps, 2, r0, r1, b0_, b1_); lb = b0_; lbh = b1_; (void)r0; (void)r1; }
        v4u seL = *(const v4u*)(SELW + tokb * 256 + 4 * lane), seN = *(const v4u*)(SELW + (tokb + 1) * 256 + 4 * lane);
        f32x2 out[8]; f32x4 hpre[4];
        int ct, cb, crl = 0, crh = 0, cbl = 0, cbh = 0;
#define V_ADV() do { ++lb; if (lb >= lbh) { ++lt; if (lt < 16) { PL_RANGE(lt, ps, 2, _r0, _r1, _b0, _b1); lb = _b0; lbh = _b1; (void)_r0; (void)_r1; seL = seN; if (lt + 1 < 16) seN = *(const v4u*)(SELW + (tokb + lt + 1) * 256 + 4 * lane); } } } while (0)
#define V_SETC() do { ct = lt; cb = lb; { PL_RANGE(ct, ps, 2, _r0, _r1, _b0, _b1); crl = _r0; crh = _r1; cbl = _b0; cbh = _b1; } } while (0)
#define V_COMPUTE(RB) do { \
            if (cb == cbl) { _Pragma("unroll") for (int _i = 0; _i < 8; ++_i) out[_i] = (f32x2){0.f, 0.f}; \
                _Pragma("unroll") for (int _i = 0; _i < 4; ++_i) hpre[_i] = *(const f32x4*)(F.h + (tokb + ct) * 1024 + 16 * lane + 4 * _i); }     \
            _Pragma("unroll") for (int _q = 0; _q < 16; ++_q) { const int _e = cb * 16 + _q; \
                float _c = sCoef[ct * 128 + _e]; _c = (_e >= crl && _e < crh) ? _c : 0.f; const f32x2 _c2 = (f32x2){_c, _c}; \
                _Pragma("unroll") for (int _j = 0; _j < 4; ++_j) { out[2 * _j] += _c2 * __builtin_amdgcn_cvt_pk_f32_fp8((int)(RB)[_q][_j], false); out[2 * _j + 1] += _c2 * __builtin_amdgcn_cvt_pk_f32_fp8((int)(RB)[_q][_j], true); } } \
            if (cb == cbh - 1) peer_token_end(F, a, layer, last, ps == 1, tokb + ct, lane, out, hpre); } while (0)
        PL_LOAD(ra, V8, seL, lb);
        V_SETC(); V_ADV();
        for (;;) {
            if (lt < 16) PL_LOAD(rb, V8, seL, lb);
            V_COMPUTE(ra);
            if (lt >= 16) break;
            V_SETC(); V_ADV();
            if (lt < 16) PL_LOAD(ra, V8, seL, lb);
            V_COMPUTE(rb);
            if (lt >= 16) break;
            V_SETC(); V_ADV();
        }
        asm volatile("s_waitcnt vmcnt(0)" ::: "memory");
        __syncthreads();
    }
#undef V_ADV
#undef V_SETC
#undef V_COMPUTE
#undef PL_LOAD
#undef PL_RANGE
}

#ifndef WIN_ALIGN
#define WIN_ALIGN true
#endif
#ifndef WIN_SP2
#define WIN_SP2 true
#endif
#ifndef REP_E
#define REP_E 1
#endif
#ifndef REP_A
#define REP_A 1
#endif
#ifndef REP_B
#define REP_B 1
#endif
#ifndef REP_C
#define REP_C 1
#endif
#ifndef REP_D
#define REP_D 1
#endif
#ifndef REP_G
#define REP_G 1
#endif
#ifndef REP_I
#define REP_I 1
#endif
#ifndef REP_K
#define REP_K 1
#endif
__global__ void __launch_bounds__(NWAVES * 64, 2) trunk_fwd(Args args) {
    extern __shared__ __attribute__((aligned(16))) unsigned char lds[];
    Frame F;
    F.lds = (LAS unsigned char*)lds;
    F.tid = threadIdx.x; F.lane = F.tid & 63; F.wave = __builtin_amdgcn_readfirstlane(F.tid >> 6); F.wave0 = F.wave;
    F.G = gridDim.x; F.bx = blockIdx.x; F.ws = (GAS unsigned char*)args.ws; F.h = args.out;
    volatile LAS unsigned* MISC = (volatile LAS unsigned*)(F.lds + MISC_OFF);
    for (int u = F.tid; u < (LDS_BYTES - LDSCTL_OFF) / 4; u += NWAVES * 64) ((LAS unsigned*)(F.lds + LDSCTL_OFF))[u] = 0u;
    __syncthreads();
    unsigned* ctl = (unsigned*)(F.ws + WS_CTL);
    XcdBarrier bar = xcd_barrier_post(ctl + CW_BAR, MISC + 8);
    GAS unsigned char* ws = F.ws;
    LAS unsigned char* ring = (LAS unsigned char*)F.lds;

    for (int rep = 0; rep < REP_A; ++rep) { prep_phase(F, args, 0, F.bx, F.G);
    xcd_barrier(bar, F.wave0); }
#define OPQ() GAS unsigned char* ws = F.ws; asm volatile("" : "+s"(ws)); GAS unsigned char* db = ws + WS_DB + (size_t)(layer & 1) * DB_SET; (void)db
    for (int layer = 0; layer < DEPTH; ++layer) {
        {   OPQ();
        for (int rep = 0; rep < REP_B; ++rep) {   if (rep) xcd_barrier(bar, F.wave0); pg8::Gemm g{(const bf16*)(ws + WS_NX), (const bf16*)(ws + WS_WIN), T, NZ, 2048, 2048}; pg8::StaticOrder S; S.init(T, NZ, F.G, F.bx);
            pg8::EpiZ E{(bf16*)(ws + WS_ZRKV), (bf16*)(ws + WS_ZL), (bf16*)(ws + WS_GUV), (bf16*)(ws + WS_SG), layer == 0 ? (bf16*)(ws + WS_VF) : (bf16*)nullptr};
            pg8::gemm_phase<pg8::EpiZ, pg8::StaticOrder, WIN_ALIGN, WIN_SP2>(ring, g, S, E, F.wave0); }
        }
        xcd_barrier(bar, F.wave0);
        {   OPQ();
        for (int rep = 0; rep < REP_C; ++rep) {   if (rep) xcd_barrier(bar, F.wave0); pg8::Gemm g{(const bf16*)(ws + WS_ZL), (const bf16*)(ws + WS_LORA + (size_t)layer * LORA_BYTES), T, 3072, 256, 512}; pg8::StaticOrder S; S.init(T, 3072, F.G, F.bx);
            pg8::EpiLora E{(bf16*)(ws + WS_EW), (size_t)(WS_AR - WS_EW) / 2, args.in[6] + (size_t)layer * 1024, args.in[8] + (size_t)layer * 1024};
            pg8::gemm_phase<pg8::EpiLora, pg8::StaticOrder, true, true>(ring, g, S, E, F.wave0); }
        if (layer > 0) {
            pg8::Gemm g{(const bf16*)(ws + WS_ZL) + 256, (const bf16*)(ws + WS_MV + (size_t)(layer - 1) * MV_BYTES), T, 1024, 256, 512}; pg8::StaticOrder S; S.init(T, 1024, F.G, F.bx);
            pg8::EpiMv E{(bf16*)(ws + WS_ZRKV), (const bf16*)(ws + WS_VF), args.in[18] + (size_t)(layer - 1) * 1024};
            pg8::gemm_phase<pg8::EpiMv, pg8::StaticOrder, true, true>(ring, g, S, E, F.wave0); }
        }
        xcd_barrier(bar, F.wave0);
        {   OPQ();
        for (int rep = 0; rep < REP_D; ++rep) {   if (rep) xcd_barrier(bar, F.wave0); const int nsb = F.G / 2, nob = F.G - nsb;
            if (F.bx < nsb) { for (int u = F.bx; u < NB * 16; u += nsb) scan_unit(F, args, layer, u); }
            else { const int ob = F.bx - nsb;
                for (int pm = ob; pm < T / 256; pm += nob)
                    for (int rep2 = 0; rep2 < REP_E; ++rep2) { gmlp_unit(F, args, layer, 2 * pm); gmlp_unit(F, args, layer, 2 * pm + 1); }
                asm volatile("s_waitcnt vmcnt(0)" ::: "memory"); __syncthreads();
                {
                    pg8::Gemm g{(const bf16*)(ws + WS_YAB) + 1024, (const bf16*)(db + DB_PBT), T, 1024, 1024, 2048}; pg8::PanelOrder S{ob, nob, T / 256, 4};
                    pg8::EpiMerge<false> E{(const bf16*)(ws + WS_SG), (bf16*)(ws + WS_GUV) + 1024, (bf16*)nullptr};
                    pg8::gemm_phase<pg8::EpiMerge<false>, pg8::PanelOrder, true, true>(ring, g, S, E, F.wave0); }
                {   pg8::Gemm g{(const bf16*)(db + DB_PB), (const bf16*)(db + DB_PLEW), T, 1024, 256, 256}; pg8::StaticOrder S; S.init(T, 1024, nob, ob);
                    pg8::EpiPlain E{(bf16*)(ws + WS_PW), 1024};
                    pg8::gemm_phase<pg8::EpiPlain, pg8::StaticOrder, true, true>(ring, g, S, E, F.wave0); }
                if (layer + 1 < DEPTH) prep_phase(F, args, layer + 1, ob, nob); } }
        }
        xcd_barrier(bar, F.wave0);
        {   OPQ();
        for (int rep = 0; rep < REP_G; ++rep) {   if (rep) xcd_barrier(bar, F.wave0); pg8::Gemm g{(const bf16*)(ws + WS_YAB), (const bf16*)(db + DB_PA), T, 1024, 1024, 2048}; pg8::StaticOrder S; S.init(T, 1024, F.G, F.bx);
            pg8::EpiMerge<true> E{(const bf16*)(ws + WS_SG), (bf16*)(ws + WS_GUV) + 1024, (bf16*)(ws + WS_MG)};
            pg8::gemm_phase<pg8::EpiMerge<true>, pg8::StaticOrder, true, true>(ring, g, S, E, F.wave0); }
        }
        xcd_barrier(bar, F.wave0);
        {   OPQ();
        {   pg8::Gemm g{(const bf16*)(ws + WS_MG), (const bf16*)(db + DB_POUT), T, 1024, 1024, 1024}; pg8::StaticOrder S; S.init(T, 1024, F.G, F.bx);
            pg8::EpiResid E{F.h};
            pg8::gemm_phase<pg8::EpiResid, pg8::StaticOrder, true, true>(ring, g, S, E, F.wave0); }
        }
        xcd_barrier(bar, F.wave0);
        {   OPQ();
        for (int rep = 0; rep < REP_I; ++rep) {   if (rep) xcd_barrier(bar, F.wave0); phase_ids(F); const int gw = F.bx * NWAVES + F.wave, NGW = F.G * NWAVES; const float* g2 = args.in[3] + (size_t)layer * 1024;
            for (int m = gw; m < T; m += NGW) norm_row_n2(F.h + (size_t)m * D, g2, (bf16*)(ws + WS_N2) + (size_t)m * D, F.lane); }
        }
        xcd_barrier(bar, F.wave0);
        {   OPQ();
        {   pg8::Gemm g{(const bf16*)(ws + WS_N2), (const bf16*)(db + DB_WQG), T, 3072, 1024, 1024}; pg8::StaticOrder S; S.init(T, 3072, F.G, F.bx);
            pg8::EpiQG E{(bf16*)(ws + WS_Q), (const bf16*)(ws + WS_PW), F.h};
            pg8::gemm_phase<pg8::EpiQG, pg8::StaticOrder, true, true>(ring, g, S, E, F.wave0); }
        }
        xcd_barrier(bar, F.wave0);
        {   OPQ();
        for (int u = F.bx; u < T / 128; u += F.G) peer_unit(F, args, layer, u, layer == DEPTH - 1);
        }
        if (layer + 1 < DEPTH) xcd_barrier(bar, F.wave0);
    }
}

extern "C" void kernel_launch(void* const* d_in, const int* in_sizes, int n_in, void* d_out, int out_size, void* d_ws, size_t ws_size, hipStream_t stream) {
    static int grid = 0;
    if (grid == 0) {
        if (n_in != 32 || out_size != T * D || ws_size < WS_END) { fprintf(stderr, "kernel_launch: unexpected sizes n_in %d out %d ws %zu (need %zu); nothing launched\n", n_in, out_size, ws_size, (size_t)WS_END); grid = -1; return; }
        int dev = 0, cus = 0, per_cu = 0;
        if (hipGetDevice(&dev) != hipSuccess || hipDeviceGetAttribute(&cus, hipDeviceAttributeMultiprocessorCount, dev) != hipSuccess) { grid = -1; return; }
        if (hipFuncSetAttribute((const void*)trunk_fwd, hipFuncAttributeMaxDynamicSharedMemorySize, LDS_BYTES) != hipSuccess) { fprintf(stderr, "kernel_launch: hipFuncSetAttribute failed\n"); grid = -1; return; }
        if (hipOccupancyMaxActiveBlocksPerMultiprocessor(&per_cu, (const void*)trunk_fwd, NWAVES * 64, LDS_BYTES) != hipSuccess || per_cu < 1)
            fprintf(stderr, "kernel_launch: note: occupancy query reports %d workgroups per CU\n", per_cu);
        (void)hipGetLastError();
        grid = cus;
    }
    if (grid < 0) return;
    (void)hipMemsetAsync((char*)d_ws + WS_CTL, 0, ZERO_BYTES, stream);
    (void)hipMemsetAsync((char*)d_ws + WIN_ZERO_OFF, 0, WIN_ZERO_BYTES, stream);
    Args a{};
    for (int i = 0; i < 32; ++i) a.in[i] = (const float*)d_in[i];
    a.out = (float*)d_out; a.ws = (unsigned char*)d_ws;
    hipLaunchKernelGGL(trunk_fwd, dim3(grid), dim3(NWAVES * 64), LDS_BYTES, stream, a);
    const hipError_t le = hipPeekAtLastError();
    if (le != hipSuccess) fprintf(stderr, "kernel_launch: launch failed: %s\n", hipGetErrorName(le));
}
```

```cpp
#include <hip/hip_runtime.h>
#include <cstdio>
#include <cstdint>
#define ZSPLIT 4
namespace pg8 {
#define PG8_LAS __attribute__((address_space(3)))
typedef unsigned short bf16_t;
typedef short bf16x8 __attribute__((ext_vector_type(8)));
typedef float f32x4 __attribute__((ext_vector_type(4)));
typedef unsigned u32x4 __attribute__((ext_vector_type(4)));
constexpr int BM = 256, BK = 64, HALF = 128, HTB = HALF * BK * 2  , STAGE_BYTES = 8 * HTB, NXCD = 8, WGM = 8;

__host__ __device__ __forceinline__ int lds_byte(int r, int c) { const int st = (r >> 4) * 2 + (c >> 5), rr = r & 15, cc = c & 31, ob = rr * 64 + cc * 2; return st * 1024 + (ob ^ (((ob >> 9) & 1) << 5)); }
__host__ __device__ __forceinline__ void stage_rc(int b, int& R, int& C) { const int st = b / 1024, sb = b % 1024, swz = sb ^ (((sb >> 9) & 1) << 5); R = (st >> 1) * 16 + swz / 64; C = (st & 1) * 32 + (swz % 64) / 2; }
__host__ __device__ __forceinline__ int perm32(int rho) { const int n = rho >> 4, i = rho & 15; return 8 * (i >> 2) + 4 * n + (i & 3); }

struct Unit { int pm, pn; };
struct Gemm { const bf16_t* A; const bf16_t* Bt; int M, N, K, lda; };

struct StaticOrder {
    int nM, nN, nwg, G, c;
    __host__ __device__ void init(int M, int N, int G_, int c_) { nM = M / BM; nN = N / BM; nwg = nM * nN; G = G_; c = c_; }
    __host__ __device__ bool next(int i, Unit& u) const {
        const long L = (long)i * G + c; if (L >= nwg) return false;
        int wgid = (int)L; { const int q = nwg / NXCD, r = nwg % NXCD, xcd = wgid % NXCD, off = wgid / NXCD; wgid = (xcd < r ? xcd * (q + 1) : r * (q + 1) + (xcd - r) * q) + off; }
        const int nig = WGM * nN, gid = wgid / nig, fm = gid * WGM, gsz = (nM - fm) < WGM ? (nM - fm) : WGM;
        u.pm = fm + ((wgid % nig) % gsz); u.pn = (wgid % nig) / gsz; return true;
    }
    __device__ __forceinline__ void a_ready(const Unit&) const {}
    __device__ __forceinline__ void done(const Unit&) const {}
};
struct PanelOrder {
    int first, stride, nM, nN, pn0;
    __host__ __device__ bool next(int i, Unit& u) const { const int p = first + (i / nN) * stride; if (p >= nM) return false; u.pm = p; u.pn = pn0 + i % nN; return true; }
    __device__ __forceinline__ void a_ready(const Unit&) const {}
    __device__ __forceinline__ void done(const Unit&) const {}
};
__device__ __forceinline__ unsigned cvt_pk_bf16(float lo, float hi) { unsigned r; asm volatile("v_cvt_pk_bf16_f32 %0, %1, %2" : "=v"(r) : "v"(lo), "v"(hi)); return r; }

__device__ __forceinline__ float fsig(float x) { return __builtin_amdgcn_rcpf(1.f + __builtin_amdgcn_exp2f(-1.44269504f * x)); }
__device__ __forceinline__ float fgelu(float x) { return x * fsig(1.5957691216f * (x + 0.044715f * x * x * x)); }
__device__ __forceinline__ float bflo(unsigned w) { return __builtin_bit_cast(float, w << 16); }
__device__ __forceinline__ float bfhi(unsigned w) { return __builtin_bit_cast(float, w & 0xffff0000u); }
__device__ __forceinline__ void unpk8(const u32x4 w, f32x4& a, f32x4& b) { a = (f32x4){bflo(w.x), bfhi(w.x), bflo(w.y), bfhi(w.y)}; b = (f32x4){bflo(w.z), bfhi(w.z), bflo(w.w), bfhi(w.w)}; }
__device__ __forceinline__ u32x4 pk8(const f32x4 a, const f32x4 b) { u32x4 w; w.x = cvt_pk_bf16(a[0], a[1]); w.y = cvt_pk_bf16(a[2], a[3]); w.z = cvt_pk_bf16(b[0], b[1]); w.w = cvt_pk_bf16(b[2], b[3]); return w; }
__device__ __forceinline__ f32x4 act4(f32x4 v, int kind) {
    if (kind == 1) { v = (f32x4){fgelu(v[0]), fgelu(v[1]), fgelu(v[2]), fgelu(v[3])}; }
    else if (kind == 2) { v = (f32x4){fsig(v[0]), fsig(v[1]), fsig(v[2]), fsig(v[3])}; }
    else if (kind == 3) { v = (f32x4){2.f * fsig(2.f * v[0]) - 1.f, 2.f * fsig(2.f * v[1]) - 1.f, 2.f * fsig(2.f * v[2]) - 1.f, 2.f * fsig(2.f * v[3]) - 1.f}; }
    return v;
}
#define EPI_ROWS_BEGIN _Pragma("unroll") for (int ai = 0; ai < 2; ++ai) _Pragma("unroll") for (int m = 0; m < 4; ++m) { const size_t row = (size_t)(row0 + ai * HALF + m * 16);
#define EPI_ROWS_END }

struct EpiZ {
    static constexpr bool PERM = true, AFTER_DRAIN = false;
    bf16_t *zrkv, *zl, *guv, *sg, *vf; int pnoff;
    __device__ __forceinline__ void operator()(const f32x4 (&acc)[2][2][4][2], const Unit& u, int wr, int wc, int fr, int fq) const {
        const int pn = u.pn + pnoff, row0 = u.pm * BM + wr * 64 + fr;
        bf16_t* dst; int ld, colt, k0, k1;
        if (pn < 12)       { dst = zrkv; ld = 3072; colt = pn * 256;        k0 = 0; k1 = 0; }
        else if (pn == 12) { dst = zl;   ld = 512;  colt = 0;               k0 = (wc < 2) ? 3 : 0; k1 = 2; }
        else if (pn == 13) { dst = zl;   ld = 512;  colt = 256;             k0 = 0; k1 = 0; }
        else if (pn < 22)  { dst = guv;  ld = 2048; colt = (pn - 14) * 256; k0 = 1; k1 = 1; }
        else               { dst = sg;   ld = 2048; colt = ((pn - 18) & 7) * 256; k0 = pn >= 26 ? 2 : 0; k1 = k0; }
        const int col0 = colt + wc * 32 + 8 * fq;
        const bool dovf = (vf != nullptr) && pn >= 8 && pn < 12;
        const int vcol0 = (pn - 8) * 256 + wc * 32 + 8 * fq;
        EPI_ROWS_BEGIN
            bf16_t* rowp = dst + row * ld + col0;
#pragma unroll
            for (int bj = 0; bj < 2; ++bj) { const int kind = bj ? k1 : k0;
                const u32x4 w = pk8(act4(acc[ai][bj][m][0], kind), act4(acc[ai][bj][m][1], kind));
                *(u32x4*)(rowp + bj * HALF) = w;
                if (dovf) *(u32x4*)(vf + row * 1024 + vcol0 + bj * HALF) = w; }
        EPI_ROWS_END
    }
};
struct EpiLora {
    static constexpr bool PERM = true, AFTER_DRAIN = false;
    bf16_t* ew; size_t stride; const float *w0, *a0; int pnoff;
    __device__ __forceinline__ void operator()(const f32x4 (&acc)[2][2][4][2], const Unit& u, int wr, int wc, int fr, int fq) const {
        const int pn = u.pn + pnoff, sel = pn >> 2, row0 = u.pm * BM + wr * 64 + fr, col0 = (pn & 3) * 256 + wc * 32 + 8 * fq;
        bf16_t* dst = ew + (size_t)sel * stride;
        const float* bp = sel == 0 ? w0 : a0;
        f32x4 bv[2][2];
#pragma unroll
        for (int bj = 0; bj < 2; ++bj)
#pragma unroll
            for (int n = 0; n < 2; ++n) bv[bj][n] = (sel < 2) ? *(const f32x4*)(bp + col0 + bj * HALF + 4 * n) : (f32x4){0.f, 0.f, 0.f, 0.f};
        EPI_ROWS_BEGIN
            bf16_t* rowp = dst + row * 1024 + col0;
#pragma unroll
            for (int bj = 0; bj < 2; ++bj) { f32x4 v0 = acc[ai][bj][m][0] + bv[bj][0], v1 = acc[ai][bj][m][1] + bv[bj][1];
                if (sel < 2) { v0 = act4(v0, 2); v1 = act4(v1, 2); }
                if (sel == 0) { v0 = v0 * 0.60653066f; v1 = v1 * 0.60653066f; }
                *(u32x4*)(rowp + bj * HALF) = pk8(v0, v1); }
        EPI_ROWS_END
    }
};
struct EpiMv {
    static constexpr bool PERM = true, AFTER_DRAIN = false;
    bf16_t* zrkv; const bf16_t* vf; const float* v0b;
    __device__ __forceinline__ void operator()(const f32x4 (&acc)[2][2][4][2], const Unit& u, int wr, int wc, int fr, int fq) const {
        const int row0 = u.pm * BM + wr * 64 + fr, col0 = u.pn * 256 + wc * 32 + 8 * fq;
        f32x4 bv[2][2];
#pragma unroll
        for (int bj = 0; bj < 2; ++bj)
#pragma unroll
            for (int n = 0; n < 2; ++n) bv[bj][n] = *(const f32x4*)(v0b + col0 + bj * HALF + 4 * n);
        EPI_ROWS_BEGIN
#pragma unroll
            for (int bj = 0; bj < 2; ++bj) { bf16_t* zp = zrkv + row * 3072 + 2048 + col0 + bj * HALF;
                f32x4 z0, z1, f0, f1; unpk8(*(const u32x4*)zp, z0, z1); unpk8(*(const u32x4*)(vf + row * 1024 + col0 + bj * HALF), f0, f1);
                const f32x4 m0 = act4(acc[ai][bj][m][0] + bv[bj][0], 2), m1 = act4(acc[ai][bj][m][1] + bv[bj][1], 2);
                *(u32x4*)zp = pk8(z0 + (f0 - z0) * m0, z1 + (f1 - z1) * m1); }
        EPI_ROWS_END
    }
};
struct EpiPlain {
    static constexpr bool PERM = true, AFTER_DRAIN = false;
    bf16_t* o; int ld;
    __device__ __forceinline__ void operator()(const f32x4 (&acc)[2][2][4][2], const Unit& u, int wr, int wc, int fr, int fq) const {
        const int row0 = u.pm * BM + wr * 64 + fr, col0 = u.pn * 256 + wc * 32 + 8 * fq;
        EPI_ROWS_BEGIN
#pragma unroll
            for (int bj = 0; bj < 2; ++bj) *(u32x4*)(o + row * ld + col0 + bj * HALF) = pk8(acc[ai][bj][m][0], acc[ai][bj][m][1]);
        EPI_ROWS_END
    }
};
template <bool SECOND> struct EpiMerge {
    static constexpr bool PERM = true, AFTER_DRAIN = false;
    const bf16_t* sg; bf16_t* m2; bf16_t* o;
    __device__ __forceinline__ void operator()(const f32x4 (&acc)[2][2][4][2], const Unit& u, int wr, int wc, int fr, int fq) const {
        const int row0 = u.pm * BM + wr * 64 + fr, col0 = u.pn * 256 + wc * 32 + 8 * fq;
#pragma unroll
        for (int ai = 0; ai < 2; ++ai) { u32x4 gv[4][2], pv[4][2];
#pragma unroll
            for (int m = 0; m < 4; ++m) { const size_t row = (size_t)(row0 + ai * HALF + m * 16);
#pragma unroll
                for (int bj = 0; bj < 2; ++bj) { const int c = col0 + bj * HALF; gv[m][bj] = *(const u32x4*)(sg + row * 2048 + (SECOND ? 0 : 1024) + c);
                    if (SECOND) pv[m][bj] = *(const u32x4*)(m2 + row * 2048 + c); } }
#pragma unroll
            for (int m = 0; m < 4; ++m) { const size_t row = (size_t)(row0 + ai * HALF + m * 16);
#pragma unroll
                for (int bj = 0; bj < 2; ++bj) { const int c = col0 + bj * HALF;
                    f32x4 g0, g1; unpk8(gv[m][bj], g0, g1); if (!SECOND) { g0 = act4(g0, 2); g1 = act4(g1, 2); }
                    f32x4 v0 = g0 * acc[ai][bj][m][0], v1 = g1 * acc[ai][bj][m][1];
                    if (SECOND) { f32x4 p0, p1; unpk8(pv[m][bj], p0, p1); v0 = v0 + p0; v1 = v1 + p1; *(u32x4*)(o + row * 1024 + c) = pk8(v0, v1); }
                    else *(u32x4*)(m2 + row * 2048 + c) = pk8(v0, v1); } } }
    }
};
struct EpiResid {
    static constexpr bool PERM = false, AFTER_DRAIN = false;
    float* h;
    __device__ __forceinline__ void operator()(const f32x4 (&acc)[2][2][4][2], const Unit& u, int wr, int wc, int fr, int fq) const {
        const int row0 = u.pm * BM + wr * 64 + fr, col0 = u.pn * 256 + wc * 32 + 4 * fq;
#pragma unroll
        for (int ai = 0; ai < 2; ++ai) { f32x4 hv[4][2][2];
#pragma unroll
            for (int m = 0; m < 4; ++m) { const float* rowp = h + (size_t)(row0 + ai * HALF + m * 16) * 1024 + col0;
#pragma unroll
                for (int bj = 0; bj < 2; ++bj)
#pragma unroll
                    for (int n = 0; n < 2; ++n) hv[m][bj][n] = *(const f32x4*)(rowp + bj * HALF + n * 16); }
#pragma unroll
            for (int m = 0; m < 4; ++m) { float* rowp = h + (size_t)(row0 + ai * HALF + m * 16) * 1024 + col0;
#pragma unroll
                for (int bj = 0; bj < 2; ++bj)
#pragma unroll
                    for (int n = 0; n < 2; ++n) *(f32x4*)(rowp + bj * HALF + n * 16) = hv[m][bj][n] + acc[ai][bj][m][n]; } }
    }
};
struct EpiQG {
    static constexpr bool PERM = true, AFTER_DRAIN = false;
    bf16_t* q; const bf16_t* pw; float* h;
    __device__ __forceinline__ void operator()(const f32x4 (&acc)[2][2][4][2], const Unit& u, int wr, int wc, int fr, int fq) const {
        const int row0 = u.pm * BM + wr * 64 + fr;
        if (u.pn < 8) { const int col0 = u.pn * 256 + wc * 32 + 8 * fq;
            EPI_ROWS_BEGIN
#pragma unroll
                for (int bj = 0; bj < 2; ++bj) *(u32x4*)(q + row * 2048 + col0 + bj * HALF) = pk8(acc[ai][bj][m][0], acc[ai][bj][m][1]);
            EPI_ROWS_END
        } else { const int col0 = (u.pn - 8) * 256 + wc * 32 + 8 * fq;
#pragma unroll
            for (int ai = 0; ai < 2; ++ai)
#pragma unroll
            for (int mh = 0; mh < 2; ++mh) { u32x4 pwv[2][2]; f32x4 hv[2][2][2];
#pragma unroll
                for (int m2_ = 0; m2_ < 2; ++m2_) { const size_t row = (size_t)(row0 + ai * HALF + (2 * mh + m2_) * 16);
#pragma unroll
                    for (int bj = 0; bj < 2; ++bj) { const int c = col0 + bj * HALF; pwv[m2_][bj] = *(const u32x4*)(pw + row * 1024 + c);
                        hv[m2_][bj][0] = *(const f32x4*)(h + row * 1024 + c); hv[m2_][bj][1] = *(const f32x4*)(h + row * 1024 + c + 4); } }
#pragma unroll
                for (int m2_ = 0; m2_ < 2; ++m2_) { const int m = 2 * mh + m2_; const size_t row = (size_t)(row0 + ai * HALF + m * 16);
#pragma unroll
                    for (int bj = 0; bj < 2; ++bj) { const int c = col0 + bj * HALF; f32x4 p0, p1; unpk8(pwv[m2_][bj], p0, p1);
                        *(f32x4*)(h + row * 1024 + c) = hv[m2_][bj][0] + p0 * act4(acc[ai][bj][m][0], 2); *(f32x4*)(h + row * 1024 + c + 4) = hv[m2_][bj][1] + p1 * act4(acc[ai][bj][m][1], 2); } } }
        }
    }
};
template <class Epi, class Sched, bool ALIGN_EPI = false, bool SP2 = false>
__device__ __forceinline__ void gemm_phase(PG8_LAS unsigned char* lds, const Gemm g, const Sched& S, const Epi& E, const int wave0) {
    int tidq; asm volatile("v_mbcnt_lo_u32_b32 %0, -1, 0\n\tv_mbcnt_hi_u32_b32 %0, -1, %0" : "=v"(tidq)); tidq += wave0 * 64;
    const int tid = tidq, wid = __builtin_amdgcn_readfirstlane(tid >> 6), lane = tid & 63, wr = wid >> 2, wc = wid & 3, fr = lane & 15, fq = lane >> 4;
    int Kq = g.K, ldaq = g.lda; const bf16_t* gA = g.A; const bf16_t* gB = g.Bt; asm volatile("" : "+s"(Kq), "+s"(ldaq), "+s"(gA), "+s"(gB));
    const int K = Kq, nt = K / BK;
    unsigned voffA[2], voffB[2];
#pragma unroll
    for (int i = 0; i < 2; ++i) { int R, C; stage_rc(tid * 16 + i * 8192, R, C); const int Rb = Epi::PERM ? ((R & ~31) + perm32(R & 31)) : R;
        voffA[i] = (unsigned)(R * ldaq + C) * 2u; voffB[i] = (unsigned)(Rb * K + C) * 2u; }
    const size_t kstep = (size_t)(BK * 2);
    const size_t hstepA = (size_t)HALF * ldaq * 2, hstepB = (size_t)HALF * K * 2;
    const size_t tstepA = 2 * hstepA, tstepB = 2 * hstepB;
    const unsigned ldsw = (unsigned)wid * 1024u;
    const int aoff = lds_byte(wr * 64 + fr, fq * 8), boff = lds_byte(wc * 32 + fr, fq * 8);
#define PG8_SA(b, h) (((b) * 2 + (h)) * HTB)
#define PG8_SB(b, h) ((4 + (b) * 2 + (h)) * HTB)
#define PG8_STAGE(bufoff, gbase, voff) do { _Pragma("unroll") for (int _i = 0; _i < 2; ++_i) \
        __builtin_amdgcn_global_load_lds((const unsigned*)((const char*)(gbase) + (voff)[_i]), (PG8_LAS unsigned*)(lds + (bufoff) + ldsw + _i * 8192), 16, 0, 0); } while (0)
#define PG8_LDA(dst, b, h) do { _Pragma("unroll") for (int m = 0; m < 4; ++m) _Pragma("unroll") for (int k = 0; k < 2; ++k) dst[m][k] = *(const PG8_LAS bf16x8*)(lds + PG8_SA(b, h) + aoff + m * 2048 + k * 1024); } while (0)
#define PG8_LDB(dst, b, h) do { _Pragma("unroll") for (int n = 0; n < 2; ++n) _Pragma("unroll") for (int k = 0; k < 2; ++k) dst[n][k] = *(const PG8_LAS bf16x8*)(lds + PG8_SB(b, h) + boff + n * 2048 + k * 1024); } while (0)
#define PG8_MMA(ai, bj, At, Bt) do { __builtin_amdgcn_s_setprio(1); _Pragma("unroll") for (int m = 0; m < 4; ++m) _Pragma("unroll") for (int n = 0; n < 2; ++n) _Pragma("unroll") for (int k = 0; k < 2; ++k) \
        acc[ai][bj][m][n] = __builtin_amdgcn_mfma_f32_16x16x32_bf16(Bt[n][k], At[m][k], acc[ai][bj][m][n], 0, 0, 0); __builtin_amdgcn_s_setprio(0); } while (0)
#define PG8_WAIT_V(n) asm volatile("s_waitcnt vmcnt(" #n ")" ::: "memory")
#define PG8_WAIT_L(n) asm volatile("s_waitcnt lgkmcnt(" #n ")" ::: "memory")
#define PG8_BAR __builtin_amdgcn_s_barrier()
#define PG8_SCHED __builtin_amdgcn_sched_barrier(0)
    Unit cur, nxt; int ui = 0;
    if (!S.next(0, cur)) return;
    f32x4 acc[2][2][4][2];
#pragma unroll
    for (int a = 0; a < 2; ++a)
#pragma unroll
        for (int b = 0; b < 2; ++b)
#pragma unroll
            for (int m = 0; m < 4; ++m)
#pragma unroll
                for (int n = 0; n < 2; ++n) acc[a][b][m][n] = (f32x4){0.f, 0.f, 0.f, 0.f};
    bf16x8 At[4][2], B0[2][2], B1[2][2];
    const char* cA = (const char*)gA + (size_t)cur.pm * tstepA; const char* cB = (const char*)gB + (size_t)cur.pn * tstepB;
    S.a_ready(cur);
    if constexpr (SP2) {
        PG8_STAGE(PG8_SB(0, 0), cB, voffB); PG8_STAGE(PG8_SB(0, 1), cB + hstepB, voffB); PG8_STAGE(PG8_SA(0, 0), cA, voffA); PG8_STAGE(PG8_SA(0, 1), cA + hstepA, voffA);
        if (wr == 1) PG8_BAR;
        PG8_WAIT_V(2); PG8_BAR;
        PG8_STAGE(PG8_SB(1, 0), cB + kstep, voffB); PG8_STAGE(PG8_SA(1, 0), cA + kstep, voffA); PG8_STAGE(PG8_SB(1, 1), cB + hstepB + kstep, voffB);
        PG8_WAIT_V(6); PG8_BAR;
    } else {
        PG8_STAGE(PG8_SB(0, 0), cB, voffB); PG8_STAGE(PG8_SA(0, 0), cA, voffA); PG8_STAGE(PG8_SB(0, 1), cB + hstepB, voffB); PG8_STAGE(PG8_SA(0, 1), cA + hstepA, voffA);
        if (wr == 1) PG8_BAR;
        PG8_WAIT_V(4); PG8_BAR;
        PG8_STAGE(PG8_SB(1, 0), cB + kstep, voffB); PG8_STAGE(PG8_SA(1, 0), cA + kstep, voffA); PG8_STAGE(PG8_SB(1, 1), cB + hstepB + kstep, voffB);
        PG8_WAIT_V(6); PG8_BAR;
    }
    for (;;) {
        const bool has_next = S.next(ui + 1, nxt);
        const char* nA = has_next ? (const char*)gA + (size_t)nxt.pm * tstepA : cA; const char* nB = has_next ? (const char*)gB + (size_t)nxt.pn * tstepB : cB;
        for (int t = 0; t < nt; t += 2) {
            const bool last = (t == nt - 2);
            const char* a1 = cA + (size_t)(t + 1) * kstep;
            const char* a2 = last ? nA : cA + (size_t)(t + 2) * kstep; const char* b2 = last ? nB : cB + (size_t)(t + 2) * kstep;
            const char* a3 = a2 + kstep; const char* b3 = b2 + kstep;
            if (last && has_next) S.a_ready(nxt);
            if constexpr (SP2) {
            PG8_LDB(B0, 0, 0); PG8_LDB(B1, 0, 1); PG8_SCHED; PG8_LDA(At, 0, 0); PG8_STAGE(PG8_SA(1, 1), a1 + hstepA, voffA);
            PG8_WAIT_V(8); PG8_WAIT_L(0); PG8_BAR; PG8_MMA(0, 0, At, B0); PG8_MMA(0, 1, At, B1); PG8_BAR; PG8_SCHED;
            PG8_LDA(At, 0, 1); PG8_STAGE(PG8_SB(0, 0), b2, voffB); PG8_STAGE(PG8_SB(0, 1), b2 + hstepB, voffB); PG8_STAGE(PG8_SA(0, 0), a2, voffA);
            PG8_WAIT_V(8); PG8_WAIT_L(0); PG8_BAR; PG8_MMA(1, 0, At, B0); PG8_MMA(1, 1, At, B1); PG8_BAR; PG8_SCHED;
            PG8_LDB(B0, 1, 0); PG8_LDB(B1, 1, 1); PG8_SCHED; PG8_LDA(At, 1, 0); PG8_STAGE(PG8_SA(0, 1), a2 + hstepA, voffA);
            PG8_WAIT_V(8); PG8_WAIT_L(0); PG8_BAR; PG8_MMA(0, 0, At, B0); PG8_MMA(0, 1, At, B1); PG8_BAR; PG8_SCHED;
            PG8_LDA(At, 1, 1); PG8_STAGE(PG8_SB(1, 0), b3, voffB); PG8_STAGE(PG8_SB(1, 1), b3 + hstepB, voffB); PG8_STAGE(PG8_SA(1, 0), a3, voffA);
            PG8_WAIT_V(8); PG8_WAIT_L(0); PG8_BAR; PG8_MMA(1, 0, At, B0); PG8_MMA(1, 1, At, B1); PG8_BAR; PG8_SCHED;
            } else {
            PG8_LDB(B0, 0, 0); PG8_SCHED; PG8_LDA(At, 0, 0); PG8_STAGE(PG8_SA(1, 1), a1 + hstepA, voffA);
            PG8_WAIT_L(8); PG8_BAR; PG8_WAIT_L(0); PG8_MMA(0, 0, At, B0); PG8_BAR; PG8_SCHED;
            PG8_LDB(B1, 0, 1); PG8_STAGE(PG8_SB(0, 0), b2, voffB);
            PG8_BAR; PG8_WAIT_L(0); PG8_MMA(0, 1, At, B1); PG8_BAR;
            PG8_LDA(At, 0, 1); PG8_STAGE(PG8_SA(0, 0), a2, voffA);
            PG8_BAR; PG8_WAIT_L(0); PG8_MMA(1, 0, At, B0); PG8_BAR; PG8_SCHED;
            PG8_STAGE(PG8_SB(0, 1), b2 + hstepB, voffB);
            PG8_WAIT_V(6); PG8_BAR; PG8_MMA(1, 1, At, B1); PG8_BAR;
            PG8_LDB(B0, 1, 0); PG8_SCHED; PG8_LDA(At, 1, 0); PG8_STAGE(PG8_SA(0, 1), a2 + hstepA, voffA);
            PG8_WAIT_L(8); PG8_BAR; PG8_WAIT_L(0); PG8_MMA(0, 0, At, B0); PG8_BAR; PG8_SCHED;
            PG8_LDB(B1, 1, 1); PG8_STAGE(PG8_SB(1, 0), b3, voffB);
            PG8_BAR; PG8_WAIT_L(0); PG8_MMA(0, 1, At, B1); PG8_BAR;
            PG8_LDA(At, 1, 1); PG8_STAGE(PG8_SA(1, 0), a3, voffA);
            PG8_BAR; PG8_WAIT_L(0); PG8_MMA(1, 0, At, B0); PG8_BAR; PG8_SCHED;
            PG8_STAGE(PG8_SB(1, 1), b3 + hstepB, voffB);
            PG8_WAIT_V(6); PG8_BAR; PG8_MMA(1, 1, At, B1); PG8_BAR;
            }
        }
        if constexpr (ALIGN_EPI) { if (wr == 0) PG8_BAR; }
        if constexpr (!Epi::AFTER_DRAIN) { E(acc, cur, wr, wc, fr, fq); S.done(cur); }
        if (!has_next) break;
#pragma unroll
        for (int a = 0; a < 2; ++a)
#pragma unroll
            for (int b = 0; b < 2; ++b)
#pragma unroll
                for (int m = 0; m < 4; ++m)
#pragma unroll
                    for (int n = 0; n < 2; ++n) acc[a][b][m][n] = (f32x4){0.f, 0.f, 0.f, 0.f};
        cur = nxt; cA = nA; cB = nB; ++ui;
        if constexpr (ALIGN_EPI) { if (wr == 1) PG8_BAR; }
    }
    PG8_WAIT_V(0);
    if constexpr (!ALIGN_EPI) { if (wr == 0) PG8_BAR; }
    PG8_BAR;
    if constexpr (Epi::AFTER_DRAIN) { E.fused(acc, cur, wr, wc, fr, fq, lds, wid, lane); S.done(cur); }
#undef PG8_SA
#undef PG8_SB
#undef PG8_STAGE
#undef PG8_LDA
#undef PG8_LDB
#undef PG8_MMA
#undef PG8_WAIT_V
#undef PG8_WAIT_L
#undef PG8_BAR
#undef PG8_SCHED
}
}

constexpr int NB = 8, SEQ = 4096, T = NB * SEQ, D = 1024, DEPTH = 4, NZ = 7680, NWAVES = 8;
constexpr int CIN = 7424;
constexpr size_t MiB = 1u << 20;
constexpr size_t WS_CTL = 0, WS_LORA = 1 * MiB, WS_MV = 7 * MiB, ZERO_BYTES = 9 * MiB;
constexpr size_t LORA_BYTES = 3072 * 256 * 2, MV_BYTES = 1024 * 256 * 2;
constexpr size_t WS_WIN = 10 * MiB;
constexpr size_t WS_DB = 40 * MiB, DB_SET = 62 * MiB;
constexpr size_t DB_PA = 0, DB_PBT = 2 * MiB, DB_POUT = 4 * MiB, DB_WQG = 6 * MiB, DB_KEYS = 12 * MiB, DB_GMW = 12 * MiB + 512 * 1024, DB_PLEW = 13 * MiB, DB_U = 14 * MiB, DB_V = 30 * MiB, DB_PB = 46 * MiB;
constexpr size_t WS_VF = 164 * MiB, WS_PW = 228 * MiB, WS_NX = 292 * MiB, WS_ZRKV = 420 * MiB, WS_ZL = 612 * MiB, WS_GUV = 644 * MiB, WS_SG = 772 * MiB;
constexpr size_t WS_EW = 900 * MiB, WS_AR = 964 * MiB, WS_G = 1028 * MiB, WS_WINB = 1092 * MiB, WINB_BYTES = 4 * MiB, WS_END = 1100 * MiB;
constexpr size_t WS_Q = WS_ZRKV, WS_SEL = WS_ZRKV + 128 * MiB, WS_MG = WS_AR, WS_N2 = WS_G;
constexpr size_t WIN_ZERO_OFF = WS_WIN + (size_t)3328 * 2048 * 2, WIN_ZERO_BYTES = (size_t)256 * 2048 * 2;
#ifndef ZSPLIT
#define ZSPLIT 2
#endif
constexpr int CW_BAR = 4096;
constexpr int RING_BYTES = 131072, LDSCTL_OFF = RING_BYTES, MISC_OFF = LDSCTL_OFF + 320, LDS_BYTES = 147456;

#define LAS __attribute__((address_space(3)))
#define GAS __attribute__((address_space(1)))
typedef unsigned short bf16;
typedef unsigned v4u __attribute__((ext_vector_type(4)));
typedef unsigned v2u __attribute__((ext_vector_type(2)));
typedef float f32x4 __attribute__((ext_vector_type(4)));
typedef float f32x2 __attribute__((ext_vector_type(2)));
typedef short bf16x8 __attribute__((ext_vector_type(8)));
using pg8::fsig; using pg8::fgelu; using pg8::bflo; using pg8::bfhi; using pg8::unpk8; using pg8::pk8; using pg8::cvt_pk_bf16;

#define XB_TMO      128
#define XB_XCNT(j)  (256  + 64 * (j))
#define XB_XSUB(j)  (1280 + 64 * (j))
#define XB_XGEN(j)  (2304 + 64 * (j))
#define XB_TOP      3328
#define XB_TOPGEN   3392
#define XCD_BAR_WORDS 3456
#define XB_SPIN_CAP (1u << 22)

__device__ __forceinline__ unsigned xb_ld(unsigned* p)              { return __hip_atomic_load(p, __ATOMIC_RELAXED, __HIP_MEMORY_SCOPE_AGENT); }
__device__ __forceinline__ unsigned xb_add(unsigned* p, unsigned v) { return __hip_atomic_fetch_add(p, v, __ATOMIC_RELAXED, __HIP_MEMORY_SCOPE_AGENT); }
__device__ __forceinline__ unsigned xb_xcc_id() { return (unsigned)__builtin_amdgcn_s_getreg((3 << 11) | 20) & 0xFu; }
#define XB_SPIN(cond, bar) do { unsigned _sp = 0; while (cond) { __builtin_amdgcn_s_sleep(1); \
    if ((++_sp & 255u) == 0u) { if (xb_ld(&(bar)[XB_TMO])) break; if (_sp > XB_SPIN_CAP) { atomicAdd(&(bar)[XB_TMO], 1u); break; } } } } while (0)

struct XcdBarrier { unsigned* bar; unsigned x; volatile LAS unsigned* st; };

__device__ __forceinline__ XcdBarrier xcd_barrier_post(unsigned* bar, volatile LAS unsigned* st) {
    XcdBarrier b; b.bar = bar; b.x = xb_xcc_id(); b.st = st;
    if (threadIdx.x == 0) (void)xb_add(&bar[XB_XCNT(b.x)], 1u);
    return b;
}
__device__ __forceinline__ void xcd_barrier_complete(unsigned* bar, unsigned x, unsigned& nloc, unsigned& nx) {
    const unsigned G = gridDim.x * gridDim.y * gridDim.z;
    unsigned sum, cnt, mine, sp = 0u;
    for (;;) {
        sum = 0u; cnt = 0u; mine = 0u;
#pragma unroll
        for (unsigned j = 0; j < 16; ++j) { const unsigned c = xb_ld(&bar[XB_XCNT(j)]); sum += c; cnt += (c > 0u) ? 1u : 0u; mine = (j == x) ? c : mine; }
        if (sum == G) break;
        __builtin_amdgcn_s_sleep(1);
        if ((++sp & 255u) == 0u) { if (xb_ld(&bar[XB_TMO])) break; if (sp > XB_SPIN_CAP) { atomicAdd(&bar[XB_TMO], 1u); break; } }
    }
    nloc = mine > 0u ? mine : 1u; nx = cnt > 0u ? cnt : 1u;
}
__device__ __forceinline__ int lane_id_now();
__device__ __forceinline__ void xcd_barrier(const XcdBarrier& b, const int wave0) {
    asm volatile("s_waitcnt vmcnt(0)" ::: "memory");
    __syncthreads();
    if (wave0 == 0 && lane_id_now() == 0) {
        unsigned* bar = b.bar;
        __builtin_amdgcn_s_waitcnt(0);
        unsigned nloc = b.st[0], nx = b.st[1];
        if (nloc == 0u) { xcd_barrier_complete(bar, b.x, nloc, nx); b.st[0] = nloc; b.st[1] = nx; }
        const unsigned old = xb_add(&bar[XB_XSUB(b.x)], 1u);
        const unsigned gen = old / nloc;
        if (old + 1u == (gen + 1u) * nloc) {
            __builtin_amdgcn_fence(__ATOMIC_RELEASE, "agent");
            asm volatile("s_waitcnt vmcnt(0)" ::: "memory");
            const unsigned og = xb_add(&bar[XB_TOP], 1u);
            const unsigned tg = og / nx;
            if (og + 1u == (tg + 1u) * nx) xb_add(&bar[XB_TOPGEN], 1u);
            else XB_SPIN(xb_ld(&bar[XB_TOPGEN]) == tg, bar);
            __builtin_amdgcn_fence(__ATOMIC_ACQUIRE, "agent");
            xb_add(&bar[XB_XGEN(b.x)], 1u);
            asm volatile("s_waitcnt vmcnt(0)" ::: "memory");
        } else {
            XB_SPIN(xb_ld(&bar[XB_XGEN(b.x)]) == gen, bar);
            __builtin_amdgcn_fence(__ATOMIC_ACQUIRE, "agent");
            asm volatile("s_waitcnt vmcnt(0)" ::: "memory");
        }
    }
    __syncthreads();
}

struct Args { const float* in[32]; float* out; unsigned char* ws; };
struct Frame {
    LAS unsigned char* lds;
    int tid, lane, wave, G, bx, wave0;
    GAS unsigned char* ws; float* h;
};
__device__ __forceinline__ int lane_id_now() { int l; asm volatile("v_mbcnt_lo_u32_b32 %0, -1, 0\n\tv_mbcnt_hi_u32_b32 %0, -1, %0" : "=v"(l)); return l; }
__device__ __forceinline__ void phase_ids(Frame& F) { const int l = lane_id_now(); F.lane = l; F.wave = F.wave0; F.tid = F.wave0 * 64 + l; GAS unsigned char* w = F.ws; asm volatile("" : "+s"(w)); F.ws = w; }
#define DPP_ADD(x, ctrl) ((x) + __builtin_bit_cast(float, __builtin_amdgcn_update_dpp(0, __builtin_bit_cast(int, (x)), (ctrl), 0xf, 0xf, false)))
__device__ __forceinline__ float sum8(float v) {
    v = DPP_ADD(v, 0xB1);
    v = DPP_ADD(v, 0x4E);
    v = DPP_ADD(v, 0x141);
    return v;
}
__device__ __forceinline__ float sum16(float v) { v = sum8(v); v = DPP_ADD(v, 0x140); return v; }
#define DPP_ADD_NS(x, ctrl) do { (x) = DPP_ADD((x), (ctrl)); asm("" : "+v"(x)); } while (0)
__device__ __forceinline__ float sum16_ns(float v) { DPP_ADD_NS(v, 0xB1); DPP_ADD_NS(v, 0x4E); DPP_ADD_NS(v, 0x141); DPP_ADD_NS(v, 0x140); return v; }
__device__ __forceinline__ float wave_sum(float v) {
    v = sum8(v);
    v = DPP_ADD(v, 0x140);
    const auto r = __builtin_amdgcn_permlane16_swap(__builtin_bit_cast(unsigned, v), __builtin_bit_cast(unsigned, v), false, false);
    v = __builtin_bit_cast(float, (unsigned)r[0]) + __builtin_bit_cast(float, (unsigned)r[1]);
    const auto q = __builtin_amdgcn_permlane32_swap(__builtin_bit_cast(unsigned, v), __builtin_bit_cast(unsigned, v), false, false);
    return __builtin_bit_cast(float, (unsigned)q[0]) + __builtin_bit_cast(float, (unsigned)q[1]);
}
__device__ __forceinline__ unsigned xor16_u(unsigned x, int lane) { const auto r = __builtin_amdgcn_permlane16_swap(x, x, false, false); return (lane & 16) ? (unsigned)r[0] : (unsigned)r[1]; }
__device__ __forceinline__ unsigned xor32_u(unsigned x, int lane) { const auto r = __builtin_amdgcn_permlane32_swap(x, x, false, false); return (lane & 32) ? (unsigned)r[0] : (unsigned)r[1]; }
__device__ __forceinline__ void tr_item(const float* W, int ldw, int ncols, bf16* WT, int ldt, int koff, int row_off, LAS float* scr, int item, int lane) {
    const int nblk = ncols / 32, kb = item / nblk, nb = item % nblk, k0 = 64 * kb, n0 = 32 * nb;
#pragma unroll 8
    for (int i = 0; i < 32; ++i) { const int kk = 2 * i + (lane >> 5); scr[kk * 33 + (lane & 31)] = W[(size_t)(k0 + kk) * ldw + n0 + (lane & 31)]; }
    asm volatile("s_waitcnt lgkmcnt(0)" ::: "memory");
    const int c = lane & 7;
#pragma unroll
    for (int j = 0; j < 4; ++j) { const int n = (lane >> 3) + 8 * j; const LAS float* s = scr + (8 * c) * 33 + n;
        v4u o; o.x = cvt_pk_bf16(s[0 * 33], s[1 * 33]); o.y = cvt_pk_bf16(s[2 * 33], s[3 * 33]); o.z = cvt_pk_bf16(s[4 * 33], s[5 * 33]); o.w = cvt_pk_bf16(s[6 * 33], s[7 * 33]);
        *(v4u*)(WT + (size_t)(row_off + n0 + n) * ldt + koff + k0 + 8 * c) = o; }
    asm volatile("s_waitcnt lgkmcnt(0)" ::: "memory");
}
__device__ __forceinline__ void cvt_chunk(const float* src, bf16* dst, size_t chunk, int lane) {
    const f32x4* s = (const f32x4*)(src + chunk * 512) + lane * 2; const f32x4 a = s[0], b = s[1];
    *(v4u*)(dst + chunk * 512 + lane * 8) = pk8(a, b);
}
__device__ __forceinline__ void cvt8_chunk(const float* src, unsigned char* dst, size_t chunk, int lane, float sc) {
    const f32x4* s = (const f32x4*)(src + chunk * 512) + lane * 2; const f32x4 a = s[0] * sc, b = s[1] * sc;
    int w0 = 0, w1 = 0;
    w0 = __builtin_amdgcn_cvt_pk_fp8_f32(a.x, a.y, w0, false); w0 = __builtin_amdgcn_cvt_pk_fp8_f32(a.z, a.w, w0, true);
    w1 = __builtin_amdgcn_cvt_pk_fp8_f32(b.x, b.y, w1, false); w1 = __builtin_amdgcn_cvt_pk_fp8_f32(b.z, b.w, w1, true);
    *(v2u*)(dst + chunk * 512 + lane * 8) = (v2u){(unsigned)w0, (unsigned)w1};
}
__device__ __forceinline__ void norm_row_nx(const float* hrow, float* hcopy, const float* g, bf16* NX, int t, int lane) {
    const f32x4* xr = (const f32x4*)hrow + lane; f32x4 v[4]; float s = 0.f;
#pragma unroll
    for (int j = 0; j < 4; ++j) { v[j] = xr[64 * j]; s += (v[j].x * v[j].x + v[j].y * v[j].y) + (v[j].z * v[j].z + v[j].w * v[j].w); }
    if (hcopy) {
#pragma unroll
        for (int j = 0; j < 4; ++j) ((f32x4*)hcopy)[lane + 64 * j] = v[j]; }
    const float rstd = 1.f / sqrtf(wave_sum(s) * (1.f / D) + 1e-6f);
    const int tt = t & (SEQ - 1);
#pragma unroll
    for (int j = 0; j < 4; ++j) { const f32x4 gv = ((const f32x4*)g)[lane + 64 * j]; const f32x4 o = v[j] * rstd * gv;
        v2u w; w.x = cvt_pk_bf16(o.x, o.y); w.y = cvt_pk_bf16(o.z, o.w);
        const int c = 4 * (lane + 64 * j);
        *(v2u*)(NX + (size_t)t * 2048 + c) = w;
        if (tt != SEQ - 1) *(v2u*)(NX + (size_t)(t + 1) * 2048 + 1024 + c) = w;
        if (tt == 0) *(v2u*)(NX + (size_t)t * 2048 + 1024 + c) = (v2u){0u, 0u}; }
}
__device__ __forceinline__ void norm_row_nx2(const float* hrow0, const float* hrow1, float* hc0, float* hc1, const float* g, bf16* NX, int t0, int t1, int lane) {
    const f32x4* xa = (const f32x4*)hrow0 + lane; const f32x4* xb = (const f32x4*)hrow1 + lane; f32x4 v[2][4]; float s0 = 0.f, s1 = 0.f;
#pragma unroll
    for (int j = 0; j < 4; ++j) { v[0][j] = xa[64 * j]; v[1][j] = xb[64 * j]; }
#pragma unroll
    for (int j = 0; j < 4; ++j) { s0 += (v[0][j].x * v[0][j].x + v[0][j].y * v[0][j].y) + (v[0][j].z * v[0][j].z + v[0][j].w * v[0][j].w); s1 += (v[1][j].x * v[1][j].x + v[1][j].y * v[1][j].y) + (v[1][j].z * v[1][j].z + v[1][j].w * v[1][j].w);
        ((f32x4*)hc0)[lane + 64 * j] = v[0][j]; ((f32x4*)hc1)[lane + 64 * j] = v[1][j]; }
    const float r0 = 1.f / sqrtf(wave_sum(s0) * (1.f / D) + 1e-6f), r1 = 1.f / sqrtf(wave_sum(s1) * (1.f / D) + 1e-6f);
#pragma unroll
    for (int rr = 0; rr < 2; ++rr) { const int t = rr ? t1 : t0, tt = t & (SEQ - 1); const float rstd = rr ? r1 : r0;
#pragma unroll
        for (int j = 0; j < 4; ++j) { const f32x4 gv = ((const f32x4*)g)[lane + 64 * j]; const f32x4 o = v[rr][j] * rstd * gv;
            v2u w; w.x = cvt_pk_bf16(o.x, o.y); w.y = cvt_pk_bf16(o.z, o.w);
            const int c = 4 * (lane + 64 * j);
            *(v2u*)(NX + (size_t)t * 2048 + c) = w;
            if (tt != SEQ - 1) *(v2u*)(NX + (size_t)(t + 1) * 2048 + 1024 + c) = w;
            if (tt == 0) *(v2u*)(NX + (size_t)t * 2048 + 1024 + c) = (v2u){0u, 0u}; } }
}
__device__ __forceinline__ void norm_row_n2x2(const float* hrow0, const float* hrow1, const float* g, bf16* o0, bf16* o1, int lane) {
    const f32x4* x0 = (const f32x4*)hrow0 + lane; const f32x4* x1 = (const f32x4*)hrow1 + lane; f32x4 v[2][4]; float s0 = 0.f, s1 = 0.f;
#pragma unroll
    for (int j = 0; j < 4; ++j) { v[0][j] = x0[64 * j]; v[1][j] = x1[64 * j]; }
#pragma unroll
    for (int j = 0; j < 4; ++j) { s0 += (v[0][j].x * v[0][j].x + v[0][j].y * v[0][j].y) + (v[0][j].z * v[0][j].z + v[0][j].w * v[0][j].w);
                                  s1 += (v[1][j].x * v[1][j].x + v[1][j].y * v[1][j].y) + (v[1][j].z * v[1][j].z + v[1][j].w * v[1][j].w); }
    const float r0 = 1.f / sqrtf(wave_sum(s0) * (1.f / D) + 1e-6f), r1 = 1.f / sqrtf(wave_sum(s1) * (1.f / D) + 1e-6f);
#pragma unroll
    for (int j = 0; j < 4; ++j) { const f32x4 gv = ((const f32x4*)g)[lane + 64 * j]; const f32x4 a = v[0][j] * r0 * gv, b = v[1][j] * r1 * gv;
        *(v2u*)(o0 + 4 * (lane + 64 * j)) = (v2u){cvt_pk_bf16(a.x, a.y), cvt_pk_bf16(a.z, a.w)}; *(v2u*)(o1 + 4 * (lane + 64 * j)) = (v2u){cvt_pk_bf16(b.x, b.y), cvt_pk_bf16(b.z, b.w)}; }
}
__device__ __forceinline__ void prep_phase(Frame& F, const Args& a, int layer, int blk, int nblk_, int part) {
    phase_ids(F);
    LAS float* scr = (LAS float*)(F.lds + F.wave * 16384);
    const int gw = blk * NWAVES + F.wave, NGW = nblk_ * NWAVES, lane = F.lane;
    GAS unsigned char* ws = F.ws; GAS unsigned char* db = F.ws + WS_DB + (size_t)(layer & 1) * DB_SET;
    bf16* WIN = (bf16*)(ws + WS_WIN); bf16* LORA = (bf16*)(ws + WS_LORA + (size_t)layer * LORA_BYTES); bf16* MVT = (bf16*)(ws + WS_MV + (size_t)(layer > 0 ? layer - 1 : 0) * MV_BYTES);
    const float* w_in = a.in[5] + (size_t)layer * 2048 * CIN;
    const int mvn = layer > 0 ? 32 : 0;
    const int c1 = 32 * 104, c2a = 32 * 64, c2b = 32 * 32, c2c = 32 * (32 - 8 * ZSPLIT), c2d = 32 * 8 * ZSPLIT, c2 = c2a + 2 * c2b, c3 = mvn, c4 = 32, c5 = 32, c6 = 64, c7 = 512, c10 = 1024, c12 = 128;
    const int total = (part & 1) ? c1 + c2 + c3 + c4 + c5 + c6 + 3 * c7 + c10 + c7 + c12 : 0;
    for (int it = gw; it < total; it += NGW) {
        int r = it;
        if (r < c1) { tr_item(w_in, CIN, 3328, WIN, 2048, 0, 0, scr, r, lane); continue; } r -= c1;
        if (r < c2a) { tr_item(w_in + 3328, CIN, 2048, WIN, 2048, 0, 3584, scr, r, lane); continue; } r -= c2a;
        if (r < c2b) { tr_item(w_in + 6400, CIN, 1024, WIN, 2048, 0, 5632, scr, r, lane); continue; } r -= c2b;
        if (r < c2c) { tr_item(w_in + 5376, CIN, 1024 - 256 * ZSPLIT, WIN, 2048, 0, 6656, scr, r, lane); continue; } r -= c2c;
        if (r < c2d) { tr_item(w_in + 6400 - 256 * ZSPLIT, CIN, 256 * ZSPLIT, (bf16*)(ws + WS_WINB + (size_t)(layer & 1) * WINB_BYTES), 2048, 0, 0, scr, r, lane); continue; } r -= c2d;
        if (r < c3) { tr_item(a.in[16] + (size_t)(layer - 1) * 2048 * 32, 32, 32, WIN, 2048, 0, 3328, scr, r, lane); continue; } r -= c3;
        if (r < c4) { tr_item(a.in[7] + (size_t)layer * 64 * 1024, 1024, 1024, LORA, 128, 0, 0, scr, r, lane); continue; } r -= c4;
        if (r < c5) { tr_item(a.in[9] + (size_t)layer * 64 * 1024, 1024, 1024, LORA, 128, 64, 1024, scr, r, lane); continue; } r -= c5;
        if (r < c6) { tr_item(a.in[10] + (size_t)layer * 128 * 1024, 1024, 1024, LORA + 2048 * 128, 128, 0, 0, scr, r, lane); continue; } r -= c6;
        if (r < c7) { tr_item(a.in[23] + (size_t)layer * D * D, D, D, (bf16*)(db + DB_PA), D, 0, 0, scr, r, lane); continue; } r -= c7;
        if (r < c7) { tr_item(a.in[24] + (size_t)layer * D * D, D, D, (bf16*)(db + DB_PBT), D, 0, 0, scr, r, lane); continue; } r -= c7;
        if (r < c7) { tr_item(a.in[25] + (size_t)layer * D * D, D, D, (bf16*)(db + DB_POUT), D, 0, 0, scr, r, lane); continue; } r -= c7;
        if (r < c10) { tr_item(a.in[26] + (size_t)layer * D * 2048, 2048, 2048, (bf16*)(db + DB_WQG), D, 0, 0, scr, r, lane); continue; } r -= c10;
        if (r < c7) { tr_item(a.in[31] + (size_t)layer * D * D, D, D, (bf16*)(db + DB_WQG), D, 0, 2048, scr, r, lane); continue; } r -= c7;
        tr_item(a.in[30] + (size_t)layer * 256 * D, D, D, (bf16*)(db + DB_PLEW), 256, 0, 0, scr, r, lane);
    }
    if (layer > 0 && (part & 1)) {
        const float* w2 = a.in[17] + (size_t)(layer - 1) * 32 * 1024;
        for (int it = gw; it < 512; it += NGW) { const int e = it * 64 + lane, n = e >> 5, k = e & 31; MVT[n * 128 + k] = (bf16)(cvt_pk_bf16(w2[k * 1024 + n], 0.f) & 0xffffu); }
    }
    {
        const float* keys = a.in[27] + (size_t)layer * 262144; const float* ut = a.in[28] + (size_t)layer * 16777216; const float* vt = a.in[29] + (size_t)layer * 16777216;
        const float* pin = a.in[1] + (size_t)layer * T * 256; const float* gws = a.in[21] + (size_t)layer * 131072;
        const int n1 = (part & 1) ? 512 : 0, n2 = (part & 2) ? 32768 : 0, n4 = (part & 1) ? 16384 : 0, n5 = (part & 1) ? 256 : 0, ntot = n1 + 2 * n2 + n4 + n5;
        for (int it = gw; it < ntot; it += NGW) {
            int r = it;
            if (r < n2) { cvt8_chunk(ut, (unsigned char*)(db + DB_U), r, lane, 256.f); continue; } r -= n2;
            if (r < n2) { cvt8_chunk(vt, (unsigned char*)(db + DB_V), r, lane, 64.f); continue; } r -= n2;
            if (r < n4) { cvt_chunk(pin, (bf16*)(db + DB_PB), r, lane); continue; } r -= n4;
            if (r < n1) { cvt_chunk(keys, (bf16*)(db + DB_KEYS), r, lane); continue; } r -= n1;
            {
                const int e0 = r * 512 + lane * 8, tq = (e0 >> 7) & 127, p0 = e0 & 127;
                const f32x4* s = (const f32x4*)(gws + e0); f32x4 x0 = s[0], x1 = s[1];
#pragma unroll
                for (int j = 0; j < 4; ++j) { if (p0 + j > tq) x0[j] = 0.f; if (p0 + 4 + j > tq) x1[j] = 0.f; }
                *(v4u*)((bf16*)(db + DB_GMW) + e0) = pk8(x0, x1);
            }
        }
    }
    if (layer == 0 && (part & 1)) {
        int m = gw;
        for (; m + NGW < T; m += 2 * NGW) norm_row_nx2(a.in[0] + (size_t)m * D, a.in[0] + (size_t)(m + NGW) * D, F.h + (size_t)m * D, F.h + (size_t)(m + NGW) * D, a.in[2], (bf16*)(ws + WS_NX), m, m + NGW, lane);
        if (m < T) norm_row_nx(a.in[0] + (size_t)m * D, F.h + (size_t)m * D, a.in[2], (bf16*)(ws + WS_NX), m, lane);
    }
}

constexpr int SC = 32, NPR = SC / 2;
constexpr int SC_VEC = SC * 64;
constexpr int SC_WW = 0, SC_VQ = NPR * 64, SC_BK = SC_VQ + NPR * 256, SC_XA = SC_BK + NPR * 128, SC_C = SC_XA + NPR * 128, SC_VP = SC_C + NPR * 20, SC_BON = SC_VP + SC * 64, SC_BUF = SC_BON + SC * 8;
static_assert(SC_BUF % 4 == 0 && SC_C % 4 == 0 && (2 * SC_BUF + 2 * SC_VEC) * 4 + 64 <= 131072, "scan LDS map");
struct ScanOps { f32x4 w[4], vq, c[4]; v4u bk[2]; bf16x8 x[2]; };
__device__ __forceinline__ void scan_load2(ScanOps& o, const LAS float* buf, const LAS float* vqp, const LAS unsigned char* bkp, int bkstep, int p, int lane) {
    const int q = lane >> 4;
    const LAS float* wp = buf + SC_WW + p * 64 + q * 4;
#pragma unroll
    for (int i = 0; i < 4; ++i) o.w[i] = *(const LAS f32x4*)(wp + 16 * i);
    o.vq = *(const LAS f32x4*)(vqp + p * 256);
    o.bk[0] = *(const LAS v4u*)(bkp + p * bkstep); o.bk[1] = *(const LAS v4u*)(bkp + p * bkstep + 16);
    const LAS unsigned char* xp = (const LAS unsigned char*)(buf + SC_XA) + p * 512 + (lane & 3) * 128 + q * 16;
    o.x[0] = *(const LAS bf16x8*)xp; o.x[1] = *(const LAS bf16x8*)(xp + 64);
#pragma unroll
    for (int i = 0; i < 4; ++i) o.c[i] = *(const LAS f32x4*)(buf + SC_C + p * 20 + 4 * i);
}
__device__ __forceinline__ const char* uni_ptr(const char* p) { const unsigned long long a = (unsigned long long)p;
    const unsigned lo = (unsigned)__builtin_amdgcn_readfirstlane((int)(unsigned)a), hi = (unsigned)__builtin_amdgcn_readfirstlane((int)(unsigned)(a >> 32));
    return (const char*)(((unsigned long long)hi << 32) | lo); }
__device__ __forceinline__ float smul(float a, float b) { float r; asm("v_mul_f32 %0, %1, %2" : "=v"(r) : "v"(a), "v"(b)); return r; }
__device__ __forceinline__ void scan_pair(const ScanOps& o, f32x4 (&St)[4], float& sa0, float& sa1, v4u (&am)[4], v4u& bm, LAS float* ypt, int ystep, unsigned m16) {
    v4u s0, s1;
    s0.x = cvt_pk_bf16(St[0].x, St[0].y); s0.y = cvt_pk_bf16(St[0].z, St[0].w); s0.z = cvt_pk_bf16(St[1].x, St[1].y); s0.w = cvt_pk_bf16(St[1].z, St[1].w);
    s1.x = cvt_pk_bf16(St[2].x, St[2].y); s1.y = cvt_pk_bf16(St[2].z, St[2].w); s1.z = cvt_pk_bf16(St[3].x, St[3].y); s1.w = cvt_pk_bf16(St[3].z, St[3].w);
    f32x4 dv = (f32x4){0.f, 0.f, 0.f, 0.f};
    dv = __builtin_amdgcn_mfma_f32_16x16x32_bf16(o.x[0], __builtin_bit_cast(bf16x8, s0), dv, 0, 0, 0);
    dv = __builtin_amdgcn_mfma_f32_16x16x32_bf16(o.x[1], __builtin_bit_cast(bf16x8, s1), dv, 0, 0, 0);
    const float v0 = o.vq.x, v1 = o.vq.y, v2 = o.vq.z;
    typedef short s16x4 __attribute__((ext_vector_type(4)));
    const v2u bm2 = (v2u){cvt_pk_bf16(sa0, v0) & m16, cvt_pk_bf16(sa1, v1) & m16};
#pragma unroll
    for (int i = 0; i < 4; ++i) { const v2u a2 = (v2u){o.bk[i >> 1][(i & 1) * 2], o.bk[i >> 1][(i & 1) * 2 + 1]};
        St[i] = __builtin_amdgcn_mfma_f32_16x16x16bf16_1k(__builtin_bit_cast(s16x4, a2), __builtin_bit_cast(s16x4, bm2),
                                                        (f32x4){smul(St[i].x, o.w[i].x), smul(St[i].y, o.w[i].y), smul(St[i].z, o.w[i].z), smul(St[i].w, o.w[i].w)}, 0, 0, 0); }
    ypt[0]     = dv.z + sa0 * o.c[2].z + v0 * o.c[2].w;
    ypt[ystep] = dv.w + sa0 * o.c[3].x + v0 * o.c[3].y + sa1 * o.c[3].z + v1 * o.c[3].w;
    const float n0 = dv.x + sa0 * o.c[0].x + v0 * o.c[0].y + sa1 * o.c[0].z + v1 * o.c[0].w;
    const float n1 = dv.y + sa0 * o.c[1].x + v0 * o.c[1].y + sa1 * o.c[1].z + v1 * o.c[1].w + n0 * o.c[2].x + v2 * o.c[2].y;
    sa0 = n0; sa1 = n1;
}
__device__ __forceinline__ void scan_unit(Frame& F, const Args& a, int layer, int unit) {
    phase_ids(F);
    const int b = unit >> 4, hh = unit & 15, tid = F.tid, lane = F.lane, wave = F.wave;
    LAS float* bufs = (LAS float*)F.lds;
    LAS float* sY = bufs + 2 * SC_BUF;
    const bf16* ZR = (const bf16*)(F.ws + WS_ZRKV); const bf16* EW = (const bf16*)(F.ws + WS_EW); const bf16* AR = (const bf16*)(F.ws + WS_AR); const bf16* GT = (const bf16*)(F.ws + WS_G);
    bf16* YA = (bf16*)(F.ws + WS_G);
    constexpr int NCH = SEQ / SC;
    if (wave < 4) {
        f32x4 St[4]; v4u am[4], bm = (v4u){0u, 0u, 0u, 0u};
#pragma unroll
        for (int i = 0; i < 4; ++i) { St[i] = (f32x4){0.f, 0.f, 0.f, 0.f}; am[i] = (v4u){0u, 0u, 0u, 0u}; }
        float sa0 = 0.f, sa1 = 0.f;
        const unsigned m16 = lane < 16 ? 0xffffffffu : 0u;
        LAS unsigned char* zblk = (LAS unsigned char*)(sY + 2 * SC_VEC);
        if (tid < 8) ((LAS unsigned*)zblk)[tid] = 0u;
        const int bkstep = lane < 16 ? 512 : 0;
        for (int it = 0; it < NCH + 2; ++it) {
            if (it >= 1 && it <= NCH) {
                const LAS float* bufc = bufs + ((it - 1) & 1) * SC_BUF;
                const LAS float* vqp = bufc + SC_VQ + 4 * (wave * 16 + (lane & 15));
                const LAS unsigned char* bkp = lane < 16 ? (const LAS unsigned char*)(bufc + SC_BK) + lane * 32 : (const LAS unsigned char*)zblk;
                LAS float* yb = lane < 16 ? sY + ((it - 1) & 1) * SC_VEC + wave * 16 + lane : (LAS float*)(zblk + 32);
                const int ystep = lane < 16 ? 64 : 0;
                if (it == 1) { sa0 = 0.f; sa1 = vqp[0] * bufc[SC_C + 16]; }
                ScanOps o0, o1;
                scan_load2(o0, bufc, vqp, bkp, bkstep, 0, lane);
#pragma unroll 1
                for (int p = 0; p < NPR; p += 2) {
                    scan_load2(o1, bufc, vqp, bkp, bkstep, p + 1, lane);
                    scan_pair(o0, St, sa0, sa1, am, bm, yb + (2 * p) * ystep, ystep, m16);
                    if (p + 2 < NPR) scan_load2(o0, bufc, vqp, bkp, bkstep, p + 2, lane);
                    scan_pair(o1, St, sa0, sa1, am, bm, yb + (2 * p + 2) * ystep, ystep, m16);
                }
            }
            __syncthreads();
        }
    } else {
        const int ht = tid - 256, tl = ht >> 3, c8 = ht & 7, ch = hh * 64 + c8 * 8;
        const int pr = ht >> 4, c4 = ht & 15, chp = hh * 64 + c4 * 4;
        const size_t po = (size_t)layer * 1024 + ch, pop = (size_t)layer * 1024 + chp;
        struct HelpIn { v2u r0, k0, v0, e0, a0, r1, k1, v1, e1, a1, k2, v2, e2, a2, k3; v4u gt; };
        HelpIn cur, nxt;
#define HELP_ROW(H, F_, RR, OFF, ARR, PITCH) (H).F_ = *(const v2u*)((ARR) + ((size_t)b * SEQ + (RR)) * (PITCH) + (OFF) + chp)
#define HELP_LOAD(H, PC, GC) do { \
            if ((PC) < NCH) { const int _t = (PC) * SC + 2 * pr; \
                HELP_ROW(H, r0, _t, 0, ZR, 3072); HELP_ROW(H, k0, _t, 1024, ZR, 3072); HELP_ROW(H, v0, _t, 2048, ZR, 3072); HELP_ROW(H, e0, _t, 0, EW, 1024); HELP_ROW(H, a0, _t, 0, AR, 1024); \
                HELP_ROW(H, r1, _t + 1, 0, ZR, 3072); HELP_ROW(H, k1, _t + 1, 1024, ZR, 3072); HELP_ROW(H, v1, _t + 1, 2048, ZR, 3072); HELP_ROW(H, e1, _t + 1, 0, EW, 1024); HELP_ROW(H, a1, _t + 1, 0, AR, 1024); \
                HELP_ROW(H, k2, _t + 2, 1024, ZR, 3072); HELP_ROW(H, v2, _t + 2, 2048, ZR, 3072); HELP_ROW(H, e2, _t + 2, 0, EW, 1024); HELP_ROW(H, a2, _t + 2, 0, AR, 1024); \
                HELP_ROW(H, k3, _t + 3, 1024, ZR, 3072); } \
            if ((GC) >= 0 && (GC) < NCH) { const size_t _row = (size_t)b * SEQ + (size_t)(GC) * SC + tl; (H).gt = *(const v4u*)(GT + _row * 1024 + ch); } } while (0)
#define UNP4(W) ((f32x4){bflo((W).x), bfhi((W).x), bflo((W).y), bfhi((W).y)})
#define EXP4(E) ((f32x4){__builtin_amdgcn_exp2f(-1.44269504f * (E).x), __builtin_amdgcn_exp2f(-1.44269504f * (E).y), __builtin_amdgcn_exp2f(-1.44269504f * (E).z), __builtin_amdgcn_exp2f(-1.44269504f * (E).w)})
#define DOT4(A, B) (((A).x * (B).x + (A).y * (B).y) + ((A).z * (B).z + (A).w * (B).w))
#define SUM16(X) sum16_ns(X)
#ifdef PROBE_SCAN
        unsigned long long ph_act = 0ull;
#endif
        HELP_LOAD(cur, 0, -2);
        for (int it = 0; it < NCH + 2; ++it) {
#ifdef PROBE_SCAN
            const unsigned long long ph0 = __builtin_amdgcn_s_memtime();
#endif
            HELP_LOAD(nxt, it + 1, it - 1);
            if (it >= 2) {
                const LAS float* buf = bufs + (it & 1) * SC_BUF; const LAS float* yb = sY + (it & 1) * SC_VEC;
                const size_t row = (size_t)b * SEQ + (size_t)(it - 2) * SC + tl; const int o = tl * 64 + c8 * 8;
                f32x4 y_[2], v_[2], g_[2];
#pragma unroll
                for (int i = 0; i < 2; ++i) { y_[i] = *(const LAS f32x4*)(yb + o + 4 * i); v_[i] = *(const LAS f32x4*)(buf + SC_VP + o + 4 * i); }
                const float bon = buf[SC_BON + tl * 8 + c8];
                unpk8(cur.gt, g_[0], g_[1]);
                const float s1 = ((y_[0].x + y_[0].y) + (y_[0].z + y_[0].w)) + ((y_[1].x + y_[1].y) + (y_[1].z + y_[1].w));
                const float mu = sum8(s1) * (1.f / 64.f);
                float s2 = 0.f;
#pragma unroll
                for (int i = 0; i < 2; ++i) { y_[i] = y_[i] - mu; const f32x4 q = y_[i] * y_[i]; s2 += (q.x + q.y) + (q.z + q.w); }
                const float rstd = __builtin_amdgcn_rsqf(sum8(s2) * (1.f / 64.f) + 64e-5f);
                f32x4 o_[2];
#pragma unroll
                for (int i = 0; i < 2; ++i) o_[i] = (y_[i] * rstd * *(const f32x4*)(a.in[14] + po + 4 * i) + *(const f32x4*)(a.in[15] + po + 4 * i) + bon * v_[i]) * g_[i];
                *(v4u*)(YA + row * 1024 + ch) = pk8(o_[0], o_[1]);
            }
            if (it < NCH) {
                LAS float* buf = bufs + (it & 1) * SC_BUF;
                const f32x4 pkk_ = *(const f32x4*)(a.in[11] + pop), pka_ = *(const f32x4*)(a.in[12] + pop), prk_ = *(const f32x4*)(a.in[13] + pop);
                const f32x4 zk0 = UNP4(cur.k0), zk1 = UNP4(cur.k1), zk2 = UNP4(cur.k2), zk3 = UNP4(cur.k3);
                f32x4 kn0 = zk0 * pkk_, kn1 = zk1 * pkk_, kn2 = zk2 * pkk_, kn3 = zk3 * pkk_;
                kn0 = kn0 * __builtin_amdgcn_rsqf(fmaxf(SUM16(DOT4(kn0, kn0)), 1e-24f)); kn1 = kn1 * __builtin_amdgcn_rsqf(fmaxf(SUM16(DOT4(kn1, kn1)), 1e-24f));
                kn2 = kn2 * __builtin_amdgcn_rsqf(fmaxf(SUM16(DOT4(kn2, kn2)), 1e-24f)); kn3 = kn3 * __builtin_amdgcn_rsqf(fmaxf(SUM16(DOT4(kn3, kn3)), 1e-24f));
                const f32x4 r0 = UNP4(cur.r0), r1 = UNP4(cur.r1), v0 = UNP4(cur.v0), v1 = UNP4(cur.v1), v2 = UNP4(cur.v2);
                const f32x4 ar0 = UNP4(cur.a0), ar1 = UNP4(cur.a1), ar2 = UNP4(cur.a2);
                const f32x4 e0 = UNP4(cur.e0), e1 = UNP4(cur.e1), e2 = UNP4(cur.e2);
                const f32x4 w0 = EXP4(e0), w1 = EXP4(e1), w2 = EXP4(e2);
                const f32x4 a1v = -kn1, a2v = -kn2, a3v = -kn3;
                const f32x4 b0 = kn0 * ar0, b1 = kn1 * ar1, b2 = kn2 * ar2;
                const f32x4 kp0 = zk0 * (1.f + (ar0 - 1.f) * pka_), kp1 = zk1 * (1.f + (ar1 - 1.f) * pka_), kp2 = zk2 * (1.f + (ar2 - 1.f) * pka_);
                const f32x4 W2 = w0 * w1, Bt = b0 * w1, Kt = kp0 * w1, x0v = a2v, x1v = w2 * a3v;
                const f32x4 X0 = W2 * x0v, X1 = W2 * x1v, X2 = w0 * r0, X3 = W2 * r1;
                *(LAS f32x4*)(buf + SC_WW + pr * 64 + c4 * 4) = W2;
                *(LAS f32x4*)(buf + SC_VP + (2 * pr) * 64 + c4 * 4) = v0; *(LAS f32x4*)(buf + SC_VP + (2 * pr + 1) * 64 + c4 * 4) = v1;
                { LAS f32x4* vq = (LAS f32x4*)(buf + SC_VQ + pr * 256 + c4 * 16);
                  vq[0] = (f32x4){v0.x, v1.x, v2.x, 0.f}; vq[1] = (f32x4){v0.y, v1.y, v2.y, 0.f}; vq[2] = (f32x4){v0.z, v1.z, v2.z, 0.f}; vq[3] = (f32x4){v0.w, v1.w, v2.w, 0.f}; }
                { LAS v2u* bkp = (LAS v2u*)(buf + SC_BK + pr * 128) + (((c4 & 3) * 4) * 4 + (c4 >> 2));
                  bkp[0] = (v2u){cvt_pk_bf16(Bt.x, Kt.x), cvt_pk_bf16(b1.x, kp1.x)}; bkp[4] = (v2u){cvt_pk_bf16(Bt.y, Kt.y), cvt_pk_bf16(b1.y, kp1.y)};
                  bkp[8] = (v2u){cvt_pk_bf16(Bt.z, Kt.z), cvt_pk_bf16(b1.z, kp1.z)}; bkp[12] = (v2u){cvt_pk_bf16(Bt.w, Kt.w), cvt_pk_bf16(b1.w, kp1.w)}; }
                { LAS unsigned char* xp = (LAS unsigned char*)(buf + SC_XA) + pr * 512 + (c4 >> 3) * 64 + (c4 & 3) * 16 + ((c4 >> 2) & 1) * 8;
                  *(LAS v2u*)xp = (v2u){cvt_pk_bf16(X0.x, X0.y), cvt_pk_bf16(X0.z, X0.w)}; *(LAS v2u*)(xp + 128) = (v2u){cvt_pk_bf16(X1.x, X1.y), cvt_pk_bf16(X1.z, X1.w)};
                  *(LAS v2u*)(xp + 256) = (v2u){cvt_pk_bf16(X2.x, X2.y), cvt_pk_bf16(X2.z, X2.w)}; *(LAS v2u*)(xp + 384) = (v2u){cvt_pk_bf16(X3.x, X3.y), cvt_pk_bf16(X3.z, X3.w)}; }
                const f32x4 ca = (f32x4){SUM16(DOT4(Bt, x0v)), SUM16(DOT4(Kt, x0v)), SUM16(DOT4(b1, x0v)), SUM16(DOT4(kp1, x0v))};
                const f32x4 cb = (f32x4){SUM16(DOT4(Bt, x1v)), SUM16(DOT4(Kt, x1v)), SUM16(DOT4(b1, x1v)), SUM16(DOT4(kp1, x1v))};
                const f32x4 cc = (f32x4){SUM16(DOT4(b2, a3v)), SUM16(DOT4(kp2, a3v)), SUM16(DOT4(b0, r0)), SUM16(DOT4(kp0, r0))};
                const f32x4 cd = (f32x4){SUM16(DOT4(Bt, r1)), SUM16(DOT4(Kt, r1)), SUM16(DOT4(b1, r1)), SUM16(DOT4(kp1, r1))};
                const float ci = SUM16(DOT4(kp0, a1v));
                const f32x4 z0 = r0 * kp0 * prk_, z1 = r1 * kp1 * prk_;
                const float bon0 = SUM16((z0.x + z0.y) + (z0.z + z0.w)), bon1 = SUM16((z1.x + z1.y) + (z1.z + z1.w));
                if (c4 == 0) { LAS f32x4* cp = (LAS f32x4*)(buf + SC_C + pr * 20); cp[0] = ca; cp[1] = cb; cp[2] = cc; cp[3] = cd; cp[4] = (f32x4){ci, 0.f, 0.f, 0.f}; }
                buf[SC_BON + (2 * pr) * 8 + (c4 >> 1)] = bon0; buf[SC_BON + (2 * pr + 1) * 8 + (c4 >> 1)] = bon1;
            }
            cur = nxt;
#ifdef PROBE_SCAN
            asm volatile("s_waitcnt vmcnt(0) lgkmcnt(0)" ::: "memory"); ph_act += __builtin_amdgcn_s_memtime() - ph0;
#endif
            __syncthreads();
        }
#ifdef PROBE_SCAN
        if (unit == 0 && layer == DEPTH - 1 && tid == 256) ((float*)(F.ws + WS_CTL))[2048 + 2] = rintf((float)ph_act / (float)(NCH + 2) * (1.f / 2000.f));
#endif
#undef HELP_LOAD
#undef HELP_ROW
#undef UNP4
#undef EXP4
#undef DOT4
#undef SUM16
    }
}

constexpr int TP = 136;
__device__ __forceinline__ void mma_128(const LAS bf16* sA, const LAS bf16* sBt, int wave, int lane, f32x4 (&acc)[4][2]) {
    const int wm = wave >> 2, wn = wave & 3, fr = lane & 15, fq = lane >> 4;
#pragma unroll
    for (int kk = 0; kk < 4; ++kk) {
        bf16x8 af[4], bf_[2];
#pragma unroll
        for (int mt = 0; mt < 4; ++mt) af[mt] = *(const LAS bf16x8*)(sA + (64 * wm + 16 * mt + fr) * TP + 32 * kk + 8 * fq);
#pragma unroll
        for (int nt = 0; nt < 2; ++nt) bf_[nt] = *(const LAS bf16x8*)(sBt + (32 * wn + 16 * nt + fr) * TP + 32 * kk + 8 * fq);
#pragma unroll
        for (int mt = 0; mt < 4; ++mt)
#pragma unroll
            for (int nt = 0; nt < 2; ++nt) acc[mt][nt] = __builtin_amdgcn_mfma_f32_16x16x32_bf16(bf_[nt], af[mt], acc[mt][nt], 0, 0, 0);
    }
}
__device__ __forceinline__ void gmlp_unit(Frame& F, const Args& a, int layer, int unit) {
    phase_ids(F);
    const size_t t0 = (size_t)unit * 128; const int tid = F.tid, lane = F.lane, wave = F.wave;
    LAS float* st = (LAS float*)F.lds; LAS bf16* sA = (LAS bf16*)(F.lds + 1024); LAS bf16* sB = (LAS bf16*)(F.lds + 1024 + 128 * TP * 2);
    bf16* GUV = (bf16*)(F.ws + WS_GUV); const bf16* GMW = (const bf16*)(F.ws + WS_DB + (size_t)(layer & 1) * DB_SET + DB_GMW);
    const float* lng = a.in[19] + (size_t)layer * 1024; const float* lnb = a.in[20] + (size_t)layer * 1024; const float* bsp = a.in[22] + (size_t)layer * 1024;
    for (int r = 0; r < 16; ++r) { const int tok = wave * 16 + r; const bf16* rowp = GUV + (t0 + tok) * 2048 + 1024;
        f32x4 x0, x1, x2, x3; unpk8(*(const v4u*)(rowp + lane * 8), x0, x1); unpk8(*(const v4u*)(rowp + 512 + lane * 8), x2, x3);
        const f32x4 sv = (x0 + x1) + (x2 + x3), qv = (x0 * x0 + x1 * x1) + (x2 * x2 + x3 * x3);
        const float s = wave_sum((sv.x + sv.y) + (sv.z + sv.w)), q = wave_sum((qv.x + qv.y) + (qv.z + qv.w));
        const float mean = s * (1.f / 1024.f), var = fmaxf(q * (1.f / 1024.f) - mean * mean, 0.f);
        if (lane == 0) { st[tok * 2] = mean; st[tok * 2 + 1] = 1.f / sqrtf(var + 1e-5f); } }
    __syncthreads();
    for (int g = 0; g < 8; ++g) {
#pragma unroll
        for (int i = 0; i < 4; ++i) { const int pc = tid + 512 * i, rr = pc >> 4, c16 = pc & 15;
            *(LAS v4u*)(sA + rr * TP + c16 * 8) = *(const v4u*)(GMW + (size_t)g * 16384 + rr * 128 + c16 * 8); }
        { const int p = tid & 127, oc0 = tid >> 7; const float mean = st[p * 2], rstd = st[p * 2 + 1];
#pragma unroll
          for (int i = 0; i < 4; ++i) { const int oc = oc0 + 4 * i, c0 = g * 128 + oc * 8;
              f32x4 x0, x1; unpk8(*(const v4u*)(GUV + (t0 + p) * 2048 + 1024 + c0), x0, x1);
              const f32x4 g0 = *(const f32x4*)(lng + c0), g1 = *(const f32x4*)(lng + c0 + 4), b0 = *(const f32x4*)(lnb + c0), b1 = *(const f32x4*)(lnb + c0 + 4);
              x0 = (x0 - mean) * rstd * g0 + b0; x1 = (x1 - mean) * rstd * g1 + b1;
              const v4u w = pk8(x0, x1);
              LAS bf16* d = sB + (oc * 8) * TP + p;
              d[0 * TP] = (bf16)(w.x & 0xffffu); d[1 * TP] = (bf16)(w.x >> 16); d[2 * TP] = (bf16)(w.y & 0xffffu); d[3 * TP] = (bf16)(w.y >> 16);
              d[4 * TP] = (bf16)(w.z & 0xffffu); d[5 * TP] = (bf16)(w.z >> 16); d[6 * TP] = (bf16)(w.w & 0xffffu); d[7 * TP] = (bf16)(w.w >> 16); } }
        __syncthreads();
        f32x4 acc[4][2];
#pragma unroll
        for (int mt = 0; mt < 4; ++mt)
#pragma unroll
            for (int nt = 0; nt < 2; ++nt) acc[mt][nt] = (f32x4){0.f, 0.f, 0.f, 0.f};
        mma_128(sA, sB, wave, lane, acc);
        { const int wm = wave >> 2, wn = wave & 3, fr = lane & 15, fq = lane >> 4;
#pragma unroll
          for (int mt = 0; mt < 4; ++mt) { const int tt = 64 * wm + 16 * mt + fr; const float bsv = bsp[g * 128 + tt];
#pragma unroll
              for (int nt = 0; nt < 2; ++nt) { const int c = g * 128 + 32 * wn + 16 * nt + 4 * fq;
                  const v2u uw = *(const v2u*)(GUV + (t0 + tt) * 2048 + c);
                  const f32x4 u4 = (f32x4){bflo(uw.x), bfhi(uw.x), bflo(uw.y), bfhi(uw.y)};
                  const f32x4 yb = u4 * (acc[mt][nt] + bsv);
                  v2u ow; ow.x = cvt_pk_bf16(yb.x, yb.y); ow.y = cvt_pk_bf16(yb.z, yb.w);
                  *(v2u*)(GUV + (t0 + tt) * 2048 + c) = ow; } } }
        __syncthreads();
    }
}

__device__ __forceinline__ unsigned fkey(float f) { const unsigned u = __builtin_bit_cast(unsigned, f); return (u & 0x80000000u) ? ~u : (u | 0x80000000u); }
__device__ __forceinline__ float kval(unsigned k, unsigned mask) { const unsigned u = k & mask; return __builtin_bit_cast(float, (u & 0x80000000u) ? (u ^ 0x80000000u) : ~u); }
__device__ __forceinline__ float swap32_add(float a, float b) { const auto r = __builtin_amdgcn_permlane32_swap(__builtin_bit_cast(unsigned, a), __builtin_bit_cast(unsigned, b), false, false);
    return __builtin_bit_cast(float, (unsigned)r[0]) + __builtin_bit_cast(float, (unsigned)r[1]); }
__device__ __forceinline__ float swap16_add(float a, float b) { const auto r = __builtin_amdgcn_permlane16_swap(__builtin_bit_cast(unsigned, a), __builtin_bit_cast(unsigned, b), false, false);
    return __builtin_bit_cast(float, (unsigned)r[0]) + __builtin_bit_cast(float, (unsigned)r[1]); }
__device__ __forceinline__ float row_sum16(float x) {
    x += __builtin_bit_cast(float, __builtin_amdgcn_update_dpp(0, __builtin_bit_cast(int, x), 0x128, 0xf, 0xf, false));
    x += __builtin_bit_cast(float, __builtin_amdgcn_update_dpp(0, __builtin_bit_cast(int, x), 0x124, 0xf, 0xf, false));
    x += __builtin_bit_cast(float, __builtin_amdgcn_update_dpp(0, __builtin_bit_cast(int, x), 0x122, 0xf, 0xf, false));
    x += __builtin_bit_cast(float, __builtin_amdgcn_update_dpp(0, __builtin_bit_cast(int, x), 0x121, 0xf, 0xf, false));
    return x; }
#define CE_DESC(a, b) do { const unsigned _h = max((a), (b)), _l = min((a), (b)); (a) = _h; (b) = _l; } while (0)
template <int OFF> __device__ __forceinline__ void bitonic_merge16(unsigned (&x)[32]) {
#pragma unroll
    for (int j = 8; j >= 1; j >>= 1)
#pragma unroll
        for (int i = 0; i < 16; ++i) { const int l = i ^ j; if (l > i) CE_DESC(x[OFF + i], x[OFF + l]); }
}
template <int OFF> __device__ __forceinline__ void bitonic_sort16(unsigned (&x)[32]) {
#pragma unroll
    for (int k = 2; k <= 16; k <<= 1)
#pragma unroll
        for (int j = k >> 1; j >= 1; j >>= 1)
#pragma unroll
            for (int i = 0; i < 16; ++i) { const int l = i ^ j; if (l > i) { if ((i & k) == 0 || k == 16) CE_DESC(x[OFF + i], x[OFF + l]); else CE_DESC(x[OFF + l], x[OFF + i]); } }
}
#ifndef REP_K
#define REP_K 1
#endif
#define TOP_INSERT(top, x) do { unsigned _x = (x); _Pragma("unroll") for (int _j = 0; _j < 16; ++_j) { const unsigned _h = max((top)[_j], _x); _x = min((top)[_j], _x); (top)[_j] = _h; } } while (0)
__device__ __forceinline__ void peer_token_end(Frame& F, const Args& a, int layer, bool last, bool final_half, size_t tok, int lane, const f32x2 (&out)[8], const f32x4 (&hpre)[4]) {
    float* hp = F.h + tok * 1024 + 16 * lane;
    f32x4 hv[4]; float s = 0.f;
#pragma unroll
    for (int i = 0; i < 4; ++i) { hv[i] = hpre[i] + (f32x4){out[2 * i].x, out[2 * i].y, out[2 * i + 1].x, out[2 * i + 1].y};
        s += (hv[i].x * hv[i].x + hv[i].y * hv[i].y) + (hv[i].z * hv[i].z + hv[i].w * hv[i].w); }
    if (!final_half) {
#pragma unroll
        for (int i = 0; i < 4; ++i) *(f32x4*)(hp + 4 * i) = hv[i];
        return; }
    const float rstd = 1.f / sqrtf(wave_sum(s) * (1.f / D) + 1e-6f);
    const float* g = (last ? a.in[4] : a.in[2] + (size_t)(layer + 1) * 1024) + 16 * lane;
    f32x4 o[4];
#pragma unroll
    for (int i = 0; i < 4; ++i) o[i] = hv[i] * rstd * *(const f32x4*)(g + 4 * i);
    if (last) {
#ifdef PROBE_SCAN
        { const float pv = ((const float*)(F.ws + WS_CTL))[2048 + PROBE_SCAN - 1];
#pragma unroll
          for (int i = 0; i < 4; ++i) o[i] = o[i] + pv; }
#endif
#pragma unroll
        for (int i = 0; i < 4; ++i) *(f32x4*)(hp + 4 * i) = o[i];
    } else {
#pragma unroll
        for (int i = 0; i < 4; ++i) *(f32x4*)(hp + 4 * i) = hv[i];
        bf16* NX = (bf16*)(F.ws + WS_NX); const v4u w0 = pk8(o[0], o[1]), w1 = pk8(o[2], o[3]); const int tt = (int)(tok & (SEQ - 1));
        *(v4u*)(NX + tok * 2048 + 16 * lane) = w0; *(v4u*)(NX + tok * 2048 + 16 * lane + 8) = w1;
        if (tt != SEQ - 1) { *(v4u*)(NX + (tok + 1) * 2048 + 1024 + 16 * lane) = w0; *(v4u*)(NX + (tok + 1) * 2048 + 1024 + 16 * lane + 8) = w1; }
        if (tt == 0) { *(v4u*)(NX + tok * 2048 + 1024 + 16 * lane) = (v4u){0u, 0u, 0u, 0u}; *(v4u*)(NX + tok * 2048 + 1024 + 16 * lane + 8) = (v4u){0u, 0u, 0u, 0u}; }
    }
}
__device__ __forceinline__ void peer_unit(Frame& F, const Args& a, int layer, int unit, bool last) {
    phase_ids(F);
    const size_t t0 = (size_t)unit * 128; const int tid = F.tid, lane = F.lane, wave = F.wave, fr = lane & 15, fq = lane >> 4;
    LAS bf16* sKey = (LAS bf16*)F.lds;
    LAS unsigned* sLT = (LAS unsigned*)(F.lds + 2 * 128 * TP * 2) + wave * 512;
    const bf16* Q = (const bf16*)(F.ws + WS_Q); const bf16* KEYS = (const bf16*)(F.ws + WS_DB + (size_t)(layer & 1) * DB_SET + DB_KEYS); v2u* SEL = (v2u*)(F.ws + WS_SEL);
    const size_t trow = t0 + wave * 16 + fr;
    v4u ktn[4]; bf16x8 qfn[4];
#define K_FETCH(J) do { _Pragma("unroll") for (int _i = 0; _i < 4; ++_i) { const int _pc = tid + 512 * _i, _rr = _pc >> 4, _c16 = _pc & 15; ktn[_i] = *(const v4u*)(KEYS + (size_t)(J) * 16384 + _rr * 128 + _c16 * 8); } \
        _Pragma("unroll") for (int _kk = 0; _kk < 4; ++_kk) qfn[_kk] = *(const bf16x8*)(Q + trow * 2048 + (J) * 128 + 32 * _kk + 8 * fq); } while (0)
#define K_STORE(J) do { _Pragma("unroll") for (int _i = 0; _i < 4; ++_i) { const int _pc = tid + 512 * _i, _rr = _pc >> 4, _c16 = _pc & 15; *(LAS v4u*)(sKey + ((J) & 1) * 128 * TP + _rr * TP + _c16 * 8) = ktn[_i]; } } while (0)
    for (int krep = 0; krep < REP_K; ++krep) {
    __syncthreads();
    K_FETCH(0); K_STORE(0);
    bf16x8 qf[4];
#pragma unroll
    for (int kk = 0; kk < 4; ++kk) qf[kk] = qfn[kk];
    __syncthreads();
    for (int hd = 0; hd < 8; ++hd) {
        for (int p = 0; p < 2; ++p) {
            const int jp = hd * 2 + p;
            if (jp + 1 < 16) K_FETCH(jp + 1);
            const LAS bf16* sKc = sKey + (jp & 1) * 128 * TP;
            f32x4 sc[8];
#pragma unroll
            for (int nt = 0; nt < 8; ++nt) sc[nt] = (f32x4){0.f, 0.f, 0.f, 0.f};
#pragma unroll
            for (int kk = 0; kk < 4; ++kk)
#pragma unroll
                for (int nt = 0; nt < 8; ++nt) { const bf16x8 kf = *(const LAS bf16x8*)(sKc + (16 * nt + fr) * TP + 32 * kk + 8 * fq);
                    sc[nt] = __builtin_amdgcn_mfma_f32_16x16x32_bf16(kf, qf[kk], sc[nt], 0, 0, 0); }
            unsigned t[32];
#pragma unroll
            for (int nt = 0; nt < 8; ++nt)
#pragma unroll
                for (int rg = 0; rg < 4; ++rg) t[4 * nt + rg] = (fkey(sc[nt][rg]) & 0xFFFFFF80u) | (unsigned)(16 * nt + 4 * fq + rg);
            bitonic_sort16<0>(t); bitonic_sort16<16>(t);
#pragma unroll
            for (int j = 0; j < 16; ++j) t[j] = max(t[j], t[31 - j]);
            bitonic_merge16<0>(t);
#pragma unroll
            for (int rnd = 0; rnd < 2; ++rnd) {
#pragma unroll
                for (int j = 0; j < 16; ++j) t[16 + j] = rnd ? xor32_u(t[j], lane) : xor16_u(t[j], lane);
#pragma unroll
                for (int j = 0; j < 16; ++j) t[j] = max(t[j], t[31 - j]);
                bitonic_merge16<0>(t); }
#pragma unroll
            for (int j = 0; j < 16; ++j) sLT[fr * 32 + p * 16 + j] = t[j];
            if (jp + 1 < 16) { K_STORE(jp + 1);
#pragma unroll
                for (int kk = 0; kk < 4; ++kk) qf[kk] = qfn[kk]; }
            __syncthreads();
        }
        float v0[16], v1[16];
#pragma unroll
        for (int j = 0; j < 16; ++j) { v0[j] = kval(sLT[fr * 32 + j], 0xFFFFFF80u); v1[j] = kval(sLT[fr * 32 + 16 + j], 0xFFFFFF80u); }
        unsigned best[32];
#define CKEY(i, j) ((fkey(v0[i] + v1[j]) & 0xFFFFFF00u) | (unsigned)((i) * 16 + (j)))
#pragma unroll
        for (int j = 0; j < 16; ++j) best[j] = CKEY(0, j);
#pragma unroll
        for (int i = 1; i < 8; ++i) {
#pragma unroll
            for (int j = 0; j < 16; ++j) if ((i + 1) * (j + 1) <= 16) best[15 - j] = max(best[15 - j], CKEY(i, j));
            bitonic_merge16<0>(best); }
#pragma unroll
        for (int i = 8; i < 16; ++i) best[15 - (i - 8)] = max(best[15 - (i - 8)], CKEY(i, 0));
        bitonic_merge16<0>(best);
#undef CKEY
        float ev[16], esum = 0.f; const float mx = kval(best[0], 0xFFFFFF00u);
#pragma unroll
        for (int k = 0; k < 16; ++k) { ev[k] = __builtin_amdgcn_exp2f((kval(best[k], 0xFFFFFF00u) - mx) * 1.44269504f); esum += ev[k]; }
        const float einv = 1.f / esum;
#pragma unroll
        for (int k = 0; k < 16; ++k) { const unsigned pos = best[k] & 255u;
            const unsigned i0 = sLT[fr * 32 + (pos >> 4)] & 127u, i1 = sLT[fr * 32 + 16 + (pos & 15u)] & 127u;
            if ((k >> 2) == fq) SEL[trow * 128 + hd * 16 + k] = (v2u){i0 * 128u + i1, __builtin_bit_cast(unsigned, ev[k] * einv)}; }
    }
    }
#undef K_FETCH
#undef K_STORE
    asm volatile("s_waitcnt vmcnt(0)" ::: "memory");
    __syncthreads();
    const bf16* N2 = (const bf16*)(F.ws + WS_N2); const unsigned char* U8 = (const unsigned char*)(F.ws + WS_DB + (size_t)(layer & 1) * DB_SET + DB_U); const unsigned char* V8 = (const unsigned char*)(F.ws + WS_DB + (size_t)(layer & 1) * DB_SET + DB_V);
    unsigned* SELW = (unsigned*)SEL;
    LAS float* sCoef = (LAS float*)F.lds + wave * 2048;
    LAS unsigned* sSort = sLT;
    const size_t tokb = t0 + wave * 16;
    unsigned cnts = 0u;
    v4u se_pf = *(const v4u*)(SELW + tokb * 256 + 4 * lane);
    for (int it = 0; it < 16; ++it) {
        const v4u se = se_pf;
        if (it < 15) se_pf = *(const v4u*)(SELW + (tokb + it + 1) * 256 + 4 * lane);
        const unsigned b0 = se.x >> 12, b1 = se.z >> 12;
        unsigned pos0 = 0u, pos1 = 0u, base = 0u, pk = 0u;
#pragma unroll
        for (unsigned k = 0; k < 4; ++k) {
            const unsigned long long m0 = __builtin_amdgcn_ballot_w64(b0 == k), m1 = __builtin_amdgcn_ballot_w64(b1 == k);
            const unsigned below = __builtin_amdgcn_mbcnt_hi((unsigned)(m0 >> 32), __builtin_amdgcn_mbcnt_lo((unsigned)m0, 0u)) + __builtin_amdgcn_mbcnt_hi((unsigned)(m1 >> 32), __builtin_amdgcn_mbcnt_lo((unsigned)m1, 0u));
            if (b0 == k) pos0 = base + below;
            if (b1 == k) pos1 = base + below + (b0 == k ? 1u : 0u);
            base += (unsigned)__builtin_popcountll(m0) + (unsigned)__builtin_popcountll(m1);
            if (k < 3) pk |= base << (8 * k);
        }
#ifdef DBG_NOSORT
        pos0 = 2 * lane; pos1 = 2 * lane + 1;
#endif
        *(LAS v2u*)(sSort + 2 * pos0) = (v2u){se.x, se.y}; *(LAS v2u*)(sSort + 2 * pos1) = (v2u){se.z, se.w};
        asm volatile("" ::: "memory");
        const v2u so0 = *(const LAS v2u*)(sSort + 4 * lane), so1 = *(const LAS v2u*)(sSort + 4 * lane + 2); const v4u so = (v4u){so0.x, so0.y, so1.x, so1.y};
        asm volatile("" ::: "memory");
#ifndef DBG_NOSTORE
        *(v4u*)(SELW + (tokb + it) * 256 + 4 * lane) = so;
#endif
        { const unsigned g0 = so0.y, g1 = so1.y; sCoef[it * 128 + 2 * lane] = __uint_as_float(g0); sCoef[it * 128 + 2 * lane + 1] = __uint_as_float(g1); }
        if (lane == it) cnts = pk;
    }
    asm volatile("s_waitcnt vmcnt(0) lgkmcnt(0)" ::: "memory");
#ifdef DBG_NOBUCKET
    cnts = 0u;
#endif
#define PL_LOAD(RB, TAB, SE, BB) do { _Pragma("unroll") for (int _q = 0; _q < 16; ++_q) { \
        const unsigned _idx = (unsigned)__builtin_amdgcn_readlane((int)((_q & 1) ? (SE).z : (SE).x), (BB) * 8 + (_q >> 1)); \
        (RB)[_q] = *(const v4u*)((TAB) + (size_t)_idx * 1024 + 16 * lane); } } while (0)
#define PL_LOAD_U(RB, SE, BB) do { const int _src = ((BB) * 8 + ((lane & 15) >> 1)) * 4; \
        const unsigned _ix = (unsigned)__builtin_amdgcn_ds_bpermute(_src, (int)(SE).x), _iz = (unsigned)__builtin_amdgcn_ds_bpermute(_src, (int)(SE).z); \
        const unsigned char* _p = U8 + (size_t)((lane & 1) ? _iz : _ix) * 1024 + 32 * (lane >> 4); \
        _Pragma("unroll") for (int _j = 0; _j < 16; ++_j) (RB)[_j] = *(const v4u*)(_p + 128 * (_j >> 1) + 16 * (_j & 1)); } while (0)
#define PL_RANGE(T, P, NP, RLO, RHI, BLO, BHI) const unsigned _pk##T = (unsigned)__builtin_amdgcn_readlane((int)cnts, (T)); \
        const int _sp##T = min((int)((((_pk##T >> 8) & 255u) + 15u) & ~15u), 128);     \
        const int RLO = (P) == 0 ? 0 : _sp##T, RHI = (P) == 0 ? _sp##T : 128; \
        const int BLO = min(RLO >> 4, 7), BHI = max((RHI + 15) >> 4, BLO + 1)
    v4u ra[16], rb[16];
#ifndef DBG_U0
#define DBG_U0 0
#define DBG_V0 0
#endif
    for (int ps = DBG_U0; ps < 2; ++ps) {
        int lt = 0, lb, lbh; { PL_RANGE(lt, ps, 2, r0, r1, b0_, b1_); lb = b0_; lbh = b1_; (void)r0; (void)r1; }
        v4u seL = *(const v4u*)(SELW + tokb * 256 + 4 * lane), seN = *(const v4u*)(SELW + (tokb + 1) * 256 + 4 * lane);
        long xlo = 0, xhi = 0; const bool dsel = ((lane >> 2) & 3) == (lane >> 4); v4u nraw0, nraw1, nnx0 = *(const v4u*)(N2 + tokb * 1024 + 16 * lane), nnx1 = *(const v4u*)(N2 + tokb * 1024 + 16 * lane + 8);
        int ct, cb, crl = 0, crh = 0, cbl = 0;
#define U_ADV() do { ++lb; if (lb >= lbh) { ++lt; if (lt < 16) { PL_RANGE(lt, ps, 2, _r0, _r1, _b0, _b1); lb = _b0; lbh = _b1; (void)_r0; (void)_r1; seL = seN; if (lt + 1 < 16) seN = *(const v4u*)(SELW + (tokb + lt + 1) * 256 + 4 * lane); } } } while (0)
#define U_COMPUTE(RB) do { \
            if (cb == cbl) { nraw0 = nnx0; nraw1 = nnx1; if (ct + 1 < 16) { nnx0 = *(const v4u*)(N2 + (tokb + ct + 1) * 1024 + 16 * lane); nnx1 = *(const v4u*)(N2 + (tokb + ct + 1) * 1024 + 16 * lane + 8); } \
                f32x4 x0, x1, x2, x3; unpk8(nraw0, x0, x1); unpk8(nraw1, x2, x3); x0 = x0 * 16.f; x1 = x1 * 16.f; x2 = x2 * 16.f; x3 = x3 * 16.f; \
                int _w0 = 0, _w1 = 0, _w2 = 0, _w3 = 0; \
                _w0 = __builtin_amdgcn_cvt_pk_fp8_f32(x0.x, x0.y, _w0, false); _w0 = __builtin_amdgcn_cvt_pk_fp8_f32(x0.z, x0.w, _w0, true); \
                _w1 = __builtin_amdgcn_cvt_pk_fp8_f32(x1.x, x1.y, _w1, false); _w1 = __builtin_amdgcn_cvt_pk_fp8_f32(x1.z, x1.w, _w1, true); \
                _w2 = __builtin_amdgcn_cvt_pk_fp8_f32(x2.x, x2.y, _w2, false); _w2 = __builtin_amdgcn_cvt_pk_fp8_f32(x2.z, x2.w, _w2, true); \
                _w3 = __builtin_amdgcn_cvt_pk_fp8_f32(x3.x, x3.y, _w3, false); _w3 = __builtin_amdgcn_cvt_pk_fp8_f32(x3.z, x3.w, _w3, true); \
                xlo = (long)(((unsigned long long)(unsigned)_w1 << 32) | (unsigned)_w0); xhi = (long)(((unsigned long long)(unsigned)_w3 << 32) | (unsigned)_w2); } \
            _Pragma("unroll") for (int _g = 0; _g < 2; ++_g) { float _p[8]; \
                _Pragma("unroll") for (int _q = 0; _q < 8; ++_q) { f32x4 _d = (f32x4){0.f, 0.f, 0.f, 0.f}; \
                    _d = __builtin_amdgcn_mfma_f32_16x16x32_fp8_fp8((long)(((unsigned long long)(RB)[8 * _g + _q].y << 32) | (RB)[8 * _g + _q].x), xlo, _d, 0, 0, 0); \
                    _d = __builtin_amdgcn_mfma_f32_16x16x32_fp8_fp8((long)(((unsigned long long)(RB)[8 * _g + _q].w << 32) | (RB)[8 * _g + _q].z), xhi, _d, 0, 0, 0); \
                    const float _sl = (lane & 2) ? ((lane & 1) ? _d.w : _d.z) : ((lane & 1) ? _d.y : _d.x); \
                    _p[_q] = dsel ? _sl : 0.f; }     \
                const float _s0 = swap32_add(_p[0], _p[4]), _s1 = swap32_add(_p[1], _p[5]), _s2 = swap32_add(_p[2], _p[6]), _s3 = swap32_add(_p[3], _p[7]); \
                float _t0 = row_sum16(swap16_add(_s0, _s2)), _t1 = row_sum16(swap16_add(_s1, _s3)); \
                _t0 = fgelu(_t0 * (1.f / 4096.f)) * (1.f / 64.f); _t1 = fgelu(_t1 * (1.f / 4096.f)) * (1.f / 64.f); \
                if ((lane & 15) == 0) { const int _r = lane >> 4, _e = cb * 16 + 8 * _g + 2 * (_r & 1) + 4 * (_r >> 1); LAS float* _c = sCoef + ct * 128 + _e; \
                    if (_e >= crl && _e < crh) _c[0] *= _t0; if (_e + 1 >= crl && _e + 1 < crh) _c[1] *= _t1; } } } while (0)
#define U_SETC() do { ct = lt; cb = lb; { PL_RANGE(ct, ps, 2, _r0, _r1, _b0, _b1); crl = _r0; crh = _r1; cbl = _b0; (void)_b1; } } while (0)
        PL_LOAD(ra, U8, seL, lb);
        U_SETC(); U_ADV();
        for (;;) {
            if (lt < 16) PL_LOAD(rb, U8, seL, lb);
            U_COMPUTE(ra);
            if (lt >= 16) break;
            U_SETC(); U_ADV();
            if (lt < 16) PL_LOAD(ra, U8, seL, lb);
            U_COMPUTE(rb);
            if (lt >= 16) break;
            U_SETC(); U_ADV();
        }
        asm volatile("s_waitcnt lgkmcnt(0)" ::: "memory");
        __syncthreads();
    }
#undef U_ADV
#undef U_COMPUTE
#undef U_SETC
    for (int ps = DBG_V0; ps < 2; ++ps) {
        int lt = 0, lb, lbh; { PL_RANGE(lt, ps, 2, r0, r1, b0_, b1_); lb = b0_; lbh = b1_; (void)r0; (void)r1; }
        v4u seL = *(const v4u*)(SELW + tokb * 256 + 4 * lane), seN = *(const v4u*)(SELW + (tokb + 1) * 256 + 4 * lane);
        f32x2 out[8]; f32x4 hpre[4], ac4[4];
        const unsigned vmask = ((lane >> 4) == ((lane & 15) >> 2)) ? (0xFFu << (8 * (lane & 3))) : 0u;
        int ct, cb, crl = 0, crh = 0, cbl = 0, cbh = 0;
#define V_ADV() do { ++lb; if (lb >= lbh) { ++lt; if (lt < 16) { PL_RANGE(lt, ps, 2, _r0, _r1, _b0, _b1); lb = _b0; lbh = _b1; (void)_r0; (void)_r1; seL = seN; if (lt + 1 < 16) seN = *(const v4u*)(SELW + (tokb + lt + 1) * 256 + 4 * lane); } } } while (0)
#define V_SETC() do { ct = lt; cb = lb; { PL_RANGE(ct, ps, 2, _r0, _r1, _b0, _b1); crl = _r0; crh = _r1; cbl = _b0; cbh = _b1; } } while (0)
#ifndef REP_LV
#define REP_LV 1
#endif
#define V_COMPUTE(RB) do { \
            if (cb == cbl) { _Pragma("unroll") for (int _i = 0; _i < 4; ++_i) { ac4[_i] = (f32x4){0.f, 0.f, 0.f, 0.f}; hpre[_i] = *(const f32x4*)(F.h + (tokb + ct) * 1024 + 16 * lane + 4 * _i); } }     \
            _Pragma("unroll") for (int _q = 0; _q < 16; ++_q) { const int _e = cb * 16 + _q; \
                float _c = sCoef[ct * 128 + _e]; _c = (_e >= crl && _e < crh) ? _c * 2048.f : 0.f; \
                int _w = __builtin_amdgcn_cvt_pk_fp8_f32(_c, _c, 0, false); _w = __builtin_amdgcn_cvt_pk_fp8_f32(_c, _c, _w, true); const unsigned _x = (unsigned)_w & vmask; \
                const long _ae = (long)(unsigned long long)_x, _ao = (long)((unsigned long long)_x << 32); \
                const long _bl = (long)(((unsigned long long)(RB)[_q].y << 32) | (RB)[_q].x), _bh = (long)(((unsigned long long)(RB)[_q].w << 32) | (RB)[_q].z); \
                ac4[0] = __builtin_amdgcn_mfma_f32_16x16x32_fp8_fp8(_ae, _bl, ac4[0], 0, 0, 0); ac4[1] = __builtin_amdgcn_mfma_f32_16x16x32_fp8_fp8(_ao, _bl, ac4[1], 0, 0, 0); \
                ac4[2] = __builtin_amdgcn_mfma_f32_16x16x32_fp8_fp8(_ae, _bh, ac4[2], 0, 0, 0); ac4[3] = __builtin_amdgcn_mfma_f32_16x16x32_fp8_fp8(_ao, _bh, ac4[3], 0, 0, 0); } \
            if (cb == cbh - 1) { _Pragma("unroll") for (int _i = 0; _i < 4; ++_i) { out[2 * _i] = (f32x2){ac4[_i].x, ac4[_i].y} * (1.f / 2048.f); out[2 * _i + 1] = (f32x2){ac4[_i].z, ac4[_i].w} * (1.f / 2048.f); } \
                peer_token_end(F, a, layer, last, ps == 1, tokb + ct, lane, out, hpre); } } while (0)
        PL_LOAD(ra, V8, seL, lb);
        V_SETC(); V_ADV();
        for (;;) {
            if (lt < 16) PL_LOAD(rb, V8, seL, lb);
            V_COMPUTE(ra);
            if (lt >= 16) break;
            V_SETC(); V_ADV();
            if (lt < 16) PL_LOAD(ra, V8, seL, lb);
            V_COMPUTE(rb);
            if (lt >= 16) break;
            V_SETC(); V_ADV();
        }
        asm volatile("s_waitcnt vmcnt(0)" ::: "memory");
        __syncthreads();
    }
#undef V_ADV
#undef V_SETC
#undef V_COMPUTE
#undef PL_LOAD
#undef PL_RANGE
}


#ifndef ZSKIP
#define ZSKIP 0
#endif
#ifndef ZGA_ALIGN
#define ZGA_ALIGN true
#endif
#ifndef ZGA_SP2
#define ZGA_SP2 true
#endif
#ifndef WIN_ALIGN
#define WIN_ALIGN true
#endif
#ifndef WIN_SP2
#define WIN_SP2 true
#endif
#ifndef REP_E
#define REP_E 1
#endif
#ifndef REP_A
#define REP_A 1
#endif
#ifndef REP_B
#define REP_B 1
#endif
#ifndef REP_C
#define REP_C 1
#endif
#ifndef REP_D
#define REP_D 1
#endif
#ifndef REP_G
#define REP_G 1
#endif
#ifndef REP_I
#define REP_I 1
#endif
#ifndef REP_K
#define REP_K 1
#endif
__global__ void __launch_bounds__(NWAVES * 64, 2) trunk_fwd(Args args) {
    extern __shared__ __attribute__((aligned(16))) unsigned char lds[];
    Frame F;
    F.lds = (LAS unsigned char*)lds;
    F.tid = threadIdx.x; F.lane = F.tid & 63; F.wave = __builtin_amdgcn_readfirstlane(F.tid >> 6); F.wave0 = F.wave;
    F.G = gridDim.x; F.bx = blockIdx.x; F.ws = (GAS unsigned char*)args.ws; F.h = args.out;
    volatile LAS unsigned* MISC = (volatile LAS unsigned*)(F.lds + MISC_OFF);
    for (int u = F.tid; u < (LDS_BYTES - LDSCTL_OFF) / 4; u += NWAVES * 64) ((LAS unsigned*)(F.lds + LDSCTL_OFF))[u] = 0u;
    __syncthreads();
    unsigned* ctl = (unsigned*)(F.ws + WS_CTL);
    XcdBarrier bar = xcd_barrier_post(ctl + CW_BAR, MISC + 8);
    GAS unsigned char* ws = F.ws;
    LAS unsigned char* ring = (LAS unsigned char*)F.lds;

    for (int rep = 0; rep < REP_A; ++rep) { prep_phase(F, args, 0, F.bx, F.G, 1);
    xcd_barrier(bar, F.wave0); }
#define OPQ() GAS unsigned char* ws = F.ws; asm volatile("" : "+s"(ws)); GAS unsigned char* db = ws + WS_DB + (size_t)(layer & 1) * DB_SET; (void)db
    for (int layer = 0; layer < DEPTH; ++layer) {
        {   OPQ();
        for (int rep = 0; rep < REP_B; ++rep) {   if (rep) xcd_barrier(bar, F.wave0); pg8::Gemm g{(const bf16*)(ws + WS_NX), (const bf16*)(ws + WS_WIN), T, NZ - 256 * ZSPLIT, 2048, 2048}; pg8::StaticOrder S; S.init(T, NZ - 256 * ZSPLIT, F.G, F.bx);
            pg8::EpiZ E{(bf16*)(ws + WS_ZRKV), (bf16*)(ws + WS_ZL), (bf16*)(ws + WS_GUV), (bf16*)(ws + WS_SG), layer == 0 ? (bf16*)(ws + WS_VF) : (bf16*)nullptr, 0};
            pg8::gemm_phase<pg8::EpiZ, pg8::StaticOrder, WIN_ALIGN, WIN_SP2>(ring, g, S, E, F.wave0); }
        }
        xcd_barrier(bar, F.wave0);
        {   OPQ();
        for (int rep = 0; rep < REP_C; ++rep) {   if (rep) xcd_barrier(bar, F.wave0); { pg8::Gemm g{(const bf16*)(ws + WS_ZL), (const bf16*)(ws + WS_LORA + (size_t)layer * LORA_BYTES), T, 2048, 128, 512}; pg8::StaticOrder S; S.init(T, 2048, F.G, F.bx);
            pg8::EpiLora E{(bf16*)(ws + WS_EW), (size_t)(WS_AR - WS_EW) / 2, args.in[6] + (size_t)layer * 1024, args.in[8] + (size_t)layer * 1024, 0};
            pg8::gemm_phase<pg8::EpiLora, pg8::StaticOrder, true, true>(ring, g, S, E, F.wave0); }
            { pg8::Gemm g{(const bf16*)(ws + WS_ZL) + 128, (const bf16*)(ws + WS_LORA + (size_t)layer * LORA_BYTES) + 2048 * 128, T, 1024, 128, 512}; pg8::StaticOrder S; S.init(T, 1024, F.G, F.bx);
            pg8::EpiLora E{(bf16*)(ws + WS_EW), (size_t)(WS_AR - WS_EW) / 2, args.in[6] + (size_t)layer * 1024, args.in[8] + (size_t)layer * 1024, 8};
            pg8::gemm_phase<pg8::EpiLora, pg8::StaticOrder, true, true>(ring, g, S, E, F.wave0); } }
        if (layer > 0) {
            pg8::Gemm g{(const bf16*)(ws + WS_ZL) + 256, (const bf16*)(ws + WS_MV + (size_t)(layer - 1) * MV_BYTES), T, 1024, 128, 512}; pg8::StaticOrder S; S.init(T, 1024, F.G, F.bx);
            pg8::EpiMv E{(bf16*)(ws + WS_ZRKV), (const bf16*)(ws + WS_VF), args.in[18] + (size_t)(layer - 1) * 1024};
            pg8::gemm_phase<pg8::EpiMv, pg8::StaticOrder, true, true>(ring, g, S, E, F.wave0); }
        }
        xcd_barrier(bar, F.wave0);
        {   OPQ();
        for (int rep = 0; rep < REP_D; ++rep) {   if (rep) xcd_barrier(bar, F.wave0); const int nsb = F.G / 2, nob = F.G - nsb;
            if (F.bx < nsb) { for (int u = F.bx; u < NB * 16; u += nsb) scan_unit(F, args, layer, u); }
            else { const int ob = F.bx - nsb;
                for (int pm = ob; pm < T / 256; pm += nob)
                    for (int rep2 = 0; rep2 < REP_E; ++rep2) { gmlp_unit(F, args, layer, 2 * pm); gmlp_unit(F, args, layer, 2 * pm + 1); }
                asm volatile("s_waitcnt vmcnt(0)" ::: "memory"); __syncthreads();
                {
                    pg8::Gemm g{(const bf16*)(ws + WS_GUV), (const bf16*)(db + DB_PBT), T, 1024, 1024, 2048}; pg8::PanelOrder S{ob, nob, T / 256, 4, 0};
                    pg8::EpiMerge<false> E{(const bf16*)(ws + WS_SG), (bf16*)(ws + WS_GUV) + 1024, (bf16*)nullptr};
                    pg8::gemm_phase<pg8::EpiMerge<false>, pg8::PanelOrder, true, true>(ring, g, S, E, F.wave0); }
                {
                    pg8::Gemm g{(const bf16*)(ws + WS_NX), (const bf16*)(ws + WS_WINB + (size_t)(layer & 1) * WINB_BYTES), T, 256 * ZSPLIT, 2048, 2048}; pg8::StaticOrder S; S.init(T, 256 * ZSPLIT, nob, ob);
                    pg8::EpiZ E{(bf16*)(ws + WS_ZRKV), (bf16*)(ws + WS_ZL), (bf16*)(ws + WS_GUV), (bf16*)(ws + WS_SG), (bf16*)nullptr, 30 - ZSPLIT};
                    pg8::gemm_phase<pg8::EpiZ, pg8::StaticOrder, true, true>(ring, g, S, E, F.wave0); }
                {   pg8::Gemm g{(const bf16*)(db + DB_PB), (const bf16*)(db + DB_PLEW), T, 1024, 256, 256}; pg8::StaticOrder S; S.init(T, 1024, nob, ob);
                    pg8::EpiPlain E{(bf16*)(ws + WS_PW), 1024};
                    pg8::gemm_phase<pg8::EpiPlain, pg8::StaticOrder, true, true>(ring, g, S, E, F.wave0); }
                if (layer == 0) prep_phase(F, args, 0, ob, nob, 2);
                if (layer + 1 < DEPTH) prep_phase(F, args, layer + 1, ob, nob, 3); } }
        }
        xcd_barrier(bar, F.wave0);
        {   OPQ();
        for (int rep = 0; rep < REP_G; ++rep) {   if (rep) xcd_barrier(bar, F.wave0); pg8::Gemm g{(const bf16*)(ws + WS_G), (const bf16*)(db + DB_PA), T, 1024, 1024, 1024}; pg8::StaticOrder S; S.init(T, 1024, F.G, F.bx);
            pg8::EpiMerge<true> E{(const bf16*)(ws + WS_SG), (bf16*)(ws + WS_GUV) + 1024, (bf16*)(ws + WS_MG)};
            pg8::gemm_phase<pg8::EpiMerge<true>, pg8::StaticOrder, true, true>(ring, g, S, E, F.wave0); }
        }
        xcd_barrier(bar, F.wave0);
        {   OPQ();
        {   pg8::Gemm g{(const bf16*)(ws + WS_MG), (const bf16*)(db + DB_POUT), T, 1024, 1024, 1024}; pg8::StaticOrder S; S.init(T, 1024, F.G, F.bx);
            pg8::EpiResid E{F.h};
            pg8::gemm_phase<pg8::EpiResid, pg8::StaticOrder, true, true>(ring, g, S, E, F.wave0); }
        }
        xcd_barrier(bar, F.wave0);
        {   OPQ();
        for (int rep = 0; rep < REP_I; ++rep) {   if (rep) xcd_barrier(bar, F.wave0); phase_ids(F); const int gw = F.bx * NWAVES + F.wave, NGW = F.G * NWAVES; const float* g2 = args.in[3] + (size_t)layer * 1024;
            for (int m = gw; m < T / 2; m += NGW) norm_row_n2x2(F.h + (size_t)m * D, F.h + (size_t)(m + T / 2) * D, g2, (bf16*)(ws + WS_N2) + (size_t)m * D, (bf16*)(ws + WS_N2) + (size_t)(m + T / 2) * D, F.lane); }
        }
        xcd_barrier(bar, F.wave0);
        {   OPQ();
        {   pg8::Gemm g{(const bf16*)(ws + WS_N2), (const bf16*)(db + DB_WQG), T, 3072, 1024, 1024}; pg8::StaticOrder S; S.init(T, 3072, F.G, F.bx);
            pg8::EpiQG E{(bf16*)(ws + WS_Q), (const bf16*)(ws + WS_PW), F.h};
            pg8::gemm_phase<pg8::EpiQG, pg8::StaticOrder, true, true>(ring, g, S, E, F.wave0); }
        }
        xcd_barrier(bar, F.wave0);
        {   OPQ();
        for (int u = F.bx; u < T / 128; u += F.G) peer_unit(F, args, layer, u, layer == DEPTH - 1);
        }
        if (layer + 1 < DEPTH) xcd_barrier(bar, F.wave0);
    }
}

extern "C" void kernel_launch(void* const* d_in, const int* in_sizes, int n_in, void* d_out, int out_size, void* d_ws, size_t ws_size, hipStream_t stream) {
    static int grid = 0;
    if (grid == 0) {
        if (n_in != 32 || out_size != T * D || ws_size < WS_END) { fprintf(stderr, "kernel_launch: unexpected sizes n_in %d out %d ws %zu (need %zu); nothing launched\n", n_in, out_size, ws_size, (size_t)WS_END); grid = -1; return; }
        int dev = 0, cus = 0, per_cu = 0;
        if (hipGetDevice(&dev) != hipSuccess || hipDeviceGetAttribute(&cus, hipDeviceAttributeMultiprocessorCount, dev) != hipSuccess) { grid = -1; return; }
        if (hipFuncSetAttribute((const void*)trunk_fwd, hipFuncAttributeMaxDynamicSharedMemorySize, LDS_BYTES) != hipSuccess) { fprintf(stderr, "kernel_launch: hipFuncSetAttribute failed\n"); grid = -1; return; }
        if (hipOccupancyMaxActiveBlocksPerMultiprocessor(&per_cu, (const void*)trunk_fwd, NWAVES * 64, LDS_BYTES) != hipSuccess || per_cu < 1)
            fprintf(stderr, "kernel_launch: note: occupancy query reports %d workgroups per CU\n", per_cu);
        (void)hipGetLastError();
        grid = cus;
    }
    if (grid < 0) return;
    (void)hipMemsetAsync((char*)d_ws + WS_CTL, 0, ZERO_BYTES, stream);
    (void)hipMemsetAsync((char*)d_ws + WIN_ZERO_OFF, 0, WIN_ZERO_BYTES, stream);
    Args a{};
    for (int i = 0; i < 32; ++i) a.in[i] = (const float*)d_in[i];
    a.out = (float*)d_out; a.ws = (unsigned char*)d_ws;
    hipLaunchKernelGGL(trunk_fwd, dim3(grid), dim3(NWAVES * 64), LDS_BYTES, stream, a);
    const hipError_t le = hipPeekAtLastError();
    if (le != hipSuccess) fprintf(stderr, "kernel_launch: launch failed: %s\n", hipGetErrorName(le));
}
```

```cpp
#include <hip/hip_runtime.h>
#include <cstdio>
#include <cstdint>
#define ZSPLIT 4
namespace pg8 {
#define PG8_LAS __attribute__((address_space(3)))
typedef unsigned short bf16_t;
typedef short bf16x8 __attribute__((ext_vector_type(8)));
typedef float f32x4 __attribute__((ext_vector_type(4)));
typedef unsigned u32x4 __attribute__((ext_vector_type(4)));
constexpr int BM = 256, BK = 64, HALF = 128, HTB = HALF * BK * 2  , STAGE_BYTES = 8 * HTB, NXCD = 8, WGM = 8;

__host__ __device__ __forceinline__ int lds_byte(int r, int c) { const int st = (r >> 4) * 2 + (c >> 5), rr = r & 15, cc = c & 31, ob = rr * 64 + cc * 2; return st * 1024 + (ob ^ (((ob >> 9) & 1) << 5)); }
__host__ __device__ __forceinline__ void stage_rc(int b, int& R, int& C) { const int st = b / 1024, sb = b % 1024, swz = sb ^ (((sb >> 9) & 1) << 5); R = (st >> 1) * 16 + swz / 64; C = (st & 1) * 32 + (swz % 64) / 2; }
__host__ __device__ __forceinline__ int perm32(int rho) { const int n = rho >> 4, i = rho & 15; return 8 * (i >> 2) + 4 * n + (i & 3); }

struct Unit { int pm, pn; };
struct Gemm { const bf16_t* A; const bf16_t* Bt; int M, N, K, lda; };

struct StaticOrder {
    int nM, nN, nwg, G, c;
    __host__ __device__ void init(int M, int N, int G_, int c_) { nM = M / BM; nN = N / BM; nwg = nM * nN; G = G_; c = c_; }
    __host__ __device__ bool next(int i, Unit& u) const {
        const long L = (long)i * G + c; if (L >= nwg) return false;
        int wgid = (int)L; { const int q = nwg / NXCD, r = nwg % NXCD, xcd = wgid % NXCD, off = wgid / NXCD; wgid = (xcd < r ? xcd * (q + 1) : r * (q + 1) + (xcd - r) * q) + off; }
        const int nig = WGM * nN, gid = wgid / nig, fm = gid * WGM, gsz = (nM - fm) < WGM ? (nM - fm) : WGM;
        u.pm = fm + ((wgid % nig) % gsz); u.pn = (wgid % nig) / gsz; return true;
    }
    __device__ __forceinline__ void a_ready(const Unit&) const {}
    __device__ __forceinline__ void done(const Unit&) const {}
};
struct PanelOrder {
    int first, stride, nM, nN, pn0;
    __host__ __device__ bool next(int i, Unit& u) const { const int p = first + (i / nN) * stride; if (p >= nM) return false; u.pm = p; u.pn = pn0 + i % nN; return true; }
    __device__ __forceinline__ void a_ready(const Unit&) const {}
    __device__ __forceinline__ void done(const Unit&) const {}
};
__device__ __forceinline__ unsigned cvt_pk_bf16(float lo, float hi) { unsigned r; asm volatile("v_cvt_pk_bf16_f32 %0, %1, %2" : "=v"(r) : "v"(lo), "v"(hi)); return r; }

__device__ __forceinline__ float fsig(float x) { return __builtin_amdgcn_rcpf(1.f + __builtin_amdgcn_exp2f(-1.44269504f * x)); }
__device__ __forceinline__ float fgelu(float x) { return x * fsig(1.5957691216f * (x + 0.044715f * x * x * x)); }
__device__ __forceinline__ float bflo(unsigned w) { return __builtin_bit_cast(float, w << 16); }
__device__ __forceinline__ float bfhi(unsigned w) { return __builtin_bit_cast(float, w & 0xffff0000u); }
__device__ __forceinline__ void unpk8(const u32x4 w, f32x4& a, f32x4& b) { a = (f32x4){bflo(w.x), bfhi(w.x), bflo(w.y), bfhi(w.y)}; b = (f32x4){bflo(w.z), bfhi(w.z), bflo(w.w), bfhi(w.w)}; }
__device__ __forceinline__ u32x4 pk8(const f32x4 a, const f32x4 b) { u32x4 w; w.x = cvt_pk_bf16(a[0], a[1]); w.y = cvt_pk_bf16(a[2], a[3]); w.z = cvt_pk_bf16(b[0], b[1]); w.w = cvt_pk_bf16(b[2], b[3]); return w; }
__device__ __forceinline__ f32x4 act4(f32x4 v, int kind) {
    if (kind == 1) { v = (f32x4){fgelu(v[0]), fgelu(v[1]), fgelu(v[2]), fgelu(v[3])}; }
    else if (kind == 2) { v = (f32x4){fsig(v[0]), fsig(v[1]), fsig(v[2]), fsig(v[3])}; }
    else if (kind == 3) { v = (f32x4){2.f * fsig(2.f * v[0]) - 1.f, 2.f * fsig(2.f * v[1]) - 1.f, 2.f * fsig(2.f * v[2]) - 1.f, 2.f * fsig(2.f * v[3]) - 1.f}; }
    return v;
}
#define EPI_ROWS_BEGIN _Pragma("unroll") for (int ai = 0; ai < 2; ++ai) _Pragma("unroll") for (int m = 0; m < 4; ++m) { const size_t row = (size_t)(row0 + ai * HALF + m * 16);
#define EPI_ROWS_END }

struct EpiZ {
    static constexpr bool PERM = true, AFTER_DRAIN = false;
    bf16_t *zrkv, *zl, *guv, *sg, *vf; int pnoff;
    __device__ __forceinline__ void operator()(const f32x4 (&acc)[2][2][4][2], const Unit& u, int wr, int wc, int fr, int fq) const {
        const int pn = u.pn + pnoff, row0 = u.pm * BM + wr * 64 + fr;
        bf16_t* dst; int ld, colt, k0, k1;
        if (pn < 12)       { dst = zrkv; ld = 3072; colt = pn * 256;        k0 = 0; k1 = 0; }
        else if (pn == 12) { dst = zl;   ld = 512;  colt = 0;               k0 = (wc < 2) ? 3 : 0; k1 = 2; }
        else if (pn == 13) { dst = zl;   ld = 512;  colt = 256;             k0 = 0; k1 = 0; }
        else if (pn < 22)  { dst = guv;  ld = 2048; colt = (pn - 14) * 256; k0 = 1; k1 = 1; }
        else               { dst = sg;   ld = 2048; colt = ((pn - 18) & 7) * 256; k0 = 2; k1 = 2; }
        const int col0 = colt + wc * 32 + 8 * fq;
        const bool dovf = (vf != nullptr) && pn >= 8 && pn < 12;
        const int vcol0 = (pn - 8) * 256 + wc * 32 + 8 * fq;
        EPI_ROWS_BEGIN
            bf16_t* rowp = dst + row * ld + col0;
#pragma unroll
            for (int bj = 0; bj < 2; ++bj) { const int kind = bj ? k1 : k0;
                const u32x4 w = pk8(act4(acc[ai][bj][m][0], kind), act4(acc[ai][bj][m][1], kind));
                *(u32x4*)(rowp + bj * HALF) = w;
                if (dovf) *(u32x4*)(vf + row * 1024 + vcol0 + bj * HALF) = w; }
        EPI_ROWS_END
    }
};
struct EpiLora {
    static constexpr bool PERM = true, AFTER_DRAIN = false;
    bf16_t* ew; size_t stride; const float *w0, *a0; int pnoff;
    __device__ __forceinline__ void operator()(const f32x4 (&acc)[2][2][4][2], const Unit& u, int wr, int wc, int fr, int fq) const {
        const int pn = u.pn + pnoff, sel = pn >> 2, row0 = u.pm * BM + wr * 64 + fr, col0 = (pn & 3) * 256 + wc * 32 + 8 * fq;
        bf16_t* dst = ew + (size_t)sel * stride;
        const float* bp = sel == 0 ? w0 : a0;
        f32x4 bv[2][2];
#pragma unroll
        for (int bj = 0; bj < 2; ++bj)
#pragma unroll
            for (int n = 0; n < 2; ++n) bv[bj][n] = (sel < 2) ? *(const f32x4*)(bp + col0 + bj * HALF + 4 * n) : (f32x4){0.f, 0.f, 0.f, 0.f};
        EPI_ROWS_BEGIN
            bf16_t* rowp = dst + row * 1024 + col0;
#pragma unroll
            for (int bj = 0; bj < 2; ++bj) { f32x4 v0 = acc[ai][bj][m][0] + bv[bj][0], v1 = acc[ai][bj][m][1] + bv[bj][1];
                if (sel < 2) { v0 = act4(v0, 2); v1 = act4(v1, 2); }
                if (sel == 0) { v0 = v0 * 0.60653066f; v1 = v1 * 0.60653066f; }
                *(u32x4*)(rowp + bj * HALF) = pk8(v0, v1); }
        EPI_ROWS_END
    }
};
struct EpiMv {
    static constexpr bool PERM = true, AFTER_DRAIN = false;
    bf16_t* zrkv; const bf16_t* vf; const float* v0b;
    __device__ __forceinline__ void operator()(const f32x4 (&acc)[2][2][4][2], const Unit& u, int wr, int wc, int fr, int fq) const {
        const int row0 = u.pm * BM + wr * 64 + fr, col0 = u.pn * 256 + wc * 32 + 8 * fq;
        f32x4 bv[2][2];
#pragma unroll
        for (int bj = 0; bj < 2; ++bj)
#pragma unroll
            for (int n = 0; n < 2; ++n) bv[bj][n] = *(const f32x4*)(v0b + col0 + bj * HALF + 4 * n);
        EPI_ROWS_BEGIN
#pragma unroll
            for (int bj = 0; bj < 2; ++bj) { bf16_t* zp = zrkv + row * 3072 + 2048 + col0 + bj * HALF;
                f32x4 z0, z1, f0, f1; unpk8(*(const u32x4*)zp, z0, z1); unpk8(*(const u32x4*)(vf + row * 1024 + col0 + bj * HALF), f0, f1);
                const f32x4 m0 = act4(acc[ai][bj][m][0] + bv[bj][0], 2), m1 = act4(acc[ai][bj][m][1] + bv[bj][1], 2);
                *(u32x4*)zp = pk8(z0 + (f0 - z0) * m0, z1 + (f1 - z1) * m1); }
        EPI_ROWS_END
    }
};
struct EpiPlain {
    static constexpr bool PERM = true, AFTER_DRAIN = false;
    bf16_t* o; int ld;
    __device__ __forceinline__ void operator()(const f32x4 (&acc)[2][2][4][2], const Unit& u, int wr, int wc, int fr, int fq) const {
        const int row0 = u.pm * BM + wr * 64 + fr, col0 = u.pn * 256 + wc * 32 + 8 * fq;
        EPI_ROWS_BEGIN
#pragma unroll
            for (int bj = 0; bj < 2; ++bj) *(u32x4*)(o + row * ld + col0 + bj * HALF) = pk8(acc[ai][bj][m][0], acc[ai][bj][m][1]);
        EPI_ROWS_END
    }
};
template <bool SECOND> struct EpiMerge {
    static constexpr bool PERM = true, AFTER_DRAIN = false;
    const bf16_t* sg; bf16_t* m2; bf16_t* o;
    __device__ __forceinline__ void operator()(const f32x4 (&acc)[2][2][4][2], const Unit& u, int wr, int wc, int fr, int fq) const {
        const int row0 = u.pm * BM + wr * 64 + fr, col0 = u.pn * 256 + wc * 32 + 8 * fq;
#pragma unroll
        for (int ai = 0; ai < 2; ++ai) { u32x4 gv[4][2], pv[4][2];
#pragma unroll
            for (int m = 0; m < 4; ++m) { const size_t row = (size_t)(row0 + ai * HALF + m * 16);
#pragma unroll
                for (int bj = 0; bj < 2; ++bj) { const int c = col0 + bj * HALF; gv[m][bj] = *(const u32x4*)(sg + row * 2048 + (SECOND ? 0 : 1024) + c);
                    if (SECOND) pv[m][bj] = *(const u32x4*)(m2 + row * 2048 + c); } }
#pragma unroll
            for (int m = 0; m < 4; ++m) { const size_t row = (size_t)(row0 + ai * HALF + m * 16);
#pragma unroll
                for (int bj = 0; bj < 2; ++bj) { const int c = col0 + bj * HALF;
                    f32x4 g0, g1; unpk8(gv[m][bj], g0, g1);
                    f32x4 v0 = g0 * acc[ai][bj][m][0], v1 = g1 * acc[ai][bj][m][1];
                    if (SECOND) { f32x4 p0, p1; unpk8(pv[m][bj], p0, p1); v0 = v0 + p0; v1 = v1 + p1; *(u32x4*)(o + row * 1024 + c) = pk8(v0, v1); }
                    else *(u32x4*)(m2 + row * 2048 + c) = pk8(v0, v1); } } }
    }
};
struct EpiResid {
    static constexpr bool PERM = false, AFTER_DRAIN = false;
    float* h;
    __device__ __forceinline__ void operator()(const f32x4 (&acc)[2][2][4][2], const Unit& u, int wr, int wc, int fr, int fq) const {
        const int row0 = u.pm * BM + wr * 64 + fr, col0 = u.pn * 256 + wc * 32 + 4 * fq;
#pragma unroll
        for (int ai = 0; ai < 2; ++ai) { f32x4 hv[4][2][2];
#pragma unroll
            for (int m = 0; m < 4; ++m) { const float* rowp = h + (size_t)(row0 + ai * HALF + m * 16) * 1024 + col0;
#pragma unroll
                for (int bj = 0; bj < 2; ++bj)
#pragma unroll
                    for (int n = 0; n < 2; ++n) hv[m][bj][n] = *(const f32x4*)(rowp + bj * HALF + n * 16); }
#pragma unroll
            for (int m = 0; m < 4; ++m) { float* rowp = h + (size_t)(row0 + ai * HALF + m * 16) * 1024 + col0;
#pragma unroll
                for (int bj = 0; bj < 2; ++bj)
#pragma unroll
                    for (int n = 0; n < 2; ++n) *(f32x4*)(rowp + bj * HALF + n * 16) = hv[m][bj][n] + acc[ai][bj][m][n]; } }
    }
};
struct EpiQG {
    static constexpr bool PERM = true, AFTER_DRAIN = false;
    bf16_t* q; const bf16_t* pw; float* h;
    __device__ __forceinline__ void operator()(const f32x4 (&acc)[2][2][4][2], const Unit& u, int wr, int wc, int fr, int fq) const {
        const int row0 = u.pm * BM + wr * 64 + fr;
        if (u.pn < 8) { const int col0 = u.pn * 256 + wc * 32 + 8 * fq;
            EPI_ROWS_BEGIN
#pragma unroll
                for (int bj = 0; bj < 2; ++bj) *(u32x4*)(q + row * 2048 + col0 + bj * HALF) = pk8(acc[ai][bj][m][0], acc[ai][bj][m][1]);
            EPI_ROWS_END
        } else { const int col0 = (u.pn - 8) * 256 + wc * 32 + 8 * fq;
#pragma unroll
            for (int ai = 0; ai < 2; ++ai)
#pragma unroll
            for (int mh = 0; mh < 2; ++mh) { u32x4 pwv[2][2]; f32x4 hv[2][2][2];
#pragma unroll
                for (int m2_ = 0; m2_ < 2; ++m2_) { const size_t row = (size_t)(row0 + ai * HALF + (2 * mh + m2_) * 16);
#pragma unroll
                    for (int bj = 0; bj < 2; ++bj) { const int c = col0 + bj * HALF; pwv[m2_][bj] = *(const u32x4*)(pw + row * 1024 + c);
                        hv[m2_][bj][0] = *(const f32x4*)(h + row * 1024 + c); hv[m2_][bj][1] = *(const f32x4*)(h + row * 1024 + c + 4); } }
#pragma unroll
                for (int m2_ = 0; m2_ < 2; ++m2_) { const int m = 2 * mh + m2_; const size_t row = (size_t)(row0 + ai * HALF + m * 16);
#pragma unroll
                    for (int bj = 0; bj < 2; ++bj) { const int c = col0 + bj * HALF; f32x4 p0, p1; unpk8(pwv[m2_][bj], p0, p1);
                        *(f32x4*)(h + row * 1024 + c) = hv[m2_][bj][0] + p0 * act4(acc[ai][bj][m][0], 2); *(f32x4*)(h + row * 1024 + c + 4) = hv[m2_][bj][1] + p1 * act4(acc[ai][bj][m][1], 2); } } }
        }
    }
};
template <class Epi, class Sched, bool ALIGN_EPI = false, bool SP2 = false>
__device__ __forceinline__ void gemm_phase(PG8_LAS unsigned char* lds, const Gemm g, const Sched& S, const Epi& E, const int wave0) {
    int tidq; asm volatile("v_mbcnt_lo_u32_b32 %0, -1, 0\n\tv_mbcnt_hi_u32_b32 %0, -1, %0" : "=v"(tidq)); tidq += wave0 * 64;
    const int tid = tidq, wid = __builtin_amdgcn_readfirstlane(tid >> 6), lane = tid & 63, wr = wid >> 2, wc = wid & 3, fr = lane & 15, fq = lane >> 4;
    int Kq = g.K, ldaq = g.lda; const bf16_t* gA = g.A; const bf16_t* gB = g.Bt; asm volatile("" : "+s"(Kq), "+s"(ldaq), "+s"(gA), "+s"(gB));
    const int K = Kq, nt = K / BK;
    unsigned voffA[2], voffB[2];
#pragma unroll
    for (int i = 0; i < 2; ++i) { int R, C; stage_rc(tid * 16 + i * 8192, R, C); const int Rb = Epi::PERM ? ((R & ~31) + perm32(R & 31)) : R;
        voffA[i] = (unsigned)(R * ldaq + C) * 2u; voffB[i] = (unsigned)(Rb * K + C) * 2u; }
    const size_t kstep = (size_t)(BK * 2);
    const size_t hstepA = (size_t)HALF * ldaq * 2, hstepB = (size_t)HALF * K * 2;
    const size_t tstepA = 2 * hstepA, tstepB = 2 * hstepB;
    const unsigned ldsw = (unsigned)wid * 1024u;
    const int aoff = lds_byte(wr * 64 + fr, fq * 8), boff = lds_byte(wc * 32 + fr, fq * 8);
#define PG8_SA(b, h) (((b) * 2 + (h)) * HTB)
#define PG8_SB(b, h) ((4 + (b) * 2 + (h)) * HTB)
#define PG8_STAGE(bufoff, gbase, voff) do { _Pragma("unroll") for (int _i = 0; _i < 2; ++_i) \
        __builtin_amdgcn_global_load_lds((const unsigned*)((const char*)(gbase) + (voff)[_i]), (PG8_LAS unsigned*)(lds + (bufoff) + ldsw + _i * 8192), 16, 0, 0); } while (0)
#define PG8_LDA(dst, b, h) do { _Pragma("unroll") for (int m = 0; m < 4; ++m) _Pragma("unroll") for (int k = 0; k < 2; ++k) dst[m][k] = *(const PG8_LAS bf16x8*)(lds + PG8_SA(b, h) + aoff + m * 2048 + k * 1024); } while (0)
#define PG8_LDB(dst, b, h) do { _Pragma("unroll") for (int n = 0; n < 2; ++n) _Pragma("unroll") for (int k = 0; k < 2; ++k) dst[n][k] = *(const PG8_LAS bf16x8*)(lds + PG8_SB(b, h) + boff + n * 2048 + k * 1024); } while (0)
#define PG8_MMA(ai, bj, At, Bt) do { __builtin_amdgcn_s_setprio(1); _Pragma("unroll") for (int m = 0; m < 4; ++m) _Pragma("unroll") for (int n = 0; n < 2; ++n) _Pragma("unroll") for (int k = 0; k < 2; ++k) \
        acc[ai][bj][m][n] = __builtin_amdgcn_mfma_f32_16x16x32_bf16(Bt[n][k], At[m][k], acc[ai][bj][m][n], 0, 0, 0); __builtin_amdgcn_s_setprio(0); } while (0)
#define PG8_WAIT_V(n) asm volatile("s_waitcnt vmcnt(" #n ")" ::: "memory")
#define PG8_WAIT_L(n) asm volatile("s_waitcnt lgkmcnt(" #n ")" ::: "memory")
#define PG8_BAR __builtin_amdgcn_s_barrier()
#define PG8_SCHED __builtin_amdgcn_sched_barrier(0)
    Unit cur, nxt; int ui = 0;
    if (!S.next(0, cur)) return;
    f32x4 acc[2][2][4][2];
#pragma unroll
    for (int a = 0; a < 2; ++a)
#pragma unroll
        for (int b = 0; b < 2; ++b)
#pragma unroll
            for (int m = 0; m < 4; ++m)
#pragma unroll
                for (int n = 0; n < 2; ++n) acc[a][b][m][n] = (f32x4){0.f, 0.f, 0.f, 0.f};
    bf16x8 At[4][2], B0[2][2], B1[2][2];
    const char* cA = (const char*)gA + (size_t)cur.pm * tstepA; const char* cB = (const char*)gB + (size_t)cur.pn * tstepB;
    S.a_ready(cur);
    if constexpr (SP2) {
        PG8_STAGE(PG8_SB(0, 0), cB, voffB); PG8_STAGE(PG8_SB(0, 1), cB + hstepB, voffB); PG8_STAGE(PG8_SA(0, 0), cA, voffA); PG8_STAGE(PG8_SA(0, 1), cA + hstepA, voffA);
        if (wr == 1) PG8_BAR;
        PG8_WAIT_V(2); PG8_BAR;
        PG8_STAGE(PG8_SB(1, 0), cB + kstep, voffB); PG8_STAGE(PG8_SA(1, 0), cA + kstep, voffA); PG8_STAGE(PG8_SB(1, 1), cB + hstepB + kstep, voffB);
        PG8_WAIT_V(6); PG8_BAR;
    } else {
        PG8_STAGE(PG8_SB(0, 0), cB, voffB); PG8_STAGE(PG8_SA(0, 0), cA, voffA); PG8_STAGE(PG8_SB(0, 1), cB + hstepB, voffB); PG8_STAGE(PG8_SA(0, 1), cA + hstepA, voffA);
        if (wr == 1) PG8_BAR;
        PG8_WAIT_V(4); PG8_BAR;
        PG8_STAGE(PG8_SB(1, 0), cB + kstep, voffB); PG8_STAGE(PG8_SA(1, 0), cA + kstep, voffA); PG8_STAGE(PG8_SB(1, 1), cB + hstepB + kstep, voffB);
        PG8_WAIT_V(6); PG8_BAR;
    }
    for (;;) {
        const bool has_next = S.next(ui + 1, nxt);
        const char* nA = has_next ? (const char*)gA + (size_t)nxt.pm * tstepA : cA; const char* nB = has_next ? (const char*)gB + (size_t)nxt.pn * tstepB : cB;
        for (int t = 0; t < nt; t += 2) {
            const bool last = (t == nt - 2);
            const char* a1 = cA + (size_t)(t + 1) * kstep;
            const char* a2 = last ? nA : cA + (size_t)(t + 2) * kstep; const char* b2 = last ? nB : cB + (size_t)(t + 2) * kstep;
            const char* a3 = a2 + kstep; const char* b3 = b2 + kstep;
            if (last && has_next) S.a_ready(nxt);
            if constexpr (SP2) {
            PG8_LDB(B0, 0, 0); PG8_LDB(B1, 0, 1); PG8_SCHED; PG8_LDA(At, 0, 0); PG8_STAGE(PG8_SA(1, 1), a1 + hstepA, voffA);
            PG8_WAIT_V(8); PG8_WAIT_L(0); PG8_BAR; PG8_MMA(0, 0, At, B0); PG8_MMA(0, 1, At, B1); PG8_BAR; PG8_SCHED;
            PG8_LDA(At, 0, 1); PG8_STAGE(PG8_SB(0, 0), b2, voffB); PG8_STAGE(PG8_SB(0, 1), b2 + hstepB, voffB); PG8_STAGE(PG8_SA(0, 0), a2, voffA);
            PG8_WAIT_V(8); PG8_WAIT_L(0); PG8_BAR; PG8_MMA(1, 0, At, B0); PG8_MMA(1, 1, At, B1); PG8_BAR; PG8_SCHED;
            PG8_LDB(B0, 1, 0); PG8_LDB(B1, 1, 1); PG8_SCHED; PG8_LDA(At, 1, 0); PG8_STAGE(PG8_SA(0, 1), a2 + hstepA, voffA);
            PG8_WAIT_V(8); PG8_WAIT_L(0); PG8_BAR; PG8_MMA(0, 0, At, B0); PG8_MMA(0, 1, At, B1); PG8_BAR; PG8_SCHED;
            PG8_LDA(At, 1, 1); PG8_STAGE(PG8_SB(1, 0), b3, voffB); PG8_STAGE(PG8_SB(1, 1), b3 + hstepB, voffB); PG8_STAGE(PG8_SA(1, 0), a3, voffA);
            PG8_WAIT_V(8); PG8_WAIT_L(0); PG8_BAR; PG8_MMA(1, 0, At, B0); PG8_MMA(1, 1, At, B1); PG8_BAR; PG8_SCHED;
            } else {
            PG8_LDB(B0, 0, 0); PG8_SCHED; PG8_LDA(At, 0, 0); PG8_STAGE(PG8_SA(1, 1), a1 + hstepA, voffA);
            PG8_WAIT_L(8); PG8_BAR; PG8_WAIT_L(0); PG8_MMA(0, 0, At, B0); PG8_BAR; PG8_SCHED;
            PG8_LDB(B1, 0, 1); PG8_STAGE(PG8_SB(0, 0), b2, voffB);
            PG8_BAR; PG8_WAIT_L(0); PG8_MMA(0, 1, At, B1); PG8_BAR;
            PG8_LDA(At, 0, 1); PG8_STAGE(PG8_SA(0, 0), a2, voffA);
            PG8_BAR; PG8_WAIT_L(0); PG8_MMA(1, 0, At, B0); PG8_BAR; PG8_SCHED;
            PG8_STAGE(PG8_SB(0, 1), b2 + hstepB, voffB);
            PG8_WAIT_V(6); PG8_BAR; PG8_MMA(1, 1, At, B1); PG8_BAR;
            PG8_LDB(B0, 1, 0); PG8_SCHED; PG8_LDA(At, 1, 0); PG8_STAGE(PG8_SA(0, 1), a2 + hstepA, voffA);
            PG8_WAIT_L(8); PG8_BAR; PG8_WAIT_L(0); PG8_MMA(0, 0, At, B0); PG8_BAR; PG8_SCHED;
            PG8_LDB(B1, 1, 1); PG8_STAGE(PG8_SB(1, 0), b3, voffB);
            PG8_BAR; PG8_WAIT_L(0); PG8_MMA(0, 1, At, B1); PG8_BAR;
            PG8_LDA(At, 1, 1); PG8_STAGE(PG8_SA(1, 0), a3, voffA);
            PG8_BAR; PG8_WAIT_L(0); PG8_MMA(1, 0, At, B0); PG8_BAR; PG8_SCHED;
            PG8_STAGE(PG8_SB(1, 1), b3 + hstepB, voffB);
            PG8_WAIT_V(6); PG8_BAR; PG8_MMA(1, 1, At, B1); PG8_BAR;
            }
        }
        if constexpr (ALIGN_EPI) { if (wr == 0) PG8_BAR; }
        if constexpr (!Epi::AFTER_DRAIN) { E(acc, cur, wr, wc, fr, fq); S.done(cur); }
        if (!has_next) break;
#pragma unroll
        for (int a = 0; a < 2; ++a)
#pragma unroll
            for (int b = 0; b < 2; ++b)
#pragma unroll
                for (int m = 0; m < 4; ++m)
#pragma unroll
                    for (int n = 0; n < 2; ++n) acc[a][b][m][n] = (f32x4){0.f, 0.f, 0.f, 0.f};
        cur = nxt; cA = nA; cB = nB; ++ui;
        if constexpr (ALIGN_EPI) { if (wr == 1) PG8_BAR; }
    }
    PG8_WAIT_V(0);
    if constexpr (!ALIGN_EPI) { if (wr == 0) PG8_BAR; }
    PG8_BAR;
    if constexpr (Epi::AFTER_DRAIN) { E.fused(acc, cur, wr, wc, fr, fq, lds, wid, lane); S.done(cur); }
#undef PG8_SA
#undef PG8_SB
#undef PG8_STAGE
#undef PG8_LDA
#undef PG8_LDB
#undef PG8_MMA
#undef PG8_WAIT_V
#undef PG8_WAIT_L
#undef PG8_BAR
#undef PG8_SCHED
}
}

constexpr int NB = 8, SEQ = 4096, T = NB * SEQ, D = 1024, DEPTH = 4, NZ = 7680, NWAVES = 8;
constexpr int CIN = 7424;
constexpr size_t MiB = 1u << 20;
constexpr size_t WS_CTL = 0, WS_LORA = 1 * MiB, WS_MV = 7 * MiB, ZERO_BYTES = 9 * MiB;
constexpr size_t LORA_BYTES = 3072 * 256 * 2, MV_BYTES = 1024 * 256 * 2;
constexpr size_t WS_WIN = 10 * MiB;
constexpr size_t WS_DB = 40 * MiB, DB_SET = 62 * MiB;
constexpr size_t DB_PA = 0, DB_PBT = 2 * MiB, DB_POUT = 4 * MiB, DB_WQG = 6 * MiB, DB_KEYS = 12 * MiB, DB_GMW = 12 * MiB + 512 * 1024, DB_PLEW = 13 * MiB, DB_U = 14 * MiB, DB_V = 30 * MiB, DB_PB = 46 * MiB;
constexpr size_t WS_VF = 164 * MiB, WS_PW = 228 * MiB, WS_NX = 292 * MiB, WS_ZRKV = 420 * MiB, WS_ZL = 612 * MiB, WS_GUV = 644 * MiB, WS_SG = 772 * MiB;
constexpr size_t WS_EW = 900 * MiB, WS_AR = 964 * MiB, WS_G = 1028 * MiB, WS_WINB = 1092 * MiB, WINB_BYTES = 4 * MiB, WS_END = 1100 * MiB;
constexpr size_t WS_Q = WS_ZRKV, WS_SEL = WS_ZRKV + 128 * MiB, WS_MG = WS_AR, WS_N2 = WS_G;
constexpr size_t WIN_ZERO_OFF = WS_WIN + (size_t)3328 * 2048 * 2, WIN_ZERO_BYTES = (size_t)256 * 2048 * 2;
#ifndef ZSPLIT
#define ZSPLIT 2
#endif
constexpr int CW_BAR = 4096;
constexpr int RING_BYTES = 131072, LDSCTL_OFF = RING_BYTES, MISC_OFF = LDSCTL_OFF + 320, LDS_BYTES = 147456;

#define LAS __attribute__((address_space(3)))
#define GAS __attribute__((address_space(1)))
typedef unsigned short bf16;
typedef unsigned v4u __attribute__((ext_vector_type(4)));
typedef unsigned v2u __attribute__((ext_vector_type(2)));
typedef float f32x4 __attribute__((ext_vector_type(4)));
typedef float f32x2 __attribute__((ext_vector_type(2)));
typedef short bf16x8 __attribute__((ext_vector_type(8)));
using pg8::fsig; using pg8::fgelu; using pg8::bflo; using pg8::bfhi; using pg8::unpk8; using pg8::pk8; using pg8::cvt_pk_bf16;

#define XB_TMO      128
#define XB_XCNT(j)  (256  + 64 * (j))
#define XB_XSUB(j)  (1280 + 64 * (j))
#define XB_XGEN(j)  (2304 + 64 * (j))
#define XB_TOP      3328
#define XB_TOPGEN   3392
#define XCD_BAR_WORDS 3456
#define XB_SPIN_CAP (1u << 22)

__device__ __forceinline__ unsigned xb_ld(unsigned* p)              { return __hip_atomic_load(p, __ATOMIC_RELAXED, __HIP_MEMORY_SCOPE_AGENT); }
__device__ __forceinline__ unsigned xb_add(unsigned* p, unsigned v) { return __hip_atomic_fetch_add(p, v, __ATOMIC_RELAXED, __HIP_MEMORY_SCOPE_AGENT); }
__device__ __forceinline__ unsigned xb_xcc_id() { return (unsigned)__builtin_amdgcn_s_getreg((3 << 11) | 20) & 0xFu; }
#define XB_SPIN(cond, bar) do { unsigned _sp = 0; while (cond) { __builtin_amdgcn_s_sleep(1); \
    if ((++_sp & 255u) == 0u) { if (xb_ld(&(bar)[XB_TMO])) break; if (_sp > XB_SPIN_CAP) { atomicAdd(&(bar)[XB_TMO], 1u); break; } } } } while (0)

struct XcdBarrier { unsigned* bar; unsigned x; volatile LAS unsigned* st; };

__device__ __forceinline__ XcdBarrier xcd_barrier_post(unsigned* bar, volatile LAS unsigned* st) {
    XcdBarrier b; b.bar = bar; b.x = xb_xcc_id(); b.st = st;
    if (threadIdx.x == 0) (void)xb_add(&bar[XB_XCNT(b.x)], 1u);
    return b;
}
__device__ __forceinline__ void xcd_barrier_complete(unsigned* bar, unsigned x, unsigned& nloc, unsigned& nx) {
    const unsigned G = gridDim.x * gridDim.y * gridDim.z;
    unsigned sum, cnt, mine, sp = 0u;
    for (;;) {
        sum = 0u; cnt = 0u; mine = 0u;
#pragma unroll
        for (unsigned j = 0; j < 16; ++j) { const unsigned c = xb_ld(&bar[XB_XCNT(j)]); sum += c; cnt += (c > 0u) ? 1u : 0u; mine = (j == x) ? c : mine; }
        if (sum == G) break;
        __builtin_amdgcn_s_sleep(1);
        if ((++sp & 255u) == 0u) { if (xb_ld(&bar[XB_TMO])) break; if (sp > XB_SPIN_CAP) { atomicAdd(&bar[XB_TMO], 1u); break; } }
    }
    nloc = mine > 0u ? mine : 1u; nx = cnt > 0u ? cnt : 1u;
}
__device__ __forceinline__ int lane_id_now();
__device__ __forceinline__ void xcd_barrier(const XcdBarrier& b, const int wave0) {
    asm volatile("s_waitcnt vmcnt(0)" ::: "memory");
    __syncthreads();
    if (wave0 == 0 && lane_id_now() == 0) {
        unsigned* bar = b.bar;
        __builtin_amdgcn_s_waitcnt(0);
        unsigned nloc = b.st[0], nx = b.st[1];
        if (nloc == 0u) { xcd_barrier_complete(bar, b.x, nloc, nx); b.st[0] = nloc; b.st[1] = nx; }
        const unsigned old = xb_add(&bar[XB_XSUB(b.x)], 1u);
        const unsigned gen = old / nloc;
        if (old + 1u == (gen + 1u) * nloc) {
            __builtin_amdgcn_fence(__ATOMIC_RELEASE, "agent");
            asm volatile("s_waitcnt vmcnt(0)" ::: "memory");
            const unsigned og = xb_add(&bar[XB_TOP], 1u);
            const unsigned tg = og / nx;
            if (og + 1u == (tg + 1u) * nx) xb_add(&bar[XB_TOPGEN], 1u);
            else XB_SPIN(xb_ld(&bar[XB_TOPGEN]) == tg, bar);
            __builtin_amdgcn_fence(__ATOMIC_ACQUIRE, "agent");
            xb_add(&bar[XB_XGEN(b.x)], 1u);
            asm volatile("s_waitcnt vmcnt(0)" ::: "memory");
        } else {
            XB_SPIN(xb_ld(&bar[XB_XGEN(b.x)]) == gen, bar);
            __builtin_amdgcn_fence(__ATOMIC_ACQUIRE, "agent");
            asm volatile("s_waitcnt vmcnt(0)" ::: "memory");
        }
    }
    __syncthreads();
}

struct Args { const float* in[32]; float* out; unsigned char* ws; };
struct Frame {
    LAS unsigned char* lds;
    int tid, lane, wave, G, bx, wave0;
    GAS unsigned char* ws; float* h;
};
__device__ __forceinline__ int lane_id_now() { int l; asm volatile("v_mbcnt_lo_u32_b32 %0, -1, 0\n\tv_mbcnt_hi_u32_b32 %0, -1, %0" : "=v"(l)); return l; }
__device__ __forceinline__ void phase_ids(Frame& F) { const int l = lane_id_now(); F.lane = l; F.wave = F.wave0; F.tid = F.wave0 * 64 + l; GAS unsigned char* w = F.ws; asm volatile("" : "+s"(w)); F.ws = w; }
#define DPP_ADD(x, ctrl) ((x) + __builtin_bit_cast(float, __builtin_amdgcn_update_dpp(0, __builtin_bit_cast(int, (x)), (ctrl), 0xf, 0xf, false)))
__device__ __forceinline__ float sum8(float v) {
    v = DPP_ADD(v, 0xB1);
    v = DPP_ADD(v, 0x4E);
    v = DPP_ADD(v, 0x141);
    return v;
}
__device__ __forceinline__ float sum16(float v) { v = sum8(v); v = DPP_ADD(v, 0x140); return v; }
#define DPP_ADD_NS(x, ctrl) do { (x) = DPP_ADD((x), (ctrl)); asm("" : "+v"(x)); } while (0)
__device__ __forceinline__ float sum16_ns(float v) { DPP_ADD_NS(v, 0xB1); DPP_ADD_NS(v, 0x4E); DPP_ADD_NS(v, 0x141); DPP_ADD_NS(v, 0x140); return v; }
__device__ __forceinline__ float wave_sum(float v) {
    v = sum8(v);
    v = DPP_ADD(v, 0x140);
    const auto r = __builtin_amdgcn_permlane16_swap(__builtin_bit_cast(unsigned, v), __builtin_bit_cast(unsigned, v), false, false);
    v = __builtin_bit_cast(float, (unsigned)r[0]) + __builtin_bit_cast(float, (unsigned)r[1]);
    const auto q = __builtin_amdgcn_permlane32_swap(__builtin_bit_cast(unsigned, v), __builtin_bit_cast(unsigned, v), false, false);
    return __builtin_bit_cast(float, (unsigned)q[0]) + __builtin_bit_cast(float, (unsigned)q[1]);
}
__device__ __forceinline__ unsigned xor16_u(unsigned x, int lane) { const auto r = __builtin_amdgcn_permlane16_swap(x, x, false, false); return (lane & 16) ? (unsigned)r[0] : (unsigned)r[1]; }
__device__ __forceinline__ unsigned xor32_u(unsigned x, int lane) { const auto r = __builtin_amdgcn_permlane32_swap(x, x, false, false); return (lane & 32) ? (unsigned)r[0] : (unsigned)r[1]; }
__device__ __forceinline__ void tr_item(const float* W, int ldw, int ncols, bf16* WT, int ldt, int koff, int row_off, LAS float* scr, int item, int lane) {
    const int nblk = ncols / 32, kb = item / nblk, nb = item % nblk, k0 = 64 * kb, n0 = 32 * nb;
#pragma unroll 8
    for (int i = 0; i < 32; ++i) { const int kk = 2 * i + (lane >> 5); scr[kk * 33 + (lane & 31)] = W[(size_t)(k0 + kk) * ldw + n0 + (lane & 31)]; }
    asm volatile("s_waitcnt lgkmcnt(0)" ::: "memory");
    const int c = lane & 7;
#pragma unroll
    for (int j = 0; j < 4; ++j) { const int n = (lane >> 3) + 8 * j; const LAS float* s = scr + (8 * c) * 33 + n;
        v4u o; o.x = cvt_pk_bf16(s[0 * 33], s[1 * 33]); o.y = cvt_pk_bf16(s[2 * 33], s[3 * 33]); o.z = cvt_pk_bf16(s[4 * 33], s[5 * 33]); o.w = cvt_pk_bf16(s[6 * 33], s[7 * 33]);
        *(v4u*)(WT + (size_t)(row_off + n0 + n) * ldt + koff + k0 + 8 * c) = o; }
    asm volatile("s_waitcnt lgkmcnt(0)" ::: "memory");
}
__device__ __forceinline__ void cvt_chunk(const float* src, bf16* dst, size_t chunk, int lane) {
    const f32x4* s = (const f32x4*)(src + chunk * 512) + lane * 2; const f32x4 a = s[0], b = s[1];
    *(v4u*)(dst + chunk * 512 + lane * 8) = pk8(a, b);
}
__device__ __forceinline__ void cvt8_chunk(const float* src, unsigned char* dst, size_t chunk, int lane, float sc) {
    const f32x4* s = (const f32x4*)(src + chunk * 512) + lane * 2; const f32x4 a = s[0] * sc, b = s[1] * sc;
    int w0 = 0, w1 = 0;
    w0 = __builtin_amdgcn_cvt_pk_fp8_f32(a.x, a.y, w0, false); w0 = __builtin_amdgcn_cvt_pk_fp8_f32(a.z, a.w, w0, true);
    w1 = __builtin_amdgcn_cvt_pk_fp8_f32(b.x, b.y, w1, false); w1 = __builtin_amdgcn_cvt_pk_fp8_f32(b.z, b.w, w1, true);
    *(v2u*)(dst + chunk * 512 + lane * 8) = (v2u){(unsigned)w0, (unsigned)w1};
}
__device__ __forceinline__ void norm_row_nx(const float* hrow, float* hcopy, const float* g, bf16* NX, int t, int lane) {
    const f32x4* xr = (const f32x4*)hrow + lane; f32x4 v[4]; float s = 0.f;
#pragma unroll
    for (int j = 0; j < 4; ++j) { v[j] = xr[64 * j]; s += (v[j].x * v[j].x + v[j].y * v[j].y) + (v[j].z * v[j].z + v[j].w * v[j].w); }
    if (hcopy) {
#pragma unroll
        for (int j = 0; j < 4; ++j) ((f32x4*)hcopy)[lane + 64 * j] = v[j]; }
    const float rstd = 1.f / sqrtf(wave_sum(s) * (1.f / D) + 1e-6f);
    const int tt = t & (SEQ - 1);
#pragma unroll
    for (int j = 0; j < 4; ++j) { const f32x4 gv = ((const f32x4*)g)[lane + 64 * j]; const f32x4 o = v[j] * rstd * gv;
        v2u w; w.x = cvt_pk_bf16(o.x, o.y); w.y = cvt_pk_bf16(o.z, o.w);
        const int c = 4 * (lane + 64 * j);
        *(v2u*)(NX + (size_t)t * 2048 + c) = w;
        if (tt != SEQ - 1) *(v2u*)(NX + (size_t)(t + 1) * 2048 + 1024 + c) = w;
        if (tt == 0) *(v2u*)(NX + (size_t)t * 2048 + 1024 + c) = (v2u){0u, 0u}; }
}
__device__ __forceinline__ void norm_row_n2x2(const float* hrow0, const float* hrow1, const float* g, bf16* o0, bf16* o1, int lane) {
    const f32x4* x0 = (const f32x4*)hrow0 + lane; const f32x4* x1 = (const f32x4*)hrow1 + lane; f32x4 v[2][4]; float s0 = 0.f, s1 = 0.f;
#pragma unroll
    for (int j = 0; j < 4; ++j) { v[0][j] = x0[64 * j]; v[1][j] = x1[64 * j]; }
#pragma unroll
    for (int j = 0; j < 4; ++j) { s0 += (v[0][j].x * v[0][j].x + v[0][j].y * v[0][j].y) + (v[0][j].z * v[0][j].z + v[0][j].w * v[0][j].w);
                                  s1 += (v[1][j].x * v[1][j].x + v[1][j].y * v[1][j].y) + (v[1][j].z * v[1][j].z + v[1][j].w * v[1][j].w); }
    const float r0 = 1.f / sqrtf(wave_sum(s0) * (1.f / D) + 1e-6f), r1 = 1.f / sqrtf(wave_sum(s1) * (1.f / D) + 1e-6f);
#pragma unroll
    for (int j = 0; j < 4; ++j) { const f32x4 gv = ((const f32x4*)g)[lane + 64 * j]; const f32x4 a = v[0][j] * r0 * gv, b = v[1][j] * r1 * gv;
        *(v2u*)(o0 + 4 * (lane + 64 * j)) = (v2u){cvt_pk_bf16(a.x, a.y), cvt_pk_bf16(a.z, a.w)}; *(v2u*)(o1 + 4 * (lane + 64 * j)) = (v2u){cvt_pk_bf16(b.x, b.y), cvt_pk_bf16(b.z, b.w)}; }
}
__device__ __forceinline__ void prep_phase(Frame& F, const Args& a, int layer, int blk, int nblk_, int part) {
    phase_ids(F);
    LAS float* scr = (LAS float*)(F.lds + F.wave * 16384);
    const int gw = blk * NWAVES + F.wave, NGW = nblk_ * NWAVES, lane = F.lane;
    GAS unsigned char* ws = F.ws; GAS unsigned char* db = F.ws + WS_DB + (size_t)(layer & 1) * DB_SET;
    bf16* WIN = (bf16*)(ws + WS_WIN); bf16* LORA = (bf16*)(ws + WS_LORA + (size_t)layer * LORA_BYTES); bf16* MVT = (bf16*)(ws + WS_MV + (size_t)(layer > 0 ? layer - 1 : 0) * MV_BYTES);
    const float* w_in = a.in[5] + (size_t)layer * 2048 * CIN;
    const int mvn = layer > 0 ? 32 : 0;
    const int c1 = 32 * 104, c2a = 32 * 64, c2b = 32 * 32, c2c = 32 * (32 - 8 * ZSPLIT), c2d = 32 * 8 * ZSPLIT, c2 = c2a + 2 * c2b, c3 = mvn, c4 = 32, c5 = 32, c6 = 64, c7 = 512, c10 = 1024, c12 = 128;
    const int total = (part & 1) ? c1 + c2 + c3 + c4 + c5 + c6 + 3 * c7 + c10 + c7 + c12 : 0;
    for (int it = gw; it < total; it += NGW) {
        int r = it;
        if (r < c1) { tr_item(w_in, CIN, 3328, WIN, 2048, 0, 0, scr, r, lane); continue; } r -= c1;
        if (r < c2a) { tr_item(w_in + 3328, CIN, 2048, WIN, 2048, 0, 3584, scr, r, lane); continue; } r -= c2a;
        if (r < c2b) { tr_item(w_in + 6400, CIN, 1024, WIN, 2048, 0, 5632, scr, r, lane); continue; } r -= c2b;
        if (r < c2c) { tr_item(w_in + 5376, CIN, 1024 - 256 * ZSPLIT, WIN, 2048, 0, 6656, scr, r, lane); continue; } r -= c2c;
        if (r < c2d) { tr_item(w_in + 6400 - 256 * ZSPLIT, CIN, 256 * ZSPLIT, (bf16*)(ws + WS_WINB + (size_t)(layer & 1) * WINB_BYTES), 2048, 0, 0, scr, r, lane); continue; } r -= c2d;
        if (r < c3) { tr_item(a.in[16] + (size_t)(layer - 1) * 2048 * 32, 32, 32, WIN, 2048, 0, 3328, scr, r, lane); continue; } r -= c3;
        if (r < c4) { tr_item(a.in[7] + (size_t)layer * 64 * 1024, 1024, 1024, LORA, 128, 0, 0, scr, r, lane); continue; } r -= c4;
        if (r < c5) { tr_item(a.in[9] + (size_t)layer * 64 * 1024, 1024, 1024, LORA, 128, 64, 1024, scr, r, lane); continue; } r -= c5;
        if (r < c6) { tr_item(a.in[10] + (size_t)layer * 128 * 1024, 1024, 1024, LORA + 2048 * 128, 128, 0, 0, scr, r, lane); continue; } r -= c6;
        if (r < c7) { tr_item(a.in[23] + (size_t)layer * D * D, D, D, (bf16*)(db + DB_PA), D, 0, 0, scr, r, lane); continue; } r -= c7;
        if (r < c7) { tr_item(a.in[24] + (size_t)layer * D * D, D, D, (bf16*)(db + DB_PBT), D, 0, 0, scr, r, lane); continue; } r -= c7;
        if (r < c7) { tr_item(a.in[25] + (size_t)layer * D * D, D, D, (bf16*)(db + DB_POUT), D, 0, 0, scr, r, lane); continue; } r -= c7;
        if (r < c10) { tr_item(a.in[26] + (size_t)layer * D * 2048, 2048, 2048, (bf16*)(db + DB_WQG), D, 0, 0, scr, r, lane); continue; } r -= c10;
        if (r < c7) { tr_item(a.in[31] + (size_t)layer * D * D, D, D, (bf16*)(db + DB_WQG), D, 0, 2048, scr, r, lane); continue; } r -= c7;
        tr_item(a.in[30] + (size_t)layer * 256 * D, D, D, (bf16*)(db + DB_PLEW), 256, 0, 0, scr, r, lane);
    }
    if (layer > 0 && (part & 1)) {
        const float* w2 = a.in[17] + (size_t)(layer - 1) * 32 * 1024;
        for (int it = gw; it < 512; it += NGW) { const int e = it * 64 + lane, n = e >> 5, k = e & 31; MVT[n * 128 + k] = (bf16)(cvt_pk_bf16(w2[k * 1024 + n], 0.f) & 0xffffu); }
    }
    {
        const float* keys = a.in[27] + (size_t)layer * 262144; const float* ut = a.in[28] + (size_t)layer * 16777216; const float* vt = a.in[29] + (size_t)layer * 16777216;
        const float* pin = a.in[1] + (size_t)layer * T * 256; const float* gws = a.in[21] + (size_t)layer * 131072;
        const int n1 = (part & 1) ? 512 : 0, n2 = (part & 2) ? 32768 : 0, n4 = (part & 1) ? 16384 : 0, n5 = (part & 1) ? 256 : 0, ntot = n1 + 2 * n2 + n4 + n5;
        for (int it = gw; it < ntot; it += NGW) {
            int r = it;
            if (r < n2) { cvt8_chunk(ut, (unsigned char*)(db + DB_U), r, lane, 256.f); continue; } r -= n2;
            if (r < n2) { cvt8_chunk(vt, (unsigned char*)(db + DB_V), r, lane, 64.f); continue; } r -= n2;
            if (r < n4) { cvt_chunk(pin, (bf16*)(db + DB_PB), r, lane); continue; } r -= n4;
            if (r < n1) { cvt_chunk(keys, (bf16*)(db + DB_KEYS), r, lane); continue; } r -= n1;
            {
                const int e0 = r * 512 + lane * 8, tq = (e0 >> 7) & 127, p0 = e0 & 127;
                const f32x4* s = (const f32x4*)(gws + e0); f32x4 x0 = s[0], x1 = s[1];
#pragma unroll
                for (int j = 0; j < 4; ++j) { if (p0 + j > tq) x0[j] = 0.f; if (p0 + 4 + j > tq) x1[j] = 0.f; }
                *(v4u*)((bf16*)(db + DB_GMW) + e0) = pk8(x0, x1);
            }
        }
    }
    if (layer == 0 && (part & 1)) {
        for (int m = gw; m < T; m += NGW) norm_row_nx(a.in[0] + (size_t)m * D, F.h + (size_t)m * D, a.in[2], (bf16*)(ws + WS_NX), m, lane);
    }
}

constexpr int SC = 32, NPR = SC / 2;
constexpr int SC_VEC = SC * 64;
constexpr int SC_WW = 0, SC_VQ = NPR * 64, SC_BK = SC_VQ + NPR * 256, SC_XA = SC_BK + NPR * 128, SC_C = SC_XA + NPR * 128, SC_VP = SC_C + NPR * 20, SC_BON = SC_VP + SC * 64, SC_BUF = SC_BON + SC * 8;
static_assert(SC_BUF % 4 == 0 && SC_C % 4 == 0 && (2 * SC_BUF + 2 * SC_VEC) * 4 + 64 <= 131072, "scan LDS map");
struct ScanOps { f32x4 w[4], vq, c[4]; v4u bk[2]; bf16x8 x[2]; };
__device__ __forceinline__ void scan_load2(ScanOps& o, const LAS float* buf, const LAS float* vqp, const LAS unsigned char* bkp, int bkstep, int p, int lane) {
    const int q = lane >> 4;
    const LAS float* wp = buf + SC_WW + p * 64 + q * 4;
#pragma unroll
    for (int i = 0; i < 4; ++i) o.w[i] = *(const LAS f32x4*)(wp + 16 * i);
    o.vq = *(const LAS f32x4*)(vqp + p * 256);
    o.bk[0] = *(const LAS v4u*)(bkp + p * bkstep); o.bk[1] = *(const LAS v4u*)(bkp + p * bkstep + 16);
    const LAS unsigned char* xp = (const LAS unsigned char*)(buf + SC_XA) + p * 512 + (lane & 3) * 128 + q * 16;
    o.x[0] = *(const LAS bf16x8*)xp; o.x[1] = *(const LAS bf16x8*)(xp + 64);
#pragma unroll
    for (int i = 0; i < 4; ++i) o.c[i] = *(const LAS f32x4*)(buf + SC_C + p * 20 + 4 * i);
}
__device__ __forceinline__ const char* uni_ptr(const char* p) { const unsigned long long a = (unsigned long long)p;
    const unsigned lo = (unsigned)__builtin_amdgcn_readfirstlane((int)(unsigned)a), hi = (unsigned)__builtin_amdgcn_readfirstlane((int)(unsigned)(a >> 32));
    return (const char*)(((unsigned long long)hi << 32) | lo); }
__device__ __forceinline__ float smul(float a, float b) { float r; asm("v_mul_f32 %0, %1, %2" : "=v"(r) : "v"(a), "v"(b)); return r; }
__device__ __forceinline__ void scan_pair(const ScanOps& o, f32x4 (&St)[4], float& sa0, float& sa1, v4u (&am)[4], v4u& bm, LAS float* ypt, int ystep, unsigned m16) {
    v4u s0, s1;
    s0.x = cvt_pk_bf16(St[0].x, St[0].y); s0.y = cvt_pk_bf16(St[0].z, St[0].w); s0.z = cvt_pk_bf16(St[1].x, St[1].y); s0.w = cvt_pk_bf16(St[1].z, St[1].w);
    s1.x = cvt_pk_bf16(St[2].x, St[2].y); s1.y = cvt_pk_bf16(St[2].z, St[2].w); s1.z = cvt_pk_bf16(St[3].x, St[3].y); s1.w = cvt_pk_bf16(St[3].z, St[3].w);
    f32x4 dv = (f32x4){0.f, 0.f, 0.f, 0.f};
    dv = __builtin_amdgcn_mfma_f32_16x16x32_bf16(o.x[0], __builtin_bit_cast(bf16x8, s0), dv, 0, 0, 0);
    dv = __builtin_amdgcn_mfma_f32_16x16x32_bf16(o.x[1], __builtin_bit_cast(bf16x8, s1), dv, 0, 0, 0);
    const float v0 = o.vq.x, v1 = o.vq.y, v2 = o.vq.z;
    typedef short s16x4 __attribute__((ext_vector_type(4)));
    const v2u bm2 = (v2u){cvt_pk_bf16(sa0, v0) & m16, cvt_pk_bf16(sa1, v1) & m16};
#pragma unroll
    for (int i = 0; i < 4; ++i) { const v2u a2 = (v2u){o.bk[i >> 1][(i & 1) * 2], o.bk[i >> 1][(i & 1) * 2 + 1]};
        St[i] = __builtin_amdgcn_mfma_f32_16x16x16bf16_1k(__builtin_bit_cast(s16x4, a2), __builtin_bit_cast(s16x4, bm2),
                                                        (f32x4){smul(St[i].x, o.w[i].x), smul(St[i].y, o.w[i].y), smul(St[i].z, o.w[i].z), smul(St[i].w, o.w[i].w)}, 0, 0, 0); }
    ypt[0]     = dv.z + sa0 * o.c[2].z + v0 * o.c[2].w;
    ypt[ystep] = dv.w + sa0 * o.c[3].x + v0 * o.c[3].y + sa1 * o.c[3].z + v1 * o.c[3].w;
    const float n0 = dv.x + sa0 * o.c[0].x + v0 * o.c[0].y + sa1 * o.c[0].z + v1 * o.c[0].w;
    const float n1 = dv.y + sa0 * o.c[1].x + v0 * o.c[1].y + sa1 * o.c[1].z + v1 * o.c[1].w + n0 * o.c[2].x + v2 * o.c[2].y;
    sa0 = n0; sa1 = n1;
}
__device__ __forceinline__ void scan_unit(Frame& F, const Args& a, int layer, int unit) {
    phase_ids(F);
    const int b = unit >> 4, hh = unit & 15, tid = F.tid, lane = F.lane, wave = F.wave;
    LAS float* bufs = (LAS float*)F.lds;
    LAS float* sY = bufs + 2 * SC_BUF;
    const bf16* ZR = (const bf16*)(F.ws + WS_ZRKV); const bf16* EW = (const bf16*)(F.ws + WS_EW); const bf16* AR = (const bf16*)(F.ws + WS_AR); const bf16* GT = (const bf16*)(F.ws + WS_G);
    bf16* YA = (bf16*)(F.ws + WS_G);
    constexpr int NCH = SEQ / SC;
    if (wave < 4) {
        f32x4 St[4]; v4u am[4], bm = (v4u){0u, 0u, 0u, 0u};
#pragma unroll
        for (int i = 0; i < 4; ++i) { St[i] = (f32x4){0.f, 0.f, 0.f, 0.f}; am[i] = (v4u){0u, 0u, 0u, 0u}; }
        float sa0 = 0.f, sa1 = 0.f;
        const unsigned m16 = lane < 16 ? 0xffffffffu : 0u;
        LAS unsigned char* zblk = (LAS unsigned char*)(sY + 2 * SC_VEC);
        if (tid < 8) ((LAS unsigned*)zblk)[tid] = 0u;
        const int bkstep = lane < 16 ? 512 : 0;
        for (int it = 0; it < NCH + 2; ++it) {
            if (it >= 1 && it <= NCH) {
                const LAS float* bufc = bufs + ((it - 1) & 1) * SC_BUF;
                const LAS float* vqp = bufc + SC_VQ + 4 * (wave * 16 + (lane & 15));
                const LAS unsigned char* bkp = lane < 16 ? (const LAS unsigned char*)(bufc + SC_BK) + lane * 32 : (const LAS unsigned char*)zblk;
                LAS float* yb = lane < 16 ? sY + ((it - 1) & 1) * SC_VEC + wave * 16 + lane : (LAS float*)(zblk + 32);
                const int ystep = lane < 16 ? 64 : 0;
                if (it == 1) { sa0 = 0.f; sa1 = vqp[0] * bufc[SC_C + 16]; }
                ScanOps o0, o1;
                scan_load2(o0, bufc, vqp, bkp, bkstep, 0, lane);
#pragma unroll 1
                for (int p = 0; p < NPR; p += 2) {
                    scan_load2(o1, bufc, vqp, bkp, bkstep, p + 1, lane);
                    scan_pair(o0, St, sa0, sa1, am, bm, yb + (2 * p) * ystep, ystep, m16);
                    if (p + 2 < NPR) scan_load2(o0, bufc, vqp, bkp, bkstep, p + 2, lane);
                    scan_pair(o1, St, sa0, sa1, am, bm, yb + (2 * p + 2) * ystep, ystep, m16);
                }
            }
            __syncthreads();
        }
    } else {
        const int ht = tid - 256, tl = ht >> 3, c8 = ht & 7, ch = hh * 64 + c8 * 8;
        const int pr = ht >> 4, c4 = ht & 15, chp = hh * 64 + c4 * 4;
        const size_t po = (size_t)layer * 1024 + ch, pop = (size_t)layer * 1024 + chp;
        struct HelpIn { v2u r0, k0, v0, e0, a0, r1, k1, v1, e1, a1, k2, v2, e2, a2, k3; v4u gt; };
        HelpIn cur, nxt;
#define HELP_ROW(H, F_, RR, OFF, ARR, PITCH) (H).F_ = *(const v2u*)((ARR) + ((size_t)b * SEQ + (RR)) * (PITCH) + (OFF) + chp)
#define HELP_LOAD(H, PC, GC) do { \
            if ((PC) < NCH) { const int _t = (PC) * SC + 2 * pr; \
                HELP_ROW(H, r0, _t, 0, ZR, 3072); HELP_ROW(H, k0, _t, 1024, ZR, 3072); HELP_ROW(H, v0, _t, 2048, ZR, 3072); HELP_ROW(H, e0, _t, 0, EW, 1024); HELP_ROW(H, a0, _t, 0, AR, 1024); \
                HELP_ROW(H, r1, _t + 1, 0, ZR, 3072); HELP_ROW(H, k1, _t + 1, 1024, ZR, 3072); HELP_ROW(H, v1, _t + 1, 2048, ZR, 3072); HELP_ROW(H, e1, _t + 1, 0, EW, 1024); HELP_ROW(H, a1, _t + 1, 0, AR, 1024); \
                HELP_ROW(H, k2, _t + 2, 1024, ZR, 3072); HELP_ROW(H, v2, _t + 2, 2048, ZR, 3072); HELP_ROW(H, e2, _t + 2, 0, EW, 1024); HELP_ROW(H, a2, _t + 2, 0, AR, 1024); \
                HELP_ROW(H, k3, _t + 3, 1024, ZR, 3072); } \
            if ((GC) >= 0 && (GC) < NCH) { const size_t _row = (size_t)b * SEQ + (size_t)(GC) * SC + tl; (H).gt = *(const v4u*)(GT + _row * 1024 + ch); } } while (0)
#define UNP4(W) ((f32x4){bflo((W).x), bfhi((W).x), bflo((W).y), bfhi((W).y)})
#define EXP4(E) ((f32x4){__builtin_amdgcn_exp2f(-1.44269504f * (E).x), __builtin_amdgcn_exp2f(-1.44269504f * (E).y), __builtin_amdgcn_exp2f(-1.44269504f * (E).z), __builtin_amdgcn_exp2f(-1.44269504f * (E).w)})
#define DOT4(A, B) (((A).x * (B).x + (A).y * (B).y) + ((A).z * (B).z + (A).w * (B).w))
#define SUM16(X) sum16_ns(X)
#ifdef PROBE_SCAN
        unsigned long long ph_act = 0ull;
#endif
        HELP_LOAD(cur, 0, -2);
        for (int it = 0; it < NCH + 2; ++it) {
#ifdef PROBE_SCAN
            const unsigned long long ph0 = __builtin_amdgcn_s_memtime();
#endif
            HELP_LOAD(nxt, it + 1, it - 1);
            if (it >= 2) {
                const LAS float* buf = bufs + (it & 1) * SC_BUF; const LAS float* yb = sY + (it & 1) * SC_VEC;
                const size_t row = (size_t)b * SEQ + (size_t)(it - 2) * SC + tl; const int o = tl * 64 + c8 * 8;
                f32x4 y_[2], v_[2], g_[2];
#pragma unroll
                for (int i = 0; i < 2; ++i) { y_[i] = *(const LAS f32x4*)(yb + o + 4 * i); v_[i] = *(const LAS f32x4*)(buf + SC_VP + o + 4 * i); }
                const float bon = buf[SC_BON + tl * 8 + c8];
                unpk8(cur.gt, g_[0], g_[1]);
                const float s1 = ((y_[0].x + y_[0].y) + (y_[0].z + y_[0].w)) + ((y_[1].x + y_[1].y) + (y_[1].z + y_[1].w));
                const float mu = sum8(s1) * (1.f / 64.f);
                float s2 = 0.f;
#pragma unroll
                for (int i = 0; i < 2; ++i) { y_[i] = y_[i] - mu; const f32x4 q = y_[i] * y_[i]; s2 += (q.x + q.y) + (q.z + q.w); }
                const float rstd = __builtin_amdgcn_rsqf(sum8(s2) * (1.f / 64.f) + 64e-5f);
                f32x4 o_[2];
#pragma unroll
                for (int i = 0; i < 2; ++i) o_[i] = (y_[i] * rstd * *(const f32x4*)(a.in[14] + po + 4 * i) + *(const f32x4*)(a.in[15] + po + 4 * i) + bon * v_[i]) * g_[i];
                *(v4u*)(YA + row * 1024 + ch) = pk8(o_[0], o_[1]);
            }
            if (it < NCH) {
                LAS float* buf = bufs + (it & 1) * SC_BUF;
                const f32x4 pkk_ = *(const f32x4*)(a.in[11] + pop), pka_ = *(const f32x4*)(a.in[12] + pop), prk_ = *(const f32x4*)(a.in[13] + pop);
                const f32x4 zk0 = UNP4(cur.k0), zk1 = UNP4(cur.k1), zk2 = UNP4(cur.k2), zk3 = UNP4(cur.k3);
                f32x4 kn0 = zk0 * pkk_, kn1 = zk1 * pkk_, kn2 = zk2 * pkk_, kn3 = zk3 * pkk_;
                kn0 = kn0 * __builtin_amdgcn_rsqf(fmaxf(SUM16(DOT4(kn0, kn0)), 1e-24f)); kn1 = kn1 * __builtin_amdgcn_rsqf(fmaxf(SUM16(DOT4(kn1, kn1)), 1e-24f));
                kn2 = kn2 * __builtin_amdgcn_rsqf(fmaxf(SUM16(DOT4(kn2, kn2)), 1e-24f)); kn3 = kn3 * __builtin_amdgcn_rsqf(fmaxf(SUM16(DOT4(kn3, kn3)), 1e-24f));
                const f32x4 r0 = UNP4(cur.r0), r1 = UNP4(cur.r1), v0 = UNP4(cur.v0), v1 = UNP4(cur.v1), v2 = UNP4(cur.v2);
                const f32x4 ar0 = UNP4(cur.a0), ar1 = UNP4(cur.a1), ar2 = UNP4(cur.a2);
                const f32x4 e0 = UNP4(cur.e0), e1 = UNP4(cur.e1), e2 = UNP4(cur.e2);
                const f32x4 w0 = EXP4(e0), w1 = EXP4(e1), w2 = EXP4(e2);
                const f32x4 a1v = -kn1, a2v = -kn2, a3v = -kn3;
                const f32x4 b0 = kn0 * ar0, b1 = kn1 * ar1, b2 = kn2 * ar2;
                const f32x4 kp0 = zk0 * (1.f + (ar0 - 1.f) * pka_), kp1 = zk1 * (1.f + (ar1 - 1.f) * pka_), kp2 = zk2 * (1.f + (ar2 - 1.f) * pka_);
                const f32x4 W2 = w0 * w1, Bt = b0 * w1, Kt = kp0 * w1, x0v = a2v, x1v = w2 * a3v;
                const f32x4 X0 = W2 * x0v, X1 = W2 * x1v, X2 = w0 * r0, X3 = W2 * r1;
                *(LAS f32x4*)(buf + SC_WW + pr * 64 + c4 * 4) = W2;
                *(LAS f32x4*)(buf + SC_VP + (2 * pr) * 64 + c4 * 4) = v0; *(LAS f32x4*)(buf + SC_VP + (2 * pr + 1) * 64 + c4 * 4) = v1;
                { LAS f32x4* vq = (LAS f32x4*)(buf + SC_VQ + pr * 256 + c4 * 16);
                  vq[0] = (f32x4){v0.x, v1.x, v2.x, 0.f}; vq[1] = (f32x4){v0.y, v1.y, v2.y, 0.f}; vq[2] = (f32x4){v0.z, v1.z, v2.z, 0.f}; vq[3] = (f32x4){v0.w, v1.w, v2.w, 0.f}; }
                { LAS v2u* bkp = (LAS v2u*)(buf + SC_BK + pr * 128) + (((c4 & 3) * 4) * 4 + (c4 >> 2));
                  bkp[0] = (v2u){cvt_pk_bf16(Bt.x, Kt.x), cvt_pk_bf16(b1.x, kp1.x)}; bkp[4] = (v2u){cvt_pk_bf16(Bt.y, Kt.y), cvt_pk_bf16(b1.y, kp1.y)};
                  bkp[8] = (v2u){cvt_pk_bf16(Bt.z, Kt.z), cvt_pk_bf16(b1.z, kp1.z)}; bkp[12] = (v2u){cvt_pk_bf16(Bt.w, Kt.w), cvt_pk_bf16(b1.w, kp1.w)}; }
                { LAS unsigned char* xp = (LAS unsigned char*)(buf + SC_XA) + pr * 512 + (c4 >> 3) * 64 + (c4 & 3) * 16 + ((c4 >> 2) & 1) * 8;
                  *(LAS v2u*)xp = (v2u){cvt_pk_bf16(X0.x, X0.y), cvt_pk_bf16(X0.z, X0.w)}; *(LAS v2u*)(xp + 128) = (v2u){cvt_pk_bf16(X1.x, X1.y), cvt_pk_bf16(X1.z, X1.w)};
                  *(LAS v2u*)(xp + 256) = (v2u){cvt_pk_bf16(X2.x, X2.y), cvt_pk_bf16(X2.z, X2.w)}; *(LAS v2u*)(xp + 384) = (v2u){cvt_pk_bf16(X3.x, X3.y), cvt_pk_bf16(X3.z, X3.w)}; }
                const f32x4 ca = (f32x4){SUM16(DOT4(Bt, x0v)), SUM16(DOT4(Kt, x0v)), SUM16(DOT4(b1, x0v)), SUM16(DOT4(kp1, x0v))};
                const f32x4 cb = (f32x4){SUM16(DOT4(Bt, x1v)), SUM16(DOT4(Kt, x1v)), SUM16(DOT4(b1, x1v)), SUM16(DOT4(kp1, x1v))};
                const f32x4 cc = (f32x4){SUM16(DOT4(b2, a3v)), SUM16(DOT4(kp2, a3v)), SUM16(DOT4(b0, r0)), SUM16(DOT4(kp0, r0))};
                const f32x4 cd = (f32x4){SUM16(DOT4(Bt, r1)), SUM16(DOT4(Kt, r1)), SUM16(DOT4(b1, r1)), SUM16(DOT4(kp1, r1))};
                const float ci = SUM16(DOT4(kp0, a1v));
                const f32x4 z0 = r0 * kp0 * prk_, z1 = r1 * kp1 * prk_;
                const float bon0 = SUM16((z0.x + z0.y) + (z0.z + z0.w)), bon1 = SUM16((z1.x + z1.y) + (z1.z + z1.w));
                if (c4 == 0) { LAS f32x4* cp = (LAS f32x4*)(buf + SC_C + pr * 20); cp[0] = ca; cp[1] = cb; cp[2] = cc; cp[3] = cd; cp[4] = (f32x4){ci, 0.f, 0.f, 0.f}; }
                buf[SC_BON + (2 * pr) * 8 + (c4 >> 1)] = bon0; buf[SC_BON + (2 * pr + 1) * 8 + (c4 >> 1)] = bon1;
            }
            cur = nxt;
#ifdef PROBE_SCAN
            asm volatile("s_waitcnt vmcnt(0) lgkmcnt(0)" ::: "memory"); ph_act += __builtin_amdgcn_s_memtime() - ph0;
#endif
            __syncthreads();
        }
#ifdef PROBE_SCAN
        if (unit == 0 && layer == DEPTH - 1 && tid == 256) ((float*)(F.ws + WS_CTL))[2048 + 2] = rintf((float)ph_act / (float)(NCH + 2) * (1.f / 2000.f));
#endif
#undef HELP_LOAD
#undef HELP_ROW
#undef UNP4
#undef EXP4
#undef DOT4
#undef SUM16
    }
}

constexpr int TP = 136;
__device__ __forceinline__ void mma_128(const LAS bf16* sA, const LAS bf16* sBt, int wave, int lane, f32x4 (&acc)[4][2]) {
    const int wm = wave >> 2, wn = wave & 3, fr = lane & 15, fq = lane >> 4;
#pragma unroll
    for (int kk = 0; kk < 4; ++kk) {
        bf16x8 af[4], bf_[2];
#pragma unroll
        for (int mt = 0; mt < 4; ++mt) af[mt] = *(const LAS bf16x8*)(sA + (64 * wm + 16 * mt + fr) * TP + 32 * kk + 8 * fq);
#pragma unroll
        for (int nt = 0; nt < 2; ++nt) bf_[nt] = *(const LAS bf16x8*)(sBt + (32 * wn + 16 * nt + fr) * TP + 32 * kk + 8 * fq);
#pragma unroll
        for (int mt = 0; mt < 4; ++mt)
#pragma unroll
            for (int nt = 0; nt < 2; ++nt) acc[mt][nt] = __builtin_amdgcn_mfma_f32_16x16x32_bf16(bf_[nt], af[mt], acc[mt][nt], 0, 0, 0);
    }
}
__device__ __forceinline__ void gmlp_unit(Frame& F, const Args& a, int layer, int unit) {
    phase_ids(F);
    const size_t t0 = (size_t)unit * 128; const int tid = F.tid, lane = F.lane, wave = F.wave;
    LAS float* st = (LAS float*)F.lds; LAS bf16* sA = (LAS bf16*)(F.lds + 1024); LAS bf16* sB = (LAS bf16*)(F.lds + 1024 + 128 * TP * 2);
    bf16* GUV = (bf16*)(F.ws + WS_GUV); const bf16* GMW = (const bf16*)(F.ws + WS_DB + (size_t)(layer & 1) * DB_SET + DB_GMW);
    const float* lng = a.in[19] + (size_t)layer * 1024; const float* lnb = a.in[20] + (size_t)layer * 1024; const float* bsp = a.in[22] + (size_t)layer * 1024;
    for (int r = 0; r < 16; ++r) { const int tok = wave * 16 + r; const bf16* rowp = GUV + (t0 + tok) * 2048 + 1024;
        f32x4 x0, x1, x2, x3; unpk8(*(const v4u*)(rowp + lane * 8), x0, x1); unpk8(*(const v4u*)(rowp + 512 + lane * 8), x2, x3);
        const f32x4 sv = (x0 + x1) + (x2 + x3), qv = (x0 * x0 + x1 * x1) + (x2 * x2 + x3 * x3);
        const float s = wave_sum((sv.x + sv.y) + (sv.z + sv.w)), q = wave_sum((qv.x + qv.y) + (qv.z + qv.w));
        const float mean = s * (1.f / 1024.f), var = fmaxf(q * (1.f / 1024.f) - mean * mean, 0.f);
        if (lane == 0) { st[tok * 2] = mean; st[tok * 2 + 1] = 1.f / sqrtf(var + 1e-5f); } }
    __syncthreads();
    for (int g = 0; g < 8; ++g) {
#pragma unroll
        for (int i = 0; i < 4; ++i) { const int pc = tid + 512 * i, rr = pc >> 4, c16 = pc & 15;
            *(LAS v4u*)(sA + rr * TP + c16 * 8) = *(const v4u*)(GMW + (size_t)g * 16384 + rr * 128 + c16 * 8); }
        { const int p = tid & 127, oc0 = tid >> 7; const float mean = st[p * 2], rstd = st[p * 2 + 1];
#pragma unroll
          for (int i = 0; i < 4; ++i) { const int oc = oc0 + 4 * i, c0 = g * 128 + oc * 8;
              f32x4 x0, x1; unpk8(*(const v4u*)(GUV + (t0 + p) * 2048 + 1024 + c0), x0, x1);
              const f32x4 g0 = *(const f32x4*)(lng + c0), g1 = *(const f32x4*)(lng + c0 + 4), b0 = *(const f32x4*)(lnb + c0), b1 = *(const f32x4*)(lnb + c0 + 4);
              x0 = (x0 - mean) * rstd * g0 + b0; x1 = (x1 - mean) * rstd * g1 + b1;
              const v4u w = pk8(x0, x1);
              LAS bf16* d = sB + (oc * 8) * TP + p;
              d[0 * TP] = (bf16)(w.x & 0xffffu); d[1 * TP] = (bf16)(w.x >> 16); d[2 * TP] = (bf16)(w.y & 0xffffu); d[3 * TP] = (bf16)(w.y >> 16);
              d[4 * TP] = (bf16)(w.z & 0xffffu); d[5 * TP] = (bf16)(w.z >> 16); d[6 * TP] = (bf16)(w.w & 0xffffu); d[7 * TP] = (bf16)(w.w >> 16); } }
        __syncthreads();
        f32x4 acc[4][2];
#pragma unroll
        for (int mt = 0; mt < 4; ++mt)
#pragma unroll
            for (int nt = 0; nt < 2; ++nt) acc[mt][nt] = (f32x4){0.f, 0.f, 0.f, 0.f};
        mma_128(sA, sB, wave, lane, acc);
        { const int wm = wave >> 2, wn = wave & 3, fr = lane & 15, fq = lane >> 4;
#pragma unroll
          for (int mt = 0; mt < 4; ++mt) { const int tt = 64 * wm + 16 * mt + fr; const float bsv = bsp[g * 128 + tt];
#pragma unroll
              for (int nt = 0; nt < 2; ++nt) { const int c = g * 128 + 32 * wn + 16 * nt + 4 * fq;
                  const v2u uw = *(const v2u*)(GUV + (t0 + tt) * 2048 + c);
                  const f32x4 u4 = (f32x4){bflo(uw.x), bfhi(uw.x), bflo(uw.y), bfhi(uw.y)};
                  const f32x4 yb = u4 * (acc[mt][nt] + bsv);
                  v2u ow; ow.x = cvt_pk_bf16(yb.x, yb.y); ow.y = cvt_pk_bf16(yb.z, yb.w);
                  *(v2u*)(GUV + (t0 + tt) * 2048 + c) = ow; } } }
        __syncthreads();
    }
}

__device__ __forceinline__ unsigned fkey(float f) { const unsigned u = __builtin_bit_cast(unsigned, f); return (u & 0x80000000u) ? ~u : (u | 0x80000000u); }
__device__ __forceinline__ float kval(unsigned k, unsigned mask) { const unsigned u = k & mask; return __builtin_bit_cast(float, (u & 0x80000000u) ? (u ^ 0x80000000u) : ~u); }
__device__ __forceinline__ float swap32_add(float a, float b) { const auto r = __builtin_amdgcn_permlane32_swap(__builtin_bit_cast(unsigned, a), __builtin_bit_cast(unsigned, b), false, false);
    return __builtin_bit_cast(float, (unsigned)r[0]) + __builtin_bit_cast(float, (unsigned)r[1]); }
__device__ __forceinline__ float swap16_add(float a, float b) { const auto r = __builtin_amdgcn_permlane16_swap(__builtin_bit_cast(unsigned, a), __builtin_bit_cast(unsigned, b), false, false);
    return __builtin_bit_cast(float, (unsigned)r[0]) + __builtin_bit_cast(float, (unsigned)r[1]); }
__device__ __forceinline__ float row_sum16(float x) {
    x += __builtin_bit_cast(float, __builtin_amdgcn_update_dpp(0, __builtin_bit_cast(int, x), 0x128, 0xf, 0xf, false));
    x += __builtin_bit_cast(float, __builtin_amdgcn_update_dpp(0, __builtin_bit_cast(int, x), 0x124, 0xf, 0xf, false));
    x += __builtin_bit_cast(float, __builtin_amdgcn_update_dpp(0, __builtin_bit_cast(int, x), 0x122, 0xf, 0xf, false));
    x += __builtin_bit_cast(float, __builtin_amdgcn_update_dpp(0, __builtin_bit_cast(int, x), 0x121, 0xf, 0xf, false));
    return x; }
#define CE_DESC(a, b) do { const unsigned _h = max((a), (b)), _l = min((a), (b)); (a) = _h; (b) = _l; } while (0)
template <int OFF> __device__ __forceinline__ void bitonic_merge16(unsigned (&x)[32]) {
#pragma unroll
    for (int j = 8; j >= 1; j >>= 1)
#pragma unroll
        for (int i = 0; i < 16; ++i) { const int l = i ^ j; if (l > i) CE_DESC(x[OFF + i], x[OFF + l]); }
}
template <int OFF> __device__ __forceinline__ void bitonic_sort16(unsigned (&x)[32]) {
#pragma unroll
    for (int k = 2; k <= 16; k <<= 1)
#pragma unroll
        for (int j = k >> 1; j >= 1; j >>= 1)
#pragma unroll
            for (int i = 0; i < 16; ++i) { const int l = i ^ j; if (l > i) { if ((i & k) == 0 || k == 16) CE_DESC(x[OFF + i], x[OFF + l]); else CE_DESC(x[OFF + l], x[OFF + i]); } }
}
#ifndef REP_K
#define REP_K 1
#endif
#define TOP_INSERT(top, x) do { unsigned _x = (x); _Pragma("unroll") for (int _j = 0; _j < 16; ++_j) { const unsigned _h = max((top)[_j], _x); _x = min((top)[_j], _x); (top)[_j] = _h; } } while (0)
__device__ __forceinline__ void peer_token_end(Frame& F, const Args& a, int layer, bool last, bool final_half, size_t tok, int lane, const f32x2 (&out)[8], const f32x4 (&hpre)[4]) {
    float* hp = F.h + tok * 1024 + 16 * lane;
    f32x4 hv[4]; float s = 0.f;
#pragma unroll
    for (int i = 0; i < 4; ++i) { hv[i] = hpre[i] + (f32x4){out[2 * i].x, out[2 * i].y, out[2 * i + 1].x, out[2 * i + 1].y};
        s += (hv[i].x * hv[i].x + hv[i].y * hv[i].y) + (hv[i].z * hv[i].z + hv[i].w * hv[i].w); }
    if (!final_half) {
#pragma unroll
        for (int i = 0; i < 4; ++i) *(f32x4*)(hp + 4 * i) = hv[i];
        return; }
    const float rstd = 1.f / sqrtf(wave_sum(s) * (1.f / D) + 1e-6f);
    const float* g = (last ? a.in[4] : a.in[2] + (size_t)(layer + 1) * 1024) + 16 * lane;
    f32x4 o[4];
#pragma unroll
    for (int i = 0; i < 4; ++i) o[i] = hv[i] * rstd * *(const f32x4*)(g + 4 * i);
    if (last) {
#ifdef PROBE_SCAN
        { const float pv = ((const float*)(F.ws + WS_CTL))[2048 + PROBE_SCAN - 1];
#pragma unroll
          for (int i = 0; i < 4; ++i) o[i] = o[i] + pv; }
#endif
#pragma unroll
        for (int i = 0; i < 4; ++i) *(f32x4*)(hp + 4 * i) = o[i];
    } else {
#pragma unroll
        for (int i = 0; i < 4; ++i) *(f32x4*)(hp + 4 * i) = hv[i];
        bf16* NX = (bf16*)(F.ws + WS_NX); const v4u w0 = pk8(o[0], o[1]), w1 = pk8(o[2], o[3]); const int tt = (int)(tok & (SEQ - 1));
        *(v4u*)(NX + tok * 2048 + 16 * lane) = w0; *(v4u*)(NX + tok * 2048 + 16 * lane + 8) = w1;
        if (tt != SEQ - 1) { *(v4u*)(NX + (tok + 1) * 2048 + 1024 + 16 * lane) = w0; *(v4u*)(NX + (tok + 1) * 2048 + 1024 + 16 * lane + 8) = w1; }
        if (tt == 0) { *(v4u*)(NX + tok * 2048 + 1024 + 16 * lane) = (v4u){0u, 0u, 0u, 0u}; *(v4u*)(NX + tok * 2048 + 1024 + 16 * lane + 8) = (v4u){0u, 0u, 0u, 0u}; }
    }
}
__device__ __forceinline__ void peer_unit(Frame& F, const Args& a, int layer, int unit, bool last) {
    phase_ids(F);
    const size_t t0 = (size_t)unit * 128; const int tid = F.tid, lane = F.lane, wave = F.wave, fr = lane & 15, fq = lane >> 4;
    LAS bf16* sKey = (LAS bf16*)F.lds;
    LAS unsigned* sLT = (LAS unsigned*)(F.lds + 2 * 128 * TP * 2) + wave * 512;
    const bf16* Q = (const bf16*)(F.ws + WS_Q); const bf16* KEYS = (const bf16*)(F.ws + WS_DB + (size_t)(layer & 1) * DB_SET + DB_KEYS); v2u* SEL = (v2u*)(F.ws + WS_SEL);
    const size_t trow = t0 + wave * 16 + fr;
    constexpr float KOFF = 32.f;
    v4u ktn[4]; bf16x8 qfn[4];
#define K_FETCH(J) do { _Pragma("unroll") for (int _i = 0; _i < 4; ++_i) { const int _pc = tid + 512 * _i, _rr = _pc >> 4, _c16 = _pc & 15; ktn[_i] = *(const v4u*)(KEYS + (size_t)(J) * 16384 + _rr * 128 + _c16 * 8); } \
        _Pragma("unroll") for (int _kk = 0; _kk < 4; ++_kk) qfn[_kk] = *(const bf16x8*)(Q + trow * 2048 + (J) * 128 + 32 * _kk + 8 * fq); } while (0)
#define K_STORE(J) do { _Pragma("unroll") for (int _i = 0; _i < 4; ++_i) { const int _pc = tid + 512 * _i, _rr = _pc >> 4, _c16 = _pc & 15; *(LAS v4u*)(sKey + ((J) & 1) * 128 * TP + _rr * TP + _c16 * 8) = ktn[_i]; } } while (0)
    for (int krep = 0; krep < REP_K; ++krep) {
    __syncthreads();
    K_FETCH(0); K_STORE(0);
    bf16x8 qf[4];
#pragma unroll
    for (int kk = 0; kk < 4; ++kk) qf[kk] = qfn[kk];
    __syncthreads();
    for (int hd = 0; hd < 8; ++hd) {
        for (int p = 0; p < 2; ++p) {
            const int jp = hd * 2 + p;
            if (jp + 1 < 16) K_FETCH(jp + 1);
            const LAS bf16* sKc = sKey + (jp & 1) * 128 * TP;
            f32x4 sc[8];
#pragma unroll
            for (int nt = 0; nt < 8; ++nt) sc[nt] = (f32x4){KOFF, KOFF, KOFF, KOFF};
#pragma unroll
            for (int kk = 0; kk < 4; ++kk)
#pragma unroll
                for (int nt = 0; nt < 8; ++nt) { const bf16x8 kf = *(const LAS bf16x8*)(sKc + (16 * nt + fr) * TP + 32 * kk + 8 * fq);
                    sc[nt] = __builtin_amdgcn_mfma_f32_16x16x32_bf16(kf, qf[kk], sc[nt], 0, 0, 0); }
            unsigned t[32];
#pragma unroll
            for (int nt = 0; nt < 8; ++nt)
#pragma unroll
                for (int rg = 0; rg < 4; ++rg) t[4 * nt + rg] = (__float_as_uint(sc[nt][rg]) & 0xFFFFFF80u) | (unsigned)(16 * nt + 4 * fq + rg);
            bitonic_sort16<0>(t); bitonic_sort16<16>(t);
#pragma unroll
            for (int j = 0; j < 16; ++j) t[j] = max(t[j], t[31 - j]);
            bitonic_merge16<0>(t);
#pragma unroll
            for (int rnd = 0; rnd < 2; ++rnd) {
#pragma unroll
                for (int j = 0; j < 16; ++j) t[16 + j] = rnd ? xor32_u(t[j], lane) : xor16_u(t[j], lane);
#pragma unroll
                for (int j = 0; j < 16; ++j) t[j] = max(t[j], t[31 - j]);
                bitonic_merge16<0>(t); }
#pragma unroll
            for (int j = 0; j < 16; ++j) sLT[fr * 32 + p * 16 + j] = t[j];
            if (jp + 1 < 16) { K_STORE(jp + 1);
#pragma unroll
                for (int kk = 0; kk < 4; ++kk) qf[kk] = qfn[kk]; }
            __syncthreads();
        }
        float v0[16], v1[16];
#pragma unroll
        for (int j = 0; j < 16; ++j) { v0[j] = __uint_as_float(sLT[fr * 32 + j] & 0xFFFFFF80u); v1[j] = __uint_as_float(sLT[fr * 32 + 16 + j] & 0xFFFFFF80u); }
        unsigned best[32];
#define CKEY(i, j) ((__float_as_uint(v0[i] + v1[j]) & 0xFFFFFF00u) | (unsigned)((i) * 16 + (j)))
#pragma unroll
        for (int j = 0; j < 16; ++j) best[j] = CKEY(0, j);
#pragma unroll
        for (int i = 1; i < 8; ++i) {
#pragma unroll
            for (int j = 0; j < 16; ++j) if ((i + 1) * (j + 1) <= 16) best[15 - j] = max(best[15 - j], CKEY(i, j));
            bitonic_merge16<0>(best); }
#pragma unroll
        for (int i = 8; i < 16; ++i) best[15 - (i - 8)] = max(best[15 - (i - 8)], CKEY(i, 0));
        bitonic_merge16<0>(best);
#undef CKEY
        float ev[16], esum = 0.f; const float mx = __uint_as_float(best[0] & 0xFFFFFF00u);
#pragma unroll
        for (int k = 0; k < 16; ++k) { ev[k] = __builtin_amdgcn_exp2f((__uint_as_float(best[k] & 0xFFFFFF00u) - mx) * 1.44269504f); esum += ev[k]; }
        const float einv = 1.f / esum;
#pragma unroll
        for (int k = 0; k < 16; ++k) { const unsigned pos = best[k] & 255u;
            const unsigned i0 = sLT[fr * 32 + (pos >> 4)] & 127u, i1 = sLT[fr * 32 + 16 + (pos & 15u)] & 127u;
            if ((k >> 2) == fq) SEL[trow * 128 + hd * 16 + k] = (v2u){i0 * 128u + i1, __builtin_bit_cast(unsigned, ev[k] * einv)}; }
    }
    }
#undef K_FETCH
#undef K_STORE
    asm volatile("s_waitcnt vmcnt(0)" ::: "memory");
    __syncthreads();
    const bf16* N2 = (const bf16*)(F.ws + WS_N2); const unsigned char* U8 = (const unsigned char*)(F.ws + WS_DB + (size_t)(layer & 1) * DB_SET + DB_U); const unsigned char* V8 = (const unsigned char*)(F.ws + WS_DB + (size_t)(layer & 1) * DB_SET + DB_V);
    unsigned* SELW = (unsigned*)SEL;
    LAS float* sCoef = (LAS float*)F.lds + wave * 2048;
    LAS unsigned* sSort = sLT;
    const size_t tokb = t0 + wave * 16;
    unsigned cnts = 0u;
    v4u se_pf = *(const v4u*)(SELW + tokb * 256 + 4 * lane);
    for (int it = 0; it < 16; ++it) {
        const v4u se = se_pf;
        if (it < 15) se_pf = *(const v4u*)(SELW + (tokb + it + 1) * 256 + 4 * lane);
        const unsigned b0 = se.x >> 12, b1 = se.z >> 12;
        unsigned pos0 = 0u, pos1 = 0u, base = 0u, pk = 0u;
#pragma unroll
        for (unsigned k = 0; k < 4; ++k) {
            const unsigned long long m0 = __builtin_amdgcn_ballot_w64(b0 == k), m1 = __builtin_amdgcn_ballot_w64(b1 == k);
            const unsigned below = __builtin_amdgcn_mbcnt_hi((unsigned)(m0 >> 32), __builtin_amdgcn_mbcnt_lo((unsigned)m0, 0u)) + __builtin_amdgcn_mbcnt_hi((unsigned)(m1 >> 32), __builtin_amdgcn_mbcnt_lo((unsigned)m1, 0u));
            if (b0 == k) pos0 = base + below;
            if (b1 == k) pos1 = base + below + (b0 == k ? 1u : 0u);
            base += (unsigned)__builtin_popcountll(m0) + (unsigned)__builtin_popcountll(m1);
            if (k < 3) pk |= base << (8 * k);
        }
#ifdef DBG_NOSORT
        pos0 = 2 * lane; pos1 = 2 * lane + 1;
#endif
        *(LAS v2u*)(sSort + 2 * pos0) = (v2u){se.x, se.y}; *(LAS v2u*)(sSort + 2 * pos1) = (v2u){se.z, se.w};
        asm volatile("" ::: "memory");
        const v2u so0 = *(const LAS v2u*)(sSort + 4 * lane), so1 = *(const LAS v2u*)(sSort + 4 * lane + 2); const v4u so = (v4u){so0.x, so0.y, so1.x, so1.y};
        asm volatile("" ::: "memory");
#ifndef DBG_NOSTORE
        *(v4u*)(SELW + (tokb + it) * 256 + 4 * lane) = so;
#endif
        { const unsigned g0 = so0.y, g1 = so1.y; sCoef[it * 128 + 2 * lane] = __uint_as_float(g0); sCoef[it * 128 + 2 * lane + 1] = __uint_as_float(g1); }
        if (lane == it) cnts = pk;
    }
    asm volatile("s_waitcnt vmcnt(0) lgkmcnt(0)" ::: "memory");
#ifdef DBG_NOBUCKET
    cnts = 0u;
#endif
#define PL_LOAD(RB, TAB, SE, BB) do { _Pragma("unroll") for (int _q = 0; _q < 16; ++_q) { \
        const unsigned _idx = (unsigned)__builtin_amdgcn_readlane((int)((_q & 1) ? (SE).z : (SE).x), (BB) * 8 + (_q >> 1)); \
        (RB)[_q] = *(const v4u*)((TAB) + (size_t)_idx * 1024 + 16 * lane); } } while (0)
#define PL_LOAD_U(RB, SE, BB) do { const int _src = ((BB) * 8 + ((lane & 15) >> 1)) * 4; \
        const unsigned _ix = (unsigned)__builtin_amdgcn_ds_bpermute(_src, (int)(SE).x), _iz = (unsigned)__builtin_amdgcn_ds_bpermute(_src, (int)(SE).z); \
        const unsigned char* _p = U8 + (size_t)((lane & 1) ? _iz : _ix) * 1024 + 32 * (lane >> 4); \
        _Pragma("unroll") for (int _j = 0; _j < 16; ++_j) (RB)[_j] = *(const v4u*)(_p + 128 * (_j >> 1) + 16 * (_j & 1)); } while (0)
#define PL_RANGE(T, P, NP, RLO, RHI, BLO, BHI) const unsigned _pk##T = (unsigned)__builtin_amdgcn_readlane((int)cnts, (T)); \
        const int _sp##T = min((int)((((_pk##T >> 8) & 255u) + 15u) & ~15u), 128);     \
        const int RLO = (P) == 0 ? 0 : _sp##T, RHI = (P) == 0 ? _sp##T : 128; \
        const int BLO = min(RLO >> 4, 7), BHI = max((RHI + 15) >> 4, BLO + 1)
    v4u ra[16], rb[16];
#ifndef DBG_U0
#define DBG_U0 0
#define DBG_V0 0
#endif
    for (int ps = DBG_U0; ps < 2; ++ps) {
        int lt = 0, lb, lbh; { PL_RANGE(lt, ps, 2, r0, r1, b0_, b1_); lb = b0_; lbh = b1_; (void)r0; (void)r1; }
        v4u seL = *(const v4u*)(SELW + tokb * 256 + 4 * lane), seN = *(const v4u*)(SELW + (tokb + 1) * 256 + 4 * lane);
        long xlo = 0, xhi = 0; const bool dsel = ((lane >> 2) & 3) == (lane >> 4); v4u nraw0, nraw1, nnx0 = *(const v4u*)(N2 + tokb * 1024 + 16 * lane), nnx1 = *(const v4u*)(N2 + tokb * 1024 + 16 * lane + 8);
        int ct, cb, crl = 0, crh = 0, cbl = 0;
#define U_ADV() do { ++lb; if (lb >= lbh) { ++lt; if (lt < 16) { PL_RANGE(lt, ps, 2, _r0, _r1, _b0, _b1); lb = _b0; lbh = _b1; (void)_r0; (void)_r1; seL = seN; if (lt + 1 < 16) seN = *(const v4u*)(SELW + (tokb + lt + 1) * 256 + 4 * lane); } } } while (0)
#define U_COMPUTE(RB) do { \
            if (cb == cbl) { nraw0 = nnx0; nraw1 = nnx1; if (ct + 1 < 16) { nnx0 = *(const v4u*)(N2 + (tokb + ct + 1) * 1024 + 16 * lane); nnx1 = *(const v4u*)(N2 + (tokb + ct + 1) * 1024 + 16 * lane + 8); } \
                f32x4 x0, x1, x2, x3; unpk8(nraw0, x0, x1); unpk8(nraw1, x2, x3); x0 = x0 * 16.f; x1 = x1 * 16.f; x2 = x2 * 16.f; x3 = x3 * 16.f; \
                int _w0 = 0, _w1 = 0, _w2 = 0, _w3 = 0; \
                _w0 = __builtin_amdgcn_cvt_pk_fp8_f32(x0.x, x0.y, _w0, false); _w0 = __builtin_amdgcn_cvt_pk_fp8_f32(x0.z, x0.w, _w0, true); \
                _w1 = __builtin_amdgcn_cvt_pk_fp8_f32(x1.x, x1.y, _w1, false); _w1 = __builtin_amdgcn_cvt_pk_fp8_f32(x1.z, x1.w, _w1, true); \
                _w2 = __builtin_amdgcn_cvt_pk_fp8_f32(x2.x, x2.y, _w2, false); _w2 = __builtin_amdgcn_cvt_pk_fp8_f32(x2.z, x2.w, _w2, true); \
                _w3 = __builtin_amdgcn_cvt_pk_fp8_f32(x3.x, x3.y, _w3, false); _w3 = __builtin_amdgcn_cvt_pk_fp8_f32(x3.z, x3.w, _w3, true); \
                xlo = (long)(((unsigned long long)(unsigned)_w1 << 32) | (unsigned)_w0); xhi = (long)(((unsigned long long)(unsigned)_w3 << 32) | (unsigned)_w2); } \
            _Pragma("unroll") for (int _g = 0; _g < 2; ++_g) { float _p[8]; \
                _Pragma("unroll") for (int _q = 0; _q < 8; ++_q) { f32x4 _d = (f32x4){0.f, 0.f, 0.f, 0.f}; \
                    _d = __builtin_amdgcn_mfma_f32_16x16x32_fp8_fp8((long)(((unsigned long long)(RB)[8 * _g + _q].y << 32) | (RB)[8 * _g + _q].x), xlo, _d, 0, 0, 0); \
                    _d = __builtin_amdgcn_mfma_f32_16x16x32_fp8_fp8((long)(((unsigned long long)(RB)[8 * _g + _q].w << 32) | (RB)[8 * _g + _q].z), xhi, _d, 0, 0, 0); \
                    const float _sl = (lane & 2) ? ((lane & 1) ? _d.w : _d.z) : ((lane & 1) ? _d.y : _d.x); \
                    _p[_q] = dsel ? _sl : 0.f; }     \
                const float _s0 = swap32_add(_p[0], _p[4]), _s1 = swap32_add(_p[1], _p[5]), _s2 = swap32_add(_p[2], _p[6]), _s3 = swap32_add(_p[3], _p[7]); \
                float _t0 = row_sum16(swap16_add(_s0, _s2)), _t1 = row_sum16(swap16_add(_s1, _s3)); \
                _t0 = fgelu(_t0 * (1.f / 4096.f)) * (1.f / 64.f); _t1 = fgelu(_t1 * (1.f / 4096.f)) * (1.f / 64.f); \
                if ((lane & 15) == 0) { const int _r = lane >> 4, _e = cb * 16 + 8 * _g + 2 * (_r & 1) + 4 * (_r >> 1); LAS float* _c = sCoef + ct * 128 + _e; \
                    if (_e >= crl && _e < crh) _c[0] *= _t0; if (_e + 1 >= crl && _e + 1 < crh) _c[1] *= _t1; } } } while (0)
#define U_SETC() do { ct = lt; cb = lb; { PL_RANGE(ct, ps, 2, _r0, _r1, _b0, _b1); crl = _r0; crh = _r1; cbl = _b0; (void)_b1; } } while (0)
        PL_LOAD(ra, U8, seL, lb);
        U_SETC(); U_ADV();
        for (;;) {
            if (lt < 16) PL_LOAD(rb, U8, seL, lb);
            U_COMPUTE(ra);
            if (lt >= 16) break;
            U_SETC(); U_ADV();
            if (lt < 16) PL_LOAD(ra, U8, seL, lb);
            U_COMPUTE(rb);
            if (lt >= 16) break;
            U_SETC(); U_ADV();
        }
        asm volatile("s_waitcnt lgkmcnt(0)" ::: "memory");
        __syncthreads();
    }
#undef U_ADV
#undef U_COMPUTE
#undef U_SETC
    for (int ps = DBG_V0; ps < 2; ++ps) {
        int lt = 0, lb, lbh; { PL_RANGE(lt, ps, 2, r0, r1, b0_, b1_); lb = b0_; lbh = b1_; (void)r0; (void)r1; }
        v4u seL = *(const v4u*)(SELW + tokb * 256 + 4 * lane), seN = *(const v4u*)(SELW + (tokb + 1) * 256 + 4 * lane);
        f32x2 out[8]; f32x4 hpre[4], ac4[4];
        const unsigned vmask = ((lane >> 4) == ((lane & 15) >> 2)) ? (0xFFu << (8 * (lane & 3))) : 0u;
        int ct, cb, crl = 0, crh = 0, cbl = 0, cbh = 0;
#define V_ADV() do { ++lb; if (lb >= lbh) { ++lt; if (lt < 16) { PL_RANGE(lt, ps, 2, _r0, _r1, _b0, _b1); lb = _b0; lbh = _b1; (void)_r0; (void)_r1; seL = seN; if (lt + 1 < 16) seN = *(const v4u*)(SELW + (tokb + lt + 1) * 256 + 4 * lane); } } } while (0)
#define V_SETC() do { ct = lt; cb = lb; { PL_RANGE(ct, ps, 2, _r0, _r1, _b0, _b1); crl = _r0; crh = _r1; cbl = _b0; cbh = _b1; } } while (0)
#ifndef REP_LV
#define REP_LV 1
#endif
#define V_COMPUTE(RB) do { \
            if (cb == cbl) { _Pragma("unroll") for (int _i = 0; _i < 4; ++_i) { ac4[_i] = (f32x4){0.f, 0.f, 0.f, 0.f}; hpre[_i] = *(const f32x4*)(F.h + (tokb + ct) * 1024 + 16 * lane + 4 * _i); } }     \
            _Pragma("unroll") for (int _q = 0; _q < 16; ++_q) { const int _e = cb * 16 + _q; \
                float _c = sCoef[ct * 128 + _e]; _c = (_e >= crl && _e < crh) ? _c * 2048.f : 0.f; \
                int _w = __builtin_amdgcn_cvt_pk_fp8_f32(_c, _c, 0, false); _w = __builtin_amdgcn_cvt_pk_fp8_f32(_c, _c, _w, true); const unsigned _x = (unsigned)_w & vmask; \
                const long _ae = (long)(unsigned long long)_x, _ao = (long)((unsigned long long)_x << 32); \
                const long _bl = (long)(((unsigned long long)(RB)[_q].y << 32) | (RB)[_q].x), _bh = (long)(((unsigned long long)(RB)[_q].w << 32) | (RB)[_q].z); \
                ac4[0] = __builtin_amdgcn_mfma_f32_16x16x32_fp8_fp8(_ae, _bl, ac4[0], 0, 0, 0); ac4[1] = __builtin_amdgcn_mfma_f32_16x16x32_fp8_fp8(_ao, _bl, ac4[1], 0, 0, 0); \
                ac4[2] = __builtin_amdgcn_mfma_f32_16x16x32_fp8_fp8(_ae, _bh, ac4[2], 0, 0, 0); ac4[3] = __builtin_amdgcn_mfma_f32_16x16x32_fp8_fp8(_ao, _bh, ac4[3], 0, 0, 0); } \
            if (cb == cbh - 1) { _Pragma("unroll") for (int _i = 0; _i < 4; ++_i) { out[2 * _i] = (f32x2){ac4[_i].x, ac4[_i].y} * (1.f / 2048.f); out[2 * _i + 1] = (f32x2){ac4[_i].z, ac4[_i].w} * (1.f / 2048.f); } \
                peer_token_end(F, a, layer, last, ps == 1, tokb + ct, lane, out, hpre); } } while (0)
        PL_LOAD(ra, V8, seL, lb);
        V_SETC(); V_ADV();
        for (;;) {
            if (lt < 16) PL_LOAD(rb, V8, seL, lb);
            V_COMPUTE(ra);
            if (lt >= 16) break;
            V_SETC(); V_ADV();
            if (lt < 16) PL_LOAD(ra, V8, seL, lb);
            V_COMPUTE(rb);
            if (lt >= 16) break;
            V_SETC(); V_ADV();
        }
        asm volatile("s_waitcnt vmcnt(0)" ::: "memory");
        __syncthreads();
    }
#undef V_ADV
#undef V_SETC
#undef V_COMPUTE
#undef PL_LOAD
#undef PL_RANGE
}


#ifndef ZSKIP
#define ZSKIP 0
#endif
#ifndef ZGA_ALIGN
#define ZGA_ALIGN true
#endif
#ifndef ZGA_SP2
#define ZGA_SP2 true
#endif
#ifndef WIN_ALIGN
#define WIN_ALIGN true
#endif
#ifndef WIN_SP2
#define WIN_SP2 true
#endif
#ifndef REP_E
#define REP_E 1
#endif
#ifndef REP_A
#define REP_A 1
#endif
#ifndef REP_B
#define REP_B 1
#endif
#ifndef REP_C
#define REP_C 1
#endif
#ifndef REP_D
#define REP_D 1
#endif
#ifndef REP_G
#define REP_G 1
#endif
#ifndef REP_I
#define REP_I 1
#endif
#ifndef REP_K
#define REP_K 1
#endif
__global__ void __launch_bounds__(NWAVES * 64, 2) trunk_fwd(Args args) {
    extern __shared__ __attribute__((aligned(16))) unsigned char lds[];
    Frame F;
    F.lds = (LAS unsigned char*)lds;
    F.tid = threadIdx.x; F.lane = F.tid & 63; F.wave = __builtin_amdgcn_readfirstlane(F.tid >> 6); F.wave0 = F.wave;
    F.G = gridDim.x; F.bx = blockIdx.x; F.ws = (GAS unsigned char*)args.ws; F.h = args.out;
    volatile LAS unsigned* MISC = (volatile LAS unsigned*)(F.lds + MISC_OFF);
    for (int u = F.tid; u < (LDS_BYTES - LDSCTL_OFF) / 4; u += NWAVES * 64) ((LAS unsigned*)(F.lds + LDSCTL_OFF))[u] = 0u;
    __syncthreads();
    unsigned* ctl = (unsigned*)(F.ws + WS_CTL);
    XcdBarrier bar = xcd_barrier_post(ctl + CW_BAR, MISC + 8);
    GAS unsigned char* ws = F.ws;
    LAS unsigned char* ring = (LAS unsigned char*)F.lds;

    for (int rep = 0; rep < REP_A; ++rep) { prep_phase(F, args, 0, F.bx, F.G, 1);
    xcd_barrier(bar, F.wave0); }
#define OPQ() GAS unsigned char* ws = F.ws; asm volatile("" : "+s"(ws)); GAS unsigned char* db = ws + WS_DB + (size_t)(layer & 1) * DB_SET; (void)db
    for (int layer = 0; layer < DEPTH; ++layer) {
        {   OPQ();
        for (int rep = 0; rep < REP_B; ++rep) {   if (rep) xcd_barrier(bar, F.wave0); pg8::Gemm g{(const bf16*)(ws + WS_NX), (const bf16*)(ws + WS_WIN), T, NZ - 256 * ZSPLIT, 2048, 2048}; pg8::StaticOrder S; S.init(T, NZ - 256 * ZSPLIT, F.G, F.bx);
            pg8::EpiZ E{(bf16*)(ws + WS_ZRKV), (bf16*)(ws + WS_ZL), (bf16*)(ws + WS_GUV), (bf16*)(ws + WS_SG), layer == 0 ? (bf16*)(ws + WS_VF) : (bf16*)nullptr, 0};
            pg8::gemm_phase<pg8::EpiZ, pg8::StaticOrder, WIN_ALIGN, WIN_SP2>(ring, g, S, E, F.wave0); }
        }
        xcd_barrier(bar, F.wave0);
        {   OPQ();
        for (int rep = 0; rep < REP_C; ++rep) {   if (rep) xcd_barrier(bar, F.wave0); { pg8::Gemm g{(const bf16*)(ws + WS_ZL), (const bf16*)(ws + WS_LORA + (size_t)layer * LORA_BYTES), T, 2048, 128, 512}; pg8::StaticOrder S; S.init(T, 2048, F.G, F.bx);
            pg8::EpiLora E{(bf16*)(ws + WS_EW), (size_t)(WS_AR - WS_EW) / 2, args.in[6] + (size_t)layer * 1024, args.in[8] + (size_t)layer * 1024, 0};
            pg8::gemm_phase<pg8::EpiLora, pg8::StaticOrder, true, true>(ring, g, S, E, F.wave0); }
            { pg8::Gemm g{(const bf16*)(ws + WS_ZL) + 128, (const bf16*)(ws + WS_LORA + (size_t)layer * LORA_BYTES) + 2048 * 128, T, 1024, 128, 512}; pg8::StaticOrder S; S.init(T, 1024, F.G, F.bx);
            pg8::EpiLora E{(bf16*)(ws + WS_EW), (size_t)(WS_AR - WS_EW) / 2, args.in[6] + (size_t)layer * 1024, args.in[8] + (size_t)layer * 1024, 8};
            pg8::gemm_phase<pg8::EpiLora, pg8::StaticOrder, true, true>(ring, g, S, E, F.wave0); } }
        if (layer > 0) {
            pg8::Gemm g{(const bf16*)(ws + WS_ZL) + 256, (const bf16*)(ws + WS_MV + (size_t)(layer - 1) * MV_BYTES), T, 1024, 128, 512}; pg8::StaticOrder S; S.init(T, 1024, F.G, F.bx);
            pg8::EpiMv E{(bf16*)(ws + WS_ZRKV), (const bf16*)(ws + WS_VF), args.in[18] + (size_t)(layer - 1) * 1024};
            pg8::gemm_phase<pg8::EpiMv, pg8::StaticOrder, true, true>(ring, g, S, E, F.wave0); }
        }
        xcd_barrier(bar, F.wave0);
        {   OPQ();
        for (int rep = 0; rep < REP_D; ++rep) {   if (rep) xcd_barrier(bar, F.wave0); const int nsb = F.G / 2, nob = F.G - nsb;
            if (F.bx < nsb) { for (int u = F.bx; u < NB * 16; u += nsb) scan_unit(F, args, layer, u); }
            else { const int ob = F.bx - nsb;
                for (int pm = ob; pm < T / 256; pm += nob)
                    for (int rep2 = 0; rep2 < REP_E; ++rep2) { gmlp_unit(F, args, layer, 2 * pm); gmlp_unit(F, args, layer, 2 * pm + 1); }
                asm volatile("s_waitcnt vmcnt(0)" ::: "memory"); __syncthreads();
                {
                    pg8::Gemm g{(const bf16*)(ws + WS_GUV), (const bf16*)(db + DB_PBT), T, 1024, 1024, 2048}; pg8::PanelOrder S{ob, nob, T / 256, 4, 0};
                    pg8::EpiMerge<false> E{(const bf16*)(ws + WS_SG), (bf16*)(ws + WS_GUV) + 1024, (bf16*)nullptr};
                    pg8::gemm_phase<pg8::EpiMerge<false>, pg8::PanelOrder, true, true>(ring, g, S, E, F.wave0); }
                {
                    pg8::Gemm g{(const bf16*)(ws + WS_NX), (const bf16*)(ws + WS_WINB + (size_t)(layer & 1) * WINB_BYTES), T, 256 * ZSPLIT, 2048, 2048}; pg8::StaticOrder S; S.init(T, 256 * ZSPLIT, nob, ob);
                    pg8::EpiZ E{(bf16*)(ws + WS_ZRKV), (bf16*)(ws + WS_ZL), (bf16*)(ws + WS_GUV), (bf16*)(ws + WS_SG), (bf16*)nullptr, 30 - ZSPLIT};
                    pg8::gemm_phase<pg8::EpiZ, pg8::StaticOrder, true, true>(ring, g, S, E, F.wave0); }
                {   pg8::Gemm g{(const bf16*)(db + DB_PB), (const bf16*)(db + DB_PLEW), T, 1024, 256, 256}; pg8::StaticOrder S; S.init(T, 1024, nob, ob);
                    pg8::EpiPlain E{(bf16*)(ws + WS_PW), 1024};
                    pg8::gemm_phase<pg8::EpiPlain, pg8::StaticOrder, true, true>(ring, g, S, E, F.wave0); }
                if (layer == 0) prep_phase(F, args, 0, ob, nob, 2);
                if (layer + 1 < DEPTH) prep_phase(F, args, layer + 1, ob, nob, 3); } }
        }
        xcd_barrier(bar, F.wave0);
        {   OPQ();
        for (int rep = 0; rep < REP_G; ++rep) {   if (rep) xcd_barrier(bar, F.wave0); pg8::Gemm g{(const bf16*)(ws + WS_G), (const bf16*)(db + DB_PA), T, 1024, 1024, 1024}; pg8::StaticOrder S; S.init(T, 1024, F.G, F.bx);
            pg8::EpiMerge<true> E{(const bf16*)(ws + WS_SG), (bf16*)(ws + WS_GUV) + 1024, (bf16*)(ws + WS_MG)};
            pg8::gemm_phase<pg8::EpiMerge<true>, pg8::StaticOrder, true, true>(ring, g, S, E, F.wave0); }
        }
        xcd_barrier(bar, F.wave0);
        {   OPQ();
        {   pg8::Gemm g{(const bf16*)(ws + WS_MG), (const bf16*)(db + DB_POUT), T, 1024, 1024, 1024}; pg8::StaticOrder S; S.init(T, 1024, F.G, F.bx);
            pg8::EpiResid E{F.h};
            pg8::gemm_phase<pg8::EpiResid, pg8::StaticOrder, true, true>(ring, g, S, E, F.wave0); }
        }
        xcd_barrier(bar, F.wave0);
        {   OPQ();
        for (int rep = 0; rep < REP_I; ++rep) {   if (rep) xcd_barrier(bar, F.wave0); phase_ids(F); const int gw = F.bx * NWAVES + F.wave, NGW = F.G * NWAVES; const float* g2 = args.in[3] + (size_t)layer * 1024;
            for (int m = gw; m < T / 2; m += NGW) norm_row_n2x2(F.h + (size_t)m * D, F.h + (size_t)(m + T / 2) * D, g2, (bf16*)(ws + WS_N2) + (size_t)m * D, (bf16*)(ws + WS_N2) + (size_t)(m + T / 2) * D, F.lane); }
        }
        xcd_barrier(bar, F.wave0);
        {   OPQ();
        {   pg8::Gemm g{(const bf16*)(ws + WS_N2), (const bf16*)(db + DB_WQG), T, 3072, 1024, 1024}; pg8::StaticOrder S; S.init(T, 3072, F.G, F.bx);
            pg8::EpiQG E{(bf16*)(ws + WS_Q), (const bf16*)(ws + WS_PW), F.h};
            pg8::gemm_phase<pg8::EpiQG, pg8::StaticOrder, true, true>(ring, g, S, E, F.wave0); }
        }
        xcd_barrier(bar, F.wave0);
        {   OPQ();
        for (int u = F.bx; u < T / 128; u += F.G) peer_unit(F, args, layer, u, layer == DEPTH - 1);
        }
        if (layer + 1 < DEPTH) xcd_barrier(bar, F.wave0);
    }
}

extern "C" void kernel_launch(void* const* d_in, const int* in_sizes, int n_in, void* d_out, int out_size, void* d_ws, size_t ws_size, hipStream_t stream) {
    static int grid = 0;
    if (grid == 0) {
        if (n_in != 32 || out_size != T * D || ws_size < WS_END) { fprintf(stderr, "kernel_launch: unexpected sizes n_in %d out %d ws %zu (need %zu); nothing launched\n", n_in, out_size, ws_size, (size_t)WS_END); grid = -1; return; }
        int dev = 0, cus = 0, per_cu = 0;
        if (hipGetDevice(&dev) != hipSuccess || hipDeviceGetAttribute(&cus, hipDeviceAttributeMultiprocessorCount, dev) != hipSuccess) { grid = -1; return; }
        if (hipFuncSetAttribute((const void*)trunk_fwd, hipFuncAttributeMaxDynamicSharedMemorySize, LDS_BYTES) != hipSuccess) { fprintf(stderr, "kernel_launch: hipFuncSetAttribute failed\n"); grid = -1; return; }
        if (hipOccupancyMaxActiveBlocksPerMultiprocessor(&per_cu, (const void*)trunk_fwd, NWAVES * 64, LDS_BYTES) != hipSuccess || per_cu < 1)
            fprintf(stderr, "kernel_launch: note: occupancy query reports %d workgroups per CU\n", per_cu);
        (void)hipGetLastError();
        grid = cus;
    }
    if (grid < 0) return;
    (void)hipMemsetAsync((char*)d_ws + WS_CTL, 0, ZERO_BYTES, stream);
    (void)hipMemsetAsync((char*)d_ws + WIN_ZERO_OFF, 0, WIN_ZERO_BYTES, stream);
    Args a{};
    for (int i = 0; i < 32; ++i) a.in[i] = (const float*)d_in[i];
    a.out = (float*)d_out; a.ws = (unsigned char*)d_ws;
    hipLaunchKernelGGL(trunk_fwd, dim3(grid), dim3(NWAVES * 64), LDS_BYTES, stream, a);
    const hipError_t le = hipPeekAtLastError();
    if (le != hipSuccess) fprintf(stderr, "kernel_launch: launch failed: %s\n", hipGetErrorName(le));
}
```

```cpp
#include <hip/hip_runtime.h>
#include <cstdio>
#include <cstdint>
#define ZSPLIT 4
namespace pg8 {
#define PG8_LAS __attribute__((address_space(3)))
typedef unsigned short bf16_t;
typedef short bf16x8 __attribute__((ext_vector_type(8)));
typedef float f32x4 __attribute__((ext_vector_type(4)));
typedef unsigned u32x4 __attribute__((ext_vector_type(4)));
constexpr int BM = 256, BK = 64, HALF = 128, HTB = HALF * BK * 2  , STAGE_BYTES = 8 * HTB, NXCD = 8, WGM = 8;

__host__ __device__ __forceinline__ int lds_byte(int r, int c) { const int st = (r >> 4) * 2 + (c >> 5), rr = r & 15, cc = c & 31, ob = rr * 64 + cc * 2; return st * 1024 + (ob ^ (((ob >> 9) & 1) << 5)); }
__host__ __device__ __forceinline__ void stage_rc(int b, int& R, int& C) { const int st = b / 1024, sb = b % 1024, swz = sb ^ (((sb >> 9) & 1) << 5); R = (st >> 1) * 16 + swz / 64; C = (st & 1) * 32 + (swz % 64) / 2; }
__host__ __device__ __forceinline__ int perm32(int rho) { const int n = rho >> 4, i = rho & 15; return 8 * (i >> 2) + 4 * n + (i & 3); }

struct Unit { int pm, pn; };
struct Gemm { const bf16_t* A; const bf16_t* Bt; int M, N, K, lda; };

struct StaticOrder {
    int nM, nN, nwg, G, c;
    __host__ __device__ void init(int M, int N, int G_, int c_) { nM = M / BM; nN = N / BM; nwg = nM * nN; G = G_; c = c_; }
    __host__ __device__ bool next(int i, Unit& u) const {
        const long L = (long)i * G + c; if (L >= nwg) return false;
        int wgid = (int)L; { const int q = nwg / NXCD, r = nwg % NXCD, xcd = wgid % NXCD, off = wgid / NXCD; wgid = (xcd < r ? xcd * (q + 1) : r * (q + 1) + (xcd - r) * q) + off; }
        const int nig = WGM * nN, gid = wgid / nig, fm = gid * WGM, gsz = (nM - fm) < WGM ? (nM - fm) : WGM;
        u.pm = fm + ((wgid % nig) % gsz); u.pn = (wgid % nig) / gsz; return true;
    }
    __device__ __forceinline__ void a_ready(const Unit&) const {}
    __device__ __forceinline__ void done(const Unit&) const {}
};
struct PanelOrder {
    int first, stride, nM, nN, pn0;
    __host__ __device__ bool next(int i, Unit& u) const { const int p = first + (i / nN) * stride; if (p >= nM) return false; u.pm = p; u.pn = pn0 + i % nN; return true; }
    __device__ __forceinline__ void a_ready(const Unit&) const {}
    __device__ __forceinline__ void done(const Unit&) const {}
};
__device__ __forceinline__ unsigned cvt_pk_bf16(float lo, float hi) { unsigned r; asm volatile("v_cvt_pk_bf16_f32 %0, %1, %2" : "=v"(r) : "v"(lo), "v"(hi)); return r; }

__device__ __forceinline__ float fsig(float x) { return __builtin_amdgcn_rcpf(1.f + __builtin_amdgcn_exp2f(-1.44269504f * x)); }
__device__ __forceinline__ float fgelu(float x) { return x * fsig(1.5957691216f * (x + 0.044715f * x * x * x)); }
__device__ __forceinline__ float bflo(unsigned w) { return __builtin_bit_cast(float, w << 16); }
__device__ __forceinline__ float bfhi(unsigned w) { return __builtin_bit_cast(float, w & 0xffff0000u); }
__device__ __forceinline__ void unpk8(const u32x4 w, f32x4& a, f32x4& b) { a = (f32x4){bflo(w.x), bfhi(w.x), bflo(w.y), bfhi(w.y)}; b = (f32x4){bflo(w.z), bfhi(w.z), bflo(w.w), bfhi(w.w)}; }
__device__ __forceinline__ u32x4 pk8(const f32x4 a, const f32x4 b) { u32x4 w; w.x = cvt_pk_bf16(a[0], a[1]); w.y = cvt_pk_bf16(a[2], a[3]); w.z = cvt_pk_bf16(b[0], b[1]); w.w = cvt_pk_bf16(b[2], b[3]); return w; }
__device__ __forceinline__ f32x4 act4(f32x4 v, int kind) {
    if (kind == 1) { v = (f32x4){fgelu(v[0]), fgelu(v[1]), fgelu(v[2]), fgelu(v[3])}; }
    else if (kind == 2) { v = (f32x4){fsig(v[0]), fsig(v[1]), fsig(v[2]), fsig(v[3])}; }
    else if (kind == 3) { v = (f32x4){2.f * fsig(2.f * v[0]) - 1.f, 2.f * fsig(2.f * v[1]) - 1.f, 2.f * fsig(2.f * v[2]) - 1.f, 2.f * fsig(2.f * v[3]) - 1.f}; }
    return v;
}
#define EPI_ROWS_BEGIN _Pragma("unroll") for (int ai = 0; ai < 2; ++ai) _Pragma("unroll") for (int m = 0; m < 4; ++m) { const size_t row = (size_t)(row0 + ai * HALF + m * 16);
#define EPI_ROWS_END }

struct EpiZ {
    static constexpr bool PERM = true, AFTER_DRAIN = false;
    bf16_t *zrkv, *zl, *guv, *sg, *vf; int pnoff;
    __device__ __forceinline__ void operator()(const f32x4 (&acc)[2][2][4][2], const Unit& u, int wr, int wc, int fr, int fq) const {
        const int pn = u.pn + pnoff, row0 = u.pm * BM + wr * 64 + fr;
        bf16_t* dst; int ld, colt, k0, k1;
        if (pn < 12)       { dst = zrkv; ld = 3072; colt = pn * 256;        k0 = 0; k1 = 0; }
        else if (pn == 12) { dst = zl;   ld = 512;  colt = 0;               k0 = (wc < 2) ? 3 : 0; k1 = 2; }
        else if (pn == 13) { dst = zl;   ld = 512;  colt = 256;             k0 = 0; k1 = 0; }
        else if (pn < 22)  { dst = guv;  ld = 2048; colt = (pn - 14) * 256; k0 = 1; k1 = 1; }
        else               { dst = sg;   ld = 2048; colt = ((pn - 18) & 7) * 256; k0 = 2; k1 = 2; }
        const int col0 = colt + wc * 32 + 8 * fq;
        const bool dovf = (vf != nullptr) && pn >= 8 && pn < 12;
        const int vcol0 = (pn - 8) * 256 + wc * 32 + 8 * fq;
        EPI_ROWS_BEGIN
            bf16_t* rowp = dst + row * ld + col0;
#pragma unroll
            for (int bj = 0; bj < 2; ++bj) { const int kind = bj ? k1 : k0;
                const u32x4 w = pk8(act4(acc[ai][bj][m][0], kind), act4(acc[ai][bj][m][1], kind));
                *(u32x4*)(rowp + bj * HALF) = w;
                if (dovf) *(u32x4*)(vf + row * 1024 + vcol0 + bj * HALF) = w; }
        EPI_ROWS_END
    }
};
struct EpiLora {
    static constexpr bool PERM = true, AFTER_DRAIN = false;
    bf16_t* ew; size_t stride; const float *w0, *a0; int pnoff;
    __device__ __forceinline__ void operator()(const f32x4 (&acc)[2][2][4][2], const Unit& u, int wr, int wc, int fr, int fq) const {
        const int pn = u.pn + pnoff, sel = pn >> 2, row0 = u.pm * BM + wr * 64 + fr, col0 = (pn & 3) * 256 + wc * 32 + 8 * fq;
        bf16_t* dst = ew + (size_t)sel * stride;
        const float* bp = sel == 0 ? w0 : a0;
        f32x4 bv[2][2];
#pragma unroll
        for (int bj = 0; bj < 2; ++bj)
#pragma unroll
            for (int n = 0; n < 2; ++n) bv[bj][n] = (sel < 2) ? *(const f32x4*)(bp + col0 + bj * HALF + 4 * n) : (f32x4){0.f, 0.f, 0.f, 0.f};
        EPI_ROWS_BEGIN
            bf16_t* rowp = dst + row * 1024 + col0;
#pragma unroll
            for (int bj = 0; bj < 2; ++bj) { f32x4 v0 = acc[ai][bj][m][0] + bv[bj][0], v1 = acc[ai][bj][m][1] + bv[bj][1];
                if (sel < 2) { v0 = act4(v0, 2); v1 = act4(v1, 2); }
                if (sel == 0) { v0 = v0 * 0.60653066f; v1 = v1 * 0.60653066f; }
                *(u32x4*)(rowp + bj * HALF) = pk8(v0, v1); }
        EPI_ROWS_END
    }
};
struct EpiMv {
    static constexpr bool PERM = true, AFTER_DRAIN = false;
    bf16_t* zrkv; const bf16_t* vf; const float* v0b;
    __device__ __forceinline__ void operator()(const f32x4 (&acc)[2][2][4][2], const Unit& u, int wr, int wc, int fr, int fq) const {
        const int row0 = u.pm * BM + wr * 64 + fr, col0 = u.pn * 256 + wc * 32 + 8 * fq;
        f32x4 bv[2][2];
#pragma unroll
        for (int bj = 0; bj < 2; ++bj)
#pragma unroll
            for (int n = 0; n < 2; ++n) bv[bj][n] = *(const f32x4*)(v0b + col0 + bj * HALF + 4 * n);
        EPI_ROWS_BEGIN
#pragma unroll
            for (int bj = 0; bj < 2; ++bj) { bf16_t* zp = zrkv + row * 3072 + 2048 + col0 + bj * HALF;
                f32x4 z0, z1, f0, f1; unpk8(*(const u32x4*)zp, z0, z1); unpk8(*(const u32x4*)(vf + row * 1024 + col0 + bj * HALF), f0, f1);
                const f32x4 m0 = act4(acc[ai][bj][m][0] + bv[bj][0], 2), m1 = act4(acc[ai][bj][m][1] + bv[bj][1], 2);
                *(u32x4*)zp = pk8(z0 + (f0 - z0) * m0, z1 + (f1 - z1) * m1); }
        EPI_ROWS_END
    }
};
struct EpiPlain {
    static constexpr bool PERM = true, AFTER_DRAIN = false;
    bf16_t* o; int ld;
    __device__ __forceinline__ void operator()(const f32x4 (&acc)[2][2][4][2], const Unit& u, int wr, int wc, int fr, int fq) const {
        const int row0 = u.pm * BM + wr * 64 + fr, col0 = u.pn * 256 + wc * 32 + 8 * fq;
        EPI_ROWS_BEGIN
#pragma unroll
            for (int bj = 0; bj < 2; ++bj) *(u32x4*)(o + row * ld + col0 + bj * HALF) = pk8(acc[ai][bj][m][0], acc[ai][bj][m][1]);
        EPI_ROWS_END
    }
};
template <bool SECOND> struct EpiMerge {
    static constexpr bool PERM = true, AFTER_DRAIN = false;
    const bf16_t* sg; bf16_t* m2; bf16_t* o;
    __device__ __forceinline__ void operator()(const f32x4 (&acc)[2][2][4][2], const Unit& u, int wr, int wc, int fr, int fq) const {
        const int row0 = u.pm * BM + wr * 64 + fr, col0 = u.pn * 256 + wc * 32 + 8 * fq;
#pragma unroll
        for (int ai = 0; ai < 2; ++ai) { u32x4 gv[4][2], pv[4][2];
#pragma unroll
            for (int m = 0; m < 4; ++m) { const size_t row = (size_t)(row0 + ai * HALF + m * 16);
#pragma unroll
                for (int bj = 0; bj < 2; ++bj) { const int c = col0 + bj * HALF; gv[m][bj] = *(const u32x4*)(sg + row * 2048 + (SECOND ? 0 : 1024) + c);
                    if (SECOND) pv[m][bj] = *(const u32x4*)(m2 + row * 2048 + c); } }
#pragma unroll
            for (int m = 0; m < 4; ++m) { const size_t row = (size_t)(row0 + ai * HALF + m * 16);
#pragma unroll
                for (int bj = 0; bj < 2; ++bj) { const int c = col0 + bj * HALF;
                    f32x4 g0, g1; unpk8(gv[m][bj], g0, g1);
                    f32x4 v0 = g0 * acc[ai][bj][m][0], v1 = g1 * acc[ai][bj][m][1];
                    if (SECOND) { f32x4 p0, p1; unpk8(pv[m][bj], p0, p1); v0 = v0 + p0; v1 = v1 + p1; *(u32x4*)(o + row * 1024 + c) = pk8(v0, v1); }
                    else *(u32x4*)(m2 + row * 2048 + c) = pk8(v0, v1); } } }
    }
};
struct EpiResid {
    static constexpr bool PERM = false, AFTER_DRAIN = false;
    float* h;
    __device__ __forceinline__ void operator()(const f32x4 (&acc)[2][2][4][2], const Unit& u, int wr, int wc, int fr, int fq) const {
        const int row0 = u.pm * BM + wr * 64 + fr, col0 = u.pn * 256 + wc * 32 + 4 * fq;
#pragma unroll
        for (int ai = 0; ai < 2; ++ai) { f32x4 hv[4][2][2];
#pragma unroll
            for (int m = 0; m < 4; ++m) { const float* rowp = h + (size_t)(row0 + ai * HALF + m * 16) * 1024 + col0;
#pragma unroll
                for (int bj = 0; bj < 2; ++bj)
#pragma unroll
                    for (int n = 0; n < 2; ++n) hv[m][bj][n] = *(const f32x4*)(rowp + bj * HALF + n * 16); }
#pragma unroll
            for (int m = 0; m < 4; ++m) { float* rowp = h + (size_t)(row0 + ai * HALF + m * 16) * 1024 + col0;
#pragma unroll
                for (int bj = 0; bj < 2; ++bj)
#pragma unroll
                    for (int n = 0; n < 2; ++n) *(f32x4*)(rowp + bj * HALF + n * 16) = hv[m][bj][n] + acc[ai][bj][m][n]; } }
    }
};
struct EpiQG {
    static constexpr bool PERM = true, AFTER_DRAIN = false;
    bf16_t* q; const bf16_t* pw; float* h;
    __device__ __forceinline__ void operator()(const f32x4 (&acc)[2][2][4][2], const Unit& u, int wr, int wc, int fr, int fq) const {
        const int row0 = u.pm * BM + wr * 64 + fr;
        if (u.pn < 8) { const int col0 = u.pn * 256 + wc * 32 + 8 * fq;
            EPI_ROWS_BEGIN
#pragma unroll
                for (int bj = 0; bj < 2; ++bj) *(u32x4*)(q + row * 2048 + col0 + bj * HALF) = pk8(acc[ai][bj][m][0], acc[ai][bj][m][1]);
            EPI_ROWS_END
        } else { const int col0 = (u.pn - 8) * 256 + wc * 32 + 8 * fq;
#pragma unroll
            for (int ai = 0; ai < 2; ++ai)
#pragma unroll
            for (int mh = 0; mh < 2; ++mh) { u32x4 pwv[2][2]; f32x4 hv[2][2][2];
#pragma unroll
                for (int m2_ = 0; m2_ < 2; ++m2_) { const size_t row = (size_t)(row0 + ai * HALF + (2 * mh + m2_) * 16);
#pragma unroll
                    for (int bj = 0; bj < 2; ++bj) { const int c = col0 + bj * HALF; pwv[m2_][bj] = *(const u32x4*)(pw + row * 1024 + c);
                        hv[m2_][bj][0] = *(const f32x4*)(h + row * 1024 + c); hv[m2_][bj][1] = *(const f32x4*)(h + row * 1024 + c + 4); } }
#pragma unroll
                for (int m2_ = 0; m2_ < 2; ++m2_) { const int m = 2 * mh + m2_; const size_t row = (size_t)(row0 + ai * HALF + m * 16);
#pragma unroll
                    for (int bj = 0; bj < 2; ++bj) { const int c = col0 + bj * HALF; f32x4 p0, p1; unpk8(pwv[m2_][bj], p0, p1);
                        *(f32x4*)(h + row * 1024 + c) = hv[m2_][bj][0] + p0 * act4(acc[ai][bj][m][0], 2); *(f32x4*)(h + row * 1024 + c + 4) = hv[m2_][bj][1] + p1 * act4(acc[ai][bj][m][1], 2); } } }
        }
    }
};
template <class Epi, class Sched, bool ALIGN_EPI = false, bool SP2 = false>
__device__ __forceinline__ void gemm_phase(PG8_LAS unsigned char* lds, const Gemm g, const Sched& S, const Epi& E, const int wave0) {
    int tidq; asm volatile("v_mbcnt_lo_u32_b32 %0, -1, 0\n\tv_mbcnt_hi_u32_b32 %0, -1, %0" : "=v"(tidq)); tidq += wave0 * 64;
    const int tid = tidq, wid = __builtin_amdgcn_readfirstlane(tid >> 6), lane = tid & 63, wr = wid >> 2, wc = wid & 3, fr = lane & 15, fq = lane >> 4;
    int Kq = g.K, ldaq = g.lda; const bf16_t* gA = g.A; const bf16_t* gB = g.Bt; asm volatile("" : "+s"(Kq), "+s"(ldaq), "+s"(gA), "+s"(gB));
    const int K = Kq, nt = K / BK;
    unsigned voffA[2], voffB[2];
#pragma unroll
    for (int i = 0; i < 2; ++i) { int R, C; stage_rc(tid * 16 + i * 8192, R, C); const int Rb = Epi::PERM ? ((R & ~31) + perm32(R & 31)) : R;
        voffA[i] = (unsigned)(R * ldaq + C) * 2u; voffB[i] = (unsigned)(Rb * K + C) * 2u; }
    const size_t kstep = (size_t)(BK * 2);
    const size_t hstepA = (size_t)HALF * ldaq * 2, hstepB = (size_t)HALF * K * 2;
    const size_t tstepA = 2 * hstepA, tstepB = 2 * hstepB;
    const unsigned ldsw = (unsigned)wid * 1024u;
    const int aoff = lds_byte(wr * 64 + fr, fq * 8), boff = lds_byte(wc * 32 + fr, fq * 8);
#define PG8_SA(b, h) (((b) * 2 + (h)) * HTB)
#define PG8_SB(b, h) ((4 + (b) * 2 + (h)) * HTB)
#define PG8_STAGE(bufoff, gbase, voff) do { _Pragma("unroll") for (int _i = 0; _i < 2; ++_i) \
        __builtin_amdgcn_global_load_lds((const unsigned*)((const char*)(gbase) + (voff)[_i]), (PG8_LAS unsigned*)(lds + (bufoff) + ldsw + _i * 8192), 16, 0, 0); } while (0)
#define PG8_LDA(dst, b, h) do { _Pragma("unroll") for (int m = 0; m < 4; ++m) _Pragma("unroll") for (int k = 0; k < 2; ++k) dst[m][k] = *(const PG8_LAS bf16x8*)(lds + PG8_SA(b, h) + aoff + m * 2048 + k * 1024); } while (0)
#define PG8_LDB(dst, b, h) do { _Pragma("unroll") for (int n = 0; n < 2; ++n) _Pragma("unroll") for (int k = 0; k < 2; ++k) dst[n][k] = *(const PG8_LAS bf16x8*)(lds + PG8_SB(b, h) + boff + n * 2048 + k * 1024); } while (0)
#define PG8_MMA(ai, bj, At, Bt) do { __builtin_amdgcn_s_setprio(1); _Pragma("unroll") for (int m = 0; m < 4; ++m) _Pragma("unroll") for (int n = 0; n < 2; ++n) _Pragma("unroll") for (int k = 0; k < 2; ++k) \
        acc[ai][bj][m][n] = __builtin_amdgcn_mfma_f32_16x16x32_bf16(Bt[n][k], At[m][k], acc[ai][bj][m][n], 0, 0, 0); __builtin_amdgcn_s_setprio(0); } while (0)
#define PG8_WAIT_V(n) asm volatile("s_waitcnt vmcnt(" #n ")" ::: "memory")
#define PG8_WAIT_L(n) asm volatile("s_waitcnt lgkmcnt(" #n ")" ::: "memory")
#define PG8_BAR __builtin_amdgcn_s_barrier()
#define PG8_SCHED __builtin_amdgcn_sched_barrier(0)
    Unit cur, nxt; int ui = 0;
    if (!S.next(0, cur)) return;
    f32x4 acc[2][2][4][2];
#pragma unroll
    for (int a = 0; a < 2; ++a)
#pragma unroll
        for (int b = 0; b < 2; ++b)
#pragma unroll
            for (int m = 0; m < 4; ++m)
#pragma unroll
                for (int n = 0; n < 2; ++n) acc[a][b][m][n] = (f32x4){0.f, 0.f, 0.f, 0.f};
    bf16x8 At[4][2], B0[2][2], B1[2][2];
    const char* cA = (const char*)gA + (size_t)cur.pm * tstepA; const char* cB = (const char*)gB + (size_t)cur.pn * tstepB;
    S.a_ready(cur);
    if constexpr (SP2) {
        PG8_STAGE(PG8_SB(0, 0), cB, voffB); PG8_STAGE(PG8_SB(0, 1), cB + hstepB, voffB); PG8_STAGE(PG8_SA(0, 0), cA, voffA); PG8_STAGE(PG8_SA(0, 1), cA + hstepA, voffA);
        if (wr == 1) PG8_BAR;
        PG8_WAIT_V(2); PG8_BAR;
        PG8_STAGE(PG8_SB(1, 0), cB + kstep, voffB); PG8_STAGE(PG8_SA(1, 0), cA + kstep, voffA); PG8_STAGE(PG8_SB(1, 1), cB + hstepB + kstep, voffB);
        PG8_WAIT_V(6); PG8_BAR;
    } else {
        PG8_STAGE(PG8_SB(0, 0), cB, voffB); PG8_STAGE(PG8_SA(0, 0), cA, voffA); PG8_STAGE(PG8_SB(0, 1), cB + hstepB, voffB); PG8_STAGE(PG8_SA(0, 1), cA + hstepA, voffA);
        if (wr == 1) PG8_BAR;
        PG8_WAIT_V(4); PG8_BAR;
        PG8_STAGE(PG8_SB(1, 0), cB + kstep, voffB); PG8_STAGE(PG8_SA(1, 0), cA + kstep, voffA); PG8_STAGE(PG8_SB(1, 1), cB + hstepB + kstep, voffB);
        PG8_WAIT_V(6); PG8_BAR;
    }
    for (;;) {
        const bool has_next = S.next(ui + 1, nxt);
        const char* nA = has_next ? (const char*)gA + (size_t)nxt.pm * tstepA : cA; const char* nB = has_next ? (const char*)gB + (size_t)nxt.pn * tstepB : cB;
        for (int t = 0; t < nt; t += 2) {
            const bool last = (t == nt - 2);
            const char* a1 = cA + (size_t)(t + 1) * kstep;
            const char* a2 = last ? nA : cA + (size_t)(t + 2) * kstep; const char* b2 = last ? nB : cB + (size_t)(t + 2) * kstep;
            const char* a3 = a2 + kstep; const char* b3 = b2 + kstep;
            if (last && has_next) S.a_ready(nxt);
            if constexpr (SP2) {
            PG8_LDB(B0, 0, 0); PG8_LDB(B1, 0, 1); PG8_SCHED; PG8_LDA(At, 0, 0); PG8_STAGE(PG8_SA(1, 1), a1 + hstepA, voffA);
            PG8_WAIT_V(8); PG8_WAIT_L(0); PG8_BAR; PG8_MMA(0, 0, At, B0); PG8_MMA(0, 1, At, B1); PG8_BAR; PG8_SCHED;
            PG8_LDA(At, 0, 1); PG8_STAGE(PG8_SB(0, 0), b2, voffB); PG8_STAGE(PG8_SB(0, 1), b2 + hstepB, voffB); PG8_STAGE(PG8_SA(0, 0), a2, voffA);
            PG8_WAIT_V(8); PG8_WAIT_L(0); PG8_BAR; PG8_MMA(1, 0, At, B0); PG8_MMA(1, 1, At, B1); PG8_BAR; PG8_SCHED;
            PG8_LDB(B0, 1, 0); PG8_LDB(B1, 1, 1); PG8_SCHED; PG8_LDA(At, 1, 0); PG8_STAGE(PG8_SA(0, 1), a2 + hstepA, voffA);
            PG8_WAIT_V(8); PG8_WAIT_L(0); PG8_BAR; PG8_MMA(0, 0, At, B0); PG8_MMA(0, 1, At, B1); PG8_BAR; PG8_SCHED;
            PG8_LDA(At, 1, 1); PG8_STAGE(PG8_SB(1, 0), b3, voffB); PG8_STAGE(PG8_SB(1, 1), b3 + hstepB, voffB); PG8_STAGE(PG8_SA(1, 0), a3, voffA);
            PG8_WAIT_V(8); PG8_WAIT_L(0); PG8_BAR; PG8_MMA(1, 0, At, B0); PG8_MMA(1, 1, At, B1); PG8_BAR; PG8_SCHED;
            } else {
            PG8_LDB(B0, 0, 0); PG8_SCHED; PG8_LDA(At, 0, 0); PG8_STAGE(PG8_SA(1, 1), a1 + hstepA, voffA);
            PG8_WAIT_L(8); PG8_BAR; PG8_WAIT_L(0); PG8_MMA(0, 0, At, B0); PG8_BAR; PG8_SCHED;
            PG8_LDB(B1, 0, 1); PG8_STAGE(PG8_SB(0, 0), b2, voffB);
            PG8_BAR; PG8_WAIT_L(0); PG8_MMA(0, 1, At, B1); PG8_BAR;
            PG8_LDA(At, 0, 1); PG8_STAGE(PG8_SA(0, 0), a2, voffA);
            PG8_BAR; PG8_WAIT_L(0); PG8_MMA(1, 0, At, B0); PG8_BAR; PG8_SCHED;
            PG8_STAGE(PG8_SB(0, 1), b2 + hstepB, voffB);
            PG8_WAIT_V(6); PG8_BAR; PG8_MMA(1, 1, At, B1); PG8_BAR;
            PG8_LDB(B0, 1, 0); PG8_SCHED; PG8_LDA(At, 1, 0); PG8_STAGE(PG8_SA(0, 1), a2 + hstepA, voffA);
            PG8_WAIT_L(8); PG8_BAR; PG8_WAIT_L(0); PG8_MMA(0, 0, At, B0); PG8_BAR; PG8_SCHED;
            PG8_LDB(B1, 1, 1); PG8_STAGE(PG8_SB(1, 0), b3, voffB);
            PG8_BAR; PG8_WAIT_L(0); PG8_MMA(0, 1, At, B1); PG8_BAR;
            PG8_LDA(At, 1, 1); PG8_STAGE(PG8_SA(1, 0), a3, voffA);
            PG8_BAR; PG8_WAIT_L(0); PG8_MMA(1, 0, At, B0); PG8_BAR; PG8_SCHED;
            PG8_STAGE(PG8_SB(1, 1), b3 + hstepB, voffB);
            PG8_WAIT_V(6); PG8_BAR; PG8_MMA(1, 1, At, B1); PG8_BAR;
            }
        }
        if constexpr (ALIGN_EPI) { if (wr == 0) PG8_BAR; }
        if constexpr (!Epi::AFTER_DRAIN) { E(acc, cur, wr, wc, fr, fq); S.done(cur); }
        if (!has_next) break;
#pragma unroll
        for (int a = 0; a < 2; ++a)
#pragma unroll
            for (int b = 0; b < 2; ++b)
#pragma unroll
                for (int m = 0; m < 4; ++m)
#pragma unroll
                    for (int n = 0; n < 2; ++n) acc[a][b][m][n] = (f32x4){0.f, 0.f, 0.f, 0.f};
        cur = nxt; cA = nA; cB = nB; ++ui;
        if constexpr (ALIGN_EPI) { if (wr == 1) PG8_BAR; }
    }
    PG8_WAIT_V(0);
    if constexpr (!ALIGN_EPI) { if (wr == 0) PG8_BAR; }
    PG8_BAR;
    if constexpr (Epi::AFTER_DRAIN) { E.fused(acc, cur, wr, wc, fr, fq, lds, wid, lane); S.done(cur); }
#undef PG8_SA
#undef PG8_SB
#undef PG8_STAGE
#undef PG8_LDA
#undef PG8_LDB
#undef PG8_MMA
#undef PG8_WAIT_V
#undef PG8_WAIT_L
#undef PG8_BAR
#undef PG8_SCHED
}
}

constexpr int NB = 8, SEQ = 4096, T = NB * SEQ, D = 1024, DEPTH = 4, NZ = 7680, NWAVES = 8;
constexpr int CIN = 7424;
constexpr size_t MiB = 1u << 20;
constexpr size_t WS_CTL = 0, WS_LORA = 1 * MiB, WS_MV = 7 * MiB, ZERO_BYTES = 9 * MiB;
constexpr size_t LORA_BYTES = 3072 * 256 * 2, MV_BYTES = 1024 * 256 * 2;
constexpr size_t WS_WIN = 10 * MiB;
constexpr size_t WS_DB = 40 * MiB, DB_SET = 62 * MiB;
constexpr size_t DB_PA = 0, DB_PBT = 2 * MiB, DB_POUT = 4 * MiB, DB_WQG = 6 * MiB, DB_KEYS = 12 * MiB, DB_GMW = 12 * MiB + 512 * 1024, DB_PLEW = 13 * MiB, DB_U = 14 * MiB, DB_V = 30 * MiB, DB_PB = 46 * MiB;
constexpr size_t WS_VF = 164 * MiB, WS_PW = 228 * MiB, WS_NX = 292 * MiB, WS_ZRKV = 420 * MiB, WS_ZL = 612 * MiB, WS_GUV = 644 * MiB, WS_SG = 772 * MiB;
constexpr size_t WS_EW = 900 * MiB, WS_AR = 964 * MiB, WS_G = 1028 * MiB, WS_WINB = 1092 * MiB, WINB_BYTES = 4 * MiB, WS_END = 1100 * MiB;
constexpr size_t WS_Q = WS_ZRKV, WS_SEL = WS_ZRKV + 128 * MiB, WS_MG = WS_AR, WS_N2 = WS_G;
constexpr size_t WIN_ZERO_OFF = WS_WIN + (size_t)3328 * 2048 * 2, WIN_ZERO_BYTES = (size_t)256 * 2048 * 2;
#ifndef ZSPLIT
#define ZSPLIT 2
#endif
constexpr int CW_BAR = 4096;
constexpr int RING_BYTES = 131072, LDSCTL_OFF = RING_BYTES, MISC_OFF = LDSCTL_OFF + 320, LDS_BYTES = 147456;

#define LAS __attribute__((address_space(3)))
#define GAS __attribute__((address_space(1)))
typedef unsigned short bf16;
typedef unsigned v4u __attribute__((ext_vector_type(4)));
typedef unsigned v2u __attribute__((ext_vector_type(2)));
typedef float f32x4 __attribute__((ext_vector_type(4)));
typedef float f32x2 __attribute__((ext_vector_type(2)));
typedef short bf16x8 __attribute__((ext_vector_type(8)));
using pg8::fsig; using pg8::fgelu; using pg8::bflo; using pg8::bfhi; using pg8::unpk8; using pg8::pk8; using pg8::cvt_pk_bf16;

#define XB_TMO      128
#define XB_XCNT(j)  (256  + 64 * (j))
#define XB_XSUB(j)  (1280 + 64 * (j))
#define XB_XGEN(j)  (2304 + 64 * (j))
#define XB_TOP      3328
#define XB_TOPGEN   3392
#define XCD_BAR_WORDS 3456
#define XB_SPIN_CAP (1u << 22)

__device__ __forceinline__ unsigned xb_ld(unsigned* p)              { return __hip_atomic_load(p, __ATOMIC_RELAXED, __HIP_MEMORY_SCOPE_AGENT); }
__device__ __forceinline__ unsigned xb_add(unsigned* p, unsigned v) { return __hip_atomic_fetch_add(p, v, __ATOMIC_RELAXED, __HIP_MEMORY_SCOPE_AGENT); }
__device__ __forceinline__ unsigned xb_xcc_id() { return (unsigned)__builtin_amdgcn_s_getreg((3 << 11) | 20) & 0xFu; }
#define XB_SPIN(cond, bar) do { unsigned _sp = 0; while (cond) { __builtin_amdgcn_s_sleep(1); \
    if ((++_sp & 255u) == 0u) { if (xb_ld(&(bar)[XB_TMO])) break; if (_sp > XB_SPIN_CAP) { atomicAdd(&(bar)[XB_TMO], 1u); break; } } } } while (0)

struct XcdBarrier { unsigned* bar; unsigned x; volatile LAS unsigned* st; };

__device__ __forceinline__ XcdBarrier xcd_barrier_post(unsigned* bar, volatile LAS unsigned* st) {
    XcdBarrier b; b.bar = bar; b.x = xb_xcc_id(); b.st = st;
    if (threadIdx.x == 0) (void)xb_add(&bar[XB_XCNT(b.x)], 1u);
    return b;
}
__device__ __forceinline__ void xcd_barrier_complete(unsigned* bar, unsigned x, unsigned& nloc, unsigned& nx) {
    const unsigned G = gridDim.x * gridDim.y * gridDim.z;
    unsigned sum, cnt, mine, sp = 0u;
    for (;;) {
        sum = 0u; cnt = 0u; mine = 0u;
#pragma unroll
        for (unsigned j = 0; j < 16; ++j) { const unsigned c = xb_ld(&bar[XB_XCNT(j)]); sum += c; cnt += (c > 0u) ? 1u : 0u; mine = (j == x) ? c : mine; }
        if (sum == G) break;
        __builtin_amdgcn_s_sleep(1);
        if ((++sp & 255u) == 0u) { if (xb_ld(&bar[XB_TMO])) break; if (sp > XB_SPIN_CAP) { atomicAdd(&bar[XB_TMO], 1u); break; } }
    }
    nloc = mine > 0u ? mine : 1u; nx = cnt > 0u ? cnt : 1u;
}
__device__ __forceinline__ int lane_id_now();
__device__ __forceinline__ void xcd_barrier(const XcdBarrier& b, const int wave0) {
    asm volatile("s_waitcnt vmcnt(0)" ::: "memory");
    __syncthreads();
    if (wave0 == 0 && lane_id_now() == 0) {
        unsigned* bar = b.bar;
        __builtin_amdgcn_s_waitcnt(0);
        unsigned nloc = b.st[0], nx = b.st[1];
        if (nloc == 0u) { xcd_barrier_complete(bar, b.x, nloc, nx); b.st[0] = nloc; b.st[1] = nx; }
        const unsigned old = xb_add(&bar[XB_XSUB(b.x)], 1u);
        const unsigned gen = old / nloc;
        if (old + 1u == (gen + 1u) * nloc) {
            __builtin_amdgcn_fence(__ATOMIC_RELEASE, "agent");
            asm volatile("s_waitcnt vmcnt(0)" ::: "memory");
            const unsigned og = xb_add(&bar[XB_TOP], 1u);
            const unsigned tg = og / nx;
            if (og + 1u == (tg + 1u) * nx) xb_add(&bar[XB_TOPGEN], 1u);
            else XB_SPIN(xb_ld(&bar[XB_TOPGEN]) == tg, bar);
            __builtin_amdgcn_fence(__ATOMIC_ACQUIRE, "agent");
            xb_add(&bar[XB_XGEN(b.x)], 1u);
            asm volatile("s_waitcnt vmcnt(0)" ::: "memory");
        } else {
            XB_SPIN(xb_ld(&bar[XB_XGEN(b.x)]) == gen, bar);
            __builtin_amdgcn_fence(__ATOMIC_ACQUIRE, "agent");
            asm volatile("s_waitcnt vmcnt(0)" ::: "memory");
        }
    }
    __syncthreads();
}

struct Args { const float* in[32]; float* out; unsigned char* ws; };
struct Frame {
    LAS unsigned char* lds;
    int tid, lane, wave, G, bx, wave0;
    GAS unsigned char* ws; float* h;
};
__device__ __forceinline__ int lane_id_now() { int l; asm volatile("v_mbcnt_lo_u32_b32 %0, -1, 0\n\tv_mbcnt_hi_u32_b32 %0, -1, %0" : "=v"(l)); return l; }
__device__ __forceinline__ void phase_ids(Frame& F) { const int l = lane_id_now(); F.lane = l; F.wave = F.wave0; F.tid = F.wave0 * 64 + l; GAS unsigned char* w = F.ws; asm volatile("" : "+s"(w)); F.ws = w; }
#define DPP_ADD(x, ctrl) ((x) + __builtin_bit_cast(float, __builtin_amdgcn_update_dpp(0, __builtin_bit_cast(int, (x)), (ctrl), 0xf, 0xf, false)))
__device__ __forceinline__ float sum8(float v) {
    v = DPP_ADD(v, 0xB1);
    v = DPP_ADD(v, 0x4E);
    v = DPP_ADD(v, 0x141);
    return v;
}
__device__ __forceinline__ float sum16(float v) { v = sum8(v); v = DPP_ADD(v, 0x140); return v; }
#define DPP_ADD_NS(x, ctrl) do { (x) = DPP_ADD((x), (ctrl)); asm("" : "+v"(x)); } while (0)
__device__ __forceinline__ float sum16_ns(float v) { DPP_ADD_NS(v, 0xB1); DPP_ADD_NS(v, 0x4E); DPP_ADD_NS(v, 0x141); DPP_ADD_NS(v, 0x140); return v; }
__device__ __forceinline__ float wave_sum(float v) {
    v = sum8(v);
    v = DPP_ADD(v, 0x140);
    const auto r = __builtin_amdgcn_permlane16_swap(__builtin_bit_cast(unsigned, v), __builtin_bit_cast(unsigned, v), false, false);
    v = __builtin_bit_cast(float, (unsigned)r[0]) + __builtin_bit_cast(float, (unsigned)r[1]);
    const auto q = __builtin_amdgcn_permlane32_swap(__builtin_bit_cast(unsigned, v), __builtin_bit_cast(unsigned, v), false, false);
    return __builtin_bit_cast(float, (unsigned)q[0]) + __builtin_bit_cast(float, (unsigned)q[1]);
}
__device__ __forceinline__ unsigned xor16_u(unsigned x, int lane) { const auto r = __builtin_amdgcn_permlane16_swap(x, x, false, false); return (lane & 16) ? (unsigned)r[0] : (unsigned)r[1]; }
__device__ __forceinline__ unsigned xor32_u(unsigned x, int lane) { const auto r = __builtin_amdgcn_permlane32_swap(x, x, false, false); return (lane & 32) ? (unsigned)r[0] : (unsigned)r[1]; }
__device__ __forceinline__ void tr_item(const float* W, int ldw, int ncols, bf16* WT, int ldt, int koff, int row_off, LAS float* scr, int item, int lane) {
    const int nblk = ncols / 32, kb = item / nblk, nb = item % nblk, k0 = 64 * kb, n0 = 32 * nb;
#pragma unroll 8
    for (int i = 0; i < 32; ++i) { const int kk = 2 * i + (lane >> 5); scr[kk * 33 + (lane & 31)] = W[(size_t)(k0 + kk) * ldw + n0 + (lane & 31)]; }
    asm volatile("s_waitcnt lgkmcnt(0)" ::: "memory");
    const int c = lane & 7;
#pragma unroll
    for (int j = 0; j < 4; ++j) { const int n = (lane >> 3) + 8 * j; const LAS float* s = scr + (8 * c) * 33 + n;
        v4u o; o.x = cvt_pk_bf16(s[0 * 33], s[1 * 33]); o.y = cvt_pk_bf16(s[2 * 33], s[3 * 33]); o.z = cvt_pk_bf16(s[4 * 33], s[5 * 33]); o.w = cvt_pk_bf16(s[6 * 33], s[7 * 33]);
        *(v4u*)(WT + (size_t)(row_off + n0 + n) * ldt + koff + k0 + 8 * c) = o; }
    asm volatile("s_waitcnt lgkmcnt(0)" ::: "memory");
}
__device__ __forceinline__ void cvt_chunk(const float* src, bf16* dst, size_t chunk, int lane) {
    const f32x4* s = (const f32x4*)(src + chunk * 512) + lane * 2; const f32x4 a = s[0], b = s[1];
    *(v4u*)(dst + chunk * 512 + lane * 8) = pk8(a, b);
}
__device__ __forceinline__ void cvt8_chunk(const float* src, unsigned char* dst, size_t chunk, int lane, float sc) {
    const f32x4* s = (const f32x4*)(src + chunk * 512) + lane * 2; const f32x4 a = s[0] * sc, b = s[1] * sc;
    int w0 = 0, w1 = 0;
    w0 = __builtin_amdgcn_cvt_pk_fp8_f32(a.x, a.y, w0, false); w0 = __builtin_amdgcn_cvt_pk_fp8_f32(a.z, a.w, w0, true);
    w1 = __builtin_amdgcn_cvt_pk_fp8_f32(b.x, b.y, w1, false); w1 = __builtin_amdgcn_cvt_pk_fp8_f32(b.z, b.w, w1, true);
    *(v2u*)(dst + chunk * 512 + lane * 8) = (v2u){(unsigned)w0, (unsigned)w1};
}
__device__ __forceinline__ void norm_row_nx(const float* hrow, float* hcopy, const float* g, bf16* NX, int t, int lane) {
    const f32x4* xr = (const f32x4*)hrow + lane; f32x4 v[4]; float s = 0.f;
#pragma unroll
    for (int j = 0; j < 4; ++j) { v[j] = xr[64 * j]; s += (v[j].x * v[j].x + v[j].y * v[j].y) + (v[j].z * v[j].z + v[j].w * v[j].w); }
    if (hcopy) {
#pragma unroll
        for (int j = 0; j < 4; ++j) ((f32x4*)hcopy)[lane + 64 * j] = v[j]; }
    const float rstd = 1.f / sqrtf(wave_sum(s) * (1.f / D) + 1e-6f);
    const int tt = t & (SEQ - 1);
#pragma unroll
    for (int j = 0; j < 4; ++j) { const f32x4 gv = ((const f32x4*)g)[lane + 64 * j]; const f32x4 o = v[j] * rstd * gv;
        v2u w; w.x = cvt_pk_bf16(o.x, o.y); w.y = cvt_pk_bf16(o.z, o.w);
        const int c = 4 * (lane + 64 * j);
        *(v2u*)(NX + (size_t)t * 2048 + c) = w;
        if (tt != SEQ - 1) *(v2u*)(NX + (size_t)(t + 1) * 2048 + 1024 + c) = w;
        if (tt == 0) *(v2u*)(NX + (size_t)t * 2048 + 1024 + c) = (v2u){0u, 0u}; }
}
__device__ __forceinline__ void norm_row_n2x2(const float* hrow0, const float* hrow1, const float* g, bf16* o0, bf16* o1, int lane) {
    const f32x4* x0 = (const f32x4*)hrow0 + lane; const f32x4* x1 = (const f32x4*)hrow1 + lane; f32x4 v[2][4]; float s0 = 0.f, s1 = 0.f;
#pragma unroll
    for (int j = 0; j < 4; ++j) { v[0][j] = x0[64 * j]; v[1][j] = x1[64 * j]; }
#pragma unroll
    for (int j = 0; j < 4; ++j) { s0 += (v[0][j].x * v[0][j].x + v[0][j].y * v[0][j].y) + (v[0][j].z * v[0][j].z + v[0][j].w * v[0][j].w);
                                  s1 += (v[1][j].x * v[1][j].x + v[1][j].y * v[1][j].y) + (v[1][j].z * v[1][j].z + v[1][j].w * v[1][j].w); }
    const float r0 = 1.f / sqrtf(wave_sum(s0) * (1.f / D) + 1e-6f), r1 = 1.f / sqrtf(wave_sum(s1) * (1.f / D) + 1e-6f);
#pragma unroll
    for (int j = 0; j < 4; ++j) { const f32x4 gv = ((const f32x4*)g)[lane + 64 * j]; const f32x4 a = v[0][j] * r0 * gv, b = v[1][j] * r1 * gv;
        *(v2u*)(o0 + 4 * (lane + 64 * j)) = (v2u){cvt_pk_bf16(a.x, a.y), cvt_pk_bf16(a.z, a.w)}; *(v2u*)(o1 + 4 * (lane + 64 * j)) = (v2u){cvt_pk_bf16(b.x, b.y), cvt_pk_bf16(b.z, b.w)}; }
}
__device__ __forceinline__ void prep_phase(Frame& F, const Args& a, int layer, int blk, int nblk_, int part) {
    phase_ids(F);
    LAS float* scr = (LAS float*)(F.lds + F.wave * 16384);
    const int gw = blk * NWAVES + F.wave, NGW = nblk_ * NWAVES, lane = F.lane;
    GAS unsigned char* ws = F.ws; GAS unsigned char* db = F.ws + WS_DB + (size_t)(layer & 1) * DB_SET;
    bf16* WIN = (bf16*)(ws + WS_WIN); bf16* LORA = (bf16*)(ws + WS_LORA + (size_t)layer * LORA_BYTES); bf16* MVT = (bf16*)(ws + WS_MV + (size_t)(layer > 0 ? layer - 1 : 0) * MV_BYTES);
    const float* w_in = a.in[5] + (size_t)layer * 2048 * CIN;
    const int mvn = layer > 0 ? 32 : 0;
    const int c1 = 32 * 104, c2a = 32 * 64, c2b = 32 * 32, c2c = 32 * (32 - 8 * ZSPLIT), c2d = 32 * 8 * ZSPLIT, c2 = c2a + 2 * c2b, c3 = mvn, c4 = 32, c5 = 32, c6 = 64, c7 = 512, c10 = 1024, c12 = 128;
    const int total = (part & 1) ? c1 + c2 + c3 + c4 + c5 + c6 + 3 * c7 + c10 + c7 + c12 : 0;
    for (int it = gw; it < total; it += NGW) {
        int r = it;
        if (r < c1) { tr_item(w_in, CIN, 3328, WIN, 2048, 0, 0, scr, r, lane); continue; } r -= c1;
        if (r < c2a) { tr_item(w_in + 3328, CIN, 2048, WIN, 2048, 0, 3584, scr, r, lane); continue; } r -= c2a;
        if (r < c2b) { tr_item(w_in + 6400, CIN, 1024, WIN, 2048, 0, 5632, scr, r, lane); continue; } r -= c2b;
        if (r < c2c) { tr_item(w_in + 5376, CIN, 1024 - 256 * ZSPLIT, WIN, 2048, 0, 6656, scr, r, lane); continue; } r -= c2c;
        if (r < c2d) { tr_item(w_in + 6400 - 256 * ZSPLIT, CIN, 256 * ZSPLIT, (bf16*)(ws + WS_WINB + (size_t)(layer & 1) * WINB_BYTES), 2048, 0, 0, scr, r, lane); continue; } r -= c2d;
        if (r < c3) { tr_item(a.in[16] + (size_t)(layer - 1) * 2048 * 32, 32, 32, WIN, 2048, 0, 3328, scr, r, lane); continue; } r -= c3;
        if (r < c4) { tr_item(a.in[7] + (size_t)layer * 64 * 1024, 1024, 1024, LORA, 128, 0, 0, scr, r, lane); continue; } r -= c4;
        if (r < c5) { tr_item(a.in[9] + (size_t)layer * 64 * 1024, 1024, 1024, LORA, 128, 64, 1024, scr, r, lane); continue; } r -= c5;
        if (r < c6) { tr_item(a.in[10] + (size_t)layer * 128 * 1024, 1024, 1024, LORA + 2048 * 128, 128, 0, 0, scr, r, lane); continue; } r -= c6;
        if (r < c7) { tr_item(a.in[23] + (size_t)layer * D * D, D, D, (bf16*)(db + DB_PA), D, 0, 0, scr, r, lane); continue; } r -= c7;
        if (r < c7) { tr_item(a.in[24] + (size_t)layer * D * D, D, D, (bf16*)(db + DB_PBT), D, 0, 0, scr, r, lane); continue; } r -= c7;
        if (r < c7) { tr_item(a.in[25] + (size_t)layer * D * D, D, D, (bf16*)(db + DB_POUT), D, 0, 0, scr, r, lane); continue; } r -= c7;
        if (r < c10) { tr_item(a.in[26] + (size_t)layer * D * 2048, 2048, 2048, (bf16*)(db + DB_WQG), D, 0, 0, scr, r, lane); continue; } r -= c10;
        if (r < c7) { tr_item(a.in[31] + (size_t)layer * D * D, D, D, (bf16*)(db + DB_WQG), D, 0, 2048, scr, r, lane); continue; } r -= c7;
        tr_item(a.in[30] + (size_t)layer * 256 * D, D, D, (bf16*)(db + DB_PLEW), 256, 0, 0, scr, r, lane);
    }
    if (layer > 0 && (part & 1)) {
        const float* w2 = a.in[17] + (size_t)(layer - 1) * 32 * 1024;
        for (int it = gw; it < 512; it += NGW) { const int e = it * 64 + lane, n = e >> 5, k = e & 31; MVT[n * 128 + k] = (bf16)(cvt_pk_bf16(w2[k * 1024 + n], 0.f) & 0xffffu); }
    }
    {
        const float* keys = a.in[27] + (size_t)layer * 262144; const float* ut = a.in[28] + (size_t)layer * 16777216; const float* vt = a.in[29] + (size_t)layer * 16777216;
        const float* pin = a.in[1] + (size_t)layer * T * 256; const float* gws = a.in[21] + (size_t)layer * 131072;
        const int n1 = (part & 1) ? 512 : 0, n2 = (part & 2) ? 32768 : 0, n4 = (part & 1) ? 16384 : 0, n5 = (part & 1) ? 256 : 0, ntot = n1 + 2 * n2 + n4 + n5;
        for (int it = gw; it < ntot; it += NGW) {
            int r = it;
            if (r < n2) { cvt8_chunk(ut, (unsigned char*)(db + DB_U), r, lane, 256.f); continue; } r -= n2;
            if (r < n2) { cvt8_chunk(vt, (unsigned char*)(db + DB_V), r, lane, 64.f); continue; } r -= n2;
            if (r < n4) { cvt_chunk(pin, (bf16*)(db + DB_PB), r, lane); continue; } r -= n4;
            if (r < n1) { cvt_chunk(keys, (bf16*)(db + DB_KEYS), r, lane); continue; } r -= n1;
            {
                const int e0 = r * 512 + lane * 8, tq = (e0 >> 7) & 127, p0 = e0 & 127;
                const f32x4* s = (const f32x4*)(gws + e0); f32x4 x0 = s[0], x1 = s[1];
#pragma unroll
                for (int j = 0; j < 4; ++j) { if (p0 + j > tq) x0[j] = 0.f; if (p0 + 4 + j > tq) x1[j] = 0.f; }
                *(v4u*)((bf16*)(db + DB_GMW) + e0) = pk8(x0, x1);
            }
        }
    }
    if (layer == 0 && (part & 1)) {
        for (int m = gw; m < T; m += NGW) norm_row_nx(a.in[0] + (size_t)m * D, F.h + (size_t)m * D, a.in[2], (bf16*)(ws + WS_NX), m, lane);
    }
}

constexpr int SC = 32, NPR = SC / 2;
constexpr int SC_VEC = SC * 64;
constexpr int SC_WW = 0, SC_VQ = NPR * 64, SC_BK = SC_VQ + NPR * 256, SC_XA = SC_BK + NPR * 128, SC_C = SC_XA + NPR * 128, SC_VP = SC_C + NPR * 20, SC_BON = SC_VP + SC * 64, SC_BUF = SC_BON + SC * 8;
static_assert(SC_BUF % 4 == 0 && SC_C % 4 == 0 && (2 * SC_BUF + 2 * SC_VEC) * 4 + 64 <= 131072, "scan LDS map");
struct ScanOps { f32x4 w[4], vq, c[4]; v4u bk[2]; bf16x8 x[2]; };
__device__ __forceinline__ void scan_load2(ScanOps& o, const LAS float* buf, const LAS float* vqp, const LAS unsigned char* bkp, int bkstep, int p, int lane) {
    const int q = lane >> 4;
    const LAS float* wp = buf + SC_WW + p * 64 + q * 4;
#pragma unroll
    for (int i = 0; i < 4; ++i) o.w[i] = *(const LAS f32x4*)(wp + 16 * i);
    o.vq = *(const LAS f32x4*)(vqp + p * 256);
    o.bk[0] = *(const LAS v4u*)(bkp + p * bkstep); o.bk[1] = *(const LAS v4u*)(bkp + p * bkstep + 16);
    const LAS unsigned char* xp = (const LAS unsigned char*)(buf + SC_XA) + p * 512 + (lane & 3) * 128 + q * 16;
    o.x[0] = *(const LAS bf16x8*)xp; o.x[1] = *(const LAS bf16x8*)(xp + 64);
#pragma unroll
    for (int i = 0; i < 4; ++i) o.c[i] = *(const LAS f32x4*)(buf + SC_C + p * 20 + 4 * i);
}
__device__ __forceinline__ const char* uni_ptr(const char* p) { const unsigned long long a = (unsigned long long)p;
    const unsigned lo = (unsigned)__builtin_amdgcn_readfirstlane((int)(unsigned)a), hi = (unsigned)__builtin_amdgcn_readfirstlane((int)(unsigned)(a >> 32));
    return (const char*)(((unsigned long long)hi << 32) | lo); }
__device__ __forceinline__ float smul(float a, float b) { float r; asm("v_mul_f32 %0, %1, %2" : "=v"(r) : "v"(a), "v"(b)); return r; }
__device__ __forceinline__ void scan_pair(const ScanOps& o, f32x4 (&St)[4], float& sa0, float& sa1, v4u (&am)[4], v4u& bm, LAS float* ypt, int ystep, unsigned m16) {
    v4u s0, s1;
    s0.x = cvt_pk_bf16(St[0].x, St[0].y); s0.y = cvt_pk_bf16(St[0].z, St[0].w); s0.z = cvt_pk_bf16(St[1].x, St[1].y); s0.w = cvt_pk_bf16(St[1].z, St[1].w);
    s1.x = cvt_pk_bf16(St[2].x, St[2].y); s1.y = cvt_pk_bf16(St[2].z, St[2].w); s1.z = cvt_pk_bf16(St[3].x, St[3].y); s1.w = cvt_pk_bf16(St[3].z, St[3].w);
    f32x4 dv = (f32x4){0.f, 0.f, 0.f, 0.f};
    dv = __builtin_amdgcn_mfma_f32_16x16x32_bf16(o.x[0], __builtin_bit_cast(bf16x8, s0), dv, 0, 0, 0);
    dv = __builtin_amdgcn_mfma_f32_16x16x32_bf16(o.x[1], __builtin_bit_cast(bf16x8, s1), dv, 0, 0, 0);
    const float v0 = o.vq.x, v1 = o.vq.y, v2 = o.vq.z;
    typedef short s16x4 __attribute__((ext_vector_type(4)));
    const v2u bm2 = (v2u){cvt_pk_bf16(sa0, v0) & m16, cvt_pk_bf16(sa1, v1) & m16};
#pragma unroll
    for (int i = 0; i < 4; ++i) { const v2u a2 = (v2u){o.bk[i >> 1][(i & 1) * 2], o.bk[i >> 1][(i & 1) * 2 + 1]};
        St[i] = __builtin_amdgcn_mfma_f32_16x16x16bf16_1k(__builtin_bit_cast(s16x4, a2), __builtin_bit_cast(s16x4, bm2),
                                                        (f32x4){smul(St[i].x, o.w[i].x), smul(St[i].y, o.w[i].y), smul(St[i].z, o.w[i].z), smul(St[i].w, o.w[i].w)}, 0, 0, 0); }
    ypt[0]     = dv.z + sa0 * o.c[2].z + v0 * o.c[2].w;
    ypt[ystep] = dv.w + sa0 * o.c[3].x + v0 * o.c[3].y + sa1 * o.c[3].z + v1 * o.c[3].w;
    const float n0 = dv.x + sa0 * o.c[0].x + v0 * o.c[0].y + sa1 * o.c[0].z + v1 * o.c[0].w;
    const float n1 = dv.y + sa0 * o.c[1].x + v0 * o.c[1].y + sa1 * o.c[1].z + v1 * o.c[1].w + n0 * o.c[2].x + v2 * o.c[2].y;
    sa0 = n0; sa1 = n1;
}
__device__ __forceinline__ void scan_unit(Frame& F, const Args& a, int layer, int unit) {
    phase_ids(F);
    const int b = unit >> 4, hh = unit & 15, tid = F.tid, lane = F.lane, wave = F.wave;
    LAS float* bufs = (LAS float*)F.lds;
    LAS float* sY = bufs + 2 * SC_BUF;
    const bf16* ZR = (const bf16*)(F.ws + WS_ZRKV); const bf16* EW = (const bf16*)(F.ws + WS_EW); const bf16* AR = (const bf16*)(F.ws + WS_AR); const bf16* GT = (const bf16*)(F.ws + WS_G);
    bf16* YA = (bf16*)(F.ws + WS_G);
    constexpr int NCH = SEQ / SC;
    if (wave < 4) {
        f32x4 St[4]; v4u am[4], bm = (v4u){0u, 0u, 0u, 0u};
#pragma unroll
        for (int i = 0; i < 4; ++i) { St[i] = (f32x4){0.f, 0.f, 0.f, 0.f}; am[i] = (v4u){0u, 0u, 0u, 0u}; }
        float sa0 = 0.f, sa1 = 0.f;
        const unsigned m16 = lane < 16 ? 0xffffffffu : 0u;
        LAS unsigned char* zblk = (LAS unsigned char*)(sY + 2 * SC_VEC);
        if (tid < 8) ((LAS unsigned*)zblk)[tid] = 0u;
        const int bkstep = lane < 16 ? 512 : 0;
        for (int it = 0; it < NCH + 2; ++it) {
            if (it >= 1 && it <= NCH) {
                const LAS float* bufc = bufs + ((it - 1) & 1) * SC_BUF;
                const LAS float* vqp = bufc + SC_VQ + 4 * (wave * 16 + (lane & 15));
                const LAS unsigned char* bkp = lane < 16 ? (const LAS unsigned char*)(bufc + SC_BK) + lane * 32 : (const LAS unsigned char*)zblk;
                LAS float* yb = lane < 16 ? sY + ((it - 1) & 1) * SC_VEC + wave * 16 + lane : (LAS float*)(zblk + 32);
                const int ystep = lane < 16 ? 64 : 0;
                if (it == 1) { sa0 = 0.f; sa1 = vqp[0] * bufc[SC_C + 16]; }
                ScanOps o0, o1;
                scan_load2(o0, bufc, vqp, bkp, bkstep, 0, lane);
#pragma unroll 1
                for (int p = 0; p < NPR; p += 2) {
                    scan_load2(o1, bufc, vqp, bkp, bkstep, p + 1, lane);
                    scan_pair(o0, St, sa0, sa1, am, bm, yb + (2 * p) * ystep, ystep, m16);
                    if (p + 2 < NPR) scan_load2(o0, bufc, vqp, bkp, bkstep, p + 2, lane);
                    scan_pair(o1, St, sa0, sa1, am, bm, yb + (2 * p + 2) * ystep, ystep, m16);
                }
            }
            __syncthreads();
        }
    } else {
        const int ht = tid - 256, tl = ht >> 3, c8 = ht & 7, ch = hh * 64 + c8 * 8;
        const int pr = ht >> 4, c4 = ht & 15, chp = hh * 64 + c4 * 4;
        const size_t po = (size_t)layer * 1024 + ch, pop = (size_t)layer * 1024 + chp;
        struct HelpIn { v2u r0, k0, v0, e0, a0, r1, k1, v1, e1, a1, k2, v2, e2, a2, k3; v4u gt; };
        HelpIn cur, nxt;
#define HELP_ROW(H, F_, RR, OFF, ARR, PITCH) (H).F_ = *(const v2u*)((ARR) + ((size_t)b * SEQ + (RR)) * (PITCH) + (OFF) + chp)
#define HELP_LOAD(H, PC, GC) do { \
            if ((PC) < NCH) { const int _t = (PC) * SC + 2 * pr; \
                HELP_ROW(H, r0, _t, 0, ZR, 3072); HELP_ROW(H, k0, _t, 1024, ZR, 3072); HELP_ROW(H, v0, _t, 2048, ZR, 3072); HELP_ROW(H, e0, _t, 0, EW, 1024); HELP_ROW(H, a0, _t, 0, AR, 1024); \
                HELP_ROW(H, r1, _t + 1, 0, ZR, 3072); HELP_ROW(H, k1, _t + 1, 1024, ZR, 3072); HELP_ROW(H, v1, _t + 1, 2048, ZR, 3072); HELP_ROW(H, e1, _t + 1, 0, EW, 1024); HELP_ROW(H, a1, _t + 1, 0, AR, 1024); \
                HELP_ROW(H, k2, _t + 2, 1024, ZR, 3072); HELP_ROW(H, v2, _t + 2, 2048, ZR, 3072); HELP_ROW(H, e2, _t + 2, 0, EW, 1024); HELP_ROW(H, a2, _t + 2, 0, AR, 1024); \
                HELP_ROW(H, k3, _t + 3, 1024, ZR, 3072); } \
            if ((GC) >= 0 && (GC) < NCH) { const size_t _row = (size_t)b * SEQ + (size_t)(GC) * SC + tl; (H).gt = *(const v4u*)(GT + _row * 1024 + ch); } } while (0)
#define UNP4(W) ((f32x4){bflo((W).x), bfhi((W).x), bflo((W).y), bfhi((W).y)})
#define EXP4(E) ((f32x4){__builtin_amdgcn_exp2f(-1.44269504f * (E).x), __builtin_amdgcn_exp2f(-1.44269504f * (E).y), __builtin_amdgcn_exp2f(-1.44269504f * (E).z), __builtin_amdgcn_exp2f(-1.44269504f * (E).w)})
#define DOT4(A, B) (((A).x * (B).x + (A).y * (B).y) + ((A).z * (B).z + (A).w * (B).w))
#define SUM16(X) sum16_ns(X)
#ifdef PROBE_SCAN
        unsigned long long ph_act = 0ull;
#endif
        HELP_LOAD(cur, 0, -2);
        for (int it = 0; it < NCH + 2; ++it) {
#ifdef PROBE_SCAN
            const unsigned long long ph0 = __builtin_amdgcn_s_memtime();
#endif
            HELP_LOAD(nxt, it + 1, it - 1);
            if (it >= 2) {
                const LAS float* buf = bufs + (it & 1) * SC_BUF; const LAS float* yb = sY + (it & 1) * SC_VEC;
                const size_t row = (size_t)b * SEQ + (size_t)(it - 2) * SC + tl; const int o = tl * 64 + c8 * 8;
                f32x4 y_[2], v_[2], g_[2];
#pragma unroll
                for (int i = 0; i < 2; ++i) { y_[i] = *(const LAS f32x4*)(yb + o + 4 * i); v_[i] = *(const LAS f32x4*)(buf + SC_VP + o + 4 * i); }
                const float bon = buf[SC_BON + tl * 8 + c8];
                unpk8(cur.gt, g_[0], g_[1]);
                const float s1 = ((y_[0].x + y_[0].y) + (y_[0].z + y_[0].w)) + ((y_[1].x + y_[1].y) + (y_[1].z + y_[1].w));
                const float mu = sum8(s1) * (1.f / 64.f);
                float s2 = 0.f;
#pragma unroll
                for (int i = 0; i < 2; ++i) { y_[i] = y_[i] - mu; const f32x4 q = y_[i] * y_[i]; s2 += (q.x + q.y) + (q.z + q.w); }
                const float rstd = __builtin_amdgcn_rsqf(sum8(s2) * (1.f / 64.f) + 64e-5f);
                f32x4 o_[2];
#pragma unroll
                for (int i = 0; i < 2; ++i) o_[i] = (y_[i] * rstd * *(const f32x4*)(a.in[14] + po + 4 * i) + *(const f32x4*)(a.in[15] + po + 4 * i) + bon * v_[i]) * g_[i];
                *(v4u*)(YA + row * 1024 + ch) = pk8(o_[0], o_[1]);
            }
            if (it < NCH) {
                LAS float* buf = bufs + (it & 1) * SC_BUF;
                const f32x4 pkk_ = *(const f32x4*)(a.in[11] + pop), pka_ = *(const f32x4*)(a.in[12] + pop), prk_ = *(const f32x4*)(a.in[13] + pop);
                const f32x4 zk0 = UNP4(cur.k0), zk1 = UNP4(cur.k1), zk2 = UNP4(cur.k2), zk3 = UNP4(cur.k3);
                f32x4 kn0 = zk0 * pkk_, kn1 = zk1 * pkk_, kn2 = zk2 * pkk_, kn3 = zk3 * pkk_;
                kn0 = kn0 * __builtin_amdgcn_rsqf(fmaxf(SUM16(DOT4(kn0, kn0)), 1e-24f)); kn1 = kn1 * __builtin_amdgcn_rsqf(fmaxf(SUM16(DOT4(kn1, kn1)), 1e-24f));
                kn2 = kn2 * __builtin_amdgcn_rsqf(fmaxf(SUM16(DOT4(kn2, kn2)), 1e-24f)); kn3 = kn3 * __builtin_amdgcn_rsqf(fmaxf(SUM16(DOT4(kn3, kn3)), 1e-24f));
                const f32x4 r0 = UNP4(cur.r0), r1 = UNP4(cur.r1), v0 = UNP4(cur.v0), v1 = UNP4(cur.v1), v2 = UNP4(cur.v2);
                const f32x4 ar0 = UNP4(cur.a0), ar1 = UNP4(cur.a1), ar2 = UNP4(cur.a2);
                const f32x4 e0 = UNP4(cur.e0), e1 = UNP4(cur.e1), e2 = UNP4(cur.e2);
                const f32x4 w0 = EXP4(e0), w1 = EXP4(e1), w2 = EXP4(e2);
                const f32x4 a1v = -kn1, a2v = -kn2, a3v = -kn3;
                const f32x4 b0 = kn0 * ar0, b1 = kn1 * ar1, b2 = kn2 * ar2;
                const f32x4 kp0 = zk0 * (1.f + (ar0 - 1.f) * pka_), kp1 = zk1 * (1.f + (ar1 - 1.f) * pka_), kp2 = zk2 * (1.f + (ar2 - 1.f) * pka_);
                const f32x4 W2 = w0 * w1, Bt = b0 * w1, Kt = kp0 * w1, x0v = a2v, x1v = w2 * a3v;
                const f32x4 X0 = W2 * x0v, X1 = W2 * x1v, X2 = w0 * r0, X3 = W2 * r1;
                *(LAS f32x4*)(buf + SC_WW + pr * 64 + c4 * 4) = W2;
                *(LAS f32x4*)(buf + SC_VP + (2 * pr) * 64 + c4 * 4) = v0; *(LAS f32x4*)(buf + SC_VP + (2 * pr + 1) * 64 + c4 * 4) = v1;
                { LAS f32x4* vq = (LAS f32x4*)(buf + SC_VQ + pr * 256 + c4 * 16);
                  vq[0] = (f32x4){v0.x, v1.x, v2.x, 0.f}; vq[1] = (f32x4){v0.y, v1.y, v2.y, 0.f}; vq[2] = (f32x4){v0.z, v1.z, v2.z, 0.f}; vq[3] = (f32x4){v0.w, v1.w, v2.w, 0.f}; }
                { LAS v2u* bkp = (LAS v2u*)(buf + SC_BK + pr * 128) + (((c4 & 3) * 4) * 4 + (c4 >> 2));
                  bkp[0] = (v2u){cvt_pk_bf16(Bt.x, Kt.x), cvt_pk_bf16(b1.x, kp1.x)}; bkp[4] = (v2u){cvt_pk_bf16(Bt.y, Kt.y), cvt_pk_bf16(b1.y, kp1.y)};
                  bkp[8] = (v2u){cvt_pk_bf16(Bt.z, Kt.z), cvt_pk_bf16(b1.z, kp1.z)}; bkp[12] = (v2u){cvt_pk_bf16(Bt.w, Kt.w), cvt_pk_bf16(b1.w, kp1.w)}; }
                { LAS unsigned char* xp = (LAS unsigned char*)(buf + SC_XA) + pr * 512 + (c4 >> 3) * 64 + (c4 & 3) * 16 + ((c4 >> 2) & 1) * 8;
                  *(LAS v2u*)xp = (v2u){cvt_pk_bf16(X0.x, X0.y), cvt_pk_bf16(X0.z, X0.w)}; *(LAS v2u*)(xp + 128) = (v2u){cvt_pk_bf16(X1.x, X1.y), cvt_pk_bf16(X1.z, X1.w)};
                  *(LAS v2u*)(xp + 256) = (v2u){cvt_pk_bf16(X2.x, X2.y), cvt_pk_bf16(X2.z, X2.w)}; *(LAS v2u*)(xp + 384) = (v2u){cvt_pk_bf16(X3.x, X3.y), cvt_pk_bf16(X3.z, X3.w)}; }
                const f32x4 ca = (f32x4){SUM16(DOT4(Bt, x0v)), SUM16(DOT4(Kt, x0v)), SUM16(DOT4(b1, x0v)), SUM16(DOT4(kp1, x0v))};
                const f32x4 cb = (f32x4){SUM16(DOT4(Bt, x1v)), SUM16(DOT4(Kt, x1v)), SUM16(DOT4(b1, x1v)), SUM16(DOT4(kp1, x1v))};
                const f32x4 cc = (f32x4){SUM16(DOT4(b2, a3v)), SUM16(DOT4(kp2, a3v)), SUM16(DOT4(b0, r0)), SUM16(DOT4(kp0, r0))};
                const f32x4 cd = (f32x4){SUM16(DOT4(Bt, r1)), SUM16(DOT4(Kt, r1)), SUM16(DOT4(b1, r1)), SUM16(DOT4(kp1, r1))};
                const float ci = SUM16(DOT4(kp0, a1v));
                const f32x4 z0 = r0 * kp0 * prk_, z1 = r1 * kp1 * prk_;
                const float bon0 = SUM16((z0.x + z0.y) + (z0.z + z0.w)), bon1 = SUM16((z1.x + z1.y) + (z1.z + z1.w));
                if (c4 == 0) { LAS f32x4* cp = (LAS f32x4*)(buf + SC_C + pr * 20); cp[0] = ca; cp[1] = cb; cp[2] = cc; cp[3] = cd; cp[4] = (f32x4){ci, 0.f, 0.f, 0.f}; }
                buf[SC_BON + (2 * pr) * 8 + (c4 >> 1)] = bon0; buf[SC_BON + (2 * pr + 1) * 8 + (c4 >> 1)] = bon1;
            }
            cur = nxt;
#ifdef PROBE_SCAN
            asm volatile("s_waitcnt vmcnt(0) lgkmcnt(0)" ::: "memory"); ph_act += __builtin_amdgcn_s_memtime() - ph0;
#endif
            __syncthreads();
        }
#ifdef PROBE_SCAN
        if (unit == 0 && layer == DEPTH - 1 && tid == 256) ((float*)(F.ws + WS_CTL))[2048 + 2] = rintf((float)ph_act / (float)(NCH + 2) * (1.f / 2000.f));
#endif
#undef HELP_LOAD
#undef HELP_ROW
#undef UNP4
#undef EXP4
#undef DOT4
#undef SUM16
    }
}

constexpr int TP = 136;
__device__ __forceinline__ void mma_128(const LAS bf16* sA, const LAS bf16* sBt, int wave, int lane, f32x4 (&acc)[4][2]) {
    const int wm = wave >> 2, wn = wave & 3, fr = lane & 15, fq = lane >> 4;
#pragma unroll
    for (int kk = 0; kk < 4; ++kk) {
        bf16x8 af[4], bf_[2];
#pragma unroll
        for (int mt = 0; mt < 4; ++mt) af[mt] = *(const LAS bf16x8*)(sA + (64 * wm + 16 * mt + fr) * TP + 32 * kk + 8 * fq);
#pragma unroll
        for (int nt = 0; nt < 2; ++nt) bf_[nt] = *(const LAS bf16x8*)(sBt + (32 * wn + 16 * nt + fr) * TP + 32 * kk + 8 * fq);
#pragma unroll
        for (int mt = 0; mt < 4; ++mt)
#pragma unroll
            for (int nt = 0; nt < 2; ++nt) acc[mt][nt] = __builtin_amdgcn_mfma_f32_16x16x32_bf16(bf_[nt], af[mt], acc[mt][nt], 0, 0, 0);
    }
}
__device__ __forceinline__ void gmlp_unit(Frame& F, const Args& a, int layer, int unit) {
    phase_ids(F);
    const size_t t0 = (size_t)unit * 128; const int tid = F.tid, lane = F.lane, wave = F.wave;
    LAS float* st = (LAS float*)F.lds; LAS bf16* sA = (LAS bf16*)(F.lds + 1024); LAS bf16* sB = (LAS bf16*)(F.lds + 1024 + 128 * TP * 2);
    bf16* GUV = (bf16*)(F.ws + WS_GUV); const bf16* GMW = (const bf16*)(F.ws + WS_DB + (size_t)(layer & 1) * DB_SET + DB_GMW);
    const float* lng = a.in[19] + (size_t)layer * 1024; const float* lnb = a.in[20] + (size_t)layer * 1024; const float* bsp = a.in[22] + (size_t)layer * 1024;
    for (int r = 0; r < 16; ++r) { const int tok = wave * 16 + r; const bf16* rowp = GUV + (t0 + tok) * 2048 + 1024;
        f32x4 x0, x1, x2, x3; unpk8(*(const v4u*)(rowp + lane * 8), x0, x1); unpk8(*(const v4u*)(rowp + 512 + lane * 8), x2, x3);
        const f32x4 sv = (x0 + x1) + (x2 + x3), qv = (x0 * x0 + x1 * x1) + (x2 * x2 + x3 * x3);
        const float s = wave_sum((sv.x + sv.y) + (sv.z + sv.w)), q = wave_sum((qv.x + qv.y) + (qv.z + qv.w));
        const float mean = s * (1.f / 1024.f), var = fmaxf(q * (1.f / 1024.f) - mean * mean, 0.f);
        if (lane == 0) { st[tok * 2] = mean; st[tok * 2 + 1] = 1.f / sqrtf(var + 1e-5f); } }
    __syncthreads();
    for (int g = 0; g < 8; ++g) {
#pragma unroll
        for (int i = 0; i < 4; ++i) { const int pc = tid + 512 * i, rr = pc >> 4, c16 = pc & 15;
            *(LAS v4u*)(sA + rr * TP + c16 * 8) = *(const v4u*)(GMW + (size_t)g * 16384 + rr * 128 + c16 * 8); }
        { const int p = tid & 127, oc0 = tid >> 7; const float mean = st[p * 2], rstd = st[p * 2 + 1];
#pragma unroll
          for (int i = 0; i < 4; ++i) { const int oc = oc0 + 4 * i, c0 = g * 128 + oc * 8;
              f32x4 x0, x1; unpk8(*(const v4u*)(GUV + (t0 + p) * 2048 + 1024 + c0), x0, x1);
              const f32x4 g0 = *(const f32x4*)(lng + c0), g1 = *(const f32x4*)(lng + c0 + 4), b0 = *(const f32x4*)(lnb + c0), b1 = *(const f32x4*)(lnb + c0 + 4);
              x0 = (x0 - mean) * rstd * g0 + b0; x1 = (x1 - mean) * rstd * g1 + b1;
              const v4u w = pk8(x0, x1);
              LAS bf16* d = sB + (oc * 8) * TP + p;
              d[0 * TP] = (bf16)(w.x & 0xffffu); d[1 * TP] = (bf16)(w.x >> 16); d[2 * TP] = (bf16)(w.y & 0xffffu); d[3 * TP] = (bf16)(w.y >> 16);
              d[4 * TP] = (bf16)(w.z & 0xffffu); d[5 * TP] = (bf16)(w.z >> 16); d[6 * TP] = (bf16)(w.w & 0xffffu); d[7 * TP] = (bf16)(w.w >> 16); } }
        __syncthreads();
        f32x4 acc[4][2];
#pragma unroll
        for (int mt = 0; mt < 4; ++mt)
#pragma unroll
            for (int nt = 0; nt < 2; ++nt) acc[mt][nt] = (f32x4){0.f, 0.f, 0.f, 0.f};
        mma_128(sA, sB, wave, lane, acc);
        { const int wm = wave >> 2, wn = wave & 3, fr = lane & 15, fq = lane >> 4;
#pragma unroll
          for (int mt = 0; mt < 4; ++mt) { const int tt = 64 * wm + 16 * mt + fr; const float bsv = bsp[g * 128 + tt];
#pragma unroll
              for (int nt = 0; nt < 2; ++nt) { const int c = g * 128 + 32 * wn + 16 * nt + 4 * fq;
                  const v2u uw = *(const v2u*)(GUV + (t0 + tt) * 2048 + c);
                  const f32x4 u4 = (f32x4){bflo(uw.x), bfhi(uw.x), bflo(uw.y), bfhi(uw.y)};
                  const f32x4 yb = u4 * (acc[mt][nt] + bsv);
                  v2u ow; ow.x = cvt_pk_bf16(yb.x, yb.y); ow.y = cvt_pk_bf16(yb.z, yb.w);
                  *(v2u*)(GUV + (t0 + tt) * 2048 + c) = ow; } } }
        __syncthreads();
    }
}

__device__ __forceinline__ unsigned fkey(float f) { const unsigned u = __builtin_bit_cast(unsigned, f); return (u & 0x80000000u) ? ~u : (u | 0x80000000u); }
__device__ __forceinline__ float kval(unsigned k, unsigned mask) { const unsigned u = k & mask; return __builtin_bit_cast(float, (u & 0x80000000u) ? (u ^ 0x80000000u) : ~u); }
__device__ __forceinline__ float swap32_add(float a, float b) { const auto r = __builtin_amdgcn_permlane32_swap(__builtin_bit_cast(unsigned, a), __builtin_bit_cast(unsigned, b), false, false);
    return __builtin_bit_cast(float, (unsigned)r[0]) + __builtin_bit_cast(float, (unsigned)r[1]); }
__device__ __forceinline__ float swap16_add(float a, float b) { const auto r = __builtin_amdgcn_permlane16_swap(__builtin_bit_cast(unsigned, a), __builtin_bit_cast(unsigned, b), false, false);
    return __builtin_bit_cast(float, (unsigned)r[0]) + __builtin_bit_cast(float, (unsigned)r[1]); }
__device__ __forceinline__ float row_sum16(float x) {
    x += __builtin_bit_cast(float, __builtin_amdgcn_update_dpp(0, __builtin_bit_cast(int, x), 0x128, 0xf, 0xf, false));
    x += __builtin_bit_cast(float, __builtin_amdgcn_update_dpp(0, __builtin_bit_cast(int, x), 0x124, 0xf, 0xf, false));
    x += __builtin_bit_cast(float, __builtin_amdgcn_update_dpp(0, __builtin_bit_cast(int, x), 0x122, 0xf, 0xf, false));
    x += __builtin_bit_cast(float, __builtin_amdgcn_update_dpp(0, __builtin_bit_cast(int, x), 0x121, 0xf, 0xf, false));
    return x; }
#define CE_DESC(a, b) do { const unsigned _h = max((a), (b)), _l = min((a), (b)); (a) = _h; (b) = _l; } while (0)
template <int OFF> __device__ __forceinline__ void bitonic_merge16(unsigned (&x)[32]) {
#pragma unroll
    for (int j = 8; j >= 1; j >>= 1)
#pragma unroll
        for (int i = 0; i < 16; ++i) { const int l = i ^ j; if (l > i) CE_DESC(x[OFF + i], x[OFF + l]); }
}
template <int OFF> __device__ __forceinline__ void bitonic_sort16(unsigned (&x)[32]) {
#pragma unroll
    for (int k = 2; k <= 16; k <<= 1)
#pragma unroll
        for (int j = k >> 1; j >= 1; j >>= 1)
#pragma unroll
            for (int i = 0; i < 16; ++i) { const int l = i ^ j; if (l > i) { if ((i & k) == 0 || k == 16) CE_DESC(x[OFF + i], x[OFF + l]); else CE_DESC(x[OFF + l], x[OFF + i]); } }
}
#ifndef REP_K
#define REP_K 1
#endif
#define TOP_INSERT(top, x) do { unsigned _x = (x); _Pragma("unroll") for (int _j = 0; _j < 16; ++_j) { const unsigned _h = max((top)[_j], _x); _x = min((top)[_j], _x); (top)[_j] = _h; } } while (0)
__device__ __forceinline__ void peer_token_end(Frame& F, const Args& a, int layer, bool last, bool final_half, size_t tok, int lane, const f32x2 (&out)[8], const f32x4 (&hpre)[4]) {
    float* hp = F.h + tok * 1024 + 16 * lane;
    f32x4 hv[4]; float s = 0.f;
#pragma unroll
    for (int i = 0; i < 4; ++i) { hv[i] = hpre[i] + (f32x4){out[2 * i].x, out[2 * i].y, out[2 * i + 1].x, out[2 * i + 1].y};
        s += (hv[i].x * hv[i].x + hv[i].y * hv[i].y) + (hv[i].z * hv[i].z + hv[i].w * hv[i].w); }
    if (!final_half) {
#pragma unroll
        for (int i = 0; i < 4; ++i) *(f32x4*)(hp + 4 * i) = hv[i];
        return; }
    const float rstd = 1.f / sqrtf(wave_sum(s) * (1.f / D) + 1e-6f);
    const float* g = (last ? a.in[4] : a.in[2] + (size_t)(layer + 1) * 1024) + 16 * lane;
    f32x4 o[4];
#pragma unroll
    for (int i = 0; i < 4; ++i) o[i] = hv[i] * rstd * *(const f32x4*)(g + 4 * i);
    if (last) {
#ifdef PROBE_SCAN
        { const float pv = ((const float*)(F.ws + WS_CTL))[2048 + PROBE_SCAN - 1];
#pragma unroll
          for (int i = 0; i < 4; ++i) o[i] = o[i] + pv; }
#endif
#pragma unroll
        for (int i = 0; i < 4; ++i) *(f32x4*)(hp + 4 * i) = o[i];
    } else {
#pragma unroll
        for (int i = 0; i < 4; ++i) *(f32x4*)(hp + 4 * i) = hv[i];
        bf16* NX = (bf16*)(F.ws + WS_NX); const v4u w0 = pk8(o[0], o[1]), w1 = pk8(o[2], o[3]); const int tt = (int)(tok & (SEQ - 1));
        *(v4u*)(NX + tok * 2048 + 16 * lane) = w0; *(v4u*)(NX + tok * 2048 + 16 * lane + 8) = w1;
        if (tt != SEQ - 1) { *(v4u*)(NX + (tok + 1) * 2048 + 1024 + 16 * lane) = w0; *(v4u*)(NX + (tok + 1) * 2048 + 1024 + 16 * lane + 8) = w1; }
        if (tt == 0) { *(v4u*)(NX + tok * 2048 + 1024 + 16 * lane) = (v4u){0u, 0u, 0u, 0u}; *(v4u*)(NX + tok * 2048 + 1024 + 16 * lane + 8) = (v4u){0u, 0u, 0u, 0u}; }
    }
}
__device__ __forceinline__ void peer_unit(Frame& F, const Args& a, int layer, int unit, bool last) {
    phase_ids(F);
    const size_t t0 = (size_t)unit * 128; const int tid = F.tid, lane = F.lane, wave = F.wave, fr = lane & 15, fq = lane >> 4;
    LAS bf16* sKey = (LAS bf16*)F.lds;
    LAS unsigned* sLT = (LAS unsigned*)(F.lds + 2 * 128 * TP * 2) + wave * 512;
    const bf16* Q = (const bf16*)(F.ws + WS_Q); const bf16* KEYS = (const bf16*)(F.ws + WS_DB + (size_t)(layer & 1) * DB_SET + DB_KEYS); v2u* SEL = (v2u*)(F.ws + WS_SEL);
    const size_t trow = t0 + wave * 16 + fr;
    constexpr float KOFF = 32.f;
    v4u ktn[4]; bf16x8 qfn[4];
#define K_FETCH(J) do { _Pragma("unroll") for (int _i = 0; _i < 4; ++_i) { const int _pc = tid + 512 * _i, _rr = _pc >> 4, _c16 = _pc & 15; ktn[_i] = *(const v4u*)(KEYS + (size_t)(J) * 16384 + _rr * 128 + _c16 * 8); } \
        _Pragma("unroll") for (int _kk = 0; _kk < 4; ++_kk) qfn[_kk] = *(const bf16x8*)(Q + trow * 2048 + (J) * 128 + 32 * _kk + 8 * fq); } while (0)
#define K_STORE(J) do { _Pragma("unroll") for (int _i = 0; _i < 4; ++_i) { const int _pc = tid + 512 * _i, _rr = _pc >> 4, _c16 = _pc & 15; *(LAS v4u*)(sKey + ((J) & 1) * 128 * TP + _rr * TP + _c16 * 8) = ktn[_i]; } } while (0)
    for (int krep = 0; krep < REP_K; ++krep) {
    __syncthreads();
    K_FETCH(0); K_STORE(0);
    bf16x8 qf[4];
#pragma unroll
    for (int kk = 0; kk < 4; ++kk) qf[kk] = qfn[kk];
    __syncthreads();
    for (int hd = 0; hd < 8; ++hd) {
        for (int p = 0; p < 2; ++p) {
            const int jp = hd * 2 + p;
            if (jp + 1 < 16) K_FETCH(jp + 1);
            const LAS bf16* sKc = sKey + (jp & 1) * 128 * TP;
            f32x4 sc[8];
#pragma unroll
            for (int nt = 0; nt < 8; ++nt) sc[nt] = (f32x4){KOFF, KOFF, KOFF, KOFF};
#pragma unroll
            for (int kk = 0; kk < 4; ++kk)
#pragma unroll
                for (int nt = 0; nt < 8; ++nt) { const bf16x8 kf = *(const LAS bf16x8*)(sKc + (16 * nt + fr) * TP + 32 * kk + 8 * fq);
                    sc[nt] = __builtin_amdgcn_mfma_f32_16x16x32_bf16(kf, qf[kk], sc[nt], 0, 0, 0); }
            unsigned t[32];
#pragma unroll
            for (int nt = 0; nt < 8; ++nt)
#pragma unroll
                for (int rg = 0; rg < 4; ++rg) t[4 * nt + rg] = (__float_as_uint(sc[nt][rg]) & 0xFFFFFF80u) | (unsigned)(16 * nt + 4 * fq + rg);
            bitonic_sort16<0>(t); bitonic_sort16<16>(t);
#pragma unroll
            for (int j = 0; j < 16; ++j) t[j] = max(t[j], t[31 - j]);
            bitonic_merge16<0>(t);
#pragma unroll
            for (int rnd = 0; rnd < 2; ++rnd) {
#pragma unroll
                for (int j = 0; j < 16; ++j) t[16 + j] = rnd ? xor32_u(t[j], lane) : xor16_u(t[j], lane);
#pragma unroll
                for (int j = 0; j < 16; ++j) t[j] = max(t[j], t[31 - j]);
                bitonic_merge16<0>(t); }
#pragma unroll
            for (int j = 0; j < 16; ++j) sLT[fr * 32 + p * 16 + j] = t[j];
            if (jp + 1 < 16) { K_STORE(jp + 1);
#pragma unroll
                for (int kk = 0; kk < 4; ++kk) qf[kk] = qfn[kk]; }
            __syncthreads();
        }
        float v0[16], v1[16];
#pragma unroll
        for (int j = 0; j < 16; ++j) { v0[j] = __uint_as_float(sLT[fr * 32 + j] & 0xFFFFFF80u); v1[j] = __uint_as_float(sLT[fr * 32 + 16 + j] & 0xFFFFFF80u); }
        unsigned best[32];
#define CKEY(i, j) ((__float_as_uint(v0[i] + v1[j]) & 0xFFFFFF00u) | (unsigned)((i) * 16 + (j)))
#pragma unroll
        for (int j = 0; j < 16; ++j) best[j] = CKEY(0, j);
#pragma unroll
        for (int i = 1; i < 16; ++i) best[16 - i] = max(best[16 - i], CKEY(i, 0));
        bitonic_merge16<0>(best);
#pragma unroll
        for (int j = 1; j < 8; ++j) best[16 - j] = max(best[16 - j], CKEY(1, j));
        bitonic_merge16<0>(best);
#pragma unroll
        for (int i = 2; i < 8; ++i) best[17 - i] = max(best[17 - i], CKEY(i, 1));
        bitonic_merge16<0>(best);
        { unsigned r6[6] = {CKEY(2, 2), CKEY(2, 3), CKEY(2, 4), CKEY(3, 2), CKEY(3, 3), CKEY(4, 2)};
          CE_DESC(r6[0], r6[5]); CE_DESC(r6[1], r6[3]); CE_DESC(r6[2], r6[4]); CE_DESC(r6[1], r6[2]); CE_DESC(r6[3], r6[4]); CE_DESC(r6[0], r6[3]);
          CE_DESC(r6[2], r6[5]); CE_DESC(r6[0], r6[1]); CE_DESC(r6[2], r6[3]); CE_DESC(r6[4], r6[5]); CE_DESC(r6[1], r6[2]); CE_DESC(r6[3], r6[4]);
#pragma unroll
          for (int k = 0; k < 6; ++k) best[15 - k] = max(best[15 - k], r6[k]); }
        bitonic_merge16<0>(best);
#undef CKEY
        float ev[16], esum = 0.f; const float mx = __uint_as_float(best[0] & 0xFFFFFF00u);
#pragma unroll
        for (int k = 0; k < 16; ++k) { ev[k] = __builtin_amdgcn_exp2f((__uint_as_float(best[k] & 0xFFFFFF00u) - mx) * 1.44269504f); esum += ev[k]; }
        const float einv = 1.f / esum;
#pragma unroll
        for (int k = 0; k < 16; ++k) { const unsigned pos = best[k] & 255u;
            const unsigned i0 = sLT[fr * 32 + (pos >> 4)] & 127u, i1 = sLT[fr * 32 + 16 + (pos & 15u)] & 127u;
            if ((k >> 2) == fq) SEL[trow * 128 + hd * 16 + k] = (v2u){i0 * 128u + i1, __builtin_bit_cast(unsigned, ev[k] * einv)}; }
    }
    }
#undef K_FETCH
#undef K_STORE
    asm volatile("s_waitcnt vmcnt(0)" ::: "memory");
    __syncthreads();
    const bf16* N2 = (const bf16*)(F.ws + WS_N2); const unsigned char* U8 = (const unsigned char*)(F.ws + WS_DB + (size_t)(layer & 1) * DB_SET + DB_U); const unsigned char* V8 = (const unsigned char*)(F.ws + WS_DB + (size_t)(layer & 1) * DB_SET + DB_V);
    unsigned* SELW = (unsigned*)SEL;
    LAS float* sCoef = (LAS float*)F.lds + wave * 2048;
    LAS unsigned* sSort = sLT;
    const size_t tokb = t0 + wave * 16;
    unsigned cnts = 0u;
    v4u se_pf = *(const v4u*)(SELW + tokb * 256 + 4 * lane);
    for (int it = 0; it < 16; ++it) {
        const v4u se = se_pf;
        if (it < 15) se_pf = *(const v4u*)(SELW + (tokb + it + 1) * 256 + 4 * lane);
        const unsigned b0 = se.x >> 12, b1 = se.z >> 12;
        unsigned pos0 = 0u, pos1 = 0u, base = 0u, pk = 0u;
#pragma unroll
        for (unsigned k = 0; k < 4; ++k) {
            const unsigned long long m0 = __builtin_amdgcn_ballot_w64(b0 == k), m1 = __builtin_amdgcn_ballot_w64(b1 == k);
            const unsigned below = __builtin_amdgcn_mbcnt_hi((unsigned)(m0 >> 32), __builtin_amdgcn_mbcnt_lo((unsigned)m0, 0u)) + __builtin_amdgcn_mbcnt_hi((unsigned)(m1 >> 32), __builtin_amdgcn_mbcnt_lo((unsigned)m1, 0u));
            if (b0 == k) pos0 = base + below;
            if (b1 == k) pos1 = base + below + (b0 == k ? 1u : 0u);
            base += (unsigned)__builtin_popcountll(m0) + (unsigned)__builtin_popcountll(m1);
            if (k < 3) pk |= base << (8 * k);
        }
#ifdef DBG_NOSORT
        pos0 = 2 * lane; pos1 = 2 * lane + 1;
#endif
        *(LAS v2u*)(sSort + 2 * pos0) = (v2u){se.x, se.y}; *(LAS v2u*)(sSort + 2 * pos1) = (v2u){se.z, se.w};
        asm volatile("" ::: "memory");
        const v2u so0 = *(const LAS v2u*)(sSort + 4 * lane), so1 = *(const LAS v2u*)(sSort + 4 * lane + 2); const v4u so = (v4u){so0.x, so0.y, so1.x, so1.y};
        asm volatile("" ::: "memory");
#ifndef DBG_NOSTORE
        *(v4u*)(SELW + (tokb + it) * 256 + 4 * lane) = so;
#endif
        { const unsigned g0 = so0.y, g1 = so1.y; sCoef[it * 128 + 2 * lane] = __uint_as_float(g0); sCoef[it * 128 + 2 * lane + 1] = __uint_as_float(g1); }
        if (lane == it) cnts = pk;
    }
    asm volatile("s_waitcnt vmcnt(0) lgkmcnt(0)" ::: "memory");
#ifdef DBG_NOBUCKET
    cnts = 0u;
#endif
#define PL_LOAD(RB, TAB, SE, BB) do { _Pragma("unroll") for (int _q = 0; _q < 16; ++_q) { \
        const unsigned _idx = (unsigned)__builtin_amdgcn_readlane((int)((_q & 1) ? (SE).z : (SE).x), (BB) * 8 + (_q >> 1)); \
        (RB)[_q] = *(const v4u*)((TAB) + (size_t)_idx * 1024 + 16 * lane); } } while (0)
#define PL_LOAD_U(RB, SE, BB) do { const int _src = ((BB) * 8 + ((lane & 15) >> 1)) * 4; \
        const unsigned _ix = (unsigned)__builtin_amdgcn_ds_bpermute(_src, (int)(SE).x), _iz = (unsigned)__builtin_amdgcn_ds_bpermute(_src, (int)(SE).z); \
        const unsigned char* _p = U8 + (size_t)((lane & 1) ? _iz : _ix) * 1024 + 32 * (lane >> 4); \
        _Pragma("unroll") for (int _j = 0; _j < 16; ++_j) (RB)[_j] = *(const v4u*)(_p + 128 * (_j >> 1) + 16 * (_j & 1)); } while (0)
#define PL_RANGE(T, P, NP, RLO, RHI, BLO, BHI) const unsigned _pk##T = (unsigned)__builtin_amdgcn_readlane((int)cnts, (T)); \
        const int _sp##T = min((int)((((_pk##T >> 8) & 255u) + 15u) & ~15u), 128);     \
        const int RLO = (P) == 0 ? 0 : _sp##T, RHI = (P) == 0 ? _sp##T : 128; \
        const int BLO = min(RLO >> 4, 7), BHI = max((RHI + 15) >> 4, BLO + 1)
    v4u ra[16], rb[16];
#ifndef DBG_U0
#define DBG_U0 0
#define DBG_V0 0
#endif
    for (int ps = DBG_U0; ps < 2; ++ps) {
        int lt = 0, lb, lbh; { PL_RANGE(lt, ps, 2, r0, r1, b0_, b1_); lb = b0_; lbh = b1_; (void)r0; (void)r1; }
        v4u seL = *(const v4u*)(SELW + tokb * 256 + 4 * lane), seN = *(const v4u*)(SELW + (tokb + 1) * 256 + 4 * lane);
        long xlo = 0, xhi = 0; const bool dsel = ((lane >> 2) & 3) == (lane >> 4); v4u nraw0, nraw1, nnx0 = *(const v4u*)(N2 + tokb * 1024 + 16 * lane), nnx1 = *(const v4u*)(N2 + tokb * 1024 + 16 * lane + 8);
        int ct, cb, crl = 0, crh = 0, cbl = 0;
#define U_ADV() do { ++lb; if (lb >= lbh) { ++lt; if (lt < 16) { PL_RANGE(lt, ps, 2, _r0, _r1, _b0, _b1); lb = _b0; lbh = _b1; (void)_r0; (void)_r1; seL = seN; if (lt + 1 < 16) seN = *(const v4u*)(SELW + (tokb + lt + 1) * 256 + 4 * lane); } } } while (0)
#define U_COMPUTE(RB) do { \
            if (cb == cbl) { nraw0 = nnx0; nraw1 = nnx1; if (ct + 1 < 16) { nnx0 = *(const v4u*)(N2 + (tokb + ct + 1) * 1024 + 16 * lane); nnx1 = *(const v4u*)(N2 + (tokb + ct + 1) * 1024 + 16 * lane + 8); } \
                f32x4 x0, x1, x2, x3; unpk8(nraw0, x0, x1); unpk8(nraw1, x2, x3); x0 = x0 * 16.f; x1 = x1 * 16.f; x2 = x2 * 16.f; x3 = x3 * 16.f; \
                int _w0 = 0, _w1 = 0, _w2 = 0, _w3 = 0; \
                _w0 = __builtin_amdgcn_cvt_pk_fp8_f32(x0.x, x0.y, _w0, false); _w0 = __builtin_amdgcn_cvt_pk_fp8_f32(x0.z, x0.w, _w0, true); \
                _w1 = __builtin_amdgcn_cvt_pk_fp8_f32(x1.x, x1.y, _w1, false); _w1 = __builtin_amdgcn_cvt_pk_fp8_f32(x1.z, x1.w, _w1, true); \
                _w2 = __builtin_amdgcn_cvt_pk_fp8_f32(x2.x, x2.y, _w2, false); _w2 = __builtin_amdgcn_cvt_pk_fp8_f32(x2.z, x2.w, _w2, true); \
                _w3 = __builtin_amdgcn_cvt_pk_fp8_f32(x3.x, x3.y, _w3, false); _w3 = __builtin_amdgcn_cvt_pk_fp8_f32(x3.z, x3.w, _w3, true); \
                xlo = (long)(((unsigned long long)(unsigned)_w1 << 32) | (unsigned)_w0); xhi = (long)(((unsigned long long)(unsigned)_w3 << 32) | (unsigned)_w2); } \
            _Pragma("unroll") for (int _g = 0; _g < 2; ++_g) { float _p[8]; \
                _Pragma("unroll") for (int _q = 0; _q < 8; ++_q) { f32x4 _d = (f32x4){0.f, 0.f, 0.f, 0.f}; \
                    _d = __builtin_amdgcn_mfma_f32_16x16x32_fp8_fp8((long)(((unsigned long long)(RB)[8 * _g + _q].y << 32) | (RB)[8 * _g + _q].x), xlo, _d, 0, 0, 0); \
                    _d = __builtin_amdgcn_mfma_f32_16x16x32_fp8_fp8((long)(((unsigned long long)(RB)[8 * _g + _q].w << 32) | (RB)[8 * _g + _q].z), xhi, _d, 0, 0, 0); \
                    const float _sl = (lane & 2) ? ((lane & 1) ? _d.w : _d.z) : ((lane & 1) ? _d.y : _d.x); \
                    _p[_q] = dsel ? _sl : 0.f; }     \
                const float _s0 = swap32_add(_p[0], _p[4]), _s1 = swap32_add(_p[1], _p[5]), _s2 = swap32_add(_p[2], _p[6]), _s3 = swap32_add(_p[3], _p[7]); \
                float _t0 = row_sum16(swap16_add(_s0, _s2)), _t1 = row_sum16(swap16_add(_s1, _s3)); \
                _t0 = fgelu(_t0 * (1.f / 4096.f)) * (1.f / 64.f); _t1 = fgelu(_t1 * (1.f / 4096.f)) * (1.f / 64.f); \
                if ((lane & 15) == 0) { const int _r = lane >> 4, _e = cb * 16 + 8 * _g + 2 * (_r & 1) + 4 * (_r >> 1); LAS float* _c = sCoef + ct * 128 + _e; \
                    if (_e >= crl && _e < crh) _c[0] *= _t0; if (_e + 1 >= crl && _e + 1 < crh) _c[1] *= _t1; } } } while (0)
#define U_SETC() do { ct = lt; cb = lb; { PL_RANGE(ct, ps, 2, _r0, _r1, _b0, _b1); crl = _r0; crh = _r1; cbl = _b0; (void)_b1; } } while (0)
        PL_LOAD(ra, U8, seL, lb);
        U_SETC(); U_ADV();
        for (;;) {
            if (lt < 16) PL_LOAD(rb, U8, seL, lb);
            U_COMPUTE(ra);
            if (lt >= 16) break;
            U_SETC(); U_ADV();
            if (lt < 16) PL_LOAD(ra, U8, seL, lb);
            U_COMPUTE(rb);
            if (lt >= 16) break;
            U_SETC(); U_ADV();
        }
        asm volatile("s_waitcnt lgkmcnt(0)" ::: "memory");
        __syncthreads();
    }
#undef U_ADV
#undef U_COMPUTE
#undef U_SETC
    for (int ps = DBG_V0; ps < 2; ++ps) {
        int lt = 0, lb, lbh; { PL_RANGE(lt, ps, 2, r0, r1, b0_, b1_); lb = b0_; lbh = b1_; (void)r0; (void)r1; }
        v4u seL = *(const v4u*)(SELW + tokb * 256 + 4 * lane), seN = *(const v4u*)(SELW + (tokb + 1) * 256 + 4 * lane);
        f32x2 out[8]; f32x4 hpre[4], ac4[4];
        const unsigned vmask = ((lane >> 4) == ((lane & 15) >> 2)) ? (0xFFu << (8 * (lane & 3))) : 0u;
        int ct, cb, crl = 0, crh = 0, cbl = 0, cbh = 0;
#define V_ADV() do { ++lb; if (lb >= lbh) { ++lt; if (lt < 16) { PL_RANGE(lt, ps, 2, _r0, _r1, _b0, _b1); lb = _b0; lbh = _b1; (void)_r0; (void)_r1; seL = seN; if (lt + 1 < 16) seN = *(const v4u*)(SELW + (tokb + lt + 1) * 256 + 4 * lane); } } } while (0)
#define V_SETC() do { ct = lt; cb = lb; { PL_RANGE(ct, ps, 2, _r0, _r1, _b0, _b1); crl = _r0; crh = _r1; cbl = _b0; cbh = _b1; } } while (0)
#ifndef REP_LV
#define REP_LV 1
#endif
#define V_COMPUTE(RB) do { \
            if (cb == cbl) { _Pragma("unroll") for (int _i = 0; _i < 4; ++_i) { ac4[_i] = (f32x4){0.f, 0.f, 0.f, 0.f}; hpre[_i] = *(const f32x4*)(F.h + (tokb + ct) * 1024 + 16 * lane + 4 * _i); } }     \
            _Pragma("unroll") for (int _q = 0; _q < 16; ++_q) { const int _e = cb * 16 + _q; \
                float _c = sCoef[ct * 128 + _e]; _c = (_e >= crl && _e < crh) ? _c * 2048.f : 0.f; \
                int _w = __builtin_amdgcn_cvt_pk_fp8_f32(_c, _c, 0, false); _w = __builtin_amdgcn_cvt_pk_fp8_f32(_c, _c, _w, true); const unsigned _x = (unsigned)_w & vmask; \
                const long _ae = (long)(unsigned long long)_x, _ao = (long)((unsigned long long)_x << 32); \
                const long _bl = (long)(((unsigned long long)(RB)[_q].y << 32) | (RB)[_q].x), _bh = (long)(((unsigned long long)(RB)[_q].w << 32) | (RB)[_q].z); \
                ac4[0] = __builtin_amdgcn_mfma_f32_16x16x32_fp8_fp8(_ae, _bl, ac4[0], 0, 0, 0); ac4[1] = __builtin_amdgcn_mfma_f32_16x16x32_fp8_fp8(_ao, _bl, ac4[1], 0, 0, 0); \
                ac4[2] = __builtin_amdgcn_mfma_f32_16x16x32_fp8_fp8(_ae, _bh, ac4[2], 0, 0, 0); ac4[3] = __builtin_amdgcn_mfma_f32_16x16x32_fp8_fp8(_ao, _bh, ac4[3], 0, 0, 0); } \
            if (cb == cbh - 1) { _Pragma("unroll") for (int _i = 0; _i < 4; ++_i) { out[2 * _i] = (f32x2){ac4[_i].x, ac4[_i].y} * (1.f / 2048.f); out[2 * _i + 1] = (f32x2){ac4[_i].z, ac4[_i].w} * (1.f / 2048.f); } \
                peer_token_end(F, a, layer, last, ps == 1, tokb + ct, lane, out, hpre); } } while (0)
        PL_LOAD(ra, V8, seL, lb);
        V_SETC(); V_ADV();
        for (;;) {
            if (lt < 16) PL_LOAD(rb, V8, seL, lb);
            V_COMPUTE(ra);
            if (lt >= 16) break;
            V_SETC(); V_ADV();
            if (lt < 16) PL_LOAD(ra, V8, seL, lb);
            V_COMPUTE(rb);
            if (lt >= 16) break;
            V_SETC(); V_ADV();
        }
        asm volatile("s_waitcnt vmcnt(0)" ::: "memory");
        __syncthreads();
    }
#undef V_ADV
#undef V_SETC
#undef V_COMPUTE
#undef PL_LOAD
#undef PL_RANGE
}


#ifndef ZSKIP
#define ZSKIP 0
#endif
#ifndef ZGA_ALIGN
#define ZGA_ALIGN true
#endif
#ifndef ZGA_SP2
#define ZGA_SP2 true
#endif
#ifndef WIN_ALIGN
#define WIN_ALIGN true
#endif
#ifndef WIN_SP2
#define WIN_SP2 true
#endif
#ifndef REP_E
#define REP_E 1
#endif
#ifndef REP_A
#define REP_A 1
#endif
#ifndef REP_B
#define REP_B 1
#endif
#ifndef REP_C
#define REP_C 1
#endif
#ifndef REP_D
#define REP_D 1
#endif
#ifndef REP_G
#define REP_G 1
#endif
#ifndef REP_I
#define REP_I 1
#endif
#ifndef REP_K
#define REP_K 1
#endif
__global__ void __launch_bounds__(NWAVES * 64, 2) trunk_fwd(Args args) {
    extern __shared__ __attribute__((aligned(16))) unsigned char lds[];
    Frame F;
    F.lds = (LAS unsigned char*)lds;
    F.tid = threadIdx.x; F.lane = F.tid & 63; F.wave = __builtin_amdgcn_readfirstlane(F.tid >> 6); F.wave0 = F.wave;
    F.G = gridDim.x; F.bx = blockIdx.x; F.ws = (GAS unsigned char*)args.ws; F.h = args.out;
    volatile LAS unsigned* MISC = (volatile LAS unsigned*)(F.lds + MISC_OFF);
    for (int u = F.tid; u < (LDS_BYTES - LDSCTL_OFF) / 4; u += NWAVES * 64) ((LAS unsigned*)(F.lds + LDSCTL_OFF))[u] = 0u;
    __syncthreads();
    unsigned* ctl = (unsigned*)(F.ws + WS_CTL);
    XcdBarrier bar = xcd_barrier_post(ctl + CW_BAR, MISC + 8);
    GAS unsigned char* ws = F.ws;
    LAS unsigned char* ring = (LAS unsigned char*)F.lds;

    for (int rep = 0; rep < REP_A; ++rep) { prep_phase(F, args, 0, F.bx, F.G, 1);
    xcd_barrier(bar, F.wave0); }
#define OPQ() GAS unsigned char* ws = F.ws; asm volatile("" : "+s"(ws)); GAS unsigned char* db = ws + WS_DB + (size_t)(layer & 1) * DB_SET; (void)db
    for (int layer = 0; layer < DEPTH; ++layer) {
        {   OPQ();
        for (int rep = 0; rep < REP_B; ++rep) {   if (rep) xcd_barrier(bar, F.wave0); pg8::Gemm g{(const bf16*)(ws + WS_NX), (const bf16*)(ws + WS_WIN), T, NZ - 256 * ZSPLIT, 2048, 2048}; pg8::StaticOrder S; S.init(T, NZ - 256 * ZSPLIT, F.G, F.bx);
            pg8::EpiZ E{(bf16*)(ws + WS_ZRKV), (bf16*)(ws + WS_ZL), (bf16*)(ws + WS_GUV), (bf16*)(ws + WS_SG), layer == 0 ? (bf16*)(ws + WS_VF) : (bf16*)nullptr, 0};
            pg8::gemm_phase<pg8::EpiZ, pg8::StaticOrder, WIN_ALIGN, WIN_SP2>(ring, g, S, E, F.wave0); }
        }
        xcd_barrier(bar, F.wave0);
        {   OPQ();
        for (int rep = 0; rep < REP_C; ++rep) {   if (rep) xcd_barrier(bar, F.wave0); { pg8::Gemm g{(const bf16*)(ws + WS_ZL), (const bf16*)(ws + WS_LORA + (size_t)layer * LORA_BYTES), T, 2048, 128, 512}; pg8::StaticOrder S; S.init(T, 2048, F.G, F.bx);
            pg8::EpiLora E{(bf16*)(ws + WS_EW), (size_t)(WS_AR - WS_EW) / 2, args.in[6] + (size_t)layer * 1024, args.in[8] + (size_t)layer * 1024, 0};
            pg8::gemm_phase<pg8::EpiLora, pg8::StaticOrder, true, true>(ring, g, S, E, F.wave0); }
            { pg8::Gemm g{(const bf16*)(ws + WS_ZL) + 128, (const bf16*)(ws + WS_LORA + (size_t)layer * LORA_BYTES) + 2048 * 128, T, 1024, 128, 512}; pg8::StaticOrder S; S.init(T, 1024, F.G, F.bx);
            pg8::EpiLora E{(bf16*)(ws + WS_EW), (size_t)(WS_AR - WS_EW) / 2, args.in[6] + (size_t)layer * 1024, args.in[8] + (size_t)layer * 1024, 8};
            pg8::gemm_phase<pg8::EpiLora, pg8::StaticOrder, true, true>(ring, g, S, E, F.wave0); } }
        if (layer > 0) {
            pg8::Gemm g{(const bf16*)(ws + WS_ZL) + 256, (const bf16*)(ws + WS_MV + (size_t)(layer - 1) * MV_BYTES), T, 1024, 128, 512}; pg8::StaticOrder S; S.init(T, 1024, F.G, F.bx);
            pg8::EpiMv E{(bf16*)(ws + WS_ZRKV), (const bf16*)(ws + WS_VF), args.in[18] + (size_t)(layer - 1) * 1024};
            pg8::gemm_phase<pg8::EpiMv, pg8::StaticOrder, true, true>(ring, g, S, E, F.wave0); }
        }
        xcd_barrier(bar, F.wave0);
        {   OPQ();
        for (int rep = 0; rep < REP_D; ++rep) {   if (rep) xcd_barrier(bar, F.wave0); const int nsb = F.G / 2, nob = F.G - nsb;
            if (F.bx < nsb) { for (int u = F.bx; u < NB * 16; u += nsb) scan_unit(F, args, layer, u); }
            else { const int ob = F.bx - nsb;
                for (int pm = ob; pm < T / 256; pm += nob)
                    for (int rep2 = 0; rep2 < REP_E; ++rep2) { gmlp_unit(F, args, layer, 2 * pm); gmlp_unit(F, args, layer, 2 * pm + 1); }
                asm volatile("s_waitcnt vmcnt(0)" ::: "memory"); __syncthreads();
                {
                    pg8::Gemm g{(const bf16*)(ws + WS_GUV), (const bf16*)(db + DB_PBT), T, 1024, 1024, 2048}; pg8::PanelOrder S{ob, nob, T / 256, 4, 0};
                    pg8::EpiMerge<false> E{(const bf16*)(ws + WS_SG), (bf16*)(ws + WS_GUV) + 1024, (bf16*)nullptr};
                    pg8::gemm_phase<pg8::EpiMerge<false>, pg8::PanelOrder, true, true>(ring, g, S, E, F.wave0); }
                {
                    pg8::Gemm g{(const bf16*)(ws + WS_NX), (const bf16*)(ws + WS_WINB + (size_t)(layer & 1) * WINB_BYTES), T, 256 * ZSPLIT, 2048, 2048}; pg8::StaticOrder S; S.init(T, 256 * ZSPLIT, nob, ob);
                    pg8::EpiZ E{(bf16*)(ws + WS_ZRKV), (bf16*)(ws + WS_ZL), (bf16*)(ws + WS_GUV), (bf16*)(ws + WS_SG), (bf16*)nullptr, 30 - ZSPLIT};
                    pg8::gemm_phase<pg8::EpiZ, pg8::StaticOrder, true, true>(ring, g, S, E, F.wave0); }
                {   pg8::Gemm g{(const bf16*)(db + DB_PB), (const bf16*)(db + DB_PLEW), T, 1024, 256, 256}; pg8::StaticOrder S; S.init(T, 1024, nob, ob);
                    pg8::EpiPlain E{(bf16*)(ws + WS_PW), 1024};
                    pg8::gemm_phase<pg8::EpiPlain, pg8::StaticOrder, true, true>(ring, g, S, E, F.wave0); }
                if (layer == 0) prep_phase(F, args, 0, ob, nob, 2);
                if (layer + 1 < DEPTH) prep_phase(F, args, layer + 1, ob, nob, 3); } }
        }
        xcd_barrier(bar, F.wave0);
        {   OPQ();
        for (int rep = 0; rep < REP_G; ++rep) {   if (rep) xcd_barrier(bar, F.wave0); pg8::Gemm g{(const bf16*)(ws + WS_G), (const bf16*)(db + DB_PA), T, 1024, 1024, 1024}; pg8::StaticOrder S; S.init(T, 1024, F.G, F.bx);
            pg8::EpiMerge<true> E{(const bf16*)(ws + WS_SG), (bf16*)(ws + WS_GUV) + 1024, (bf16*)(ws + WS_MG)};
            pg8::gemm_phase<pg8::EpiMerge<true>, pg8::StaticOrder, true, true>(ring, g, S, E, F.wave0); }
        }
        xcd_barrier(bar, F.wave0);
        {   OPQ();
        {   pg8::Gemm g{(const bf16*)(ws + WS_MG), (const bf16*)(db + DB_POUT), T, 1024, 1024, 1024}; pg8::StaticOrder S; S.init(T, 1024, F.G, F.bx);
            pg8::EpiResid E{F.h};
            pg8::gemm_phase<pg8::EpiResid, pg8::StaticOrder, true, true>(ring, g, S, E, F.wave0); }
        }
        xcd_barrier(bar, F.wave0);
        {   OPQ();
        for (int rep = 0; rep < REP_I; ++rep) {   if (rep) xcd_barrier(bar, F.wave0); phase_ids(F); const int gw = F.bx * NWAVES + F.wave, NGW = F.G * NWAVES; const float* g2 = args.in[3] + (size_t)layer * 1024;
            for (int m = gw; m < T / 2; m += NGW) norm_row_n2x2(F.h + (size_t)m * D, F.h + (size_t)(m + T / 2) * D, g2, (bf16*)(ws + WS_N2) + (size_t)m * D, (bf16*)(ws + WS_N2) + (size_t)(m + T / 2) * D, F.lane); }
        }
        xcd_barrier(bar, F.wave0);
        {   OPQ();
        {   pg8::Gemm g{(const bf16*)(ws + WS_N2), (const bf16*)(db + DB_WQG), T, 3072, 1024, 1024}; pg8::StaticOrder S; S.init(T, 3072, F.G, F.bx);
            pg8::EpiQG E{(bf16*)(ws + WS_Q), (const bf16*)(ws + WS_PW), F.h};
            pg8::gemm_phase<pg8::EpiQG, pg8::StaticOrder, true, true>(ring, g, S, E, F.wave0); }
        }
        xcd_barrier(bar, F.wave0);
        {   OPQ();
        for (int u = F.bx; u < T / 128; u += F.G) peer_unit(F, args, layer, u, layer == DEPTH - 1);
        }
        if (layer + 1 < DEPTH) xcd_barrier(bar, F.wave0);
    }
}

extern "C" void kernel_launch(void* const* d_in, const int* in_sizes, int n_in, void* d_out, int out_size, void* d_ws, size_t ws_size, hipStream_t stream) {
    static int grid = 0;
    if (grid == 0) {
        if (n_in != 32 || out_size != T * D || ws_size < WS_END) { fprintf(stderr, "kernel_launch: unexpected sizes n_in %d out %d ws %zu (need %zu); nothing launched\n", n_in, out_size, ws_size, (size_t)WS_END); grid = -1; return; }
        int dev = 0, cus = 0, per_cu = 0;
        if (hipGetDevice(&dev) != hipSuccess || hipDeviceGetAttribute(&cus, hipDeviceAttributeMultiprocessorCount, dev) != hipSuccess) { grid = -1; return; }
        if (hipFuncSetAttribute((const void*)trunk_fwd, hipFuncAttributeMaxDynamicSharedMemorySize, LDS_BYTES) != hipSuccess) { fprintf(stderr, "kernel_launch: hipFuncSetAttribute failed\n"); grid = -1; return; }
        if (hipOccupancyMaxActiveBlocksPerMultiprocessor(&per_cu, (const void*)trunk_fwd, NWAVES * 64, LDS_BYTES) != hipSuccess || per_cu < 1)
            fprintf(stderr, "kernel_launch: note: occupancy query reports %d workgroups per CU\n", per_cu);
        (void)hipGetLastError();
        grid = cus;
    }
    if (grid < 0) return;
    (void)hipMemsetAsync((char*)d_ws + WS_CTL, 0, ZERO_BYTES, stream);
    (void)hipMemsetAsync((char*)d_ws + WIN_ZERO_OFF, 0, WIN_ZERO_BYTES, stream);
    Args a{};
    for (int i = 0; i < 32; ++i) a.in[i] = (const float*)d_in[i];
    a.out = (float*)d_out; a.ws = (unsigned char*)d_ws;
    hipLaunchKernelGGL(trunk_fwd, dim3(grid), dim3(NWAVES * 64), LDS_BYTES, stream, a);
    const hipError_t le = hipPeekAtLastError();
    if (le != hipSuccess) fprintf(stderr, "kernel_launch: launch failed: %s\n", hipGetErrorName(le));
}
```

```cpp
#include <hip/hip_runtime.h>
#include <cstdio>
#include <cstdint>
#define ZSPLIT 4
namespace pg8 {
#define PG8_LAS __attribute__((address_space(3)))
typedef unsigned short bf16_t;
typedef short bf16x8 __attribute__((ext_vector_type(8)));
typedef float f32x4 __attribute__((ext_vector_type(4)));
typedef unsigned u32x4 __attribute__((ext_vector_type(4)));
constexpr int BM = 256, BK = 64, HALF = 128, HTB = HALF * BK * 2  , STAGE_BYTES = 8 * HTB, NXCD = 8, WGM = 8;

__host__ __device__ __forceinline__ int lds_byte(int r, int c) { const int st = (r >> 4) * 2 + (c >> 5), rr = r & 15, cc = c & 31, ob = rr * 64 + cc * 2; return st * 1024 + (ob ^ (((ob >> 9) & 1) << 5)); }
__host__ __device__ __forceinline__ void stage_rc(int b, int& R, int& C) { const int st = b / 1024, sb = b % 1024, swz = sb ^ (((sb >> 9) & 1) << 5); R = (st >> 1) * 16 + swz / 64; C = (st & 1) * 32 + (swz % 64) / 2; }
__host__ __device__ __forceinline__ int perm32(int rho) { const int n = rho >> 4, i = rho & 15; return 8 * (i >> 2) + 4 * n + (i & 3); }

struct Unit { int pm, pn; };
struct Gemm { const bf16_t* A; const bf16_t* Bt; int M, N, K, lda; };

struct StaticOrder {
    int nM, nN, nwg, G, c;
    __host__ __device__ void init(int M, int N, int G_, int c_) { nM = M / BM; nN = N / BM; nwg = nM * nN; G = G_; c = c_; }
    __host__ __device__ bool next(int i, Unit& u) const {
        const long L = (long)i * G + c; if (L >= nwg) return false;
        int wgid = (int)L; { const int q = nwg / NXCD, r = nwg % NXCD, xcd = wgid % NXCD, off = wgid / NXCD; wgid = (xcd < r ? xcd * (q + 1) : r * (q + 1) + (xcd - r) * q) + off; }
        const int nig = WGM * nN, gid = wgid / nig, fm = gid * WGM, gsz = (nM - fm) < WGM ? (nM - fm) : WGM;
        u.pm = fm + ((wgid % nig) % gsz); u.pn = (wgid % nig) / gsz; return true;
    }
    __device__ __forceinline__ void a_ready(const Unit&) const {}
    __device__ __forceinline__ void done(const Unit&) const {}
};
struct PanelOrder {
    int first, stride, nM, nN, pn0;
    __host__ __device__ bool next(int i, Unit& u) const { const int p = first + (i / nN) * stride; if (p >= nM) return false; u.pm = p; u.pn = pn0 + i % nN; return true; }
    __device__ __forceinline__ void a_ready(const Unit&) const {}
    __device__ __forceinline__ void done(const Unit&) const {}
};
__device__ __forceinline__ unsigned cvt_pk_bf16(float lo, float hi) { unsigned r; asm volatile("v_cvt_pk_bf16_f32 %0, %1, %2" : "=v"(r) : "v"(lo), "v"(hi)); return r; }

__device__ __forceinline__ float fsig(float x) { return __builtin_amdgcn_rcpf(1.f + __builtin_amdgcn_exp2f(-1.44269504f * x)); }
__device__ __forceinline__ float fgelu(float x) { return x * fsig(1.5957691216f * (x + 0.044715f * x * x * x)); }
__device__ __forceinline__ float bflo(unsigned w) { return __builtin_bit_cast(float, w << 16); }
__device__ __forceinline__ float bfhi(unsigned w) { return __builtin_bit_cast(float, w & 0xffff0000u); }
__device__ __forceinline__ void unpk8(const u32x4 w, f32x4& a, f32x4& b) { a = (f32x4){bflo(w.x), bfhi(w.x), bflo(w.y), bfhi(w.y)}; b = (f32x4){bflo(w.z), bfhi(w.z), bflo(w.w), bfhi(w.w)}; }
__device__ __forceinline__ u32x4 pk8(const f32x4 a, const f32x4 b) { u32x4 w; w.x = cvt_pk_bf16(a[0], a[1]); w.y = cvt_pk_bf16(a[2], a[3]); w.z = cvt_pk_bf16(b[0], b[1]); w.w = cvt_pk_bf16(b[2], b[3]); return w; }
__device__ __forceinline__ f32x4 act4(f32x4 v, int kind) {
    if (kind == 1) { v = (f32x4){fgelu(v[0]), fgelu(v[1]), fgelu(v[2]), fgelu(v[3])}; }
    else if (kind == 2) { v = (f32x4){fsig(v[0]), fsig(v[1]), fsig(v[2]), fsig(v[3])}; }
    else if (kind == 3) { v = (f32x4){2.f * fsig(2.f * v[0]) - 1.f, 2.f * fsig(2.f * v[1]) - 1.f, 2.f * fsig(2.f * v[2]) - 1.f, 2.f * fsig(2.f * v[3]) - 1.f}; }
    return v;
}
#define EPI_ROWS_BEGIN _Pragma("unroll") for (int ai = 0; ai < 2; ++ai) _Pragma("unroll") for (int m = 0; m < 4; ++m) { const size_t row = (size_t)(row0 + ai * HALF + m * 16);
#define EPI_ROWS_END }

struct EpiZ {
    static constexpr bool PERM = true, AFTER_DRAIN = false;
    bf16_t *zrkv, *zl, *guv, *sg, *vf; int pnoff;
    __device__ __forceinline__ void operator()(const f32x4 (&acc)[2][2][4][2], const Unit& u, int wr, int wc, int fr, int fq) const {
        const int pn = u.pn + pnoff, row0 = u.pm * BM + wr * 64 + fr;
        bf16_t* dst; int ld, colt, k0, k1;
        if (pn < 12)       { dst = zrkv; ld = 3072; colt = pn * 256;        k0 = 0; k1 = 0; }
        else if (pn == 12) { dst = zl;   ld = 512;  colt = 0;               k0 = (wc < 2) ? 3 : 0; k1 = 2; }
        else if (pn == 13) { dst = zl;   ld = 512;  colt = 256;             k0 = 0; k1 = 0; }
        else if (pn < 22)  { dst = guv;  ld = 2048; colt = (pn - 14) * 256; k0 = 1; k1 = 1; }
        else               { dst = sg;   ld = 2048; colt = ((pn - 18) & 7) * 256; k0 = 2; k1 = 2; }
        const int col0 = colt + wc * 32 + 8 * fq;
        const bool dovf = (vf != nullptr) && pn >= 8 && pn < 12;
        const int vcol0 = (pn - 8) * 256 + wc * 32 + 8 * fq;
        EPI_ROWS_BEGIN
            bf16_t* rowp = dst + row * ld + col0;
#pragma unroll
            for (int bj = 0; bj < 2; ++bj) { const int kind = bj ? k1 : k0;
                const u32x4 w = pk8(act4(acc[ai][bj][m][0], kind), act4(acc[ai][bj][m][1], kind));
                *(u32x4*)(rowp + bj * HALF) = w;
                if (dovf) *(u32x4*)(vf + row * 1024 + vcol0 + bj * HALF) = w; }
        EPI_ROWS_END
    }
};
struct EpiLora {
    static constexpr bool PERM = true, AFTER_DRAIN = false;
    bf16_t* ew; size_t stride; const float *w0, *a0; int pnoff;
    __device__ __forceinline__ void operator()(const f32x4 (&acc)[2][2][4][2], const Unit& u, int wr, int wc, int fr, int fq) const {
        const int pn = u.pn + pnoff, sel = pn >> 2, row0 = u.pm * BM + wr * 64 + fr, col0 = (pn & 3) * 256 + wc * 32 + 8 * fq;
        bf16_t* dst = ew + (size_t)sel * stride;
        const float* bp = sel == 0 ? w0 : a0;
        f32x4 bv[2][2];
#pragma unroll
        for (int bj = 0; bj < 2; ++bj)
#pragma unroll
            for (int n = 0; n < 2; ++n) bv[bj][n] = (sel < 2) ? *(const f32x4*)(bp + col0 + bj * HALF + 4 * n) : (f32x4){0.f, 0.f, 0.f, 0.f};
        EPI_ROWS_BEGIN
            bf16_t* rowp = dst + row * 1024 + col0;
#pragma unroll
            for (int bj = 0; bj < 2; ++bj) { f32x4 v0 = acc[ai][bj][m][0] + bv[bj][0], v1 = acc[ai][bj][m][1] + bv[bj][1];
                if (sel < 2) { v0 = act4(v0, 2); v1 = act4(v1, 2); }
                if (sel == 0) { v0 = v0 * 0.60653066f; v1 = v1 * 0.60653066f; }
                *(u32x4*)(rowp + bj * HALF) = pk8(v0, v1); }
        EPI_ROWS_END
    }
};
struct EpiMv {
    static constexpr bool PERM = true, AFTER_DRAIN = false;
    bf16_t* zrkv; const bf16_t* vf; const float* v0b;
    __device__ __forceinline__ void operator()(const f32x4 (&acc)[2][2][4][2], const Unit& u, int wr, int wc, int fr, int fq) const {
        const int row0 = u.pm * BM + wr * 64 + fr, col0 = u.pn * 256 + wc * 32 + 8 * fq;
        f32x4 bv[2][2];
#pragma unroll
        for (int bj = 0; bj < 2; ++bj)
#pragma unroll
            for (int n = 0; n < 2; ++n) bv[bj][n] = *(const f32x4*)(v0b + col0 + bj * HALF + 4 * n);
        EPI_ROWS_BEGIN
#pragma unroll
            for (int bj = 0; bj < 2; ++bj) { bf16_t* zp = zrkv + row * 3072 + 2048 + col0 + bj * HALF;
                f32x4 z0, z1, f0, f1; unpk8(*(const u32x4*)zp, z0, z1); unpk8(*(const u32x4*)(vf + row * 1024 + col0 + bj * HALF), f0, f1);
                const f32x4 m0 = act4(acc[ai][bj][m][0] + bv[bj][0], 2), m1 = act4(acc[ai][bj][m][1] + bv[bj][1], 2);
                *(u32x4*)zp = pk8(z0 + (f0 - z0) * m0, z1 + (f1 - z1) * m1); }
        EPI_ROWS_END
    }
};
struct EpiPlain {
    static constexpr bool PERM = true, AFTER_DRAIN = false;
    bf16_t* o; int ld;
    __device__ __forceinline__ void operator()(const f32x4 (&acc)[2][2][4][2], const Unit& u, int wr, int wc, int fr, int fq) const {
        const int row0 = u.pm * BM + wr * 64 + fr, col0 = u.pn * 256 + wc * 32 + 8 * fq;
        EPI_ROWS_BEGIN
#pragma unroll
            for (int bj = 0; bj < 2; ++bj) *(u32x4*)(o + row * ld + col0 + bj * HALF) = pk8(acc[ai][bj][m][0], acc[ai][bj][m][1]);
        EPI_ROWS_END
    }
};
template <bool SECOND> struct EpiMerge {
    static constexpr bool PERM = true, AFTER_DRAIN = false;
    const bf16_t* sg; bf16_t* m2; bf16_t* o;
    __device__ __forceinline__ void operator()(const f32x4 (&acc)[2][2][4][2], const Unit& u, int wr, int wc, int fr, int fq) const {
        const int row0 = u.pm * BM + wr * 64 + fr, col0 = u.pn * 256 + wc * 32 + 8 * fq;
#pragma unroll
        for (int ai = 0; ai < 2; ++ai) { u32x4 gv[4][2], pv[4][2];
#pragma unroll
            for (int m = 0; m < 4; ++m) { const size_t row = (size_t)(row0 + ai * HALF + m * 16);
#pragma unroll
                for (int bj = 0; bj < 2; ++bj) { const int c = col0 + bj * HALF; gv[m][bj] = *(const u32x4*)(sg + row * 2048 + (SECOND ? 0 : 1024) + c);
                    if (SECOND) pv[m][bj] = *(const u32x4*)(m2 + row * 2048 + c); } }
#pragma unroll
            for (int m = 0; m < 4; ++m) { const size_t row = (size_t)(row0 + ai * HALF + m * 16);
#pragma unroll
                for (int bj = 0; bj < 2; ++bj) { const int c = col0 + bj * HALF;
                    f32x4 g0, g1; unpk8(gv[m][bj], g0, g1);
                    f32x4 v0 = g0 * acc[ai][bj][m][0], v1 = g1 * acc[ai][bj][m][1];
                    if (SECOND) { f32x4 p0, p1; unpk8(pv[m][bj], p0, p1); v0 = v0 + p0; v1 = v1 + p1; *(u32x4*)(o + row * 1024 + c) = pk8(v0, v1); }
                    else *(u32x4*)(m2 + row * 2048 + c) = pk8(v0, v1); } } }
    }
};
struct EpiResid {
    static constexpr bool PERM = false, AFTER_DRAIN = false;
    float* h;
    __device__ __forceinline__ void operator()(const f32x4 (&acc)[2][2][4][2], const Unit& u, int wr, int wc, int fr, int fq) const {
        const int row0 = u.pm * BM + wr * 64 + fr, col0 = u.pn * 256 + wc * 32 + 4 * fq;
#pragma unroll
        for (int ai = 0; ai < 2; ++ai) { f32x4 hv[4][2][2];
#pragma unroll
            for (int m = 0; m < 4; ++m) { const float* rowp = h + (size_t)(row0 + ai * HALF + m * 16) * 1024 + col0;
#pragma unroll
                for (int bj = 0; bj < 2; ++bj)
#pragma unroll
                    for (int n = 0; n < 2; ++n) hv[m][bj][n] = *(const f32x4*)(rowp + bj * HALF + n * 16); }
#pragma unroll
            for (int m = 0; m < 4; ++m) { float* rowp = h + (size_t)(row0 + ai * HALF + m * 16) * 1024 + col0;
#pragma unroll
                for (int bj = 0; bj < 2; ++bj)
#pragma unroll
                    for (int n = 0; n < 2; ++n) *(f32x4*)(rowp + bj * HALF + n * 16) = hv[m][bj][n] + acc[ai][bj][m][n]; } }
    }
};
struct EpiQG {
    static constexpr bool PERM = true, AFTER_DRAIN = false;
    bf16_t* q; bf16_t* pw; float* h;
    __device__ __forceinline__ void operator()(const f32x4 (&acc)[2][2][4][2], const Unit& u, int wr, int wc, int fr, int fq) const {
        const int row0 = u.pm * BM + wr * 64 + fr;
        if (u.pn < 8) { const int col0 = u.pn * 256 + wc * 32 + 8 * fq;
            EPI_ROWS_BEGIN
#pragma unroll
                for (int bj = 0; bj < 2; ++bj) *(u32x4*)(q + row * 2048 + col0 + bj * HALF) = pk8(acc[ai][bj][m][0], acc[ai][bj][m][1]);
            EPI_ROWS_END
        } else { const int col0 = (u.pn - 8) * 256 + wc * 32 + 8 * fq;
#pragma unroll
            for (int ai = 0; ai < 2; ++ai)
#pragma unroll
            for (int mh = 0; mh < 2; ++mh) { u32x4 pwv[2][2];
#pragma unroll
                for (int m2_ = 0; m2_ < 2; ++m2_) { const size_t row = (size_t)(row0 + ai * HALF + (2 * mh + m2_) * 16);
#pragma unroll
                    for (int bj = 0; bj < 2; ++bj) { const int c = col0 + bj * HALF; pwv[m2_][bj] = *(const u32x4*)(pw + row * 1024 + c); } }
#pragma unroll
                for (int m2_ = 0; m2_ < 2; ++m2_) { const int m = 2 * mh + m2_; const size_t row = (size_t)(row0 + ai * HALF + m * 16);
#pragma unroll
                    for (int bj = 0; bj < 2; ++bj) { const int c = col0 + bj * HALF; f32x4 p0, p1; unpk8(pwv[m2_][bj], p0, p1);
                        *(u32x4*)(pw + row * 1024 + c) = pk8(p0 * act4(acc[ai][bj][m][0], 2), p1 * act4(acc[ai][bj][m][1], 2)); } } }
        }
    }
};
template <class Epi, class Sched, bool ALIGN_EPI = false, bool SP2 = false>
__device__ __forceinline__ void gemm_phase(PG8_LAS unsigned char* lds, const Gemm g, const Sched& S, const Epi& E, const int wave0) {
    int tidq; asm volatile("v_mbcnt_lo_u32_b32 %0, -1, 0\n\tv_mbcnt_hi_u32_b32 %0, -1, %0" : "=v"(tidq)); tidq += wave0 * 64;
    const int tid = tidq, wid = __builtin_amdgcn_readfirstlane(tid >> 6), lane = tid & 63, wr = wid >> 2, wc = wid & 3, fr = lane & 15, fq = lane >> 4;
    int Kq = g.K, ldaq = g.lda; const bf16_t* gA = g.A; const bf16_t* gB = g.Bt; asm volatile("" : "+s"(Kq), "+s"(ldaq), "+s"(gA), "+s"(gB));
    const int K = Kq, nt = K / BK;
    unsigned voffA[2], voffB[2];
#pragma unroll
    for (int i = 0; i < 2; ++i) { int R, C; stage_rc(tid * 16 + i * 8192, R, C); const int Rb = Epi::PERM ? ((R & ~31) + perm32(R & 31)) : R;
        voffA[i] = (unsigned)(R * ldaq + C) * 2u; voffB[i] = (unsigned)(Rb * K + C) * 2u; }
    const size_t kstep = (size_t)(BK * 2);
    const size_t hstepA = (size_t)HALF * ldaq * 2, hstepB = (size_t)HALF * K * 2;
    const size_t tstepA = 2 * hstepA, tstepB = 2 * hstepB;
    const unsigned ldsw = (unsigned)wid * 1024u;
    const int aoff = lds_byte(wr * 64 + fr, fq * 8), boff = lds_byte(wc * 32 + fr, fq * 8);
#define PG8_SA(b, h) (((b) * 2 + (h)) * HTB)
#define PG8_SB(b, h) ((4 + (b) * 2 + (h)) * HTB)
#define PG8_STAGE(bufoff, gbase, voff) do { _Pragma("unroll") for (int _i = 0; _i < 2; ++_i) \
        __builtin_amdgcn_global_load_lds((const unsigned*)((const char*)(gbase) + (voff)[_i]), (PG8_LAS unsigned*)(lds + (bufoff) + ldsw + _i * 8192), 16, 0, 0); } while (0)
#define PG8_LDA(dst, b, h) do { _Pragma("unroll") for (int m = 0; m < 4; ++m) _Pragma("unroll") for (int k = 0; k < 2; ++k) dst[m][k] = *(const PG8_LAS bf16x8*)(lds + PG8_SA(b, h) + aoff + m * 2048 + k * 1024); } while (0)
#define PG8_LDB(dst, b, h) do { _Pragma("unroll") for (int n = 0; n < 2; ++n) _Pragma("unroll") for (int k = 0; k < 2; ++k) dst[n][k] = *(const PG8_LAS bf16x8*)(lds + PG8_SB(b, h) + boff + n * 2048 + k * 1024); } while (0)
#define PG8_MMA(ai, bj, At, Bt) do { __builtin_amdgcn_s_setprio(1); _Pragma("unroll") for (int m = 0; m < 4; ++m) _Pragma("unroll") for (int n = 0; n < 2; ++n) _Pragma("unroll") for (int k = 0; k < 2; ++k) \
        acc[ai][bj][m][n] = __builtin_amdgcn_mfma_f32_16x16x32_bf16(Bt[n][k], At[m][k], acc[ai][bj][m][n], 0, 0, 0); __builtin_amdgcn_s_setprio(0); } while (0)
#define PG8_WAIT_V(n) asm volatile("s_waitcnt vmcnt(" #n ")" ::: "memory")
#define PG8_WAIT_L(n) asm volatile("s_waitcnt lgkmcnt(" #n ")" ::: "memory")
#define PG8_BAR __builtin_amdgcn_s_barrier()
#define PG8_SCHED __builtin_amdgcn_sched_barrier(0)
    Unit cur, nxt; int ui = 0;
    if (!S.next(0, cur)) return;
    f32x4 acc[2][2][4][2];
#pragma unroll
    for (int a = 0; a < 2; ++a)
#pragma unroll
        for (int b = 0; b < 2; ++b)
#pragma unroll
            for (int m = 0; m < 4; ++m)
#pragma unroll
                for (int n = 0; n < 2; ++n) acc[a][b][m][n] = (f32x4){0.f, 0.f, 0.f, 0.f};
    bf16x8 At[4][2], B0[2][2], B1[2][2];
    const char* cA = (const char*)gA + (size_t)cur.pm * tstepA; const char* cB = (const char*)gB + (size_t)cur.pn * tstepB;
    S.a_ready(cur);
    if constexpr (SP2) {
        PG8_STAGE(PG8_SB(0, 0), cB, voffB); PG8_STAGE(PG8_SB(0, 1), cB + hstepB, voffB); PG8_STAGE(PG8_SA(0, 0), cA, voffA); PG8_STAGE(PG8_SA(0, 1), cA + hstepA, voffA);
        if (wr == 1) PG8_BAR;
        PG8_WAIT_V(2); PG8_BAR;
        PG8_STAGE(PG8_SB(1, 0), cB + kstep, voffB); PG8_STAGE(PG8_SA(1, 0), cA + kstep, voffA); PG8_STAGE(PG8_SB(1, 1), cB + hstepB + kstep, voffB);
        PG8_WAIT_V(6); PG8_BAR;
    } else {
        PG8_STAGE(PG8_SB(0, 0), cB, voffB); PG8_STAGE(PG8_SA(0, 0), cA, voffA); PG8_STAGE(PG8_SB(0, 1), cB + hstepB, voffB); PG8_STAGE(PG8_SA(0, 1), cA + hstepA, voffA);
        if (wr == 1) PG8_BAR;
        PG8_WAIT_V(4); PG8_BAR;
        PG8_STAGE(PG8_SB(1, 0), cB + kstep, voffB); PG8_STAGE(PG8_SA(1, 0), cA + kstep, voffA); PG8_STAGE(PG8_SB(1, 1), cB + hstepB + kstep, voffB);
        PG8_WAIT_V(6); PG8_BAR;
    }
    for (;;) {
        const bool has_next = S.next(ui + 1, nxt);
        const char* nA = has_next ? (const char*)gA + (size_t)nxt.pm * tstepA : cA; const char* nB = has_next ? (const char*)gB + (size_t)nxt.pn * tstepB : cB;
        for (int t = 0; t < nt; t += 2) {
            const bool last = (t == nt - 2);
            const char* a1 = cA + (size_t)(t + 1) * kstep;
            const char* a2 = last ? nA : cA + (size_t)(t + 2) * kstep; const char* b2 = last ? nB : cB + (size_t)(t + 2) * kstep;
            const char* a3 = a2 + kstep; const char* b3 = b2 + kstep;
            if (last && has_next) S.a_ready(nxt);
            if constexpr (SP2) {
            PG8_LDB(B0, 0, 0); PG8_LDB(B1, 0, 1); PG8_SCHED; PG8_LDA(At, 0, 0); PG8_STAGE(PG8_SA(1, 1), a1 + hstepA, voffA);
            PG8_WAIT_V(8); PG8_WAIT_L(0); PG8_BAR; PG8_MMA(0, 0, At, B0); PG8_MMA(0, 1, At, B1); PG8_BAR; PG8_SCHED;
            PG8_LDA(At, 0, 1); PG8_STAGE(PG8_SB(0, 0), b2, voffB); PG8_STAGE(PG8_SB(0, 1), b2 + hstepB, voffB); PG8_STAGE(PG8_SA(0, 0), a2, voffA);
            PG8_WAIT_V(8); PG8_WAIT_L(0); PG8_BAR; PG8_MMA(1, 0, At, B0); PG8_MMA(1, 1, At, B1); PG8_BAR; PG8_SCHED;
            PG8_LDB(B0, 1, 0); PG8_LDB(B1, 1, 1); PG8_SCHED; PG8_LDA(At, 1, 0); PG8_STAGE(PG8_SA(0, 1), a2 + hstepA, voffA);
            PG8_WAIT_V(8); PG8_WAIT_L(0); PG8_BAR; PG8_MMA(0, 0, At, B0); PG8_MMA(0, 1, At, B1); PG8_BAR; PG8_SCHED;
            PG8_LDA(At, 1, 1); PG8_STAGE(PG8_SB(1, 0), b3, voffB); PG8_STAGE(PG8_SB(1, 1), b3 + hstepB, voffB); PG8_STAGE(PG8_SA(1, 0), a3, voffA);
            PG8_WAIT_V(8); PG8_WAIT_L(0); PG8_BAR; PG8_MMA(1, 0, At, B0); PG8_MMA(1, 1, At, B1); PG8_BAR; PG8_SCHED;
            } else {
            PG8_LDB(B0, 0, 0); PG8_SCHED; PG8_LDA(At, 0, 0); PG8_STAGE(PG8_SA(1, 1), a1 + hstepA, voffA);
            PG8_WAIT_L(8); PG8_BAR; PG8_WAIT_L(0); PG8_MMA(0, 0, At, B0); PG8_BAR; PG8_SCHED;
            PG8_LDB(B1, 0, 1); PG8_STAGE(PG8_SB(0, 0), b2, voffB);
            PG8_BAR; PG8_WAIT_L(0); PG8_MMA(0, 1, At, B1); PG8_BAR;
            PG8_LDA(At, 0, 1); PG8_STAGE(PG8_SA(0, 0), a2, voffA);
            PG8_BAR; PG8_WAIT_L(0); PG8_MMA(1, 0, At, B0); PG8_BAR; PG8_SCHED;
            PG8_STAGE(PG8_SB(0, 1), b2 + hstepB, voffB);
            PG8_WAIT_V(6); PG8_BAR; PG8_MMA(1, 1, At, B1); PG8_BAR;
            PG8_LDB(B0, 1, 0); PG8_SCHED; PG8_LDA(At, 1, 0); PG8_STAGE(PG8_SA(0, 1), a2 + hstepA, voffA);
            PG8_WAIT_L(8); PG8_BAR; PG8_WAIT_L(0); PG8_MMA(0, 0, At, B0); PG8_BAR; PG8_SCHED;
            PG8_LDB(B1, 1, 1); PG8_STAGE(PG8_SB(1, 0), b3, voffB);
            PG8_BAR; PG8_WAIT_L(0); PG8_MMA(0, 1, At, B1); PG8_BAR;
            PG8_LDA(At, 1, 1); PG8_STAGE(PG8_SA(1, 0), a3, voffA);
            PG8_BAR; PG8_WAIT_L(0); PG8_MMA(1, 0, At, B0); PG8_BAR; PG8_SCHED;
            PG8_STAGE(PG8_SB(1, 1), b3 + hstepB, voffB);
            PG8_WAIT_V(6); PG8_BAR; PG8_MMA(1, 1, At, B1); PG8_BAR;
            }
        }
        if constexpr (ALIGN_EPI) { if (wr == 0) PG8_BAR; }
        if constexpr (!Epi::AFTER_DRAIN) { E(acc, cur, wr, wc, fr, fq); S.done(cur); }
        if (!has_next) break;
#pragma unroll
        for (int a = 0; a < 2; ++a)
#pragma unroll
            for (int b = 0; b < 2; ++b)
#pragma unroll
                for (int m = 0; m < 4; ++m)
#pragma unroll
                    for (int n = 0; n < 2; ++n) acc[a][b][m][n] = (f32x4){0.f, 0.f, 0.f, 0.f};
        cur = nxt; cA = nA; cB = nB; ++ui;
        if constexpr (ALIGN_EPI) { if (wr == 1) PG8_BAR; }
    }
    PG8_WAIT_V(0);
    if constexpr (!ALIGN_EPI) { if (wr == 0) PG8_BAR; }
    PG8_BAR;
    if constexpr (Epi::AFTER_DRAIN) { E.fused(acc, cur, wr, wc, fr, fq, lds, wid, lane); S.done(cur); }
#undef PG8_SA
#undef PG8_SB
#undef PG8_STAGE
#undef PG8_LDA
#undef PG8_LDB
#undef PG8_MMA
#undef PG8_WAIT_V
#undef PG8_WAIT_L
#undef PG8_BAR
#undef PG8_SCHED
}
}

constexpr int NB = 8, SEQ = 4096, T = NB * SEQ, D = 1024, DEPTH = 4, NZ = 7680, NWAVES = 8;
constexpr int CIN = 7424;
constexpr size_t MiB = 1u << 20;
constexpr size_t WS_CTL = 0, WS_LORA = 1 * MiB, WS_MV = 7 * MiB, ZERO_BYTES = 9 * MiB;
constexpr size_t LORA_BYTES = 3072 * 256 * 2, MV_BYTES = 1024 * 256 * 2;
constexpr size_t WS_WIN = 10 * MiB;
constexpr size_t WS_DB = 40 * MiB, DB_SET = 62 * MiB;
constexpr size_t DB_PA = 0, DB_PBT = 2 * MiB, DB_POUT = 4 * MiB, DB_WQG = 6 * MiB, DB_KEYS = 12 * MiB, DB_GMW = 12 * MiB + 512 * 1024, DB_PLEW = 13 * MiB, DB_U = 14 * MiB, DB_V = 30 * MiB, DB_PB = 46 * MiB;
constexpr size_t WS_VF = 164 * MiB, WS_PW = 228 * MiB, WS_NX = 292 * MiB, WS_ZRKV = 420 * MiB, WS_ZL = 612 * MiB, WS_GUV = 644 * MiB, WS_SG = 772 * MiB;
constexpr size_t WS_EW = 900 * MiB, WS_AR = 964 * MiB, WS_G = 1028 * MiB, WS_WINB = 1092 * MiB, WINB_BYTES = 4 * MiB, WS_END = 1100 * MiB;
constexpr size_t WS_Q = WS_ZRKV, WS_SEL = WS_ZRKV + 128 * MiB, WS_MG = WS_AR, WS_N2 = WS_G;
constexpr size_t WIN_ZERO_OFF = WS_WIN + (size_t)3328 * 2048 * 2, WIN_ZERO_BYTES = (size_t)256 * 2048 * 2;
#ifndef ZSPLIT
#define ZSPLIT 2
#endif
constexpr int CW_BAR = 4096;
constexpr int RING_BYTES = 131072, LDSCTL_OFF = RING_BYTES, MISC_OFF = LDSCTL_OFF + 320, LDS_BYTES = 147456;

#define LAS __attribute__((address_space(3)))
#define GAS __attribute__((address_space(1)))
typedef unsigned short bf16;
typedef unsigned v4u __attribute__((ext_vector_type(4)));
typedef unsigned v2u __attribute__((ext_vector_type(2)));
typedef float f32x4 __attribute__((ext_vector_type(4)));
typedef float f32x2 __attribute__((ext_vector_type(2)));
typedef short bf16x8 __attribute__((ext_vector_type(8)));
using pg8::fsig; using pg8::fgelu; using pg8::bflo; using pg8::bfhi; using pg8::unpk8; using pg8::pk8; using pg8::cvt_pk_bf16;

#define XB_TMO      128
#define XB_XCNT(j)  (256  + 64 * (j))
#define XB_XSUB(j)  (1280 + 64 * (j))
#define XB_XGEN(j)  (2304 + 64 * (j))
#define XB_TOP      3328
#define XB_TOPGEN   3392
#define XCD_BAR_WORDS 3456
#define XB_SPIN_CAP (1u << 22)

__device__ __forceinline__ unsigned xb_ld(unsigned* p)              { return __hip_atomic_load(p, __ATOMIC_RELAXED, __HIP_MEMORY_SCOPE_AGENT); }
__device__ __forceinline__ unsigned xb_add(unsigned* p, unsigned v) { return __hip_atomic_fetch_add(p, v, __ATOMIC_RELAXED, __HIP_MEMORY_SCOPE_AGENT); }
__device__ __forceinline__ unsigned xb_xcc_id() { return (unsigned)__builtin_amdgcn_s_getreg((3 << 11) | 20) & 0xFu; }
#define XB_SPIN(cond, bar) do { unsigned _sp = 0; while (cond) { __builtin_amdgcn_s_sleep(1); \
    if ((++_sp & 255u) == 0u) { if (xb_ld(&(bar)[XB_TMO])) break; if (_sp > XB_SPIN_CAP) { atomicAdd(&(bar)[XB_TMO], 1u); break; } } } } while (0)

struct XcdBarrier { unsigned* bar; unsigned x; volatile LAS unsigned* st; };

__device__ __forceinline__ XcdBarrier xcd_barrier_post(unsigned* bar, volatile LAS unsigned* st) {
    XcdBarrier b; b.bar = bar; b.x = xb_xcc_id(); b.st = st;
    if (threadIdx.x == 0) (void)xb_add(&bar[XB_XCNT(b.x)], 1u);
    return b;
}
__device__ __forceinline__ void xcd_barrier_complete(unsigned* bar, unsigned x, unsigned& nloc, unsigned& nx) {
    const unsigned G = gridDim.x * gridDim.y * gridDim.z;
    unsigned sum, cnt, mine, sp = 0u;
    for (;;) {
        sum = 0u; cnt = 0u; mine = 0u;
#pragma unroll
        for (unsigned j = 0; j < 16; ++j) { const unsigned c = xb_ld(&bar[XB_XCNT(j)]); sum += c; cnt += (c > 0u) ? 1u : 0u; mine = (j == x) ? c : mine; }
        if (sum == G) break;
        __builtin_amdgcn_s_sleep(1);
        if ((++sp & 255u) == 0u) { if (xb_ld(&bar[XB_TMO])) break; if (sp > XB_SPIN_CAP) { atomicAdd(&bar[XB_TMO], 1u); break; } }
    }
    nloc = mine > 0u ? mine : 1u; nx = cnt > 0u ? cnt : 1u;
}
__device__ __forceinline__ int lane_id_now();
__device__ __forceinline__ void xcd_barrier(const XcdBarrier& b, const int wave0) {
    asm volatile("s_waitcnt vmcnt(0)" ::: "memory");
    __syncthreads();
    if (wave0 == 0 && lane_id_now() == 0) {
        unsigned* bar = b.bar;
        __builtin_amdgcn_s_waitcnt(0);
        unsigned nloc = b.st[0], nx = b.st[1];
        if (nloc == 0u) { xcd_barrier_complete(bar, b.x, nloc, nx); b.st[0] = nloc; b.st[1] = nx; }
        const unsigned old = xb_add(&bar[XB_XSUB(b.x)], 1u);
        const unsigned gen = old / nloc;
        if (old + 1u == (gen + 1u) * nloc) {
            __builtin_amdgcn_fence(__ATOMIC_RELEASE, "agent");
            asm volatile("s_waitcnt vmcnt(0)" ::: "memory");
            const unsigned og = xb_add(&bar[XB_TOP], 1u);
            const unsigned tg = og / nx;
            if (og + 1u == (tg + 1u) * nx) xb_add(&bar[XB_TOPGEN], 1u);
            else XB_SPIN(xb_ld(&bar[XB_TOPGEN]) == tg, bar);
            __builtin_amdgcn_fence(__ATOMIC_ACQUIRE, "agent");
            xb_add(&bar[XB_XGEN(b.x)], 1u);
            asm volatile("s_waitcnt vmcnt(0)" ::: "memory");
        } else {
            XB_SPIN(xb_ld(&bar[XB_XGEN(b.x)]) == gen, bar);
            __builtin_amdgcn_fence(__ATOMIC_ACQUIRE, "agent");
            asm volatile("s_waitcnt vmcnt(0)" ::: "memory");
        }
    }
    __syncthreads();
}

struct Args { const float* in[32]; float* out; unsigned char* ws; };
struct Frame {
    LAS unsigned char* lds;
    int tid, lane, wave, G, bx, wave0;
    GAS unsigned char* ws; float* h;
};
__device__ __forceinline__ int lane_id_now() { int l; asm volatile("v_mbcnt_lo_u32_b32 %0, -1, 0\n\tv_mbcnt_hi_u32_b32 %0, -1, %0" : "=v"(l)); return l; }
__device__ __forceinline__ void phase_ids(Frame& F) { const int l = lane_id_now(); F.lane = l; F.wave = F.wave0; F.tid = F.wave0 * 64 + l; GAS unsigned char* w = F.ws; asm volatile("" : "+s"(w)); F.ws = w; }
#define DPP_ADD(x, ctrl) ((x) + __builtin_bit_cast(float, __builtin_amdgcn_update_dpp(0, __builtin_bit_cast(int, (x)), (ctrl), 0xf, 0xf, false)))
__device__ __forceinline__ float sum8(float v) {
    v = DPP_ADD(v, 0xB1);
    v = DPP_ADD(v, 0x4E);
    v = DPP_ADD(v, 0x141);
    return v;
}
__device__ __forceinline__ float sum16(float v) { v = sum8(v); v = DPP_ADD(v, 0x140); return v; }
#define DPP_ADD_NS(x, ctrl) do { (x) = DPP_ADD((x), (ctrl)); asm("" : "+v"(x)); } while (0)
__device__ __forceinline__ float sum16_ns(float v) { DPP_ADD_NS(v, 0xB1); DPP_ADD_NS(v, 0x4E); DPP_ADD_NS(v, 0x141); DPP_ADD_NS(v, 0x140); return v; }
__device__ __forceinline__ float wave_sum(float v) {
    v = sum8(v);
    v = DPP_ADD(v, 0x140);
    const auto r = __builtin_amdgcn_permlane16_swap(__builtin_bit_cast(unsigned, v), __builtin_bit_cast(unsigned, v), false, false);
    v = __builtin_bit_cast(float, (unsigned)r[0]) + __builtin_bit_cast(float, (unsigned)r[1]);
    const auto q = __builtin_amdgcn_permlane32_swap(__builtin_bit_cast(unsigned, v), __builtin_bit_cast(unsigned, v), false, false);
    return __builtin_bit_cast(float, (unsigned)q[0]) + __builtin_bit_cast(float, (unsigned)q[1]);
}
__device__ __forceinline__ unsigned xor16_u(unsigned x, int lane) { const auto r = __builtin_amdgcn_permlane16_swap(x, x, false, false); return (lane & 16) ? (unsigned)r[0] : (unsigned)r[1]; }
__device__ __forceinline__ unsigned xor32_u(unsigned x, int lane) { const auto r = __builtin_amdgcn_permlane32_swap(x, x, false, false); return (lane & 32) ? (unsigned)r[0] : (unsigned)r[1]; }
__device__ __forceinline__ void tr_item(const float* W, int ldw, int ncols, bf16* WT, int ldt, int koff, int row_off, LAS float* scr, int item, int lane) {
    const int nblk = ncols / 32, kb = item / nblk, nb = item % nblk, k0 = 64 * kb, n0 = 32 * nb;
#pragma unroll 8
    for (int i = 0; i < 32; ++i) { const int kk = 2 * i + (lane >> 5); scr[kk * 33 + (lane & 31)] = W[(size_t)(k0 + kk) * ldw + n0 + (lane & 31)]; }
    asm volatile("s_waitcnt lgkmcnt(0)" ::: "memory");
    const int c = lane & 7;
#pragma unroll
    for (int j = 0; j < 4; ++j) { const int n = (lane >> 3) + 8 * j; const LAS float* s = scr + (8 * c) * 33 + n;
        v4u o; o.x = cvt_pk_bf16(s[0 * 33], s[1 * 33]); o.y = cvt_pk_bf16(s[2 * 33], s[3 * 33]); o.z = cvt_pk_bf16(s[4 * 33], s[5 * 33]); o.w = cvt_pk_bf16(s[6 * 33], s[7 * 33]);
        *(v4u*)(WT + (size_t)(row_off + n0 + n) * ldt + koff + k0 + 8 * c) = o; }
    asm volatile("s_waitcnt lgkmcnt(0)" ::: "memory");
}
__device__ __forceinline__ void cvt_chunk(const float* src, bf16* dst, size_t chunk, int lane) {
    const f32x4* s = (const f32x4*)(src + chunk * 512) + lane * 2; const f32x4 a = s[0], b = s[1];
    *(v4u*)(dst + chunk * 512 + lane * 8) = pk8(a, b);
}
__device__ __forceinline__ void cvt8_chunk(const float* src, unsigned char* dst, size_t chunk, int lane, float sc) {
    const f32x4* s = (const f32x4*)(src + chunk * 512) + lane * 2; const f32x4 a = s[0] * sc, b = s[1] * sc;
    int w0 = 0, w1 = 0;
    w0 = __builtin_amdgcn_cvt_pk_fp8_f32(a.x, a.y, w0, false); w0 = __builtin_amdgcn_cvt_pk_fp8_f32(a.z, a.w, w0, true);
    w1 = __builtin_amdgcn_cvt_pk_fp8_f32(b.x, b.y, w1, false); w1 = __builtin_amdgcn_cvt_pk_fp8_f32(b.z, b.w, w1, true);
    *(v2u*)(dst + chunk * 512 + lane * 8) = (v2u){(unsigned)w0, (unsigned)w1};
}
__device__ __forceinline__ void norm_row_nx(const float* hrow, float* hcopy, const float* g, bf16* NX, int t, int lane) {
    const f32x4* xr = (const f32x4*)hrow + lane; f32x4 v[4]; float s = 0.f;
#pragma unroll
    for (int j = 0; j < 4; ++j) { v[j] = xr[64 * j]; s += (v[j].x * v[j].x + v[j].y * v[j].y) + (v[j].z * v[j].z + v[j].w * v[j].w); }
    if (hcopy) {
#pragma unroll
        for (int j = 0; j < 4; ++j) ((f32x4*)hcopy)[lane + 64 * j] = v[j]; }
    const float rstd = 1.f / sqrtf(wave_sum(s) * (1.f / D) + 1e-6f);
    const int tt = t & (SEQ - 1);
#pragma unroll
    for (int j = 0; j < 4; ++j) { const f32x4 gv = ((const f32x4*)g)[lane + 64 * j]; const f32x4 o = v[j] * rstd * gv;
        v2u w; w.x = cvt_pk_bf16(o.x, o.y); w.y = cvt_pk_bf16(o.z, o.w);
        const int c = 4 * (lane + 64 * j);
        *(v2u*)(NX + (size_t)t * 2048 + c) = w;
        if (tt != SEQ - 1) *(v2u*)(NX + (size_t)(t + 1) * 2048 + 1024 + c) = w;
        if (tt == 0) *(v2u*)(NX + (size_t)t * 2048 + 1024 + c) = (v2u){0u, 0u}; }
}
__device__ __forceinline__ void norm_row_n2x2(const float* hrow0, const float* hrow1, const float* g, bf16* o0, bf16* o1, int lane) {
    const f32x4* x0 = (const f32x4*)hrow0 + lane; const f32x4* x1 = (const f32x4*)hrow1 + lane; f32x4 v[2][4]; float s0 = 0.f, s1 = 0.f;
#pragma unroll
    for (int j = 0; j < 4; ++j) { v[0][j] = x0[64 * j]; v[1][j] = x1[64 * j]; }
#pragma unroll
    for (int j = 0; j < 4; ++j) { s0 += (v[0][j].x * v[0][j].x + v[0][j].y * v[0][j].y) + (v[0][j].z * v[0][j].z + v[0][j].w * v[0][j].w);
                                  s1 += (v[1][j].x * v[1][j].x + v[1][j].y * v[1][j].y) + (v[1][j].z * v[1][j].z + v[1][j].w * v[1][j].w); }
    const float r0 = 1.f / sqrtf(wave_sum(s0) * (1.f / D) + 1e-6f), r1 = 1.f / sqrtf(wave_sum(s1) * (1.f / D) + 1e-6f);
#pragma unroll
    for (int j = 0; j < 4; ++j) { const f32x4 gv = ((const f32x4*)g)[lane + 64 * j]; const f32x4 a = v[0][j] * r0 * gv, b = v[1][j] * r1 * gv;
        *(v2u*)(o0 + 4 * (lane + 64 * j)) = (v2u){cvt_pk_bf16(a.x, a.y), cvt_pk_bf16(a.z, a.w)}; *(v2u*)(o1 + 4 * (lane + 64 * j)) = (v2u){cvt_pk_bf16(b.x, b.y), cvt_pk_bf16(b.z, b.w)}; }
}
__device__ __forceinline__ void prep_phase(Frame& F, const Args& a, int layer, int blk, int nblk_, int part) {
    phase_ids(F);
    LAS float* scr = (LAS float*)(F.lds + F.wave * 16384);
    const int gw = blk * NWAVES + F.wave, NGW = nblk_ * NWAVES, lane = F.lane;
    GAS unsigned char* ws = F.ws; GAS unsigned char* db = F.ws + WS_DB + (size_t)(layer & 1) * DB_SET;
    bf16* WIN = (bf16*)(ws + WS_WIN); bf16* LORA = (bf16*)(ws + WS_LORA + (size_t)layer * LORA_BYTES); bf16* MVT = (bf16*)(ws + WS_MV + (size_t)(layer > 0 ? layer - 1 : 0) * MV_BYTES);
    const float* w_in = a.in[5] + (size_t)layer * 2048 * CIN;
    const int mvn = layer > 0 ? 32 : 0;
    const int c1 = 32 * 104, c2a = 32 * 64, c2b = 32 * 32, c2c = 32 * (32 - 8 * ZSPLIT), c2d = 32 * 8 * ZSPLIT, c2 = c2a + 2 * c2b, c3 = mvn, c4 = 32, c5 = 32, c6 = 64, c7 = 512, c10 = 1024, c12 = 128;
    const int total = (part & 1) ? c1 + c2 + c3 + c4 + c5 + c6 + 3 * c7 + c10 + c7 + c12 : 0;
    for (int it = gw; it < total; it += NGW) {
        int r = it;
        if (r < c1) { tr_item(w_in, CIN, 3328, WIN, 2048, 0, 0, scr, r, lane); continue; } r -= c1;
        if (r < c2a) { tr_item(w_in + 3328, CIN, 2048, WIN, 2048, 0, 3584, scr, r, lane); continue; } r -= c2a;
        if (r < c2b) { tr_item(w_in + 6400, CIN, 1024, WIN, 2048, 0, 5632, scr, r, lane); continue; } r -= c2b;
        if (r < c2c) { tr_item(w_in + 5376, CIN, 1024 - 256 * ZSPLIT, WIN, 2048, 0, 6656, scr, r, lane); continue; } r -= c2c;
        if (r < c2d) { tr_item(w_in + 6400 - 256 * ZSPLIT, CIN, 256 * ZSPLIT, (bf16*)(ws + WS_WINB + (size_t)(layer & 1) * WINB_BYTES), 2048, 0, 0, scr, r, lane); continue; } r -= c2d;
        if (r < c3) { tr_item(a.in[16] + (size_t)(layer - 1) * 2048 * 32, 32, 32, WIN, 2048, 0, 3328, scr, r, lane); continue; } r -= c3;
        if (r < c4) { tr_item(a.in[7] + (size_t)layer * 64 * 1024, 1024, 1024, LORA, 128, 0, 0, scr, r, lane); continue; } r -= c4;
        if (r < c5) { tr_item(a.in[9] + (size_t)layer * 64 * 1024, 1024, 1024, LORA, 128, 64, 1024, scr, r, lane); continue; } r -= c5;
        if (r < c6) { tr_item(a.in[10] + (size_t)layer * 128 * 1024, 1024, 1024, LORA + 2048 * 128, 128, 0, 0, scr, r, lane); continue; } r -= c6;
        if (r < c7) { tr_item(a.in[23] + (size_t)layer * D * D, D, D, (bf16*)(db + DB_PA), D, 0, 0, scr, r, lane); continue; } r -= c7;
        if (r < c7) { tr_item(a.in[24] + (size_t)layer * D * D, D, D, (bf16*)(db + DB_PBT), D, 0, 0, scr, r, lane); continue; } r -= c7;
        if (r < c7) { tr_item(a.in[25] + (size_t)layer * D * D, D, D, (bf16*)(db + DB_POUT), D, 0, 0, scr, r, lane); continue; } r -= c7;
        if (r < c10) { tr_item(a.in[26] + (size_t)layer * D * 2048, 2048, 2048, (bf16*)(db + DB_WQG), D, 0, 0, scr, r, lane); continue; } r -= c10;
        if (r < c7) { tr_item(a.in[31] + (size_t)layer * D * D, D, D, (bf16*)(db + DB_WQG), D, 0, 2048, scr, r, lane); continue; } r -= c7;
        tr_item(a.in[30] + (size_t)layer * 256 * D, D, D, (bf16*)(db + DB_PLEW), 256, 0, 0, scr, r, lane);
    }
    if (layer > 0 && (part & 1)) {
        const float* w2 = a.in[17] + (size_t)(layer - 1) * 32 * 1024;
        for (int it = gw; it < 512; it += NGW) { const int e = it * 64 + lane, n = e >> 5, k = e & 31; MVT[n * 128 + k] = (bf16)(cvt_pk_bf16(w2[k * 1024 + n], 0.f) & 0xffffu); }
    }
    {
        const float* keys = a.in[27] + (size_t)layer * 262144; const float* ut = a.in[28] + (size_t)layer * 16777216; const float* vt = a.in[29] + (size_t)layer * 16777216;
        const float* pin = a.in[1] + (size_t)layer * T * 256; const float* gws = a.in[21] + (size_t)layer * 131072;
        const int n1 = (part & 1) ? 512 : 0, n2 = (part & 2) ? 32768 : 0, n4 = (part & 1) ? 16384 : 0, n5 = (part & 1) ? 256 : 0, ntot = n1 + 2 * n2 + n4 + n5;
        for (int it = gw; it < ntot; it += NGW) {
            int r = it;
            if (r < n2) { cvt8_chunk(ut, (unsigned char*)(db + DB_U), r, lane, 256.f); continue; } r -= n2;
            if (r < n2) { cvt8_chunk(vt, (unsigned char*)(db + DB_V), r, lane, 64.f); continue; } r -= n2;
            if (r < n4) { cvt_chunk(pin, (bf16*)(db + DB_PB), r, lane); continue; } r -= n4;
            if (r < n1) { cvt_chunk(keys, (bf16*)(db + DB_KEYS), r, lane); continue; } r -= n1;
            {
                const int e0 = r * 512 + lane * 8, tq = (e0 >> 7) & 127, p0 = e0 & 127;
                const f32x4* s = (const f32x4*)(gws + e0); f32x4 x0 = s[0], x1 = s[1];
#pragma unroll
                for (int j = 0; j < 4; ++j) { if (p0 + j > tq) x0[j] = 0.f; if (p0 + 4 + j > tq) x1[j] = 0.f; }
                *(v4u*)((bf16*)(db + DB_GMW) + e0) = pk8(x0, x1);
            }
        }
    }
    if (layer == 0 && (part & 1)) {
        for (int m = gw; m < T; m += NGW) norm_row_nx(a.in[0] + (size_t)m * D, F.h + (size_t)m * D, a.in[2], (bf16*)(ws + WS_NX), m, lane);
    }
}

constexpr int SC = 32, NPR = SC / 2;
constexpr int SC_VEC = SC * 64;
constexpr int SC_WW = 0, SC_VQ = NPR * 64, SC_BK = SC_VQ + NPR * 256, SC_XA = SC_BK + NPR * 128, SC_C = SC_XA + NPR * 128, SC_VP = SC_C + NPR * 20, SC_BON = SC_VP + SC * 64, SC_BUF = SC_BON + SC * 8;
static_assert(SC_BUF % 4 == 0 && SC_C % 4 == 0 && (2 * SC_BUF + 2 * SC_VEC) * 4 + 64 <= 131072, "scan LDS map");
struct ScanOps { f32x4 w[4], vq, c[4]; v4u bk[2]; bf16x8 x[2]; };
__device__ __forceinline__ void scan_load2(ScanOps& o, const LAS float* buf, const LAS float* vqp, const LAS unsigned char* bkp, int bkstep, int p, int lane) {
    const int q = lane >> 4;
    const LAS float* wp = buf + SC_WW + p * 64 + q * 4;
#pragma unroll
    for (int i = 0; i < 4; ++i) o.w[i] = *(const LAS f32x4*)(wp + 16 * i);
    o.vq = *(const LAS f32x4*)(vqp + p * 256);
    o.bk[0] = *(const LAS v4u*)(bkp + p * bkstep); o.bk[1] = *(const LAS v4u*)(bkp + p * bkstep + 16);
    const LAS unsigned char* xp = (const LAS unsigned char*)(buf + SC_XA) + p * 512 + (lane & 3) * 128 + q * 16;
    o.x[0] = *(const LAS bf16x8*)xp; o.x[1] = *(const LAS bf16x8*)(xp + 64);
#pragma unroll
    for (int i = 0; i < 4; ++i) o.c[i] = *(const LAS f32x4*)(buf + SC_C + p * 20 + 4 * i);
}
__device__ __forceinline__ const char* uni_ptr(const char* p) { const unsigned long long a = (unsigned long long)p;
    const unsigned lo = (unsigned)__builtin_amdgcn_readfirstlane((int)(unsigned)a), hi = (unsigned)__builtin_amdgcn_readfirstlane((int)(unsigned)(a >> 32));
    return (const char*)(((unsigned long long)hi << 32) | lo); }
__device__ __forceinline__ float smul(float a, float b) { float r; asm("v_mul_f32 %0, %1, %2" : "=v"(r) : "v"(a), "v"(b)); return r; }
__device__ __forceinline__ void scan_pair(const ScanOps& o, f32x4 (&St)[4], float& sa0, float& sa1, v4u (&am)[4], v4u& bm, LAS float* ypt, int ystep, unsigned m16) {
    v4u s0, s1;
    s0.x = cvt_pk_bf16(St[0].x, St[0].y); s0.y = cvt_pk_bf16(St[0].z, St[0].w); s0.z = cvt_pk_bf16(St[1].x, St[1].y); s0.w = cvt_pk_bf16(St[1].z, St[1].w);
    s1.x = cvt_pk_bf16(St[2].x, St[2].y); s1.y = cvt_pk_bf16(St[2].z, St[2].w); s1.z = cvt_pk_bf16(St[3].x, St[3].y); s1.w = cvt_pk_bf16(St[3].z, St[3].w);
    f32x4 dv = (f32x4){0.f, 0.f, 0.f, 0.f};
    dv = __builtin_amdgcn_mfma_f32_16x16x32_bf16(o.x[0], __builtin_bit_cast(bf16x8, s0), dv, 0, 0, 0);
    dv = __builtin_amdgcn_mfma_f32_16x16x32_bf16(o.x[1], __builtin_bit_cast(bf16x8, s1), dv, 0, 0, 0);
    const float v0 = o.vq.x, v1 = o.vq.y, v2 = o.vq.z;
    typedef short s16x4 __attribute__((ext_vector_type(4)));
    const v2u bm2 = (v2u){cvt_pk_bf16(sa0, v0) & m16, cvt_pk_bf16(sa1, v1) & m16};
#pragma unroll
    for (int i = 0; i < 4; ++i) { const v2u a2 = (v2u){o.bk[i >> 1][(i & 1) * 2], o.bk[i >> 1][(i & 1) * 2 + 1]};
        St[i] = __builtin_amdgcn_mfma_f32_16x16x16bf16_1k(__builtin_bit_cast(s16x4, a2), __builtin_bit_cast(s16x4, bm2),
                                                        (f32x4){smul(St[i].x, o.w[i].x), smul(St[i].y, o.w[i].y), smul(St[i].z, o.w[i].z), smul(St[i].w, o.w[i].w)}, 0, 0, 0); }
    ypt[0]     = dv.z + sa0 * o.c[2].z + v0 * o.c[2].w;
    ypt[ystep] = dv.w + sa0 * o.c[3].x + v0 * o.c[3].y + sa1 * o.c[3].z + v1 * o.c[3].w;
    const float n0 = dv.x + sa0 * o.c[0].x + v0 * o.c[0].y + sa1 * o.c[0].z + v1 * o.c[0].w;
    const float n1 = dv.y + sa0 * o.c[1].x + v0 * o.c[1].y + sa1 * o.c[1].z + v1 * o.c[1].w + n0 * o.c[2].x + v2 * o.c[2].y;
    sa0 = n0; sa1 = n1;
}
__device__ __forceinline__ void scan_unit(Frame& F, const Args& a, int layer, int unit) {
    phase_ids(F);
    const int b = unit >> 4, hh = unit & 15, tid = F.tid, lane = F.lane, wave = F.wave;
    LAS float* bufs = (LAS float*)F.lds;
    LAS float* sY = bufs + 2 * SC_BUF;
    const bf16* ZR = (const bf16*)(F.ws + WS_ZRKV); const bf16* EW = (const bf16*)(F.ws + WS_EW); const bf16* AR = (const bf16*)(F.ws + WS_AR); const bf16* GT = (const bf16*)(F.ws + WS_G);
    bf16* YA = (bf16*)(F.ws + WS_G);
    constexpr int NCH = SEQ / SC;
    if (wave < 4) {
        f32x4 St[4]; v4u am[4], bm = (v4u){0u, 0u, 0u, 0u};
#pragma unroll
        for (int i = 0; i < 4; ++i) { St[i] = (f32x4){0.f, 0.f, 0.f, 0.f}; am[i] = (v4u){0u, 0u, 0u, 0u}; }
        float sa0 = 0.f, sa1 = 0.f;
        const unsigned m16 = lane < 16 ? 0xffffffffu : 0u;
        LAS unsigned char* zblk = (LAS unsigned char*)(sY + 2 * SC_VEC);
        if (tid < 8) ((LAS unsigned*)zblk)[tid] = 0u;
        const int bkstep = lane < 16 ? 512 : 0;
        for (int it = 0; it < NCH + 2; ++it) {
            if (it >= 1 && it <= NCH) {
                const LAS float* bufc = bufs + ((it - 1) & 1) * SC_BUF;
                const LAS float* vqp = bufc + SC_VQ + 4 * (wave * 16 + (lane & 15));
                const LAS unsigned char* bkp = lane < 16 ? (const LAS unsigned char*)(bufc + SC_BK) + lane * 32 : (const LAS unsigned char*)zblk;
                LAS float* yb = lane < 16 ? sY + ((it - 1) & 1) * SC_VEC + wave * 16 + lane : (LAS float*)(zblk + 32);
                const int ystep = lane < 16 ? 64 : 0;
                if (it == 1) { sa0 = 0.f; sa1 = vqp[0] * bufc[SC_C + 16]; }
                ScanOps o0, o1;
                scan_load2(o0, bufc, vqp, bkp, bkstep, 0, lane);
#pragma unroll 1
                for (int p = 0; p < NPR; p += 2) {
                    scan_load2(o1, bufc, vqp, bkp, bkstep, p + 1, lane);
                    scan_pair(o0, St, sa0, sa1, am, bm, yb + (2 * p) * ystep, ystep, m16);
                    if (p + 2 < NPR) scan_load2(o0, bufc, vqp, bkp, bkstep, p + 2, lane);
                    scan_pair(o1, St, sa0, sa1, am, bm, yb + (2 * p + 2) * ystep, ystep, m16);
                }
            }
            __syncthreads();
        }
    } else {
        const int ht = tid - 256, tl = ht >> 3, c8 = ht & 7, ch = hh * 64 + c8 * 8;
        const int pr = ht >> 4, c4 = ht & 15, chp = hh * 64 + c4 * 4;
        const size_t po = (size_t)layer * 1024 + ch, pop = (size_t)layer * 1024 + chp;
        struct HelpIn { v2u r0, k0, v0, e0, a0, r1, k1, v1, e1, a1, k2, v2, e2, a2, k3; v4u gt; };
        HelpIn cur, nxt;
#define HELP_ROW(H, F_, RR, OFF, ARR, PITCH) (H).F_ = *(const v2u*)((ARR) + ((size_t)b * SEQ + (RR)) * (PITCH) + (OFF) + chp)
#define HELP_LOAD(H, PC, GC) do { \
            if ((PC) < NCH) { const int _t = (PC) * SC + 2 * pr; \
                HELP_ROW(H, r0, _t, 0, ZR, 3072); HELP_ROW(H, k0, _t, 1024, ZR, 3072); HELP_ROW(H, v0, _t, 2048, ZR, 3072); HELP_ROW(H, e0, _t, 0, EW, 1024); HELP_ROW(H, a0, _t, 0, AR, 1024); \
                HELP_ROW(H, r1, _t + 1, 0, ZR, 3072); HELP_ROW(H, k1, _t + 1, 1024, ZR, 3072); HELP_ROW(H, v1, _t + 1, 2048, ZR, 3072); HELP_ROW(H, e1, _t + 1, 0, EW, 1024); HELP_ROW(H, a1, _t + 1, 0, AR, 1024); \
                HELP_ROW(H, k2, _t + 2, 1024, ZR, 3072); HELP_ROW(H, v2, _t + 2, 2048, ZR, 3072); HELP_ROW(H, e2, _t + 2, 0, EW, 1024); HELP_ROW(H, a2, _t + 2, 0, AR, 1024); \
                HELP_ROW(H, k3, _t + 3, 1024, ZR, 3072); } \
            if ((GC) >= 0 && (GC) < NCH) { const size_t _row = (size_t)b * SEQ + (size_t)(GC) * SC + tl; (H).gt = *(const v4u*)(GT + _row * 1024 + ch); } } while (0)
#define UNP4(W) ((f32x4){bflo((W).x), bfhi((W).x), bflo((W).y), bfhi((W).y)})
#define EXP4(E) ((f32x4){__builtin_amdgcn_exp2f(-1.44269504f * (E).x), __builtin_amdgcn_exp2f(-1.44269504f * (E).y), __builtin_amdgcn_exp2f(-1.44269504f * (E).z), __builtin_amdgcn_exp2f(-1.44269504f * (E).w)})
#define DOT4(A, B) (((A).x * (B).x + (A).y * (B).y) + ((A).z * (B).z + (A).w * (B).w))
#define SUM16(X) sum16_ns(X)
#ifdef PROBE_SCAN
        unsigned long long ph_act = 0ull;
#endif
        HELP_LOAD(cur, 0, -2);
        for (int it = 0; it < NCH + 2; ++it) {
#ifdef PROBE_SCAN
            const unsigned long long ph0 = __builtin_amdgcn_s_memtime();
#endif
            HELP_LOAD(nxt, it + 1, it - 1);
            if (it >= 2) {
                const LAS float* buf = bufs + (it & 1) * SC_BUF; const LAS float* yb = sY + (it & 1) * SC_VEC;
                const size_t row = (size_t)b * SEQ + (size_t)(it - 2) * SC + tl; const int o = tl * 64 + c8 * 8;
                f32x4 y_[2], v_[2], g_[2];
#pragma unroll
                for (int i = 0; i < 2; ++i) { y_[i] = *(const LAS f32x4*)(yb + o + 4 * i); v_[i] = *(const LAS f32x4*)(buf + SC_VP + o + 4 * i); }
                const float bon = buf[SC_BON + tl * 8 + c8];
                unpk8(cur.gt, g_[0], g_[1]);
                const float s1 = ((y_[0].x + y_[0].y) + (y_[0].z + y_[0].w)) + ((y_[1].x + y_[1].y) + (y_[1].z + y_[1].w));
                const float mu = sum8(s1) * (1.f / 64.f);
                float s2 = 0.f;
#pragma unroll
                for (int i = 0; i < 2; ++i) { y_[i] = y_[i] - mu; const f32x4 q = y_[i] * y_[i]; s2 += (q.x + q.y) + (q.z + q.w); }
                const float rstd = __builtin_amdgcn_rsqf(sum8(s2) * (1.f / 64.f) + 64e-5f);
                f32x4 o_[2];
#pragma unroll
                for (int i = 0; i < 2; ++i) o_[i] = (y_[i] * rstd * *(const f32x4*)(a.in[14] + po + 4 * i) + *(const f32x4*)(a.in[15] + po + 4 * i) + bon * v_[i]) * g_[i];
                *(v4u*)(YA + row * 1024 + ch) = pk8(o_[0], o_[1]);
            }
            if (it < NCH) {
                LAS float* buf = bufs + (it & 1) * SC_BUF;
                const f32x4 pkk_ = *(const f32x4*)(a.in[11] + pop), pka_ = *(const f32x4*)(a.in[12] + pop), prk_ = *(const f32x4*)(a.in[13] + pop);
                const f32x4 zk0 = UNP4(cur.k0), zk1 = UNP4(cur.k1), zk2 = UNP4(cur.k2), zk3 = UNP4(cur.k3);
                f32x4 kn0 = zk0 * pkk_, kn1 = zk1 * pkk_, kn2 = zk2 * pkk_, kn3 = zk3 * pkk_;
                kn0 = kn0 * __builtin_amdgcn_rsqf(fmaxf(SUM16(DOT4(kn0, kn0)), 1e-24f)); kn1 = kn1 * __builtin_amdgcn_rsqf(fmaxf(SUM16(DOT4(kn1, kn1)), 1e-24f));
                kn2 = kn2 * __builtin_amdgcn_rsqf(fmaxf(SUM16(DOT4(kn2, kn2)), 1e-24f)); kn3 = kn3 * __builtin_amdgcn_rsqf(fmaxf(SUM16(DOT4(kn3, kn3)), 1e-24f));
                const f32x4 r0 = UNP4(cur.r0), r1 = UNP4(cur.r1), v0 = UNP4(cur.v0), v1 = UNP4(cur.v1), v2 = UNP4(cur.v2);
                const f32x4 ar0 = UNP4(cur.a0), ar1 = UNP4(cur.a1), ar2 = UNP4(cur.a2);
                const f32x4 e0 = UNP4(cur.e0), e1 = UNP4(cur.e1), e2 = UNP4(cur.e2);
                const f32x4 w0 = EXP4(e0), w1 = EXP4(e1), w2 = EXP4(e2);
                const f32x4 a1v = -kn1, a2v = -kn2, a3v = -kn3;
                const f32x4 b0 = kn0 * ar0, b1 = kn1 * ar1, b2 = kn2 * ar2;
                const f32x4 kp0 = zk0 * (1.f + (ar0 - 1.f) * pka_), kp1 = zk1 * (1.f + (ar1 - 1.f) * pka_), kp2 = zk2 * (1.f + (ar2 - 1.f) * pka_);
                const f32x4 W2 = w0 * w1, Bt = b0 * w1, Kt = kp0 * w1, x0v = a2v, x1v = w2 * a3v;
                const f32x4 X0 = W2 * x0v, X1 = W2 * x1v, X2 = w0 * r0, X3 = W2 * r1;
                *(LAS f32x4*)(buf + SC_WW + pr * 64 + c4 * 4) = W2;
                *(LAS f32x4*)(buf + SC_VP + (2 * pr) * 64 + c4 * 4) = v0; *(LAS f32x4*)(buf + SC_VP + (2 * pr + 1) * 64 + c4 * 4) = v1;
                { LAS f32x4* vq = (LAS f32x4*)(buf + SC_VQ + pr * 256 + c4 * 16);
                  vq[0] = (f32x4){v0.x, v1.x, v2.x, 0.f}; vq[1] = (f32x4){v0.y, v1.y, v2.y, 0.f}; vq[2] = (f32x4){v0.z, v1.z, v2.z, 0.f}; vq[3] = (f32x4){v0.w, v1.w, v2.w, 0.f}; }
                { LAS v2u* bkp = (LAS v2u*)(buf + SC_BK + pr * 128) + (((c4 & 3) * 4) * 4 + (c4 >> 2));
                  bkp[0] = (v2u){cvt_pk_bf16(Bt.x, Kt.x), cvt_pk_bf16(b1.x, kp1.x)}; bkp[4] = (v2u){cvt_pk_bf16(Bt.y, Kt.y), cvt_pk_bf16(b1.y, kp1.y)};
                  bkp[8] = (v2u){cvt_pk_bf16(Bt.z, Kt.z), cvt_pk_bf16(b1.z, kp1.z)}; bkp[12] = (v2u){cvt_pk_bf16(Bt.w, Kt.w), cvt_pk_bf16(b1.w, kp1.w)}; }
                { LAS unsigned char* xp = (LAS unsigned char*)(buf + SC_XA) + pr * 512 + (c4 >> 3) * 64 + (c4 & 3) * 16 + ((c4 >> 2) & 1) * 8;
                  *(LAS v2u*)xp = (v2u){cvt_pk_bf16(X0.x, X0.y), cvt_pk_bf16(X0.z, X0.w)}; *(LAS v2u*)(xp + 128) = (v2u){cvt_pk_bf16(X1.x, X1.y), cvt_pk_bf16(X1.z, X1.w)};
                  *(LAS v2u*)(xp + 256) = (v2u){cvt_pk_bf16(X2.x, X2.y), cvt_pk_bf16(X2.z, X2.w)}; *(LAS v2u*)(xp + 384) = (v2u){cvt_pk_bf16(X3.x, X3.y), cvt_pk_bf16(X3.z, X3.w)}; }
                const f32x4 ca = (f32x4){SUM16(DOT4(Bt, x0v)), SUM16(DOT4(Kt, x0v)), SUM16(DOT4(b1, x0v)), SUM16(DOT4(kp1, x0v))};
                const f32x4 cb = (f32x4){SUM16(DOT4(Bt, x1v)), SUM16(DOT4(Kt, x1v)), SUM16(DOT4(b1, x1v)), SUM16(DOT4(kp1, x1v))};
                const f32x4 cc = (f32x4){SUM16(DOT4(b2, a3v)), SUM16(DOT4(kp2, a3v)), SUM16(DOT4(b0, r0)), SUM16(DOT4(kp0, r0))};
                const f32x4 cd = (f32x4){SUM16(DOT4(Bt, r1)), SUM16(DOT4(Kt, r1)), SUM16(DOT4(b1, r1)), SUM16(DOT4(kp1, r1))};
                const float ci = SUM16(DOT4(kp0, a1v));
                const f32x4 z0 = r0 * kp0 * prk_, z1 = r1 * kp1 * prk_;
                const float bon0 = SUM16((z0.x + z0.y) + (z0.z + z0.w)), bon1 = SUM16((z1.x + z1.y) + (z1.z + z1.w));
                if (c4 == 0) { LAS f32x4* cp = (LAS f32x4*)(buf + SC_C + pr * 20); cp[0] = ca; cp[1] = cb; cp[2] = cc; cp[3] = cd; cp[4] = (f32x4){ci, 0.f, 0.f, 0.f}; }
                buf[SC_BON + (2 * pr) * 8 + (c4 >> 1)] = bon0; buf[SC_BON + (2 * pr + 1) * 8 + (c4 >> 1)] = bon1;
            }
            cur = nxt;
#ifdef PROBE_SCAN
            asm volatile("s_waitcnt vmcnt(0) lgkmcnt(0)" ::: "memory"); ph_act += __builtin_amdgcn_s_memtime() - ph0;
#endif
            __syncthreads();
        }
#ifdef PROBE_SCAN
        if (unit == 0 && layer == DEPTH - 1 && tid == 256) ((float*)(F.ws + WS_CTL))[2048 + 2] = rintf((float)ph_act / (float)(NCH + 2) * (1.f / 2000.f));
#endif
#undef HELP_LOAD
#undef HELP_ROW
#undef UNP4
#undef EXP4
#undef DOT4
#undef SUM16
    }
}

constexpr int TP = 136;
__device__ __forceinline__ void mma_128(const LAS bf16* sA, const LAS bf16* sBt, int wave, int lane, f32x4 (&acc)[4][2]) {
    const int wm = wave >> 2, wn = wave & 3, fr = lane & 15, fq = lane >> 4;
#pragma unroll
    for (int kk = 0; kk < 4; ++kk) {
        bf16x8 af[4], bf_[2];
#pragma unroll
        for (int mt = 0; mt < 4; ++mt) af[mt] = *(const LAS bf16x8*)(sA + (64 * wm + 16 * mt + fr) * TP + 32 * kk + 8 * fq);
#pragma unroll
        for (int nt = 0; nt < 2; ++nt) bf_[nt] = *(const LAS bf16x8*)(sBt + (32 * wn + 16 * nt + fr) * TP + 32 * kk + 8 * fq);
#pragma unroll
        for (int mt = 0; mt < 4; ++mt)
#pragma unroll
            for (int nt = 0; nt < 2; ++nt) acc[mt][nt] = __builtin_amdgcn_mfma_f32_16x16x32_bf16(bf_[nt], af[mt], acc[mt][nt], 0, 0, 0);
    }
}
__device__ __forceinline__ void gmlp_unit(Frame& F, const Args& a, int layer, int unit) {
    phase_ids(F);
    const size_t t0 = (size_t)unit * 128; const int tid = F.tid, lane = F.lane, wave = F.wave;
    LAS float* st = (LAS float*)F.lds; LAS bf16* sA = (LAS bf16*)(F.lds + 1024); LAS bf16* sB = (LAS bf16*)(F.lds + 1024 + 128 * TP * 2);
    bf16* GUV = (bf16*)(F.ws + WS_GUV); const bf16* GMW = (const bf16*)(F.ws + WS_DB + (size_t)(layer & 1) * DB_SET + DB_GMW);
    const float* lng = a.in[19] + (size_t)layer * 1024; const float* lnb = a.in[20] + (size_t)layer * 1024; const float* bsp = a.in[22] + (size_t)layer * 1024;
    for (int r = 0; r < 16; ++r) { const int tok = wave * 16 + r; const bf16* rowp = GUV + (t0 + tok) * 2048 + 1024;
        f32x4 x0, x1, x2, x3; unpk8(*(const v4u*)(rowp + lane * 8), x0, x1); unpk8(*(const v4u*)(rowp + 512 + lane * 8), x2, x3);
        const f32x4 sv = (x0 + x1) + (x2 + x3), qv = (x0 * x0 + x1 * x1) + (x2 * x2 + x3 * x3);
        const float s = wave_sum((sv.x + sv.y) + (sv.z + sv.w)), q = wave_sum((qv.x + qv.y) + (qv.z + qv.w));
        const float mean = s * (1.f / 1024.f), var = fmaxf(q * (1.f / 1024.f) - mean * mean, 0.f);
        if (lane == 0) { st[tok * 2] = mean; st[tok * 2 + 1] = 1.f / sqrtf(var + 1e-5f); } }
    __syncthreads();
    for (int g = 0; g < 8; ++g) {
#pragma unroll
        for (int i = 0; i < 4; ++i) { const int pc = tid + 512 * i, rr = pc >> 4, c16 = pc & 15;
            *(LAS v4u*)(sA + rr * TP + c16 * 8) = *(const v4u*)(GMW + (size_t)g * 16384 + rr * 128 + c16 * 8); }
        { const int p = tid & 127, oc0 = tid >> 7; const float mean = st[p * 2], rstd = st[p * 2 + 1];
#pragma unroll
          for (int i = 0; i < 4; ++i) { const int oc = oc0 + 4 * i, c0 = g * 128 + oc * 8;
              f32x4 x0, x1; unpk8(*(const v4u*)(GUV + (t0 + p) * 2048 + 1024 + c0), x0, x1);
              const f32x4 g0 = *(const f32x4*)(lng + c0), g1 = *(const f32x4*)(lng + c0 + 4), b0 = *(const f32x4*)(lnb + c0), b1 = *(const f32x4*)(lnb + c0 + 4);
              x0 = (x0 - mean) * rstd * g0 + b0; x1 = (x1 - mean) * rstd * g1 + b1;
              const v4u w = pk8(x0, x1);
              LAS bf16* d = sB + (oc * 8) * TP + p;
              d[0 * TP] = (bf16)(w.x & 0xffffu); d[1 * TP] = (bf16)(w.x >> 16); d[2 * TP] = (bf16)(w.y & 0xffffu); d[3 * TP] = (bf16)(w.y >> 16);
              d[4 * TP] = (bf16)(w.z & 0xffffu); d[5 * TP] = (bf16)(w.z >> 16); d[6 * TP] = (bf16)(w.w & 0xffffu); d[7 * TP] = (bf16)(w.w >> 16); } }
        __syncthreads();
        f32x4 acc[4][2];
#pragma unroll
        for (int mt = 0; mt < 4; ++mt)
#pragma unroll
            for (int nt = 0; nt < 2; ++nt) acc[mt][nt] = (f32x4){0.f, 0.f, 0.f, 0.f};
        mma_128(sA, sB, wave, lane, acc);
        { const int wm = wave >> 2, wn = wave & 3, fr = lane & 15, fq = lane >> 4;
#pragma unroll
          for (int mt = 0; mt < 4; ++mt) { const int tt = 64 * wm + 16 * mt + fr; const float bsv = bsp[g * 128 + tt];
#pragma unroll
              for (int nt = 0; nt < 2; ++nt) { const int c = g * 128 + 32 * wn + 16 * nt + 4 * fq;
                  const v2u uw = *(const v2u*)(GUV + (t0 + tt) * 2048 + c);
                  const f32x4 u4 = (f32x4){bflo(uw.x), bfhi(uw.x), bflo(uw.y), bfhi(uw.y)};
                  const f32x4 yb = u4 * (acc[mt][nt] + bsv);
                  v2u ow; ow.x = cvt_pk_bf16(yb.x, yb.y); ow.y = cvt_pk_bf16(yb.z, yb.w);
                  *(v2u*)(GUV + (t0 + tt) * 2048 + c) = ow; } } }
        __syncthreads();
    }
}

__device__ __forceinline__ unsigned fkey(float f) { const unsigned u = __builtin_bit_cast(unsigned, f); return (u & 0x80000000u) ? ~u : (u | 0x80000000u); }
__device__ __forceinline__ float kval(unsigned k, unsigned mask) { const unsigned u = k & mask; return __builtin_bit_cast(float, (u & 0x80000000u) ? (u ^ 0x80000000u) : ~u); }
__device__ __forceinline__ float swap32_add(float a, float b) { const auto r = __builtin_amdgcn_permlane32_swap(__builtin_bit_cast(unsigned, a), __builtin_bit_cast(unsigned, b), false, false);
    return __builtin_bit_cast(float, (unsigned)r[0]) + __builtin_bit_cast(float, (unsigned)r[1]); }
__device__ __forceinline__ float swap16_add(float a, float b) { const auto r = __builtin_amdgcn_permlane16_swap(__builtin_bit_cast(unsigned, a), __builtin_bit_cast(unsigned, b), false, false);
    return __builtin_bit_cast(float, (unsigned)r[0]) + __builtin_bit_cast(float, (unsigned)r[1]); }
__device__ __forceinline__ float row_sum16(float x) {
    x += __builtin_bit_cast(float, __builtin_amdgcn_update_dpp(0, __builtin_bit_cast(int, x), 0x128, 0xf, 0xf, false));
    x += __builtin_bit_cast(float, __builtin_amdgcn_update_dpp(0, __builtin_bit_cast(int, x), 0x124, 0xf, 0xf, false));
    x += __builtin_bit_cast(float, __builtin_amdgcn_update_dpp(0, __builtin_bit_cast(int, x), 0x122, 0xf, 0xf, false));
    x += __builtin_bit_cast(float, __builtin_amdgcn_update_dpp(0, __builtin_bit_cast(int, x), 0x121, 0xf, 0xf, false));
    return x; }
#define CE_DESC(a, b) do { const unsigned _h = max((a), (b)), _l = min((a), (b)); (a) = _h; (b) = _l; } while (0)
template <int OFF> __device__ __forceinline__ void bitonic_merge16(unsigned (&x)[32]) {
#pragma unroll
    for (int j = 8; j >= 1; j >>= 1)
#pragma unroll
        for (int i = 0; i < 16; ++i) { const int l = i ^ j; if (l > i) CE_DESC(x[OFF + i], x[OFF + l]); }
}
template <int OFF> __device__ __forceinline__ void bitonic_sort16(unsigned (&x)[32]) {
#pragma unroll
    for (int k = 2; k <= 16; k <<= 1)
#pragma unroll
        for (int j = k >> 1; j >= 1; j >>= 1)
#pragma unroll
            for (int i = 0; i < 16; ++i) { const int l = i ^ j; if (l > i) { if ((i & k) == 0 || k == 16) CE_DESC(x[OFF + i], x[OFF + l]); else CE_DESC(x[OFF + l], x[OFF + i]); } }
}
#ifndef REP_K
#define REP_K 1
#endif
#define TOP_INSERT(top, x) do { unsigned _x = (x); _Pragma("unroll") for (int _j = 0; _j < 16; ++_j) { const unsigned _h = max((top)[_j], _x); _x = min((top)[_j], _x); (top)[_j] = _h; } } while (0)
__device__ __forceinline__ void peer_token_end(Frame& F, const Args& a, int layer, bool last, bool final_half, size_t tok, int lane, const f32x2 (&out)[8], const f32x4 (&hpre)[4], const v4u (&gpre)[2]) {
    float* hp = F.h + tok * 1024 + 16 * lane;
    f32x4 hv[4]; float s = 0.f;
    f32x4 ge[4]; if (final_half) { unpk8(gpre[0], ge[0], ge[1]); unpk8(gpre[1], ge[2], ge[3]); } else { ge[0] = ge[1] = ge[2] = ge[3] = (f32x4){0.f, 0.f, 0.f, 0.f}; }
#pragma unroll
    for (int i = 0; i < 4; ++i) { hv[i] = hpre[i] + ge[i] + (f32x4){out[2 * i].x, out[2 * i].y, out[2 * i + 1].x, out[2 * i + 1].y};
        s += (hv[i].x * hv[i].x + hv[i].y * hv[i].y) + (hv[i].z * hv[i].z + hv[i].w * hv[i].w); }
    if (!final_half) {
#pragma unroll
        for (int i = 0; i < 4; ++i) *(f32x4*)(hp + 4 * i) = hv[i];
        return; }
    const float rstd = 1.f / sqrtf(wave_sum(s) * (1.f / D) + 1e-6f);
    const float* g = (last ? a.in[4] : a.in[2] + (size_t)(layer + 1) * 1024) + 16 * lane;
    f32x4 o[4];
#pragma unroll
    for (int i = 0; i < 4; ++i) o[i] = hv[i] * rstd * *(const f32x4*)(g + 4 * i);
    if (last) {
#ifdef PROBE_SCAN
        { const float pv = ((const float*)(F.ws + WS_CTL))[2048 + PROBE_SCAN - 1];
#pragma unroll
          for (int i = 0; i < 4; ++i) o[i] = o[i] + pv; }
#endif
#pragma unroll
        for (int i = 0; i < 4; ++i) *(f32x4*)(hp + 4 * i) = o[i];
    } else {
#pragma unroll
        for (int i = 0; i < 4; ++i) *(f32x4*)(hp + 4 * i) = hv[i];
        bf16* NX = (bf16*)(F.ws + WS_NX); const v4u w0 = pk8(o[0], o[1]), w1 = pk8(o[2], o[3]); const int tt = (int)(tok & (SEQ - 1));
        *(v4u*)(NX + tok * 2048 + 16 * lane) = w0; *(v4u*)(NX + tok * 2048 + 16 * lane + 8) = w1;
        if (tt != SEQ - 1) { *(v4u*)(NX + (tok + 1) * 2048 + 1024 + 16 * lane) = w0; *(v4u*)(NX + (tok + 1) * 2048 + 1024 + 16 * lane + 8) = w1; }
        if (tt == 0) { *(v4u*)(NX + tok * 2048 + 1024 + 16 * lane) = (v4u){0u, 0u, 0u, 0u}; *(v4u*)(NX + tok * 2048 + 1024 + 16 * lane + 8) = (v4u){0u, 0u, 0u, 0u}; }
    }
}
__device__ __forceinline__ void peer_unit(Frame& F, const Args& a, int layer, int unit, bool last) {
    phase_ids(F);
    const size_t t0 = (size_t)unit * 128; const int tid = F.tid, lane = F.lane, wave = F.wave, fr = lane & 15, fq = lane >> 4;
    LAS bf16* sKey = (LAS bf16*)F.lds;
    LAS unsigned* sLT = (LAS unsigned*)(F.lds + 2 * 128 * TP * 2) + wave * 512;
    const bf16* Q = (const bf16*)(F.ws + WS_Q); const bf16* KEYS = (const bf16*)(F.ws + WS_DB + (size_t)(layer & 1) * DB_SET + DB_KEYS); v2u* SEL = (v2u*)(F.ws + WS_SEL);
    const size_t trow = t0 + wave * 16 + fr;
    constexpr float KOFF = 32.f;
    v4u ktn[4]; bf16x8 qfn[4];
#define K_FETCH(J) do { _Pragma("unroll") for (int _i = 0; _i < 4; ++_i) { const int _pc = tid + 512 * _i, _rr = _pc >> 4, _c16 = _pc & 15; ktn[_i] = *(const v4u*)(KEYS + (size_t)(J) * 16384 + _rr * 128 + _c16 * 8); } \
        _Pragma("unroll") for (int _kk = 0; _kk < 4; ++_kk) qfn[_kk] = *(const bf16x8*)(Q + trow * 2048 + (J) * 128 + 32 * _kk + 8 * fq); } while (0)
#define K_STORE(J) do { _Pragma("unroll") for (int _i = 0; _i < 4; ++_i) { const int _pc = tid + 512 * _i, _rr = _pc >> 4, _c16 = _pc & 15; *(LAS v4u*)(sKey + ((J) & 1) * 128 * TP + _rr * TP + _c16 * 8) = ktn[_i]; } } while (0)
    for (int krep = 0; krep < REP_K; ++krep) {
    __syncthreads();
    K_FETCH(0); K_STORE(0);
    bf16x8 qf[4];
#pragma unroll
    for (int kk = 0; kk < 4; ++kk) qf[kk] = qfn[kk];
    __syncthreads();
    for (int hd = 0; hd < 8; ++hd) {
        for (int p = 0; p < 2; ++p) {
            const int jp = hd * 2 + p;
            if (jp + 1 < 16) K_FETCH(jp + 1);
            const LAS bf16* sKc = sKey + (jp & 1) * 128 * TP;
            f32x4 sc[8];
#pragma unroll
            for (int nt = 0; nt < 8; ++nt) sc[nt] = (f32x4){KOFF, KOFF, KOFF, KOFF};
#pragma unroll
            for (int kk = 0; kk < 4; ++kk)
#pragma unroll
                for (int nt = 0; nt < 8; ++nt) { const bf16x8 kf = *(const LAS bf16x8*)(sKc + (16 * nt + fr) * TP + 32 * kk + 8 * fq);
                    sc[nt] = __builtin_amdgcn_mfma_f32_16x16x32_bf16(kf, qf[kk], sc[nt], 0, 0, 0); }
            unsigned t[32];
#pragma unroll
            for (int nt = 0; nt < 8; ++nt)
#pragma unroll
                for (int rg = 0; rg < 4; ++rg) t[4 * nt + rg] = (__float_as_uint(sc[nt][rg]) & 0xFFFFFF80u) | (unsigned)(16 * nt + 4 * fq + rg);
            bitonic_sort16<0>(t); bitonic_sort16<16>(t);
#pragma unroll
            for (int j = 0; j < 16; ++j) t[j] = max(t[j], t[31 - j]);
            bitonic_merge16<0>(t);
#pragma unroll
            for (int rnd = 0; rnd < 2; ++rnd) {
#pragma unroll
                for (int j = 0; j < 16; ++j) t[16 + j] = rnd ? xor32_u(t[j], lane) : xor16_u(t[j], lane);
#pragma unroll
                for (int j = 0; j < 16; ++j) t[j] = max(t[j], t[31 - j]);
                bitonic_merge16<0>(t); }
#pragma unroll
            for (int j = 0; j < 16; ++j) sLT[fr * 32 + p * 16 + j] = t[j];
            if (jp + 1 < 16) { K_STORE(jp + 1);
#pragma unroll
                for (int kk = 0; kk < 4; ++kk) qf[kk] = qfn[kk]; }
            __syncthreads();
        }
        float v0[16], v1[16];
#pragma unroll
        for (int j = 0; j < 16; ++j) { v0[j] = __uint_as_float(sLT[fr * 32 + j] & 0xFFFFFF80u); v1[j] = __uint_as_float(sLT[fr * 32 + 16 + j] & 0xFFFFFF80u); }
        unsigned best[32];
#define CKEY(i, j) ((__float_as_uint(v0[i] + v1[j]) & 0xFFFFFF00u) | (unsigned)((i) * 16 + (j)))
#pragma unroll
        for (int j = 0; j < 16; ++j) best[j] = CKEY(0, j);
#pragma unroll
        for (int i = 1; i < 16; ++i) best[16 - i] = max(best[16 - i], CKEY(i, 0));
        bitonic_merge16<0>(best);
#pragma unroll
        for (int j = 1; j < 8; ++j) best[16 - j] = max(best[16 - j], CKEY(1, j));
        bitonic_merge16<0>(best);
#pragma unroll
        for (int i = 2; i < 8; ++i) best[17 - i] = max(best[17 - i], CKEY(i, 1));
        bitonic_merge16<0>(best);
        { unsigned r6[6] = {CKEY(2, 2), CKEY(2, 3), CKEY(2, 4), CKEY(3, 2), CKEY(3, 3), CKEY(4, 2)};
          CE_DESC(r6[0], r6[5]); CE_DESC(r6[1], r6[3]); CE_DESC(r6[2], r6[4]); CE_DESC(r6[1], r6[2]); CE_DESC(r6[3], r6[4]); CE_DESC(r6[0], r6[3]);
          CE_DESC(r6[2], r6[5]); CE_DESC(r6[0], r6[1]); CE_DESC(r6[2], r6[3]); CE_DESC(r6[4], r6[5]); CE_DESC(r6[1], r6[2]); CE_DESC(r6[3], r6[4]);
#pragma unroll
          for (int k = 0; k < 6; ++k) best[15 - k] = max(best[15 - k], r6[k]); }
        bitonic_merge16<0>(best);
#undef CKEY
        float ev[16], esum = 0.f; const float mx = __uint_as_float(best[0] & 0xFFFFFF00u);
#pragma unroll
        for (int k = 0; k < 16; ++k) { ev[k] = __builtin_amdgcn_exp2f((__uint_as_float(best[k] & 0xFFFFFF00u) - mx) * 1.44269504f); esum += ev[k]; }
        const float einv = 1.f / esum;
#pragma unroll
        for (int k = 0; k < 16; ++k) { const unsigned pos = best[k] & 255u;
            const unsigned i0 = sLT[fr * 32 + (pos >> 4)] & 127u, i1 = sLT[fr * 32 + 16 + (pos & 15u)] & 127u;
            if ((k >> 2) == fq) SEL[trow * 128 + hd * 16 + k] = (v2u){i0 * 128u + i1, __builtin_bit_cast(unsigned, ev[k] * einv)}; }
    }
    }
#undef K_FETCH
#undef K_STORE
    asm volatile("s_waitcnt vmcnt(0)" ::: "memory");
    __syncthreads();
    const bf16* N2 = (const bf16*)(F.ws + WS_N2); const unsigned char* U8 = (const unsigned char*)(F.ws + WS_DB + (size_t)(layer & 1) * DB_SET + DB_U); const unsigned char* V8 = (const unsigned char*)(F.ws + WS_DB + (size_t)(layer & 1) * DB_SET + DB_V);
    unsigned* SELW = (unsigned*)SEL;
    LAS float* sCoef = (LAS float*)F.lds + wave * 2048;
    LAS unsigned* sSort = sLT;
    const size_t tokb = t0 + wave * 16;
    unsigned cnts = 0u;
    v4u se_pf = *(const v4u*)(SELW + tokb * 256 + 4 * lane);
    for (int it = 0; it < 16; ++it) {
        const v4u se = se_pf;
        if (it < 15) se_pf = *(const v4u*)(SELW + (tokb + it + 1) * 256 + 4 * lane);
        const unsigned b0 = se.x >> 12, b1 = se.z >> 12;
        unsigned pos0 = 0u, pos1 = 0u, base = 0u, pk = 0u;
#pragma unroll
        for (unsigned k = 0; k < 4; ++k) {
            const unsigned long long m0 = __builtin_amdgcn_ballot_w64(b0 == k), m1 = __builtin_amdgcn_ballot_w64(b1 == k);
            const unsigned below = __builtin_amdgcn_mbcnt_hi((unsigned)(m0 >> 32), __builtin_amdgcn_mbcnt_lo((unsigned)m0, 0u)) + __builtin_amdgcn_mbcnt_hi((unsigned)(m1 >> 32), __builtin_amdgcn_mbcnt_lo((unsigned)m1, 0u));
            if (b0 == k) pos0 = base + below;
            if (b1 == k) pos1 = base + below + (b0 == k ? 1u : 0u);
            base += (unsigned)__builtin_popcountll(m0) + (unsigned)__builtin_popcountll(m1);
            if (k < 3) pk |= base << (8 * k);
        }
#ifdef DBG_NOSORT
        pos0 = 2 * lane; pos1 = 2 * lane + 1;
#endif
        *(LAS v2u*)(sSort + 2 * pos0) = (v2u){se.x, se.y}; *(LAS v2u*)(sSort + 2 * pos1) = (v2u){se.z, se.w};
        asm volatile("" ::: "memory");
        const v2u so0 = *(const LAS v2u*)(sSort + 4 * lane), so1 = *(const LAS v2u*)(sSort + 4 * lane + 2); const v4u so = (v4u){so0.x, so0.y, so1.x, so1.y};
        asm volatile("" ::: "memory");
#ifndef DBG_NOSTORE
        *(v4u*)(SELW + (tokb + it) * 256 + 4 * lane) = so;
#endif
        { const unsigned g0 = so0.y, g1 = so1.y; sCoef[it * 128 + 2 * lane] = __uint_as_float(g0); sCoef[it * 128 + 2 * lane + 1] = __uint_as_float(g1); }
        if (lane == it) cnts = pk;
    }
    asm volatile("s_waitcnt vmcnt(0) lgkmcnt(0)" ::: "memory");
#ifdef DBG_NOBUCKET
    cnts = 0u;
#endif
#define PL_LOAD(RB, TAB, SE, BB) do { _Pragma("unroll") for (int _q = 0; _q < 16; ++_q) { \
        const unsigned _idx = (unsigned)__builtin_amdgcn_readlane((int)((_q & 1) ? (SE).z : (SE).x), (BB) * 8 + (_q >> 1)); \
        (RB)[_q] = *(const v4u*)((TAB) + (size_t)_idx * 1024 + 16 * lane); } } while (0)
#define PL_LOAD_U(RB, SE, BB) do { const int _src = ((BB) * 8 + ((lane & 15) >> 1)) * 4; \
        const unsigned _ix = (unsigned)__builtin_amdgcn_ds_bpermute(_src, (int)(SE).x), _iz = (unsigned)__builtin_amdgcn_ds_bpermute(_src, (int)(SE).z); \
        const unsigned char* _p = U8 + (size_t)((lane & 1) ? _iz : _ix) * 1024 + 32 * (lane >> 4); \
        _Pragma("unroll") for (int _j = 0; _j < 16; ++_j) (RB)[_j] = *(const v4u*)(_p + 128 * (_j >> 1) + 16 * (_j & 1)); } while (0)
#define PL_RANGE(T, P, NP, RLO, RHI, BLO, BHI) const unsigned _pk##T = (unsigned)__builtin_amdgcn_readlane((int)cnts, (T)); \
        const int _sp##T = min((int)((((_pk##T >> 8) & 255u) + 15u) & ~15u), 128);     \
        const int RLO = (P) == 0 ? 0 : _sp##T, RHI = (P) == 0 ? _sp##T : 128; \
        const int BLO = min(RLO >> 4, 7), BHI = max((RHI + 15) >> 4, BLO + 1)
    v4u ra[16], rb[16];
#ifndef DBG_U0
#define DBG_U0 0
#define DBG_V0 0
#endif
    for (int ps = DBG_U0; ps < 2; ++ps) {
        int lt = 0, lb, lbh; { PL_RANGE(lt, ps, 2, r0, r1, b0_, b1_); lb = b0_; lbh = b1_; (void)r0; (void)r1; }
        v4u seL = *(const v4u*)(SELW + tokb * 256 + 4 * lane), seN = *(const v4u*)(SELW + (tokb + 1) * 256 + 4 * lane);
        long xlo = 0, xhi = 0; const bool dsel = ((lane >> 2) & 3) == (lane >> 4); v4u nraw0, nraw1, nnx0 = *(const v4u*)(N2 + tokb * 1024 + 16 * lane), nnx1 = *(const v4u*)(N2 + tokb * 1024 + 16 * lane + 8);
        int ct, cb, crl = 0, crh = 0, cbl = 0;
#define U_ADV() do { ++lb; if (lb >= lbh) { ++lt; if (lt < 16) { PL_RANGE(lt, ps, 2, _r0, _r1, _b0, _b1); lb = _b0; lbh = _b1; (void)_r0; (void)_r1; seL = seN; if (lt + 1 < 16) seN = *(const v4u*)(SELW + (tokb + lt + 1) * 256 + 4 * lane); } } } while (0)
#define U_COMPUTE(RB) do { \
            if (cb == cbl) { nraw0 = nnx0; nraw1 = nnx1; if (ct + 1 < 16) { nnx0 = *(const v4u*)(N2 + (tokb + ct + 1) * 1024 + 16 * lane); nnx1 = *(const v4u*)(N2 + (tokb + ct + 1) * 1024 + 16 * lane + 8); } \
                f32x4 x0, x1, x2, x3; unpk8(nraw0, x0, x1); unpk8(nraw1, x2, x3); x0 = x0 * 16.f; x1 = x1 * 16.f; x2 = x2 * 16.f; x3 = x3 * 16.f; \
                int _w0 = 0, _w1 = 0, _w2 = 0, _w3 = 0; \
                _w0 = __builtin_amdgcn_cvt_pk_fp8_f32(x0.x, x0.y, _w0, false); _w0 = __builtin_amdgcn_cvt_pk_fp8_f32(x0.z, x0.w, _w0, true); \
                _w1 = __builtin_amdgcn_cvt_pk_fp8_f32(x1.x, x1.y, _w1, false); _w1 = __builtin_amdgcn_cvt_pk_fp8_f32(x1.z, x1.w, _w1, true); \
                _w2 = __builtin_amdgcn_cvt_pk_fp8_f32(x2.x, x2.y, _w2, false); _w2 = __builtin_amdgcn_cvt_pk_fp8_f32(x2.z, x2.w, _w2, true); \
                _w3 = __builtin_amdgcn_cvt_pk_fp8_f32(x3.x, x3.y, _w3, false); _w3 = __builtin_amdgcn_cvt_pk_fp8_f32(x3.z, x3.w, _w3, true); \
                xlo = (long)(((unsigned long long)(unsigned)_w1 << 32) | (unsigned)_w0); xhi = (long)(((unsigned long long)(unsigned)_w3 << 32) | (unsigned)_w2); } \
            _Pragma("unroll") for (int _g = 0; _g < 2; ++_g) { float _p[8]; \
                _Pragma("unroll") for (int _q = 0; _q < 8; ++_q) { f32x4 _d = (f32x4){0.f, 0.f, 0.f, 0.f}; \
                    _d = __builtin_amdgcn_mfma_f32_16x16x32_fp8_fp8((long)(((unsigned long long)(RB)[8 * _g + _q].y << 32) | (RB)[8 * _g + _q].x), xlo, _d, 0, 0, 0); \
                    _d = __builtin_amdgcn_mfma_f32_16x16x32_fp8_fp8((long)(((unsigned long long)(RB)[8 * _g + _q].w << 32) | (RB)[8 * _g + _q].z), xhi, _d, 0, 0, 0); \
                    const float _sl = (lane & 2) ? ((lane & 1) ? _d.w : _d.z) : ((lane & 1) ? _d.y : _d.x); \
                    _p[_q] = dsel ? _sl : 0.f; }     \
                const float _s0 = swap32_add(_p[0], _p[4]), _s1 = swap32_add(_p[1], _p[5]), _s2 = swap32_add(_p[2], _p[6]), _s3 = swap32_add(_p[3], _p[7]); \
                float _t0 = row_sum16(swap16_add(_s0, _s2)), _t1 = row_sum16(swap16_add(_s1, _s3)); \
                _t0 = fgelu(_t0 * (1.f / 4096.f)) * (1.f / 64.f); _t1 = fgelu(_t1 * (1.f / 4096.f)) * (1.f / 64.f); \
                if ((lane & 15) == 0) { const int _r = lane >> 4, _e = cb * 16 + 8 * _g + 2 * (_r & 1) + 4 * (_r >> 1); LAS float* _c = sCoef + ct * 128 + _e; \
                    if (_e >= crl && _e < crh) _c[0] *= _t0; if (_e + 1 >= crl && _e + 1 < crh) _c[1] *= _t1; } } } while (0)
#define U_SETC() do { ct = lt; cb = lb; { PL_RANGE(ct, ps, 2, _r0, _r1, _b0, _b1); crl = _r0; crh = _r1; cbl = _b0; (void)_b1; } } while (0)
        PL_LOAD(ra, U8, seL, lb);
        U_SETC(); U_ADV();
        for (;;) {
            if (lt < 16) PL_LOAD(rb, U8, seL, lb);
            U_COMPUTE(ra);
            if (lt >= 16) break;
            U_SETC(); U_ADV();
            if (lt < 16) PL_LOAD(ra, U8, seL, lb);
            U_COMPUTE(rb);
            if (lt >= 16) break;
            U_SETC(); U_ADV();
        }
        asm volatile("s_waitcnt lgkmcnt(0)" ::: "memory");
        __syncthreads();
    }
#undef U_ADV
#undef U_COMPUTE
#undef U_SETC
    for (int ps = DBG_V0; ps < 2; ++ps) {
        int lt = 0, lb, lbh; { PL_RANGE(lt, ps, 2, r0, r1, b0_, b1_); lb = b0_; lbh = b1_; (void)r0; (void)r1; }
        v4u seL = *(const v4u*)(SELW + tokb * 256 + 4 * lane), seN = *(const v4u*)(SELW + (tokb + 1) * 256 + 4 * lane);
        f32x2 out[8]; f32x4 hpre[4], ac4[4]; v4u gpre[2] = {(v4u){0u, 0u, 0u, 0u}, (v4u){0u, 0u, 0u, 0u}}; const bf16* PWG = (const bf16*)(F.ws + WS_PW);
        const unsigned vmask = ((lane >> 4) == ((lane & 15) >> 2)) ? (0xFFu << (8 * (lane & 3))) : 0u;
        int ct, cb, crl = 0, crh = 0, cbl = 0, cbh = 0;
#define V_ADV() do { ++lb; if (lb >= lbh) { ++lt; if (lt < 16) { PL_RANGE(lt, ps, 2, _r0, _r1, _b0, _b1); lb = _b0; lbh = _b1; (void)_r0; (void)_r1; seL = seN; if (lt + 1 < 16) seN = *(const v4u*)(SELW + (tokb + lt + 1) * 256 + 4 * lane); } } } while (0)
#define V_SETC() do { ct = lt; cb = lb; { PL_RANGE(ct, ps, 2, _r0, _r1, _b0, _b1); crl = _r0; crh = _r1; cbl = _b0; cbh = _b1; } } while (0)
#ifndef REP_LV
#define REP_LV 1
#endif
#define V_COMPUTE(RB) do { \
            if (cb == cbl) { _Pragma("unroll") for (int _i = 0; _i < 4; ++_i) { ac4[_i] = (f32x4){0.f, 0.f, 0.f, 0.f}; hpre[_i] = *(const f32x4*)(F.h + (tokb + ct) * 1024 + 16 * lane + 4 * _i); } \
                if (ps == 1) { gpre[0] = *(const v4u*)(PWG + (tokb + ct) * 1024 + 16 * lane); gpre[1] = *(const v4u*)(PWG + (tokb + ct) * 1024 + 16 * lane + 8); } }     \
            _Pragma("unroll") for (int _q = 0; _q < 16; ++_q) { const int _e = cb * 16 + _q; \
                float _c = sCoef[ct * 128 + _e]; _c = (_e >= crl && _e < crh) ? _c * 2048.f : 0.f; \
                int _w = __builtin_amdgcn_cvt_pk_fp8_f32(_c, _c, 0, false); _w = __builtin_amdgcn_cvt_pk_fp8_f32(_c, _c, _w, true); const unsigned _x = (unsigned)_w & vmask; \
                const long _ae = (long)(unsigned long long)_x, _ao = (long)((unsigned long long)_x << 32); \
                const long _bl = (long)(((unsigned long long)(RB)[_q].y << 32) | (RB)[_q].x), _bh = (long)(((unsigned long long)(RB)[_q].w << 32) | (RB)[_q].z); \
                ac4[0] = __builtin_amdgcn_mfma_f32_16x16x32_fp8_fp8(_ae, _bl, ac4[0], 0, 0, 0); ac4[1] = __builtin_amdgcn_mfma_f32_16x16x32_fp8_fp8(_ao, _bl, ac4[1], 0, 0, 0); \
                ac4[2] = __builtin_amdgcn_mfma_f32_16x16x32_fp8_fp8(_ae, _bh, ac4[2], 0, 0, 0); ac4[3] = __builtin_amdgcn_mfma_f32_16x16x32_fp8_fp8(_ao, _bh, ac4[3], 0, 0, 0); } \
            if (cb == cbh - 1) { _Pragma("unroll") for (int _i = 0; _i < 4; ++_i) { out[2 * _i] = (f32x2){ac4[_i].x, ac4[_i].y} * (1.f / 2048.f); out[2 * _i + 1] = (f32x2){ac4[_i].z, ac4[_i].w} * (1.f / 2048.f); } \
                peer_token_end(F, a, layer, last, ps == 1, tokb + ct, lane, out, hpre, gpre); } } while (0)
        PL_LOAD(ra, V8, seL, lb);
        V_SETC(); V_ADV();
        for (;;) {
            if (lt < 16) PL_LOAD(rb, V8, seL, lb);
            V_COMPUTE(ra);
            if (lt >= 16) break;
            V_SETC(); V_ADV();
            if (lt < 16) PL_LOAD(ra, V8, seL, lb);
            V_COMPUTE(rb);
            if (lt >= 16) break;
            V_SETC(); V_ADV();
        }
        asm volatile("s_waitcnt vmcnt(0)" ::: "memory");
        __syncthreads();
    }
#undef V_ADV
#undef V_SETC
#undef V_COMPUTE
#undef PL_LOAD
#undef PL_RANGE
}


#ifndef ZSKIP
#define ZSKIP 0
#endif
#ifndef ZGA_ALIGN
#define ZGA_ALIGN true
#endif
#ifndef ZGA_SP2
#define ZGA_SP2 true
#endif
#ifndef WIN_ALIGN
#define WIN_ALIGN true
#endif
#ifndef WIN_SP2
#define WIN_SP2 true
#endif
#ifndef REP_E
#define REP_E 1
#endif
#ifndef REP_A
#define REP_A 1
#endif
#ifndef REP_B
#define REP_B 1
#endif
#ifndef REP_C
#define REP_C 1
#endif
#ifndef REP_D
#define REP_D 1
#endif
#ifndef REP_G
#define REP_G 1
#endif
#ifndef REP_I
#define REP_I 1
#endif
#ifndef REP_K
#define REP_K 1
#endif
__global__ void __launch_bounds__(NWAVES * 64, 2) trunk_fwd(Args args) {
    extern __shared__ __attribute__((aligned(16))) unsigned char lds[];
    Frame F;
    F.lds = (LAS unsigned char*)lds;
    F.tid = threadIdx.x; F.lane = F.tid & 63; F.wave = __builtin_amdgcn_readfirstlane(F.tid >> 6); F.wave0 = F.wave;
    F.G = gridDim.x; F.bx = blockIdx.x; F.ws = (GAS unsigned char*)args.ws; F.h = args.out;
    volatile LAS unsigned* MISC = (volatile LAS unsigned*)(F.lds + MISC_OFF);
    for (int u = F.tid; u < (LDS_BYTES - LDSCTL_OFF) / 4; u += NWAVES * 64) ((LAS unsigned*)(F.lds + LDSCTL_OFF))[u] = 0u;
    __syncthreads();
    unsigned* ctl = (unsigned*)(F.ws + WS_CTL);
    XcdBarrier bar = xcd_barrier_post(ctl + CW_BAR, MISC + 8);
    GAS unsigned char* ws = F.ws;
    LAS unsigned char* ring = (LAS unsigned char*)F.lds;

    for (int rep = 0; rep < REP_A; ++rep) { prep_phase(F, args, 0, F.bx, F.G, 1);
    xcd_barrier(bar, F.wave0); }
#define OPQ() GAS unsigned char* ws = F.ws; asm volatile("" : "+s"(ws)); GAS unsigned char* db = ws + WS_DB + (size_t)(layer & 1) * DB_SET; (void)db
    for (int layer = 0; layer < DEPTH; ++layer) {
        {   OPQ();
        for (int rep = 0; rep < REP_B; ++rep) {   if (rep) xcd_barrier(bar, F.wave0); pg8::Gemm g{(const bf16*)(ws + WS_NX), (const bf16*)(ws + WS_WIN), T, NZ - 256 * ZSPLIT, 2048, 2048}; pg8::StaticOrder S; S.init(T, NZ - 256 * ZSPLIT, F.G, F.bx);
            pg8::EpiZ E{(bf16*)(ws + WS_ZRKV), (bf16*)(ws + WS_ZL), (bf16*)(ws + WS_GUV), (bf16*)(ws + WS_SG), layer == 0 ? (bf16*)(ws + WS_VF) : (bf16*)nullptr, 0};
            pg8::gemm_phase<pg8::EpiZ, pg8::StaticOrder, WIN_ALIGN, WIN_SP2>(ring, g, S, E, F.wave0); }
        }
        xcd_barrier(bar, F.wave0);
        {   OPQ();
        for (int rep = 0; rep < REP_C; ++rep) {   if (rep) xcd_barrier(bar, F.wave0); { pg8::Gemm g{(const bf16*)(ws + WS_ZL), (const bf16*)(ws + WS_LORA + (size_t)layer * LORA_BYTES), T, 2048, 128, 512}; pg8::StaticOrder S; S.init(T, 2048, F.G, F.bx);
            pg8::EpiLora E{(bf16*)(ws + WS_EW), (size_t)(WS_AR - WS_EW) / 2, args.in[6] + (size_t)layer * 1024, args.in[8] + (size_t)layer * 1024, 0};
            pg8::gemm_phase<pg8::EpiLora, pg8::StaticOrder, true, true>(ring, g, S, E, F.wave0); }
            { pg8::Gemm g{(const bf16*)(ws + WS_ZL) + 128, (const bf16*)(ws + WS_LORA + (size_t)layer * LORA_BYTES) + 2048 * 128, T, 1024, 128, 512}; pg8::StaticOrder S; S.init(T, 1024, F.G, F.bx);
            pg8::EpiLora E{(bf16*)(ws + WS_EW), (size_t)(WS_AR - WS_EW) / 2, args.in[6] + (size_t)layer * 1024, args.in[8] + (size_t)layer * 1024, 8};
            pg8::gemm_phase<pg8::EpiLora, pg8::StaticOrder, true, true>(ring, g, S, E, F.wave0); } }
        if (layer > 0) {
            pg8::Gemm g{(const bf16*)(ws + WS_ZL) + 256, (const bf16*)(ws + WS_MV + (size_t)(layer - 1) * MV_BYTES), T, 1024, 128, 512}; pg8::StaticOrder S; S.init(T, 1024, F.G, F.bx);
            pg8::EpiMv E{(bf16*)(ws + WS_ZRKV), (const bf16*)(ws + WS_VF), args.in[18] + (size_t)(layer - 1) * 1024};
            pg8::gemm_phase<pg8::EpiMv, pg8::StaticOrder, true, true>(ring, g, S, E, F.wave0); }
        }
        xcd_barrier(bar, F.wave0);
        {   OPQ();
        for (int rep = 0; rep < REP_D; ++rep) {   if (rep) xcd_barrier(bar, F.wave0); const int nsb = F.G / 2, nob = F.G - nsb;
            if (F.bx < nsb) { for (int u = F.bx; u < NB * 16; u += nsb) scan_unit(F, args, layer, u); }
            else { const int ob = F.bx - nsb;
                for (int pm = ob; pm < T / 256; pm += nob)
                    for (int rep2 = 0; rep2 < REP_E; ++rep2) { gmlp_unit(F, args, layer, 2 * pm); gmlp_unit(F, args, layer, 2 * pm + 1); }
                asm volatile("s_waitcnt vmcnt(0)" ::: "memory"); __syncthreads();
                {
                    pg8::Gemm g{(const bf16*)(ws + WS_GUV), (const bf16*)(db + DB_PBT), T, 1024, 1024, 2048}; pg8::PanelOrder S{ob, nob, T / 256, 4, 0};
                    pg8::EpiMerge<false> E{(const bf16*)(ws + WS_SG), (bf16*)(ws + WS_GUV) + 1024, (bf16*)nullptr};
                    pg8::gemm_phase<pg8::EpiMerge<false>, pg8::PanelOrder, true, true>(ring, g, S, E, F.wave0); }
                {
                    pg8::Gemm g{(const bf16*)(ws + WS_NX), (const bf16*)(ws + WS_WINB + (size_t)(layer & 1) * WINB_BYTES), T, 256 * ZSPLIT, 2048, 2048}; pg8::StaticOrder S; S.init(T, 256 * ZSPLIT, nob, ob);
                    pg8::EpiZ E{(bf16*)(ws + WS_ZRKV), (bf16*)(ws + WS_ZL), (bf16*)(ws + WS_GUV), (bf16*)(ws + WS_SG), (bf16*)nullptr, 30 - ZSPLIT};
                    pg8::gemm_phase<pg8::EpiZ, pg8::StaticOrder, true, true>(ring, g, S, E, F.wave0); }
                {   pg8::Gemm g{(const bf16*)(db + DB_PB), (const bf16*)(db + DB_PLEW), T, 1024, 256, 256}; pg8::StaticOrder S; S.init(T, 1024, nob, ob);
                    pg8::EpiPlain E{(bf16*)(ws + WS_PW), 1024};
                    pg8::gemm_phase<pg8::EpiPlain, pg8::StaticOrder, true, true>(ring, g, S, E, F.wave0); }
                if (layer == 0) prep_phase(F, args, 0, ob, nob, 2);
                if (layer + 1 < DEPTH) prep_phase(F, args, layer + 1, ob, nob, 3); } }
        }
        xcd_barrier(bar, F.wave0);
        {   OPQ();
        for (int rep = 0; rep < REP_G; ++rep) {   if (rep) xcd_barrier(bar, F.wave0); pg8::Gemm g{(const bf16*)(ws + WS_G), (const bf16*)(db + DB_PA), T, 1024, 1024, 1024}; pg8::StaticOrder S; S.init(T, 1024, F.G, F.bx);
            pg8::EpiMerge<true> E{(const bf16*)(ws + WS_SG), (bf16*)(ws + WS_GUV) + 1024, (bf16*)(ws + WS_MG)};
            pg8::gemm_phase<pg8::EpiMerge<true>, pg8::StaticOrder, true, true>(ring, g, S, E, F.wave0); }
        }
        xcd_barrier(bar, F.wave0);
        {   OPQ();
        {   pg8::Gemm g{(const bf16*)(ws + WS_MG), (const bf16*)(db + DB_POUT), T, 1024, 1024, 1024}; pg8::StaticOrder S; S.init(T, 1024, F.G, F.bx);
            pg8::EpiResid E{F.h};
            pg8::gemm_phase<pg8::EpiResid, pg8::StaticOrder, true, true>(ring, g, S, E, F.wave0); }
        }
        xcd_barrier(bar, F.wave0);
        {   OPQ();
        for (int rep = 0; rep < REP_I; ++rep) {   if (rep) xcd_barrier(bar, F.wave0); phase_ids(F); const int gw = F.bx * NWAVES + F.wave, NGW = F.G * NWAVES; const float* g2 = args.in[3] + (size_t)layer * 1024;
            for (int m = gw; m < T / 2; m += NGW) norm_row_n2x2(F.h + (size_t)m * D, F.h + (size_t)(m + T / 2) * D, g2, (bf16*)(ws + WS_N2) + (size_t)m * D, (bf16*)(ws + WS_N2) + (size_t)(m + T / 2) * D, F.lane); }
        }
        xcd_barrier(bar, F.wave0);
        {   OPQ();
        {   pg8::Gemm g{(const bf16*)(ws + WS_N2), (const bf16*)(db + DB_WQG), T, 3072, 1024, 1024}; pg8::StaticOrder S; S.init(T, 3072, F.G, F.bx);
            pg8::EpiQG E{(bf16*)(ws + WS_Q), (bf16*)(ws + WS_PW), F.h};
            pg8::gemm_phase<pg8::EpiQG, pg8::StaticOrder, true, true>(ring, g, S, E, F.wave0); }
        }
        xcd_barrier(bar, F.wave0);
        {   OPQ();
        for (int u = F.bx; u < T / 128; u += F.G) peer_unit(F, args, layer, u, layer == DEPTH - 1);
        }
        if (layer + 1 < DEPTH) xcd_barrier(bar, F.wave0);
    }
}

extern "C" void kernel_launch(void* const* d_in, const int* in_sizes, int n_in, void* d_out, int out_size, void* d_ws, size_t ws_size, hipStream_t stream) {
    static int grid = 0;
    if (grid == 0) {
        if (n_in != 32 || out_size != T * D || ws_size < WS_END) { fprintf(stderr, "kernel_launch: unexpected sizes n_in %d out %d ws %zu (need %zu); nothing launched\n", n_in, out_size, ws_size, (size_t)WS_END); grid = -1; return; }
        int dev = 0, cus = 0, per_cu = 0;
        if (hipGetDevice(&dev) != hipSuccess || hipDeviceGetAttribute(&cus, hipDeviceAttributeMultiprocessorCount, dev) != hipSuccess) { grid = -1; return; }
        if (hipFuncSetAttribute((const void*)trunk_fwd, hipFuncAttributeMaxDynamicSharedMemorySize, LDS_BYTES) != hipSuccess) { fprintf(stderr, "kernel_launch: hipFuncSetAttribute failed\n"); grid = -1; return; }
        if (hipOccupancyMaxActiveBlocksPerMultiprocessor(&per_cu, (const void*)trunk_fwd, NWAVES * 64, LDS_BYTES) != hipSuccess || per_cu < 1)
            fprintf(stderr, "kernel_launch: note: occupancy query reports %d workgroups per CU\n", per_cu);
        (void)hipGetLastError();
        grid = cus;
    }
    if (grid < 0) return;
    (void)hipMemsetAsync((char*)d_ws + WS_CTL, 0, ZERO_BYTES, stream);
    (void)hipMemsetAsync((char*)d_ws + WIN_ZERO_OFF, 0, WIN_ZERO_BYTES, stream);
    Args a{};
    for (int i = 0; i < 32; ++i) a.in[i] = (const float*)d_in[i];
    a.out = (float*)d_out; a.ws = (unsigned char*)d_ws;
    hipLaunchKernelGGL(trunk_fwd, dim3(grid), dim3(NWAVES * 64), LDS_BYTES, stream, a);
    const hipError_t le = hipPeekAtLastError();
    if (le != hipSuccess) fprintf(stderr, "kernel_launch: launch failed: %s\n", hipGetErrorName(le));
}
```

```cpp
#include <hip/hip_runtime.h>
#include <cstdio>
#include <cstdint>
#define ZSPLIT 4
namespace pg8 {
#define PG8_LAS __attribute__((address_space(3)))
typedef unsigned short bf16_t;
typedef short bf16x8 __attribute__((ext_vector_type(8)));
typedef float f32x4 __attribute__((ext_vector_type(4)));
typedef unsigned u32x4 __attribute__((ext_vector_type(4)));
constexpr int BM = 256, BK = 64, HALF = 128, HTB = HALF * BK * 2  , STAGE_BYTES = 8 * HTB, NXCD = 8, WGM = 8;

__host__ __device__ __forceinline__ int lds_byte(int r, int c) { const int st = (r >> 4) * 2 + (c >> 5), rr = r & 15, cc = c & 31, ob = rr * 64 + cc * 2; return st * 1024 + (ob ^ (((ob >> 9) & 1) << 5)); }
__host__ __device__ __forceinline__ void stage_rc(int b, int& R, int& C) { const int st = b / 1024, sb = b % 1024, swz = sb ^ (((sb >> 9) & 1) << 5); R = (st >> 1) * 16 + swz / 64; C = (st & 1) * 32 + (swz % 64) / 2; }
__host__ __device__ __forceinline__ int perm32(int rho) { const int n = rho >> 4, i = rho & 15; return 8 * (i >> 2) + 4 * n + (i & 3); }

struct Unit { int pm, pn; };
struct Gemm { const bf16_t* A; const bf16_t* Bt; int M, N, K, lda; };

struct StaticOrder {
    int nM, nN, nwg, G, c;
    __host__ __device__ void init(int M, int N, int G_, int c_) { nM = M / BM; nN = N / BM; nwg = nM * nN; G = G_; c = c_; }
    __host__ __device__ bool next(int i, Unit& u) const {
        const long L = (long)i * G + c; if (L >= nwg) return false;
        int wgid = (int)L; { const int q = nwg / NXCD, r = nwg % NXCD, xcd = wgid % NXCD, off = wgid / NXCD; wgid = (xcd < r ? xcd * (q + 1) : r * (q + 1) + (xcd - r) * q) + off; }
        const int nig = WGM * nN, gid = wgid / nig, fm = gid * WGM, gsz = (nM - fm) < WGM ? (nM - fm) : WGM;
        u.pm = fm + ((wgid % nig) % gsz); u.pn = (wgid % nig) / gsz; return true;
    }
    __device__ __forceinline__ void a_ready(const Unit&) const {}
    __device__ __forceinline__ void done(const Unit&) const {}
};
struct PanelOrder {
    int first, stride, nM, nN, pn0;
    __host__ __device__ bool next(int i, Unit& u) const { const int p = first + (i / nN) * stride; if (p >= nM) return false; u.pm = p; u.pn = pn0 + i % nN; return true; }
    __device__ __forceinline__ void a_ready(const Unit&) const {}
    __device__ __forceinline__ void done(const Unit&) const {}
};
__device__ __forceinline__ unsigned cvt_pk_bf16(float lo, float hi) { unsigned r; asm volatile("v_cvt_pk_bf16_f32 %0, %1, %2" : "=v"(r) : "v"(lo), "v"(hi)); return r; }

__device__ __forceinline__ float fsig(float x) { return __builtin_amdgcn_rcpf(1.f + __builtin_amdgcn_exp2f(-1.44269504f * x)); }
__device__ __forceinline__ float fgelu(float x) { return x * fsig(1.5957691216f * (x + 0.044715f * x * x * x)); }
__device__ __forceinline__ float bflo(unsigned w) { return __builtin_bit_cast(float, w << 16); }
__device__ __forceinline__ float bfhi(unsigned w) { return __builtin_bit_cast(float, w & 0xffff0000u); }
__device__ __forceinline__ void unpk8(const u32x4 w, f32x4& a, f32x4& b) { a = (f32x4){bflo(w.x), bfhi(w.x), bflo(w.y), bfhi(w.y)}; b = (f32x4){bflo(w.z), bfhi(w.z), bflo(w.w), bfhi(w.w)}; }
__device__ __forceinline__ u32x4 pk8(const f32x4 a, const f32x4 b) { u32x4 w; w.x = cvt_pk_bf16(a[0], a[1]); w.y = cvt_pk_bf16(a[2], a[3]); w.z = cvt_pk_bf16(b[0], b[1]); w.w = cvt_pk_bf16(b[2], b[3]); return w; }
__device__ __forceinline__ f32x4 act4(f32x4 v, int kind) {
    if (kind == 1) { v = (f32x4){fgelu(v[0]), fgelu(v[1]), fgelu(v[2]), fgelu(v[3])}; }
    else if (kind == 2) { v = (f32x4){fsig(v[0]), fsig(v[1]), fsig(v[2]), fsig(v[3])}; }
    else if (kind == 3) { v = (f32x4){2.f * fsig(2.f * v[0]) - 1.f, 2.f * fsig(2.f * v[1]) - 1.f, 2.f * fsig(2.f * v[2]) - 1.f, 2.f * fsig(2.f * v[3]) - 1.f}; }
    return v;
}
#define EPI_ROWS_BEGIN _Pragma("unroll") for (int ai = 0; ai < 2; ++ai) _Pragma("unroll") for (int m = 0; m < 4; ++m) { const size_t row = (size_t)(row0 + ai * HALF + m * 16);
#define EPI_ROWS_END }

struct EpiZ {
    static constexpr bool PERM = true, AFTER_DRAIN = false;
    bf16_t *zrkv, *zl, *guv, *sg, *vf; int pnoff;
    __device__ __forceinline__ void operator()(const f32x4 (&acc)[2][2][4][2], const Unit& u, int wr, int wc, int fr, int fq) const {
        const int pn = u.pn + pnoff, row0 = u.pm * BM + wr * 64 + fr;
        bf16_t* dst; int ld, colt, k0, k1;
        if (pn < 12)       { dst = zrkv; ld = 3072; colt = pn * 256;        k0 = 0; k1 = 0; }
        else if (pn == 12) { dst = zl;   ld = 512;  colt = 0;               k0 = (wc < 2) ? 3 : 0; k1 = 2; }
        else if (pn == 13) { dst = zl;   ld = 512;  colt = 256;             k0 = 0; k1 = 0; }
        else if (pn < 22)  { dst = guv;  ld = 2048; colt = (pn - 14) * 256; k0 = 1; k1 = 1; }
        else               { dst = sg;   ld = 2048; colt = ((pn - 18) & 7) * 256; k0 = 2; k1 = 2; }
        const int col0 = colt + wc * 32 + 8 * fq;
        const bool dovf = (vf != nullptr) && pn >= 8 && pn < 12;
        const int vcol0 = (pn - 8) * 256 + wc * 32 + 8 * fq;
        EPI_ROWS_BEGIN
            bf16_t* rowp = dst + row * ld + col0;
#pragma unroll
            for (int bj = 0; bj < 2; ++bj) { const int kind = bj ? k1 : k0;
                const u32x4 w = pk8(act4(acc[ai][bj][m][0], kind), act4(acc[ai][bj][m][1], kind));
                *(u32x4*)(rowp + bj * HALF) = w;
                if (dovf) *(u32x4*)(vf + row * 1024 + vcol0 + bj * HALF) = w; }
        EPI_ROWS_END
    }
};
struct EpiLora {
    static constexpr bool PERM = true, AFTER_DRAIN = false;
    bf16_t* ew; size_t stride; const float *w0, *a0; int pnoff;
    __device__ __forceinline__ void operator()(const f32x4 (&acc)[2][2][4][2], const Unit& u, int wr, int wc, int fr, int fq) const {
        const int pn = u.pn + pnoff, sel = pn >> 2, row0 = u.pm * BM + wr * 64 + fr, col0 = (pn & 3) * 256 + wc * 32 + 8 * fq;
        bf16_t* dst = ew + (size_t)sel * stride;
        const float* bp = sel == 0 ? w0 : a0;
        f32x4 bv[2][2];
#pragma unroll
        for (int bj = 0; bj < 2; ++bj)
#pragma unroll
            for (int n = 0; n < 2; ++n) bv[bj][n] = (sel < 2) ? *(const f32x4*)(bp + col0 + bj * HALF + 4 * n) : (f32x4){0.f, 0.f, 0.f, 0.f};
        EPI_ROWS_BEGIN
            bf16_t* rowp = dst + row * 1024 + col0;
#pragma unroll
            for (int bj = 0; bj < 2; ++bj) { f32x4 v0 = acc[ai][bj][m][0] + bv[bj][0], v1 = acc[ai][bj][m][1] + bv[bj][1];
                if (sel < 2) { v0 = act4(v0, 2); v1 = act4(v1, 2); }
                if (sel == 0) { v0 = v0 * 0.60653066f; v1 = v1 * 0.60653066f; }
                *(u32x4*)(rowp + bj * HALF) = pk8(v0, v1); }
        EPI_ROWS_END
    }
};
struct EpiMv {
    static constexpr bool PERM = true, AFTER_DRAIN = false;
    bf16_t* zrkv; const bf16_t* vf; const float* v0b;
    __device__ __forceinline__ void operator()(const f32x4 (&acc)[2][2][4][2], const Unit& u, int wr, int wc, int fr, int fq) const {
        const int row0 = u.pm * BM + wr * 64 + fr, col0 = u.pn * 256 + wc * 32 + 8 * fq;
        f32x4 bv[2][2];
#pragma unroll
        for (int bj = 0; bj < 2; ++bj)
#pragma unroll
            for (int n = 0; n < 2; ++n) bv[bj][n] = *(const f32x4*)(v0b + col0 + bj * HALF + 4 * n);
        EPI_ROWS_BEGIN
#pragma unroll
            for (int bj = 0; bj < 2; ++bj) { bf16_t* zp = zrkv + row * 3072 + 2048 + col0 + bj * HALF;
                f32x4 z0, z1, f0, f1; unpk8(*(const u32x4*)zp, z0, z1); unpk8(*(const u32x4*)(vf + row * 1024 + col0 + bj * HALF), f0, f1);
                const f32x4 m0 = act4(acc[ai][bj][m][0] + bv[bj][0], 2), m1 = act4(acc[ai][bj][m][1] + bv[bj][1], 2);
                *(u32x4*)zp = pk8(z0 + (f0 - z0) * m0, z1 + (f1 - z1) * m1); }
        EPI_ROWS_END
    }
};
struct EpiPlain {
    static constexpr bool PERM = true, AFTER_DRAIN = false;
    bf16_t* o; int ld;
    __device__ __forceinline__ void operator()(const f32x4 (&acc)[2][2][4][2], const Unit& u, int wr, int wc, int fr, int fq) const {
        const int row0 = u.pm * BM + wr * 64 + fr, col0 = u.pn * 256 + wc * 32 + 8 * fq;
        EPI_ROWS_BEGIN
#pragma unroll
            for (int bj = 0; bj < 2; ++bj) *(u32x4*)(o + row * ld + col0 + bj * HALF) = pk8(acc[ai][bj][m][0], acc[ai][bj][m][1]);
        EPI_ROWS_END
    }
};
template <bool SECOND> struct EpiMerge {
    static constexpr bool PERM = true, AFTER_DRAIN = false;
    const bf16_t* sg; bf16_t* m2; bf16_t* o;
    __device__ __forceinline__ void operator()(const f32x4 (&acc)[2][2][4][2], const Unit& u, int wr, int wc, int fr, int fq) const {
        const int row0 = u.pm * BM + wr * 64 + fr, col0 = u.pn * 256 + wc * 32 + 8 * fq;
#pragma unroll
        for (int ai = 0; ai < 2; ++ai) { u32x4 gv[4][2], pv[4][2];
#pragma unroll
            for (int m = 0; m < 4; ++m) { const size_t row = (size_t)(row0 + ai * HALF + m * 16);
#pragma unroll
                for (int bj = 0; bj < 2; ++bj) { const int c = col0 + bj * HALF; gv[m][bj] = *(const u32x4*)(sg + row * 2048 + (SECOND ? 0 : 1024) + c);
                    if (SECOND) pv[m][bj] = *(const u32x4*)(m2 + row * 2048 + c); } }
#pragma unroll
            for (int m = 0; m < 4; ++m) { const size_t row = (size_t)(row0 + ai * HALF + m * 16);
#pragma unroll
                for (int bj = 0; bj < 2; ++bj) { const int c = col0 + bj * HALF;
                    f32x4 g0, g1; unpk8(gv[m][bj], g0, g1);
                    f32x4 v0 = g0 * acc[ai][bj][m][0], v1 = g1 * acc[ai][bj][m][1];
                    if (SECOND) { f32x4 p0, p1; unpk8(pv[m][bj], p0, p1); v0 = v0 + p0; v1 = v1 + p1; *(u32x4*)(o + row * 1024 + c) = pk8(v0, v1); }
                    else *(u32x4*)(m2 + row * 2048 + c) = pk8(v0, v1); } } }
    }
};
struct EpiResid {
    static constexpr bool PERM = false, AFTER_DRAIN = false;
    float* h;
    __device__ __forceinline__ void operator()(const f32x4 (&acc)[2][2][4][2], const Unit& u, int wr, int wc, int fr, int fq) const {
        const int row0 = u.pm * BM + wr * 64 + fr, col0 = u.pn * 256 + wc * 32 + 4 * fq;
#pragma unroll
        for (int ai = 0; ai < 2; ++ai) { f32x4 hv[4][2][2];
#pragma unroll
            for (int m = 0; m < 4; ++m) { const float* rowp = h + (size_t)(row0 + ai * HALF + m * 16) * 1024 + col0;
#pragma unroll
                for (int bj = 0; bj < 2; ++bj)
#pragma unroll
                    for (int n = 0; n < 2; ++n) hv[m][bj][n] = *(const f32x4*)(rowp + bj * HALF + n * 16); }
#pragma unroll
            for (int m = 0; m < 4; ++m) { float* rowp = h + (size_t)(row0 + ai * HALF + m * 16) * 1024 + col0;
#pragma unroll
                for (int bj = 0; bj < 2; ++bj)
#pragma unroll
                    for (int n = 0; n < 2; ++n) *(f32x4*)(rowp + bj * HALF + n * 16) = hv[m][bj][n] + acc[ai][bj][m][n]; } }
    }
};
struct EpiQG {
    static constexpr bool PERM = true, AFTER_DRAIN = false;
    bf16_t* q; bf16_t* pw; float* h;
    __device__ __forceinline__ void operator()(const f32x4 (&acc)[2][2][4][2], const Unit& u, int wr, int wc, int fr, int fq) const {
        const int row0 = u.pm * BM + wr * 64 + fr;
        if (u.pn < 8) { const int col0 = u.pn * 256 + wc * 32 + 8 * fq;
            EPI_ROWS_BEGIN
#pragma unroll
                for (int bj = 0; bj < 2; ++bj) *(u32x4*)(q + row * 2048 + col0 + bj * HALF) = pk8(acc[ai][bj][m][0], acc[ai][bj][m][1]);
            EPI_ROWS_END
        } else { const int col0 = (u.pn - 8) * 256 + wc * 32 + 8 * fq;
#pragma unroll
            for (int ai = 0; ai < 2; ++ai)
#pragma unroll
            for (int mh = 0; mh < 2; ++mh) { u32x4 pwv[2][2];
#pragma unroll
                for (int m2_ = 0; m2_ < 2; ++m2_) { const size_t row = (size_t)(row0 + ai * HALF + (2 * mh + m2_) * 16);
#pragma unroll
                    for (int bj = 0; bj < 2; ++bj) { const int c = col0 + bj * HALF; pwv[m2_][bj] = *(const u32x4*)(pw + row * 1024 + c); } }
#pragma unroll
                for (int m2_ = 0; m2_ < 2; ++m2_) { const int m = 2 * mh + m2_; const size_t row = (size_t)(row0 + ai * HALF + m * 16);
#pragma unroll
                    for (int bj = 0; bj < 2; ++bj) { const int c = col0 + bj * HALF; f32x4 p0, p1; unpk8(pwv[m2_][bj], p0, p1);
                        *(u32x4*)(pw + row * 1024 + c) = pk8(p0 * act4(acc[ai][bj][m][0], 2), p1 * act4(acc[ai][bj][m][1], 2)); } } }
        }
    }
};
template <class Epi, class Sched, bool ALIGN_EPI = false, bool SP2 = false>
__device__ __forceinline__ void gemm_phase(PG8_LAS unsigned char* lds, const Gemm g, const Sched& S, const Epi& E, const int wave0) {
    int tidq; asm volatile("v_mbcnt_lo_u32_b32 %0, -1, 0\n\tv_mbcnt_hi_u32_b32 %0, -1, %0" : "=v"(tidq)); tidq += wave0 * 64;
    const int tid = tidq, wid = __builtin_amdgcn_readfirstlane(tid >> 6), lane = tid & 63, wr = wid >> 2, wc = wid & 3, fr = lane & 15, fq = lane >> 4;
    int Kq = g.K, ldaq = g.lda; const bf16_t* gA = g.A; const bf16_t* gB = g.Bt; asm volatile("" : "+s"(Kq), "+s"(ldaq), "+s"(gA), "+s"(gB));
    const int K = Kq, nt = K / BK;
    unsigned voffA[2], voffB[2];
#pragma unroll
    for (int i = 0; i < 2; ++i) { int R, C; stage_rc(tid * 16 + i * 8192, R, C); const int Rb = Epi::PERM ? ((R & ~31) + perm32(R & 31)) : R;
        voffA[i] = (unsigned)(R * ldaq + C) * 2u; voffB[i] = (unsigned)(Rb * K + C) * 2u; }
    const size_t kstep = (size_t)(BK * 2);
    const size_t hstepA = (size_t)HALF * ldaq * 2, hstepB = (size_t)HALF * K * 2;
    const size_t tstepA = 2 * hstepA, tstepB = 2 * hstepB;
    const unsigned ldsw = (unsigned)wid * 1024u;
    const int aoff = lds_byte(wr * 64 + fr, fq * 8), boff = lds_byte(wc * 32 + fr, fq * 8);
#define PG8_SA(b, h) (((b) * 2 + (h)) * HTB)
#define PG8_SB(b, h) ((4 + (b) * 2 + (h)) * HTB)
#define PG8_STAGE(bufoff, gbase, voff) do { _Pragma("unroll") for (int _i = 0; _i < 2; ++_i) \
        __builtin_amdgcn_global_load_lds((const unsigned*)((const char*)(gbase) + (voff)[_i]), (PG8_LAS unsigned*)(lds + (bufoff) + ldsw + _i * 8192), 16, 0, 0); } while (0)
#define PG8_LDA(dst, b, h) do { _Pragma("unroll") for (int m = 0; m < 4; ++m) _Pragma("unroll") for (int k = 0; k < 2; ++k) dst[m][k] = *(const PG8_LAS bf16x8*)(lds + PG8_SA(b, h) + aoff + m * 2048 + k * 1024); } while (0)
#define PG8_LDB(dst, b, h) do { _Pragma("unroll") for (int n = 0; n < 2; ++n) _Pragma("unroll") for (int k = 0; k < 2; ++k) dst[n][k] = *(const PG8_LAS bf16x8*)(lds + PG8_SB(b, h) + boff + n * 2048 + k * 1024); } while (0)
#define PG8_MMA(ai, bj, At, Bt) do { __builtin_amdgcn_s_setprio(1); _Pragma("unroll") for (int m = 0; m < 4; ++m) _Pragma("unroll") for (int n = 0; n < 2; ++n) _Pragma("unroll") for (int k = 0; k < 2; ++k) \
        acc[ai][bj][m][n] = __builtin_amdgcn_mfma_f32_16x16x32_bf16(Bt[n][k], At[m][k], acc[ai][bj][m][n], 0, 0, 0); __builtin_amdgcn_s_setprio(0); } while (0)
#define PG8_WAIT_V(n) asm volatile("s_waitcnt vmcnt(" #n ")" ::: "memory")
#define PG8_WAIT_L(n) asm volatile("s_waitcnt lgkmcnt(" #n ")" ::: "memory")
#define PG8_BAR __builtin_amdgcn_s_barrier()
#define PG8_SCHED __builtin_amdgcn_sched_barrier(0)
    Unit cur, nxt; int ui = 0;
    if (!S.next(0, cur)) return;
    f32x4 acc[2][2][4][2];
#pragma unroll
    for (int a = 0; a < 2; ++a)
#pragma unroll
        for (int b = 0; b < 2; ++b)
#pragma unroll
            for (int m = 0; m < 4; ++m)
#pragma unroll
                for (int n = 0; n < 2; ++n) acc[a][b][m][n] = (f32x4){0.f, 0.f, 0.f, 0.f};
    bf16x8 At[4][2], B0[2][2], B1[2][2];
    const char* cA = (const char*)gA + (size_t)cur.pm * tstepA; const char* cB = (const char*)gB + (size_t)cur.pn * tstepB;
    S.a_ready(cur);
    if constexpr (SP2) {
        PG8_STAGE(PG8_SB(0, 0), cB, voffB); PG8_STAGE(PG8_SB(0, 1), cB + hstepB, voffB); PG8_STAGE(PG8_SA(0, 0), cA, voffA); PG8_STAGE(PG8_SA(0, 1), cA + hstepA, voffA);
        if (wr == 1) PG8_BAR;
        PG8_WAIT_V(2); PG8_BAR;
        PG8_STAGE(PG8_SB(1, 0), cB + kstep, voffB); PG8_STAGE(PG8_SA(1, 0), cA + kstep, voffA); PG8_STAGE(PG8_SB(1, 1), cB + hstepB + kstep, voffB);
        PG8_WAIT_V(6); PG8_BAR;
    } else {
        PG8_STAGE(PG8_SB(0, 0), cB, voffB); PG8_STAGE(PG8_SA(0, 0), cA, voffA); PG8_STAGE(PG8_SB(0, 1), cB + hstepB, voffB); PG8_STAGE(PG8_SA(0, 1), cA + hstepA, voffA);
        if (wr == 1) PG8_BAR;
        PG8_WAIT_V(4); PG8_BAR;
        PG8_STAGE(PG8_SB(1, 0), cB + kstep, voffB); PG8_STAGE(PG8_SA(1, 0), cA + kstep, voffA); PG8_STAGE(PG8_SB(1, 1), cB + hstepB + kstep, voffB);
        PG8_WAIT_V(6); PG8_BAR;
    }
    for (;;) {
        const bool has_next = S.next(ui + 1, nxt);
        const char* nA = has_next ? (const char*)gA + (size_t)nxt.pm * tstepA : cA; const char* nB = has_next ? (const char*)gB + (size_t)nxt.pn * tstepB : cB;
        for (int t = 0; t < nt; t += 2) {
            const bool last = (t == nt - 2);
            const char* a1 = cA + (size_t)(t + 1) * kstep;
            const char* a2 = last ? nA : cA + (size_t)(t + 2) * kstep; const char* b2 = last ? nB : cB + (size_t)(t + 2) * kstep;
            const char* a3 = a2 + kstep; const char* b3 = b2 + kstep;
            if (last && has_next) S.a_ready(nxt);
            if constexpr (SP2) {
            PG8_LDB(B0, 0, 0); PG8_LDB(B1, 0, 1); PG8_SCHED; PG8_LDA(At, 0, 0); PG8_STAGE(PG8_SA(1, 1), a1 + hstepA, voffA);
            PG8_WAIT_V(8); PG8_WAIT_L(0); PG8_BAR; PG8_MMA(0, 0, At, B0); PG8_MMA(0, 1, At, B1); PG8_BAR; PG8_SCHED;
            PG8_LDA(At, 0, 1); PG8_STAGE(PG8_SB(0, 0), b2, voffB); PG8_STAGE(PG8_SB(0, 1), b2 + hstepB, voffB); PG8_STAGE(PG8_SA(0, 0), a2, voffA);
            PG8_WAIT_V(8); PG8_WAIT_L(0); PG8_BAR; PG8_MMA(1, 0, At, B0); PG8_MMA(1, 1, At, B1); PG8_BAR; PG8_SCHED;
            PG8_LDB(B0, 1, 0); PG8_LDB(B1, 1, 1); PG8_SCHED; PG8_LDA(At, 1, 0); PG8_STAGE(PG8_SA(0, 1), a2 + hstepA, voffA);
            PG8_WAIT_V(8); PG8_WAIT_L(0); PG8_BAR; PG8_MMA(0, 0, At, B0); PG8_MMA(0, 1, At, B1); PG8_BAR; PG8_SCHED;
            PG8_LDA(At, 1, 1); PG8_STAGE(PG8_SB(1, 0), b3, voffB); PG8_STAGE(PG8_SB(1, 1), b3 + hstepB, voffB); PG8_STAGE(PG8_SA(1, 0), a3, voffA);
            PG8_WAIT_V(8); PG8_WAIT_L(0); PG8_BAR; PG8_MMA(1, 0, At, B0); PG8_MMA(1, 1, At, B1); PG8_BAR; PG8_SCHED;
            } else {
            PG8_LDB(B0, 0, 0); PG8_SCHED; PG8_LDA(At, 0, 0); PG8_STAGE(PG8_SA(1, 1), a1 + hstepA, voffA);
            PG8_WAIT_L(8); PG8_BAR; PG8_WAIT_L(0); PG8_MMA(0, 0, At, B0); PG8_BAR; PG8_SCHED;
            PG8_LDB(B1, 0, 1); PG8_STAGE(PG8_SB(0, 0), b2, voffB);
            PG8_BAR; PG8_WAIT_L(0); PG8_MMA(0, 1, At, B1); PG8_BAR;
            PG8_LDA(At, 0, 1); PG8_STAGE(PG8_SA(0, 0), a2, voffA);
            PG8_BAR; PG8_WAIT_L(0); PG8_MMA(1, 0, At, B0); PG8_BAR; PG8_SCHED;
            PG8_STAGE(PG8_SB(0, 1), b2 + hstepB, voffB);
            PG8_WAIT_V(6); PG8_BAR; PG8_MMA(1, 1, At, B1); PG8_BAR;
            PG8_LDB(B0, 1, 0); PG8_SCHED; PG8_LDA(At, 1, 0); PG8_STAGE(PG8_SA(0, 1), a2 + hstepA, voffA);
            PG8_WAIT_L(8); PG8_BAR; PG8_WAIT_L(0); PG8_MMA(0, 0, At, B0); PG8_BAR; PG8_SCHED;
            PG8_LDB(B1, 1, 1); PG8_STAGE(PG8_SB(1, 0), b3, voffB);
            PG8_BAR; PG8_WAIT_L(0); PG8_MMA(0, 1, At, B1); PG8_BAR;
            PG8_LDA(At, 1, 1); PG8_STAGE(PG8_SA(1, 0), a3, voffA);
            PG8_BAR; PG8_WAIT_L(0); PG8_MMA(1, 0, At, B0); PG8_BAR; PG8_SCHED;
            PG8_STAGE(PG8_SB(1, 1), b3 + hstepB, voffB);
            PG8_WAIT_V(6); PG8_BAR; PG8_MMA(1, 1, At, B1); PG8_BAR;
            }
        }
        if constexpr (ALIGN_EPI) { if (wr == 0) PG8_BAR; }
        if constexpr (!Epi::AFTER_DRAIN) { E(acc, cur, wr, wc, fr, fq); S.done(cur); }
        if (!has_next) break;
#pragma unroll
        for (int a = 0; a < 2; ++a)
#pragma unroll
            for (int b = 0; b < 2; ++b)
#pragma unroll
                for (int m = 0; m < 4; ++m)
#pragma unroll
                    for (int n = 0; n < 2; ++n) acc[a][b][m][n] = (f32x4){0.f, 0.f, 0.f, 0.f};
        cur = nxt; cA = nA; cB = nB; ++ui;
        if constexpr (ALIGN_EPI) { if (wr == 1) PG8_BAR; }
    }
    PG8_WAIT_V(0);
    if constexpr (!ALIGN_EPI) { if (wr == 0) PG8_BAR; }
    PG8_BAR;
    if constexpr (Epi::AFTER_DRAIN) { E.fused(acc, cur, wr, wc, fr, fq, lds, wid, lane); S.done(cur); }
#undef PG8_SA
#undef PG8_SB
#undef PG8_STAGE
#undef PG8_LDA
#undef PG8_LDB
#undef PG8_MMA
#undef PG8_WAIT_V
#undef PG8_WAIT_L
#undef PG8_BAR
#undef PG8_SCHED
}
}

constexpr int NB = 8, SEQ = 4096, T = NB * SEQ, D = 1024, DEPTH = 4, NZ = 7680, NWAVES = 8;
constexpr int CIN = 7424;
constexpr size_t MiB = 1u << 20;
constexpr size_t WS_CTL = 0, WS_LORA = 1 * MiB, WS_MV = 7 * MiB, ZERO_BYTES = 9 * MiB;
constexpr size_t LORA_BYTES = 3072 * 256 * 2, MV_BYTES = 1024 * 256 * 2;
constexpr size_t WS_WIN = 10 * MiB;
constexpr size_t WS_DB = 40 * MiB, DB_SET = 62 * MiB;
constexpr size_t DB_PA = 0, DB_PBT = 2 * MiB, DB_POUT = 4 * MiB, DB_WQG = 6 * MiB, DB_KEYS = 12 * MiB, DB_GMW = 12 * MiB + 512 * 1024, DB_PLEW = 13 * MiB, DB_U = 14 * MiB, DB_V = 30 * MiB, DB_PB = 46 * MiB;
constexpr size_t WS_VF = 164 * MiB, WS_PW = 228 * MiB, WS_NX = 292 * MiB, WS_ZRKV = 420 * MiB, WS_ZL = 612 * MiB, WS_GUV = 644 * MiB, WS_SG = 772 * MiB;
constexpr size_t WS_EW = 900 * MiB, WS_AR = 964 * MiB, WS_G = 1028 * MiB, WS_WINB = 1092 * MiB, WINB_BYTES = 4 * MiB, WS_END = 1100 * MiB;
constexpr size_t WS_Q = WS_ZRKV, WS_SEL = WS_ZRKV + 128 * MiB, WS_MG = WS_AR, WS_N2 = WS_G;
constexpr size_t WIN_ZERO_OFF = WS_WIN + (size_t)3328 * 2048 * 2, WIN_ZERO_BYTES = (size_t)256 * 2048 * 2;
#ifndef ZSPLIT
#define ZSPLIT 2
#endif
constexpr int CW_BAR = 4096;
constexpr int RING_BYTES = 131072, LDSCTL_OFF = RING_BYTES, MISC_OFF = LDSCTL_OFF + 320, LDS_BYTES = 147456;

#define LAS __attribute__((address_space(3)))
#define GAS __attribute__((address_space(1)))
typedef unsigned short bf16;
typedef unsigned v4u __attribute__((ext_vector_type(4)));
typedef unsigned v2u __attribute__((ext_vector_type(2)));
typedef float f32x4 __attribute__((ext_vector_type(4)));
typedef float f32x2 __attribute__((ext_vector_type(2)));
typedef short bf16x8 __attribute__((ext_vector_type(8)));
using pg8::fsig; using pg8::fgelu; using pg8::bflo; using pg8::bfhi; using pg8::unpk8; using pg8::pk8; using pg8::cvt_pk_bf16;

#define XB_TMO      128
#define XB_XCNT(j)  (256  + 64 * (j))
#define XB_XSUB(j)  (1280 + 64 * (j))
#define XB_XGEN(j)  (2304 + 64 * (j))
#define XB_TOP      3328
#define XB_TOPGEN   3392
#define XCD_BAR_WORDS 3456
#define XB_SPIN_CAP (1u << 22)

__device__ __forceinline__ unsigned xb_ld(unsigned* p)              { return __hip_atomic_load(p, __ATOMIC_RELAXED, __HIP_MEMORY_SCOPE_AGENT); }
__device__ __forceinline__ unsigned xb_add(unsigned* p, unsigned v) { return __hip_atomic_fetch_add(p, v, __ATOMIC_RELAXED, __HIP_MEMORY_SCOPE_AGENT); }
__device__ __forceinline__ unsigned xb_xcc_id() { return (unsigned)__builtin_amdgcn_s_getreg((3 << 11) | 20) & 0xFu; }
#define XB_SPIN(cond, bar) do { unsigned _sp = 0; while (cond) { __builtin_amdgcn_s_sleep(1); \
    if ((++_sp & 255u) == 0u) { if (xb_ld(&(bar)[XB_TMO])) break; if (_sp > XB_SPIN_CAP) { atomicAdd(&(bar)[XB_TMO], 1u); break; } } } } while (0)

struct XcdBarrier { unsigned* bar; unsigned x; volatile LAS unsigned* st; };

__device__ __forceinline__ XcdBarrier xcd_barrier_post(unsigned* bar, volatile LAS unsigned* st) {
    XcdBarrier b; b.bar = bar; b.x = xb_xcc_id(); b.st = st;
    if (threadIdx.x == 0) (void)xb_add(&bar[XB_XCNT(b.x)], 1u);
    return b;
}
__device__ __forceinline__ void xcd_barrier_complete(unsigned* bar, unsigned x, unsigned& nloc, unsigned& nx) {
    const unsigned G = gridDim.x * gridDim.y * gridDim.z;
    unsigned sum, cnt, mine, sp = 0u;
    for (;;) {
        sum = 0u; cnt = 0u; mine = 0u;
#pragma unroll
        for (unsigned j = 0; j < 16; ++j) { const unsigned c = xb_ld(&bar[XB_XCNT(j)]); sum += c; cnt += (c > 0u) ? 1u : 0u; mine = (j == x) ? c : mine; }
        if (sum == G) break;
        __builtin_amdgcn_s_sleep(1);
        if ((++sp & 255u) == 0u) { if (xb_ld(&bar[XB_TMO])) break; if (sp > XB_SPIN_CAP) { atomicAdd(&bar[XB_TMO], 1u); break; } }
    }
    nloc = mine > 0u ? mine : 1u; nx = cnt > 0u ? cnt : 1u;
}
__device__ __forceinline__ int lane_id_now();
__device__ __forceinline__ void xcd_barrier(const XcdBarrier& b, const int wave0) {
    asm volatile("s_waitcnt vmcnt(0)" ::: "memory");
    __syncthreads();
    if (wave0 == 0 && lane_id_now() == 0) {
        unsigned* bar = b.bar;
        __builtin_amdgcn_s_waitcnt(0);
        unsigned nloc = b.st[0], nx = b.st[1];
        if (nloc == 0u) { xcd_barrier_complete(bar, b.x, nloc, nx); b.st[0] = nloc; b.st[1] = nx; }
        const unsigned old = xb_add(&bar[XB_XSUB(b.x)], 1u);
        const unsigned gen = old / nloc;
        if (old + 1u == (gen + 1u) * nloc) {
            __builtin_amdgcn_fence(__ATOMIC_RELEASE, "agent");
            asm volatile("s_waitcnt vmcnt(0)" ::: "memory");
            const unsigned og = xb_add(&bar[XB_TOP], 1u);
            const unsigned tg = og / nx;
            if (og + 1u == (tg + 1u) * nx) xb_add(&bar[XB_TOPGEN], 1u);
            else XB_SPIN(xb_ld(&bar[XB_TOPGEN]) == tg, bar);
            __builtin_amdgcn_fence(__ATOMIC_ACQUIRE, "agent");
            xb_add(&bar[XB_XGEN(b.x)], 1u);
            asm volatile("s_waitcnt vmcnt(0)" ::: "memory");
        } else {
            XB_SPIN(xb_ld(&bar[XB_XGEN(b.x)]) == gen, bar);
            __builtin_amdgcn_fence(__ATOMIC_ACQUIRE, "agent");
            asm volatile("s_waitcnt vmcnt(0)" ::: "memory");
        }
    }
    __syncthreads();
}

struct Args { const float* in[32]; float* out; unsigned char* ws; };
struct Frame {
    LAS unsigned char* lds;
    int tid, lane, wave, G, bx, wave0;
    GAS unsigned char* ws; float* h;
};
__device__ __forceinline__ int lane_id_now() { int l; asm volatile("v_mbcnt_lo_u32_b32 %0, -1, 0\n\tv_mbcnt_hi_u32_b32 %0, -1, %0" : "=v"(l)); return l; }
__device__ __forceinline__ void phase_ids(Frame& F) { const int l = lane_id_now(); F.lane = l; F.wave = F.wave0; F.tid = F.wave0 * 64 + l; GAS unsigned char* w = F.ws; asm volatile("" : "+s"(w)); F.ws = w; }
#define DPP_ADD(x, ctrl) ((x) + __builtin_bit_cast(float, __builtin_amdgcn_update_dpp(0, __builtin_bit_cast(int, (x)), (ctrl), 0xf, 0xf, false)))
__device__ __forceinline__ float sum8(float v) {
    v = DPP_ADD(v, 0xB1);
    v = DPP_ADD(v, 0x4E);
    v = DPP_ADD(v, 0x141);
    return v;
}
__device__ __forceinline__ float sum16(float v) { v = sum8(v); v = DPP_ADD(v, 0x140); return v; }
#define DPP_ADD_NS(x, ctrl) do { (x) = DPP_ADD((x), (ctrl)); asm("" : "+v"(x)); } while (0)
__device__ __forceinline__ float sum16_ns(float v) { DPP_ADD_NS(v, 0xB1); DPP_ADD_NS(v, 0x4E); DPP_ADD_NS(v, 0x141); DPP_ADD_NS(v, 0x140); return v; }
__device__ __forceinline__ float wave_sum(float v) {
    v = sum8(v);
    v = DPP_ADD(v, 0x140);
    const auto r = __builtin_amdgcn_permlane16_swap(__builtin_bit_cast(unsigned, v), __builtin_bit_cast(unsigned, v), false, false);
    v = __builtin_bit_cast(float, (unsigned)r[0]) + __builtin_bit_cast(float, (unsigned)r[1]);
    const auto q = __builtin_amdgcn_permlane32_swap(__builtin_bit_cast(unsigned, v), __builtin_bit_cast(unsigned, v), false, false);
    return __builtin_bit_cast(float, (unsigned)q[0]) + __builtin_bit_cast(float, (unsigned)q[1]);
}
__device__ __forceinline__ unsigned xor16_u(unsigned x, int lane) { const auto r = __builtin_amdgcn_permlane16_swap(x, x, false, false); return (lane & 16) ? (unsigned)r[0] : (unsigned)r[1]; }
__device__ __forceinline__ unsigned xor32_u(unsigned x, int lane) { const auto r = __builtin_amdgcn_permlane32_swap(x, x, false, false); return (lane & 32) ? (unsigned)r[0] : (unsigned)r[1]; }
__device__ __forceinline__ void tr_item(const float* W, int ldw, int ncols, bf16* WT, int ldt, int koff, int row_off, LAS float* scr, int item, int lane) {
    const int nblk = ncols / 32, kb = item / nblk, nb = item % nblk, k0 = 64 * kb, n0 = 32 * nb;
#pragma unroll 8
    for (int i = 0; i < 32; ++i) { const int kk = 2 * i + (lane >> 5); scr[kk * 33 + (lane & 31)] = W[(size_t)(k0 + kk) * ldw + n0 + (lane & 31)]; }
    asm volatile("s_waitcnt lgkmcnt(0)" ::: "memory");
    const int c = lane & 7;
#pragma unroll
    for (int j = 0; j < 4; ++j) { const int n = (lane >> 3) + 8 * j; const LAS float* s = scr + (8 * c) * 33 + n;
        v4u o; o.x = cvt_pk_bf16(s[0 * 33], s[1 * 33]); o.y = cvt_pk_bf16(s[2 * 33], s[3 * 33]); o.z = cvt_pk_bf16(s[4 * 33], s[5 * 33]); o.w = cvt_pk_bf16(s[6 * 33], s[7 * 33]);
        *(v4u*)(WT + (size_t)(row_off + n0 + n) * ldt + koff + k0 + 8 * c) = o; }
    asm volatile("s_waitcnt lgkmcnt(0)" ::: "memory");
}
__device__ __forceinline__ void cvt_chunk(const float* src, bf16* dst, size_t chunk, int lane) {
    const f32x4* s = (const f32x4*)(src + chunk * 512) + lane * 2; const f32x4 a = s[0], b = s[1];
    *(v4u*)(dst + chunk * 512 + lane * 8) = pk8(a, b);
}
__device__ __forceinline__ void cvt8_chunk(const float* src, unsigned char* dst, size_t chunk, int lane, float sc) {
    const f32x4* s = (const f32x4*)(src + chunk * 512) + lane * 2; const f32x4 a = s[0] * sc, b = s[1] * sc;
    int w0 = 0, w1 = 0;
    w0 = __builtin_amdgcn_cvt_pk_fp8_f32(a.x, a.y, w0, false); w0 = __builtin_amdgcn_cvt_pk_fp8_f32(a.z, a.w, w0, true);
    w1 = __builtin_amdgcn_cvt_pk_fp8_f32(b.x, b.y, w1, false); w1 = __builtin_amdgcn_cvt_pk_fp8_f32(b.z, b.w, w1, true);
    *(v2u*)(dst + chunk * 512 + lane * 8) = (v2u){(unsigned)w0, (unsigned)w1};
}
__device__ __forceinline__ void norm_row_nx(const float* hrow, float* hcopy, const float* g, bf16* NX, int t, int lane) {
    const f32x4* xr = (const f32x4*)hrow + lane; f32x4 v[4]; float s = 0.f;
#pragma unroll
    for (int j = 0; j < 4; ++j) { v[j] = xr[64 * j]; s += (v[j].x * v[j].x + v[j].y * v[j].y) + (v[j].z * v[j].z + v[j].w * v[j].w); }
    if (hcopy) {
#pragma unroll
        for (int j = 0; j < 4; ++j) ((f32x4*)hcopy)[lane + 64 * j] = v[j]; }
    const float rstd = 1.f / sqrtf(wave_sum(s) * (1.f / D) + 1e-6f);
    const int tt = t & (SEQ - 1);
#pragma unroll
    for (int j = 0; j < 4; ++j) { const f32x4 gv = ((const f32x4*)g)[lane + 64 * j]; const f32x4 o = v[j] * rstd * gv;
        v2u w; w.x = cvt_pk_bf16(o.x, o.y); w.y = cvt_pk_bf16(o.z, o.w);
        const int c = 4 * (lane + 64 * j);
        *(v2u*)(NX + (size_t)t * 2048 + c) = w;
        if (tt != SEQ - 1) *(v2u*)(NX + (size_t)(t + 1) * 2048 + 1024 + c) = w;
        if (tt == 0) *(v2u*)(NX + (size_t)t * 2048 + 1024 + c) = (v2u){0u, 0u}; }
}
__device__ __forceinline__ void norm_row_n2x2(const float* hrow0, const float* hrow1, const float* g, bf16* o0, bf16* o1, int lane) {
    const f32x4* x0 = (const f32x4*)hrow0 + lane; const f32x4* x1 = (const f32x4*)hrow1 + lane; f32x4 v[2][4]; float s0 = 0.f, s1 = 0.f;
#pragma unroll
    for (int j = 0; j < 4; ++j) { v[0][j] = x0[64 * j]; v[1][j] = x1[64 * j]; }
#pragma unroll
    for (int j = 0; j < 4; ++j) { s0 += (v[0][j].x * v[0][j].x + v[0][j].y * v[0][j].y) + (v[0][j].z * v[0][j].z + v[0][j].w * v[0][j].w);
                                  s1 += (v[1][j].x * v[1][j].x + v[1][j].y * v[1][j].y) + (v[1][j].z * v[1][j].z + v[1][j].w * v[1][j].w); }
    const float r0 = 1.f / sqrtf(wave_sum(s0) * (1.f / D) + 1e-6f), r1 = 1.f / sqrtf(wave_sum(s1) * (1.f / D) + 1e-6f);
#pragma unroll
    for (int j = 0; j < 4; ++j) { const f32x4 gv = ((const f32x4*)g)[lane + 64 * j]; const f32x4 a = v[0][j] * r0 * gv, b = v[1][j] * r1 * gv;
        *(v2u*)(o0 + 4 * (lane + 64 * j)) = (v2u){cvt_pk_bf16(a.x, a.y), cvt_pk_bf16(a.z, a.w)}; *(v2u*)(o1 + 4 * (lane + 64 * j)) = (v2u){cvt_pk_bf16(b.x, b.y), cvt_pk_bf16(b.z, b.w)}; }
}
__device__ __forceinline__ void prep_phase(Frame& F, const Args& a, int layer, int blk, int nblk_, int part) {
    phase_ids(F);
    LAS float* scr = (LAS float*)(F.lds + F.wave * 16384);
    const int gw = blk * NWAVES + F.wave, NGW = nblk_ * NWAVES, lane = F.lane;
    GAS unsigned char* ws = F.ws; GAS unsigned char* db = F.ws + WS_DB + (size_t)(layer & 1) * DB_SET;
    bf16* WIN = (bf16*)(ws + WS_WIN); bf16* LORA = (bf16*)(ws + WS_LORA + (size_t)layer * LORA_BYTES); bf16* MVT = (bf16*)(ws + WS_MV + (size_t)(layer > 0 ? layer - 1 : 0) * MV_BYTES);
    const float* w_in = a.in[5] + (size_t)layer * 2048 * CIN;
    const int mvn = layer > 0 ? 32 : 0;
    const int c1 = 32 * 104, c2a = 32 * 64, c2b = 32 * 32, c2c = 32 * (32 - 8 * ZSPLIT), c2d = 32 * 8 * ZSPLIT, c2 = c2a + 2 * c2b, c3 = mvn, c4 = 32, c5 = 32, c6 = 64, c7 = 512, c10 = 1024, c12 = 128;
    const int total = (part & 1) ? c1 + c2 + c3 + c4 + c5 + c6 + 3 * c7 + c10 + c7 + c12 : 0;
    for (int it = gw; it < total; it += NGW) {
        int r = it;
        if (r < c1) { tr_item(w_in, CIN, 3328, WIN, 2048, 0, 0, scr, r, lane); continue; } r -= c1;
        if (r < c2a) { tr_item(w_in + 3328, CIN, 2048, WIN, 2048, 0, 3584, scr, r, lane); continue; } r -= c2a;
        if (r < c2b) { tr_item(w_in + 6400, CIN, 1024, WIN, 2048, 0, 5632, scr, r, lane); continue; } r -= c2b;
        if (r < c2c) { tr_item(w_in + 5376, CIN, 1024 - 256 * ZSPLIT, WIN, 2048, 0, 6656, scr, r, lane); continue; } r -= c2c;
        if (r < c2d) { tr_item(w_in + 6400 - 256 * ZSPLIT, CIN, 256 * ZSPLIT, (bf16*)(ws + WS_WINB + (size_t)(layer & 1) * WINB_BYTES), 2048, 0, 0, scr, r, lane); continue; } r -= c2d;
        if (r < c3) { tr_item(a.in[16] + (size_t)(layer - 1) * 2048 * 32, 32, 32, WIN, 2048, 0, 3328, scr, r, lane); continue; } r -= c3;
        if (r < c4) { tr_item(a.in[7] + (size_t)layer * 64 * 1024, 1024, 1024, LORA, 128, 0, 0, scr, r, lane); continue; } r -= c4;
        if (r < c5) { tr_item(a.in[9] + (size_t)layer * 64 * 1024, 1024, 1024, LORA, 128, 64, 1024, scr, r, lane); continue; } r -= c5;
        if (r < c6) { tr_item(a.in[10] + (size_t)layer * 128 * 1024, 1024, 1024, LORA + 2048 * 128, 128, 0, 0, scr, r, lane); continue; } r -= c6;
        if (r < c7) { tr_item(a.in[23] + (size_t)layer * D * D, D, D, (bf16*)(db + DB_PA), D, 0, 0, scr, r, lane); continue; } r -= c7;
        if (r < c7) { tr_item(a.in[24] + (size_t)layer * D * D, D, D, (bf16*)(db + DB_PBT), D, 0, 0, scr, r, lane); continue; } r -= c7;
        if (r < c7) { tr_item(a.in[25] + (size_t)layer * D * D, D, D, (bf16*)(db + DB_POUT), D, 0, 0, scr, r, lane); continue; } r -= c7;
        if (r < c10) { tr_item(a.in[26] + (size_t)layer * D * 2048, 2048, 2048, (bf16*)(db + DB_WQG), D, 0, 0, scr, r, lane); continue; } r -= c10;
        if (r < c7) { tr_item(a.in[31] + (size_t)layer * D * D, D, D, (bf16*)(db + DB_WQG), D, 0, 2048, scr, r, lane); continue; } r -= c7;
        tr_item(a.in[30] + (size_t)layer * 256 * D, D, D, (bf16*)(db + DB_PLEW), 256, 0, 0, scr, r, lane);
    }
    if (layer > 0 && (part & 1)) {
        const float* w2 = a.in[17] + (size_t)(layer - 1) * 32 * 1024;
        for (int it = gw; it < 512; it += NGW) { const int e = it * 64 + lane, n = e >> 5, k = e & 31; MVT[n * 128 + k] = (bf16)(cvt_pk_bf16(w2[k * 1024 + n], 0.f) & 0xffffu); }
    }
    {
        const float* keys = a.in[27] + (size_t)layer * 262144; const float* ut = a.in[28] + (size_t)layer * 16777216; const float* vt = a.in[29] + (size_t)layer * 16777216;
        const float* pin = a.in[1] + (size_t)layer * T * 256; const float* gws = a.in[21] + (size_t)layer * 131072;
        const int n1 = (part & 1) ? 512 : 0, n2 = (part & 2) ? 32768 : 0, n4 = (part & 1) ? 16384 : 0, n5 = (part & 1) ? 256 : 0, ntot = n1 + 2 * n2 + n4 + n5;
        for (int it = gw; it < ntot; it += NGW) {
            int r = it;
            if (r < n2) { cvt8_chunk(ut, (unsigned char*)(db + DB_U), r, lane, 256.f); continue; } r -= n2;
            if (r < n2) { cvt8_chunk(vt, (unsigned char*)(db + DB_V), r, lane, 64.f); continue; } r -= n2;
            if (r < n4) { cvt_chunk(pin, (bf16*)(db + DB_PB), r, lane); continue; } r -= n4;
            if (r < n1) { cvt_chunk(keys, (bf16*)(db + DB_KEYS), r, lane); continue; } r -= n1;
            {
                const int e0 = r * 512 + lane * 8, tq = (e0 >> 7) & 127, p0 = e0 & 127;
                const f32x4* s = (const f32x4*)(gws + e0); f32x4 x0 = s[0], x1 = s[1];
#pragma unroll
                for (int j = 0; j < 4; ++j) { if (p0 + j > tq) x0[j] = 0.f; if (p0 + 4 + j > tq) x1[j] = 0.f; }
                *(v4u*)((bf16*)(db + DB_GMW) + e0) = pk8(x0, x1);
            }
        }
    }
    if (layer == 0 && (part & 1)) {
        for (int m = gw; m < T; m += NGW) norm_row_nx(a.in[0] + (size_t)m * D, F.h + (size_t)m * D, a.in[2], (bf16*)(ws + WS_NX), m, lane);
    }
}

constexpr int SC = 32, NPR = SC / 2;
constexpr int SC_VEC = SC * 64;
constexpr int SC_WW = 0, SC_VQ = NPR * 64, SC_BK = SC_VQ + NPR * 256, SC_XA = SC_BK + NPR * 128, SC_C = SC_XA + NPR * 128, SC_VP = SC_C + NPR * 20, SC_BON = SC_VP + SC * 64, SC_BUF = SC_BON + SC * 8;
static_assert(SC_BUF % 4 == 0 && SC_C % 4 == 0 && (2 * SC_BUF + 2 * SC_VEC) * 4 + 64 <= 131072, "scan LDS map");
struct ScanOps { f32x4 w[4], vq, c[4]; v4u bk[2]; bf16x8 x[2]; };
__device__ __forceinline__ void scan_load2(ScanOps& o, const LAS float* buf, const LAS float* vqp, const LAS unsigned char* bkp, int bkstep, int p, int lane) {
    const int q = lane >> 4;
    const LAS float* wp = buf + SC_WW + p * 64 + q * 4;
#pragma unroll
    for (int i = 0; i < 4; ++i) o.w[i] = *(const LAS f32x4*)(wp + 16 * i);
    o.vq = *(const LAS f32x4*)(vqp + p * 256);
    o.bk[0] = *(const LAS v4u*)(bkp + p * bkstep); o.bk[1] = *(const LAS v4u*)(bkp + p * bkstep + 16);
    const LAS unsigned char* xp = (const LAS unsigned char*)(buf + SC_XA) + p * 512 + (lane & 3) * 128 + q * 16;
    o.x[0] = *(const LAS bf16x8*)xp; o.x[1] = *(const LAS bf16x8*)(xp + 64);
#pragma unroll
    for (int i = 0; i < 4; ++i) o.c[i] = *(const LAS f32x4*)(buf + SC_C + p * 20 + 4 * i);
}
__device__ __forceinline__ const char* uni_ptr(const char* p) { const unsigned long long a = (unsigned long long)p;
    const unsigned lo = (unsigned)__builtin_amdgcn_readfirstlane((int)(unsigned)a), hi = (unsigned)__builtin_amdgcn_readfirstlane((int)(unsigned)(a >> 32));
    return (const char*)(((unsigned long long)hi << 32) | lo); }
__device__ __forceinline__ float smul(float a, float b) { float r; asm("v_mul_f32 %0, %1, %2" : "=v"(r) : "v"(a), "v"(b)); return r; }
__device__ __forceinline__ void scan_pair(const ScanOps& o, f32x4 (&St)[4], float& sa0, float& sa1, v4u (&am)[4], v4u& bm, LAS float* ypt, int ystep, unsigned m16) {
    v4u s0, s1;
    s0.x = cvt_pk_bf16(St[0].x, St[0].y); s0.y = cvt_pk_bf16(St[0].z, St[0].w); s0.z = cvt_pk_bf16(St[1].x, St[1].y); s0.w = cvt_pk_bf16(St[1].z, St[1].w);
    s1.x = cvt_pk_bf16(St[2].x, St[2].y); s1.y = cvt_pk_bf16(St[2].z, St[2].w); s1.z = cvt_pk_bf16(St[3].x, St[3].y); s1.w = cvt_pk_bf16(St[3].z, St[3].w);
    f32x4 dv = (f32x4){0.f, 0.f, 0.f, 0.f};
    dv = __builtin_amdgcn_mfma_f32_16x16x32_bf16(o.x[0], __builtin_bit_cast(bf16x8, s0), dv, 0, 0, 0);
    dv = __builtin_amdgcn_mfma_f32_16x16x32_bf16(o.x[1], __builtin_bit_cast(bf16x8, s1), dv, 0, 0, 0);
    const float v0 = o.vq.x, v1 = o.vq.y, v2 = o.vq.z;
    typedef short s16x4 __attribute__((ext_vector_type(4)));
    const v2u bm2 = (v2u){cvt_pk_bf16(sa0, v0) & m16, cvt_pk_bf16(sa1, v1) & m16};
#pragma unroll
    for (int i = 0; i < 4; ++i) { const v2u a2 = (v2u){o.bk[i >> 1][(i & 1) * 2], o.bk[i >> 1][(i & 1) * 2 + 1]};
        St[i] = __builtin_amdgcn_mfma_f32_16x16x16bf16_1k(__builtin_bit_cast(s16x4, a2), __builtin_bit_cast(s16x4, bm2),
                                                        (f32x4){smul(St[i].x, o.w[i].x), smul(St[i].y, o.w[i].y), smul(St[i].z, o.w[i].z), smul(St[i].w, o.w[i].w)}, 0, 0, 0); }
    ypt[0]     = dv.z + sa0 * o.c[2].z + v0 * o.c[2].w;
    ypt[ystep] = dv.w + sa0 * o.c[3].x + v0 * o.c[3].y + sa1 * o.c[3].z + v1 * o.c[3].w;
    const float n0 = dv.x + sa0 * o.c[0].x + v0 * o.c[0].y + sa1 * o.c[0].z + v1 * o.c[0].w;
    const float n1 = dv.y + sa0 * o.c[1].x + v0 * o.c[1].y + sa1 * o.c[1].z + v1 * o.c[1].w + n0 * o.c[2].x + v2 * o.c[2].y;
    sa0 = n0; sa1 = n1;
}
__device__ __forceinline__ void scan_unit(Frame& F, const Args& a, int layer, int unit) {
    phase_ids(F);
    const int b = unit >> 4, hh = unit & 15, tid = F.tid, lane = F.lane, wave = F.wave;
    LAS float* bufs = (LAS float*)F.lds;
    LAS float* sY = bufs + 2 * SC_BUF;
    const bf16* ZR = (const bf16*)(F.ws + WS_ZRKV); const bf16* EW = (const bf16*)(F.ws + WS_EW); const bf16* AR = (const bf16*)(F.ws + WS_AR); const bf16* GT = (const bf16*)(F.ws + WS_G);
    bf16* YA = (bf16*)(F.ws + WS_G);
    constexpr int NCH = SEQ / SC;
    if (wave < 4) {
        f32x4 St[4]; v4u am[4], bm = (v4u){0u, 0u, 0u, 0u};
#pragma unroll
        for (int i = 0; i < 4; ++i) { St[i] = (f32x4){0.f, 0.f, 0.f, 0.f}; am[i] = (v4u){0u, 0u, 0u, 0u}; }
        float sa0 = 0.f, sa1 = 0.f;
        const unsigned m16 = lane < 16 ? 0xffffffffu : 0u;
        LAS unsigned char* zblk = (LAS unsigned char*)(sY + 2 * SC_VEC);
        if (tid < 8) ((LAS unsigned*)zblk)[tid] = 0u;
        const int bkstep = lane < 16 ? 512 : 0;
        for (int it = 0; it < NCH + 2; ++it) {
            if (it >= 1 && it <= NCH) {
                const LAS float* bufc = bufs + ((it - 1) & 1) * SC_BUF;
                const LAS float* vqp = bufc + SC_VQ + 4 * (wave * 16 + (lane & 15));
                const LAS unsigned char* bkp = lane < 16 ? (const LAS unsigned char*)(bufc + SC_BK) + lane * 32 : (const LAS unsigned char*)zblk;
                LAS float* yb = lane < 16 ? sY + ((it - 1) & 1) * SC_VEC + wave * 16 + lane : (LAS float*)(zblk + 32);
                const int ystep = lane < 16 ? 64 : 0;
                if (it == 1) { sa0 = 0.f; sa1 = vqp[0] * bufc[SC_C + 16]; }
                ScanOps o0, o1;
                scan_load2(o0, bufc, vqp, bkp, bkstep, 0, lane);
#pragma unroll 1
                for (int p = 0; p < NPR; p += 2) {
                    scan_load2(o1, bufc, vqp, bkp, bkstep, p + 1, lane);
                    scan_pair(o0, St, sa0, sa1, am, bm, yb + (2 * p) * ystep, ystep, m16);
                    if (p + 2 < NPR) scan_load2(o0, bufc, vqp, bkp, bkstep, p + 2, lane);
                    scan_pair(o1, St, sa0, sa1, am, bm, yb + (2 * p + 2) * ystep, ystep, m16);
                }
            }
            __syncthreads();
        }
    } else {
        const int ht = tid - 256, tl = ht >> 3, c8 = ht & 7, ch = hh * 64 + c8 * 8;
        const int pr = ht >> 4, c4 = ht & 15, chp = hh * 64 + c4 * 4;
        const size_t po = (size_t)layer * 1024 + ch, pop = (size_t)layer * 1024 + chp;
        struct HelpIn { v2u r0, k0, v0, e0, a0, r1, k1, v1, e1, a1, k2, v2, e2, a2, k3; v4u gt; };
        HelpIn cur, nxt;
#define HELP_ROW(H, F_, RR, OFF, ARR, PITCH) (H).F_ = *(const v2u*)((ARR) + ((size_t)b * SEQ + (RR)) * (PITCH) + (OFF) + chp)
#define HELP_LOAD(H, PC, GC) do { \
            if ((PC) < NCH) { const int _t = (PC) * SC + 2 * pr; \
                HELP_ROW(H, r0, _t, 0, ZR, 3072); HELP_ROW(H, k0, _t, 1024, ZR, 3072); HELP_ROW(H, v0, _t, 2048, ZR, 3072); HELP_ROW(H, e0, _t, 0, EW, 1024); HELP_ROW(H, a0, _t, 0, AR, 1024); \
                HELP_ROW(H, r1, _t + 1, 0, ZR, 3072); HELP_ROW(H, k1, _t + 1, 1024, ZR, 3072); HELP_ROW(H, v1, _t + 1, 2048, ZR, 3072); HELP_ROW(H, e1, _t + 1, 0, EW, 1024); HELP_ROW(H, a1, _t + 1, 0, AR, 1024); \
                HELP_ROW(H, k2, _t + 2, 1024, ZR, 3072); HELP_ROW(H, v2, _t + 2, 2048, ZR, 3072); HELP_ROW(H, e2, _t + 2, 0, EW, 1024); HELP_ROW(H, a2, _t + 2, 0, AR, 1024); \
                HELP_ROW(H, k3, _t + 3, 1024, ZR, 3072); } \
            if ((GC) >= 0 && (GC) < NCH) { const size_t _row = (size_t)b * SEQ + (size_t)(GC) * SC + tl; (H).gt = *(const v4u*)(GT + _row * 1024 + ch); } } while (0)
#define UNP4(W) ((f32x4){bflo((W).x), bfhi((W).x), bflo((W).y), bfhi((W).y)})
#define EXP4(E) ((f32x4){__builtin_amdgcn_exp2f(-1.44269504f * (E).x), __builtin_amdgcn_exp2f(-1.44269504f * (E).y), __builtin_amdgcn_exp2f(-1.44269504f * (E).z), __builtin_amdgcn_exp2f(-1.44269504f * (E).w)})
#define DOT4(A, B) (((A).x * (B).x + (A).y * (B).y) + ((A).z * (B).z + (A).w * (B).w))
#define SUM16(X) sum16_ns(X)
#ifdef PROBE_SCAN
        unsigned long long ph_act = 0ull;
#endif
        HELP_LOAD(cur, 0, -2);
        for (int it = 0; it < NCH + 2; ++it) {
#ifdef PROBE_SCAN
            const unsigned long long ph0 = __builtin_amdgcn_s_memtime();
#endif
            HELP_LOAD(nxt, it + 1, it - 1);
            if (it >= 2) {
                const LAS float* buf = bufs + (it & 1) * SC_BUF; const LAS float* yb = sY + (it & 1) * SC_VEC;
                const size_t row = (size_t)b * SEQ + (size_t)(it - 2) * SC + tl; const int o = tl * 64 + c8 * 8;
                f32x4 y_[2], v_[2], g_[2];
#pragma unroll
                for (int i = 0; i < 2; ++i) { y_[i] = *(const LAS f32x4*)(yb + o + 4 * i); v_[i] = *(const LAS f32x4*)(buf + SC_VP + o + 4 * i); }
                const float bon = buf[SC_BON + tl * 8 + c8];
                unpk8(cur.gt, g_[0], g_[1]);
                const float s1 = ((y_[0].x + y_[0].y) + (y_[0].z + y_[0].w)) + ((y_[1].x + y_[1].y) + (y_[1].z + y_[1].w));
                const float mu = sum8(s1) * (1.f / 64.f);
                float s2 = 0.f;
#pragma unroll
                for (int i = 0; i < 2; ++i) { y_[i] = y_[i] - mu; const f32x4 q = y_[i] * y_[i]; s2 += (q.x + q.y) + (q.z + q.w); }
                const float rstd = __builtin_amdgcn_rsqf(sum8(s2) * (1.f / 64.f) + 64e-5f);
                f32x4 o_[2];
#pragma unroll
                for (int i = 0; i < 2; ++i) o_[i] = (y_[i] * rstd * *(const f32x4*)(a.in[14] + po + 4 * i) + *(const f32x4*)(a.in[15] + po + 4 * i) + bon * v_[i]) * g_[i];
                *(v4u*)(YA + row * 1024 + ch) = pk8(o_[0], o_[1]);
            }
            if (it < NCH) {
                LAS float* buf = bufs + (it & 1) * SC_BUF;
                const f32x4 pkk_ = *(const f32x4*)(a.in[11] + pop), pka_ = *(const f32x4*)(a.in[12] + pop), prk_ = *(const f32x4*)(a.in[13] + pop);
                const f32x4 zk0 = UNP4(cur.k0), zk1 = UNP4(cur.k1), zk2 = UNP4(cur.k2), zk3 = UNP4(cur.k3);
                f32x4 kn0 = zk0 * pkk_, kn1 = zk1 * pkk_, kn2 = zk2 * pkk_, kn3 = zk3 * pkk_;
                kn0 = kn0 * __builtin_amdgcn_rsqf(fmaxf(SUM16(DOT4(kn0, kn0)), 1e-24f)); kn1 = kn1 * __builtin_amdgcn_rsqf(fmaxf(SUM16(DOT4(kn1, kn1)), 1e-24f));
                kn2 = kn2 * __builtin_amdgcn_rsqf(fmaxf(SUM16(DOT4(kn2, kn2)), 1e-24f)); kn3 = kn3 * __builtin_amdgcn_rsqf(fmaxf(SUM16(DOT4(kn3, kn3)), 1e-24f));
                const f32x4 r0 = UNP4(cur.r0), r1 = UNP4(cur.r1), v0 = UNP4(cur.v0), v1 = UNP4(cur.v1), v2 = UNP4(cur.v2);
                const f32x4 ar0 = UNP4(cur.a0), ar1 = UNP4(cur.a1), ar2 = UNP4(cur.a2);
                const f32x4 e0 = UNP4(cur.e0), e1 = UNP4(cur.e1), e2 = UNP4(cur.e2);
                const f32x4 w0 = EXP4(e0), w1 = EXP4(e1), w2 = EXP4(e2);
                const f32x4 a1v = -kn1, a2v = -kn2, a3v = -kn3;
                const f32x4 b0 = kn0 * ar0, b1 = kn1 * ar1, b2 = kn2 * ar2;
                const f32x4 kp0 = zk0 * (1.f + (ar0 - 1.f) * pka_), kp1 = zk1 * (1.f + (ar1 - 1.f) * pka_), kp2 = zk2 * (1.f + (ar2 - 1.f) * pka_);
                const f32x4 W2 = w0 * w1, Bt = b0 * w1, Kt = kp0 * w1, x0v = a2v, x1v = w2 * a3v;
                const f32x4 X0 = W2 * x0v, X1 = W2 * x1v, X2 = w0 * r0, X3 = W2 * r1;
                *(LAS f32x4*)(buf + SC_WW + pr * 64 + c4 * 4) = W2;
                *(LAS f32x4*)(buf + SC_VP + (2 * pr) * 64 + c4 * 4) = v0; *(LAS f32x4*)(buf + SC_VP + (2 * pr + 1) * 64 + c4 * 4) = v1;
                { LAS f32x4* vq = (LAS f32x4*)(buf + SC_VQ + pr * 256 + c4 * 16);
                  vq[0] = (f32x4){v0.x, v1.x, v2.x, 0.f}; vq[1] = (f32x4){v0.y, v1.y, v2.y, 0.f}; vq[2] = (f32x4){v0.z, v1.z, v2.z, 0.f}; vq[3] = (f32x4){v0.w, v1.w, v2.w, 0.f}; }
                { LAS v2u* bkp = (LAS v2u*)(buf + SC_BK + pr * 128) + (((c4 & 3) * 4) * 4 + (c4 >> 2));
                  bkp[0] = (v2u){cvt_pk_bf16(Bt.x, Kt.x), cvt_pk_bf16(b1.x, kp1.x)}; bkp[4] = (v2u){cvt_pk_bf16(Bt.y, Kt.y), cvt_pk_bf16(b1.y, kp1.y)};
                  bkp[8] = (v2u){cvt_pk_bf16(Bt.z, Kt.z), cvt_pk_bf16(b1.z, kp1.z)}; bkp[12] = (v2u){cvt_pk_bf16(Bt.w, Kt.w), cvt_pk_bf16(b1.w, kp1.w)}; }
                { LAS unsigned char* xp = (LAS unsigned char*)(buf + SC_XA) + pr * 512 + (c4 >> 3) * 64 + (c4 & 3) * 16 + ((c4 >> 2) & 1) * 8;
                  *(LAS v2u*)xp = (v2u){cvt_pk_bf16(X0.x, X0.y), cvt_pk_bf16(X0.z, X0.w)}; *(LAS v2u*)(xp + 128) = (v2u){cvt_pk_bf16(X1.x, X1.y), cvt_pk_bf16(X1.z, X1.w)};
                  *(LAS v2u*)(xp + 256) = (v2u){cvt_pk_bf16(X2.x, X2.y), cvt_pk_bf16(X2.z, X2.w)}; *(LAS v2u*)(xp + 384) = (v2u){cvt_pk_bf16(X3.x, X3.y), cvt_pk_bf16(X3.z, X3.w)}; }
                const f32x4 ca = (f32x4){SUM16(DOT4(Bt, x0v)), SUM16(DOT4(Kt, x0v)), SUM16(DOT4(b1, x0v)), SUM16(DOT4(kp1, x0v))};
                const f32x4 cb = (f32x4){SUM16(DOT4(Bt, x1v)), SUM16(DOT4(Kt, x1v)), SUM16(DOT4(b1, x1v)), SUM16(DOT4(kp1, x1v))};
                const f32x4 cc = (f32x4){SUM16(DOT4(b2, a3v)), SUM16(DOT4(kp2, a3v)), SUM16(DOT4(b0, r0)), SUM16(DOT4(kp0, r0))};
                const f32x4 cd = (f32x4){SUM16(DOT4(Bt, r1)), SUM16(DOT4(Kt, r1)), SUM16(DOT4(b1, r1)), SUM16(DOT4(kp1, r1))};
                const float ci = SUM16(DOT4(kp0, a1v));
                const f32x4 z0 = r0 * kp0 * prk_, z1 = r1 * kp1 * prk_;
                const float bon0 = SUM16((z0.x + z0.y) + (z0.z + z0.w)), bon1 = SUM16((z1.x + z1.y) + (z1.z + z1.w));
                if (c4 == 0) { LAS f32x4* cp = (LAS f32x4*)(buf + SC_C + pr * 20); cp[0] = ca; cp[1] = cb; cp[2] = cc; cp[3] = cd; cp[4] = (f32x4){ci, 0.f, 0.f, 0.f}; }
                buf[SC_BON + (2 * pr) * 8 + (c4 >> 1)] = bon0; buf[SC_BON + (2 * pr + 1) * 8 + (c4 >> 1)] = bon1;
            }
            cur = nxt;
#ifdef PROBE_SCAN
            asm volatile("s_waitcnt vmcnt(0) lgkmcnt(0)" ::: "memory"); ph_act += __builtin_amdgcn_s_memtime() - ph0;
#endif
            __syncthreads();
        }
#ifdef PROBE_SCAN
        if (unit == 0 && layer == DEPTH - 1 && tid == 256) ((float*)(F.ws + WS_CTL))[2048 + 2] = rintf((float)ph_act / (float)(NCH + 2) * (1.f / 2000.f));
#endif
#undef HELP_LOAD
#undef HELP_ROW
#undef UNP4
#undef EXP4
#undef DOT4
#undef SUM16
    }
}

constexpr int TP = 136;
__device__ __forceinline__ void mma_128(const LAS bf16* sA, const LAS bf16* sBt, int wave, int lane, f32x4 (&acc)[4][2]) {
    const int wm = wave >> 2, wn = wave & 3, fr = lane & 15, fq = lane >> 4;
#pragma unroll
    for (int kk = 0; kk < 4; ++kk) {
        bf16x8 af[4], bf_[2];
#pragma unroll
        for (int mt = 0; mt < 4; ++mt) af[mt] = *(const LAS bf16x8*)(sA + (64 * wm + 16 * mt + fr) * TP + 32 * kk + 8 * fq);
#pragma unroll
        for (int nt = 0; nt < 2; ++nt) bf_[nt] = *(const LAS bf16x8*)(sBt + (32 * wn + 16 * nt + fr) * TP + 32 * kk + 8 * fq);
#pragma unroll
        for (int mt = 0; mt < 4; ++mt)
#pragma unroll
            for (int nt = 0; nt < 2; ++nt) acc[mt][nt] = __builtin_amdgcn_mfma_f32_16x16x32_bf16(bf_[nt], af[mt], acc[mt][nt], 0, 0, 0);
    }
}
__device__ __forceinline__ void gmlp_unit(Frame& F, const Args& a, int layer, int unit) {
    phase_ids(F);
    const size_t t0 = (size_t)unit * 128; const int tid = F.tid, lane = F.lane, wave = F.wave;
    LAS float* st = (LAS float*)F.lds; LAS bf16* sA = (LAS bf16*)(F.lds + 1024); LAS bf16* sB = (LAS bf16*)(F.lds + 1024 + 128 * TP * 2);
    bf16* GUV = (bf16*)(F.ws + WS_GUV); const bf16* GMW = (const bf16*)(F.ws + WS_DB + (size_t)(layer & 1) * DB_SET + DB_GMW);
    const float* lng = a.in[19] + (size_t)layer * 1024; const float* lnb = a.in[20] + (size_t)layer * 1024; const float* bsp = a.in[22] + (size_t)layer * 1024;
    for (int r = 0; r < 16; ++r) { const int tok = wave * 16 + r; const bf16* rowp = GUV + (t0 + tok) * 2048 + 1024;
        f32x4 x0, x1, x2, x3; unpk8(*(const v4u*)(rowp + lane * 8), x0, x1); unpk8(*(const v4u*)(rowp + 512 + lane * 8), x2, x3);
        const f32x4 sv = (x0 + x1) + (x2 + x3), qv = (x0 * x0 + x1 * x1) + (x2 * x2 + x3 * x3);
        const float s = wave_sum((sv.x + sv.y) + (sv.z + sv.w)), q = wave_sum((qv.x + qv.y) + (qv.z + qv.w));
        const float mean = s * (1.f / 1024.f), var = fmaxf(q * (1.f / 1024.f) - mean * mean, 0.f);
        if (lane == 0) { st[tok * 2] = mean; st[tok * 2 + 1] = 1.f / sqrtf(var + 1e-5f); } }
    __syncthreads();
    for (int g = 0; g < 8; ++g) {
#pragma unroll
        for (int i = 0; i < 4; ++i) { const int pc = tid + 512 * i, rr = pc >> 4, c16 = pc & 15;
            *(LAS v4u*)(sA + rr * TP + c16 * 8) = *(const v4u*)(GMW + (size_t)g * 16384 + rr * 128 + c16 * 8); }
        { const int p = tid & 127, oc0 = tid >> 7; const float mean = st[p * 2], rstd = st[p * 2 + 1];
#pragma unroll
          for (int i = 0; i < 4; ++i) { const int oc = oc0 + 4 * i, c0 = g * 128 + oc * 8;
              f32x4 x0, x1; unpk8(*(const v4u*)(GUV + (t0 + p) * 2048 + 1024 + c0), x0, x1);
              const f32x4 g0 = *(const f32x4*)(lng + c0), g1 = *(const f32x4*)(lng + c0 + 4), b0 = *(const f32x4*)(lnb + c0), b1 = *(const f32x4*)(lnb + c0 + 4);
              x0 = (x0 - mean) * rstd * g0 + b0; x1 = (x1 - mean) * rstd * g1 + b1;
              const v4u w = pk8(x0, x1);
              LAS bf16* d = sB + (oc * 8) * TP + p;
              d[0 * TP] = (bf16)(w.x & 0xffffu); d[1 * TP] = (bf16)(w.x >> 16); d[2 * TP] = (bf16)(w.y & 0xffffu); d[3 * TP] = (bf16)(w.y >> 16);
              d[4 * TP] = (bf16)(w.z & 0xffffu); d[5 * TP] = (bf16)(w.z >> 16); d[6 * TP] = (bf16)(w.w & 0xffffu); d[7 * TP] = (bf16)(w.w >> 16); } }
        __syncthreads();
        f32x4 acc[4][2];
#pragma unroll
        for (int mt = 0; mt < 4; ++mt)
#pragma unroll
            for (int nt = 0; nt < 2; ++nt) acc[mt][nt] = (f32x4){0.f, 0.f, 0.f, 0.f};
        mma_128(sA, sB, wave, lane, acc);
        { const int wm = wave >> 2, wn = wave & 3, fr = lane & 15, fq = lane >> 4;
#pragma unroll
          for (int mt = 0; mt < 4; ++mt) { const int tt = 64 * wm + 16 * mt + fr; const float bsv = bsp[g * 128 + tt];
#pragma unroll
              for (int nt = 0; nt < 2; ++nt) { const int c = g * 128 + 32 * wn + 16 * nt + 4 * fq;
                  const v2u uw = *(const v2u*)(GUV + (t0 + tt) * 2048 + c);
                  const f32x4 u4 = (f32x4){bflo(uw.x), bfhi(uw.x), bflo(uw.y), bfhi(uw.y)};
                  const f32x4 yb = u4 * (acc[mt][nt] + bsv);
                  v2u ow; ow.x = cvt_pk_bf16(yb.x, yb.y); ow.y = cvt_pk_bf16(yb.z, yb.w);
                  *(v2u*)(GUV + (t0 + tt) * 2048 + c) = ow; } } }
        __syncthreads();
    }
}

__device__ __forceinline__ unsigned fkey(float f) { const unsigned u = __builtin_bit_cast(unsigned, f); return (u & 0x80000000u) ? ~u : (u | 0x80000000u); }
__device__ __forceinline__ float kval(unsigned k, unsigned mask) { const unsigned u = k & mask; return __builtin_bit_cast(float, (u & 0x80000000u) ? (u ^ 0x80000000u) : ~u); }
__device__ __forceinline__ float swap32_add(float a, float b) { const auto r = __builtin_amdgcn_permlane32_swap(__builtin_bit_cast(unsigned, a), __builtin_bit_cast(unsigned, b), false, false);
    return __builtin_bit_cast(float, (unsigned)r[0]) + __builtin_bit_cast(float, (unsigned)r[1]); }
__device__ __forceinline__ float swap16_add(float a, float b) { const auto r = __builtin_amdgcn_permlane16_swap(__builtin_bit_cast(unsigned, a), __builtin_bit_cast(unsigned, b), false, false);
    return __builtin_bit_cast(float, (unsigned)r[0]) + __builtin_bit_cast(float, (unsigned)r[1]); }
__device__ __forceinline__ float row_sum16(float x) {
    x += __builtin_bit_cast(float, __builtin_amdgcn_update_dpp(0, __builtin_bit_cast(int, x), 0x128, 0xf, 0xf, false));
    x += __builtin_bit_cast(float, __builtin_amdgcn_update_dpp(0, __builtin_bit_cast(int, x), 0x124, 0xf, 0xf, false));
    x += __builtin_bit_cast(float, __builtin_amdgcn_update_dpp(0, __builtin_bit_cast(int, x), 0x122, 0xf, 0xf, false));
    x += __builtin_bit_cast(float, __builtin_amdgcn_update_dpp(0, __builtin_bit_cast(int, x), 0x121, 0xf, 0xf, false));
    return x; }
#define CE_DESC(a, b) do { const unsigned _h = max((a), (b)), _l = min((a), (b)); (a) = _h; (b) = _l; } while (0)
template <int OFF> __device__ __forceinline__ void bitonic_merge16(unsigned (&x)[32]) {
#pragma unroll
    for (int j = 8; j >= 1; j >>= 1)
#pragma unroll
        for (int i = 0; i < 16; ++i) { const int l = i ^ j; if (l > i) CE_DESC(x[OFF + i], x[OFF + l]); }
}
template <int OFF> __device__ __forceinline__ void bitonic_sort16(unsigned (&x)[32]) {
#pragma unroll
    for (int k = 2; k <= 16; k <<= 1)
#pragma unroll
        for (int j = k >> 1; j >= 1; j >>= 1)
#pragma unroll
            for (int i = 0; i < 16; ++i) { const int l = i ^ j; if (l > i) { if ((i & k) == 0 || k == 16) CE_DESC(x[OFF + i], x[OFF + l]); else CE_DESC(x[OFF + l], x[OFF + i]); } }
}
#ifndef REP_K
#define REP_K 1
#endif
#define TOP_INSERT(top, x) do { unsigned _x = (x); _Pragma("unroll") for (int _j = 0; _j < 16; ++_j) { const unsigned _h = max((top)[_j], _x); _x = min((top)[_j], _x); (top)[_j] = _h; } } while (0)
__device__ __forceinline__ void peer_token_end(Frame& F, const Args& a, int layer, bool last, bool final_half, size_t tok, int lane, const f32x2 (&out)[8], const f32x4 (&hpre)[4], const v4u (&gpre)[2]) {
    float* hp = F.h + tok * 1024 + 16 * lane;
    f32x4 hv[4], ge[4]; float s = 0.f;
    unpk8(gpre[0], ge[0], ge[1]); unpk8(gpre[1], ge[2], ge[3]);
    if (!final_half) {
        bf16* gp = (bf16*)(F.ws + WS_PW) + tok * 1024 + 16 * lane;
        *(v4u*)gp = pk8(ge[0] + (f32x4){out[0].x, out[0].y, out[1].x, out[1].y}, ge[1] + (f32x4){out[2].x, out[2].y, out[3].x, out[3].y});
        *(v4u*)(gp + 8) = pk8(ge[2] + (f32x4){out[4].x, out[4].y, out[5].x, out[5].y}, ge[3] + (f32x4){out[6].x, out[6].y, out[7].x, out[7].y});
        return; }
#pragma unroll
    for (int i = 0; i < 4; ++i) { hv[i] = hpre[i] + ge[i] + (f32x4){out[2 * i].x, out[2 * i].y, out[2 * i + 1].x, out[2 * i + 1].y};
        s += (hv[i].x * hv[i].x + hv[i].y * hv[i].y) + (hv[i].z * hv[i].z + hv[i].w * hv[i].w); }
    const float rstd = 1.f / sqrtf(wave_sum(s) * (1.f / D) + 1e-6f);
    const float* g = (last ? a.in[4] : a.in[2] + (size_t)(layer + 1) * 1024) + 16 * lane;
    f32x4 o[4];
#pragma unroll
    for (int i = 0; i < 4; ++i) o[i] = hv[i] * rstd * *(const f32x4*)(g + 4 * i);
    if (last) {
#ifdef PROBE_SCAN
        { const float pv = ((const float*)(F.ws + WS_CTL))[2048 + PROBE_SCAN - 1];
#pragma unroll
          for (int i = 0; i < 4; ++i) o[i] = o[i] + pv; }
#endif
#pragma unroll
        for (int i = 0; i < 4; ++i) *(f32x4*)(hp + 4 * i) = o[i];
    } else {
#pragma unroll
        for (int i = 0; i < 4; ++i) *(f32x4*)(hp + 4 * i) = hv[i];
        bf16* NX = (bf16*)(F.ws + WS_NX); const v4u w0 = pk8(o[0], o[1]), w1 = pk8(o[2], o[3]); const int tt = (int)(tok & (SEQ - 1));
        *(v4u*)(NX + tok * 2048 + 16 * lane) = w0; *(v4u*)(NX + tok * 2048 + 16 * lane + 8) = w1;
        if (tt != SEQ - 1) { *(v4u*)(NX + (tok + 1) * 2048 + 1024 + 16 * lane) = w0; *(v4u*)(NX + (tok + 1) * 2048 + 1024 + 16 * lane + 8) = w1; }
        if (tt == 0) { *(v4u*)(NX + tok * 2048 + 1024 + 16 * lane) = (v4u){0u, 0u, 0u, 0u}; *(v4u*)(NX + tok * 2048 + 1024 + 16 * lane + 8) = (v4u){0u, 0u, 0u, 0u}; }
    }
}
__device__ __forceinline__ void peer_unit(Frame& F, const Args& a, int layer, int unit, bool last) {
    phase_ids(F);
    const size_t t0 = (size_t)unit * 128; const int tid = F.tid, lane = F.lane, wave = F.wave, fr = lane & 15, fq = lane >> 4;
    LAS bf16* sKey = (LAS bf16*)F.lds;
    LAS unsigned* sLT = (LAS unsigned*)(F.lds + 2 * 128 * TP * 2) + wave * 512;
    const bf16* Q = (const bf16*)(F.ws + WS_Q); const bf16* KEYS = (const bf16*)(F.ws + WS_DB + (size_t)(layer & 1) * DB_SET + DB_KEYS); v2u* SEL = (v2u*)(F.ws + WS_SEL);
    const size_t trow = t0 + wave * 16 + fr;
    constexpr float KOFF = 32.f;
    v4u ktn[4]; bf16x8 qfn[4];
#define K_FETCH(J) do { _Pragma("unroll") for (int _i = 0; _i < 4; ++_i) { const int _pc = tid + 512 * _i, _rr = _pc >> 4, _c16 = _pc & 15; ktn[_i] = *(const v4u*)(KEYS + (size_t)(J) * 16384 + _rr * 128 + _c16 * 8); } \
        _Pragma("unroll") for (int _kk = 0; _kk < 4; ++_kk) qfn[_kk] = *(const bf16x8*)(Q + trow * 2048 + (J) * 128 + 32 * _kk + 8 * fq); } while (0)
#define K_STORE(J) do { _Pragma("unroll") for (int _i = 0; _i < 4; ++_i) { const int _pc = tid + 512 * _i, _rr = _pc >> 4, _c16 = _pc & 15; *(LAS v4u*)(sKey + ((J) & 1) * 128 * TP + _rr * TP + _c16 * 8) = ktn[_i]; } } while (0)
    for (int krep = 0; krep < REP_K; ++krep) {
    __syncthreads();
    K_FETCH(0); K_STORE(0);
    bf16x8 qf[4];
#pragma unroll
    for (int kk = 0; kk < 4; ++kk) qf[kk] = qfn[kk];
    __syncthreads();
    for (int hd = 0; hd < 8; ++hd) {
        for (int p = 0; p < 2; ++p) {
            const int jp = hd * 2 + p;
            if (jp + 1 < 16) K_FETCH(jp + 1);
            const LAS bf16* sKc = sKey + (jp & 1) * 128 * TP;
            f32x4 sc[8];
#pragma unroll
            for (int nt = 0; nt < 8; ++nt) sc[nt] = (f32x4){KOFF, KOFF, KOFF, KOFF};
#pragma unroll
            for (int kk = 0; kk < 4; ++kk)
#pragma unroll
                for (int nt = 0; nt < 8; ++nt) { const bf16x8 kf = *(const LAS bf16x8*)(sKc + (16 * nt + fr) * TP + 32 * kk + 8 * fq);
                    sc[nt] = __builtin_amdgcn_mfma_f32_16x16x32_bf16(kf, qf[kk], sc[nt], 0, 0, 0); }
            unsigned t[32];
#pragma unroll
            for (int nt = 0; nt < 8; ++nt)
#pragma unroll
                for (int rg = 0; rg < 4; ++rg) t[4 * nt + rg] = (__float_as_uint(sc[nt][rg]) & 0xFFFFFF80u) | (unsigned)(16 * nt + 4 * fq + rg);
            bitonic_sort16<0>(t); bitonic_sort16<16>(t);
#pragma unroll
            for (int j = 0; j < 16; ++j) t[j] = max(t[j], t[31 - j]);
            bitonic_merge16<0>(t);
#pragma unroll
            for (int rnd = 0; rnd < 2; ++rnd) {
#pragma unroll
                for (int j = 0; j < 16; ++j) t[16 + j] = rnd ? xor32_u(t[j], lane) : xor16_u(t[j], lane);
#pragma unroll
                for (int j = 0; j < 16; ++j) t[j] = max(t[j], t[31 - j]);
                bitonic_merge16<0>(t); }
#pragma unroll
            for (int j = 0; j < 16; ++j) sLT[fr * 32 + p * 16 + j] = t[j];
            if (jp + 1 < 16) { K_STORE(jp + 1);
#pragma unroll
                for (int kk = 0; kk < 4; ++kk) qf[kk] = qfn[kk]; }
            __syncthreads();
        }
        float v0[16], v1[16];
#pragma unroll
        for (int j = 0; j < 16; ++j) { v0[j] = __uint_as_float(sLT[fr * 32 + j] & 0xFFFFFF80u); v1[j] = __uint_as_float(sLT[fr * 32 + 16 + j] & 0xFFFFFF80u); }
        unsigned best[32];
#define CKEY(i, j) ((__float_as_uint(v0[i] + v1[j]) & 0xFFFFFF00u) | (unsigned)((i) * 16 + (j)))
#pragma unroll
        for (int j = 0; j < 16; ++j) best[j] = CKEY(0, j);
#pragma unroll
        for (int i = 1; i < 16; ++i) best[16 - i] = max(best[16 - i], CKEY(i, 0));
        bitonic_merge16<0>(best);
#pragma unroll
        for (int j = 1; j < 8; ++j) best[16 - j] = max(best[16 - j], CKEY(1, j));
        bitonic_merge16<0>(best);
#pragma unroll
        for (int i = 2; i < 8; ++i) best[17 - i] = max(best[17 - i], CKEY(i, 1));
        bitonic_merge16<0>(best);
        { unsigned r6[6] = {CKEY(2, 2), CKEY(2, 3), CKEY(2, 4), CKEY(3, 2), CKEY(3, 3), CKEY(4, 2)};
          CE_DESC(r6[0], r6[5]); CE_DESC(r6[1], r6[3]); CE_DESC(r6[2], r6[4]); CE_DESC(r6[1], r6[2]); CE_DESC(r6[3], r6[4]); CE_DESC(r6[0], r6[3]);
          CE_DESC(r6[2], r6[5]); CE_DESC(r6[0], r6[1]); CE_DESC(r6[2], r6[3]); CE_DESC(r6[4], r6[5]); CE_DESC(r6[1], r6[2]); CE_DESC(r6[3], r6[4]);
#pragma unroll
          for (int k = 0; k < 6; ++k) best[15 - k] = max(best[15 - k], r6[k]); }
        bitonic_merge16<0>(best);
#undef CKEY
        float ev[16], esum = 0.f; const float mx = __uint_as_float(best[0] & 0xFFFFFF00u);
#pragma unroll
        for (int k = 0; k < 16; ++k) { ev[k] = __builtin_amdgcn_exp2f((__uint_as_float(best[k] & 0xFFFFFF00u) - mx) * 1.44269504f); esum += ev[k]; }
        const float einv = 1.f / esum;
#pragma unroll
        for (int k = 0; k < 16; ++k) { const unsigned pos = best[k] & 255u;
            const unsigned i0 = sLT[fr * 32 + (pos >> 4)] & 127u, i1 = sLT[fr * 32 + 16 + (pos & 15u)] & 127u;
            if ((k >> 2) == fq) SEL[trow * 128 + hd * 16 + k] = (v2u){i0 * 128u + i1, __builtin_bit_cast(unsigned, ev[k] * einv)}; }
    }
    }
#undef K_FETCH
#undef K_STORE
    asm volatile("s_waitcnt vmcnt(0)" ::: "memory");
    __syncthreads();
    const bf16* N2 = (const bf16*)(F.ws + WS_N2); const unsigned char* U8 = (const unsigned char*)(F.ws + WS_DB + (size_t)(layer & 1) * DB_SET + DB_U); const unsigned char* V8 = (const unsigned char*)(F.ws + WS_DB + (size_t)(layer & 1) * DB_SET + DB_V);
    unsigned* SELW = (unsigned*)SEL;
    LAS float* sCoef = (LAS float*)F.lds + wave * 2048;
    LAS unsigned* sSort = sLT;
    const size_t tokb = t0 + wave * 16;
    unsigned cnts = 0u;
    v4u se_pf = *(const v4u*)(SELW + tokb * 256 + 4 * lane);
    for (int it = 0; it < 16; ++it) {
        const v4u se = se_pf;
        if (it < 15) se_pf = *(const v4u*)(SELW + (tokb + it + 1) * 256 + 4 * lane);
        const unsigned b0 = se.x >> 12, b1 = se.z >> 12;
        unsigned pos0 = 0u, pos1 = 0u, base = 0u, pk = 0u;
#pragma unroll
        for (unsigned k = 0; k < 4; ++k) {
            const unsigned long long m0 = __builtin_amdgcn_ballot_w64(b0 == k), m1 = __builtin_amdgcn_ballot_w64(b1 == k);
            const unsigned below = __builtin_amdgcn_mbcnt_hi((unsigned)(m0 >> 32), __builtin_amdgcn_mbcnt_lo((unsigned)m0, 0u)) + __builtin_amdgcn_mbcnt_hi((unsigned)(m1 >> 32), __builtin_amdgcn_mbcnt_lo((unsigned)m1, 0u));
            if (b0 == k) pos0 = base + below;
            if (b1 == k) pos1 = base + below + (b0 == k ? 1u : 0u);
            base += (unsigned)__builtin_popcountll(m0) + (unsigned)__builtin_popcountll(m1);
            if (k < 3) pk |= base << (8 * k);
        }
#ifdef DBG_NOSORT
        pos0 = 2 * lane; pos1 = 2 * lane + 1;
#endif
        *(LAS v2u*)(sSort + 2 * pos0) = (v2u){se.x, se.y}; *(LAS v2u*)(sSort + 2 * pos1) = (v2u){se.z, se.w};
        asm volatile("" ::: "memory");
        const v2u so0 = *(const LAS v2u*)(sSort + 4 * lane), so1 = *(const LAS v2u*)(sSort + 4 * lane + 2); const v4u so = (v4u){so0.x, so0.y, so1.x, so1.y};
        asm volatile("" ::: "memory");
#ifndef DBG_NOSTORE
        *(v4u*)(SELW + (tokb + it) * 256 + 4 * lane) = so;
#endif
        { const unsigned g0 = so0.y, g1 = so1.y; sCoef[it * 128 + 2 * lane] = __uint_as_float(g0); sCoef[it * 128 + 2 * lane + 1] = __uint_as_float(g1); }
        if (lane == it) cnts = pk;
    }
    asm volatile("s_waitcnt vmcnt(0) lgkmcnt(0)" ::: "memory");
#ifdef DBG_NOBUCKET
    cnts = 0u;
#endif
#define PL_LOAD(RB, TAB, SE, BB) do { _Pragma("unroll") for (int _q = 0; _q < 16; ++_q) { \
        const unsigned _idx = (unsigned)__builtin_amdgcn_readlane((int)((_q & 1) ? (SE).z : (SE).x), (BB) * 8 + (_q >> 1)); \
        (RB)[_q] = *(const v4u*)((TAB) + (size_t)_idx * 1024 + 16 * lane); } } while (0)
#define PL_LOAD_U(RB, SE, BB) do { const int _src = ((BB) * 8 + ((lane & 15) >> 1)) * 4; \
        const unsigned _ix = (unsigned)__builtin_amdgcn_ds_bpermute(_src, (int)(SE).x), _iz = (unsigned)__builtin_amdgcn_ds_bpermute(_src, (int)(SE).z); \
        const unsigned char* _p = U8 + (size_t)((lane & 1) ? _iz : _ix) * 1024 + 32 * (lane >> 4); \
        _Pragma("unroll") for (int _j = 0; _j < 16; ++_j) (RB)[_j] = *(const v4u*)(_p + 128 * (_j >> 1) + 16 * (_j & 1)); } while (0)
#define PL_RANGE(T, P, NP, RLO, RHI, BLO, BHI) const unsigned _pk##T = (unsigned)__builtin_amdgcn_readlane((int)cnts, (T)); \
        const int _sp##T = min((int)((((_pk##T >> 8) & 255u) + 15u) & ~15u), 128);     \
        const int RLO = (P) == 0 ? 0 : _sp##T, RHI = (P) == 0 ? _sp##T : 128; \
        const int BLO = min(RLO >> 4, 7), BHI = max((RHI + 15) >> 4, BLO + 1)
    v4u ra[16], rb[16];
#ifndef DBG_U0
#define DBG_U0 0
#define DBG_V0 0
#endif
    for (int ps = DBG_U0; ps < 2; ++ps) {
        int lt = 0, lb, lbh; { PL_RANGE(lt, ps, 2, r0, r1, b0_, b1_); lb = b0_; lbh = b1_; (void)r0; (void)r1; }
        v4u seL = *(const v4u*)(SELW + tokb * 256 + 4 * lane), seN = *(const v4u*)(SELW + (tokb + 1) * 256 + 4 * lane);
        long xlo = 0, xhi = 0; const bool dsel = ((lane >> 2) & 3) == (lane >> 4); v4u nraw0, nraw1, nnx0 = *(const v4u*)(N2 + tokb * 1024 + 16 * lane), nnx1 = *(const v4u*)(N2 + tokb * 1024 + 16 * lane + 8);
        int ct, cb, crl = 0, crh = 0, cbl = 0;
#define U_ADV() do { ++lb; if (lb >= lbh) { ++lt; if (lt < 16) { PL_RANGE(lt, ps, 2, _r0, _r1, _b0, _b1); lb = _b0; lbh = _b1; (void)_r0; (void)_r1; seL = seN; if (lt + 1 < 16) seN = *(const v4u*)(SELW + (tokb + lt + 1) * 256 + 4 * lane); } } } while (0)
#define U_COMPUTE(RB) do { \
            if (cb == cbl) { nraw0 = nnx0; nraw1 = nnx1; if (ct + 1 < 16) { nnx0 = *(const v4u*)(N2 + (tokb + ct + 1) * 1024 + 16 * lane); nnx1 = *(const v4u*)(N2 + (tokb + ct + 1) * 1024 + 16 * lane + 8); } \
                f32x4 x0, x1, x2, x3; unpk8(nraw0, x0, x1); unpk8(nraw1, x2, x3); x0 = x0 * 16.f; x1 = x1 * 16.f; x2 = x2 * 16.f; x3 = x3 * 16.f; \
                int _w0 = 0, _w1 = 0, _w2 = 0, _w3 = 0; \
                _w0 = __builtin_amdgcn_cvt_pk_fp8_f32(x0.x, x0.y, _w0, false); _w0 = __builtin_amdgcn_cvt_pk_fp8_f32(x0.z, x0.w, _w0, true); \
                _w1 = __builtin_amdgcn_cvt_pk_fp8_f32(x1.x, x1.y, _w1, false); _w1 = __builtin_amdgcn_cvt_pk_fp8_f32(x1.z, x1.w, _w1, true); \
                _w2 = __builtin_amdgcn_cvt_pk_fp8_f32(x2.x, x2.y, _w2, false); _w2 = __builtin_amdgcn_cvt_pk_fp8_f32(x2.z, x2.w, _w2, true); \
                _w3 = __builtin_amdgcn_cvt_pk_fp8_f32(x3.x, x3.y, _w3, false); _w3 = __builtin_amdgcn_cvt_pk_fp8_f32(x3.z, x3.w, _w3, true); \
                xlo = (long)(((unsigned long long)(unsigned)_w1 << 32) | (unsigned)_w0); xhi = (long)(((unsigned long long)(unsigned)_w3 << 32) | (unsigned)_w2); } \
            _Pragma("unroll") for (int _g = 0; _g < 2; ++_g) { float _p[8]; \
                _Pragma("unroll") for (int _q = 0; _q < 8; ++_q) { f32x4 _d = (f32x4){0.f, 0.f, 0.f, 0.f}; \
                    _d = __builtin_amdgcn_mfma_f32_16x16x32_fp8_fp8((long)(((unsigned long long)(RB)[8 * _g + _q].y << 32) | (RB)[8 * _g + _q].x), xlo, _d, 0, 0, 0); \
                    _d = __builtin_amdgcn_mfma_f32_16x16x32_fp8_fp8((long)(((unsigned long long)(RB)[8 * _g + _q].w << 32) | (RB)[8 * _g + _q].z), xhi, _d, 0, 0, 0); \
                    const float _sl = (lane & 2) ? ((lane & 1) ? _d.w : _d.z) : ((lane & 1) ? _d.y : _d.x); \
                    _p[_q] = dsel ? _sl : 0.f; }     \
                const float _s0 = swap32_add(_p[0], _p[4]), _s1 = swap32_add(_p[1], _p[5]), _s2 = swap32_add(_p[2], _p[6]), _s3 = swap32_add(_p[3], _p[7]); \
                float _t0 = row_sum16(swap16_add(_s0, _s2)), _t1 = row_sum16(swap16_add(_s1, _s3)); \
                _t0 = fgelu(_t0 * (1.f / 4096.f)) * (1.f / 64.f); _t1 = fgelu(_t1 * (1.f / 4096.f)) * (1.f / 64.f); \
                if ((lane & 15) == 0) { const int _r = lane >> 4, _e = cb * 16 + 8 * _g + 2 * (_r & 1) + 4 * (_r >> 1); LAS float* _c = sCoef + ct * 128 + _e; \
                    if (_e >= crl && _e < crh) _c[0] *= _t0; if (_e + 1 >= crl && _e + 1 < crh) _c[1] *= _t1; } } } while (0)
#define U_SETC() do { ct = lt; cb = lb; { PL_RANGE(ct, ps, 2, _r0, _r1, _b0, _b1); crl = _r0; crh = _r1; cbl = _b0; (void)_b1; } } while (0)
        PL_LOAD(ra, U8, seL, lb);
        U_SETC(); U_ADV();
        for (;;) {
            if (lt < 16) PL_LOAD(rb, U8, seL, lb);
            U_COMPUTE(ra);
            if (lt >= 16) break;
            U_SETC(); U_ADV();
            if (lt < 16) PL_LOAD(ra, U8, seL, lb);
            U_COMPUTE(rb);
            if (lt >= 16) break;
            U_SETC(); U_ADV();
        }
        asm volatile("s_waitcnt lgkmcnt(0)" ::: "memory");
        __syncthreads();
    }
#undef U_ADV
#undef U_COMPUTE
#undef U_SETC
    for (int ps = DBG_V0; ps < 2; ++ps) {
        int lt = 0, lb, lbh; { PL_RANGE(lt, ps, 2, r0, r1, b0_, b1_); lb = b0_; lbh = b1_; (void)r0; (void)r1; }
        v4u seL = *(const v4u*)(SELW + tokb * 256 + 4 * lane), seN = *(const v4u*)(SELW + (tokb + 1) * 256 + 4 * lane);
        f32x2 out[8]; f32x4 hpre[4] = {(f32x4){0.f, 0.f, 0.f, 0.f}, (f32x4){0.f, 0.f, 0.f, 0.f}, (f32x4){0.f, 0.f, 0.f, 0.f}, (f32x4){0.f, 0.f, 0.f, 0.f}}, ac4[4]; v4u gpre[2] = {(v4u){0u, 0u, 0u, 0u}, (v4u){0u, 0u, 0u, 0u}}; const bf16* PWG = (const bf16*)(F.ws + WS_PW);
        const unsigned vmask = ((lane >> 4) == ((lane & 15) >> 2)) ? (0xFFu << (8 * (lane & 3))) : 0u;
        int ct, cb, crl = 0, crh = 0, cbl = 0, cbh = 0;
#define V_ADV() do { ++lb; if (lb >= lbh) { ++lt; if (lt < 16) { PL_RANGE(lt, ps, 2, _r0, _r1, _b0, _b1); lb = _b0; lbh = _b1; (void)_r0; (void)_r1; seL = seN; if (lt + 1 < 16) seN = *(const v4u*)(SELW + (tokb + lt + 1) * 256 + 4 * lane); } } } while (0)
#define V_SETC() do { ct = lt; cb = lb; { PL_RANGE(ct, ps, 2, _r0, _r1, _b0, _b1); crl = _r0; crh = _r1; cbl = _b0; cbh = _b1; } } while (0)
#ifndef REP_LV
#define REP_LV 1
#endif
#define V_COMPUTE(RB) do { \
            if (cb == cbl) { _Pragma("unroll") for (int _i = 0; _i < 4; ++_i) { ac4[_i] = (f32x4){0.f, 0.f, 0.f, 0.f}; if (ps == 1) hpre[_i] = *(const f32x4*)(F.h + (tokb + ct) * 1024 + 16 * lane + 4 * _i); } \
                gpre[0] = *(const v4u*)(PWG + (tokb + ct) * 1024 + 16 * lane); gpre[1] = *(const v4u*)(PWG + (tokb + ct) * 1024 + 16 * lane + 8); }     \
            _Pragma("unroll") for (int _q = 0; _q < 16; ++_q) { const int _e = cb * 16 + _q; \
                float _c = sCoef[ct * 128 + _e]; _c = (_e >= crl && _e < crh) ? _c * 2048.f : 0.f; \
                int _w = __builtin_amdgcn_cvt_pk_fp8_f32(_c, _c, 0, false); _w = __builtin_amdgcn_cvt_pk_fp8_f32(_c, _c, _w, true); const unsigned _x = (unsigned)_w & vmask; \
                const long _ae = (long)(unsigned long long)_x, _ao = (long)((unsigned long long)_x << 32); \
                const long _bl = (long)(((unsigned long long)(RB)[_q].y << 32) | (RB)[_q].x), _bh = (long)(((unsigned long long)(RB)[_q].w << 32) | (RB)[_q].z); \
                ac4[0] = __builtin_amdgcn_mfma_f32_16x16x32_fp8_fp8(_ae, _bl, ac4[0], 0, 0, 0); ac4[1] = __builtin_amdgcn_mfma_f32_16x16x32_fp8_fp8(_ao, _bl, ac4[1], 0, 0, 0); \
                ac4[2] = __builtin_amdgcn_mfma_f32_16x16x32_fp8_fp8(_ae, _bh, ac4[2], 0, 0, 0); ac4[3] = __builtin_amdgcn_mfma_f32_16x16x32_fp8_fp8(_ao, _bh, ac4[3], 0, 0, 0); } \
            if (cb == cbh - 1) { _Pragma("unroll") for (int _i = 0; _i < 4; ++_i) { out[2 * _i] = (f32x2){ac4[_i].x, ac4[_i].y} * (1.f / 2048.f); out[2 * _i + 1] = (f32x2){ac4[_i].z, ac4[_i].w} * (1.f / 2048.f); } \
                peer_token_end(F, a, layer, last, ps == 1, tokb + ct, lane, out, hpre, gpre); } } while (0)
        PL_LOAD(ra, V8, seL, lb);
        V_SETC(); V_ADV();
        for (;;) {
            if (lt < 16) PL_LOAD(rb, V8, seL, lb);
            V_COMPUTE(ra);
            if (lt >= 16) break;
            V_SETC(); V_ADV();
            if (lt < 16) PL_LOAD(ra, V8, seL, lb);
            V_COMPUTE(rb);
            if (lt >= 16) break;
            V_SETC(); V_ADV();
        }
        asm volatile("s_waitcnt vmcnt(0)" ::: "memory");
        __syncthreads();
    }
#undef V_ADV
#undef V_SETC
#undef V_COMPUTE
#undef PL_LOAD
#undef PL_RANGE
}


#ifndef ZSKIP
#define ZSKIP 0
#endif
#ifndef ZGA_ALIGN
#define ZGA_ALIGN true
#endif
#ifndef ZGA_SP2
#define ZGA_SP2 true
#endif
#ifndef WIN_ALIGN
#define WIN_ALIGN true
#endif
#ifndef WIN_SP2
#define WIN_SP2 true
#endif
#ifndef REP_E
#define REP_E 1
#endif
#ifndef REP_A
#define REP_A 1
#endif
#ifndef REP_B
#define REP_B 1
#endif
#ifndef REP_C
#define REP_C 1
#endif
#ifndef REP_D
#define REP_D 1
#endif
#ifndef REP_G
#define REP_G 1
#endif
#ifndef REP_I
#define REP_I 1
#endif
#ifndef REP_K
#define REP_K 1
#endif
__global__ void __launch_bounds__(NWAVES * 64, 2) trunk_fwd(Args args) {
    extern __shared__ __attribute__((aligned(16))) unsigned char lds[];
    Frame F;
    F.lds = (LAS unsigned char*)lds;
    F.tid = threadIdx.x; F.lane = F.tid & 63; F.wave = __builtin_amdgcn_readfirstlane(F.tid >> 6); F.wave0 = F.wave;
    F.G = gridDim.x; F.bx = blockIdx.x; F.ws = (GAS unsigned char*)args.ws; F.h = args.out;
    volatile LAS unsigned* MISC = (volatile LAS unsigned*)(F.lds + MISC_OFF);
    for (int u = F.tid; u < (LDS_BYTES - LDSCTL_OFF) / 4; u += NWAVES * 64) ((LAS unsigned*)(F.lds + LDSCTL_OFF))[u] = 0u;
    __syncthreads();
    unsigned* ctl = (unsigned*)(F.ws + WS_CTL);
    XcdBarrier bar = xcd_barrier_post(ctl + CW_BAR, MISC + 8);
    GAS unsigned char* ws = F.ws;
    LAS unsigned char* ring = (LAS unsigned char*)F.lds;

    for (int rep = 0; rep < REP_A; ++rep) { prep_phase(F, args, 0, F.bx, F.G, 1);
    xcd_barrier(bar, F.wave0); }
#define OPQ() GAS unsigned char* ws = F.ws; asm volatile("" : "+s"(ws)); GAS unsigned char* db = ws + WS_DB + (size_t)(layer & 1) * DB_SET; (void)db
    for (int layer = 0; layer < DEPTH; ++layer) {
        {   OPQ();
        for (int rep = 0; rep < REP_B; ++rep) {   if (rep) xcd_barrier(bar, F.wave0); pg8::Gemm g{(const bf16*)(ws + WS_NX), (const bf16*)(ws + WS_WIN), T, NZ - 256 * ZSPLIT, 2048, 2048}; pg8::StaticOrder S; S.init(T, NZ - 256 * ZSPLIT, F.G, F.bx);
            pg8::EpiZ E{(bf16*)(ws + WS_ZRKV), (bf16*)(ws + WS_ZL), (bf16*)(ws + WS_GUV), (bf16*)(ws + WS_SG), layer == 0 ? (bf16*)(ws + WS_VF) : (bf16*)nullptr, 0};
            pg8::gemm_phase<pg8::EpiZ, pg8::StaticOrder, WIN_ALIGN, WIN_SP2>(ring, g, S, E, F.wave0); }
        }
        xcd_barrier(bar, F.wave0);
        {   OPQ();
        for (int rep = 0; rep < REP_C; ++rep) {   if (rep) xcd_barrier(bar, F.wave0); { pg8::Gemm g{(const bf16*)(ws + WS_ZL), (const bf16*)(ws + WS_LORA + (size_t)layer * LORA_BYTES), T, 2048, 128, 512}; pg8::StaticOrder S; S.init(T, 2048, F.G, F.bx);
            pg8::EpiLora E{(bf16*)(ws + WS_EW), (size_t)(WS_AR - WS_EW) / 2, args.in[6] + (size_t)layer * 1024, args.in[8] + (size_t)layer * 1024, 0};
            pg8::gemm_phase<pg8::EpiLora, pg8::StaticOrder, true, true>(ring, g, S, E, F.wave0); }
            { pg8::Gemm g{(const bf16*)(ws + WS_ZL) + 128, (const bf16*)(ws + WS_LORA + (size_t)layer * LORA_BYTES) + 2048 * 128, T, 1024, 128, 512}; pg8::StaticOrder S; S.init(T, 1024, F.G, F.bx);
            pg8::EpiLora E{(bf16*)(ws + WS_EW), (size_t)(WS_AR - WS_EW) / 2, args.in[6] + (size_t)layer * 1024, args.in[8] + (size_t)layer * 1024, 8};
            pg8::gemm_phase<pg8::EpiLora, pg8::StaticOrder, true, true>(ring, g, S, E, F.wave0); } }
        if (layer > 0) {
            pg8::Gemm g{(const bf16*)(ws + WS_ZL) + 256, (const bf16*)(ws + WS_MV + (size_t)(layer - 1) * MV_BYTES), T, 1024, 128, 512}; pg8::StaticOrder S; S.init(T, 1024, F.G, F.bx);
            pg8::EpiMv E{(bf16*)(ws + WS_ZRKV), (const bf16*)(ws + WS_VF), args.in[18] + (size_t)(layer - 1) * 1024};
            pg8::gemm_phase<pg8::EpiMv, pg8::StaticOrder, true, true>(ring, g, S, E, F.wave0); }
        }
        xcd_barrier(bar, F.wave0);
        {   OPQ();
        for (int rep = 0; rep < REP_D; ++rep) {   if (rep) xcd_barrier(bar, F.wave0); const int nsb = F.G / 2, nob = F.G - nsb;
            if (F.bx < nsb) { for (int u = F.bx; u < NB * 16; u += nsb) scan_unit(F, args, layer, u); }
            else { const int ob = F.bx - nsb;
                for (int pm = ob; pm < T / 256; pm += nob)
                    for (int rep2 = 0; rep2 < REP_E; ++rep2) { gmlp_unit(F, args, layer, 2 * pm); gmlp_unit(F, args, layer, 2 * pm + 1); }
                asm volatile("s_waitcnt vmcnt(0)" ::: "memory"); __syncthreads();
                {
                    pg8::Gemm g{(const bf16*)(ws + WS_GUV), (const bf16*)(db + DB_PBT), T, 1024, 1024, 2048}; pg8::PanelOrder S{ob, nob, T / 256, 4, 0};
                    pg8::EpiMerge<false> E{(const bf16*)(ws + WS_SG), (bf16*)(ws + WS_GUV) + 1024, (bf16*)nullptr};
                    pg8::gemm_phase<pg8::EpiMerge<false>, pg8::PanelOrder, true, true>(ring, g, S, E, F.wave0); }
                {
                    pg8::Gemm g{(const bf16*)(ws + WS_NX), (const bf16*)(ws + WS_WINB + (size_t)(layer & 1) * WINB_BYTES), T, 256 * ZSPLIT, 2048, 2048}; pg8::StaticOrder S; S.init(T, 256 * ZSPLIT, nob, ob);
                    pg8::EpiZ E{(bf16*)(ws + WS_ZRKV), (bf16*)(ws + WS_ZL), (bf16*)(ws + WS_GUV), (bf16*)(ws + WS_SG), (bf16*)nullptr, 30 - ZSPLIT};
                    pg8::gemm_phase<pg8::EpiZ, pg8::StaticOrder, true, true>(ring, g, S, E, F.wave0); }
                {   pg8::Gemm g{(const bf16*)(db + DB_PB), (const bf16*)(db + DB_PLEW), T, 1024, 256, 256}; pg8::StaticOrder S; S.init(T, 1024, nob, ob);
                    pg8::EpiPlain E{(bf16*)(ws + WS_PW), 1024};
                    pg8::gemm_phase<pg8::EpiPlain, pg8::StaticOrder, true, true>(ring, g, S, E, F.wave0); }
                if (layer == 0) prep_phase(F, args, 0, ob, nob, 2);
                if (layer + 1 < DEPTH) prep_phase(F, args, layer + 1, ob, nob, 3); } }
        }
        xcd_barrier(bar, F.wave0);
        {   OPQ();
        for (int rep = 0; rep < REP_G; ++rep) {   if (rep) xcd_barrier(bar, F.wave0); pg8::Gemm g{(const bf16*)(ws + WS_G), (const bf16*)(db + DB_PA), T, 1024, 1024, 1024}; pg8::StaticOrder S; S.init(T, 1024, F.G, F.bx);
            pg8::EpiMerge<true> E{(const bf16*)(ws + WS_SG), (bf16*)(ws + WS_GUV) + 1024, (bf16*)(ws + WS_MG)};
            pg8::gemm_phase<pg8::EpiMerge<true>, pg8::StaticOrder, true, true>(ring, g, S, E, F.wave0); }
        }
        xcd_barrier(bar, F.wave0);
        {   OPQ();
        {   pg8::Gemm g{(const bf16*)(ws + WS_MG), (const bf16*)(db + DB_POUT), T, 1024, 1024, 1024}; pg8::StaticOrder S; S.init(T, 1024, F.G, F.bx);
            pg8::EpiResid E{F.h};
            pg8::gemm_phase<pg8::EpiResid, pg8::StaticOrder, true, true>(ring, g, S, E, F.wave0); }
        }
        xcd_barrier(bar, F.wave0);
        {   OPQ();
        for (int rep = 0; rep < REP_I; ++rep) {   if (rep) xcd_barrier(bar, F.wave0); phase_ids(F); const int gw = F.bx * NWAVES + F.wave, NGW = F.G * NWAVES; const float* g2 = args.in[3] + (size_t)layer * 1024;
            for (int m = gw; m < T / 2; m += NGW) norm_row_n2x2(F.h + (size_t)m * D, F.h + (size_t)(m + T / 2) * D, g2, (bf16*)(ws + WS_N2) + (size_t)m * D, (bf16*)(ws + WS_N2) + (size_t)(m + T / 2) * D, F.lane); }
        }
        xcd_barrier(bar, F.wave0);
        {   OPQ();
        {   pg8::Gemm g{(const bf16*)(ws + WS_N2), (const bf16*)(db + DB_WQG), T, 3072, 1024, 1024}; pg8::StaticOrder S; S.init(T, 3072, F.G, F.bx);
            pg8::EpiQG E{(bf16*)(ws + WS_Q), (bf16*)(ws + WS_PW), F.h};
            pg8::gemm_phase<pg8::EpiQG, pg8::StaticOrder, true, true>(ring, g, S, E, F.wave0); }
        }
        xcd_barrier(bar, F.wave0);
        {   OPQ();
        for (int u = F.bx; u < T / 128; u += F.G) peer_unit(F, args, layer, u, layer == DEPTH - 1);
        }
        if (layer + 1 < DEPTH) xcd_barrier(bar, F.wave0);
    }
}

extern "C" void kernel_launch(void* const* d_in, const int* in_sizes, int n_in, void* d_out, int out_size, void* d_ws, size_t ws_size, hipStream_t stream) {
    static int grid = 0;
    if (grid == 0) {
        if (n_in != 32 || out_size != T * D || ws_size < WS_END) { fprintf(stderr, "kernel_launch: unexpected sizes n_in %d out %d ws %zu (need %zu); nothing launched\n", n_in, out_size, ws_size, (size_t)WS_END); grid = -1; return; }
        int dev = 0, cus = 0, per_cu = 0;
        if (hipGetDevice(&dev) != hipSuccess || hipDeviceGetAttribute(&cus, hipDeviceAttributeMultiprocessorCount, dev) != hipSuccess) { grid = -1; return; }
        if (hipFuncSetAttribute((const void*)trunk_fwd, hipFuncAttributeMaxDynamicSharedMemorySize, LDS_BYTES) != hipSuccess) { fprintf(stderr, "kernel_launch: hipFuncSetAttribute failed\n"); grid = -1; return; }
        if (hipOccupancyMaxActiveBlocksPerMultiprocessor(&per_cu, (const void*)trunk_fwd, NWAVES * 64, LDS_BYTES) != hipSuccess || per_cu < 1)
            fprintf(stderr, "kernel_launch: note: occupancy query reports %d workgroups per CU\n", per_cu);
        (void)hipGetLastError();
        grid = cus;
    }
    if (grid < 0) return;
    (void)hipMemsetAsync((char*)d_ws + WS_CTL, 0, ZERO_BYTES, stream);
    (void)hipMemsetAsync((char*)d_ws + WIN_ZERO_OFF, 0, WIN_ZERO_BYTES, stream);
    Args a{};
    for (int i = 0; i < 32; ++i) a.in[i] = (const float*)d_in[i];
    a.out = (float*)d_out; a.ws = (unsigned char*)d_ws;
    hipLaunchKernelGGL(trunk_fwd, dim3(grid), dim3(NWAVES * 64), LDS_BYTES, stream, a);
    const hipError_t le = hipPeekAtLastError();
    if (le != hipSuccess) fprintf(stderr, "kernel_launch: launch failed: %s\n", hipGetErrorName(le));
}
```

```cpp
#include <hip/hip_runtime.h>
#include <cstdio>
#include <cstdint>
#define ZSPLIT 4
namespace pg8 {
#define PG8_LAS __attribute__((address_space(3)))
typedef unsigned short bf16_t;
typedef short bf16x8 __attribute__((ext_vector_type(8)));
typedef float f32x4 __attribute__((ext_vector_type(4)));
typedef unsigned u32x4 __attribute__((ext_vector_type(4)));
constexpr int BM = 256, BK = 64, HALF = 128, HTB = HALF * BK * 2  , STAGE_BYTES = 8 * HTB, NXCD = 8, WGM = 8;

__host__ __device__ __forceinline__ int lds_byte(int r, int c) { const int st = (r >> 4) * 2 + (c >> 5), rr = r & 15, cc = c & 31, ob = rr * 64 + cc * 2; return st * 1024 + (ob ^ (((ob >> 9) & 1) << 5)); }
__host__ __device__ __forceinline__ void stage_rc(int b, int& R, int& C) { const int st = b / 1024, sb = b % 1024, swz = sb ^ (((sb >> 9) & 1) << 5); R = (st >> 1) * 16 + swz / 64; C = (st & 1) * 32 + (swz % 64) / 2; }
__host__ __device__ __forceinline__ int perm32(int rho) { const int n = rho >> 4, i = rho & 15; return 8 * (i >> 2) + 4 * n + (i & 3); }

struct Unit { int pm, pn; };
struct Gemm { const bf16_t* A; const bf16_t* Bt; int M, N, K, lda; };

struct StaticOrder {
    int nM, nN, nwg, G, c;
    __host__ __device__ void init(int M, int N, int G_, int c_) { nM = M / BM; nN = N / BM; nwg = nM * nN; G = G_; c = c_; }
    __host__ __device__ bool next(int i, Unit& u) const {
        const long L = (long)i * G + c; if (L >= nwg) return false;
        int wgid = (int)L; { const int q = nwg / NXCD, r = nwg % NXCD, xcd = wgid % NXCD, off = wgid / NXCD; wgid = (xcd < r ? xcd * (q + 1) : r * (q + 1) + (xcd - r) * q) + off; }
        const int nig = WGM * nN, gid = wgid / nig, fm = gid * WGM, gsz = (nM - fm) < WGM ? (nM - fm) : WGM;
        u.pm = fm + ((wgid % nig) % gsz); u.pn = (wgid % nig) / gsz; return true;
    }
    __device__ __forceinline__ void a_ready(const Unit&) const {}
    __device__ __forceinline__ void done(const Unit&) const {}
};
struct PanelOrder {
    int first, stride, nM, nN, pn0;
    __host__ __device__ bool next(int i, Unit& u) const { const int p = first + (i / nN) * stride; if (p >= nM) return false; u.pm = p; u.pn = pn0 + i % nN; return true; }
    __device__ __forceinline__ void a_ready(const Unit&) const {}
    __device__ __forceinline__ void done(const Unit&) const {}
};
__device__ __forceinline__ unsigned cvt_pk_bf16(float lo, float hi) { unsigned r; asm volatile("v_cvt_pk_bf16_f32 %0, %1, %2" : "=v"(r) : "v"(lo), "v"(hi)); return r; }

__device__ __forceinline__ float fsig(float x) { return __builtin_amdgcn_rcpf(1.f + __builtin_amdgcn_exp2f(-1.44269504f * x)); }
__device__ __forceinline__ float fgelu(float x) { return x * fsig(1.5957691216f * (x + 0.044715f * x * x * x)); }
__device__ __forceinline__ float bflo(unsigned w) { return __builtin_bit_cast(float, w << 16); }
__device__ __forceinline__ float bfhi(unsigned w) { return __builtin_bit_cast(float, w & 0xffff0000u); }
__device__ __forceinline__ void unpk8(const u32x4 w, f32x4& a, f32x4& b) { a = (f32x4){bflo(w.x), bfhi(w.x), bflo(w.y), bfhi(w.y)}; b = (f32x4){bflo(w.z), bfhi(w.z), bflo(w.w), bfhi(w.w)}; }
__device__ __forceinline__ u32x4 pk8(const f32x4 a, const f32x4 b) { u32x4 w; w.x = cvt_pk_bf16(a[0], a[1]); w.y = cvt_pk_bf16(a[2], a[3]); w.z = cvt_pk_bf16(b[0], b[1]); w.w = cvt_pk_bf16(b[2], b[3]); return w; }
__device__ __forceinline__ f32x4 act4(f32x4 v, int kind) {
    if (kind == 1) { v = (f32x4){fgelu(v[0]), fgelu(v[1]), fgelu(v[2]), fgelu(v[3])}; }
    else if (kind == 2) { v = (f32x4){fsig(v[0]), fsig(v[1]), fsig(v[2]), fsig(v[3])}; }
    else if (kind == 3) { v = (f32x4){2.f * fsig(2.f * v[0]) - 1.f, 2.f * fsig(2.f * v[1]) - 1.f, 2.f * fsig(2.f * v[2]) - 1.f, 2.f * fsig(2.f * v[3]) - 1.f}; }
    return v;
}
#define EPI_ROWS_BEGIN _Pragma("unroll") for (int ai = 0; ai < 2; ++ai) _Pragma("unroll") for (int m = 0; m < 4; ++m) { const size_t row = (size_t)(row0 + ai * HALF + m * 16);
#define EPI_ROWS_END }

struct EpiZ {
    static constexpr bool PERM = true, AFTER_DRAIN = false;
    bf16_t *zrkv, *zl, *guv, *sg, *vf; int pnoff;
    __device__ __forceinline__ void operator()(const f32x4 (&acc)[2][2][4][2], const Unit& u, int wr, int wc, int fr, int fq) const {
        const int pn = u.pn + pnoff, row0 = u.pm * BM + wr * 64 + fr;
        bf16_t* dst; int ld, colt, k0, k1;
        if (pn < 12)       { dst = zrkv; ld = 3072; colt = pn * 256;        k0 = 0; k1 = 0; }
        else if (pn == 12) { dst = zl;   ld = 512;  colt = 0;               k0 = (wc < 2) ? 3 : 0; k1 = 2; }
        else if (pn == 13) { dst = zl;   ld = 512;  colt = 256;             k0 = 0; k1 = 0; }
        else if (pn < 22)  { dst = guv;  ld = 2048; colt = (pn - 14) * 256; k0 = 1; k1 = 1; }
        else               { dst = sg;   ld = 2048; colt = ((pn - 18) & 7) * 256; k0 = 2; k1 = 2; }
        const int col0 = colt + wc * 32 + 8 * fq;
        const bool dovf = (vf != nullptr) && pn >= 8 && pn < 12;
        const int vcol0 = (pn - 8) * 256 + wc * 32 + 8 * fq;
        EPI_ROWS_BEGIN
            bf16_t* rowp = dst + row * ld + col0;
#pragma unroll
            for (int bj = 0; bj < 2; ++bj) { const int kind = bj ? k1 : k0;
                const u32x4 w = pk8(act4(acc[ai][bj][m][0], kind), act4(acc[ai][bj][m][1], kind));
                *(u32x4*)(rowp + bj * HALF) = w;
                if (dovf) *(u32x4*)(vf + row * 1024 + vcol0 + bj * HALF) = w; }
        EPI_ROWS_END
    }
};
struct EpiLora {
    static constexpr bool PERM = true, AFTER_DRAIN = false;
    bf16_t* ew; size_t stride; const float *w0, *a0; int pnoff;
    __device__ __forceinline__ void operator()(const f32x4 (&acc)[2][2][4][2], const Unit& u, int wr, int wc, int fr, int fq) const {
        const int pn = u.pn + pnoff, sel = pn >> 2, row0 = u.pm * BM + wr * 64 + fr, col0 = (pn & 3) * 256 + wc * 32 + 8 * fq;
        bf16_t* dst = ew + (size_t)sel * stride;
        const float* bp = sel == 0 ? w0 : a0;
        f32x4 bv[2][2];
#pragma unroll
        for (int bj = 0; bj < 2; ++bj)
#pragma unroll
            for (int n = 0; n < 2; ++n) bv[bj][n] = (sel < 2) ? *(const f32x4*)(bp + col0 + bj * HALF + 4 * n) : (f32x4){0.f, 0.f, 0.f, 0.f};
        EPI_ROWS_BEGIN
            bf16_t* rowp = dst + row * 1024 + col0;
#pragma unroll
            for (int bj = 0; bj < 2; ++bj) { f32x4 v0 = acc[ai][bj][m][0] + bv[bj][0], v1 = acc[ai][bj][m][1] + bv[bj][1];
                if (sel < 2) { v0 = act4(v0, 2); v1 = act4(v1, 2); }
                if (sel == 0) { v0 = v0 * 0.60653066f; v1 = v1 * 0.60653066f; }
                *(u32x4*)(rowp + bj * HALF) = pk8(v0, v1); }
        EPI_ROWS_END
    }
};
struct EpiMv {
    static constexpr bool PERM = true, AFTER_DRAIN = false;
    bf16_t* zrkv; const bf16_t* vf; const float* v0b;
    __device__ __forceinline__ void operator()(const f32x4 (&acc)[2][2][4][2], const Unit& u, int wr, int wc, int fr, int fq) const {
        const int row0 = u.pm * BM + wr * 64 + fr, col0 = u.pn * 256 + wc * 32 + 8 * fq;
        f32x4 bv[2][2];
#pragma unroll
        for (int bj = 0; bj < 2; ++bj)
#pragma unroll
            for (int n = 0; n < 2; ++n) bv[bj][n] = *(const f32x4*)(v0b + col0 + bj * HALF + 4 * n);
        EPI_ROWS_BEGIN
#pragma unroll
            for (int bj = 0; bj < 2; ++bj) { bf16_t* zp = zrkv + row * 3072 + 2048 + col0 + bj * HALF;
                f32x4 z0, z1, f0, f1; unpk8(*(const u32x4*)zp, z0, z1); unpk8(*(const u32x4*)(vf + row * 1024 + col0 + bj * HALF), f0, f1);
                const f32x4 m0 = act4(acc[ai][bj][m][0] + bv[bj][0], 2), m1 = act4(acc[ai][bj][m][1] + bv[bj][1], 2);
                *(u32x4*)zp = pk8(z0 + (f0 - z0) * m0, z1 + (f1 - z1) * m1); }
        EPI_ROWS_END
    }
};
struct EpiPlain {
    static constexpr bool PERM = true, AFTER_DRAIN = false;
    bf16_t* o; int ld;
    __device__ __forceinline__ void operator()(const f32x4 (&acc)[2][2][4][2], const Unit& u, int wr, int wc, int fr, int fq) const {
        const int row0 = u.pm * BM + wr * 64 + fr, col0 = u.pn * 256 + wc * 32 + 8 * fq;
        EPI_ROWS_BEGIN
#pragma unroll
            for (int bj = 0; bj < 2; ++bj) *(u32x4*)(o + row * ld + col0 + bj * HALF) = pk8(acc[ai][bj][m][0], acc[ai][bj][m][1]);
        EPI_ROWS_END
    }
};
template <bool SECOND> struct EpiMerge {
    static constexpr bool PERM = true, AFTER_DRAIN = false;
    const bf16_t* sg; bf16_t* m2; bf16_t* o;
    __device__ __forceinline__ void operator()(const f32x4 (&acc)[2][2][4][2], const Unit& u, int wr, int wc, int fr, int fq) const {
        const int row0 = u.pm * BM + wr * 64 + fr, col0 = u.pn * 256 + wc * 32 + 8 * fq;
#pragma unroll
        for (int ai = 0; ai < 2; ++ai) { u32x4 gv[4][2], pv[4][2];
#pragma unroll
            for (int m = 0; m < 4; ++m) { const size_t row = (size_t)(row0 + ai * HALF + m * 16);
#pragma unroll
                for (int bj = 0; bj < 2; ++bj) { const int c = col0 + bj * HALF; gv[m][bj] = *(const u32x4*)(sg + row * 2048 + (SECOND ? 0 : 1024) + c);
                    if (SECOND) pv[m][bj] = *(const u32x4*)(m2 + row * 2048 + c); } }
#pragma unroll
            for (int m = 0; m < 4; ++m) { const size_t row = (size_t)(row0 + ai * HALF + m * 16);
#pragma unroll
                for (int bj = 0; bj < 2; ++bj) { const int c = col0 + bj * HALF;
                    f32x4 g0, g1; unpk8(gv[m][bj], g0, g1);
                    f32x4 v0 = g0 * acc[ai][bj][m][0], v1 = g1 * acc[ai][bj][m][1];
                    if (SECOND) { f32x4 p0, p1; unpk8(pv[m][bj], p0, p1); v0 = v0 + p0; v1 = v1 + p1; *(u32x4*)(o + row * 1024 + c) = pk8(v0, v1); }
                    else *(u32x4*)(m2 + row * 2048 + c) = pk8(v0, v1); } } }
    }
};
struct EpiResid {
    static constexpr bool PERM = false, AFTER_DRAIN = false;
    float* h;
    __device__ __forceinline__ void operator()(const f32x4 (&acc)[2][2][4][2], const Unit& u, int wr, int wc, int fr, int fq) const {
        const int row0 = u.pm * BM + wr * 64 + fr, col0 = u.pn * 256 + wc * 32 + 4 * fq;
#pragma unroll
        for (int ai = 0; ai < 2; ++ai) { f32x4 hv[4][2][2];
#pragma unroll
            for (int m = 0; m < 4; ++m) { const float* rowp = h + (size_t)(row0 + ai * HALF + m * 16) * 1024 + col0;
#pragma unroll
                for (int bj = 0; bj < 2; ++bj)
#pragma unroll
                    for (int n = 0; n < 2; ++n) hv[m][bj][n] = *(const f32x4*)(rowp + bj * HALF + n * 16); }
#pragma unroll
            for (int m = 0; m < 4; ++m) { float* rowp = h + (size_t)(row0 + ai * HALF + m * 16) * 1024 + col0;
#pragma unroll
                for (int bj = 0; bj < 2; ++bj)
#pragma unroll
                    for (int n = 0; n < 2; ++n) *(f32x4*)(rowp + bj * HALF + n * 16) = hv[m][bj][n] + acc[ai][bj][m][n]; } }
    }
};
struct EpiQG {
    static constexpr bool PERM = true, AFTER_DRAIN = false;
    bf16_t* q; bf16_t* pw; float* h;
    __device__ __forceinline__ void operator()(const f32x4 (&acc)[2][2][4][2], const Unit& u, int wr, int wc, int fr, int fq) const {
        const int row0 = u.pm * BM + wr * 64 + fr;
        if (u.pn < 8) { const int col0 = u.pn * 256 + wc * 32 + 8 * fq;
            EPI_ROWS_BEGIN
#pragma unroll
                for (int bj = 0; bj < 2; ++bj) *(u32x4*)(q + row * 2048 + col0 + bj * HALF) = pk8(acc[ai][bj][m][0], acc[ai][bj][m][1]);
            EPI_ROWS_END
        } else { const int col0 = (u.pn - 8) * 256 + wc * 32 + 8 * fq;
#pragma unroll
            for (int ai = 0; ai < 2; ++ai)
#pragma unroll
            for (int mh = 0; mh < 2; ++mh) { u32x4 pwv[2][2];
#pragma unroll
                for (int m2_ = 0; m2_ < 2; ++m2_) { const size_t row = (size_t)(row0 + ai * HALF + (2 * mh + m2_) * 16);
#pragma unroll
                    for (int bj = 0; bj < 2; ++bj) { const int c = col0 + bj * HALF; pwv[m2_][bj] = *(const u32x4*)(pw + row * 1024 + c); } }
#pragma unroll
                for (int m2_ = 0; m2_ < 2; ++m2_) { const int m = 2 * mh + m2_; const size_t row = (size_t)(row0 + ai * HALF + m * 16);
#pragma unroll
                    for (int bj = 0; bj < 2; ++bj) { const int c = col0 + bj * HALF; f32x4 p0, p1; unpk8(pwv[m2_][bj], p0, p1);
                        *(u32x4*)(pw + row * 1024 + c) = pk8(p0 * act4(acc[ai][bj][m][0], 2), p1 * act4(acc[ai][bj][m][1], 2)); } } }
        }
    }
};
template <class Epi, class Sched, bool ALIGN_EPI = false, bool SP2 = false>
__device__ __forceinline__ void gemm_phase(PG8_LAS unsigned char* lds, const Gemm g, const Sched& S, const Epi& E, const int wave0) {
    int tidq; asm volatile("v_mbcnt_lo_u32_b32 %0, -1, 0\n\tv_mbcnt_hi_u32_b32 %0, -1, %0" : "=v"(tidq)); tidq += wave0 * 64;
    const int tid = tidq, wid = __builtin_amdgcn_readfirstlane(tid >> 6), lane = tid & 63, wr = wid >> 2, wc = wid & 3, fr = lane & 15, fq = lane >> 4;
    int Kq = g.K, ldaq = g.lda; const bf16_t* gA = g.A; const bf16_t* gB = g.Bt; asm volatile("" : "+s"(Kq), "+s"(ldaq), "+s"(gA), "+s"(gB));
    const int K = Kq, nt = K / BK;
    unsigned voffA[2], voffB[2];
#pragma unroll
    for (int i = 0; i < 2; ++i) { int R, C; stage_rc(tid * 16 + i * 8192, R, C); const int Rb = Epi::PERM ? ((R & ~31) + perm32(R & 31)) : R;
        voffA[i] = (unsigned)(R * ldaq + C) * 2u; voffB[i] = (unsigned)(Rb * K + C) * 2u; }
    const size_t kstep = (size_t)(BK * 2);
    const size_t hstepA = (size_t)HALF * ldaq * 2, hstepB = (size_t)HALF * K * 2;
    const size_t tstepA = 2 * hstepA, tstepB = 2 * hstepB;
    const unsigned ldsw = (unsigned)wid * 1024u;
    const int aoff = lds_byte(wr * 64 + fr, fq * 8), boff = lds_byte(wc * 32 + fr, fq * 8);
#define PG8_SA(b, h) (((b) * 2 + (h)) * HTB)
#define PG8_SB(b, h) ((4 + (b) * 2 + (h)) * HTB)
#define PG8_STAGE(bufoff, gbase, voff) do { _Pragma("unroll") for (int _i = 0; _i < 2; ++_i) \
        __builtin_amdgcn_global_load_lds((const unsigned*)((const char*)(gbase) + (voff)[_i]), (PG8_LAS unsigned*)(lds + (bufoff) + ldsw + _i * 8192), 16, 0, 0); } while (0)
#define PG8_LDA(dst, b, h) do { _Pragma("unroll") for (int m = 0; m < 4; ++m) _Pragma("unroll") for (int k = 0; k < 2; ++k) dst[m][k] = *(const PG8_LAS bf16x8*)(lds + PG8_SA(b, h) + aoff + m * 2048 + k * 1024); } while (0)
#define PG8_LDB(dst, b, h) do { _Pragma("unroll") for (int n = 0; n < 2; ++n) _Pragma("unroll") for (int k = 0; k < 2; ++k) dst[n][k] = *(const PG8_LAS bf16x8*)(lds + PG8_SB(b, h) + boff + n * 2048 + k * 1024); } while (0)
#define PG8_MMA(ai, bj, At, Bt) do { __builtin_amdgcn_s_setprio(1); _Pragma("unroll") for (int m = 0; m < 4; ++m) _Pragma("unroll") for (int n = 0; n < 2; ++n) _Pragma("unroll") for (int k = 0; k < 2; ++k) \
        acc[ai][bj][m][n] = __builtin_amdgcn_mfma_f32_16x16x32_bf16(Bt[n][k], At[m][k], acc[ai][bj][m][n], 0, 0, 0); __builtin_amdgcn_s_setprio(0); } while (0)
#define PG8_WAIT_V(n) asm volatile("s_waitcnt vmcnt(" #n ")" ::: "memory")
#define PG8_WAIT_L(n) asm volatile("s_waitcnt lgkmcnt(" #n ")" ::: "memory")
#define PG8_BAR __builtin_amdgcn_s_barrier()
#define PG8_SCHED __builtin_amdgcn_sched_barrier(0)
    Unit cur, nxt; int ui = 0;
    if (!S.next(0, cur)) return;
    f32x4 acc[2][2][4][2];
#pragma unroll
    for (int a = 0; a < 2; ++a)
#pragma unroll
        for (int b = 0; b < 2; ++b)
#pragma unroll
            for (int m = 0; m < 4; ++m)
#pragma unroll
                for (int n = 0; n < 2; ++n) acc[a][b][m][n] = (f32x4){0.f, 0.f, 0.f, 0.f};
    bf16x8 At[4][2], B0[2][2], B1[2][2];
    const char* cA = (const char*)gA + (size_t)cur.pm * tstepA; const char* cB = (const char*)gB + (size_t)cur.pn * tstepB;
    S.a_ready(cur);
    if constexpr (SP2) {
        PG8_STAGE(PG8_SB(0, 0), cB, voffB); PG8_STAGE(PG8_SB(0, 1), cB + hstepB, voffB); PG8_STAGE(PG8_SA(0, 0), cA, voffA); PG8_STAGE(PG8_SA(0, 1), cA + hstepA, voffA);
        if (wr == 1) PG8_BAR;
        PG8_WAIT_V(2); PG8_BAR;
        PG8_STAGE(PG8_SB(1, 0), cB + kstep, voffB); PG8_STAGE(PG8_SA(1, 0), cA + kstep, voffA); PG8_STAGE(PG8_SB(1, 1), cB + hstepB + kstep, voffB);
        PG8_WAIT_V(6); PG8_BAR;
    } else {
        PG8_STAGE(PG8_SB(0, 0), cB, voffB); PG8_STAGE(PG8_SA(0, 0), cA, voffA); PG8_STAGE(PG8_SB(0, 1), cB + hstepB, voffB); PG8_STAGE(PG8_SA(0, 1), cA + hstepA, voffA);
        if (wr == 1) PG8_BAR;
        PG8_WAIT_V(4); PG8_BAR;
        PG8_STAGE(PG8_SB(1, 0), cB + kstep, voffB); PG8_STAGE(PG8_SA(1, 0), cA + kstep, voffA); PG8_STAGE(PG8_SB(1, 1), cB + hstepB + kstep, voffB);
        PG8_WAIT_V(6); PG8_BAR;
    }
    for (;;) {
        const bool has_next = S.next(ui + 1, nxt);
        const char* nA = has_next ? (const char*)gA + (size_t)nxt.pm * tstepA : cA; const char* nB = has_next ? (const char*)gB + (size_t)nxt.pn * tstepB : cB;
        for (int t = 0; t < nt; t += 2) {
            const bool last = (t == nt - 2);
            const char* a1 = cA + (size_t)(t + 1) * kstep;
            const char* a2 = last ? nA : cA + (size_t)(t + 2) * kstep; const char* b2 = last ? nB : cB + (size_t)(t + 2) * kstep;
            const char* a3 = a2 + kstep; const char* b3 = b2 + kstep;
            if (last && has_next) S.a_ready(nxt);
            if constexpr (SP2) {
            PG8_LDB(B0, 0, 0); PG8_LDB(B1, 0, 1); PG8_SCHED; PG8_LDA(At, 0, 0); PG8_STAGE(PG8_SA(1, 1), a1 + hstepA, voffA);
            PG8_WAIT_V(8); PG8_WAIT_L(0); PG8_BAR; PG8_MMA(0, 0, At, B0); PG8_MMA(0, 1, At, B1); PG8_BAR; PG8_SCHED;
            PG8_LDA(At, 0, 1); PG8_STAGE(PG8_SB(0, 0), b2, voffB); PG8_STAGE(PG8_SB(0, 1), b2 + hstepB, voffB); PG8_STAGE(PG8_SA(0, 0), a2, voffA);
            PG8_WAIT_V(8); PG8_WAIT_L(0); PG8_BAR; PG8_MMA(1, 0, At, B0); PG8_MMA(1, 1, At, B1); PG8_BAR; PG8_SCHED;
            PG8_LDB(B0, 1, 0); PG8_LDB(B1, 1, 1); PG8_SCHED; PG8_LDA(At, 1, 0); PG8_STAGE(PG8_SA(0, 1), a2 + hstepA, voffA);
            PG8_WAIT_V(8); PG8_WAIT_L(0); PG8_BAR; PG8_MMA(0, 0, At, B0); PG8_MMA(0, 1, At, B1); PG8_BAR; PG8_SCHED;
            PG8_LDA(At, 1, 1); PG8_STAGE(PG8_SB(1, 0), b3, voffB); PG8_STAGE(PG8_SB(1, 1), b3 + hstepB, voffB); PG8_STAGE(PG8_SA(1, 0), a3, voffA);
            PG8_WAIT_V(8); PG8_WAIT_L(0); PG8_BAR; PG8_MMA(1, 0, At, B0); PG8_MMA(1, 1, At, B1); PG8_BAR; PG8_SCHED;
            } else {
            PG8_LDB(B0, 0, 0); PG8_SCHED; PG8_LDA(At, 0, 0); PG8_STAGE(PG8_SA(1, 1), a1 + hstepA, voffA);
            PG8_WAIT_L(8); PG8_BAR; PG8_WAIT_L(0); PG8_MMA(0, 0, At, B0); PG8_BAR; PG8_SCHED;
            PG8_LDB(B1, 0, 1); PG8_STAGE(PG8_SB(0, 0), b2, voffB);
            PG8_BAR; PG8_WAIT_L(0); PG8_MMA(0, 1, At, B1); PG8_BAR;
            PG8_LDA(At, 0, 1); PG8_STAGE(PG8_SA(0, 0), a2, voffA);
            PG8_BAR; PG8_WAIT_L(0); PG8_MMA(1, 0, At, B0); PG8_BAR; PG8_SCHED;
            PG8_STAGE(PG8_SB(0, 1), b2 + hstepB, voffB);
            PG8_WAIT_V(6); PG8_BAR; PG8_MMA(1, 1, At, B1); PG8_BAR;
            PG8_LDB(B0, 1, 0); PG8_SCHED; PG8_LDA(At, 1, 0); PG8_STAGE(PG8_SA(0, 1), a2 + hstepA, voffA);
            PG8_WAIT_L(8); PG8_BAR; PG8_WAIT_L(0); PG8_MMA(0, 0, At, B0); PG8_BAR; PG8_SCHED;
            PG8_LDB(B1, 1, 1); PG8_STAGE(PG8_SB(1, 0), b3, voffB);
            PG8_BAR; PG8_WAIT_L(0); PG8_MMA(0, 1, At, B1); PG8_BAR;
            PG8_LDA(At, 1, 1); PG8_STAGE(PG8_SA(1, 0), a3, voffA);
            PG8_BAR; PG8_WAIT_L(0); PG8_MMA(1, 0, At, B0); PG8_BAR; PG8_SCHED;
            PG8_STAGE(PG8_SB(1, 1), b3 + hstepB, voffB);
            PG8_WAIT_V(6); PG8_BAR; PG8_MMA(1, 1, At, B1); PG8_BAR;
            }
        }
        if constexpr (ALIGN_EPI) { if (wr == 0) PG8_BAR; }
        if constexpr (!Epi::AFTER_DRAIN) { E(acc, cur, wr, wc, fr, fq); S.done(cur); }
        if (!has_next) break;
#pragma unroll
        for (int a = 0; a < 2; ++a)
#pragma unroll
            for (int b = 0; b < 2; ++b)
#pragma unroll
                for (int m = 0; m < 4; ++m)
#pragma unroll
                    for (int n = 0; n < 2; ++n) acc[a][b][m][n] = (f32x4){0.f, 0.f, 0.f, 0.f};
        cur = nxt; cA = nA; cB = nB; ++ui;
        if constexpr (ALIGN_EPI) { if (wr == 1) PG8_BAR; }
    }
    PG8_WAIT_V(0);
    if constexpr (!ALIGN_EPI) { if (wr == 0) PG8_BAR; }
    PG8_BAR;
    if constexpr (Epi::AFTER_DRAIN) { E.fused(acc, cur, wr, wc, fr, fq, lds, wid, lane); S.done(cur); }
#undef PG8_SA
#undef PG8_SB
#undef PG8_STAGE
#undef PG8_LDA
#undef PG8_LDB
#undef PG8_MMA
#undef PG8_WAIT_V
#undef PG8_WAIT_L
#undef PG8_BAR
#undef PG8_SCHED
}
}

constexpr int NB = 8, SEQ = 4096, T = NB * SEQ, D = 1024, DEPTH = 4, NZ = 7680, NWAVES = 8;
constexpr int CIN = 7424;
constexpr size_t MiB = 1u << 20;
constexpr size_t WS_CTL = 0, WS_LORA = 1 * MiB, WS_MV = 7 * MiB, ZERO_BYTES = 9 * MiB;
constexpr size_t LORA_BYTES = 3072 * 256 * 2, MV_BYTES = 1024 * 256 * 2;
constexpr size_t WS_WIN = 10 * MiB;
constexpr size_t WS_DB = 40 * MiB, DB_SET = 62 * MiB;
constexpr size_t DB_PA = 0, DB_PBT = 2 * MiB, DB_POUT = 4 * MiB, DB_WQG = 6 * MiB, DB_KEYS = 12 * MiB, DB_GMW = 12 * MiB + 512 * 1024, DB_PLEW = 13 * MiB, DB_U = 14 * MiB, DB_V = 30 * MiB, DB_PB = 46 * MiB;
constexpr size_t WS_VF = 164 * MiB, WS_PW = 228 * MiB, WS_NX = 292 * MiB, WS_ZRKV = 420 * MiB, WS_ZL = 612 * MiB, WS_GUV = 644 * MiB, WS_SG = 772 * MiB;
constexpr size_t WS_EW = 900 * MiB, WS_AR = 964 * MiB, WS_G = 1028 * MiB, WS_WINB = 1092 * MiB, WINB_BYTES = 4 * MiB, WS_END = 1100 * MiB;
constexpr size_t WS_Q = WS_ZRKV, WS_SEL = WS_ZRKV + 128 * MiB, WS_MG = WS_AR, WS_N2 = WS_G;
constexpr size_t WIN_ZERO_OFF = WS_WIN + (size_t)3328 * 2048 * 2, WIN_ZERO_BYTES = (size_t)256 * 2048 * 2;
#ifndef ZSPLIT
#define ZSPLIT 2
#endif
constexpr int CW_BAR = 4096;
constexpr int RING_BYTES = 131072, LDSCTL_OFF = RING_BYTES, MISC_OFF = LDSCTL_OFF + 320, LDS_BYTES = 147456;

#define LAS __attribute__((address_space(3)))
#define GAS __attribute__((address_space(1)))
typedef unsigned short bf16;
typedef unsigned v4u __attribute__((ext_vector_type(4)));
typedef unsigned v2u __attribute__((ext_vector_type(2)));
typedef float f32x4 __attribute__((ext_vector_type(4)));
typedef float f32x2 __attribute__((ext_vector_type(2)));
typedef short bf16x8 __attribute__((ext_vector_type(8)));
using pg8::fsig; using pg8::fgelu; using pg8::bflo; using pg8::bfhi; using pg8::unpk8; using pg8::pk8; using pg8::cvt_pk_bf16;

#define XB_TMO      128
#define XB_XCNT(j)  (256  + 64 * (j))
#define XB_XSUB(j)  (1280 + 64 * (j))
#define XB_XGEN(j)  (2304 + 64 * (j))
#define XB_TOP      3328
#define XB_TOPGEN   3392
#define XCD_BAR_WORDS 3456
#define XB_SPIN_CAP (1u << 22)

__device__ __forceinline__ unsigned xb_ld(unsigned* p)              { return __hip_atomic_load(p, __ATOMIC_RELAXED, __HIP_MEMORY_SCOPE_AGENT); }
__device__ __forceinline__ unsigned xb_add(unsigned* p, unsigned v) { return __hip_atomic_fetch_add(p, v, __ATOMIC_RELAXED, __HIP_MEMORY_SCOPE_AGENT); }
__device__ __forceinline__ unsigned xb_xcc_id() { return (unsigned)__builtin_amdgcn_s_getreg((3 << 11) | 20) & 0xFu; }
#define XB_SPIN(cond, bar) do { unsigned _sp = 0; while (cond) { __builtin_amdgcn_s_sleep(1); \
    if ((++_sp & 255u) == 0u) { if (xb_ld(&(bar)[XB_TMO])) break; if (_sp > XB_SPIN_CAP) { atomicAdd(&(bar)[XB_TMO], 1u); break; } } } } while (0)

struct XcdBarrier { unsigned* bar; unsigned x; volatile LAS unsigned* st; };

__device__ __forceinline__ XcdBarrier xcd_barrier_post(unsigned* bar, volatile LAS unsigned* st) {
    XcdBarrier b; b.bar = bar; b.x = xb_xcc_id(); b.st = st;
    if (threadIdx.x == 0) (void)xb_add(&bar[XB_XCNT(b.x)], 1u);
    return b;
}
__device__ __forceinline__ void xcd_barrier_complete(unsigned* bar, unsigned x, unsigned& nloc, unsigned& nx) {
    const unsigned G = gridDim.x * gridDim.y * gridDim.z;
    unsigned sum, cnt, mine, sp = 0u;
    for (;;) {
        sum = 0u; cnt = 0u; mine = 0u;
#pragma unroll
        for (unsigned j = 0; j < 16; ++j) { const unsigned c = xb_ld(&bar[XB_XCNT(j)]); sum += c; cnt += (c > 0u) ? 1u : 0u; mine = (j == x) ? c : mine; }
        if (sum == G) break;
        __builtin_amdgcn_s_sleep(1);
        if ((++sp & 255u) == 0u) { if (xb_ld(&bar[XB_TMO])) break; if (sp > XB_SPIN_CAP) { atomicAdd(&bar[XB_TMO], 1u); break; } }
    }
    nloc = mine > 0u ? mine : 1u; nx = cnt > 0u ? cnt : 1u;
}
__device__ __forceinline__ int lane_id_now();
__device__ __forceinline__ void xcd_barrier(const XcdBarrier& b, const int wave0) {
    asm volatile("s_waitcnt vmcnt(0)" ::: "memory");
    __syncthreads();
    if (wave0 == 0 && lane_id_now() == 0) {
        unsigned* bar = b.bar;
        __builtin_amdgcn_s_waitcnt(0);
        unsigned nloc = b.st[0], nx = b.st[1];
        if (nloc == 0u) { xcd_barrier_complete(bar, b.x, nloc, nx); b.st[0] = nloc; b.st[1] = nx; }
        const unsigned old = xb_add(&bar[XB_XSUB(b.x)], 1u);
        const unsigned gen = old / nloc;
        if (old + 1u == (gen + 1u) * nloc) {
            __builtin_amdgcn_fence(__ATOMIC_RELEASE, "agent");
            asm volatile("s_waitcnt vmcnt(0)" ::: "memory");
            const unsigned og = xb_add(&bar[XB_TOP], 1u);
            const unsigned tg = og / nx;
            if (og + 1u == (tg + 1u) * nx) xb_add(&bar[XB_TOPGEN], 1u);
            else XB_SPIN(xb_ld(&bar[XB_TOPGEN]) == tg, bar);
            __builtin_amdgcn_fence(__ATOMIC_ACQUIRE, "agent");
            xb_add(&bar[XB_XGEN(b.x)], 1u);
            asm volatile("s_waitcnt vmcnt(0)" ::: "memory");
        } else {
            XB_SPIN(xb_ld(&bar[XB_XGEN(b.x)]) == gen, bar);
            __builtin_amdgcn_fence(__ATOMIC_ACQUIRE, "agent");
            asm volatile("s_waitcnt vmcnt(0)" ::: "memory");
        }
    }
    __syncthreads();
}

struct Args { const float* in[32]; float* out; unsigned char* ws; };
struct Frame {
    LAS unsigned char* lds;
    int tid, lane, wave, G, bx, wave0;
    GAS unsigned char* ws; float* h;
};
__device__ __forceinline__ int lane_id_now() { int l; asm volatile("v_mbcnt_lo_u32_b32 %0, -1, 0\n\tv_mbcnt_hi_u32_b32 %0, -1, %0" : "=v"(l)); return l; }
__device__ __forceinline__ void phase_ids(Frame& F) { const int l = lane_id_now(); F.lane = l; F.wave = F.wave0; F.tid = F.wave0 * 64 + l; GAS unsigned char* w = F.ws; asm volatile("" : "+s"(w)); F.ws = w; }
#define DPP_ADD(x, ctrl) ((x) + __builtin_bit_cast(float, __builtin_amdgcn_update_dpp(0, __builtin_bit_cast(int, (x)), (ctrl), 0xf, 0xf, false)))
__device__ __forceinline__ float sum8(float v) {
    v = DPP_ADD(v, 0xB1);
    v = DPP_ADD(v, 0x4E);
    v = DPP_ADD(v, 0x141);
    return v;
}
__device__ __forceinline__ float sum16(float v) { v = sum8(v); v = DPP_ADD(v, 0x140); return v; }
#define DPP_ADD_NS(x, ctrl) do { (x) = DPP_ADD((x), (ctrl)); asm("" : "+v"(x)); } while (0)
__device__ __forceinline__ float sum16_ns(float v) { DPP_ADD_NS(v, 0xB1); DPP_ADD_NS(v, 0x4E); DPP_ADD_NS(v, 0x141); DPP_ADD_NS(v, 0x140); return v; }
__device__ __forceinline__ float wave_sum(float v) {
    v = sum8(v);
    v = DPP_ADD(v, 0x140);
    const auto r = __builtin_amdgcn_permlane16_swap(__builtin_bit_cast(unsigned, v), __builtin_bit_cast(unsigned, v), false, false);
    v = __builtin_bit_cast(float, (unsigned)r[0]) + __builtin_bit_cast(float, (unsigned)r[1]);
    const auto q = __builtin_amdgcn_permlane32_swap(__builtin_bit_cast(unsigned, v), __builtin_bit_cast(unsigned, v), false, false);
    return __builtin_bit_cast(float, (unsigned)q[0]) + __builtin_bit_cast(float, (unsigned)q[1]);
}
__device__ __forceinline__ unsigned xor16_u(unsigned x, int lane) { const auto r = __builtin_amdgcn_permlane16_swap(x, x, false, false); return (lane & 16) ? (unsigned)r[0] : (unsigned)r[1]; }
__device__ __forceinline__ unsigned xor32_u(unsigned x, int lane) { const auto r = __builtin_amdgcn_permlane32_swap(x, x, false, false); return (lane & 32) ? (unsigned)r[0] : (unsigned)r[1]; }
__device__ __forceinline__ void tr_item(const float* W, int ldw, int ncols, bf16* WT, int ldt, int koff, int row_off, LAS float* scr, int item, int lane) {
    const int nblk = ncols / 32, kb = item / nblk, nb = item % nblk, k0 = 64 * kb, n0 = 32 * nb;
#pragma unroll 8
    for (int i = 0; i < 32; ++i) { const int kk = 2 * i + (lane >> 5); scr[kk * 33 + (lane & 31)] = W[(size_t)(k0 + kk) * ldw + n0 + (lane & 31)]; }
    asm volatile("s_waitcnt lgkmcnt(0)" ::: "memory");
    const int c = lane & 7;
#pragma unroll
    for (int j = 0; j < 4; ++j) { const int n = (lane >> 3) + 8 * j; const LAS float* s = scr + (8 * c) * 33 + n;
        v4u o; o.x = cvt_pk_bf16(s[0 * 33], s[1 * 33]); o.y = cvt_pk_bf16(s[2 * 33], s[3 * 33]); o.z = cvt_pk_bf16(s[4 * 33], s[5 * 33]); o.w = cvt_pk_bf16(s[6 * 33], s[7 * 33]);
        *(v4u*)(WT + (size_t)(row_off + n0 + n) * ldt + koff + k0 + 8 * c) = o; }
    asm volatile("s_waitcnt lgkmcnt(0)" ::: "memory");
}
__device__ __forceinline__ void cvt_chunk(const float* src, bf16* dst, size_t chunk, int lane) {
    const f32x4* s = (const f32x4*)(src + chunk * 512) + lane * 2; const f32x4 a = s[0], b = s[1];
    *(v4u*)(dst + chunk * 512 + lane * 8) = pk8(a, b);
}
__device__ __forceinline__ void cvt8_chunk(const float* src, unsigned char* dst, size_t chunk, int lane, float sc) {
    const f32x4* s = (const f32x4*)(src + chunk * 512) + lane * 2; const f32x4 a = s[0] * sc, b = s[1] * sc;
    int w0 = 0, w1 = 0;
    w0 = __builtin_amdgcn_cvt_pk_fp8_f32(a.x, a.y, w0, false); w0 = __builtin_amdgcn_cvt_pk_fp8_f32(a.z, a.w, w0, true);
    w1 = __builtin_amdgcn_cvt_pk_fp8_f32(b.x, b.y, w1, false); w1 = __builtin_amdgcn_cvt_pk_fp8_f32(b.z, b.w, w1, true);
    *(v2u*)(dst + chunk * 512 + lane * 8) = (v2u){(unsigned)w0, (unsigned)w1};
}
__device__ __forceinline__ void norm_row_nx(const float* hrow, float* hcopy, const float* g, bf16* NX, int t, int lane) {
    const f32x4* xr = (const f32x4*)hrow + lane; f32x4 v[4]; float s = 0.f;
#pragma unroll
    for (int j = 0; j < 4; ++j) { v[j] = xr[64 * j]; s += (v[j].x * v[j].x + v[j].y * v[j].y) + (v[j].z * v[j].z + v[j].w * v[j].w); }
    if (hcopy) {
#pragma unroll
        for (int j = 0; j < 4; ++j) ((f32x4*)hcopy)[lane + 64 * j] = v[j]; }
    const float rstd = 1.f / sqrtf(wave_sum(s) * (1.f / D) + 1e-6f);
    const int tt = t & (SEQ - 1);
#pragma unroll
    for (int j = 0; j < 4; ++j) { const f32x4 gv = ((const f32x4*)g)[lane + 64 * j]; const f32x4 o = v[j] * rstd * gv;
        v2u w; w.x = cvt_pk_bf16(o.x, o.y); w.y = cvt_pk_bf16(o.z, o.w);
        const int c = 4 * (lane + 64 * j);
        *(v2u*)(NX + (size_t)t * 2048 + c) = w;
        if (tt != SEQ - 1) *(v2u*)(NX + (size_t)(t + 1) * 2048 + 1024 + c) = w;
        if (tt == 0) *(v2u*)(NX + (size_t)t * 2048 + 1024 + c) = (v2u){0u, 0u}; }
}
__device__ __forceinline__ void norm_row_n2x2(const float* hrow0, const float* hrow1, const float* g, bf16* o0, bf16* o1, int lane) {
    const f32x4* x0 = (const f32x4*)hrow0 + lane; const f32x4* x1 = (const f32x4*)hrow1 + lane; f32x4 v[2][4]; float s0 = 0.f, s1 = 0.f;
#pragma unroll
    for (int j = 0; j < 4; ++j) { v[0][j] = x0[64 * j]; v[1][j] = x1[64 * j]; }
#pragma unroll
    for (int j = 0; j < 4; ++j) { s0 += (v[0][j].x * v[0][j].x + v[0][j].y * v[0][j].y) + (v[0][j].z * v[0][j].z + v[0][j].w * v[0][j].w);
                                  s1 += (v[1][j].x * v[1][j].x + v[1][j].y * v[1][j].y) + (v[1][j].z * v[1][j].z + v[1][j].w * v[1][j].w); }
    const float r0 = 1.f / sqrtf(wave_sum(s0) * (1.f / D) + 1e-6f), r1 = 1.f / sqrtf(wave_sum(s1) * (1.f / D) + 1e-6f);
#pragma unroll
    for (int j = 0; j < 4; ++j) { const f32x4 gv = ((const f32x4*)g)[lane + 64 * j]; const f32x4 a = v[0][j] * r0 * gv, b = v[1][j] * r1 * gv;
        *(v2u*)(o0 + 4 * (lane + 64 * j)) = (v2u){cvt_pk_bf16(a.x, a.y), cvt_pk_bf16(a.z, a.w)}; *(v2u*)(o1 + 4 * (lane + 64 * j)) = (v2u){cvt_pk_bf16(b.x, b.y), cvt_pk_bf16(b.z, b.w)}; }
}
__device__ __forceinline__ void prep_phase(Frame& F, const Args& a, int layer, int blk, int nblk_, int part) {
    phase_ids(F);
    LAS float* scr = (LAS float*)(F.lds + F.wave * 16384);
    const int gw = blk * NWAVES + F.wave, NGW = nblk_ * NWAVES, lane = F.lane;
    GAS unsigned char* ws = F.ws; GAS unsigned char* db = F.ws + WS_DB + (size_t)(layer & 1) * DB_SET;
    bf16* WIN = (bf16*)(ws + WS_WIN); bf16* LORA = (bf16*)(ws + WS_LORA + (size_t)layer * LORA_BYTES); bf16* MVT = (bf16*)(ws + WS_MV + (size_t)(layer > 0 ? layer - 1 : 0) * MV_BYTES);
    const float* w_in = a.in[5] + (size_t)layer * 2048 * CIN;
    const int mvn = layer > 0 ? 32 : 0;
    const int c1 = 32 * 104, c2a = 32 * 64, c2b = 32 * 32, c2c = 32 * (32 - 8 * ZSPLIT), c2d = 32 * 8 * ZSPLIT, c2 = c2a + 2 * c2b, c3 = mvn, c4 = 32, c5 = 32, c6 = 64, c7 = 512, c10 = 1024, c12 = 128;
    const int total = (part & 1) ? c1 + c2 + c3 + c4 + c5 + c6 + 3 * c7 + c10 + c7 + c12 : 0;
    for (int it = gw; it < total; it += NGW) {
        int r = it;
        if (r < c1) { tr_item(w_in, CIN, 3328, WIN, 2048, 0, 0, scr, r, lane); continue; } r -= c1;
        if (r < c2a) { tr_item(w_in + 3328, CIN, 2048, WIN, 2048, 0, 3584, scr, r, lane); continue; } r -= c2a;
        if (r < c2b) { tr_item(w_in + 6400, CIN, 1024, WIN, 2048, 0, 5632, scr, r, lane); continue; } r -= c2b;
        if (r < c2c) { tr_item(w_in + 5376, CIN, 1024 - 256 * ZSPLIT, WIN, 2048, 0, 6656, scr, r, lane); continue; } r -= c2c;
        if (r < c2d) { tr_item(w_in + 6400 - 256 * ZSPLIT, CIN, 256 * ZSPLIT, (bf16*)(ws + WS_WINB + (size_t)(layer & 1) * WINB_BYTES), 2048, 0, 0, scr, r, lane); continue; } r -= c2d;
        if (r < c3) { tr_item(a.in[16] + (size_t)(layer - 1) * 2048 * 32, 32, 32, WIN, 2048, 0, 3328, scr, r, lane); continue; } r -= c3;
        if (r < c4) { tr_item(a.in[7] + (size_t)layer * 64 * 1024, 1024, 1024, LORA, 128, 0, 0, scr, r, lane); continue; } r -= c4;
        if (r < c5) { tr_item(a.in[9] + (size_t)layer * 64 * 1024, 1024, 1024, LORA, 128, 64, 1024, scr, r, lane); continue; } r -= c5;
        if (r < c6) { tr_item(a.in[10] + (size_t)layer * 128 * 1024, 1024, 1024, LORA + 2048 * 128, 128, 0, 0, scr, r, lane); continue; } r -= c6;
        if (r < c7) { tr_item(a.in[23] + (size_t)layer * D * D, D, D, (bf16*)(db + DB_PA), D, 0, 0, scr, r, lane); continue; } r -= c7;
        if (r < c7) { tr_item(a.in[24] + (size_t)layer * D * D, D, D, (bf16*)(db + DB_PBT), D, 0, 0, scr, r, lane); continue; } r -= c7;
        if (r < c7) { tr_item(a.in[25] + (size_t)layer * D * D, D, D, (bf16*)(db + DB_POUT), D, 0, 0, scr, r, lane); continue; } r -= c7;
        if (r < c10) { tr_item(a.in[26] + (size_t)layer * D * 2048, 2048, 2048, (bf16*)(db + DB_WQG), D, 0, 0, scr, r, lane); continue; } r -= c10;
        if (r < c7) { tr_item(a.in[31] + (size_t)layer * D * D, D, D, (bf16*)(db + DB_WQG), D, 0, 2048, scr, r, lane); continue; } r -= c7;
        tr_item(a.in[30] + (size_t)layer * 256 * D, D, D, (bf16*)(db + DB_PLEW), 256, 0, 0, scr, r, lane);
    }
    if (layer > 0 && (part & 1)) {
        const float* w2 = a.in[17] + (size_t)(layer - 1) * 32 * 1024;
        for (int it = gw; it < 512; it += NGW) { const int e = it * 64 + lane, n = e >> 5, k = e & 31; MVT[n * 128 + k] = (bf16)(cvt_pk_bf16(w2[k * 1024 + n], 0.f) & 0xffffu); }
    }
    {
        const float* keys = a.in[27] + (size_t)layer * 262144; const float* ut = a.in[28] + (size_t)layer * 16777216; const float* vt = a.in[29] + (size_t)layer * 16777216;
        const float* pin = a.in[1] + (size_t)layer * T * 256; const float* gws = a.in[21] + (size_t)layer * 131072;
        const int n1 = (part & 1) ? 512 : 0, n2 = (part & 2) ? 32768 : 0, n4 = (part & 1) ? 16384 : 0, n5 = (part & 1) ? 256 : 0, ntot = n1 + 2 * n2 + n4 + n5;
        for (int it = gw; it < ntot; it += NGW) {
            int r = it;
            if (r < n2) { cvt8_chunk(ut, (unsigned char*)(db + DB_U), r, lane, 256.f); continue; } r -= n2;
            if (r < n2) { cvt8_chunk(vt, (unsigned char*)(db + DB_V), r, lane, 64.f); continue; } r -= n2;
            if (r < n4) { cvt_chunk(pin, (bf16*)(db + DB_PB), r, lane); continue; } r -= n4;
            if (r < n1) { cvt_chunk(keys, (bf16*)(db + DB_KEYS), r, lane); continue; } r -= n1;
            {
                const int e0 = r * 512 + lane * 8, tq = (e0 >> 7) & 127, p0 = e0 & 127;
                const f32x4* s = (const f32x4*)(gws + e0); f32x4 x0 = s[0], x1 = s[1];
#pragma unroll
                for (int j = 0; j < 4; ++j) { if (p0 + j > tq) x0[j] = 0.f; if (p0 + 4 + j > tq) x1[j] = 0.f; }
                *(v4u*)((bf16*)(db + DB_GMW) + e0) = pk8(x0, x1);
            }
        }
    }
    if (layer == 0 && (part & 1)) {
        for (int m = gw; m < T; m += NGW) norm_row_nx(a.in[0] + (size_t)m * D, F.h + (size_t)m * D, a.in[2], (bf16*)(ws + WS_NX), m, lane);
    }
}

constexpr int SC = 32, NPR = SC / 2;
constexpr int SC_VEC = SC * 64;
constexpr int SC_WW = 0, SC_VQ = NPR * 64, SC_BK = SC_VQ + NPR * 256, SC_XA = SC_BK + NPR * 128, SC_C = SC_XA + NPR * 128, SC_VP = SC_C + NPR * 20, SC_BON = SC_VP + SC * 64, SC_BUF = SC_BON + SC * 8;
static_assert(SC_BUF % 4 == 0 && SC_C % 4 == 0 && (2 * SC_BUF + 2 * SC_VEC) * 4 + 64 <= 131072, "scan LDS map");
struct ScanOps { f32x4 w[4], vq, c[4]; v4u bk[2]; bf16x8 x[2]; };
__device__ __forceinline__ void scan_load2(ScanOps& o, const LAS float* buf, const LAS float* vqp, const LAS unsigned char* bkp, int bkstep, int p, int lane) {
    const int q = lane >> 4;
    const LAS float* wp = buf + SC_WW + p * 64 + q * 4;
#pragma unroll
    for (int i = 0; i < 4; ++i) o.w[i] = *(const LAS f32x4*)(wp + 16 * i);
    o.vq = *(const LAS f32x4*)(vqp + p * 256);
    o.bk[0] = *(const LAS v4u*)(bkp + p * bkstep); o.bk[1] = *(const LAS v4u*)(bkp + p * bkstep + 16);
    const LAS unsigned char* xp = (const LAS unsigned char*)(buf + SC_XA) + p * 512 + (lane & 3) * 128 + q * 16;
    o.x[0] = *(const LAS bf16x8*)xp; o.x[1] = *(const LAS bf16x8*)(xp + 64);
#pragma unroll
    for (int i = 0; i < 4; ++i) o.c[i] = *(const LAS f32x4*)(buf + SC_C + p * 20 + 4 * i);
}
__device__ __forceinline__ const char* uni_ptr(const char* p) { const unsigned long long a = (unsigned long long)p;
    const unsigned lo = (unsigned)__builtin_amdgcn_readfirstlane((int)(unsigned)a), hi = (unsigned)__builtin_amdgcn_readfirstlane((int)(unsigned)(a >> 32));
    return (const char*)(((unsigned long long)hi << 32) | lo); }
__device__ __forceinline__ float smul(float a, float b) { float r; asm("v_mul_f32 %0, %1, %2" : "=v"(r) : "v"(a), "v"(b)); return r; }
__device__ __forceinline__ void scan_pair(const ScanOps& o, f32x4 (&St)[4], float& sa0, float& sa1, v4u (&am)[4], v4u& bm, LAS float* ypt, int ystep, unsigned m16) {
    v4u s0, s1;
    s0.x = cvt_pk_bf16(St[0].x, St[0].y); s0.y = cvt_pk_bf16(St[0].z, St[0].w); s0.z = cvt_pk_bf16(St[1].x, St[1].y); s0.w = cvt_pk_bf16(St[1].z, St[1].w);
    s1.x = cvt_pk_bf16(St[2].x, St[2].y); s1.y = cvt_pk_bf16(St[2].z, St[2].w); s1.z = cvt_pk_bf16(St[3].x, St[3].y); s1.w = cvt_pk_bf16(St[3].z, St[3].w);
    f32x4 dv = (f32x4){0.f, 0.f, 0.f, 0.f};
    dv = __builtin_amdgcn_mfma_f32_16x16x32_bf16(o.x[0], __builtin_bit_cast(bf16x8, s0), dv, 0, 0, 0);
    dv = __builtin_amdgcn_mfma_f32_16x16x32_bf16(o.x[1], __builtin_bit_cast(bf16x8, s1), dv, 0, 0, 0);
    const float v0 = o.vq.x, v1 = o.vq.y, v2 = o.vq.z;
    typedef short s16x4 __attribute__((ext_vector_type(4)));
    const v2u bm2 = (v2u){cvt_pk_bf16(sa0, v0) & m16, cvt_pk_bf16(sa1, v1) & m16};
#pragma unroll
    for (int i = 0; i < 4; ++i) { const v2u a2 = (v2u){o.bk[i >> 1][(i & 1) * 2], o.bk[i >> 1][(i & 1) * 2 + 1]};
        St[i] = __builtin_amdgcn_mfma_f32_16x16x16bf16_1k(__builtin_bit_cast(s16x4, a2), __builtin_bit_cast(s16x4, bm2),
                                                        (f32x4){smul(St[i].x, o.w[i].x), smul(St[i].y, o.w[i].y), smul(St[i].z, o.w[i].z), smul(St[i].w, o.w[i].w)}, 0, 0, 0); }
    ypt[0]     = dv.z + sa0 * o.c[2].z + v0 * o.c[2].w;
    ypt[ystep] = dv.w + sa0 * o.c[3].x + v0 * o.c[3].y + sa1 * o.c[3].z + v1 * o.c[3].w;
    const float n0 = dv.x + sa0 * o.c[0].x + v0 * o.c[0].y + sa1 * o.c[0].z + v1 * o.c[0].w;
    const float n1 = dv.y + sa0 * o.c[1].x + v0 * o.c[1].y + sa1 * o.c[1].z + v1 * o.c[1].w + n0 * o.c[2].x + v2 * o.c[2].y;
    sa0 = n0; sa1 = n1;
}
__device__ __forceinline__ void scan_unit(Frame& F, const Args& a, int layer, int unit) {
    phase_ids(F);
    const int b = unit >> 4, hh = unit & 15, tid = F.tid, lane = F.lane, wave = F.wave;
    LAS float* bufs = (LAS float*)F.lds;
    LAS float* sY = bufs + 2 * SC_BUF;
    const bf16* ZR = (const bf16*)(F.ws + WS_ZRKV); const bf16* EW = (const bf16*)(F.ws + WS_EW); const bf16* AR = (const bf16*)(F.ws + WS_AR); const bf16* GT = (const bf16*)(F.ws + WS_G);
    bf16* YA = (bf16*)(F.ws + WS_G);
    constexpr int NCH = SEQ / SC;
    if (wave < 4) {
        f32x4 St[4]; v4u am[4], bm = (v4u){0u, 0u, 0u, 0u};
#pragma unroll
        for (int i = 0; i < 4; ++i) { St[i] = (f32x4){0.f, 0.f, 0.f, 0.f}; am[i] = (v4u){0u, 0u, 0u, 0u}; }
        float sa0 = 0.f, sa1 = 0.f;
        const unsigned m16 = lane < 16 ? 0xffffffffu : 0u;
        LAS unsigned char* zblk = (LAS unsigned char*)(sY + 2 * SC_VEC);
        if (tid < 8) ((LAS unsigned*)zblk)[tid] = 0u;
        const int bkstep = lane < 16 ? 512 : 0;
        for (int it = 0; it < NCH + 2; ++it) {
            if (it >= 1 && it <= NCH) {
                const LAS float* bufc = bufs + ((it - 1) & 1) * SC_BUF;
                const LAS float* vqp = bufc + SC_VQ + 4 * (wave * 16 + (lane & 15));
                const LAS unsigned char* bkp = lane < 16 ? (const LAS unsigned char*)(bufc + SC_BK) + lane * 32 : (const LAS unsigned char*)zblk;
                LAS float* yb = lane < 16 ? sY + ((it - 1) & 1) * SC_VEC + wave * 16 + lane : (LAS float*)(zblk + 32);
                const int ystep = lane < 16 ? 64 : 0;
                if (it == 1) { sa0 = 0.f; sa1 = vqp[0] * bufc[SC_C + 16]; }
                ScanOps o0, o1;
                scan_load2(o0, bufc, vqp, bkp, bkstep, 0, lane);
#pragma unroll 1
                for (int p = 0; p < NPR; p += 2) {
                    scan_load2(o1, bufc, vqp, bkp, bkstep, p + 1, lane);
                    scan_pair(o0, St, sa0, sa1, am, bm, yb + (2 * p) * ystep, ystep, m16);
                    if (p + 2 < NPR) scan_load2(o0, bufc, vqp, bkp, bkstep, p + 2, lane);
                    scan_pair(o1, St, sa0, sa1, am, bm, yb + (2 * p + 2) * ystep, ystep, m16);
                }
            }
            __syncthreads();
        }
    } else {
        const int ht = tid - 256, tl = ht >> 3, c8 = ht & 7, ch = hh * 64 + c8 * 8;
        const int pr = ht >> 4, c4 = ht & 15, chp = hh * 64 + c4 * 4;
        const size_t po = (size_t)layer * 1024 + ch, pop = (size_t)layer * 1024 + chp;
        struct HelpIn { v2u r0, k0, v0, e0, a0, r1, k1, v1, e1, a1, k2, v2, e2, a2, k3; v4u gt; };
        HelpIn cur, nxt;
#define HELP_ROW(H, F_, RR, OFF, ARR, PITCH) (H).F_ = *(const v2u*)((ARR) + ((size_t)b * SEQ + (RR)) * (PITCH) + (OFF) + chp)
#define HELP_LOAD(H, PC, GC) do { \
            if ((PC) < NCH) { const int _t = (PC) * SC + 2 * pr; \
                HELP_ROW(H, r0, _t, 0, ZR, 3072); HELP_ROW(H, k0, _t, 1024, ZR, 3072); HELP_ROW(H, v0, _t, 2048, ZR, 3072); HELP_ROW(H, e0, _t, 0, EW, 1024); HELP_ROW(H, a0, _t, 0, AR, 1024); \
                HELP_ROW(H, r1, _t + 1, 0, ZR, 3072); HELP_ROW(H, k1, _t + 1, 1024, ZR, 3072); HELP_ROW(H, v1, _t + 1, 2048, ZR, 3072); HELP_ROW(H, e1, _t + 1, 0, EW, 1024); HELP_ROW(H, a1, _t + 1, 0, AR, 1024); \
                HELP_ROW(H, k2, _t + 2, 1024, ZR, 3072); HELP_ROW(H, v2, _t + 2, 2048, ZR, 3072); HELP_ROW(H, e2, _t + 2, 0, EW, 1024); HELP_ROW(H, a2, _t + 2, 0, AR, 1024); \
                HELP_ROW(H, k3, _t + 3, 1024, ZR, 3072); } \
            if ((GC) >= 0 && (GC) < NCH) { const size_t _row = (size_t)b * SEQ + (size_t)(GC) * SC + tl; (H).gt = *(const v4u*)(GT + _row * 1024 + ch); } } while (0)
#define UNP4(W) ((f32x4){bflo((W).x), bfhi((W).x), bflo((W).y), bfhi((W).y)})
#define EXP4(E) ((f32x4){__builtin_amdgcn_exp2f(-1.44269504f * (E).x), __builtin_amdgcn_exp2f(-1.44269504f * (E).y), __builtin_amdgcn_exp2f(-1.44269504f * (E).z), __builtin_amdgcn_exp2f(-1.44269504f * (E).w)})
#define DOT4(A, B) (((A).x * (B).x + (A).y * (B).y) + ((A).z * (B).z + (A).w * (B).w))
#define SUM16(X) sum16_ns(X)
#ifdef PROBE_SCAN
        unsigned long long ph_act = 0ull;
#endif
        HELP_LOAD(cur, 0, -2);
        for (int it = 0; it < NCH + 2; ++it) {
#ifdef PROBE_SCAN
            const unsigned long long ph0 = __builtin_amdgcn_s_memtime();
#endif
            HELP_LOAD(nxt, it + 1, it - 1);
            if (it >= 2) {
                const LAS float* buf = bufs + (it & 1) * SC_BUF; const LAS float* yb = sY + (it & 1) * SC_VEC;
                const size_t row = (size_t)b * SEQ + (size_t)(it - 2) * SC + tl; const int o = tl * 64 + c8 * 8;
                f32x4 y_[2], v_[2], g_[2];
#pragma unroll
                for (int i = 0; i < 2; ++i) { y_[i] = *(const LAS f32x4*)(yb + o + 4 * i); v_[i] = *(const LAS f32x4*)(buf + SC_VP + o + 4 * i); }
                const float bon = buf[SC_BON + tl * 8 + c8];
                unpk8(cur.gt, g_[0], g_[1]);
                const float s1 = ((y_[0].x + y_[0].y) + (y_[0].z + y_[0].w)) + ((y_[1].x + y_[1].y) + (y_[1].z + y_[1].w));
                const float mu = sum8(s1) * (1.f / 64.f);
                float s2 = 0.f;
#pragma unroll
                for (int i = 0; i < 2; ++i) { y_[i] = y_[i] - mu; const f32x4 q = y_[i] * y_[i]; s2 += (q.x + q.y) + (q.z + q.w); }
                const float rstd = __builtin_amdgcn_rsqf(sum8(s2) * (1.f / 64.f) + 64e-5f);
                f32x4 o_[2];
#pragma unroll
                for (int i = 0; i < 2; ++i) o_[i] = (y_[i] * rstd * *(const f32x4*)(a.in[14] + po + 4 * i) + *(const f32x4*)(a.in[15] + po + 4 * i) + bon * v_[i]) * g_[i];
                *(v4u*)(YA + row * 1024 + ch) = pk8(o_[0], o_[1]);
            }
            if (it < NCH) {
                LAS float* buf = bufs + (it & 1) * SC_BUF;
                const f32x4 pkk_ = *(const f32x4*)(a.in[11] + pop), pka_ = *(const f32x4*)(a.in[12] + pop), prk_ = *(const f32x4*)(a.in[13] + pop);
                const f32x4 zk0 = UNP4(cur.k0), zk1 = UNP4(cur.k1), zk2 = UNP4(cur.k2), zk3 = UNP4(cur.k3);
                f32x4 kn0 = zk0 * pkk_, kn1 = zk1 * pkk_, kn2 = zk2 * pkk_, kn3 = zk3 * pkk_;
                kn0 = kn0 * __builtin_amdgcn_rsqf(fmaxf(SUM16(DOT4(kn0, kn0)), 1e-24f)); kn1 = kn1 * __builtin_amdgcn_rsqf(fmaxf(SUM16(DOT4(kn1, kn1)), 1e-24f));
                kn2 = kn2 * __builtin_amdgcn_rsqf(fmaxf(SUM16(DOT4(kn2, kn2)), 1e-24f)); kn3 = kn3 * __builtin_amdgcn_rsqf(fmaxf(SUM16(DOT4(kn3, kn3)), 1e-24f));
                const f32x4 r0 = UNP4(cur.r0), r1 = UNP4(cur.r1), v0 = UNP4(cur.v0), v1 = UNP4(cur.v1), v2 = UNP4(cur.v2);
                const f32x4 ar0 = UNP4(cur.a0), ar1 = UNP4(cur.a1), ar2 = UNP4(cur.a2);
                const f32x4 e0 = UNP4(cur.e0), e1 = UNP4(cur.e1), e2 = UNP4(cur.e2);
                const f32x4 w0 = EXP4(e0), w1 = EXP4(e1), w2 = EXP4(e2);
                const f32x4 a1v = -kn1, a2v = -kn2, a3v = -kn3;
                const f32x4 b0 = kn0 * ar0, b1 = kn1 * ar1, b2 = kn2 * ar2;
                const f32x4 kp0 = zk0 * (1.f + (ar0 - 1.f) * pka_), kp1 = zk1 * (1.f + (ar1 - 1.f) * pka_), kp2 = zk2 * (1.f + (ar2 - 1.f) * pka_);
                const f32x4 W2 = w0 * w1, Bt = b0 * w1, Kt = kp0 * w1, x0v = a2v, x1v = w2 * a3v;
                const f32x4 X0 = W2 * x0v, X1 = W2 * x1v, X2 = w0 * r0, X3 = W2 * r1;
                *(LAS f32x4*)(buf + SC_WW + pr * 64 + c4 * 4) = W2;
                *(LAS f32x4*)(buf + SC_VP + (2 * pr) * 64 + c4 * 4) = v0; *(LAS f32x4*)(buf + SC_VP + (2 * pr + 1) * 64 + c4 * 4) = v1;
                { LAS f32x4* vq = (LAS f32x4*)(buf + SC_VQ + pr * 256 + c4 * 16);
                  vq[0] = (f32x4){v0.x, v1.x, v2.x, 0.f}; vq[1] = (f32x4){v0.y, v1.y, v2.y, 0.f}; vq[2] = (f32x4){v0.z, v1.z, v2.z, 0.f}; vq[3] = (f32x4){v0.w, v1.w, v2.w, 0.f}; }
                { LAS v2u* bkp = (LAS v2u*)(buf + SC_BK + pr * 128) + (((c4 & 3) * 4) * 4 + (c4 >> 2));
                  bkp[0] = (v2u){cvt_pk_bf16(Bt.x, Kt.x), cvt_pk_bf16(b1.x, kp1.x)}; bkp[4] = (v2u){cvt_pk_bf16(Bt.y, Kt.y), cvt_pk_bf16(b1.y, kp1.y)};
                  bkp[8] = (v2u){cvt_pk_bf16(Bt.z, Kt.z), cvt_pk_bf16(b1.z, kp1.z)}; bkp[12] = (v2u){cvt_pk_bf16(Bt.w, Kt.w), cvt_pk_bf16(b1.w, kp1.w)}; }
                { LAS unsigned char* xp = (LAS unsigned char*)(buf + SC_XA) + pr * 512 + (c4 >> 3) * 64 + (c4 & 3) * 16 + ((c4 >> 2) & 1) * 8;
                  *(LAS v2u*)xp = (v2u){cvt_pk_bf16(X0.x, X0.y), cvt_pk_bf16(X0.z, X0.w)}; *(LAS v2u*)(xp + 128) = (v2u){cvt_pk_bf16(X1.x, X1.y), cvt_pk_bf16(X1.z, X1.w)};
                  *(LAS v2u*)(xp + 256) = (v2u){cvt_pk_bf16(X2.x, X2.y), cvt_pk_bf16(X2.z, X2.w)}; *(LAS v2u*)(xp + 384) = (v2u){cvt_pk_bf16(X3.x, X3.y), cvt_pk_bf16(X3.z, X3.w)}; }
                const f32x4 ca = (f32x4){SUM16(DOT4(Bt, x0v)), SUM16(DOT4(Kt, x0v)), SUM16(DOT4(b1, x0v)), SUM16(DOT4(kp1, x0v))};
                const f32x4 cb = (f32x4){SUM16(DOT4(Bt, x1v)), SUM16(DOT4(Kt, x1v)), SUM16(DOT4(b1, x1v)), SUM16(DOT4(kp1, x1v))};
                const f32x4 cc = (f32x4){SUM16(DOT4(b2, a3v)), SUM16(DOT4(kp2, a3v)), SUM16(DOT4(b0, r0)), SUM16(DOT4(kp0, r0))};
                const f32x4 cd = (f32x4){SUM16(DOT4(Bt, r1)), SUM16(DOT4(Kt, r1)), SUM16(DOT4(b1, r1)), SUM16(DOT4(kp1, r1))};
                const float ci = SUM16(DOT4(kp0, a1v));
                const f32x4 z0 = r0 * kp0 * prk_, z1 = r1 * kp1 * prk_;
                const float bon0 = SUM16((z0.x + z0.y) + (z0.z + z0.w)), bon1 = SUM16((z1.x + z1.y) + (z1.z + z1.w));
                if (c4 == 0) { LAS f32x4* cp = (LAS f32x4*)(buf + SC_C + pr * 20); cp[0] = ca; cp[1] = cb; cp[2] = cc; cp[3] = cd; cp[4] = (f32x4){ci, 0.f, 0.f, 0.f}; }
                buf[SC_BON + (2 * pr) * 8 + (c4 >> 1)] = bon0; buf[SC_BON + (2 * pr + 1) * 8 + (c4 >> 1)] = bon1;
            }
            cur = nxt;
#ifdef PROBE_SCAN
            asm volatile("s_waitcnt vmcnt(0) lgkmcnt(0)" ::: "memory"); ph_act += __builtin_amdgcn_s_memtime() - ph0;
#endif
            __syncthreads();
        }
#ifdef PROBE_SCAN
        if (unit == 0 && layer == DEPTH - 1 && tid == 256) ((float*)(F.ws + WS_CTL))[2048 + 2] = rintf((float)ph_act / (float)(NCH + 2) * (1.f / 2000.f));
#endif
#undef HELP_LOAD
#undef HELP_ROW
#undef UNP4
#undef EXP4
#undef DOT4
#undef SUM16
    }
}

constexpr int TP = 136;
__device__ __forceinline__ void mma_128(const LAS bf16* sA, const LAS bf16* sBt, int wave, int lane, f32x4 (&acc)[4][2]) {
    const int wm = wave >> 2, wn = wave & 3, fr = lane & 15, fq = lane >> 4;
#pragma unroll
    for (int kk = 0; kk < 4; ++kk) {
        bf16x8 af[4], bf_[2];
#pragma unroll
        for (int mt = 0; mt < 4; ++mt) af[mt] = *(const LAS bf16x8*)(sA + (64 * wm + 16 * mt + fr) * TP + 32 * kk + 8 * fq);
#pragma unroll
        for (int nt = 0; nt < 2; ++nt) bf_[nt] = *(const LAS bf16x8*)(sBt + (32 * wn + 16 * nt + fr) * TP + 32 * kk + 8 * fq);
#pragma unroll
        for (int mt = 0; mt < 4; ++mt)
#pragma unroll
            for (int nt = 0; nt < 2; ++nt) acc[mt][nt] = __builtin_amdgcn_mfma_f32_16x16x32_bf16(bf_[nt], af[mt], acc[mt][nt], 0, 0, 0);
    }
}
__device__ __forceinline__ void gmlp_unit(Frame& F, const Args& a, int layer, int unit) {
    phase_ids(F);
    const size_t t0 = (size_t)unit * 128; const int tid = F.tid, lane = F.lane, wave = F.wave;
    LAS float* st = (LAS float*)F.lds; LAS bf16* sA = (LAS bf16*)(F.lds + 1024); LAS bf16* sB = (LAS bf16*)(F.lds + 1024 + 128 * TP * 2);
    bf16* GUV = (bf16*)(F.ws + WS_GUV); const bf16* GMW = (const bf16*)(F.ws + WS_DB + (size_t)(layer & 1) * DB_SET + DB_GMW);
    const float* lng = a.in[19] + (size_t)layer * 1024; const float* lnb = a.in[20] + (size_t)layer * 1024; const float* bsp = a.in[22] + (size_t)layer * 1024;
    for (int r = 0; r < 16; ++r) { const int tok = wave * 16 + r; const bf16* rowp = GUV + (t0 + tok) * 2048 + 1024;
        f32x4 x0, x1, x2, x3; unpk8(*(const v4u*)(rowp + lane * 8), x0, x1); unpk8(*(const v4u*)(rowp + 512 + lane * 8), x2, x3);
        const f32x4 sv = (x0 + x1) + (x2 + x3), qv = (x0 * x0 + x1 * x1) + (x2 * x2 + x3 * x3);
        const float s = wave_sum((sv.x + sv.y) + (sv.z + sv.w)), q = wave_sum((qv.x + qv.y) + (qv.z + qv.w));
        const float mean = s * (1.f / 1024.f), var = fmaxf(q * (1.f / 1024.f) - mean * mean, 0.f);
        if (lane == 0) { st[tok * 2] = mean; st[tok * 2 + 1] = 1.f / sqrtf(var + 1e-5f); } }
    __syncthreads();
    for (int g = 0; g < 8; ++g) {
#pragma unroll
        for (int i = 0; i < 4; ++i) { const int pc = tid + 512 * i, rr = pc >> 4, c16 = pc & 15;
            *(LAS v4u*)(sA + rr * TP + c16 * 8) = *(const v4u*)(GMW + (size_t)g * 16384 + rr * 128 + c16 * 8); }
        { const int p = tid & 127, oc0 = tid >> 7; const float mean = st[p * 2], rstd = st[p * 2 + 1];
#pragma unroll
          for (int i = 0; i < 4; ++i) { const int oc = oc0 + 4 * i, c0 = g * 128 + oc * 8;
              f32x4 x0, x1; unpk8(*(const v4u*)(GUV + (t0 + p) * 2048 + 1024 + c0), x0, x1);
              const f32x4 g0 = *(const f32x4*)(lng + c0), g1 = *(const f32x4*)(lng + c0 + 4), b0 = *(const f32x4*)(lnb + c0), b1 = *(const f32x4*)(lnb + c0 + 4);
              x0 = (x0 - mean) * rstd * g0 + b0; x1 = (x1 - mean) * rstd * g1 + b1;
              const v4u w = pk8(x0, x1);
              LAS bf16* d = sB + (oc * 8) * TP + p;
              d[0 * TP] = (bf16)(w.x & 0xffffu); d[1 * TP] = (bf16)(w.x >> 16); d[2 * TP] = (bf16)(w.y & 0xffffu); d[3 * TP] = (bf16)(w.y >> 16);
              d[4 * TP] = (bf16)(w.z & 0xffffu); d[5 * TP] = (bf16)(w.z >> 16); d[6 * TP] = (bf16)(w.w & 0xffffu); d[7 * TP] = (bf16)(w.w >> 16); } }
        __syncthreads();
        f32x4 acc[4][2];
#pragma unroll
        for (int mt = 0; mt < 4; ++mt)
#pragma unroll
            for (int nt = 0; nt < 2; ++nt) acc[mt][nt] = (f32x4){0.f, 0.f, 0.f, 0.f};
        mma_128(sA, sB, wave, lane, acc);
        { const int wm = wave >> 2, wn = wave & 3, fr = lane & 15, fq = lane >> 4;
#pragma unroll
          for (int mt = 0; mt < 4; ++mt) { const int tt = 64 * wm + 16 * mt + fr; const float bsv = bsp[g * 128 + tt];
#pragma unroll
              for (int nt = 0; nt < 2; ++nt) { const int c = g * 128 + 32 * wn + 16 * nt + 4 * fq;
                  const v2u uw = *(const v2u*)(GUV + (t0 + tt) * 2048 + c);
                  const f32x4 u4 = (f32x4){bflo(uw.x), bfhi(uw.x), bflo(uw.y), bfhi(uw.y)};
                  const f32x4 yb = u4 * (acc[mt][nt] + bsv);
                  v2u ow; ow.x = cvt_pk_bf16(yb.x, yb.y); ow.y = cvt_pk_bf16(yb.z, yb.w);
                  *(v2u*)(GUV + (t0 + tt) * 2048 + c) = ow; } } }
        __syncthreads();
    }
}

__device__ __forceinline__ unsigned fkey(float f) { const unsigned u = __builtin_bit_cast(unsigned, f); return (u & 0x80000000u) ? ~u : (u | 0x80000000u); }
__device__ __forceinline__ float kval(unsigned k, unsigned mask) { const unsigned u = k & mask; return __builtin_bit_cast(float, (u & 0x80000000u) ? (u ^ 0x80000000u) : ~u); }
__device__ __forceinline__ float swap32_add(float a, float b) { const auto r = __builtin_amdgcn_permlane32_swap(__builtin_bit_cast(unsigned, a), __builtin_bit_cast(unsigned, b), false, false);
    return __builtin_bit_cast(float, (unsigned)r[0]) + __builtin_bit_cast(float, (unsigned)r[1]); }
__device__ __forceinline__ float swap16_add(float a, float b) { const auto r = __builtin_amdgcn_permlane16_swap(__builtin_bit_cast(unsigned, a), __builtin_bit_cast(unsigned, b), false, false);
    return __builtin_bit_cast(float, (unsigned)r[0]) + __builtin_bit_cast(float, (unsigned)r[1]); }
__device__ __forceinline__ float row_sum16(float x) {
    x += __builtin_bit_cast(float, __builtin_amdgcn_update_dpp(0, __builtin_bit_cast(int, x), 0x128, 0xf, 0xf, false));
    x += __builtin_bit_cast(float, __builtin_amdgcn_update_dpp(0, __builtin_bit_cast(int, x), 0x124, 0xf, 0xf, false));
    x += __builtin_bit_cast(float, __builtin_amdgcn_update_dpp(0, __builtin_bit_cast(int, x), 0x122, 0xf, 0xf, false));
    x += __builtin_bit_cast(float, __builtin_amdgcn_update_dpp(0, __builtin_bit_cast(int, x), 0x121, 0xf, 0xf, false));
    return x; }
#define CE_DESC(a, b) do { const unsigned _h = max((a), (b)), _l = min((a), (b)); (a) = _h; (b) = _l; } while (0)
template <int OFF> __device__ __forceinline__ void bitonic_merge16(unsigned (&x)[32]) {
#pragma unroll
    for (int j = 8; j >= 1; j >>= 1)
#pragma unroll
        for (int i = 0; i < 16; ++i) { const int l = i ^ j; if (l > i) CE_DESC(x[OFF + i], x[OFF + l]); }
}
template <int OFF> __device__ __forceinline__ void bitonic_sort16(unsigned (&x)[32]) {
#pragma unroll
    for (int k = 2; k <= 16; k <<= 1)
#pragma unroll
        for (int j = k >> 1; j >= 1; j >>= 1)
#pragma unroll
            for (int i = 0; i < 16; ++i) { const int l = i ^ j; if (l > i) { if ((i & k) == 0 || k == 16) CE_DESC(x[OFF + i], x[OFF + l]); else CE_DESC(x[OFF + l], x[OFF + i]); } }
}
#ifndef REP_K
#define REP_K 1
#endif
#define TOP_INSERT(top, x) do { unsigned _x = (x); _Pragma("unroll") for (int _j = 0; _j < 16; ++_j) { const unsigned _h = max((top)[_j], _x); _x = min((top)[_j], _x); (top)[_j] = _h; } } while (0)
__device__ __forceinline__ void peer_token_end(Frame& F, const Args& a, int layer, bool last, bool final_half, size_t tok, int lane, const f32x2 (&out)[8], const f32x4 (&hpre)[4], const v4u (&gpre)[2]) {
    float* hp = F.h + tok * 1024 + 16 * lane;
    f32x4 hv[4], ge[4]; float s = 0.f;
    unpk8(gpre[0], ge[0], ge[1]); unpk8(gpre[1], ge[2], ge[3]);
    if (!final_half) {
        bf16* gp = (bf16*)(F.ws + WS_PW) + tok * 1024 + 16 * lane;
        *(v4u*)gp = pk8(ge[0] + (f32x4){out[0].x, out[0].y, out[1].x, out[1].y}, ge[1] + (f32x4){out[2].x, out[2].y, out[3].x, out[3].y});
        *(v4u*)(gp + 8) = pk8(ge[2] + (f32x4){out[4].x, out[4].y, out[5].x, out[5].y}, ge[3] + (f32x4){out[6].x, out[6].y, out[7].x, out[7].y});
        return; }
#pragma unroll
    for (int i = 0; i < 4; ++i) { hv[i] = hpre[i] + ge[i] + (f32x4){out[2 * i].x, out[2 * i].y, out[2 * i + 1].x, out[2 * i + 1].y};
        s += (hv[i].x * hv[i].x + hv[i].y * hv[i].y) + (hv[i].z * hv[i].z + hv[i].w * hv[i].w); }
    const float rstd = 1.f / sqrtf(wave_sum(s) * (1.f / D) + 1e-6f);
    const float* g = (last ? a.in[4] : a.in[2] + (size_t)(layer + 1) * 1024) + 16 * lane;
    f32x4 o[4];
#pragma unroll
    for (int i = 0; i < 4; ++i) o[i] = hv[i] * rstd * *(const f32x4*)(g + 4 * i);
    if (last) {
#ifdef PROBE_SCAN
        { const float pv = ((const float*)(F.ws + WS_CTL))[2048 + PROBE_SCAN - 1];
#pragma unroll
          for (int i = 0; i < 4; ++i) o[i] = o[i] + pv; }
#endif
#pragma unroll
        for (int i = 0; i < 4; ++i) *(f32x4*)(hp + 4 * i) = o[i];
    } else {
#pragma unroll
        for (int i = 0; i < 4; ++i) *(f32x4*)(hp + 4 * i) = hv[i];
        bf16* NX = (bf16*)(F.ws + WS_NX); const v4u w0 = pk8(o[0], o[1]), w1 = pk8(o[2], o[3]); const int tt = (int)(tok & (SEQ - 1));
        *(v4u*)(NX + tok * 2048 + 16 * lane) = w0; *(v4u*)(NX + tok * 2048 + 16 * lane + 8) = w1;
        if (tt != SEQ - 1) { *(v4u*)(NX + (tok + 1) * 2048 + 1024 + 16 * lane) = w0; *(v4u*)(NX + (tok + 1) * 2048 + 1024 + 16 * lane + 8) = w1; }
        if (tt == 0) { *(v4u*)(NX + tok * 2048 + 1024 + 16 * lane) = (v4u){0u, 0u, 0u, 0u}; *(v4u*)(NX + tok * 2048 + 1024 + 16 * lane + 8) = (v4u){0u, 0u, 0u, 0u}; }
    }
}
__device__ __forceinline__ void peer_unit(Frame& F, const Args& a, int layer, int unit, bool last) {
    phase_ids(F);
    const size_t t0 = (size_t)unit * 128; const int tid = F.tid, lane = F.lane, wave = F.wave, fr = lane & 15, fq = lane >> 4;
    LAS bf16* sKey = (LAS bf16*)F.lds;
    LAS unsigned* sLT = (LAS unsigned*)(F.lds + 2 * 128 * TP * 2) + wave * 512;
    const bf16* Q = (const bf16*)(F.ws + WS_Q); const bf16* KEYS = (const bf16*)(F.ws + WS_DB + (size_t)(layer & 1) * DB_SET + DB_KEYS); v2u* SEL = (v2u*)(F.ws + WS_SEL);
    const size_t trow = t0 + wave * 16 + fr;
    constexpr float KOFF = 32.f;
    v4u ktn[4]; bf16x8 qfn[4];
#define K_FETCH(J) do { _Pragma("unroll") for (int _i = 0; _i < 4; ++_i) { const int _pc = tid + 512 * _i, _rr = _pc >> 4, _c16 = _pc & 15; ktn[_i] = *(const v4u*)(KEYS + (size_t)(J) * 16384 + _rr * 128 + _c16 * 8); } \
        _Pragma("unroll") for (int _kk = 0; _kk < 4; ++_kk) qfn[_kk] = *(const bf16x8*)(Q + trow * 2048 + (J) * 128 + 32 * _kk + 8 * fq); } while (0)
#define K_STORE(J) do { _Pragma("unroll") for (int _i = 0; _i < 4; ++_i) { const int _pc = tid + 512 * _i, _rr = _pc >> 4, _c16 = _pc & 15; *(LAS v4u*)(sKey + ((J) & 1) * 128 * TP + _rr * TP + _c16 * 8) = ktn[_i]; } } while (0)
    for (int krep = 0; krep < REP_K; ++krep) {
    __syncthreads();
    K_FETCH(0); K_STORE(0);
    bf16x8 qf[4];
#pragma unroll
    for (int kk = 0; kk < 4; ++kk) qf[kk] = qfn[kk];
    __syncthreads();
    for (int hd = 0; hd < 8; ++hd) {
        for (int p = 0; p < 2; ++p) {
            const int jp = hd * 2 + p;
            if (jp + 1 < 16) K_FETCH(jp + 1);
            const LAS bf16* sKc = sKey + (jp & 1) * 128 * TP;
            f32x4 sc[8];
#pragma unroll
            for (int nt = 0; nt < 8; ++nt) sc[nt] = (f32x4){KOFF, KOFF, KOFF, KOFF};
#pragma unroll
            for (int kk = 0; kk < 4; ++kk)
#pragma unroll
                for (int nt = 0; nt < 8; ++nt) { const bf16x8 kf = *(const LAS bf16x8*)(sKc + (16 * nt + fr) * TP + 32 * kk + 8 * fq);
                    sc[nt] = __builtin_amdgcn_mfma_f32_16x16x32_bf16(kf, qf[kk], sc[nt], 0, 0, 0); }
            unsigned t[32];
#pragma unroll
            for (int nt = 0; nt < 8; ++nt)
#pragma unroll
                for (int rg = 0; rg < 4; ++rg) t[4 * nt + rg] = (__float_as_uint(sc[nt][rg]) & 0xFFFFFF80u) | (unsigned)(16 * nt + 4 * fq + rg);
            bitonic_sort16<0>(t); bitonic_sort16<16>(t);
#pragma unroll
            for (int j = 0; j < 16; ++j) t[j] = max(t[j], t[31 - j]);
            bitonic_merge16<0>(t);
#pragma unroll
            for (int rnd = 0; rnd < 2; ++rnd) {
#pragma unroll
                for (int j = 0; j < 16; ++j) t[16 + j] = rnd ? xor32_u(t[j], lane) : xor16_u(t[j], lane);
#pragma unroll
                for (int j = 0; j < 16; ++j) t[j] = max(t[j], t[31 - j]);
                bitonic_merge16<0>(t); }
#pragma unroll
            for (int j = 0; j < 16; ++j) sLT[fr * 32 + p * 16 + j] = t[j];
            if (jp + 1 < 16) { K_STORE(jp + 1);
#pragma unroll
                for (int kk = 0; kk < 4; ++kk) qf[kk] = qfn[kk]; }
            __syncthreads();
        }
        float v0[16], v1[16];
#pragma unroll
        for (int j = 0; j < 16; ++j) { v0[j] = __uint_as_float(sLT[fr * 32 + j] & 0xFFFFFF80u); v1[j] = __uint_as_float(sLT[fr * 32 + 16 + j] & 0xFFFFFF80u); }
        unsigned best[32];
#define CKEY(i, j) ((__float_as_uint(v0[i] + v1[j]) & 0xFFFFFF00u) | (unsigned)((i) * 16 + (j)))
#pragma unroll
        for (int j = 0; j < 16; ++j) best[j] = CKEY(0, j);
#pragma unroll
        for (int i = 1; i < 16; ++i) best[16 - i] = max(best[16 - i], CKEY(i, 0));
        bitonic_merge16<0>(best);
#pragma unroll
        for (int j = 1; j < 8; ++j) best[16 - j] = max(best[16 - j], CKEY(1, j));
        bitonic_merge16<0>(best);
#pragma unroll
        for (int i = 2; i < 8; ++i) best[17 - i] = max(best[17 - i], CKEY(i, 1));
        bitonic_merge16<0>(best);
        { unsigned r6[6] = {CKEY(2, 2), CKEY(2, 3), CKEY(2, 4), CKEY(3, 2), CKEY(3, 3), CKEY(4, 2)};
          CE_DESC(r6[0], r6[5]); CE_DESC(r6[1], r6[3]); CE_DESC(r6[2], r6[4]); CE_DESC(r6[1], r6[2]); CE_DESC(r6[3], r6[4]); CE_DESC(r6[0], r6[3]);
          CE_DESC(r6[2], r6[5]); CE_DESC(r6[0], r6[1]); CE_DESC(r6[2], r6[3]); CE_DESC(r6[4], r6[5]); CE_DESC(r6[1], r6[2]); CE_DESC(r6[3], r6[4]);
#pragma unroll
          for (int k = 0; k < 6; ++k) best[15 - k] = max(best[15 - k], r6[k]); }
        bitonic_merge16<0>(best);
#undef CKEY
        float ev[16], esum = 0.f; const float mx = __uint_as_float(best[0] & 0xFFFFFF00u);
#pragma unroll
        for (int k = 0; k < 16; ++k) { ev[k] = __builtin_amdgcn_exp2f((__uint_as_float(best[k] & 0xFFFFFF00u) - mx) * 1.44269504f); esum += ev[k]; }
        const float einv = 1.f / esum;
#pragma unroll
        for (int k = 0; k < 16; ++k) { const unsigned pos = best[k] & 255u;
            const unsigned i0 = sLT[fr * 32 + (pos >> 4)] & 127u, i1 = sLT[fr * 32 + 16 + (pos & 15u)] & 127u;
            if ((k >> 2) == fq) SEL[trow * 128 + hd * 16 + k] = (v2u){i0 * 128u + i1, __builtin_bit_cast(unsigned, ev[k] * einv)}; }
    }
    }
#undef K_FETCH
#undef K_STORE
    asm volatile("s_waitcnt vmcnt(0)" ::: "memory");
    __syncthreads();
    const bf16* N2 = (const bf16*)(F.ws + WS_N2); const unsigned char* U8 = (const unsigned char*)(F.ws + WS_DB + (size_t)(layer & 1) * DB_SET + DB_U); const unsigned char* V8 = (const unsigned char*)(F.ws + WS_DB + (size_t)(layer & 1) * DB_SET + DB_V);
    unsigned* SELW = (unsigned*)SEL;
    LAS unsigned* sIdx = (LAS unsigned*)(F.lds + 90112) + wave * 1024;
    LAS float* sCoef = (LAS float*)F.lds + wave * 2048;
    LAS unsigned* sSort = sLT;
    const size_t tokb = t0 + wave * 16;
    unsigned cnts = 0u;
    v4u se_pf = *(const v4u*)(SELW + tokb * 256 + 4 * lane);
    for (int it = 0; it < 16; ++it) {
        const v4u se = se_pf;
        if (it < 15) se_pf = *(const v4u*)(SELW + (tokb + it + 1) * 256 + 4 * lane);
        const unsigned b0 = se.x >> 12, b1 = se.z >> 12;
        unsigned pos0 = 0u, pos1 = 0u, base = 0u, pk = 0u;
#pragma unroll
        for (unsigned k = 0; k < 4; ++k) {
            const unsigned long long m0 = __builtin_amdgcn_ballot_w64(b0 == k), m1 = __builtin_amdgcn_ballot_w64(b1 == k);
            const unsigned below = __builtin_amdgcn_mbcnt_hi((unsigned)(m0 >> 32), __builtin_amdgcn_mbcnt_lo((unsigned)m0, 0u)) + __builtin_amdgcn_mbcnt_hi((unsigned)(m1 >> 32), __builtin_amdgcn_mbcnt_lo((unsigned)m1, 0u));
            if (b0 == k) pos0 = base + below;
            if (b1 == k) pos1 = base + below + (b0 == k ? 1u : 0u);
            base += (unsigned)__builtin_popcountll(m0) + (unsigned)__builtin_popcountll(m1);
            if (k < 3) pk |= base << (8 * k);
        }
#ifdef DBG_NOSORT
        pos0 = 2 * lane; pos1 = 2 * lane + 1;
#endif
        *(LAS v2u*)(sSort + 2 * pos0) = (v2u){se.x, se.y}; *(LAS v2u*)(sSort + 2 * pos1) = (v2u){se.z, se.w};
        asm volatile("" ::: "memory");
        const v2u so0 = *(const LAS v2u*)(sSort + 4 * lane), so1 = *(const LAS v2u*)(sSort + 4 * lane + 2); const v4u so = (v4u){so0.x, so0.y, so1.x, so1.y};
        asm volatile("" ::: "memory");
        sIdx[it * 64 + lane] = (so0.x & 0xffffu) | (so1.x << 16);
        (void)so;
        { const unsigned g0 = so0.y, g1 = so1.y; sCoef[it * 128 + 2 * lane] = __uint_as_float(g0); sCoef[it * 128 + 2 * lane + 1] = __uint_as_float(g1); }
        if (lane == it) cnts = pk;
    }
    asm volatile("s_waitcnt vmcnt(0) lgkmcnt(0)" ::: "memory");
#ifdef DBG_NOBUCKET
    cnts = 0u;
#endif
#define PL_LOAD(RB, TAB, SE, BB) do { _Pragma("unroll") for (int _q = 0; _q < 16; ++_q) { \
        const unsigned _pw = (unsigned)__builtin_amdgcn_readlane((int)(SE), (BB) * 8 + (_q >> 1)); const unsigned _idx = (_q & 1) ? (_pw >> 16) : (_pw & 0xffffu); \
        (RB)[_q] = *(const v4u*)((TAB) + (size_t)_idx * 1024 + 16 * lane); } } while (0)
#define PL_LOAD_U(RB, SE, BB) do { const int _src = ((BB) * 8 + ((lane & 15) >> 1)) * 4; \
        const unsigned _ix = (unsigned)__builtin_amdgcn_ds_bpermute(_src, (int)(SE).x), _iz = (unsigned)__builtin_amdgcn_ds_bpermute(_src, (int)(SE).z); \
        const unsigned char* _p = U8 + (size_t)((lane & 1) ? _iz : _ix) * 1024 + 32 * (lane >> 4); \
        _Pragma("unroll") for (int _j = 0; _j < 16; ++_j) (RB)[_j] = *(const v4u*)(_p + 128 * (_j >> 1) + 16 * (_j & 1)); } while (0)
#define PL_RANGE(T, P, NP, RLO, RHI, BLO, BHI) const unsigned _pk##T = (unsigned)__builtin_amdgcn_readlane((int)cnts, (T)); \
        const int _sp##T = min((int)((((_pk##T >> 8) & 255u) + 15u) & ~15u), 128);     \
        const int RLO = (P) == 0 ? 0 : _sp##T, RHI = (P) == 0 ? _sp##T : 128; \
        const int BLO = min(RLO >> 4, 7), BHI = max((RHI + 15) >> 4, BLO + 1)
    v4u ra[16], rb[16];
#ifndef DBG_U0
#define DBG_U0 0
#define DBG_V0 0
#endif
    for (int ps = DBG_U0; ps < 2; ++ps) {
        int lt = 0, lb, lbh; { PL_RANGE(lt, ps, 2, r0, r1, b0_, b1_); lb = b0_; lbh = b1_; (void)r0; (void)r1; }
        unsigned seL = sIdx[lane];
        long xlo = 0, xhi = 0; const bool dsel = ((lane >> 2) & 3) == (lane >> 4); v4u nraw0, nraw1, nnx0 = *(const v4u*)(N2 + tokb * 1024 + 16 * lane), nnx1 = *(const v4u*)(N2 + tokb * 1024 + 16 * lane + 8);
        int ct, cb, crl = 0, crh = 0, cbl = 0;
#define U_ADV() do { ++lb; if (lb >= lbh) { ++lt; if (lt < 16) { PL_RANGE(lt, ps, 2, _r0, _r1, _b0, _b1); lb = _b0; lbh = _b1; (void)_r0; (void)_r1; seL = sIdx[lt * 64 + lane]; } } } while (0)
#define U_COMPUTE(RB) do { \
            if (cb == cbl) { nraw0 = nnx0; nraw1 = nnx1; if (ct + 1 < 16) { nnx0 = *(const v4u*)(N2 + (tokb + ct + 1) * 1024 + 16 * lane); nnx1 = *(const v4u*)(N2 + (tokb + ct + 1) * 1024 + 16 * lane + 8); } \
                f32x4 x0, x1, x2, x3; unpk8(nraw0, x0, x1); unpk8(nraw1, x2, x3); x0 = x0 * 16.f; x1 = x1 * 16.f; x2 = x2 * 16.f; x3 = x3 * 16.f; \
                int _w0 = 0, _w1 = 0, _w2 = 0, _w3 = 0; \
                _w0 = __builtin_amdgcn_cvt_pk_fp8_f32(x0.x, x0.y, _w0, false); _w0 = __builtin_amdgcn_cvt_pk_fp8_f32(x0.z, x0.w, _w0, true); \
                _w1 = __builtin_amdgcn_cvt_pk_fp8_f32(x1.x, x1.y, _w1, false); _w1 = __builtin_amdgcn_cvt_pk_fp8_f32(x1.z, x1.w, _w1, true); \
                _w2 = __builtin_amdgcn_cvt_pk_fp8_f32(x2.x, x2.y, _w2, false); _w2 = __builtin_amdgcn_cvt_pk_fp8_f32(x2.z, x2.w, _w2, true); \
                _w3 = __builtin_amdgcn_cvt_pk_fp8_f32(x3.x, x3.y, _w3, false); _w3 = __builtin_amdgcn_cvt_pk_fp8_f32(x3.z, x3.w, _w3, true); \
                xlo = (long)(((unsigned long long)(unsigned)_w1 << 32) | (unsigned)_w0); xhi = (long)(((unsigned long long)(unsigned)_w3 << 32) | (unsigned)_w2); } \
            _Pragma("unroll") for (int _g = 0; _g < 2; ++_g) { float _p[8]; \
                _Pragma("unroll") for (int _q = 0; _q < 8; ++_q) { f32x4 _d = (f32x4){0.f, 0.f, 0.f, 0.f}; \
                    _d = __builtin_amdgcn_mfma_f32_16x16x32_fp8_fp8((long)(((unsigned long long)(RB)[8 * _g + _q].y << 32) | (RB)[8 * _g + _q].x), xlo, _d, 0, 0, 0); \
                    _d = __builtin_amdgcn_mfma_f32_16x16x32_fp8_fp8((long)(((unsigned long long)(RB)[8 * _g + _q].w << 32) | (RB)[8 * _g + _q].z), xhi, _d, 0, 0, 0); \
                    const float _sl = (lane & 2) ? ((lane & 1) ? _d.w : _d.z) : ((lane & 1) ? _d.y : _d.x); \
                    _p[_q] = dsel ? _sl : 0.f; }     \
                const float _s0 = swap32_add(_p[0], _p[4]), _s1 = swap32_add(_p[1], _p[5]), _s2 = swap32_add(_p[2], _p[6]), _s3 = swap32_add(_p[3], _p[7]); \
                float _t0 = row_sum16(swap16_add(_s0, _s2)), _t1 = row_sum16(swap16_add(_s1, _s3)); \
                _t0 = fgelu(_t0 * (1.f / 4096.f)) * (1.f / 64.f); _t1 = fgelu(_t1 * (1.f / 4096.f)) * (1.f / 64.f); \
                if ((lane & 15) == 0) { const int _r = lane >> 4, _e = cb * 16 + 8 * _g + 2 * (_r & 1) + 4 * (_r >> 1); LAS float* _c = sCoef + ct * 128 + _e; \
                    if (_e >= crl && _e < crh) _c[0] *= _t0; if (_e + 1 >= crl && _e + 1 < crh) _c[1] *= _t1; } } } while (0)
#define U_SETC() do { ct = lt; cb = lb; { PL_RANGE(ct, ps, 2, _r0, _r1, _b0, _b1); crl = _r0; crh = _r1; cbl = _b0; (void)_b1; } } while (0)
        PL_LOAD(ra, U8, seL, lb);
        U_SETC(); U_ADV();
        for (;;) {
            if (lt < 16) PL_LOAD(rb, U8, seL, lb);
            U_COMPUTE(ra);
            if (lt >= 16) break;
            U_SETC(); U_ADV();
            if (lt < 16) PL_LOAD(ra, U8, seL, lb);
            U_COMPUTE(rb);
            if (lt >= 16) break;
            U_SETC(); U_ADV();
        }
        asm volatile("s_waitcnt lgkmcnt(0)" ::: "memory");
        __syncthreads();
    }
#undef U_ADV
#undef U_COMPUTE
#undef U_SETC
    for (int ps = DBG_V0; ps < 2; ++ps) {
        int lt = 0, lb, lbh; { PL_RANGE(lt, ps, 2, r0, r1, b0_, b1_); lb = b0_; lbh = b1_; (void)r0; (void)r1; }
        unsigned seL = sIdx[lane];
        f32x2 out[8]; f32x4 hpre[4] = {(f32x4){0.f, 0.f, 0.f, 0.f}, (f32x4){0.f, 0.f, 0.f, 0.f}, (f32x4){0.f, 0.f, 0.f, 0.f}, (f32x4){0.f, 0.f, 0.f, 0.f}}, ac4[4]; v4u gpre[2] = {(v4u){0u, 0u, 0u, 0u}, (v4u){0u, 0u, 0u, 0u}}; const bf16* PWG = (const bf16*)(F.ws + WS_PW);
        const unsigned vmask = ((lane >> 4) == ((lane & 15) >> 2)) ? (0xFFu << (8 * (lane & 3))) : 0u;
        int ct, cb, crl = 0, crh = 0, cbl = 0, cbh = 0;
#define V_ADV() do { ++lb; if (lb >= lbh) { ++lt; if (lt < 16) { PL_RANGE(lt, ps, 2, _r0, _r1, _b0, _b1); lb = _b0; lbh = _b1; (void)_r0; (void)_r1; seL = sIdx[lt * 64 + lane]; } } } while (0)
#define V_SETC() do { ct = lt; cb = lb; { PL_RANGE(ct, ps, 2, _r0, _r1, _b0, _b1); crl = _r0; crh = _r1; cbl = _b0; cbh = _b1; } } while (0)
#ifndef REP_LV
#define REP_LV 1
#endif
#define V_COMPUTE(RB) do { \
            if (cb == cbl) { _Pragma("unroll") for (int _i = 0; _i < 4; ++_i) { ac4[_i] = (f32x4){0.f, 0.f, 0.f, 0.f}; if (ps == 1) hpre[_i] = *(const f32x4*)(F.h + (tokb + ct) * 1024 + 16 * lane + 4 * _i); } \
                gpre[0] = *(const v4u*)(PWG + (tokb + ct) * 1024 + 16 * lane); gpre[1] = *(const v4u*)(PWG + (tokb + ct) * 1024 + 16 * lane + 8); }     \
            _Pragma("unroll") for (int _q = 0; _q < 16; ++_q) { const int _e = cb * 16 + _q; \
                float _c = sCoef[ct * 128 + _e]; _c = (_e >= crl && _e < crh) ? _c * 2048.f : 0.f; \
                int _w = __builtin_amdgcn_cvt_pk_fp8_f32(_c, _c, 0, false); _w = __builtin_amdgcn_cvt_pk_fp8_f32(_c, _c, _w, true); const unsigned _x = (unsigned)_w & vmask; \
                const long _ae = (long)(unsigned long long)_x, _ao = (long)((unsigned long long)_x << 32); \
                const long _bl = (long)(((unsigned long long)(RB)[_q].y << 32) | (RB)[_q].x), _bh = (long)(((unsigned long long)(RB)[_q].w << 32) | (RB)[_q].z); \
                ac4[0] = __builtin_amdgcn_mfma_f32_16x16x32_fp8_fp8(_ae, _bl, ac4[0], 0, 0, 0); ac4[1] = __builtin_amdgcn_mfma_f32_16x16x32_fp8_fp8(_ao, _bl, ac4[1], 0, 0, 0); \
                ac4[2] = __builtin_amdgcn_mfma_f32_16x16x32_fp8_fp8(_ae, _bh, ac4[2], 0, 0, 0); ac4[3] = __builtin_amdgcn_mfma_f32_16x16x32_fp8_fp8(_ao, _bh, ac4[3], 0, 0, 0); } \
            if (cb == cbh - 1) { _Pragma("unroll") for (int _i = 0; _i < 4; ++_i) { out[2 * _i] = (f32x2){ac4[_i].x, ac4[_i].y} * (1.f / 2048.f); out[2 * _i + 1] = (f32x2){ac4[_i].z, ac4[_i].w} * (1.f / 2048.f); } \
                peer_token_end(F, a, layer, last, ps == 1, tokb + ct, lane, out, hpre, gpre); } } while (0)
        PL_LOAD(ra, V8, seL, lb);
        V_SETC(); V_ADV();
        for (;;) {
            if (lt < 16) PL_LOAD(rb, V8, seL, lb);
            V_COMPUTE(ra);
            if (lt >= 16) break;
            V_SETC(); V_ADV();
            if (lt < 16) PL_LOAD(ra, V8, seL, lb);
            V_COMPUTE(rb);
            if (lt >= 16) break;
            V_SETC(); V_ADV();
        }
        asm volatile("s_waitcnt vmcnt(0)" ::: "memory");
        __syncthreads();
    }
#undef V_ADV
#undef V_SETC
#undef V_COMPUTE
#undef PL_LOAD
#undef PL_RANGE
}


#ifndef ZSKIP
#define ZSKIP 0
#endif
#ifndef ZGA_ALIGN
#define ZGA_ALIGN true
#endif
#ifndef ZGA_SP2
#define ZGA_SP2 true
#endif
#ifndef WIN_ALIGN
#define WIN_ALIGN true
#endif
#ifndef WIN_SP2
#define WIN_SP2 true
#endif
#ifndef REP_E
#define REP_E 1
#endif
#ifndef REP_A
#define REP_A 1
#endif
#ifndef REP_B
#define REP_B 1
#endif
#ifndef REP_C
#define REP_C 1
#endif
#ifndef REP_D
#define REP_D 1
#endif
#ifndef REP_G
#define REP_G 1
#endif
#ifndef REP_I
#define REP_I 1
#endif
#ifndef REP_K
#define REP_K 1
#endif
__global__ void __launch_bounds__(NWAVES * 64, 2) trunk_fwd(Args args) {
    extern __shared__ __attribute__((aligned(16))) unsigned char lds[];
    Frame F;
    F.lds = (LAS unsigned char*)lds;
    F.tid = threadIdx.x; F.lane = F.tid & 63; F.wave = __builtin_amdgcn_readfirstlane(F.tid >> 6); F.wave0 = F.wave;
    F.G = gridDim.x; F.bx = blockIdx.x; F.ws = (GAS unsigned char*)args.ws; F.h = args.out;
    volatile LAS unsigned* MISC = (volatile LAS unsigned*)(F.lds + MISC_OFF);
    for (int u = F.tid; u < (LDS_BYTES - LDSCTL_OFF) / 4; u += NWAVES * 64) ((LAS unsigned*)(F.lds + LDSCTL_OFF))[u] = 0u;
    __syncthreads();
    unsigned* ctl = (unsigned*)(F.ws + WS_CTL);
    XcdBarrier bar = xcd_barrier_post(ctl + CW_BAR, MISC + 8);
    GAS unsigned char* ws = F.ws;
    LAS unsigned char* ring = (LAS unsigned char*)F.lds;

    for (int rep = 0; rep < REP_A; ++rep) { prep_phase(F, args, 0, F.bx, F.G, 1);
    xcd_barrier(bar, F.wave0); }
#define OPQ() GAS unsigned char* ws = F.ws; asm volatile("" : "+s"(ws)); GAS unsigned char* db = ws + WS_DB + (size_t)(layer & 1) * DB_SET; (void)db
    for (int layer = 0; layer < DEPTH; ++layer) {
        {   OPQ();
        for (int rep = 0; rep < REP_B; ++rep) {   if (rep) xcd_barrier(bar, F.wave0); pg8::Gemm g{(const bf16*)(ws + WS_NX), (const bf16*)(ws + WS_WIN), T, NZ - 256 * ZSPLIT, 2048, 2048}; pg8::StaticOrder S; S.init(T, NZ - 256 * ZSPLIT, F.G, F.bx);
            pg8::EpiZ E{(bf16*)(ws + WS_ZRKV), (bf16*)(ws + WS_ZL), (bf16*)(ws + WS_GUV), (bf16*)(ws + WS_SG), layer == 0 ? (bf16*)(ws + WS_VF) : (bf16*)nullptr, 0};
            pg8::gemm_phase<pg8::EpiZ, pg8::StaticOrder, WIN_ALIGN, WIN_SP2>(ring, g, S, E, F.wave0); }
        }
        xcd_barrier(bar, F.wave0);
        {   OPQ();
        for (int rep = 0; rep < REP_C; ++rep) {   if (rep) xcd_barrier(bar, F.wave0); { pg8::Gemm g{(const bf16*)(ws + WS_ZL), (const bf16*)(ws + WS_LORA + (size_t)layer * LORA_BYTES), T, 2048, 128, 512}; pg8::StaticOrder S; S.init(T, 2048, F.G, F.bx);
            pg8::EpiLora E{(bf16*)(ws + WS_EW), (size_t)(WS_AR - WS_EW) / 2, args.in[6] + (size_t)layer * 1024, args.in[8] + (size_t)layer * 1024, 0};
            pg8::gemm_phase<pg8::EpiLora, pg8::StaticOrder, true, true>(ring, g, S, E, F.wave0); }
            { pg8::Gemm g{(const bf16*)(ws + WS_ZL) + 128, (const bf16*)(ws + WS_LORA + (size_t)layer * LORA_BYTES) + 2048 * 128, T, 1024, 128, 512}; pg8::StaticOrder S; S.init(T, 1024, F.G, F.bx);
            pg8::EpiLora E{(bf16*)(ws + WS_EW), (size_t)(WS_AR - WS_EW) / 2, args.in[6] + (size_t)layer * 1024, args.in[8] + (size_t)layer * 1024, 8};
            pg8::gemm_phase<pg8::EpiLora, pg8::StaticOrder, true, true>(ring, g, S, E, F.wave0); } }
        if (layer > 0) {
            pg8::Gemm g{(const bf16*)(ws + WS_ZL) + 256, (const bf16*)(ws + WS_MV + (size_t)(layer - 1) * MV_BYTES), T, 1024, 128, 512}; pg8::StaticOrder S; S.init(T, 1024, F.G, F.bx);
            pg8::EpiMv E{(bf16*)(ws + WS_ZRKV), (const bf16*)(ws + WS_VF), args.in[18] + (size_t)(layer - 1) * 1024};
            pg8::gemm_phase<pg8::EpiMv, pg8::StaticOrder, true, true>(ring, g, S, E, F.wave0); }
        }
        xcd_barrier(bar, F.wave0);
        {   OPQ();
        for (int rep = 0; rep < REP_D; ++rep) {   if (rep) xcd_barrier(bar, F.wave0); const int nsb = F.G / 2, nob = F.G - nsb;
            if (F.bx < nsb) { for (int u = F.bx; u < NB * 16; u += nsb) scan_unit(F, args, layer, u); }
            else { const int ob = F.bx - nsb;
                for (int pm = ob; pm < T / 256; pm += nob)
                    for (int rep2 = 0; rep2 < REP_E; ++rep2) { gmlp_unit(F, args, layer, 2 * pm); gmlp_unit(F, args, layer, 2 * pm + 1); }
                asm volatile("s_waitcnt vmcnt(0)" ::: "memory"); __syncthreads();
                {
                    pg8::Gemm g{(const bf16*)(ws + WS_GUV), (const bf16*)(db + DB_PBT), T, 1024, 1024, 2048}; pg8::PanelOrder S{ob, nob, T / 256, 4, 0};
                    pg8::EpiMerge<false> E{(const bf16*)(ws + WS_SG), (bf16*)(ws + WS_GUV) + 1024, (bf16*)nullptr};
                    pg8::gemm_phase<pg8::EpiMerge<false>, pg8::PanelOrder, true, true>(ring, g, S, E, F.wave0); }
                {
                    pg8::Gemm g{(const bf16*)(ws + WS_NX), (const bf16*)(ws + WS_WINB + (size_t)(layer & 1) * WINB_BYTES), T, 256 * ZSPLIT, 2048, 2048}; pg8::StaticOrder S; S.init(T, 256 * ZSPLIT, nob, ob);
                    pg8::EpiZ E{(bf16*)(ws + WS_ZRKV), (bf16*)(ws + WS_ZL), (bf16*)(ws + WS_GUV), (bf16*)(ws + WS_SG), (bf16*)nullptr, 30 - ZSPLIT};
                    pg8::gemm_phase<pg8::EpiZ, pg8::StaticOrder, true, true>(ring, g, S, E, F.wave0); }
                {   pg8::Gemm g{(const bf16*)(db + DB_PB), (const bf16*)(db + DB_PLEW), T, 1024, 256, 256}; pg8::StaticOrder S; S.init(T, 1024, nob, ob);
                    pg8::EpiPlain E{(bf16*)(ws + WS_PW), 1024};
                    pg8::gemm_phase<pg8::EpiPlain, pg8::StaticOrder, true, true>(ring, g, S, E, F.wave0); }
                if (layer == 0) prep_phase(F, args, 0, ob, nob, 2);
                if (layer + 1 < DEPTH) prep_phase(F, args, layer + 1, ob, nob, 3); } }
        }
        xcd_barrier(bar, F.wave0);
        {   OPQ();
        for (int rep = 0; rep < REP_G; ++rep) {   if (rep) xcd_barrier(bar, F.wave0); pg8::Gemm g{(const bf16*)(ws + WS_G), (const bf16*)(db + DB_PA), T, 1024, 1024, 1024}; pg8::StaticOrder S; S.init(T, 1024, F.G, F.bx);
            pg8::EpiMerge<true> E{(const bf16*)(ws + WS_SG), (bf16*)(ws + WS_GUV) + 1024, (bf16*)(ws + WS_MG)};
            pg8::gemm_phase<pg8::EpiMerge<true>, pg8::StaticOrder, true, true>(ring, g, S, E, F.wave0); }
        }
        xcd_barrier(bar, F.wave0);
        {   OPQ();
        {   pg8::Gemm g{(const bf16*)(ws + WS_MG), (const bf16*)(db + DB_POUT), T, 1024, 1024, 1024}; pg8::StaticOrder S; S.init(T, 1024, F.G, F.bx);
            pg8::EpiResid E{F.h};
            pg8::gemm_phase<pg8::EpiResid, pg8::StaticOrder, true, true>(ring, g, S, E, F.wave0); }
        }
        xcd_barrier(bar, F.wave0);
        {   OPQ();
        for (int rep = 0; rep < REP_I; ++rep) {   if (rep) xcd_barrier(bar, F.wave0); phase_ids(F); const int gw = F.bx * NWAVES + F.wave, NGW = F.G * NWAVES; const float* g2 = args.in[3] + (size_t)layer * 1024;
            for (int m = gw; m < T / 2; m += NGW) norm_row_n2x2(F.h + (size_t)m * D, F.h + (size_t)(m + T / 2) * D, g2, (bf16*)(ws + WS_N2) + (size_t)m * D, (bf16*)(ws + WS_N2) + (size_t)(m + T / 2) * D, F.lane); }
        }
        xcd_barrier(bar, F.wave0);
        {   OPQ();
        {   pg8::Gemm g{(const bf16*)(ws + WS_N2), (const bf16*)(db + DB_WQG), T, 3072, 1024, 1024}; pg8::StaticOrder S; S.init(T, 3072, F.G, F.bx);
            pg8::EpiQG E{(bf16*)(ws + WS_Q), (bf16*)(ws + WS_PW), F.h};
            pg8::gemm_phase<pg8::EpiQG, pg8::StaticOrder, true, true>(ring, g, S, E, F.wave0); }
        }
        xcd_barrier(bar, F.wave0);
        {   OPQ();
        for (int u = F.bx; u < T / 128; u += F.G) peer_unit(F, args, layer, u, layer == DEPTH - 1);
        }
        if (layer + 1 < DEPTH) xcd_barrier(bar, F.wave0);
    }
}

extern "C" void kernel_launch(void* const* d_in, const int* in_sizes, int n_in, void* d_out, int out_size, void* d_ws, size_t ws_size, hipStream_t stream) {
    static int grid = 0;
    if (grid == 0) {
        if (n_in != 32 || out_size != T * D || ws_size < WS_END) { fprintf(stderr, "kernel_launch: unexpected sizes n_in %d out %d ws %zu (need %zu); nothing launched\n", n_in, out_size, ws_size, (size_t)WS_END); grid = -1; return; }
        int dev = 0, cus = 0, per_cu = 0;
        if (hipGetDevice(&dev) != hipSuccess || hipDeviceGetAttribute(&cus, hipDeviceAttributeMultiprocessorCount, dev) != hipSuccess) { grid = -1; return; }
        if (hipFuncSetAttribute((const void*)trunk_fwd, hipFuncAttributeMaxDynamicSharedMemorySize, LDS_BYTES) != hipSuccess) { fprintf(stderr, "kernel_launch: hipFuncSetAttribute failed\n"); grid = -1; return; }
        if (hipOccupancyMaxActiveBlocksPerMultiprocessor(&per_cu, (const void*)trunk_fwd, NWAVES * 64, LDS_BYTES) != hipSuccess || per_cu < 1)
            fprintf(stderr, "kernel_launch: note: occupancy query reports %d workgroups per CU\n", per_cu);
        (void)hipGetLastError();
        grid = cus;
    }
    if (grid < 0) return;
    (void)hipMemsetAsync((char*)d_ws + WS_CTL, 0, ZERO_BYTES, stream);
    (void)hipMemsetAsync((char*)d_ws + WIN_ZERO_OFF, 0, WIN_ZERO_BYTES, stream);
    Args a{};
    for (int i = 0; i < 32; ++i) a.in[i] = (const float*)d_in[i];
    a.out = (float*)d_out; a.ws = (unsigned char*)d_ws;
    hipLaunchKernelGGL(trunk_fwd, dim3(grid), dim3(NWAVES * 64), LDS_BYTES, stream, a);
    const hipError_t le = hipPeekAtLastError();
    if (le != hipSuccess) fprintf(stderr, "kernel_launch: launch failed: %s\n", hipGetErrorName(le));
}
```

```cpp
#include <hip/hip_runtime.h>
#include <cstdio>
#include <cstdint>
#define ZSPLIT 4
namespace pg8 {
#define PG8_LAS __attribute__((address_space(3)))
typedef unsigned short bf16_t;
typedef short bf16x8 __attribute__((ext_vector_type(8)));
typedef float f32x4 __attribute__((ext_vector_type(4)));
typedef unsigned u32x4 __attribute__((ext_vector_type(4)));
constexpr int BM = 256, BK = 64, HALF = 128, HTB = HALF * BK * 2  , STAGE_BYTES = 8 * HTB, NXCD = 8, WGM = 8;

__host__ __device__ __forceinline__ int lds_byte(int r, int c) { const int st = (r >> 4) * 2 + (c >> 5), rr = r & 15, cc = c & 31, ob = rr * 64 + cc * 2; return st * 1024 + (ob ^ (((ob >> 9) & 1) << 5)); }
__host__ __device__ __forceinline__ void stage_rc(int b, int& R, int& C) { const int st = b / 1024, sb = b % 1024, swz = sb ^ (((sb >> 9) & 1) << 5); R = (st >> 1) * 16 + swz / 64; C = (st & 1) * 32 + (swz % 64) / 2; }
__host__ __device__ __forceinline__ int perm32(int rho) { const int n = rho >> 4, i = rho & 15; return 8 * (i >> 2) + 4 * n + (i & 3); }

struct Unit { int pm, pn; };
struct Gemm { const bf16_t* A; const bf16_t* Bt; int M, N, K, lda; int abatch; };

struct StaticOrder {
    int nM, nN, nwg, G, c;
    __host__ __device__ void init(int M, int N, int G_, int c_) { nM = M / BM; nN = N / BM; nwg = nM * nN; G = G_; c = c_; }
    __host__ __device__ bool next(int i, Unit& u) const {
        const long L = (long)i * G + c; if (L >= nwg) return false;
        int wgid = (int)L; { const int q = nwg / NXCD, r = nwg % NXCD, xcd = wgid % NXCD, off = wgid / NXCD; wgid = (xcd < r ? xcd * (q + 1) : r * (q + 1) + (xcd - r) * q) + off; }
        const int nig = WGM * nN, gid = wgid / nig, fm = gid * WGM, gsz = (nM - fm) < WGM ? (nM - fm) : WGM;
        u.pm = fm + ((wgid % nig) % gsz); u.pn = (wgid % nig) / gsz; return true;
    }
    __device__ __forceinline__ void a_ready(const Unit&) const {}
    __device__ __forceinline__ void done(const Unit&) const {}
};
struct PanelOrder {
    int first, stride, nM, nN, pn0;
    __host__ __device__ bool next(int i, Unit& u) const { const int p = first + (i / nN) * stride; if (p >= nM) return false; u.pm = p; u.pn = pn0 + i % nN; return true; }
    __device__ __forceinline__ void a_ready(const Unit&) const {}
    __device__ __forceinline__ void done(const Unit&) const {}
};
__device__ __forceinline__ unsigned cvt_pk_bf16(float lo, float hi) { unsigned r; asm volatile("v_cvt_pk_bf16_f32 %0, %1, %2" : "=v"(r) : "v"(lo), "v"(hi)); return r; }

__device__ __forceinline__ float fsig(float x) { return __builtin_amdgcn_rcpf(1.f + __builtin_amdgcn_exp2f(-1.44269504f * x)); }
__device__ __forceinline__ float fgelu(float x) { return x * fsig(1.5957691216f * (x + 0.044715f * x * x * x)); }
__device__ __forceinline__ float bflo(unsigned w) { return __builtin_bit_cast(float, w << 16); }
__device__ __forceinline__ float bfhi(unsigned w) { return __builtin_bit_cast(float, w & 0xffff0000u); }
__device__ __forceinline__ void unpk8(const u32x4 w, f32x4& a, f32x4& b) { a = (f32x4){bflo(w.x), bfhi(w.x), bflo(w.y), bfhi(w.y)}; b = (f32x4){bflo(w.z), bfhi(w.z), bflo(w.w), bfhi(w.w)}; }
__device__ __forceinline__ u32x4 pk8(const f32x4 a, const f32x4 b) { u32x4 w; w.x = cvt_pk_bf16(a[0], a[1]); w.y = cvt_pk_bf16(a[2], a[3]); w.z = cvt_pk_bf16(b[0], b[1]); w.w = cvt_pk_bf16(b[2], b[3]); return w; }
__device__ __forceinline__ f32x4 act4(f32x4 v, int kind) {
    if (kind == 1) { v = (f32x4){fgelu(v[0]), fgelu(v[1]), fgelu(v[2]), fgelu(v[3])}; }
    else if (kind == 2) { v = (f32x4){fsig(v[0]), fsig(v[1]), fsig(v[2]), fsig(v[3])}; }
    else if (kind == 3) { v = (f32x4){2.f * fsig(2.f * v[0]) - 1.f, 2.f * fsig(2.f * v[1]) - 1.f, 2.f * fsig(2.f * v[2]) - 1.f, 2.f * fsig(2.f * v[3]) - 1.f}; }
    return v;
}
#define EPI_ROWS_BEGIN _Pragma("unroll") for (int ai = 0; ai < 2; ++ai) _Pragma("unroll") for (int m = 0; m < 4; ++m) { const size_t row = (size_t)(row0 + ai * HALF + m * 16);
#define EPI_ROWS_END }

struct EpiZ {
    static constexpr bool PERM = true, AFTER_DRAIN = false;
    bf16_t *zrkv, *zl, *guv, *sg, *vf; int pnoff;
    __device__ __forceinline__ void operator()(const f32x4 (&acc)[2][2][4][2], const Unit& u, int wr, int wc, int fr, int fq) const {
        const int pn = u.pn + pnoff, row0 = u.pm * BM + wr * 64 + fr;
        bf16_t* dst; int ld, colt, k0, k1;
        if (pn < 12)       { dst = zrkv; ld = 3072; colt = pn * 256;        k0 = 0; k1 = 0; }
        else if (pn == 12) { dst = zl;   ld = 512;  colt = 0;               k0 = (wc < 2) ? 3 : 0; k1 = 2; }
        else if (pn == 13) { dst = zl;   ld = 512;  colt = 256;             k0 = 0; k1 = 0; }
        else if (pn < 22)  { dst = guv;  ld = 2048; colt = (pn - 14) * 256; k0 = 1; k1 = 1; }
        else               { dst = sg;   ld = 2048; colt = ((pn - 18) & 7) * 256; k0 = 2; k1 = 2; }
        const int col0 = colt + wc * 32 + 8 * fq;
        const bool dovf = (vf != nullptr) && pn >= 8 && pn < 12;
        const int vcol0 = (pn - 8) * 256 + wc * 32 + 8 * fq;
        EPI_ROWS_BEGIN
            bf16_t* rowp = dst + row * ld + col0;
#pragma unroll
            for (int bj = 0; bj < 2; ++bj) { const int kind = bj ? k1 : k0;
                const u32x4 w = pk8(act4(acc[ai][bj][m][0], kind), act4(acc[ai][bj][m][1], kind));
                *(u32x4*)(rowp + bj * HALF) = w;
                if (dovf) *(u32x4*)(vf + row * 1024 + vcol0 + bj * HALF) = w; }
        EPI_ROWS_END
    }
};
struct EpiLora {
    static constexpr bool PERM = true, AFTER_DRAIN = false;
    bf16_t* ew; size_t stride; const float *w0, *a0; int pnoff;
    __device__ __forceinline__ void operator()(const f32x4 (&acc)[2][2][4][2], const Unit& u, int wr, int wc, int fr, int fq) const {
        const int pn = u.pn + pnoff, sel = pn >> 2, row0 = u.pm * BM + wr * 64 + fr, col0 = (pn & 3) * 256 + wc * 32 + 8 * fq;
        bf16_t* dst = ew + (size_t)sel * stride;
        const float* bp = sel == 0 ? w0 : a0;
        f32x4 bv[2][2];
#pragma unroll
        for (int bj = 0; bj < 2; ++bj)
#pragma unroll
            for (int n = 0; n < 2; ++n) bv[bj][n] = (sel < 2) ? *(const f32x4*)(bp + col0 + bj * HALF + 4 * n) : (f32x4){0.f, 0.f, 0.f, 0.f};
        EPI_ROWS_BEGIN
            bf16_t* rowp = dst + row * 1024 + col0;
#pragma unroll
            for (int bj = 0; bj < 2; ++bj) { f32x4 v0 = acc[ai][bj][m][0] + bv[bj][0], v1 = acc[ai][bj][m][1] + bv[bj][1];
                if (sel < 2) { v0 = act4(v0, 2); v1 = act4(v1, 2); }
                if (sel == 0) { v0 = v0 * 0.60653066f; v1 = v1 * 0.60653066f; }
                *(u32x4*)(rowp + bj * HALF) = pk8(v0, v1); }
        EPI_ROWS_END
    }
};
struct EpiMv {
    static constexpr bool PERM = true, AFTER_DRAIN = false;
    bf16_t* zrkv; const bf16_t* vf; const float* v0b;
    __device__ __forceinline__ void operator()(const f32x4 (&acc)[2][2][4][2], const Unit& u, int wr, int wc, int fr, int fq) const {
        const int row0 = u.pm * BM + wr * 64 + fr, col0 = u.pn * 256 + wc * 32 + 8 * fq;
        f32x4 bv[2][2];
#pragma unroll
        for (int bj = 0; bj < 2; ++bj)
#pragma unroll
            for (int n = 0; n < 2; ++n) bv[bj][n] = *(const f32x4*)(v0b + col0 + bj * HALF + 4 * n);
        EPI_ROWS_BEGIN
#pragma unroll
            for (int bj = 0; bj < 2; ++bj) { bf16_t* zp = zrkv + row * 3072 + 2048 + col0 + bj * HALF;
                f32x4 z0, z1, f0, f1; unpk8(*(const u32x4*)zp, z0, z1); unpk8(*(const u32x4*)(vf + row * 1024 + col0 + bj * HALF), f0, f1);
                const f32x4 m0 = act4(acc[ai][bj][m][0] + bv[bj][0], 2), m1 = act4(acc[ai][bj][m][1] + bv[bj][1], 2);
                *(u32x4*)zp = pk8(z0 + (f0 - z0) * m0, z1 + (f1 - z1) * m1); }
        EPI_ROWS_END
    }
};
struct EpiPlain {
    static constexpr bool PERM = true, AFTER_DRAIN = false;
    bf16_t* o; int ld;
    __device__ __forceinline__ void operator()(const f32x4 (&acc)[2][2][4][2], const Unit& u, int wr, int wc, int fr, int fq) const {
        const int row0 = u.pm * BM + wr * 64 + fr, col0 = u.pn * 256 + wc * 32 + 8 * fq;
        EPI_ROWS_BEGIN
#pragma unroll
            for (int bj = 0; bj < 2; ++bj) *(u32x4*)(o + row * ld + col0 + bj * HALF) = pk8(acc[ai][bj][m][0], acc[ai][bj][m][1]);
        EPI_ROWS_END
    }
};
template <bool SECOND> struct EpiMerge {
    static constexpr bool PERM = true, AFTER_DRAIN = false;
    const bf16_t* sg; bf16_t* m2; bf16_t* o;
    __device__ __forceinline__ void operator()(const f32x4 (&acc)[2][2][4][2], const Unit& u, int wr, int wc, int fr, int fq) const {
        const int row0 = u.pm * BM + wr * 64 + fr, col0 = u.pn * 256 + wc * 32 + 8 * fq;
#pragma unroll
        for (int ai = 0; ai < 2; ++ai) { u32x4 gv[4][2], pv[4][2];
#pragma unroll
            for (int m = 0; m < 4; ++m) { const size_t row = (size_t)(row0 + ai * HALF + m * 16);
#pragma unroll
                for (int bj = 0; bj < 2; ++bj) { const int c = col0 + bj * HALF; gv[m][bj] = *(const u32x4*)(sg + row * 2048 + (SECOND ? 0 : 1024) + c);
                    if (SECOND) pv[m][bj] = *(const u32x4*)(m2 + row * 2048 + c); } }
#pragma unroll
            for (int m = 0; m < 4; ++m) { const size_t row = (size_t)(row0 + ai * HALF + m * 16);
#pragma unroll
                for (int bj = 0; bj < 2; ++bj) { const int c = col0 + bj * HALF;
                    f32x4 g0, g1; unpk8(gv[m][bj], g0, g1);
                    f32x4 v0 = g0 * acc[ai][bj][m][0], v1 = g1 * acc[ai][bj][m][1];
                    if (SECOND) { f32x4 p0, p1; unpk8(pv[m][bj], p0, p1); v0 = v0 + p0; v1 = v1 + p1; *(u32x4*)(o + row * 1024 + c) = pk8(v0, v1); }
                    else *(u32x4*)(m2 + row * 2048 + c) = pk8(v0, v1); } } }
    }
};
struct EpiResid {
    static constexpr bool PERM = false, AFTER_DRAIN = false;
    float* h;
    __device__ __forceinline__ void operator()(const f32x4 (&acc)[2][2][4][2], const Unit& u, int wr, int wc, int fr, int fq) const {
        const int row0 = u.pm * BM + wr * 64 + fr, col0 = u.pn * 256 + wc * 32 + 4 * fq;
#pragma unroll
        for (int ai = 0; ai < 2; ++ai) { f32x4 hv[4][2][2];
#pragma unroll
            for (int m = 0; m < 4; ++m) { const float* rowp = h + (size_t)(row0 + ai * HALF + m * 16) * 1024 + col0;
#pragma unroll
                for (int bj = 0; bj < 2; ++bj)
#pragma unroll
                    for (int n = 0; n < 2; ++n) hv[m][bj][n] = *(const f32x4*)(rowp + bj * HALF + n * 16); }
#pragma unroll
            for (int m = 0; m < 4; ++m) { float* rowp = h + (size_t)(row0 + ai * HALF + m * 16) * 1024 + col0;
#pragma unroll
                for (int bj = 0; bj < 2; ++bj)
#pragma unroll
                    for (int n = 0; n < 2; ++n) *(f32x4*)(rowp + bj * HALF + n * 16) = hv[m][bj][n] + acc[ai][bj][m][n]; } }
    }
};
struct EpiQG {
    static constexpr bool PERM = true, AFTER_DRAIN = false;
    bf16_t* q; bf16_t* pw; float* h;
    __device__ __forceinline__ void operator()(const f32x4 (&acc)[2][2][4][2], const Unit& u, int wr, int wc, int fr, int fq) const {
        const int row0 = u.pm * BM + wr * 64 + fr;
        if (u.pn < 8) { const int col0 = u.pn * 256 + wc * 32 + 8 * fq;
            EPI_ROWS_BEGIN
#pragma unroll
                for (int bj = 0; bj < 2; ++bj) *(u32x4*)(q + row * 2048 + col0 + bj * HALF) = pk8(acc[ai][bj][m][0], acc[ai][bj][m][1]);
            EPI_ROWS_END
        } else { const int col0 = (u.pn - 8) * 256 + wc * 32 + 8 * fq;
#pragma unroll
            for (int ai = 0; ai < 2; ++ai)
#pragma unroll
            for (int mh = 0; mh < 2; ++mh) { u32x4 pwv[2][2];
#pragma unroll
                for (int m2_ = 0; m2_ < 2; ++m2_) { const size_t row = (size_t)(row0 + ai * HALF + (2 * mh + m2_) * 16);
#pragma unroll
                    for (int bj = 0; bj < 2; ++bj) { const int c = col0 + bj * HALF; pwv[m2_][bj] = *(const u32x4*)(pw + row * 1024 + c); } }
#pragma unroll
                for (int m2_ = 0; m2_ < 2; ++m2_) { const int m = 2 * mh + m2_; const size_t row = (size_t)(row0 + ai * HALF + m * 16);
#pragma unroll
                    for (int bj = 0; bj < 2; ++bj) { const int c = col0 + bj * HALF; f32x4 p0, p1; unpk8(pwv[m2_][bj], p0, p1);
                        *(u32x4*)(pw + row * 1024 + c) = pk8(p0 * act4(acc[ai][bj][m][0], 2), p1 * act4(acc[ai][bj][m][1], 2)); } } }
        }
    }
};
template <class Epi, class Sched, bool ALIGN_EPI = false, bool SP2 = false>
__device__ __forceinline__ void gemm_phase(PG8_LAS unsigned char* lds, const Gemm g, const Sched& S, const Epi& E, const int wave0) {
    int tidq; asm volatile("v_mbcnt_lo_u32_b32 %0, -1, 0\n\tv_mbcnt_hi_u32_b32 %0, -1, %0" : "=v"(tidq)); tidq += wave0 * 64;
    const int tid = tidq, wid = __builtin_amdgcn_readfirstlane(tid >> 6), lane = tid & 63, wr = wid >> 2, wc = wid & 3, fr = lane & 15, fq = lane >> 4;
    int Kq = g.K, ldaq = g.lda; const bf16_t* gA = g.A; const bf16_t* gB = g.Bt; asm volatile("" : "+s"(Kq), "+s"(ldaq), "+s"(gA), "+s"(gB));
    const int K = Kq, nt = K / BK;
    unsigned voffA[2], voffB[2];
#pragma unroll
    for (int i = 0; i < 2; ++i) { int R, C; stage_rc(tid * 16 + i * 8192, R, C); const int Rb = Epi::PERM ? ((R & ~31) + perm32(R & 31)) : R;
        voffA[i] = (unsigned)(R * ldaq + C) * 2u; voffB[i] = (unsigned)(Rb * K + C) * 2u; }
    const size_t kstep = (size_t)(BK * 2);
    const size_t hstepA = (size_t)HALF * ldaq * 2, hstepB = (size_t)HALF * K * 2;
    const size_t tstepA = 2 * hstepA, tstepB = 2 * hstepB;
    const unsigned ldsw = (unsigned)wid * 1024u;
    const int aoff = lds_byte(wr * 64 + fr, fq * 8), boff = lds_byte(wc * 32 + fr, fq * 8);
#define PG8_SA(b, h) (((b) * 2 + (h)) * HTB)
#define PG8_SB(b, h) ((4 + (b) * 2 + (h)) * HTB)
#define PG8_STAGE(bufoff, gbase, voff) do { _Pragma("unroll") for (int _i = 0; _i < 2; ++_i) \
        __builtin_amdgcn_global_load_lds((const unsigned*)((const char*)(gbase) + (voff)[_i]), (PG8_LAS unsigned*)(lds + (bufoff) + ldsw + _i * 8192), 16, 0, 0); } while (0)
#define PG8_LDA(dst, b, h) do { _Pragma("unroll") for (int m = 0; m < 4; ++m) _Pragma("unroll") for (int k = 0; k < 2; ++k) dst[m][k] = *(const PG8_LAS bf16x8*)(lds + PG8_SA(b, h) + aoff + m * 2048 + k * 1024); } while (0)
#define PG8_LDB(dst, b, h) do { _Pragma("unroll") for (int n = 0; n < 2; ++n) _Pragma("unroll") for (int k = 0; k < 2; ++k) dst[n][k] = *(const PG8_LAS bf16x8*)(lds + PG8_SB(b, h) + boff + n * 2048 + k * 1024); } while (0)
#define PG8_MMA(ai, bj, At, Bt) do { __builtin_amdgcn_s_setprio(1); _Pragma("unroll") for (int m = 0; m < 4; ++m) _Pragma("unroll") for (int n = 0; n < 2; ++n) _Pragma("unroll") for (int k = 0; k < 2; ++k) \
        acc[ai][bj][m][n] = __builtin_amdgcn_mfma_f32_16x16x32_bf16(Bt[n][k], At[m][k], acc[ai][bj][m][n], 0, 0, 0); __builtin_amdgcn_s_setprio(0); } while (0)
#define PG8_WAIT_V(n) asm volatile("s_waitcnt vmcnt(" #n ")" ::: "memory")
#define PG8_WAIT_L(n) asm volatile("s_waitcnt lgkmcnt(" #n ")" ::: "memory")
#define PG8_BAR __builtin_amdgcn_s_barrier()
#define PG8_SCHED __builtin_amdgcn_sched_barrier(0)
    Unit cur, nxt; int ui = 0;
    if (!S.next(0, cur)) return;
    f32x4 acc[2][2][4][2];
#pragma unroll
    for (int a = 0; a < 2; ++a)
#pragma unroll
        for (int b = 0; b < 2; ++b)
#pragma unroll
            for (int m = 0; m < 4; ++m)
#pragma unroll
                for (int n = 0; n < 2; ++n) acc[a][b][m][n] = (f32x4){0.f, 0.f, 0.f, 0.f};
    bf16x8 At[4][2], B0[2][2], B1[2][2];
    const size_t arow = g.abatch ? (size_t)ldaq * 2 : 0;
    const char* cA = (const char*)gA + (size_t)cur.pm * tstepA + (size_t)(cur.pm >> 4) * arow; const char* cB = (const char*)gB + (size_t)cur.pn * tstepB;
    S.a_ready(cur);
    if constexpr (SP2) {
        PG8_STAGE(PG8_SB(0, 0), cB, voffB); PG8_STAGE(PG8_SB(0, 1), cB + hstepB, voffB); PG8_STAGE(PG8_SA(0, 0), cA, voffA); PG8_STAGE(PG8_SA(0, 1), cA + hstepA, voffA);
        if (wr == 1) PG8_BAR;
        PG8_WAIT_V(2); PG8_BAR;
        PG8_STAGE(PG8_SB(1, 0), cB + kstep, voffB); PG8_STAGE(PG8_SA(1, 0), cA + kstep, voffA); PG8_STAGE(PG8_SB(1, 1), cB + hstepB + kstep, voffB);
        PG8_WAIT_V(6); PG8_BAR;
    } else {
        PG8_STAGE(PG8_SB(0, 0), cB, voffB); PG8_STAGE(PG8_SA(0, 0), cA, voffA); PG8_STAGE(PG8_SB(0, 1), cB + hstepB, voffB); PG8_STAGE(PG8_SA(0, 1), cA + hstepA, voffA);
        if (wr == 1) PG8_BAR;
        PG8_WAIT_V(4); PG8_BAR;
        PG8_STAGE(PG8_SB(1, 0), cB + kstep, voffB); PG8_STAGE(PG8_SA(1, 0), cA + kstep, voffA); PG8_STAGE(PG8_SB(1, 1), cB + hstepB + kstep, voffB);
        PG8_WAIT_V(6); PG8_BAR;
    }
    for (;;) {
        const bool has_next = S.next(ui + 1, nxt);
        const char* nA = has_next ? (const char*)gA + (size_t)nxt.pm * tstepA + (size_t)(nxt.pm >> 4) * arow : cA; const char* nB = has_next ? (const char*)gB + (size_t)nxt.pn * tstepB : cB;
        for (int t = 0; t < nt; t += 2) {
            const bool last = (t == nt - 2);
            const char* a1 = cA + (size_t)(t + 1) * kstep;
            const char* a2 = last ? nA : cA + (size_t)(t + 2) * kstep; const char* b2 = last ? nB : cB + (size_t)(t + 2) * kstep;
            const char* a3 = a2 + kstep; const char* b3 = b2 + kstep;
            if (last && has_next) S.a_ready(nxt);
            if constexpr (SP2) {
            PG8_LDB(B0, 0, 0); PG8_LDB(B1, 0, 1); PG8_SCHED; PG8_LDA(At, 0, 0); PG8_STAGE(PG8_SA(1, 1), a1 + hstepA, voffA);
            PG8_WAIT_V(8); PG8_WAIT_L(0); PG8_BAR; PG8_MMA(0, 0, At, B0); PG8_MMA(0, 1, At, B1); PG8_BAR; PG8_SCHED;
            PG8_LDA(At, 0, 1); PG8_STAGE(PG8_SB(0, 0), b2, voffB); PG8_STAGE(PG8_SB(0, 1), b2 + hstepB, voffB); PG8_STAGE(PG8_SA(0, 0), a2, voffA);
            PG8_WAIT_V(8); PG8_WAIT_L(0); PG8_BAR; PG8_MMA(1, 0, At, B0); PG8_MMA(1, 1, At, B1); PG8_BAR; PG8_SCHED;
            PG8_LDB(B0, 1, 0); PG8_LDB(B1, 1, 1); PG8_SCHED; PG8_LDA(At, 1, 0); PG8_STAGE(PG8_SA(0, 1), a2 + hstepA, voffA);
            PG8_WAIT_V(8); PG8_WAIT_L(0); PG8_BAR; PG8_MMA(0, 0, At, B0); PG8_MMA(0, 1, At, B1); PG8_BAR; PG8_SCHED;
            PG8_LDA(At, 1, 1); PG8_STAGE(PG8_SB(1, 0), b3, voffB); PG8_STAGE(PG8_SB(1, 1), b3 + hstepB, voffB); PG8_STAGE(PG8_SA(1, 0), a3, voffA);
            PG8_WAIT_V(8); PG8_WAIT_L(0); PG8_BAR; PG8_MMA(1, 0, At, B0); PG8_MMA(1, 1, At, B1); PG8_BAR; PG8_SCHED;
            } else {
            PG8_LDB(B0, 0, 0); PG8_SCHED; PG8_LDA(At, 0, 0); PG8_STAGE(PG8_SA(1, 1), a1 + hstepA, voffA);
            PG8_WAIT_L(8); PG8_BAR; PG8_WAIT_L(0); PG8_MMA(0, 0, At, B0); PG8_BAR; PG8_SCHED;
            PG8_LDB(B1, 0, 1); PG8_STAGE(PG8_SB(0, 0), b2, voffB);
            PG8_BAR; PG8_WAIT_L(0); PG8_MMA(0, 1, At, B1); PG8_BAR;
            PG8_LDA(At, 0, 1); PG8_STAGE(PG8_SA(0, 0), a2, voffA);
            PG8_BAR; PG8_WAIT_L(0); PG8_MMA(1, 0, At, B0); PG8_BAR; PG8_SCHED;
            PG8_STAGE(PG8_SB(0, 1), b2 + hstepB, voffB);
            PG8_WAIT_V(6); PG8_BAR; PG8_MMA(1, 1, At, B1); PG8_BAR;
            PG8_LDB(B0, 1, 0); PG8_SCHED; PG8_LDA(At, 1, 0); PG8_STAGE(PG8_SA(0, 1), a2 + hstepA, voffA);
            PG8_WAIT_L(8); PG8_BAR; PG8_WAIT_L(0); PG8_MMA(0, 0, At, B0); PG8_BAR; PG8_SCHED;
            PG8_LDB(B1, 1, 1); PG8_STAGE(PG8_SB(1, 0), b3, voffB);
            PG8_BAR; PG8_WAIT_L(0); PG8_MMA(0, 1, At, B1); PG8_BAR;
            PG8_LDA(At, 1, 1); PG8_STAGE(PG8_SA(1, 0), a3, voffA);
            PG8_BAR; PG8_WAIT_L(0); PG8_MMA(1, 0, At, B0); PG8_BAR; PG8_SCHED;
            PG8_STAGE(PG8_SB(1, 1), b3 + hstepB, voffB);
            PG8_WAIT_V(6); PG8_BAR; PG8_MMA(1, 1, At, B1); PG8_BAR;
            }
        }
        if constexpr (ALIGN_EPI) { if (wr == 0) PG8_BAR; }
        if constexpr (!Epi::AFTER_DRAIN) { E(acc, cur, wr, wc, fr, fq); S.done(cur); }
        if (!has_next) break;
#pragma unroll
        for (int a = 0; a < 2; ++a)
#pragma unroll
            for (int b = 0; b < 2; ++b)
#pragma unroll
                for (int m = 0; m < 4; ++m)
#pragma unroll
                    for (int n = 0; n < 2; ++n) acc[a][b][m][n] = (f32x4){0.f, 0.f, 0.f, 0.f};
        cur = nxt; cA = nA; cB = nB; ++ui;
        if constexpr (ALIGN_EPI) { if (wr == 1) PG8_BAR; }
    }
    PG8_WAIT_V(0);
    if constexpr (!ALIGN_EPI) { if (wr == 0) PG8_BAR; }
    PG8_BAR;
    if constexpr (Epi::AFTER_DRAIN) { E.fused(acc, cur, wr, wc, fr, fq, lds, wid, lane); S.done(cur); }
#undef PG8_SA
#undef PG8_SB
#undef PG8_STAGE
#undef PG8_LDA
#undef PG8_LDB
#undef PG8_MMA
#undef PG8_WAIT_V
#undef PG8_WAIT_L
#undef PG8_BAR
#undef PG8_SCHED
}
}

constexpr int NB = 8, SEQ = 4096, T = NB * SEQ, D = 1024, DEPTH = 4, NZ = 7680, NWAVES = 8;
constexpr int CIN = 7424;
constexpr size_t MiB = 1u << 20;
constexpr size_t WS_CTL = 0, WS_LORA = 1 * MiB, WS_MV = 7 * MiB, ZERO_BYTES = 9 * MiB;
constexpr size_t LORA_BYTES = 3072 * 256 * 2, MV_BYTES = 1024 * 256 * 2;
constexpr size_t WS_WIN = 10 * MiB;
constexpr size_t WS_DB = 40 * MiB, DB_SET = 62 * MiB;
constexpr size_t DB_PA = 0, DB_PBT = 2 * MiB, DB_POUT = 4 * MiB, DB_WQG = 6 * MiB, DB_KEYS = 12 * MiB, DB_GMW = 12 * MiB + 512 * 1024, DB_PLEW = 13 * MiB, DB_U = 14 * MiB, DB_V = 30 * MiB, DB_PB = 46 * MiB;
constexpr size_t WS_VF = 164 * MiB, WS_PW = 228 * MiB, WS_NX = 292 * MiB, WS_ZRKV = 420 * MiB, WS_ZL = 612 * MiB, WS_GUV = 644 * MiB, WS_SG = 772 * MiB;
constexpr size_t WS_EW = 900 * MiB, WS_AR = 964 * MiB, WS_G = 1028 * MiB, WS_WINB = 1092 * MiB, WINB_BYTES = 4 * MiB, WS_END = 1100 * MiB;
constexpr size_t WS_Q = WS_ZRKV, WS_SEL = WS_ZRKV + 128 * MiB, WS_MG = WS_AR, WS_N2 = WS_G;
constexpr size_t WIN_ZERO_OFF = WS_WIN + (size_t)3328 * 2048 * 2, WIN_ZERO_BYTES = (size_t)256 * 2048 * 2;
#ifndef ZSPLIT
#define ZSPLIT 2
#endif
constexpr int CW_BAR = 4096;
constexpr int RING_BYTES = 131072, LDSCTL_OFF = RING_BYTES, MISC_OFF = LDSCTL_OFF + 320, LDS_BYTES = 147456;

#define LAS __attribute__((address_space(3)))
#define GAS __attribute__((address_space(1)))
typedef unsigned short bf16;
typedef unsigned v4u __attribute__((ext_vector_type(4)));
typedef unsigned v2u __attribute__((ext_vector_type(2)));
typedef float f32x4 __attribute__((ext_vector_type(4)));
typedef float f32x2 __attribute__((ext_vector_type(2)));
typedef short bf16x8 __attribute__((ext_vector_type(8)));
using pg8::fsig; using pg8::fgelu; using pg8::bflo; using pg8::bfhi; using pg8::unpk8; using pg8::pk8; using pg8::cvt_pk_bf16;

#define XB_TMO      128
#define XB_XCNT(j)  (256  + 64 * (j))
#define XB_XSUB(j)  (1280 + 64 * (j))
#define XB_XGEN(j)  (2304 + 64 * (j))
#define XB_TOP      3328
#define XB_TOPGEN   3392
#define XCD_BAR_WORDS 3456
#define XB_SPIN_CAP (1u << 22)

__device__ __forceinline__ unsigned xb_ld(unsigned* p)              { return __hip_atomic_load(p, __ATOMIC_RELAXED, __HIP_MEMORY_SCOPE_AGENT); }
__device__ __forceinline__ unsigned xb_add(unsigned* p, unsigned v) { return __hip_atomic_fetch_add(p, v, __ATOMIC_RELAXED, __HIP_MEMORY_SCOPE_AGENT); }
__device__ __forceinline__ unsigned xb_xcc_id() { return (unsigned)__builtin_amdgcn_s_getreg((3 << 11) | 20) & 0xFu; }
#define XB_SPIN(cond, bar) do { unsigned _sp = 0; while (cond) { __builtin_amdgcn_s_sleep(1); \
    if ((++_sp & 255u) == 0u) { if (xb_ld(&(bar)[XB_TMO])) break; if (_sp > XB_SPIN_CAP) { atomicAdd(&(bar)[XB_TMO], 1u); break; } } } } while (0)

struct XcdBarrier { unsigned* bar; unsigned x; volatile LAS unsigned* st; };

__device__ __forceinline__ XcdBarrier xcd_barrier_post(unsigned* bar, volatile LAS unsigned* st) {
    XcdBarrier b; b.bar = bar; b.x = xb_xcc_id(); b.st = st;
    if (threadIdx.x == 0) (void)xb_add(&bar[XB_XCNT(b.x)], 1u);
    return b;
}
__device__ __forceinline__ void xcd_barrier_complete(unsigned* bar, unsigned x, unsigned& nloc, unsigned& nx) {
    const unsigned G = gridDim.x * gridDim.y * gridDim.z;
    unsigned sum, cnt, mine, sp = 0u;
    for (;;) {
        sum = 0u; cnt = 0u; mine = 0u;
#pragma unroll
        for (unsigned j = 0; j < 16; ++j) { const unsigned c = xb_ld(&bar[XB_XCNT(j)]); sum += c; cnt += (c > 0u) ? 1u : 0u; mine = (j == x) ? c : mine; }
        if (sum == G) break;
        __builtin_amdgcn_s_sleep(1);
        if ((++sp & 255u) == 0u) { if (xb_ld(&bar[XB_TMO])) break; if (sp > XB_SPIN_CAP) { atomicAdd(&bar[XB_TMO], 1u); break; } }
    }
    nloc = mine > 0u ? mine : 1u; nx = cnt > 0u ? cnt : 1u;
}
__device__ __forceinline__ int lane_id_now();
__device__ __forceinline__ void xcd_barrier(const XcdBarrier& b, const int wave0) {
    asm volatile("s_waitcnt vmcnt(0)" ::: "memory");
    __syncthreads();
    if (wave0 == 0 && lane_id_now() == 0) {
        unsigned* bar = b.bar;
        __builtin_amdgcn_s_waitcnt(0);
        unsigned nloc = b.st[0], nx = b.st[1];
        if (nloc == 0u) { xcd_barrier_complete(bar, b.x, nloc, nx); b.st[0] = nloc; b.st[1] = nx; }
        const unsigned old = xb_add(&bar[XB_XSUB(b.x)], 1u);
        const unsigned gen = old / nloc;
        if (old + 1u == (gen + 1u) * nloc) {
            __builtin_amdgcn_fence(__ATOMIC_RELEASE, "agent");
            asm volatile("s_waitcnt vmcnt(0)" ::: "memory");
            const unsigned og = xb_add(&bar[XB_TOP], 1u);
            const unsigned tg = og / nx;
            if (og + 1u == (tg + 1u) * nx) xb_add(&bar[XB_TOPGEN], 1u);
            else XB_SPIN(xb_ld(&bar[XB_TOPGEN]) == tg, bar);
            __builtin_amdgcn_fence(__ATOMIC_ACQUIRE, "agent");
            xb_add(&bar[XB_XGEN(b.x)], 1u);
            asm volatile("s_waitcnt vmcnt(0)" ::: "memory");
        } else {
            XB_SPIN(xb_ld(&bar[XB_XGEN(b.x)]) == gen, bar);
            __builtin_amdgcn_fence(__ATOMIC_ACQUIRE, "agent");
            asm volatile("s_waitcnt vmcnt(0)" ::: "memory");
        }
    }
    __syncthreads();
}

struct Args { const float* in[32]; float* out; unsigned char* ws; };
struct Frame {
    LAS unsigned char* lds;
    int tid, lane, wave, G, bx, wave0;
    GAS unsigned char* ws; float* h;
};
__device__ __forceinline__ int lane_id_now() { int l; asm volatile("v_mbcnt_lo_u32_b32 %0, -1, 0\n\tv_mbcnt_hi_u32_b32 %0, -1, %0" : "=v"(l)); return l; }
__device__ __forceinline__ void phase_ids(Frame& F) { const int l = lane_id_now(); F.lane = l; F.wave = F.wave0; F.tid = F.wave0 * 64 + l; GAS unsigned char* w = F.ws; asm volatile("" : "+s"(w)); F.ws = w; }
#define DPP_ADD(x, ctrl) ((x) + __builtin_bit_cast(float, __builtin_amdgcn_update_dpp(0, __builtin_bit_cast(int, (x)), (ctrl), 0xf, 0xf, false)))
__device__ __forceinline__ float sum8(float v) {
    v = DPP_ADD(v, 0xB1);
    v = DPP_ADD(v, 0x4E);
    v = DPP_ADD(v, 0x141);
    return v;
}
__device__ __forceinline__ float sum16(float v) { v = sum8(v); v = DPP_ADD(v, 0x140); return v; }
#define DPP_ADD_NS(x, ctrl) do { (x) = DPP_ADD((x), (ctrl)); asm("" : "+v"(x)); } while (0)
__device__ __forceinline__ float sum16_ns(float v) { DPP_ADD_NS(v, 0xB1); DPP_ADD_NS(v, 0x4E); DPP_ADD_NS(v, 0x141); DPP_ADD_NS(v, 0x140); return v; }
__device__ __forceinline__ float wave_sum(float v) {
    v = sum8(v);
    v = DPP_ADD(v, 0x140);
    const auto r = __builtin_amdgcn_permlane16_swap(__builtin_bit_cast(unsigned, v), __builtin_bit_cast(unsigned, v), false, false);
    v = __builtin_bit_cast(float, (unsigned)r[0]) + __builtin_bit_cast(float, (unsigned)r[1]);
    const auto q = __builtin_amdgcn_permlane32_swap(__builtin_bit_cast(unsigned, v), __builtin_bit_cast(unsigned, v), false, false);
    return __builtin_bit_cast(float, (unsigned)q[0]) + __builtin_bit_cast(float, (unsigned)q[1]);
}
__device__ __forceinline__ unsigned xor16_u(unsigned x, int lane) { const auto r = __builtin_amdgcn_permlane16_swap(x, x, false, false); return (lane & 16) ? (unsigned)r[0] : (unsigned)r[1]; }
__device__ __forceinline__ unsigned xor32_u(unsigned x, int lane) { const auto r = __builtin_amdgcn_permlane32_swap(x, x, false, false); return (lane & 32) ? (unsigned)r[0] : (unsigned)r[1]; }
__device__ __forceinline__ void tr_item(const float* W, int ldw, int ncols, bf16* WT, int ldt, int koff, int row_off, LAS float* scr, int item, int lane, int kx = 0) {
    const int nblk = ncols / 32, kb = item / nblk, nb = item % nblk, k0 = 64 * kb, n0 = 32 * nb;
#pragma unroll 8
    for (int i = 0; i < 32; ++i) { const int kk = 2 * i + (lane >> 5); scr[kk * 33 + (lane & 31)] = W[(size_t)(k0 + kk) * ldw + n0 + (lane & 31)]; }
    asm volatile("s_waitcnt lgkmcnt(0)" ::: "memory");
    const int c = lane & 7;
#pragma unroll
    for (int j = 0; j < 4; ++j) { const int n = (lane >> 3) + 8 * j; const LAS float* s = scr + (8 * c) * 33 + n;
        v4u o; o.x = cvt_pk_bf16(s[0 * 33], s[1 * 33]); o.y = cvt_pk_bf16(s[2 * 33], s[3 * 33]); o.z = cvt_pk_bf16(s[4 * 33], s[5 * 33]); o.w = cvt_pk_bf16(s[6 * 33], s[7 * 33]);
        *(v4u*)(WT + (size_t)(row_off + n0 + n) * ldt + ((koff + k0 + 8 * c) ^ kx)) = o; }
    asm volatile("s_waitcnt lgkmcnt(0)" ::: "memory");
}
__device__ __forceinline__ void cvt_chunk(const float* src, bf16* dst, size_t chunk, int lane) {
    const f32x4* s = (const f32x4*)(src + chunk * 512) + lane * 2; const f32x4 a = s[0], b = s[1];
    *(v4u*)(dst + chunk * 512 + lane * 8) = pk8(a, b);
}
__device__ __forceinline__ void cvt8_chunk(const float* src, unsigned char* dst, size_t chunk, int lane, float sc) {
    const f32x4* s = (const f32x4*)(src + chunk * 512) + lane * 2; const f32x4 a = s[0] * sc, b = s[1] * sc;
    int w0 = 0, w1 = 0;
    w0 = __builtin_amdgcn_cvt_pk_fp8_f32(a.x, a.y, w0, false); w0 = __builtin_amdgcn_cvt_pk_fp8_f32(a.z, a.w, w0, true);
    w1 = __builtin_amdgcn_cvt_pk_fp8_f32(b.x, b.y, w1, false); w1 = __builtin_amdgcn_cvt_pk_fp8_f32(b.z, b.w, w1, true);
    *(v2u*)(dst + chunk * 512 + lane * 8) = (v2u){(unsigned)w0, (unsigned)w1};
}
#define NXROW(t) ((size_t)(t) + ((size_t)(t) >> 12) + 1)
__device__ __forceinline__ void norm_row_nx(const float* hrow, float* hcopy, const float* g, bf16* NX, int t, int lane) {
    const f32x4* xr = (const f32x4*)hrow + lane; f32x4 v[4]; float s = 0.f;
#pragma unroll
    for (int j = 0; j < 4; ++j) { v[j] = xr[64 * j]; s += (v[j].x * v[j].x + v[j].y * v[j].y) + (v[j].z * v[j].z + v[j].w * v[j].w); }
    if (hcopy) {
#pragma unroll
        for (int j = 0; j < 4; ++j) ((f32x4*)hcopy)[lane + 64 * j] = v[j]; }
    const float rstd = 1.f / sqrtf(wave_sum(s) * (1.f / D) + 1e-6f);
#pragma unroll
    for (int j = 0; j < 4; ++j) { const f32x4 gv = ((const f32x4*)g)[lane + 64 * j]; const f32x4 o = v[j] * rstd * gv;
        v2u w; w.x = cvt_pk_bf16(o.x, o.y); w.y = cvt_pk_bf16(o.z, o.w);
        const int c = 4 * (lane + 64 * j);
        *(v2u*)(NX + NXROW(t) * 1024 + c) = w; }
}
__device__ __forceinline__ void norm_row_n2x2(const float* hrow0, const float* hrow1, const float* g, bf16* o0, bf16* o1, int lane) {
    const f32x4* x0 = (const f32x4*)hrow0 + lane; const f32x4* x1 = (const f32x4*)hrow1 + lane; f32x4 v[2][4]; float s0 = 0.f, s1 = 0.f;
#pragma unroll
    for (int j = 0; j < 4; ++j) { v[0][j] = x0[64 * j]; v[1][j] = x1[64 * j]; }
#pragma unroll
    for (int j = 0; j < 4; ++j) { s0 += (v[0][j].x * v[0][j].x + v[0][j].y * v[0][j].y) + (v[0][j].z * v[0][j].z + v[0][j].w * v[0][j].w);
                                  s1 += (v[1][j].x * v[1][j].x + v[1][j].y * v[1][j].y) + (v[1][j].z * v[1][j].z + v[1][j].w * v[1][j].w); }
    const float r0 = 1.f / sqrtf(wave_sum(s0) * (1.f / D) + 1e-6f), r1 = 1.f / sqrtf(wave_sum(s1) * (1.f / D) + 1e-6f);
#pragma unroll
    for (int j = 0; j < 4; ++j) { const f32x4 gv = ((const f32x4*)g)[lane + 64 * j]; const f32x4 a = v[0][j] * r0 * gv, b = v[1][j] * r1 * gv;
        *(v2u*)(o0 + 4 * (lane + 64 * j)) = (v2u){cvt_pk_bf16(a.x, a.y), cvt_pk_bf16(a.z, a.w)}; *(v2u*)(o1 + 4 * (lane + 64 * j)) = (v2u){cvt_pk_bf16(b.x, b.y), cvt_pk_bf16(b.z, b.w)}; }
}
__device__ __forceinline__ void prep_phase(Frame& F, const Args& a, int layer, int blk, int nblk_, int part) {
    phase_ids(F);
    LAS float* scr = (LAS float*)(F.lds + F.wave * 16384);
    const int gw = blk * NWAVES + F.wave, NGW = nblk_ * NWAVES, lane = F.lane;
    GAS unsigned char* ws = F.ws; GAS unsigned char* db = F.ws + WS_DB + (size_t)(layer & 1) * DB_SET;
    bf16* WIN = (bf16*)(ws + WS_WIN); bf16* LORA = (bf16*)(ws + WS_LORA + (size_t)layer * LORA_BYTES); bf16* MVT = (bf16*)(ws + WS_MV + (size_t)(layer > 0 ? layer - 1 : 0) * MV_BYTES);
    const float* w_in = a.in[5] + (size_t)layer * 2048 * CIN;
    const int mvn = layer > 0 ? 32 : 0;
    const int c1 = 32 * 104, c2a = 32 * 64, c2b = 32 * 32, c2c = 32 * (32 - 8 * ZSPLIT), c2d = 32 * 8 * ZSPLIT, c2 = c2a + 2 * c2b, c3 = mvn, c4 = 32, c5 = 32, c6 = 64, c7 = 512, c10 = 1024, c12 = 128;
    const int total = (part & 1) ? c1 + c2 + c3 + c4 + c5 + c6 + 3 * c7 + c10 + c7 + c12 : 0;
    for (int it = gw; it < total; it += NGW) {
        int r = it;
        if (r < c1) { tr_item(w_in, CIN, 3328, WIN, 2048, 0, 0, scr, r, lane, 1024); continue; } r -= c1;
        if (r < c2a) { tr_item(w_in + 3328, CIN, 2048, WIN, 2048, 0, 3584, scr, r, lane, 1024); continue; } r -= c2a;
        if (r < c2b) { tr_item(w_in + 6400, CIN, 1024, WIN, 2048, 0, 5632, scr, r, lane, 1024); continue; } r -= c2b;
        if (r < c2c) { tr_item(w_in + 5376, CIN, 1024 - 256 * ZSPLIT, WIN, 2048, 0, 6656, scr, r, lane, 1024); continue; } r -= c2c;
        if (r < c2d) { tr_item(w_in + 6400 - 256 * ZSPLIT, CIN, 256 * ZSPLIT, (bf16*)(ws + WS_WINB + (size_t)(layer & 1) * WINB_BYTES), 2048, 0, 0, scr, r, lane, 1024); continue; } r -= c2d;
        if (r < c3) { tr_item(a.in[16] + (size_t)(layer - 1) * 2048 * 32, 32, 32, WIN, 2048, 0, 3328, scr, r, lane, 1024); continue; } r -= c3;
        if (r < c4) { tr_item(a.in[7] + (size_t)layer * 64 * 1024, 1024, 1024, LORA, 128, 0, 0, scr, r, lane); continue; } r -= c4;
        if (r < c5) { tr_item(a.in[9] + (size_t)layer * 64 * 1024, 1024, 1024, LORA, 128, 64, 1024, scr, r, lane); continue; } r -= c5;
        if (r < c6) { tr_item(a.in[10] + (size_t)layer * 128 * 1024, 1024, 1024, LORA + 2048 * 128, 128, 0, 0, scr, r, lane); continue; } r -= c6;
        if (r < c7) { tr_item(a.in[23] + (size_t)layer * D * D, D, D, (bf16*)(db + DB_PA), D, 0, 0, scr, r, lane); continue; } r -= c7;
        if (r < c7) { tr_item(a.in[24] + (size_t)layer * D * D, D, D, (bf16*)(db + DB_PBT), D, 0, 0, scr, r, lane); continue; } r -= c7;
        if (r < c7) { tr_item(a.in[25] + (size_t)layer * D * D, D, D, (bf16*)(db + DB_POUT), D, 0, 0, scr, r, lane); continue; } r -= c7;
        if (r < c10) { tr_item(a.in[26] + (size_t)layer * D * 2048, 2048, 2048, (bf16*)(db + DB_WQG), D, 0, 0, scr, r, lane); continue; } r -= c10;
        if (r < c7) { tr_item(a.in[31] + (size_t)layer * D * D, D, D, (bf16*)(db + DB_WQG), D, 0, 2048, scr, r, lane); continue; } r -= c7;
        tr_item(a.in[30] + (size_t)layer * 256 * D, D, D, (bf16*)(db + DB_PLEW), 256, 0, 0, scr, r, lane);
    }
    if (layer > 0 && (part & 1)) {
        const float* w2 = a.in[17] + (size_t)(layer - 1) * 32 * 1024;
        for (int it = gw; it < 512; it += NGW) { const int e = it * 64 + lane, n = e >> 5, k = e & 31; MVT[n * 128 + k] = (bf16)(cvt_pk_bf16(w2[k * 1024 + n], 0.f) & 0xffffu); }
    }
    {
        const float* keys = a.in[27] + (size_t)layer * 262144; const float* ut = a.in[28] + (size_t)layer * 16777216; const float* vt = a.in[29] + (size_t)layer * 16777216;
        const float* pin = a.in[1] + (size_t)layer * T * 256; const float* gws = a.in[21] + (size_t)layer * 131072;
        const int n1 = (part & 1) ? 512 : 0, n2 = (part & 2) ? 32768 : 0, n4 = (part & 1) ? 16384 : 0, n5 = (part & 1) ? 256 : 0, ntot = n1 + 2 * n2 + n4 + n5;
        for (int it = gw; it < ntot; it += NGW) {
            int r = it;
            if (r < n2) { cvt8_chunk(ut, (unsigned char*)(db + DB_U), r, lane, 256.f); continue; } r -= n2;
            if (r < n2) { cvt8_chunk(vt, (unsigned char*)(db + DB_V), r, lane, 64.f); continue; } r -= n2;
            if (r < n4) { cvt_chunk(pin, (bf16*)(db + DB_PB), r, lane); continue; } r -= n4;
            if (r < n1) { cvt_chunk(keys, (bf16*)(db + DB_KEYS), r, lane); continue; } r -= n1;
            {
                const int e0 = r * 512 + lane * 8, tq = (e0 >> 7) & 127, p0 = e0 & 127;
                const f32x4* s = (const f32x4*)(gws + e0); f32x4 x0 = s[0], x1 = s[1];
#pragma unroll
                for (int j = 0; j < 4; ++j) { if (p0 + j > tq) x0[j] = 0.f; if (p0 + 4 + j > tq) x1[j] = 0.f; }
                *(v4u*)((bf16*)(db + DB_GMW) + e0) = pk8(x0, x1);
            }
        }
    }
    if (layer == 0 && (part & 1)) {
        if (gw < NB) *(v4u*)((bf16*)(ws + WS_NX) + (size_t)gw * (SEQ + 1) * 1024 + 8 * lane) = (v4u){0u, 0u, 0u, 0u}, *(v4u*)((bf16*)(ws + WS_NX) + (size_t)gw * (SEQ + 1) * 1024 + 512 + 8 * lane) = (v4u){0u, 0u, 0u, 0u};
        for (int m = gw; m < T; m += NGW) norm_row_nx(a.in[0] + (size_t)m * D, F.h + (size_t)m * D, a.in[2], (bf16*)(ws + WS_NX), m, lane);
    }
}

constexpr int SC = 32, NPR = SC / 2;
constexpr int SC_VEC = SC * 64;
constexpr int SC_WW = 0, SC_VQ = NPR * 64, SC_BK = SC_VQ + NPR * 256, SC_XA = SC_BK + NPR * 128, SC_C = SC_XA + NPR * 128, SC_VP = SC_C + NPR * 20, SC_BON = SC_VP + SC * 64, SC_BUF = SC_BON + SC * 8;
static_assert(SC_BUF % 4 == 0 && SC_C % 4 == 0 && (2 * SC_BUF + 2 * SC_VEC) * 4 + 64 <= 131072, "scan LDS map");
struct ScanOps { f32x4 w[4], vq, c[4]; v4u bk[2]; bf16x8 x[2]; };
__device__ __forceinline__ void scan_load2(ScanOps& o, const LAS float* buf, const LAS float* vqp, const LAS unsigned char* bkp, int bkstep, int p, int lane) {
    const int q = lane >> 4;
    const LAS float* wp = buf + SC_WW + p * 64 + q * 4;
#pragma unroll
    for (int i = 0; i < 4; ++i) o.w[i] = *(const LAS f32x4*)(wp + 16 * i);
    o.vq = *(const LAS f32x4*)(vqp + p * 256);
    o.bk[0] = *(const LAS v4u*)(bkp + p * bkstep); o.bk[1] = *(const LAS v4u*)(bkp + p * bkstep + 16);
    const LAS unsigned char* xp = (const LAS unsigned char*)(buf + SC_XA) + p * 512 + (lane & 3) * 128 + q * 16;
    o.x[0] = *(const LAS bf16x8*)xp; o.x[1] = *(const LAS bf16x8*)(xp + 64);
#pragma unroll
    for (int i = 0; i < 4; ++i) o.c[i] = *(const LAS f32x4*)(buf + SC_C + p * 20 + 4 * i);
}
__device__ __forceinline__ const char* uni_ptr(const char* p) { const unsigned long long a = (unsigned long long)p;
    const unsigned lo = (unsigned)__builtin_amdgcn_readfirstlane((int)(unsigned)a), hi = (unsigned)__builtin_amdgcn_readfirstlane((int)(unsigned)(a >> 32));
    return (const char*)(((unsigned long long)hi << 32) | lo); }
__device__ __forceinline__ float smul(float a, float b) { float r; asm("v_mul_f32 %0, %1, %2" : "=v"(r) : "v"(a), "v"(b)); return r; }
__device__ __forceinline__ void scan_pair(const ScanOps& o, f32x4 (&St)[4], float& sa0, float& sa1, v4u (&am)[4], v4u& bm, LAS float* ypt, int ystep, unsigned m16) {
    v4u s0, s1;
    s0.x = cvt_pk_bf16(St[0].x, St[0].y); s0.y = cvt_pk_bf16(St[0].z, St[0].w); s0.z = cvt_pk_bf16(St[1].x, St[1].y); s0.w = cvt_pk_bf16(St[1].z, St[1].w);
    s1.x = cvt_pk_bf16(St[2].x, St[2].y); s1.y = cvt_pk_bf16(St[2].z, St[2].w); s1.z = cvt_pk_bf16(St[3].x, St[3].y); s1.w = cvt_pk_bf16(St[3].z, St[3].w);
    f32x4 dv = (f32x4){0.f, 0.f, 0.f, 0.f};
    dv = __builtin_amdgcn_mfma_f32_16x16x32_bf16(o.x[0], __builtin_bit_cast(bf16x8, s0), dv, 0, 0, 0);
    dv = __builtin_amdgcn_mfma_f32_16x16x32_bf16(o.x[1], __builtin_bit_cast(bf16x8, s1), dv, 0, 0, 0);
    const float v0 = o.vq.x, v1 = o.vq.y, v2 = o.vq.z;
    typedef short s16x4 __attribute__((ext_vector_type(4)));
    const v2u bm2 = (v2u){cvt_pk_bf16(sa0, v0) & m16, cvt_pk_bf16(sa1, v1) & m16};
#pragma unroll
    for (int i = 0; i < 4; ++i) { const v2u a2 = (v2u){o.bk[i >> 1][(i & 1) * 2], o.bk[i >> 1][(i & 1) * 2 + 1]};
        St[i] = __builtin_amdgcn_mfma_f32_16x16x16bf16_1k(__builtin_bit_cast(s16x4, a2), __builtin_bit_cast(s16x4, bm2),
                                                        (f32x4){smul(St[i].x, o.w[i].x), smul(St[i].y, o.w[i].y), smul(St[i].z, o.w[i].z), smul(St[i].w, o.w[i].w)}, 0, 0, 0); }
    ypt[0]     = dv.z + sa0 * o.c[2].z + v0 * o.c[2].w;
    ypt[ystep] = dv.w + sa0 * o.c[3].x + v0 * o.c[3].y + sa1 * o.c[3].z + v1 * o.c[3].w;
    const float n0 = dv.x + sa0 * o.c[0].x + v0 * o.c[0].y + sa1 * o.c[0].z + v1 * o.c[0].w;
    const float n1 = dv.y + sa0 * o.c[1].x + v0 * o.c[1].y + sa1 * o.c[1].z + v1 * o.c[1].w + n0 * o.c[2].x + v2 * o.c[2].y;
    sa0 = n0; sa1 = n1;
}
__device__ __forceinline__ void scan_unit(Frame& F, const Args& a, int layer, int unit) {
    phase_ids(F);
    const int b = unit >> 4, hh = unit & 15, tid = F.tid, lane = F.lane, wave = F.wave;
    LAS float* bufs = (LAS float*)F.lds;
    LAS float* sY = bufs + 2 * SC_BUF;
    const bf16* ZR = (const bf16*)(F.ws + WS_ZRKV); const bf16* EW = (const bf16*)(F.ws + WS_EW); const bf16* AR = (const bf16*)(F.ws + WS_AR); const bf16* GT = (const bf16*)(F.ws + WS_G);
    bf16* YA = (bf16*)(F.ws + WS_G);
    constexpr int NCH = SEQ / SC;
    if (wave < 4) {
        f32x4 St[4]; v4u am[4], bm = (v4u){0u, 0u, 0u, 0u};
#pragma unroll
        for (int i = 0; i < 4; ++i) { St[i] = (f32x4){0.f, 0.f, 0.f, 0.f}; am[i] = (v4u){0u, 0u, 0u, 0u}; }
        float sa0 = 0.f, sa1 = 0.f;
        const unsigned m16 = lane < 16 ? 0xffffffffu : 0u;
        LAS unsigned char* zblk = (LAS unsigned char*)(sY + 2 * SC_VEC);
        if (tid < 8) ((LAS unsigned*)zblk)[tid] = 0u;
        const int bkstep = lane < 16 ? 512 : 0;
        for (int it = 0; it < NCH + 2; ++it) {
            if (it >= 1 && it <= NCH) {
                const LAS float* bufc = bufs + ((it - 1) & 1) * SC_BUF;
                const LAS float* vqp = bufc + SC_VQ + 4 * (wave * 16 + (lane & 15));
                const LAS unsigned char* bkp = lane < 16 ? (const LAS unsigned char*)(bufc + SC_BK) + lane * 32 : (const LAS unsigned char*)zblk;
                LAS float* yb = lane < 16 ? sY + ((it - 1) & 1) * SC_VEC + wave * 16 + lane : (LAS float*)(zblk + 32);
                const int ystep = lane < 16 ? 64 : 0;
                if (it == 1) { sa0 = 0.f; sa1 = vqp[0] * bufc[SC_C + 16]; }
                ScanOps o0, o1;
                scan_load2(o0, bufc, vqp, bkp, bkstep, 0, lane);
#pragma unroll 1
                for (int p = 0; p < NPR; p += 2) {
                    scan_load2(o1, bufc, vqp, bkp, bkstep, p + 1, lane);
                    scan_pair(o0, St, sa0, sa1, am, bm, yb + (2 * p) * ystep, ystep, m16);
                    if (p + 2 < NPR) scan_load2(o0, bufc, vqp, bkp, bkstep, p + 2, lane);
                    scan_pair(o1, St, sa0, sa1, am, bm, yb + (2 * p + 2) * ystep, ystep, m16);
                }
            }
            __syncthreads();
        }
    } else {
        const int ht = tid - 256, tl = ht >> 3, c8 = ht & 7, ch = hh * 64 + c8 * 8;
        const int pr = ht >> 4, c4 = ht & 15, chp = hh * 64 + c4 * 4;
        const size_t po = (size_t)layer * 1024 + ch, pop = (size_t)layer * 1024 + chp;
        struct HelpIn { v2u r0, k0, v0, e0, a0, r1, k1, v1, e1, a1, k2, v2, e2, a2, k3; v4u gt; };
        HelpIn cur, nxt;
#define HELP_ROW(H, F_, RR, OFF, ARR, PITCH) (H).F_ = *(const v2u*)((ARR) + ((size_t)b * SEQ + (RR)) * (PITCH) + (OFF) + chp)
#define HELP_LOAD(H, PC, GC) do { \
            if ((PC) < NCH) { const int _t = (PC) * SC + 2 * pr; \
                HELP_ROW(H, r0, _t, 0, ZR, 3072); HELP_ROW(H, k0, _t, 1024, ZR, 3072); HELP_ROW(H, v0, _t, 2048, ZR, 3072); HELP_ROW(H, e0, _t, 0, EW, 1024); HELP_ROW(H, a0, _t, 0, AR, 1024); \
                HELP_ROW(H, r1, _t + 1, 0, ZR, 3072); HELP_ROW(H, k1, _t + 1, 1024, ZR, 3072); HELP_ROW(H, v1, _t + 1, 2048, ZR, 3072); HELP_ROW(H, e1, _t + 1, 0, EW, 1024); HELP_ROW(H, a1, _t + 1, 0, AR, 1024); \
                HELP_ROW(H, k2, _t + 2, 1024, ZR, 3072); HELP_ROW(H, v2, _t + 2, 2048, ZR, 3072); HELP_ROW(H, e2, _t + 2, 0, EW, 1024); HELP_ROW(H, a2, _t + 2, 0, AR, 1024); \
                HELP_ROW(H, k3, _t + 3, 1024, ZR, 3072); } \
            if ((GC) >= 0 && (GC) < NCH) { const size_t _row = (size_t)b * SEQ + (size_t)(GC) * SC + tl; (H).gt = *(const v4u*)(GT + _row * 1024 + ch); } } while (0)
#define UNP4(W) ((f32x4){bflo((W).x), bfhi((W).x), bflo((W).y), bfhi((W).y)})
#define EXP4(E) ((f32x4){__builtin_amdgcn_exp2f(-1.44269504f * (E).x), __builtin_amdgcn_exp2f(-1.44269504f * (E).y), __builtin_amdgcn_exp2f(-1.44269504f * (E).z), __builtin_amdgcn_exp2f(-1.44269504f * (E).w)})
#define DOT4(A, B) (((A).x * (B).x + (A).y * (B).y) + ((A).z * (B).z + (A).w * (B).w))
#define SUM16(X) sum16_ns(X)
#ifdef PROBE_SCAN
        unsigned long long ph_act = 0ull;
#endif
        HELP_LOAD(cur, 0, -2);
        for (int it = 0; it < NCH + 2; ++it) {
#ifdef PROBE_SCAN
            const unsigned long long ph0 = __builtin_amdgcn_s_memtime();
#endif
            HELP_LOAD(nxt, it + 1, it - 1);
            if (it >= 2) {
                const LAS float* buf = bufs + (it & 1) * SC_BUF; const LAS float* yb = sY + (it & 1) * SC_VEC;
                const size_t row = (size_t)b * SEQ + (size_t)(it - 2) * SC + tl; const int o = tl * 64 + c8 * 8;
                f32x4 y_[2], v_[2], g_[2];
#pragma unroll
                for (int i = 0; i < 2; ++i) { y_[i] = *(const LAS f32x4*)(yb + o + 4 * i); v_[i] = *(const LAS f32x4*)(buf + SC_VP + o + 4 * i); }
                const float bon = buf[SC_BON + tl * 8 + c8];
                unpk8(cur.gt, g_[0], g_[1]);
                const float s1 = ((y_[0].x + y_[0].y) + (y_[0].z + y_[0].w)) + ((y_[1].x + y_[1].y) + (y_[1].z + y_[1].w));
                const float mu = sum8(s1) * (1.f / 64.f);
                float s2 = 0.f;
#pragma unroll
                for (int i = 0; i < 2; ++i) { y_[i] = y_[i] - mu; const f32x4 q = y_[i] * y_[i]; s2 += (q.x + q.y) + (q.z + q.w); }
                const float rstd = __builtin_amdgcn_rsqf(sum8(s2) * (1.f / 64.f) + 64e-5f);
                f32x4 o_[2];
#pragma unroll
                for (int i = 0; i < 2; ++i) o_[i] = (y_[i] * rstd * *(const f32x4*)(a.in[14] + po + 4 * i) + *(const f32x4*)(a.in[15] + po + 4 * i) + bon * v_[i]) * g_[i];
                *(v4u*)(YA + row * 1024 + ch) = pk8(o_[0], o_[1]);
            }
            if (it < NCH) {
                LAS float* buf = bufs + (it & 1) * SC_BUF;
                const f32x4 pkk_ = *(const f32x4*)(a.in[11] + pop), pka_ = *(const f32x4*)(a.in[12] + pop), prk_ = *(const f32x4*)(a.in[13] + pop);
                const f32x4 zk0 = UNP4(cur.k0), zk1 = UNP4(cur.k1), zk2 = UNP4(cur.k2), zk3 = UNP4(cur.k3);
                f32x4 kn0 = zk0 * pkk_, kn1 = zk1 * pkk_, kn2 = zk2 * pkk_, kn3 = zk3 * pkk_;
                kn0 = kn0 * __builtin_amdgcn_rsqf(fmaxf(SUM16(DOT4(kn0, kn0)), 1e-24f)); kn1 = kn1 * __builtin_amdgcn_rsqf(fmaxf(SUM16(DOT4(kn1, kn1)), 1e-24f));
                kn2 = kn2 * __builtin_amdgcn_rsqf(fmaxf(SUM16(DOT4(kn2, kn2)), 1e-24f)); kn3 = kn3 * __builtin_amdgcn_rsqf(fmaxf(SUM16(DOT4(kn3, kn3)), 1e-24f));
                const f32x4 r0 = UNP4(cur.r0), r1 = UNP4(cur.r1), v0 = UNP4(cur.v0), v1 = UNP4(cur.v1), v2 = UNP4(cur.v2);
                const f32x4 ar0 = UNP4(cur.a0), ar1 = UNP4(cur.a1), ar2 = UNP4(cur.a2);
                const f32x4 e0 = UNP4(cur.e0), e1 = UNP4(cur.e1), e2 = UNP4(cur.e2);
                const f32x4 w0 = EXP4(e0), w1 = EXP4(e1), w2 = EXP4(e2);
                const f32x4 a1v = -kn1, a2v = -kn2, a3v = -kn3;
                const f32x4 b0 = kn0 * ar0, b1 = kn1 * ar1, b2 = kn2 * ar2;
                const f32x4 kp0 = zk0 * (1.f + (ar0 - 1.f) * pka_), kp1 = zk1 * (1.f + (ar1 - 1.f) * pka_), kp2 = zk2 * (1.f + (ar2 - 1.f) * pka_);
                const f32x4 W2 = w0 * w1, Bt = b0 * w1, Kt = kp0 * w1, x0v = a2v, x1v = w2 * a3v;
                const f32x4 X0 = W2 * x0v, X1 = W2 * x1v, X2 = w0 * r0, X3 = W2 * r1;
                *(LAS f32x4*)(buf + SC_WW + pr * 64 + c4 * 4) = W2;
                *(LAS f32x4*)(buf + SC_VP + (2 * pr) * 64 + c4 * 4) = v0; *(LAS f32x4*)(buf + SC_VP + (2 * pr + 1) * 64 + c4 * 4) = v1;
                { LAS f32x4* vq = (LAS f32x4*)(buf + SC_VQ + pr * 256 + c4 * 16);
                  vq[0] = (f32x4){v0.x, v1.x, v2.x, 0.f}; vq[1] = (f32x4){v0.y, v1.y, v2.y, 0.f}; vq[2] = (f32x4){v0.z, v1.z, v2.z, 0.f}; vq[3] = (f32x4){v0.w, v1.w, v2.w, 0.f}; }
                { LAS v2u* bkp = (LAS v2u*)(buf + SC_BK + pr * 128) + (((c4 & 3) * 4) * 4 + (c4 >> 2));
                  bkp[0] = (v2u){cvt_pk_bf16(Bt.x, Kt.x), cvt_pk_bf16(b1.x, kp1.x)}; bkp[4] = (v2u){cvt_pk_bf16(Bt.y, Kt.y), cvt_pk_bf16(b1.y, kp1.y)};
                  bkp[8] = (v2u){cvt_pk_bf16(Bt.z, Kt.z), cvt_pk_bf16(b1.z, kp1.z)}; bkp[12] = (v2u){cvt_pk_bf16(Bt.w, Kt.w), cvt_pk_bf16(b1.w, kp1.w)}; }
                { LAS unsigned char* xp = (LAS unsigned char*)(buf + SC_XA) + pr * 512 + (c4 >> 3) * 64 + (c4 & 3) * 16 + ((c4 >> 2) & 1) * 8;
                  *(LAS v2u*)xp = (v2u){cvt_pk_bf16(X0.x, X0.y), cvt_pk_bf16(X0.z, X0.w)}; *(LAS v2u*)(xp + 128) = (v2u){cvt_pk_bf16(X1.x, X1.y), cvt_pk_bf16(X1.z, X1.w)};
                  *(LAS v2u*)(xp + 256) = (v2u){cvt_pk_bf16(X2.x, X2.y), cvt_pk_bf16(X2.z, X2.w)}; *(LAS v2u*)(xp + 384) = (v2u){cvt_pk_bf16(X3.x, X3.y), cvt_pk_bf16(X3.z, X3.w)}; }
                const f32x4 ca = (f32x4){SUM16(DOT4(Bt, x0v)), SUM16(DOT4(Kt, x0v)), SUM16(DOT4(b1, x0v)), SUM16(DOT4(kp1, x0v))};
                const f32x4 cb = (f32x4){SUM16(DOT4(Bt, x1v)), SUM16(DOT4(Kt, x1v)), SUM16(DOT4(b1, x1v)), SUM16(DOT4(kp1, x1v))};
                const f32x4 cc = (f32x4){SUM16(DOT4(b2, a3v)), SUM16(DOT4(kp2, a3v)), SUM16(DOT4(b0, r0)), SUM16(DOT4(kp0, r0))};
                const f32x4 cd = (f32x4){SUM16(DOT4(Bt, r1)), SUM16(DOT4(Kt, r1)), SUM16(DOT4(b1, r1)), SUM16(DOT4(kp1, r1))};
                const float ci = SUM16(DOT4(kp0, a1v));
                const f32x4 z0 = r0 * kp0 * prk_, z1 = r1 * kp1 * prk_;
                const float bon0 = SUM16((z0.x + z0.y) + (z0.z + z0.w)), bon1 = SUM16((z1.x + z1.y) + (z1.z + z1.w));
                if (c4 == 0) { LAS f32x4* cp = (LAS f32x4*)(buf + SC_C + pr * 20); cp[0] = ca; cp[1] = cb; cp[2] = cc; cp[3] = cd; cp[4] = (f32x4){ci, 0.f, 0.f, 0.f}; }
                buf[SC_BON + (2 * pr) * 8 + (c4 >> 1)] = bon0; buf[SC_BON + (2 * pr + 1) * 8 + (c4 >> 1)] = bon1;
            }
            cur = nxt;
#ifdef PROBE_SCAN
            asm volatile("s_waitcnt vmcnt(0) lgkmcnt(0)" ::: "memory"); ph_act += __builtin_amdgcn_s_memtime() - ph0;
#endif
            __syncthreads();
        }
#ifdef PROBE_SCAN
        if (unit == 0 && layer == DEPTH - 1 && tid == 256) ((float*)(F.ws + WS_CTL))[2048 + 2] = rintf((float)ph_act / (float)(NCH + 2) * (1.f / 2000.f));
#endif
#undef HELP_LOAD
#undef HELP_ROW
#undef UNP4
#undef EXP4
#undef DOT4
#undef SUM16
    }
}

constexpr int TP = 136;
__device__ __forceinline__ void mma_128(const LAS bf16* sA, const LAS bf16* sBt, int wave, int lane, f32x4 (&acc)[4][2]) {
    const int wm = wave >> 2, wn = wave & 3, fr = lane & 15, fq = lane >> 4;
#pragma unroll
    for (int kk = 0; kk < 4; ++kk) {
        bf16x8 af[4], bf_[2];
#pragma unroll
        for (int mt = 0; mt < 4; ++mt) af[mt] = *(const LAS bf16x8*)(sA + (64 * wm + 16 * mt + fr) * TP + 32 * kk + 8 * fq);
#pragma unroll
        for (int nt = 0; nt < 2; ++nt) bf_[nt] = *(const LAS bf16x8*)(sBt + (32 * wn + 16 * nt + fr) * TP + 32 * kk + 8 * fq);
#pragma unroll
        for (int mt = 0; mt < 4; ++mt)
#pragma unroll
            for (int nt = 0; nt < 2; ++nt) acc[mt][nt] = __builtin_amdgcn_mfma_f32_16x16x32_bf16(bf_[nt], af[mt], acc[mt][nt], 0, 0, 0);
    }
}
__device__ __forceinline__ void gmlp_unit(Frame& F, const Args& a, int layer, int unit) {
    phase_ids(F);
    const size_t t0 = (size_t)unit * 128; const int tid = F.tid, lane = F.lane, wave = F.wave;
    LAS float* st = (LAS float*)F.lds; LAS bf16* sA = (LAS bf16*)(F.lds + 1024); LAS bf16* sB = (LAS bf16*)(F.lds + 1024 + 128 * TP * 2);
    bf16* GUV = (bf16*)(F.ws + WS_GUV); const bf16* GMW = (const bf16*)(F.ws + WS_DB + (size_t)(layer & 1) * DB_SET + DB_GMW);
    const float* lng = a.in[19] + (size_t)layer * 1024; const float* lnb = a.in[20] + (size_t)layer * 1024; const float* bsp = a.in[22] + (size_t)layer * 1024;
    for (int r = 0; r < 16; ++r) { const int tok = wave * 16 + r; const bf16* rowp = GUV + (t0 + tok) * 2048 + 1024;
        f32x4 x0, x1, x2, x3; unpk8(*(const v4u*)(rowp + lane * 8), x0, x1); unpk8(*(const v4u*)(rowp + 512 + lane * 8), x2, x3);
        const f32x4 sv = (x0 + x1) + (x2 + x3), qv = (x0 * x0 + x1 * x1) + (x2 * x2 + x3 * x3);
        const float s = wave_sum((sv.x + sv.y) + (sv.z + sv.w)), q = wave_sum((qv.x + qv.y) + (qv.z + qv.w));
        const float mean = s * (1.f / 1024.f), var = fmaxf(q * (1.f / 1024.f) - mean * mean, 0.f);
        if (lane == 0) { st[tok * 2] = mean; st[tok * 2 + 1] = 1.f / sqrtf(var + 1e-5f); } }
    __syncthreads();
    for (int g = 0; g < 8; ++g) {
#pragma unroll
        for (int i = 0; i < 4; ++i) { const int pc = tid + 512 * i, rr = pc >> 4, c16 = pc & 15;
            *(LAS v4u*)(sA + rr * TP + c16 * 8) = *(const v4u*)(GMW + (size_t)g * 16384 + rr * 128 + c16 * 8); }
        { const int p = tid & 127, oc0 = tid >> 7; const float mean = st[p * 2], rstd = st[p * 2 + 1];
#pragma unroll
          for (int i = 0; i < 4; ++i) { const int oc = oc0 + 4 * i, c0 = g * 128 + oc * 8;
              f32x4 x0, x1; unpk8(*(const v4u*)(GUV + (t0 + p) * 2048 + 1024 + c0), x0, x1);
              const f32x4 g0 = *(const f32x4*)(lng + c0), g1 = *(const f32x4*)(lng + c0 + 4), b0 = *(const f32x4*)(lnb + c0), b1 = *(const f32x4*)(lnb + c0 + 4);
              x0 = (x0 - mean) * rstd * g0 + b0; x1 = (x1 - mean) * rstd * g1 + b1;
              const v4u w = pk8(x0, x1);
              LAS bf16* d = sB + (oc * 8) * TP + p;
              d[0 * TP] = (bf16)(w.x & 0xffffu); d[1 * TP] = (bf16)(w.x >> 16); d[2 * TP] = (bf16)(w.y & 0xffffu); d[3 * TP] = (bf16)(w.y >> 16);
              d[4 * TP] = (bf16)(w.z & 0xffffu); d[5 * TP] = (bf16)(w.z >> 16); d[6 * TP] = (bf16)(w.w & 0xffffu); d[7 * TP] = (bf16)(w.w >> 16); } }
        __syncthreads();
        f32x4 acc[4][2];
#pragma unroll
        for (int mt = 0; mt < 4; ++mt)
#pragma unroll
            for (int nt = 0; nt < 2; ++nt) acc[mt][nt] = (f32x4){0.f, 0.f, 0.f, 0.f};
        mma_128(sA, sB, wave, lane, acc);
        { const int wm = wave >> 2, wn = wave & 3, fr = lane & 15, fq = lane >> 4;
#pragma unroll
          for (int mt = 0; mt < 4; ++mt) { const int tt = 64 * wm + 16 * mt + fr; const float bsv = bsp[g * 128 + tt];
#pragma unroll
              for (int nt = 0; nt < 2; ++nt) { const int c = g * 128 + 32 * wn + 16 * nt + 4 * fq;
                  const v2u uw = *(const v2u*)(GUV + (t0 + tt) * 2048 + c);
                  const f32x4 u4 = (f32x4){bflo(uw.x), bfhi(uw.x), bflo(uw.y), bfhi(uw.y)};
                  const f32x4 yb = u4 * (acc[mt][nt] + bsv);
                  v2u ow; ow.x = cvt_pk_bf16(yb.x, yb.y); ow.y = cvt_pk_bf16(yb.z, yb.w);
                  *(v2u*)(GUV + (t0 + tt) * 2048 + c) = ow; } } }
        __syncthreads();
    }
}

__device__ __forceinline__ unsigned fkey(float f) { const unsigned u = __builtin_bit_cast(unsigned, f); return (u & 0x80000000u) ? ~u : (u | 0x80000000u); }
__device__ __forceinline__ float kval(unsigned k, unsigned mask) { const unsigned u = k & mask; return __builtin_bit_cast(float, (u & 0x80000000u) ? (u ^ 0x80000000u) : ~u); }
__device__ __forceinline__ float swap32_add(float a, float b) { const auto r = __builtin_amdgcn_permlane32_swap(__builtin_bit_cast(unsigned, a), __builtin_bit_cast(unsigned, b), false, false);
    return __builtin_bit_cast(float, (unsigned)r[0]) + __builtin_bit_cast(float, (unsigned)r[1]); }
__device__ __forceinline__ float swap16_add(float a, float b) { const auto r = __builtin_amdgcn_permlane16_swap(__builtin_bit_cast(unsigned, a), __builtin_bit_cast(unsigned, b), false, false);
    return __builtin_bit_cast(float, (unsigned)r[0]) + __builtin_bit_cast(float, (unsigned)r[1]); }
__device__ __forceinline__ float row_sum16(float x) {
    x += __builtin_bit_cast(float, __builtin_amdgcn_update_dpp(0, __builtin_bit_cast(int, x), 0x128, 0xf, 0xf, false));
    x += __builtin_bit_cast(float, __builtin_amdgcn_update_dpp(0, __builtin_bit_cast(int, x), 0x124, 0xf, 0xf, false));
    x += __builtin_bit_cast(float, __builtin_amdgcn_update_dpp(0, __builtin_bit_cast(int, x), 0x122, 0xf, 0xf, false));
    x += __builtin_bit_cast(float, __builtin_amdgcn_update_dpp(0, __builtin_bit_cast(int, x), 0x121, 0xf, 0xf, false));
    return x; }
#define CE_DESC(a, b) do { const unsigned _h = max((a), (b)), _l = min((a), (b)); (a) = _h; (b) = _l; } while (0)
template <int OFF> __device__ __forceinline__ void bitonic_merge16(unsigned (&x)[32]) {
#pragma unroll
    for (int j = 8; j >= 1; j >>= 1)
#pragma unroll
        for (int i = 0; i < 16; ++i) { const int l = i ^ j; if (l > i) CE_DESC(x[OFF + i], x[OFF + l]); }
}
template <int OFF> __device__ __forceinline__ void bitonic_sort16(unsigned (&x)[32]) {
#pragma unroll
    for (int k = 2; k <= 16; k <<= 1)
#pragma unroll
        for (int j = k >> 1; j >= 1; j >>= 1)
#pragma unroll
            for (int i = 0; i < 16; ++i) { const int l = i ^ j; if (l > i) { if ((i & k) == 0 || k == 16) CE_DESC(x[OFF + i], x[OFF + l]); else CE_DESC(x[OFF + l], x[OFF + i]); } }
}
#ifndef REP_K
#define REP_K 1
#endif
#define TOP_INSERT(top, x) do { unsigned _x = (x); _Pragma("unroll") for (int _j = 0; _j < 16; ++_j) { const unsigned _h = max((top)[_j], _x); _x = min((top)[_j], _x); (top)[_j] = _h; } } while (0)
__device__ __forceinline__ void peer_token_end(Frame& F, const Args& a, int layer, bool last, bool final_half, size_t tok, int lane, const f32x2 (&out)[8], const f32x4 (&hpre)[4], const v4u (&gpre)[2]) {
    float* hp = F.h + tok * 1024 + 16 * lane;
    f32x4 hv[4], ge[4]; float s = 0.f;
    unpk8(gpre[0], ge[0], ge[1]); unpk8(gpre[1], ge[2], ge[3]);
    if (!final_half) {
        bf16* gp = (bf16*)(F.ws + WS_PW) + tok * 1024 + 16 * lane;
        *(v4u*)gp = pk8(ge[0] + (f32x4){out[0].x, out[0].y, out[1].x, out[1].y}, ge[1] + (f32x4){out[2].x, out[2].y, out[3].x, out[3].y});
        *(v4u*)(gp + 8) = pk8(ge[2] + (f32x4){out[4].x, out[4].y, out[5].x, out[5].y}, ge[3] + (f32x4){out[6].x, out[6].y, out[7].x, out[7].y});
        return; }
#pragma unroll
    for (int i = 0; i < 4; ++i) { hv[i] = hpre[i] + ge[i] + (f32x4){out[2 * i].x, out[2 * i].y, out[2 * i + 1].x, out[2 * i + 1].y};
        s += (hv[i].x * hv[i].x + hv[i].y * hv[i].y) + (hv[i].z * hv[i].z + hv[i].w * hv[i].w); }
    const float rstd = 1.f / sqrtf(wave_sum(s) * (1.f / D) + 1e-6f);
    const float* g = (last ? a.in[4] : a.in[2] + (size_t)(layer + 1) * 1024) + 16 * lane;
    f32x4 o[4];
#pragma unroll
    for (int i = 0; i < 4; ++i) o[i] = hv[i] * rstd * *(const f32x4*)(g + 4 * i);
    if (last) {
#ifdef PROBE_SCAN
        { const float pv = ((const float*)(F.ws + WS_CTL))[2048 + PROBE_SCAN - 1];
#pragma unroll
          for (int i = 0; i < 4; ++i) o[i] = o[i] + pv; }
#endif
#pragma unroll
        for (int i = 0; i < 4; ++i) *(f32x4*)(hp + 4 * i) = o[i];
    } else {
#pragma unroll
        for (int i = 0; i < 4; ++i) *(f32x4*)(hp + 4 * i) = hv[i];
        bf16* NX = (bf16*)(F.ws + WS_NX) + NXROW(tok) * 1024 + 16 * lane; const v4u w0 = pk8(o[0], o[1]), w1 = pk8(o[2], o[3]);
        *(v4u*)NX = w0; *(v4u*)(NX + 8) = w1;
    }
}
__device__ __forceinline__ void peer_unit(Frame& F, const Args& a, int layer, int unit, bool last) {
    phase_ids(F);
    const size_t t0 = (size_t)unit * 128; const int tid = F.tid, lane = F.lane, wave = F.wave, fr = lane & 15, fq = lane >> 4;
    LAS bf16* sKey = (LAS bf16*)F.lds;
    LAS unsigned* sLT = (LAS unsigned*)(F.lds + 2 * 128 * TP * 2) + wave * 512;
    const bf16* Q = (const bf16*)(F.ws + WS_Q); const bf16* KEYS = (const bf16*)(F.ws + WS_DB + (size_t)(layer & 1) * DB_SET + DB_KEYS); v2u* SEL = (v2u*)(F.ws + WS_SEL);
    const size_t trow = t0 + wave * 16 + fr;
    constexpr float KOFF = 32.f;
    v4u ktn[4]; bf16x8 qfn[4];
#define K_FETCH(J) do { _Pragma("unroll") for (int _i = 0; _i < 4; ++_i) { const int _pc = tid + 512 * _i, _rr = _pc >> 4, _c16 = _pc & 15; ktn[_i] = *(const v4u*)(KEYS + (size_t)(J) * 16384 + _rr * 128 + _c16 * 8); } \
        _Pragma("unroll") for (int _kk = 0; _kk < 4; ++_kk) qfn[_kk] = *(const bf16x8*)(Q + trow * 2048 + (J) * 128 + 32 * _kk + 8 * fq); } while (0)
#define K_STORE(J) do { _Pragma("unroll") for (int _i = 0; _i < 4; ++_i) { const int _pc = tid + 512 * _i, _rr = _pc >> 4, _c16 = _pc & 15; *(LAS v4u*)(sKey + ((J) & 1) * 128 * TP + _rr * TP + _c16 * 8) = ktn[_i]; } } while (0)
    for (int krep = 0; krep < REP_K; ++krep) {
    __syncthreads();
    K_FETCH(0); K_STORE(0);
    bf16x8 qf[4];
#pragma unroll
    for (int kk = 0; kk < 4; ++kk) qf[kk] = qfn[kk];
    __syncthreads();
    for (int hd = 0; hd < 8; ++hd) {
        for (int p = 0; p < 2; ++p) {
            const int jp = hd * 2 + p;
            if (jp + 1 < 16) K_FETCH(jp + 1);
            const LAS bf16* sKc = sKey + (jp & 1) * 128 * TP;
            f32x4 sc[8];
#pragma unroll
            for (int nt = 0; nt < 8; ++nt) sc[nt] = (f32x4){KOFF, KOFF, KOFF, KOFF};
#pragma unroll
            for (int kk = 0; kk < 4; ++kk)
#pragma unroll
                for (int nt = 0; nt < 8; ++nt) { const bf16x8 kf = *(const LAS bf16x8*)(sKc + (16 * nt + fr) * TP + 32 * kk + 8 * fq);
                    sc[nt] = __builtin_amdgcn_mfma_f32_16x16x32_bf16(kf, qf[kk], sc[nt], 0, 0, 0); }
            unsigned t[32];
#pragma unroll
            for (int nt = 0; nt < 8; ++nt)
#pragma unroll
                for (int rg = 0; rg < 4; ++rg) t[4 * nt + rg] = (__float_as_uint(sc[nt][rg]) & 0xFFFFFF80u) | (unsigned)(16 * nt + 4 * fq + rg);
            bitonic_sort16<0>(t); bitonic_sort16<16>(t);
#pragma unroll
            for (int j = 0; j < 16; ++j) t[j] = max(t[j], t[31 - j]);
            bitonic_merge16<0>(t);
#pragma unroll
            for (int rnd = 0; rnd < 2; ++rnd) {
#pragma unroll
                for (int j = 0; j < 16; ++j) t[16 + j] = rnd ? xor32_u(t[j], lane) : xor16_u(t[j], lane);
#pragma unroll
                for (int j = 0; j < 16; ++j) t[j] = max(t[j], t[31 - j]);
                bitonic_merge16<0>(t); }
#pragma unroll
            for (int j = 0; j < 16; ++j) sLT[fr * 32 + p * 16 + j] = t[j];
            if (jp + 1 < 16) { K_STORE(jp + 1);
#pragma unroll
                for (int kk = 0; kk < 4; ++kk) qf[kk] = qfn[kk]; }
            __syncthreads();
        }
        float v0[16], v1[16];
#pragma unroll
        for (int j = 0; j < 16; ++j) { v0[j] = __uint_as_float(sLT[fr * 32 + j] & 0xFFFFFF80u); v1[j] = __uint_as_float(sLT[fr * 32 + 16 + j] & 0xFFFFFF80u); }
        unsigned best[32];
#define CKEY(i, j) ((__float_as_uint(v0[i] + v1[j]) & 0xFFFFFF00u) | (unsigned)((i) * 16 + (j)))
#pragma unroll
        for (int j = 0; j < 16; ++j) best[j] = CKEY(0, j);
#pragma unroll
        for (int i = 1; i < 16; ++i) best[16 - i] = max(best[16 - i], CKEY(i, 0));
        bitonic_merge16<0>(best);
#pragma unroll
        for (int j = 1; j < 8; ++j) best[16 - j] = max(best[16 - j], CKEY(1, j));
        bitonic_merge16<0>(best);
#pragma unroll
        for (int i = 2; i < 8; ++i) best[17 - i] = max(best[17 - i], CKEY(i, 1));
        bitonic_merge16<0>(best);
        { unsigned r6[6] = {CKEY(2, 2), CKEY(2, 3), CKEY(2, 4), CKEY(3, 2), CKEY(3, 3), CKEY(4, 2)};
          CE_DESC(r6[0], r6[5]); CE_DESC(r6[1], r6[3]); CE_DESC(r6[2], r6[4]); CE_DESC(r6[1], r6[2]); CE_DESC(r6[3], r6[4]); CE_DESC(r6[0], r6[3]);
          CE_DESC(r6[2], r6[5]); CE_DESC(r6[0], r6[1]); CE_DESC(r6[2], r6[3]); CE_DESC(r6[4], r6[5]); CE_DESC(r6[1], r6[2]); CE_DESC(r6[3], r6[4]);
#pragma unroll
          for (int k = 0; k < 6; ++k) best[15 - k] = max(best[15 - k], r6[k]); }
        bitonic_merge16<0>(best);
#undef CKEY
        float ev[16], esum = 0.f; const float mx = __uint_as_float(best[0] & 0xFFFFFF00u);
#pragma unroll
        for (int k = 0; k < 16; ++k) { ev[k] = __builtin_amdgcn_exp2f((__uint_as_float(best[k] & 0xFFFFFF00u) - mx) * 1.44269504f); esum += ev[k]; }
        const float einv = 1.f / esum;
#pragma unroll
        for (int k = 0; k < 16; ++k) { const unsigned pos = best[k] & 255u;
            const unsigned i0 = sLT[fr * 32 + (pos >> 4)] & 127u, i1 = sLT[fr * 32 + 16 + (pos & 15u)] & 127u;
            if ((k >> 2) == fq) SEL[trow * 128 + hd * 16 + k] = (v2u){i0 * 128u + i1, __builtin_bit_cast(unsigned, ev[k] * einv)}; }
    }
    }
#undef K_FETCH
#undef K_STORE
    asm volatile("s_waitcnt vmcnt(0)" ::: "memory");
    __syncthreads();
    const bf16* N2 = (const bf16*)(F.ws + WS_N2); const unsigned char* U8 = (const unsigned char*)(F.ws + WS_DB + (size_t)(layer & 1) * DB_SET + DB_U); const unsigned char* V8 = (const unsigned char*)(F.ws + WS_DB + (size_t)(layer & 1) * DB_SET + DB_V);
    unsigned* SELW = (unsigned*)SEL;
    LAS unsigned* sIdx = (LAS unsigned*)(F.lds + 90112) + wave * 1024;
    LAS float* sCoef = (LAS float*)F.lds + wave * 2048;
    LAS unsigned* sSort = sLT;
    const size_t tokb = t0 + wave * 16;
    unsigned cnts = 0u;
    v4u se_pf = *(const v4u*)(SELW + tokb * 256 + 4 * lane);
    for (int it = 0; it < 16; ++it) {
        const v4u se = se_pf;
        if (it < 15) se_pf = *(const v4u*)(SELW + (tokb + it + 1) * 256 + 4 * lane);
        const unsigned b0 = se.x >> 12, b1 = se.z >> 12;
        unsigned pos0 = 0u, pos1 = 0u, base = 0u, pk = 0u;
#pragma unroll
        for (unsigned k = 0; k < 4; ++k) {
            const unsigned long long m0 = __builtin_amdgcn_ballot_w64(b0 == k), m1 = __builtin_amdgcn_ballot_w64(b1 == k);
            const unsigned below = __builtin_amdgcn_mbcnt_hi((unsigned)(m0 >> 32), __builtin_amdgcn_mbcnt_lo((unsigned)m0, 0u)) + __builtin_amdgcn_mbcnt_hi((unsigned)(m1 >> 32), __builtin_amdgcn_mbcnt_lo((unsigned)m1, 0u));
            if (b0 == k) pos0 = base + below;
            if (b1 == k) pos1 = base + below + (b0 == k ? 1u : 0u);
            base += (unsigned)__builtin_popcountll(m0) + (unsigned)__builtin_popcountll(m1);
            if (k < 3) pk |= base << (8 * k);
        }
#ifdef DBG_NOSORT
        pos0 = 2 * lane; pos1 = 2 * lane + 1;
#endif
        *(LAS v2u*)(sSort + 2 * pos0) = (v2u){se.x, se.y}; *(LAS v2u*)(sSort + 2 * pos1) = (v2u){se.z, se.w};
        asm volatile("" ::: "memory");
        const v2u so0 = *(const LAS v2u*)(sSort + 4 * lane), so1 = *(const LAS v2u*)(sSort + 4 * lane + 2); const v4u so = (v4u){so0.x, so0.y, so1.x, so1.y};
        asm volatile("" ::: "memory");
        sIdx[it * 64 + lane] = (so0.x & 0xffffu) | (so1.x << 16);
        (void)so;
        { const unsigned g0 = so0.y, g1 = so1.y; sCoef[it * 128 + 2 * lane] = __uint_as_float(g0); sCoef[it * 128 + 2 * lane + 1] = __uint_as_float(g1); }
        if (lane == it) cnts = pk;
    }
    asm volatile("s_waitcnt vmcnt(0) lgkmcnt(0)" ::: "memory");
#ifdef DBG_NOBUCKET
    cnts = 0u;
#endif
#define PL_LOAD(RB, TAB, SE, BB) do { _Pragma("unroll") for (int _q = 0; _q < 16; ++_q) { \
        const unsigned _pw = (unsigned)__builtin_amdgcn_readlane((int)(SE), (BB) * 8 + (_q >> 1)); const unsigned _idx = (_q & 1) ? (_pw >> 16) : (_pw & 0xffffu); \
        (RB)[_q] = *(const v4u*)((TAB) + (size_t)_idx * 1024 + 16 * lane); } } while (0)
#define PL_LOAD_U(RB, SE, BB) do { const int _src = ((BB) * 8 + ((lane & 15) >> 1)) * 4; \
        const unsigned _ix = (unsigned)__builtin_amdgcn_ds_bpermute(_src, (int)(SE).x), _iz = (unsigned)__builtin_amdgcn_ds_bpermute(_src, (int)(SE).z); \
        const unsigned char* _p = U8 + (size_t)((lane & 1) ? _iz : _ix) * 1024 + 32 * (lane >> 4); \
        _Pragma("unroll") for (int _j = 0; _j < 16; ++_j) (RB)[_j] = *(const v4u*)(_p + 128 * (_j >> 1) + 16 * (_j & 1)); } while (0)
#define PL_RANGE(T, P, NP, RLO, RHI, BLO, BHI) const unsigned _pk##T = (unsigned)__builtin_amdgcn_readlane((int)cnts, (T)); \
        const int _sp##T = min((int)((((_pk##T >> 8) & 255u) + 15u) & ~15u), 128);     \
        const int RLO = (P) == 0 ? 0 : _sp##T, RHI = (P) == 0 ? _sp##T : 128; \
        const int BLO = min(RLO >> 4, 7), BHI = max((RHI + 15) >> 4, BLO + 1)
    v4u ra[16], rb[16];
#ifndef DBG_U0
#define DBG_U0 0
#define DBG_V0 0
#endif
    for (int ps = DBG_U0; ps < 2; ++ps) {
        int lt = 0, lb, lbh; { PL_RANGE(lt, ps, 2, r0, r1, b0_, b1_); lb = b0_; lbh = b1_; (void)r0; (void)r1; }
        unsigned seL = sIdx[lane];
        long xlo = 0, xhi = 0; const bool dsel = ((lane >> 2) & 3) == (lane >> 4); v4u nraw0, nraw1, nnx0 = *(const v4u*)(N2 + tokb * 1024 + 16 * lane), nnx1 = *(const v4u*)(N2 + tokb * 1024 + 16 * lane + 8);
        int ct, cb, crl = 0, crh = 0, cbl = 0;
#define U_ADV() do { ++lb; if (lb >= lbh) { ++lt; if (lt < 16) { PL_RANGE(lt, ps, 2, _r0, _r1, _b0, _b1); lb = _b0; lbh = _b1; (void)_r0; (void)_r1; seL = sIdx[lt * 64 + lane]; } } } while (0)
#define U_COMPUTE(RB) do { \
            if (cb == cbl) { nraw0 = nnx0; nraw1 = nnx1; if (ct + 1 < 16) { nnx0 = *(const v4u*)(N2 + (tokb + ct + 1) * 1024 + 16 * lane); nnx1 = *(const v4u*)(N2 + (tokb + ct + 1) * 1024 + 16 * lane + 8); } \
                f32x4 x0, x1, x2, x3; unpk8(nraw0, x0, x1); unpk8(nraw1, x2, x3); x0 = x0 * 16.f; x1 = x1 * 16.f; x2 = x2 * 16.f; x3 = x3 * 16.f; \
                int _w0 = 0, _w1 = 0, _w2 = 0, _w3 = 0; \
                _w0 = __builtin_amdgcn_cvt_pk_fp8_f32(x0.x, x0.y, _w0, false); _w0 = __builtin_amdgcn_cvt_pk_fp8_f32(x0.z, x0.w, _w0, true); \
                _w1 = __builtin_amdgcn_cvt_pk_fp8_f32(x1.x, x1.y, _w1, false); _w1 = __builtin_amdgcn_cvt_pk_fp8_f32(x1.z, x1.w, _w1, true); \
                _w2 = __builtin_amdgcn_cvt_pk_fp8_f32(x2.x, x2.y, _w2, false); _w2 = __builtin_amdgcn_cvt_pk_fp8_f32(x2.z, x2.w, _w2, true); \
                _w3 = __builtin_amdgcn_cvt_pk_fp8_f32(x3.x, x3.y, _w3, false); _w3 = __builtin_amdgcn_cvt_pk_fp8_f32(x3.z, x3.w, _w3, true); \
                xlo = (long)(((unsigned long long)(unsigned)_w1 << 32) | (unsigned)_w0); xhi = (long)(((unsigned long long)(unsigned)_w3 << 32) | (unsigned)_w2); } \
            _Pragma("unroll") for (int _g = 0; _g < 2; ++_g) { float _p[8]; \
                _Pragma("unroll") for (int _q = 0; _q < 8; ++_q) { f32x4 _d = (f32x4){0.f, 0.f, 0.f, 0.f}; \
                    _d = __builtin_amdgcn_mfma_f32_16x16x32_fp8_fp8((long)(((unsigned long long)(RB)[8 * _g + _q].y << 32) | (RB)[8 * _g + _q].x), xlo, _d, 0, 0, 0); \
                    _d = __builtin_amdgcn_mfma_f32_16x16x32_fp8_fp8((long)(((unsigned long long)(RB)[8 * _g + _q].w << 32) | (RB)[8 * _g + _q].z), xhi, _d, 0, 0, 0); \
                    const float _sl = (lane & 2) ? ((lane & 1) ? _d.w : _d.z) : ((lane & 1) ? _d.y : _d.x); \
                    _p[_q] = dsel ? _sl : 0.f; }     \
                const float _s0 = swap32_add(_p[0], _p[4]), _s1 = swap32_add(_p[1], _p[5]), _s2 = swap32_add(_p[2], _p[6]), _s3 = swap32_add(_p[3], _p[7]); \
                float _t0 = row_sum16(swap16_add(_s0, _s2)), _t1 = row_sum16(swap16_add(_s1, _s3)); \
                _t0 = fgelu(_t0 * (1.f / 4096.f)) * (1.f / 64.f); _t1 = fgelu(_t1 * (1.f / 4096.f)) * (1.f / 64.f); \
                if ((lane & 15) == 0) { const int _r = lane >> 4, _e = cb * 16 + 8 * _g + 2 * (_r & 1) + 4 * (_r >> 1); LAS float* _c = sCoef + ct * 128 + _e; \
                    if (_e >= crl && _e < crh) _c[0] *= _t0; if (_e + 1 >= crl && _e + 1 < crh) _c[1] *= _t1; } } } while (0)
#define U_SETC() do { ct = lt; cb = lb; { PL_RANGE(ct, ps, 2, _r0, _r1, _b0, _b1); crl = _r0; crh = _r1; cbl = _b0; (void)_b1; } } while (0)
        PL_LOAD(ra, U8, seL, lb);
        U_SETC(); U_ADV();
        for (;;) {
            if (lt < 16) PL_LOAD(rb, U8, seL, lb);
            U_COMPUTE(ra);
            if (lt >= 16) break;
            U_SETC(); U_ADV();
            if (lt < 16) PL_LOAD(ra, U8, seL, lb);
            U_COMPUTE(rb);
            if (lt >= 16) break;
            U_SETC(); U_ADV();
        }
        asm volatile("s_waitcnt lgkmcnt(0)" ::: "memory");
        __syncthreads();
    }
#undef U_ADV
#undef U_COMPUTE
#undef U_SETC
    for (int ps = DBG_V0; ps < 2; ++ps) {
        int lt = 0, lb, lbh; { PL_RANGE(lt, ps, 2, r0, r1, b0_, b1_); lb = b0_; lbh = b1_; (void)r0; (void)r1; }
        unsigned seL = sIdx[lane];
        f32x2 out[8]; f32x4 hpre[4] = {(f32x4){0.f, 0.f, 0.f, 0.f}, (f32x4){0.f, 0.f, 0.f, 0.f}, (f32x4){0.f, 0.f, 0.f, 0.f}, (f32x4){0.f, 0.f, 0.f, 0.f}}, ac4[4]; v4u gpre[2] = {(v4u){0u, 0u, 0u, 0u}, (v4u){0u, 0u, 0u, 0u}}; const bf16* PWG = (const bf16*)(F.ws + WS_PW);
        const unsigned vmask = ((lane >> 4) == ((lane & 15) >> 2)) ? (0xFFu << (8 * (lane & 3))) : 0u;
        int ct, cb, crl = 0, crh = 0, cbl = 0, cbh = 0;
#define V_ADV() do { ++lb; if (lb >= lbh) { ++lt; if (lt < 16) { PL_RANGE(lt, ps, 2, _r0, _r1, _b0, _b1); lb = _b0; lbh = _b1; (void)_r0; (void)_r1; seL = sIdx[lt * 64 + lane]; } } } while (0)
#define V_SETC() do { ct = lt; cb = lb; { PL_RANGE(ct, ps, 2, _r0, _r1, _b0, _b1); crl = _r0; crh = _r1; cbl = _b0; cbh = _b1; } } while (0)
#ifndef REP_LV
#define REP_LV 1
#endif
#define V_COMPUTE(RB) do { \
            if (cb == cbl) { _Pragma("unroll") for (int _i = 0; _i < 4; ++_i) { ac4[_i] = (f32x4){0.f, 0.f, 0.f, 0.f}; if (ps == 1) hpre[_i] = *(const f32x4*)(F.h + (tokb + ct) * 1024 + 16 * lane + 4 * _i); } \
                gpre[0] = *(const v4u*)(PWG + (tokb + ct) * 1024 + 16 * lane); gpre[1] = *(const v4u*)(PWG + (tokb + ct) * 1024 + 16 * lane + 8); }     \
            _Pragma("unroll") for (int _q = 0; _q < 16; ++_q) { const int _e = cb * 16 + _q; \
                float _c = sCoef[ct * 128 + _e]; _c = (_e >= crl && _e < crh) ? _c * 2048.f : 0.f; \
                int _w = __builtin_amdgcn_cvt_pk_fp8_f32(_c, _c, 0, false); _w = __builtin_amdgcn_cvt_pk_fp8_f32(_c, _c, _w, true); const unsigned _x = (unsigned)_w & vmask; \
                const long _ae = (long)(unsigned long long)_x, _ao = (long)((unsigned long long)_x << 32); \
                const long _bl = (long)(((unsigned long long)(RB)[_q].y << 32) | (RB)[_q].x), _bh = (long)(((unsigned long long)(RB)[_q].w << 32) | (RB)[_q].z); \
                ac4[0] = __builtin_amdgcn_mfma_f32_16x16x32_fp8_fp8(_ae, _bl, ac4[0], 0, 0, 0); ac4[1] = __builtin_amdgcn_mfma_f32_16x16x32_fp8_fp8(_ao, _bl, ac4[1], 0, 0, 0); \
                ac4[2] = __builtin_amdgcn_mfma_f32_16x16x32_fp8_fp8(_ae, _bh, ac4[2], 0, 0, 0); ac4[3] = __builtin_amdgcn_mfma_f32_16x16x32_fp8_fp8(_ao, _bh, ac4[3], 0, 0, 0); } \
            if (cb == cbh - 1) { _Pragma("unroll") for (int _i = 0; _i < 4; ++_i) { out[2 * _i] = (f32x2){ac4[_i].x, ac4[_i].y} * (1.f / 2048.f); out[2 * _i + 1] = (f32x2){ac4[_i].z, ac4[_i].w} * (1.f / 2048.f); } \
                peer_token_end(F, a, layer, last, ps == 1, tokb + ct, lane, out, hpre, gpre); } } while (0)
        PL_LOAD(ra, V8, seL, lb);
        V_SETC(); V_ADV();
        for (;;) {
            if (lt < 16) PL_LOAD(rb, V8, seL, lb);
            V_COMPUTE(ra);
            if (lt >= 16) break;
            V_SETC(); V_ADV();
            if (lt < 16) PL_LOAD(ra, V8, seL, lb);
            V_COMPUTE(rb);
            if (lt >= 16) break;
            V_SETC(); V_ADV();
        }
        asm volatile("s_waitcnt vmcnt(0)" ::: "memory");
        __syncthreads();
    }
#undef V_ADV
#undef V_SETC
#undef V_COMPUTE
#undef PL_LOAD
#undef PL_RANGE
}


#ifndef ZSKIP
#define ZSKIP 0
#endif
#ifndef ZGA_ALIGN
#define ZGA_ALIGN true
#endif
#ifndef ZGA_SP2
#define ZGA_SP2 true
#endif
#ifndef WIN_ALIGN
#define WIN_ALIGN true
#endif
#ifndef WIN_SP2
#define WIN_SP2 true
#endif
#ifndef REP_E
#define REP_E 1
#endif
#ifndef REP_A
#define REP_A 1
#endif
#ifndef REP_B
#define REP_B 1
#endif
#ifndef REP_C
#define REP_C 1
#endif
#ifndef REP_D
#define REP_D 1
#endif
#ifndef REP_G
#define REP_G 1
#endif
#ifndef REP_I
#define REP_I 1
#endif
#ifndef REP_K
#define REP_K 1
#endif
__global__ void __launch_bounds__(NWAVES * 64, 2) trunk_fwd(Args args) {
    extern __shared__ __attribute__((aligned(16))) unsigned char lds[];
    Frame F;
    F.lds = (LAS unsigned char*)lds;
    F.tid = threadIdx.x; F.lane = F.tid & 63; F.wave = __builtin_amdgcn_readfirstlane(F.tid >> 6); F.wave0 = F.wave;
    F.G = gridDim.x; F.bx = blockIdx.x; F.ws = (GAS unsigned char*)args.ws; F.h = args.out;
    volatile LAS unsigned* MISC = (volatile LAS unsigned*)(F.lds + MISC_OFF);
    for (int u = F.tid; u < (LDS_BYTES - LDSCTL_OFF) / 4; u += NWAVES * 64) ((LAS unsigned*)(F.lds + LDSCTL_OFF))[u] = 0u;
    __syncthreads();
    unsigned* ctl = (unsigned*)(F.ws + WS_CTL);
    XcdBarrier bar = xcd_barrier_post(ctl + CW_BAR, MISC + 8);
    GAS unsigned char* ws = F.ws;
    LAS unsigned char* ring = (LAS unsigned char*)F.lds;

    for (int rep = 0; rep < REP_A; ++rep) { prep_phase(F, args, 0, F.bx, F.G, 1);
    xcd_barrier(bar, F.wave0); }
#define OPQ() GAS unsigned char* ws = F.ws; asm volatile("" : "+s"(ws)); GAS unsigned char* db = ws + WS_DB + (size_t)(layer & 1) * DB_SET; (void)db
    for (int layer = 0; layer < DEPTH; ++layer) {
        {   OPQ();
        for (int rep = 0; rep < REP_B; ++rep) {   if (rep) xcd_barrier(bar, F.wave0); pg8::Gemm g{(const bf16*)(ws + WS_NX), (const bf16*)(ws + WS_WIN), T, NZ - 256 * ZSPLIT, 2048, 1024, 16}; pg8::StaticOrder S; S.init(T, NZ - 256 * ZSPLIT, F.G, F.bx);
            pg8::EpiZ E{(bf16*)(ws + WS_ZRKV), (bf16*)(ws + WS_ZL), (bf16*)(ws + WS_GUV), (bf16*)(ws + WS_SG), layer == 0 ? (bf16*)(ws + WS_VF) : (bf16*)nullptr, 0};
            pg8::gemm_phase<pg8::EpiZ, pg8::StaticOrder, WIN_ALIGN, WIN_SP2>(ring, g, S, E, F.wave0); }
        }
        xcd_barrier(bar, F.wave0);
        {   OPQ();
        for (int rep = 0; rep < REP_C; ++rep) {   if (rep) xcd_barrier(bar, F.wave0); { pg8::Gemm g{(const bf16*)(ws + WS_ZL), (const bf16*)(ws + WS_LORA + (size_t)layer * LORA_BYTES), T, 2048, 128, 512}; pg8::StaticOrder S; S.init(T, 2048, F.G, F.bx);
            pg8::EpiLora E{(bf16*)(ws + WS_EW), (size_t)(WS_AR - WS_EW) / 2, args.in[6] + (size_t)layer * 1024, args.in[8] + (size_t)layer * 1024, 0};
            pg8::gemm_phase<pg8::EpiLora, pg8::StaticOrder, true, true>(ring, g, S, E, F.wave0); }
            { pg8::Gemm g{(const bf16*)(ws + WS_ZL) + 128, (const bf16*)(ws + WS_LORA + (size_t)layer * LORA_BYTES) + 2048 * 128, T, 1024, 128, 512}; pg8::StaticOrder S; S.init(T, 1024, F.G, F.bx);
            pg8::EpiLora E{(bf16*)(ws + WS_EW), (size_t)(WS_AR - WS_EW) / 2, args.in[6] + (size_t)layer * 1024, args.in[8] + (size_t)layer * 1024, 8};
            pg8::gemm_phase<pg8::EpiLora, pg8::StaticOrder, true, true>(ring, g, S, E, F.wave0); } }
        if (layer > 0) {
            pg8::Gemm g{(const bf16*)(ws + WS_ZL) + 256, (const bf16*)(ws + WS_MV + (size_t)(layer - 1) * MV_BYTES), T, 1024, 128, 512}; pg8::StaticOrder S; S.init(T, 1024, F.G, F.bx);
            pg8::EpiMv E{(bf16*)(ws + WS_ZRKV), (const bf16*)(ws + WS_VF), args.in[18] + (size_t)(layer - 1) * 1024};
            pg8::gemm_phase<pg8::EpiMv, pg8::StaticOrder, true, true>(ring, g, S, E, F.wave0); }
        }
        xcd_barrier(bar, F.wave0);
        {   OPQ();
        for (int rep = 0; rep < REP_D; ++rep) {   if (rep) xcd_barrier(bar, F.wave0); const int nsb = F.G / 2, nob = F.G - nsb;
            if (F.bx < nsb) { for (int u = F.bx; u < NB * 16; u += nsb) scan_unit(F, args, layer, u); }
            else { const int ob = F.bx - nsb;
                for (int pm = ob; pm < T / 256; pm += nob)
                    for (int rep2 = 0; rep2 < REP_E; ++rep2) { gmlp_unit(F, args, layer, 2 * pm); gmlp_unit(F, args, layer, 2 * pm + 1); }
                asm volatile("s_waitcnt vmcnt(0)" ::: "memory"); __syncthreads();
                {
                    pg8::Gemm g{(const bf16*)(ws + WS_GUV), (const bf16*)(db + DB_PBT), T, 1024, 1024, 2048}; pg8::PanelOrder S{ob, nob, T / 256, 4, 0};
                    pg8::EpiMerge<false> E{(const bf16*)(ws + WS_SG), (bf16*)(ws + WS_GUV) + 1024, (bf16*)nullptr};
                    pg8::gemm_phase<pg8::EpiMerge<false>, pg8::PanelOrder, true, true>(ring, g, S, E, F.wave0); }
                {
                    pg8::Gemm g{(const bf16*)(ws + WS_NX), (const bf16*)(ws + WS_WINB + (size_t)(layer & 1) * WINB_BYTES), T, 256 * ZSPLIT, 2048, 1024, 16}; pg8::StaticOrder S; S.init(T, 256 * ZSPLIT, nob, ob);
                    pg8::EpiZ E{(bf16*)(ws + WS_ZRKV), (bf16*)(ws + WS_ZL), (bf16*)(ws + WS_GUV), (bf16*)(ws + WS_SG), (bf16*)nullptr, 30 - ZSPLIT};
                    pg8::gemm_phase<pg8::EpiZ, pg8::StaticOrder, true, true>(ring, g, S, E, F.wave0); }
                {   pg8::Gemm g{(const bf16*)(db + DB_PB), (const bf16*)(db + DB_PLEW), T, 1024, 256, 256}; pg8::StaticOrder S; S.init(T, 1024, nob, ob);
                    pg8::EpiPlain E{(bf16*)(ws + WS_PW), 1024};
                    pg8::gemm_phase<pg8::EpiPlain, pg8::StaticOrder, true, true>(ring, g, S, E, F.wave0); }
                if (layer == 0) prep_phase(F, args, 0, ob, nob, 2);
                if (layer + 1 < DEPTH) prep_phase(F, args, layer + 1, ob, nob, 3); } }
        }
        xcd_barrier(bar, F.wave0);
        {   OPQ();
        for (int rep = 0; rep < REP_G; ++rep) {   if (rep) xcd_barrier(bar, F.wave0); pg8::Gemm g{(const bf16*)(ws + WS_G), (const bf16*)(db + DB_PA), T, 1024, 1024, 1024}; pg8::StaticOrder S; S.init(T, 1024, F.G, F.bx);
            pg8::EpiMerge<true> E{(const bf16*)(ws + WS_SG), (bf16*)(ws + WS_GUV) + 1024, (bf16*)(ws + WS_MG)};
            pg8::gemm_phase<pg8::EpiMerge<true>, pg8::StaticOrder, true, true>(ring, g, S, E, F.wave0); }
        }
        xcd_barrier(bar, F.wave0);
        {   OPQ();
        {   pg8::Gemm g{(const bf16*)(ws + WS_MG), (const bf16*)(db + DB_POUT), T, 1024, 1024, 1024}; pg8::StaticOrder S; S.init(T, 1024, F.G, F.bx);
            pg8::EpiResid E{F.h};
            pg8::gemm_phase<pg8::EpiResid, pg8::StaticOrder, true, true>(ring, g, S, E, F.wave0); }
        }
        xcd_barrier(bar, F.wave0);
        {   OPQ();
        for (int rep = 0; rep < REP_I; ++rep) {   if (rep) xcd_barrier(bar, F.wave0); phase_ids(F); const int gw = F.bx * NWAVES + F.wave, NGW = F.G * NWAVES; const float* g2 = args.in[3] + (size_t)layer * 1024;
            for (int m = gw; m < T / 2; m += NGW) norm_row_n2x2(F.h + (size_t)m * D, F.h + (size_t)(m + T / 2) * D, g2, (bf16*)(ws + WS_N2) + (size_t)m * D, (bf16*)(ws + WS_N2) + (size_t)(m + T / 2) * D, F.lane); }
        }
        xcd_barrier(bar, F.wave0);
        {   OPQ();
        {   pg8::Gemm g{(const bf16*)(ws + WS_N2), (const bf16*)(db + DB_WQG), T, 3072, 1024, 1024}; pg8::StaticOrder S; S.init(T, 3072, F.G, F.bx);
            pg8::EpiQG E{(bf16*)(ws + WS_Q), (bf16*)(ws + WS_PW), F.h};
            pg8::gemm_phase<pg8::EpiQG, pg8::StaticOrder, true, true>(ring, g, S, E, F.wave0); }
        }
        xcd_barrier(bar, F.wave0);
        {   OPQ();
        for (int u = F.bx; u < T / 128; u += F.G) peer_unit(F, args, layer, u, layer == DEPTH - 1);
        }
        if (layer + 1 < DEPTH) xcd_barrier(bar, F.wave0);
    }
}

extern "C" void kernel_launch(void* const* d_in, const int* in_sizes, int n_in, void* d_out, int out_size, void* d_ws, size_t ws_size, hipStream_t stream) {
    static int grid = 0;
    if (grid == 0) {
        if (n_in != 32 || out_size != T * D || ws_size < WS_END) { fprintf(stderr, "kernel_launch: unexpected sizes n_in %d out %d ws %zu (need %zu); nothing launched\n", n_in, out_size, ws_size, (size_t)WS_END); grid = -1; return; }
        int dev = 0, cus = 0, per_cu = 0;
        if (hipGetDevice(&dev) != hipSuccess || hipDeviceGetAttribute(&cus, hipDeviceAttributeMultiprocessorCount, dev) != hipSuccess) { grid = -1; return; }
        if (hipFuncSetAttribute((const void*)trunk_fwd, hipFuncAttributeMaxDynamicSharedMemorySize, LDS_BYTES) != hipSuccess) { fprintf(stderr, "kernel_launch: hipFuncSetAttribute failed\n"); grid = -1; return; }
        if (hipOccupancyMaxActiveBlocksPerMultiprocessor(&per_cu, (const void*)trunk_fwd, NWAVES * 64, LDS_BYTES) != hipSuccess || per_cu < 1)
            fprintf(stderr, "kernel_launch: note: occupancy query reports %d workgroups per CU\n", per_cu);
        (void)hipGetLastError();
        grid = cus;
    }
    if (grid < 0) return;
    (void)hipMemsetAsync((char*)d_ws + WS_CTL, 0, ZERO_BYTES, stream);
    (void)hipMemsetAsync((char*)d_ws + WIN_ZERO_OFF, 0, WIN_ZERO_BYTES, stream);
    Args a{};
    for (int i = 0; i < 32; ++i) a.in[i] = (const float*)d_in[i];
    a.out = (float*)d_out; a.ws = (unsigned char*)d_ws;
    hipLaunchKernelGGL(trunk_fwd, dim3(grid), dim3(NWAVES * 64), LDS_BYTES, stream, a);
    const hipError_t le = hipPeekAtLastError();
    if (le != hipSuccess) fprintf(stderr, "kernel_launch: launch failed: %s\n", hipGetErrorName(le));
}
```

```cpp
#include <hip/hip_runtime.h>
#include <cstdio>
#include <cstdint>
#define ZSPLIT 4
#define UPASS 4
#define VPASS 4
namespace pg8 {
#define PG8_LAS __attribute__((address_space(3)))
typedef unsigned short bf16_t;
typedef short bf16x8 __attribute__((ext_vector_type(8)));
typedef float f32x4 __attribute__((ext_vector_type(4)));
typedef unsigned u32x4 __attribute__((ext_vector_type(4)));
constexpr int BM = 256, BK = 64, HALF = 128, HTB = HALF * BK * 2  , STAGE_BYTES = 8 * HTB, NXCD = 8, WGM = 8;

__host__ __device__ __forceinline__ int lds_byte(int r, int c) { const int st = (r >> 4) * 2 + (c >> 5), rr = r & 15, cc = c & 31, ob = rr * 64 + cc * 2; return st * 1024 + (ob ^ (((ob >> 9) & 1) << 5)); }
__host__ __device__ __forceinline__ void stage_rc(int b, int& R, int& C) { const int st = b / 1024, sb = b % 1024, swz = sb ^ (((sb >> 9) & 1) << 5); R = (st >> 1) * 16 + swz / 64; C = (st & 1) * 32 + (swz % 64) / 2; }
__host__ __device__ __forceinline__ int perm32(int rho) { const int n = rho >> 4, i = rho & 15; return 8 * (i >> 2) + 4 * n + (i & 3); }

struct Unit { int pm, pn; };
struct Gemm { const bf16_t* A; const bf16_t* Bt; int M, N, K, lda; int abatch; };

struct StaticOrder {
    int nM, nN, nwg, G, c;
    __host__ __device__ void init(int M, int N, int G_, int c_) { nM = M / BM; nN = N / BM; nwg = nM * nN; G = G_; c = c_; }
    __host__ __device__ bool next(int i, Unit& u) const {
        const long L = (long)i * G + c; if (L >= nwg) return false;
        int wgid = (int)L; { const int q = nwg / NXCD, r = nwg % NXCD, xcd = wgid % NXCD, off = wgid / NXCD; wgid = (xcd < r ? xcd * (q + 1) : r * (q + 1) + (xcd - r) * q) + off; }
        const int nig = WGM * nN, gid = wgid / nig, fm = gid * WGM, gsz = (nM - fm) < WGM ? (nM - fm) : WGM;
        u.pm = fm + ((wgid % nig) % gsz); u.pn = (wgid % nig) / gsz; return true;
    }
    __device__ __forceinline__ void a_ready(const Unit&) const {}
    __device__ __forceinline__ void done(const Unit&) const {}
};
struct PanelOrder {
    int first, stride, nM, nN, pn0;
    __host__ __device__ bool next(int i, Unit& u) const { const int p = first + (i / nN) * stride; if (p >= nM) return false; u.pm = p; u.pn = pn0 + i % nN; return true; }
    __device__ __forceinline__ void a_ready(const Unit&) const {}
    __device__ __forceinline__ void done(const Unit&) const {}
};
__device__ __forceinline__ unsigned cvt_pk_bf16(float lo, float hi) { unsigned r; asm volatile("v_cvt_pk_bf16_f32 %0, %1, %2" : "=v"(r) : "v"(lo), "v"(hi)); return r; }

__device__ __forceinline__ float fsig(float x) { return __builtin_amdgcn_rcpf(1.f + __builtin_amdgcn_exp2f(-1.44269504f * x)); }
__device__ __forceinline__ float fgelu(float x) { return x * fsig(1.5957691216f * (x + 0.044715f * x * x * x)); }
__device__ __forceinline__ float bflo(unsigned w) { return __builtin_bit_cast(float, w << 16); }
__device__ __forceinline__ float bfhi(unsigned w) { return __builtin_bit_cast(float, w & 0xffff0000u); }
__device__ __forceinline__ void unpk8(const u32x4 w, f32x4& a, f32x4& b) { a = (f32x4){bflo(w.x), bfhi(w.x), bflo(w.y), bfhi(w.y)}; b = (f32x4){bflo(w.z), bfhi(w.z), bflo(w.w), bfhi(w.w)}; }
__device__ __forceinline__ u32x4 pk8(const f32x4 a, const f32x4 b) { u32x4 w; w.x = cvt_pk_bf16(a[0], a[1]); w.y = cvt_pk_bf16(a[2], a[3]); w.z = cvt_pk_bf16(b[0], b[1]); w.w = cvt_pk_bf16(b[2], b[3]); return w; }
__device__ __forceinline__ f32x4 act4(f32x4 v, int kind) {
    if (kind == 1) { v = (f32x4){fgelu(v[0]), fgelu(v[1]), fgelu(v[2]), fgelu(v[3])}; }
    else if (kind == 2) { v = (f32x4){fsig(v[0]), fsig(v[1]), fsig(v[2]), fsig(v[3])}; }
    else if (kind == 3) { v = (f32x4){2.f * fsig(2.f * v[0]) - 1.f, 2.f * fsig(2.f * v[1]) - 1.f, 2.f * fsig(2.f * v[2]) - 1.f, 2.f * fsig(2.f * v[3]) - 1.f}; }
    return v;
}
#define EPI_ROWS_BEGIN _Pragma("unroll") for (int ai = 0; ai < 2; ++ai) _Pragma("unroll") for (int m = 0; m < 4; ++m) { const size_t row = (size_t)(row0 + ai * HALF + m * 16);
#define EPI_ROWS_END }

struct EpiZ {
    static constexpr bool PERM = true, AFTER_DRAIN = false;
    bf16_t *zrkv, *zl, *guv, *sg, *vf; int pnoff;
    __device__ __forceinline__ void operator()(const f32x4 (&acc)[2][2][4][2], const Unit& u, int wr, int wc, int fr, int fq) const {
        const int pn = u.pn + pnoff, row0 = u.pm * BM + wr * 64 + fr;
        bf16_t* dst; int ld, colt, k0, k1;
        if (pn < 12)       { dst = zrkv; ld = 3072; colt = pn * 256;        k0 = 0; k1 = 0; }
        else if (pn == 12) { dst = zl;   ld = 512;  colt = 0;               k0 = (wc < 2) ? 3 : 0; k1 = 2; }
        else if (pn == 13) { dst = zl;   ld = 512;  colt = 256;             k0 = 0; k1 = 0; }
        else if (pn < 22)  { dst = guv;  ld = 2048; colt = (pn - 14) * 256; k0 = 1; k1 = 1; }
        else               { dst = sg;   ld = 2048; colt = ((pn - 18) & 7) * 256; k0 = 2; k1 = 2; }
        const int col0 = colt + wc * 32 + 8 * fq;
        const bool dovf = (vf != nullptr) && pn >= 8 && pn < 12;
        const int vcol0 = (pn - 8) * 256 + wc * 32 + 8 * fq;
        EPI_ROWS_BEGIN
            bf16_t* rowp = dst + row * ld + col0;
#pragma unroll
            for (int bj = 0; bj < 2; ++bj) { const int kind = bj ? k1 : k0;
                const u32x4 w = pk8(act4(acc[ai][bj][m][0], kind), act4(acc[ai][bj][m][1], kind));
                *(u32x4*)(rowp + bj * HALF) = w;
                if (dovf) *(u32x4*)(vf + row * 1024 + vcol0 + bj * HALF) = w; }
        EPI_ROWS_END
    }
};
struct EpiLora {
    static constexpr bool PERM = true, AFTER_DRAIN = false;
    bf16_t* ew; size_t stride; const float *w0, *a0; int pnoff;
    __device__ __forceinline__ void operator()(const f32x4 (&acc)[2][2][4][2], const Unit& u, int wr, int wc, int fr, int fq) const {
        const int pn = u.pn + pnoff, sel = pn >> 2, row0 = u.pm * BM + wr * 64 + fr, col0 = (pn & 3) * 256 + wc * 32 + 8 * fq;
        bf16_t* dst = ew + (size_t)sel * stride;
        const float* bp = sel == 0 ? w0 : a0;
        f32x4 bv[2][2];
#pragma unroll
        for (int bj = 0; bj < 2; ++bj)
#pragma unroll
            for (int n = 0; n < 2; ++n) bv[bj][n] = (sel < 2) ? *(const f32x4*)(bp + col0 + bj * HALF + 4 * n) : (f32x4){0.f, 0.f, 0.f, 0.f};
        EPI_ROWS_BEGIN
            bf16_t* rowp = dst + row * 1024 + col0;
#pragma unroll
            for (int bj = 0; bj < 2; ++bj) { f32x4 v0 = acc[ai][bj][m][0] + bv[bj][0], v1 = acc[ai][bj][m][1] + bv[bj][1];
                if (sel < 2) { v0 = act4(v0, 2); v1 = act4(v1, 2); }
                if (sel == 0) { v0 = v0 * 0.60653066f; v1 = v1 * 0.60653066f; }
                *(u32x4*)(rowp + bj * HALF) = pk8(v0, v1); }
        EPI_ROWS_END
    }
};
struct EpiMv {
    static constexpr bool PERM = true, AFTER_DRAIN = false;
    bf16_t* zrkv; const bf16_t* vf; const float* v0b;
    __device__ __forceinline__ void operator()(const f32x4 (&acc)[2][2][4][2], const Unit& u, int wr, int wc, int fr, int fq) const {
        const int row0 = u.pm * BM + wr * 64 + fr, col0 = u.pn * 256 + wc * 32 + 8 * fq;
        f32x4 bv[2][2];
#pragma unroll
        for (int bj = 0; bj < 2; ++bj)
#pragma unroll
            for (int n = 0; n < 2; ++n) bv[bj][n] = *(const f32x4*)(v0b + col0 + bj * HALF + 4 * n);
        EPI_ROWS_BEGIN
#pragma unroll
            for (int bj = 0; bj < 2; ++bj) { bf16_t* zp = zrkv + row * 3072 + 2048 + col0 + bj * HALF;
                f32x4 z0, z1, f0, f1; unpk8(*(const u32x4*)zp, z0, z1); unpk8(*(const u32x4*)(vf + row * 1024 + col0 + bj * HALF), f0, f1);
                const f32x4 m0 = act4(acc[ai][bj][m][0] + bv[bj][0], 2), m1 = act4(acc[ai][bj][m][1] + bv[bj][1], 2);
                *(u32x4*)zp = pk8(z0 + (f0 - z0) * m0, z1 + (f1 - z1) * m1); }
        EPI_ROWS_END
    }
};
struct EpiPlain {
    static constexpr bool PERM = true, AFTER_DRAIN = false;
    bf16_t* o; int ld;
    __device__ __forceinline__ void operator()(const f32x4 (&acc)[2][2][4][2], const Unit& u, int wr, int wc, int fr, int fq) const {
        const int row0 = u.pm * BM + wr * 64 + fr, col0 = u.pn * 256 + wc * 32 + 8 * fq;
        EPI_ROWS_BEGIN
#pragma unroll
            for (int bj = 0; bj < 2; ++bj) *(u32x4*)(o + row * ld + col0 + bj * HALF) = pk8(acc[ai][bj][m][0], acc[ai][bj][m][1]);
        EPI_ROWS_END
    }
};
template <bool SECOND> struct EpiMerge {
    static constexpr bool PERM = true, AFTER_DRAIN = false;
    const bf16_t* sg; bf16_t* m2; bf16_t* o;
    __device__ __forceinline__ void operator()(const f32x4 (&acc)[2][2][4][2], const Unit& u, int wr, int wc, int fr, int fq) const {
        const int row0 = u.pm * BM + wr * 64 + fr, col0 = u.pn * 256 + wc * 32 + 8 * fq;
#pragma unroll
        for (int ai = 0; ai < 2; ++ai) { u32x4 gv[4][2], pv[4][2];
#pragma unroll
            for (int m = 0; m < 4; ++m) { const size_t row = (size_t)(row0 + ai * HALF + m * 16);
#pragma unroll
                for (int bj = 0; bj < 2; ++bj) { const int c = col0 + bj * HALF; gv[m][bj] = *(const u32x4*)(sg + row * 2048 + (SECOND ? 0 : 1024) + c);
                    if (SECOND) pv[m][bj] = *(const u32x4*)(m2 + row * 2048 + c); } }
#pragma unroll
            for (int m = 0; m < 4; ++m) { const size_t row = (size_t)(row0 + ai * HALF + m * 16);
#pragma unroll
                for (int bj = 0; bj < 2; ++bj) { const int c = col0 + bj * HALF;
                    f32x4 g0, g1; unpk8(gv[m][bj], g0, g1);
                    f32x4 v0 = g0 * acc[ai][bj][m][0], v1 = g1 * acc[ai][bj][m][1];
                    if (SECOND) { f32x4 p0, p1; unpk8(pv[m][bj], p0, p1); v0 = v0 + p0; v1 = v1 + p1; *(u32x4*)(o + row * 1024 + c) = pk8(v0, v1); }
                    else *(u32x4*)(m2 + row * 2048 + c) = pk8(v0, v1); } } }
    }
};
struct EpiResid {
    static constexpr bool PERM = false, AFTER_DRAIN = false;
    float* h;
    __device__ __forceinline__ void operator()(const f32x4 (&acc)[2][2][4][2], const Unit& u, int wr, int wc, int fr, int fq) const {
        const int row0 = u.pm * BM + wr * 64 + fr, col0 = u.pn * 256 + wc * 32 + 4 * fq;
#pragma unroll
        for (int ai = 0; ai < 2; ++ai) { f32x4 hv[4][2][2];
#pragma unroll
            for (int m = 0; m < 4; ++m) { const float* rowp = h + (size_t)(row0 + ai * HALF + m * 16) * 1024 + col0;
#pragma unroll
                for (int bj = 0; bj < 2; ++bj)
#pragma unroll
                    for (int n = 0; n < 2; ++n) hv[m][bj][n] = *(const f32x4*)(rowp + bj * HALF + n * 16); }
#pragma unroll
            for (int m = 0; m < 4; ++m) { float* rowp = h + (size_t)(row0 + ai * HALF + m * 16) * 1024 + col0;
#pragma unroll
                for (int bj = 0; bj < 2; ++bj)
#pragma unroll
                    for (int n = 0; n < 2; ++n) *(f32x4*)(rowp + bj * HALF + n * 16) = hv[m][bj][n] + acc[ai][bj][m][n]; } }
    }
};
struct EpiQG {
    static constexpr bool PERM = true, AFTER_DRAIN = false;
    bf16_t* q; bf16_t* pw; float* h;
    __device__ __forceinline__ void operator()(const f32x4 (&acc)[2][2][4][2], const Unit& u, int wr, int wc, int fr, int fq) const {
        const int row0 = u.pm * BM + wr * 64 + fr;
        if (u.pn < 8) { const int col0 = u.pn * 256 + wc * 32 + 8 * fq;
            EPI_ROWS_BEGIN
#pragma unroll
                for (int bj = 0; bj < 2; ++bj) *(u32x4*)(q + row * 2048 + col0 + bj * HALF) = pk8(acc[ai][bj][m][0], acc[ai][bj][m][1]);
            EPI_ROWS_END
        } else { const int col0 = (u.pn - 8) * 256 + wc * 32 + 8 * fq;
#pragma unroll
            for (int ai = 0; ai < 2; ++ai)
#pragma unroll
            for (int mh = 0; mh < 2; ++mh) { u32x4 pwv[2][2];
#pragma unroll
                for (int m2_ = 0; m2_ < 2; ++m2_) { const size_t row = (size_t)(row0 + ai * HALF + (2 * mh + m2_) * 16);
#pragma unroll
                    for (int bj = 0; bj < 2; ++bj) { const int c = col0 + bj * HALF; pwv[m2_][bj] = *(const u32x4*)(pw + row * 1024 + c); } }
#pragma unroll
                for (int m2_ = 0; m2_ < 2; ++m2_) { const int m = 2 * mh + m2_; const size_t row = (size_t)(row0 + ai * HALF + m * 16);
#pragma unroll
                    for (int bj = 0; bj < 2; ++bj) { const int c = col0 + bj * HALF; f32x4 p0, p1; unpk8(pwv[m2_][bj], p0, p1);
                        *(u32x4*)(pw + row * 1024 + c) = pk8(p0 * act4(acc[ai][bj][m][0], 2), p1 * act4(acc[ai][bj][m][1], 2)); } } }
        }
    }
};
template <class Epi, class Sched, bool ALIGN_EPI = false, bool SP2 = false>
__device__ __forceinline__ void gemm_phase(PG8_LAS unsigned char* lds, const Gemm g, const Sched& S, const Epi& E, const int wave0) {
    int tidq; asm volatile("v_mbcnt_lo_u32_b32 %0, -1, 0\n\tv_mbcnt_hi_u32_b32 %0, -1, %0" : "=v"(tidq)); tidq += wave0 * 64;
    const int tid = tidq, wid = __builtin_amdgcn_readfirstlane(tid >> 6), lane = tid & 63, wr = wid >> 2, wc = wid & 3, fr = lane & 15, fq = lane >> 4;
    int Kq = g.K, ldaq = g.lda; const bf16_t* gA = g.A; const bf16_t* gB = g.Bt; asm volatile("" : "+s"(Kq), "+s"(ldaq), "+s"(gA), "+s"(gB));
    const int K = Kq, nt = K / BK;
    unsigned voffA[2], voffB[2];
#pragma unroll
    for (int i = 0; i < 2; ++i) { int R, C; stage_rc(tid * 16 + i * 8192, R, C); const int Rb = Epi::PERM ? ((R & ~31) + perm32(R & 31)) : R;
        voffA[i] = (unsigned)(R * ldaq + C) * 2u; voffB[i] = (unsigned)(Rb * K + C) * 2u; }
    const size_t kstep = (size_t)(BK * 2);
    const size_t hstepA = (size_t)HALF * ldaq * 2, hstepB = (size_t)HALF * K * 2;
    const size_t tstepA = 2 * hstepA, tstepB = 2 * hstepB;
    const unsigned ldsw = (unsigned)wid * 1024u;
    const int aoff = lds_byte(wr * 64 + fr, fq * 8), boff = lds_byte(wc * 32 + fr, fq * 8);
#define PG8_SA(b, h) (((b) * 2 + (h)) * HTB)
#define PG8_SB(b, h) ((4 + (b) * 2 + (h)) * HTB)
#define PG8_STAGE(bufoff, gbase, voff) do { _Pragma("unroll") for (int _i = 0; _i < 2; ++_i) \
        __builtin_amdgcn_global_load_lds((const unsigned*)((const char*)(gbase) + (voff)[_i]), (PG8_LAS unsigned*)(lds + (bufoff) + ldsw + _i * 8192), 16, 0, 0); } while (0)
#define PG8_LDA(dst, b, h) do { _Pragma("unroll") for (int m = 0; m < 4; ++m) _Pragma("unroll") for (int k = 0; k < 2; ++k) dst[m][k] = *(const PG8_LAS bf16x8*)(lds + PG8_SA(b, h) + aoff + m * 2048 + k * 1024); } while (0)
#define PG8_LDB(dst, b, h) do { _Pragma("unroll") for (int n = 0; n < 2; ++n) _Pragma("unroll") for (int k = 0; k < 2; ++k) dst[n][k] = *(const PG8_LAS bf16x8*)(lds + PG8_SB(b, h) + boff + n * 2048 + k * 1024); } while (0)
#define PG8_MMA(ai, bj, At, Bt) do { __builtin_amdgcn_s_setprio(1); _Pragma("unroll") for (int m = 0; m < 4; ++m) _Pragma("unroll") for (int n = 0; n < 2; ++n) _Pragma("unroll") for (int k = 0; k < 2; ++k) \
        acc[ai][bj][m][n] = __builtin_amdgcn_mfma_f32_16x16x32_bf16(Bt[n][k], At[m][k], acc[ai][bj][m][n], 0, 0, 0); __builtin_amdgcn_s_setprio(0); } while (0)
#define PG8_WAIT_V(n) asm volatile("s_waitcnt vmcnt(" #n ")" ::: "memory")
#define PG8_WAIT_L(n) asm volatile("s_waitcnt lgkmcnt(" #n ")" ::: "memory")
#define PG8_BAR __builtin_amdgcn_s_barrier()
#define PG8_SCHED __builtin_amdgcn_sched_barrier(0)
    Unit cur, nxt; int ui = 0;
    if (!S.next(0, cur)) return;
    f32x4 acc[2][2][4][2];
#pragma unroll
    for (int a = 0; a < 2; ++a)
#pragma unroll
        for (int b = 0; b < 2; ++b)
#pragma unroll
            for (int m = 0; m < 4; ++m)
#pragma unroll
                for (int n = 0; n < 2; ++n) acc[a][b][m][n] = (f32x4){0.f, 0.f, 0.f, 0.f};
    bf16x8 At[4][2], B0[2][2], B1[2][2];
    const size_t arow = g.abatch ? (size_t)ldaq * 2 : 0;
    const char* cA = (const char*)gA + (size_t)cur.pm * tstepA + (size_t)(cur.pm >> 4) * arow; const char* cB = (const char*)gB + (size_t)cur.pn * tstepB;
    S.a_ready(cur);
    if constexpr (SP2) {
        PG8_STAGE(PG8_SB(0, 0), cB, voffB); PG8_STAGE(PG8_SB(0, 1), cB + hstepB, voffB); PG8_STAGE(PG8_SA(0, 0), cA, voffA); PG8_STAGE(PG8_SA(0, 1), cA + hstepA, voffA);
        if (wr == 1) PG8_BAR;
        PG8_WAIT_V(2); PG8_BAR;
        PG8_STAGE(PG8_SB(1, 0), cB + kstep, voffB); PG8_STAGE(PG8_SA(1, 0), cA + kstep, voffA); PG8_STAGE(PG8_SB(1, 1), cB + hstepB + kstep, voffB);
        PG8_WAIT_V(6); PG8_BAR;
    } else {
        PG8_STAGE(PG8_SB(0, 0), cB, voffB); PG8_STAGE(PG8_SA(0, 0), cA, voffA); PG8_STAGE(PG8_SB(0, 1), cB + hstepB, voffB); PG8_STAGE(PG8_SA(0, 1), cA + hstepA, voffA);
        if (wr == 1) PG8_BAR;
        PG8_WAIT_V(4); PG8_BAR;
        PG8_STAGE(PG8_SB(1, 0), cB + kstep, voffB); PG8_STAGE(PG8_SA(1, 0), cA + kstep, voffA); PG8_STAGE(PG8_SB(1, 1), cB + hstepB + kstep, voffB);
        PG8_WAIT_V(6); PG8_BAR;
    }
    for (;;) {
        const bool has_next = S.next(ui + 1, nxt);
        const char* nA = has_next ? (const char*)gA + (size_t)nxt.pm * tstepA + (size_t)(nxt.pm >> 4) * arow : cA; const char* nB = has_next ? (const char*)gB + (size_t)nxt.pn * tstepB : cB;
        for (int t = 0; t < nt; t += 2) {
            const bool last = (t == nt - 2);
            const char* a1 = cA + (size_t)(t + 1) * kstep;
            const char* a2 = last ? nA : cA + (size_t)(t + 2) * kstep; const char* b2 = last ? nB : cB + (size_t)(t + 2) * kstep;
            const char* a3 = a2 + kstep; const char* b3 = b2 + kstep;
            if (last && has_next) S.a_ready(nxt);
            if constexpr (SP2) {
            PG8_LDB(B0, 0, 0); PG8_LDB(B1, 0, 1); PG8_SCHED; PG8_LDA(At, 0, 0); PG8_STAGE(PG8_SA(1, 1), a1 + hstepA, voffA);
            PG8_WAIT_V(8); PG8_WAIT_L(0); PG8_BAR; PG8_MMA(0, 0, At, B0); PG8_MMA(0, 1, At, B1); PG8_BAR; PG8_SCHED;
            PG8_LDA(At, 0, 1); PG8_STAGE(PG8_SB(0, 0), b2, voffB); PG8_STAGE(PG8_SB(0, 1), b2 + hstepB, voffB); PG8_STAGE(PG8_SA(0, 0), a2, voffA);
            PG8_WAIT_V(8); PG8_WAIT_L(0); PG8_BAR; PG8_MMA(1, 0, At, B0); PG8_MMA(1, 1, At, B1); PG8_BAR; PG8_SCHED;
            PG8_LDB(B0, 1, 0); PG8_LDB(B1, 1, 1); PG8_SCHED; PG8_LDA(At, 1, 0); PG8_STAGE(PG8_SA(0, 1), a2 + hstepA, voffA);
            PG8_WAIT_V(8); PG8_WAIT_L(0); PG8_BAR; PG8_MMA(0, 0, At, B0); PG8_MMA(0, 1, At, B1); PG8_BAR; PG8_SCHED;
            PG8_LDA(At, 1, 1); PG8_STAGE(PG8_SB(1, 0), b3, voffB); PG8_STAGE(PG8_SB(1, 1), b3 + hstepB, voffB); PG8_STAGE(PG8_SA(1, 0), a3, voffA);
            PG8_WAIT_V(8); PG8_WAIT_L(0); PG8_BAR; PG8_MMA(1, 0, At, B0); PG8_MMA(1, 1, At, B1); PG8_BAR; PG8_SCHED;
            } else {
            PG8_LDB(B0, 0, 0); PG8_SCHED; PG8_LDA(At, 0, 0); PG8_STAGE(PG8_SA(1, 1), a1 + hstepA, voffA);
            PG8_WAIT_L(8); PG8_BAR; PG8_WAIT_L(0); PG8_MMA(0, 0, At, B0); PG8_BAR; PG8_SCHED;
            PG8_LDB(B1, 0, 1); PG8_STAGE(PG8_SB(0, 0), b2, voffB);
            PG8_BAR; PG8_WAIT_L(0); PG8_MMA(0, 1, At, B1); PG8_BAR;
            PG8_LDA(At, 0, 1); PG8_STAGE(PG8_SA(0, 0), a2, voffA);
            PG8_BAR; PG8_WAIT_L(0); PG8_MMA(1, 0, At, B0); PG8_BAR; PG8_SCHED;
            PG8_STAGE(PG8_SB(0, 1), b2 + hstepB, voffB);
            PG8_WAIT_V(6); PG8_BAR; PG8_MMA(1, 1, At, B1); PG8_BAR;
            PG8_LDB(B0, 1, 0); PG8_SCHED; PG8_LDA(At, 1, 0); PG8_STAGE(PG8_SA(0, 1), a2 + hstepA, voffA);
            PG8_WAIT_L(8); PG8_BAR; PG8_WAIT_L(0); PG8_MMA(0, 0, At, B0); PG8_BAR; PG8_SCHED;
            PG8_LDB(B1, 1, 1); PG8_STAGE(PG8_SB(1, 0), b3, voffB);
            PG8_BAR; PG8_WAIT_L(0); PG8_MMA(0, 1, At, B1); PG8_BAR;
            PG8_LDA(At, 1, 1); PG8_STAGE(PG8_SA(1, 0), a3, voffA);
            PG8_BAR; PG8_WAIT_L(0); PG8_MMA(1, 0, At, B0); PG8_BAR; PG8_SCHED;
            PG8_STAGE(PG8_SB(1, 1), b3 + hstepB, voffB);
            PG8_WAIT_V(6); PG8_BAR; PG8_MMA(1, 1, At, B1); PG8_BAR;
            }
        }
        if constexpr (ALIGN_EPI) { if (wr == 0) PG8_BAR; }
        if constexpr (!Epi::AFTER_DRAIN) { E(acc, cur, wr, wc, fr, fq); S.done(cur); }
        if (!has_next) break;
#pragma unroll
        for (int a = 0; a < 2; ++a)
#pragma unroll
            for (int b = 0; b < 2; ++b)
#pragma unroll
                for (int m = 0; m < 4; ++m)
#pragma unroll
                    for (int n = 0; n < 2; ++n) acc[a][b][m][n] = (f32x4){0.f, 0.f, 0.f, 0.f};
        cur = nxt; cA = nA; cB = nB; ++ui;
        if constexpr (ALIGN_EPI) { if (wr == 1) PG8_BAR; }
    }
    PG8_WAIT_V(0);
    if constexpr (!ALIGN_EPI) { if (wr == 0) PG8_BAR; }
    PG8_BAR;
    if constexpr (Epi::AFTER_DRAIN) { E.fused(acc, cur, wr, wc, fr, fq, lds, wid, lane); S.done(cur); }
#undef PG8_SA
#undef PG8_SB
#undef PG8_STAGE
#undef PG8_LDA
#undef PG8_LDB
#undef PG8_MMA
#undef PG8_WAIT_V
#undef PG8_WAIT_L
#undef PG8_BAR
#undef PG8_SCHED
}
}

constexpr int NB = 8, SEQ = 4096, T = NB * SEQ, D = 1024, DEPTH = 4, NZ = 7680, NWAVES = 8;
constexpr int CIN = 7424;
constexpr size_t MiB = 1u << 20;
constexpr size_t WS_CTL = 0, WS_LORA = 1 * MiB, WS_MV = 7 * MiB, ZERO_BYTES = 9 * MiB;
constexpr size_t LORA_BYTES = 3072 * 256 * 2, MV_BYTES = 1024 * 256 * 2;
constexpr size_t WS_WIN = 10 * MiB;
constexpr size_t WS_DB = 40 * MiB, DB_SET = 62 * MiB;
constexpr size_t DB_PA = 0, DB_PBT = 2 * MiB, DB_POUT = 4 * MiB, DB_WQG = 6 * MiB, DB_KEYS = 12 * MiB, DB_GMW = 12 * MiB + 512 * 1024, DB_PLEW = 13 * MiB, DB_U = 14 * MiB, DB_V = 30 * MiB, DB_PB = 46 * MiB;
constexpr size_t WS_VF = 164 * MiB, WS_PW = 228 * MiB, WS_NX = 292 * MiB, WS_ZRKV = 420 * MiB, WS_ZL = 612 * MiB, WS_GUV = 644 * MiB, WS_SG = 772 * MiB;
constexpr size_t WS_EW = 900 * MiB, WS_AR = 964 * MiB, WS_G = 1028 * MiB, WS_WINB = 1092 * MiB, WINB_BYTES = 4 * MiB, WS_END = 1100 * MiB;
constexpr size_t WS_Q = WS_ZRKV, WS_SEL = WS_ZRKV + 128 * MiB, WS_MG = WS_AR, WS_N2 = WS_G;
constexpr size_t WIN_ZERO_OFF = WS_WIN + (size_t)3328 * 2048 * 2, WIN_ZERO_BYTES = (size_t)256 * 2048 * 2;
#ifndef ZSPLIT
#define ZSPLIT 2
#endif
constexpr int CW_BAR = 4096;
constexpr int RING_BYTES = 131072, LDSCTL_OFF = RING_BYTES, MISC_OFF = LDSCTL_OFF + 320, LDS_BYTES = 147456;

#define LAS __attribute__((address_space(3)))
#define GAS __attribute__((address_space(1)))
typedef unsigned short bf16;
typedef unsigned v4u __attribute__((ext_vector_type(4)));
typedef unsigned v2u __attribute__((ext_vector_type(2)));
typedef float f32x4 __attribute__((ext_vector_type(4)));
typedef float f32x2 __attribute__((ext_vector_type(2)));
typedef short bf16x8 __attribute__((ext_vector_type(8)));
using pg8::fsig; using pg8::fgelu; using pg8::bflo; using pg8::bfhi; using pg8::unpk8; using pg8::pk8; using pg8::cvt_pk_bf16;

#define XB_TMO      128
#define XB_XCNT(j)  (256  + 64 * (j))
#define XB_XSUB(j)  (1280 + 64 * (j))
#define XB_XGEN(j)  (2304 + 64 * (j))
#define XB_TOP      3328
#define XB_TOPGEN   3392
#define XCD_BAR_WORDS 3456
#define XB_SPIN_CAP (1u << 22)

__device__ __forceinline__ unsigned xb_ld(unsigned* p)              { return __hip_atomic_load(p, __ATOMIC_RELAXED, __HIP_MEMORY_SCOPE_AGENT); }
__device__ __forceinline__ unsigned xb_add(unsigned* p, unsigned v) { return __hip_atomic_fetch_add(p, v, __ATOMIC_RELAXED, __HIP_MEMORY_SCOPE_AGENT); }
__device__ __forceinline__ unsigned xb_xcc_id() { return (unsigned)__builtin_amdgcn_s_getreg((3 << 11) | 20) & 0xFu; }
#define XB_SPIN(cond, bar) do { unsigned _sp = 0; while (cond) { __builtin_amdgcn_s_sleep(1); \
    if ((++_sp & 255u) == 0u) { if (xb_ld(&(bar)[XB_TMO])) break; if (_sp > XB_SPIN_CAP) { atomicAdd(&(bar)[XB_TMO], 1u); break; } } } } while (0)

struct XcdBarrier { unsigned* bar; unsigned x; volatile LAS unsigned* st; };

__device__ __forceinline__ XcdBarrier xcd_barrier_post(unsigned* bar, volatile LAS unsigned* st) {
    XcdBarrier b; b.bar = bar; b.x = xb_xcc_id(); b.st = st;
    if (threadIdx.x == 0) (void)xb_add(&bar[XB_XCNT(b.x)], 1u);
    return b;
}
__device__ __forceinline__ void xcd_barrier_complete(unsigned* bar, unsigned x, unsigned& nloc, unsigned& nx) {
    const unsigned G = gridDim.x * gridDim.y * gridDim.z;
    unsigned sum, cnt, mine, sp = 0u;
    for (;;) {
        sum = 0u; cnt = 0u; mine = 0u;
#pragma unroll
        for (unsigned j = 0; j < 16; ++j) { const unsigned c = xb_ld(&bar[XB_XCNT(j)]); sum += c; cnt += (c > 0u) ? 1u : 0u; mine = (j == x) ? c : mine; }
        if (sum == G) break;
        __builtin_amdgcn_s_sleep(1);
        if ((++sp & 255u) == 0u) { if (xb_ld(&bar[XB_TMO])) break; if (sp > XB_SPIN_CAP) { atomicAdd(&bar[XB_TMO], 1u); break; } }
    }
    nloc = mine > 0u ? mine : 1u; nx = cnt > 0u ? cnt : 1u;
}
__device__ __forceinline__ int lane_id_now();
__device__ __forceinline__ void xcd_barrier(const XcdBarrier& b, const int wave0) {
    asm volatile("s_waitcnt vmcnt(0)" ::: "memory");
    __syncthreads();
    if (wave0 == 0 && lane_id_now() == 0) {
        unsigned* bar = b.bar;
        __builtin_amdgcn_s_waitcnt(0);
        unsigned nloc = b.st[0], nx = b.st[1];
        if (nloc == 0u) { xcd_barrier_complete(bar, b.x, nloc, nx); b.st[0] = nloc; b.st[1] = nx; }
        const unsigned old = xb_add(&bar[XB_XSUB(b.x)], 1u);
        const unsigned gen = old / nloc;
        if (old + 1u == (gen + 1u) * nloc) {
            __builtin_amdgcn_fence(__ATOMIC_RELEASE, "agent");
            asm volatile("s_waitcnt vmcnt(0)" ::: "memory");
            const unsigned og = xb_add(&bar[XB_TOP], 1u);
            const unsigned tg = og / nx;
            if (og + 1u == (tg + 1u) * nx) xb_add(&bar[XB_TOPGEN], 1u);
            else XB_SPIN(xb_ld(&bar[XB_TOPGEN]) == tg, bar);
            __builtin_amdgcn_fence(__ATOMIC_ACQUIRE, "agent");
            xb_add(&bar[XB_XGEN(b.x)], 1u);
            asm volatile("s_waitcnt vmcnt(0)" ::: "memory");
        } else {
            XB_SPIN(xb_ld(&bar[XB_XGEN(b.x)]) == gen, bar);
            __builtin_amdgcn_fence(__ATOMIC_ACQUIRE, "agent");
            asm volatile("s_waitcnt vmcnt(0)" ::: "memory");
        }
    }
    __syncthreads();
}

struct Args { const float* in[32]; float* out; unsigned char* ws; };
struct Frame {
    LAS unsigned char* lds;
    int tid, lane, wave, G, bx, wave0;
    GAS unsigned char* ws; float* h;
};
__device__ __forceinline__ int lane_id_now() { int l; asm volatile("v_mbcnt_lo_u32_b32 %0, -1, 0\n\tv_mbcnt_hi_u32_b32 %0, -1, %0" : "=v"(l)); return l; }
__device__ __forceinline__ void phase_ids(Frame& F) { const int l = lane_id_now(); F.lane = l; F.wave = F.wave0; F.tid = F.wave0 * 64 + l; GAS unsigned char* w = F.ws; asm volatile("" : "+s"(w)); F.ws = w; }
#define DPP_ADD(x, ctrl) ((x) + __builtin_bit_cast(float, __builtin_amdgcn_update_dpp(0, __builtin_bit_cast(int, (x)), (ctrl), 0xf, 0xf, false)))
__device__ __forceinline__ float sum8(float v) {
    v = DPP_ADD(v, 0xB1);
    v = DPP_ADD(v, 0x4E);
    v = DPP_ADD(v, 0x141);
    return v;
}
__device__ __forceinline__ float sum16(float v) { v = sum8(v); v = DPP_ADD(v, 0x140); return v; }
#define DPP_ADD_NS(x, ctrl) do { (x) = DPP_ADD((x), (ctrl)); asm("" : "+v"(x)); } while (0)
__device__ __forceinline__ float sum16_ns(float v) { DPP_ADD_NS(v, 0xB1); DPP_ADD_NS(v, 0x4E); DPP_ADD_NS(v, 0x141); DPP_ADD_NS(v, 0x140); return v; }
__device__ __forceinline__ float wave_sum(float v) {
    v = sum8(v);
    v = DPP_ADD(v, 0x140);
    const auto r = __builtin_amdgcn_permlane16_swap(__builtin_bit_cast(unsigned, v), __builtin_bit_cast(unsigned, v), false, false);
    v = __builtin_bit_cast(float, (unsigned)r[0]) + __builtin_bit_cast(float, (unsigned)r[1]);
    const auto q = __builtin_amdgcn_permlane32_swap(__builtin_bit_cast(unsigned, v), __builtin_bit_cast(unsigned, v), false, false);
    return __builtin_bit_cast(float, (unsigned)q[0]) + __builtin_bit_cast(float, (unsigned)q[1]);
}
__device__ __forceinline__ unsigned xor16_u(unsigned x, int lane) { const auto r = __builtin_amdgcn_permlane16_swap(x, x, false, false); return (lane & 16) ? (unsigned)r[0] : (unsigned)r[1]; }
__device__ __forceinline__ unsigned xor32_u(unsigned x, int lane) { const auto r = __builtin_amdgcn_permlane32_swap(x, x, false, false); return (lane & 32) ? (unsigned)r[0] : (unsigned)r[1]; }
__device__ __forceinline__ void tr_item(const float* W, int ldw, int ncols, bf16* WT, int ldt, int koff, int row_off, LAS float* scr, int item, int lane, int kx = 0) {
    const int nblk = ncols / 32, kb = item / nblk, nb = item % nblk, k0 = 64 * kb, n0 = 32 * nb;
#pragma unroll 8
    for (int i = 0; i < 32; ++i) { const int kk = 2 * i + (lane >> 5); scr[kk * 33 + (lane & 31)] = W[(size_t)(k0 + kk) * ldw + n0 + (lane & 31)]; }
    asm volatile("s_waitcnt lgkmcnt(0)" ::: "memory");
    const int c = lane & 7;
#pragma unroll
    for (int j = 0; j < 4; ++j) { const int n = (lane >> 3) + 8 * j; const LAS float* s = scr + (8 * c) * 33 + n;
        v4u o; o.x = cvt_pk_bf16(s[0 * 33], s[1 * 33]); o.y = cvt_pk_bf16(s[2 * 33], s[3 * 33]); o.z = cvt_pk_bf16(s[4 * 33], s[5 * 33]); o.w = cvt_pk_bf16(s[6 * 33], s[7 * 33]);
        *(v4u*)(WT + (size_t)(row_off + n0 + n) * ldt + ((koff + k0 + 8 * c) ^ kx)) = o; }
    asm volatile("s_waitcnt lgkmcnt(0)" ::: "memory");
}
__device__ __forceinline__ void cvt_chunk(const float* src, bf16* dst, size_t chunk, int lane) {
    const f32x4* s = (const f32x4*)(src + chunk * 512) + lane * 2; const f32x4 a = s[0], b = s[1];
    *(v4u*)(dst + chunk * 512 + lane * 8) = pk8(a, b);
}
__device__ __forceinline__ void cvt8_chunk(const float* src, unsigned char* dst, size_t chunk, int lane, float sc) {
    const f32x4* s = (const f32x4*)(src + chunk * 512) + lane * 2; const f32x4 a = s[0] * sc, b = s[1] * sc;
    int w0 = 0, w1 = 0;
    w0 = __builtin_amdgcn_cvt_pk_fp8_f32(a.x, a.y, w0, false); w0 = __builtin_amdgcn_cvt_pk_fp8_f32(a.z, a.w, w0, true);
    w1 = __builtin_amdgcn_cvt_pk_fp8_f32(b.x, b.y, w1, false); w1 = __builtin_amdgcn_cvt_pk_fp8_f32(b.z, b.w, w1, true);
    *(v2u*)(dst + chunk * 512 + lane * 8) = (v2u){(unsigned)w0, (unsigned)w1};
}
#define NXROW(t) ((size_t)(t) + ((size_t)(t) >> 12) + 1)
__device__ __forceinline__ void norm_row_nx(const float* hrow, float* hcopy, const float* g, bf16* NX, int t, int lane) {
    const f32x4* xr = (const f32x4*)hrow + lane; f32x4 v[4]; float s = 0.f;
#pragma unroll
    for (int j = 0; j < 4; ++j) { v[j] = xr[64 * j]; s += (v[j].x * v[j].x + v[j].y * v[j].y) + (v[j].z * v[j].z + v[j].w * v[j].w); }
    if (hcopy) {
#pragma unroll
        for (int j = 0; j < 4; ++j) ((f32x4*)hcopy)[lane + 64 * j] = v[j]; }
    const float rstd = 1.f / sqrtf(wave_sum(s) * (1.f / D) + 1e-6f);
#pragma unroll
    for (int j = 0; j < 4; ++j) { const f32x4 gv = ((const f32x4*)g)[lane + 64 * j]; const f32x4 o = v[j] * rstd * gv;
        v2u w; w.x = cvt_pk_bf16(o.x, o.y); w.y = cvt_pk_bf16(o.z, o.w);
        const int c = 4 * (lane + 64 * j);
        *(v2u*)(NX + NXROW(t) * 1024 + c) = w; }
}
__device__ __forceinline__ void norm_row_n2x2(const float* hrow0, const float* hrow1, const float* g, bf16* o0, bf16* o1, int lane) {
    const f32x4* x0 = (const f32x4*)hrow0 + lane; const f32x4* x1 = (const f32x4*)hrow1 + lane; f32x4 v[2][4]; float s0 = 0.f, s1 = 0.f;
#pragma unroll
    for (int j = 0; j < 4; ++j) { v[0][j] = x0[64 * j]; v[1][j] = x1[64 * j]; }
#pragma unroll
    for (int j = 0; j < 4; ++j) { s0 += (v[0][j].x * v[0][j].x + v[0][j].y * v[0][j].y) + (v[0][j].z * v[0][j].z + v[0][j].w * v[0][j].w);
                                  s1 += (v[1][j].x * v[1][j].x + v[1][j].y * v[1][j].y) + (v[1][j].z * v[1][j].z + v[1][j].w * v[1][j].w); }
    const float r0 = 1.f / sqrtf(wave_sum(s0) * (1.f / D) + 1e-6f), r1 = 1.f / sqrtf(wave_sum(s1) * (1.f / D) + 1e-6f);
#pragma unroll
    for (int j = 0; j < 4; ++j) { const f32x4 gv = ((const f32x4*)g)[lane + 64 * j]; const f32x4 a = v[0][j] * r0 * gv, b = v[1][j] * r1 * gv;
        *(v2u*)(o0 + 4 * (lane + 64 * j)) = (v2u){cvt_pk_bf16(a.x, a.y), cvt_pk_bf16(a.z, a.w)}; *(v2u*)(o1 + 4 * (lane + 64 * j)) = (v2u){cvt_pk_bf16(b.x, b.y), cvt_pk_bf16(b.z, b.w)}; }
}
__device__ __forceinline__ void prep_phase(Frame& F, const Args& a, int layer, int blk, int nblk_, int part) {
    phase_ids(F);
    LAS float* scr = (LAS float*)(F.lds + F.wave * 16384);
    const int gw = blk * NWAVES + F.wave, NGW = nblk_ * NWAVES, lane = F.lane;
    GAS unsigned char* ws = F.ws; GAS unsigned char* db = F.ws + WS_DB + (size_t)(layer & 1) * DB_SET;
    bf16* WIN = (bf16*)(ws + WS_WIN); bf16* LORA = (bf16*)(ws + WS_LORA + (size_t)layer * LORA_BYTES); bf16* MVT = (bf16*)(ws + WS_MV + (size_t)(layer > 0 ? layer - 1 : 0) * MV_BYTES);
    const float* w_in = a.in[5] + (size_t)layer * 2048 * CIN;
    const int mvn = layer > 0 ? 32 : 0;
    const int c1 = 32 * 104, c2a = 32 * 64, c2b = 32 * 32, c2c = 32 * (32 - 8 * ZSPLIT), c2d = 32 * 8 * ZSPLIT, c2 = c2a + 2 * c2b, c3 = mvn, c4 = 32, c5 = 32, c6 = 64, c7 = 512, c10 = 1024, c12 = 128;
    const int total = (part & 1) ? c1 + c2 + c3 + c4 + c5 + c6 + 3 * c7 + c10 + c7 + c12 : 0;
    for (int it = gw; it < total; it += NGW) {
        int r = it;
        if (r < c1) { tr_item(w_in, CIN, 3328, WIN, 2048, 0, 0, scr, r, lane, 1024); continue; } r -= c1;
        if (r < c2a) { tr_item(w_in + 3328, CIN, 2048, WIN, 2048, 0, 3584, scr, r, lane, 1024); continue; } r -= c2a;
        if (r < c2b) { tr_item(w_in + 6400, CIN, 1024, WIN, 2048, 0, 5632, scr, r, lane, 1024); continue; } r -= c2b;
        if (r < c2c) { tr_item(w_in + 5376, CIN, 1024 - 256 * ZSPLIT, WIN, 2048, 0, 6656, scr, r, lane, 1024); continue; } r -= c2c;
        if (r < c2d) { tr_item(w_in + 6400 - 256 * ZSPLIT, CIN, 256 * ZSPLIT, (bf16*)(ws + WS_WINB + (size_t)(layer & 1) * WINB_BYTES), 2048, 0, 0, scr, r, lane, 1024); continue; } r -= c2d;
        if (r < c3) { tr_item(a.in[16] + (size_t)(layer - 1) * 2048 * 32, 32, 32, WIN, 2048, 0, 3328, scr, r, lane, 1024); continue; } r -= c3;
        if (r < c4) { tr_item(a.in[7] + (size_t)layer * 64 * 1024, 1024, 1024, LORA, 128, 0, 0, scr, r, lane); continue; } r -= c4;
        if (r < c5) { tr_item(a.in[9] + (size_t)layer * 64 * 1024, 1024, 1024, LORA, 128, 64, 1024, scr, r, lane); continue; } r -= c5;
        if (r < c6) { tr_item(a.in[10] + (size_t)layer * 128 * 1024, 1024, 1024, LORA + 2048 * 128, 128, 0, 0, scr, r, lane); continue; } r -= c6;
        if (r < c7) { tr_item(a.in[23] + (size_t)layer * D * D, D, D, (bf16*)(db + DB_PA), D, 0, 0, scr, r, lane); continue; } r -= c7;
        if (r < c7) { tr_item(a.in[24] + (size_t)layer * D * D, D, D, (bf16*)(db + DB_PBT), D, 0, 0, scr, r, lane); continue; } r -= c7;
        if (r < c7) { tr_item(a.in[25] + (size_t)layer * D * D, D, D, (bf16*)(db + DB_POUT), D, 0, 0, scr, r, lane); continue; } r -= c7;
        if (r < c10) { tr_item(a.in[26] + (size_t)layer * D * 2048, 2048, 2048, (bf16*)(db + DB_WQG), D, 0, 0, scr, r, lane); continue; } r -= c10;
        if (r < c7) { tr_item(a.in[31] + (size_t)layer * D * D, D, D, (bf16*)(db + DB_WQG), D, 0, 2048, scr, r, lane); continue; } r -= c7;
        tr_item(a.in[30] + (size_t)layer * 256 * D, D, D, (bf16*)(db + DB_PLEW), 256, 0, 0, scr, r, lane);
    }
    if (layer > 0 && (part & 1)) {
        const float* w2 = a.in[17] + (size_t)(layer - 1) * 32 * 1024;
        for (int it = gw; it < 512; it += NGW) { const int e = it * 64 + lane, n = e >> 5, k = e & 31; MVT[n * 128 + k] = (bf16)(cvt_pk_bf16(w2[k * 1024 + n], 0.f) & 0xffffu); }
    }
    {
        const float* keys = a.in[27] + (size_t)layer * 262144; const float* ut = a.in[28] + (size_t)layer * 16777216; const float* vt = a.in[29] + (size_t)layer * 16777216;
        const float* pin = a.in[1] + (size_t)layer * T * 256; const float* gws = a.in[21] + (size_t)layer * 131072;
        const int n1 = (part & 1) ? 512 : 0, n2 = (part & 2) ? 32768 : 0, n4 = (part & 1) ? 16384 : 0, n5 = (part & 1) ? 256 : 0, ntot = n1 + 2 * n2 + n4 + n5;
        for (int it = gw; it < ntot; it += NGW) {
            int r = it;
            if (r < n2) { cvt8_chunk(ut, (unsigned char*)(db + DB_U), r, lane, 256.f); continue; } r -= n2;
            if (r < n2) { cvt8_chunk(vt, (unsigned char*)(db + DB_V), r, lane, 64.f); continue; } r -= n2;
            if (r < n4) { cvt_chunk(pin, (bf16*)(db + DB_PB), r, lane); continue; } r -= n4;
            if (r < n1) { cvt_chunk(keys, (bf16*)(db + DB_KEYS), r, lane); continue; } r -= n1;
            {
                const int e0 = r * 512 + lane * 8, tq = (e0 >> 7) & 127, p0 = e0 & 127;
                const f32x4* s = (const f32x4*)(gws + e0); f32x4 x0 = s[0], x1 = s[1];
#pragma unroll
                for (int j = 0; j < 4; ++j) { if (p0 + j > tq) x0[j] = 0.f; if (p0 + 4 + j > tq) x1[j] = 0.f; }
                *(v4u*)((bf16*)(db + DB_GMW) + e0) = pk8(x0, x1);
            }
        }
    }
    if (layer == 0 && (part & 1)) {
        if (gw < NB) *(v4u*)((bf16*)(ws + WS_NX) + (size_t)gw * (SEQ + 1) * 1024 + 8 * lane) = (v4u){0u, 0u, 0u, 0u}, *(v4u*)((bf16*)(ws + WS_NX) + (size_t)gw * (SEQ + 1) * 1024 + 512 + 8 * lane) = (v4u){0u, 0u, 0u, 0u};
        for (int m = gw; m < T; m += NGW) norm_row_nx(a.in[0] + (size_t)m * D, F.h + (size_t)m * D, a.in[2], (bf16*)(ws + WS_NX), m, lane);
    }
}

constexpr int SC = 32, NPR = SC / 2;
constexpr int SC_VEC = SC * 64;
constexpr int SC_WW = 0, SC_VQ = NPR * 64, SC_BK = SC_VQ + NPR * 256, SC_XA = SC_BK + NPR * 128, SC_C = SC_XA + NPR * 128, SC_VP = SC_C + NPR * 20, SC_BON = SC_VP + SC * 64, SC_BUF = SC_BON + SC * 8;
static_assert(SC_BUF % 4 == 0 && SC_C % 4 == 0 && (2 * SC_BUF + 2 * SC_VEC) * 4 + 64 <= 131072, "scan LDS map");
struct ScanOps { f32x4 w[4], vq, c[4]; v4u bk[2]; bf16x8 x[2]; };
__device__ __forceinline__ void scan_load2(ScanOps& o, const LAS float* buf, const LAS float* vqp, const LAS unsigned char* bkp, int bkstep, int p, int lane) {
    const int q = lane >> 4;
    const LAS float* wp = buf + SC_WW + p * 64 + q * 4;
#pragma unroll
    for (int i = 0; i < 4; ++i) o.w[i] = *(const LAS f32x4*)(wp + 16 * i);
    o.vq = *(const LAS f32x4*)(vqp + p * 256);
    o.bk[0] = *(const LAS v4u*)(bkp + p * bkstep); o.bk[1] = *(const LAS v4u*)(bkp + p * bkstep + 16);
    const LAS unsigned char* xp = (const LAS unsigned char*)(buf + SC_XA) + p * 512 + (lane & 3) * 128 + q * 16;
    o.x[0] = *(const LAS bf16x8*)xp; o.x[1] = *(const LAS bf16x8*)(xp + 64);
#pragma unroll
    for (int i = 0; i < 4; ++i) o.c[i] = *(const LAS f32x4*)(buf + SC_C + p * 20 + 4 * i);
}
__device__ __forceinline__ const char* uni_ptr(const char* p) { const unsigned long long a = (unsigned long long)p;
    const unsigned lo = (unsigned)__builtin_amdgcn_readfirstlane((int)(unsigned)a), hi = (unsigned)__builtin_amdgcn_readfirstlane((int)(unsigned)(a >> 32));
    return (const char*)(((unsigned long long)hi << 32) | lo); }
__device__ __forceinline__ float smul(float a, float b) { float r; asm("v_mul_f32 %0, %1, %2" : "=v"(r) : "v"(a), "v"(b)); return r; }
__device__ __forceinline__ void scan_pair(const ScanOps& o, f32x4 (&St)[4], float& sa0, float& sa1, v4u (&am)[4], v4u& bm, LAS float* ypt, int ystep, unsigned m16) {
    v4u s0, s1;
    s0.x = cvt_pk_bf16(St[0].x, St[0].y); s0.y = cvt_pk_bf16(St[0].z, St[0].w); s0.z = cvt_pk_bf16(St[1].x, St[1].y); s0.w = cvt_pk_bf16(St[1].z, St[1].w);
    s1.x = cvt_pk_bf16(St[2].x, St[2].y); s1.y = cvt_pk_bf16(St[2].z, St[2].w); s1.z = cvt_pk_bf16(St[3].x, St[3].y); s1.w = cvt_pk_bf16(St[3].z, St[3].w);
    f32x4 dv = (f32x4){0.f, 0.f, 0.f, 0.f};
    dv = __builtin_amdgcn_mfma_f32_16x16x32_bf16(o.x[0], __builtin_bit_cast(bf16x8, s0), dv, 0, 0, 0);
    dv = __builtin_amdgcn_mfma_f32_16x16x32_bf16(o.x[1], __builtin_bit_cast(bf16x8, s1), dv, 0, 0, 0);
    const float v0 = o.vq.x, v1 = o.vq.y, v2 = o.vq.z;
    typedef short s16x4 __attribute__((ext_vector_type(4)));
    const v2u bm2 = (v2u){cvt_pk_bf16(sa0, v0) & m16, cvt_pk_bf16(sa1, v1) & m16};
#pragma unroll
    for (int i = 0; i < 4; ++i) { const v2u a2 = (v2u){o.bk[i >> 1][(i & 1) * 2], o.bk[i >> 1][(i & 1) * 2 + 1]};
        St[i] = __builtin_amdgcn_mfma_f32_16x16x16bf16_1k(__builtin_bit_cast(s16x4, a2), __builtin_bit_cast(s16x4, bm2),
                                                        (f32x4){smul(St[i].x, o.w[i].x), smul(St[i].y, o.w[i].y), smul(St[i].z, o.w[i].z), smul(St[i].w, o.w[i].w)}, 0, 0, 0); }
    ypt[0]     = dv.z + sa0 * o.c[2].z + v0 * o.c[2].w;
    ypt[ystep] = dv.w + sa0 * o.c[3].x + v0 * o.c[3].y + sa1 * o.c[3].z + v1 * o.c[3].w;
    const float n0 = dv.x + sa0 * o.c[0].x + v0 * o.c[0].y + sa1 * o.c[0].z + v1 * o.c[0].w;
    const float n1 = dv.y + sa0 * o.c[1].x + v0 * o.c[1].y + sa1 * o.c[1].z + v1 * o.c[1].w + n0 * o.c[2].x + v2 * o.c[2].y;
    sa0 = n0; sa1 = n1;
}
__device__ __forceinline__ void scan_unit(Frame& F, const Args& a, int layer, int unit) {
    phase_ids(F);
    const int b = unit >> 4, hh = unit & 15, tid = F.tid, lane = F.lane, wave = F.wave;
    LAS float* bufs = (LAS float*)F.lds;
    LAS float* sY = bufs + 2 * SC_BUF;
    const bf16* ZR = (const bf16*)(F.ws + WS_ZRKV); const bf16* EW = (const bf16*)(F.ws + WS_EW); const bf16* AR = (const bf16*)(F.ws + WS_AR); const bf16* GT = (const bf16*)(F.ws + WS_G);
    bf16* YA = (bf16*)(F.ws + WS_G);
    constexpr int NCH = SEQ / SC;
    if (wave < 4) {
        f32x4 St[4]; v4u am[4], bm = (v4u){0u, 0u, 0u, 0u};
#pragma unroll
        for (int i = 0; i < 4; ++i) { St[i] = (f32x4){0.f, 0.f, 0.f, 0.f}; am[i] = (v4u){0u, 0u, 0u, 0u}; }
        float sa0 = 0.f, sa1 = 0.f;
        const unsigned m16 = lane < 16 ? 0xffffffffu : 0u;
        LAS unsigned char* zblk = (LAS unsigned char*)(sY + 2 * SC_VEC);
        if (tid < 8) ((LAS unsigned*)zblk)[tid] = 0u;
        const int bkstep = lane < 16 ? 512 : 0;
        for (int it = 0; it < NCH + 2; ++it) {
            if (it >= 1 && it <= NCH) {
                const LAS float* bufc = bufs + ((it - 1) & 1) * SC_BUF;
                const LAS float* vqp = bufc + SC_VQ + 4 * (wave * 16 + (lane & 15));
                const LAS unsigned char* bkp = lane < 16 ? (const LAS unsigned char*)(bufc + SC_BK) + lane * 32 : (const LAS unsigned char*)zblk;
                LAS float* yb = lane < 16 ? sY + ((it - 1) & 1) * SC_VEC + wave * 16 + lane : (LAS float*)(zblk + 32);
                const int ystep = lane < 16 ? 64 : 0;
                if (it == 1) { sa0 = 0.f; sa1 = vqp[0] * bufc[SC_C + 16]; }
                ScanOps o0, o1;
                scan_load2(o0, bufc, vqp, bkp, bkstep, 0, lane);
#pragma unroll 1
                for (int p = 0; p < NPR; p += 2) {
                    scan_load2(o1, bufc, vqp, bkp, bkstep, p + 1, lane);
                    scan_pair(o0, St, sa0, sa1, am, bm, yb + (2 * p) * ystep, ystep, m16);
                    if (p + 2 < NPR) scan_load2(o0, bufc, vqp, bkp, bkstep, p + 2, lane);
                    scan_pair(o1, St, sa0, sa1, am, bm, yb + (2 * p + 2) * ystep, ystep, m16);
                }
            }
            __syncthreads();
        }
    } else {
        const int ht = tid - 256, tl = ht >> 3, c8 = ht & 7, ch = hh * 64 + c8 * 8;
        const int pr = ht >> 4, c4 = ht & 15, chp = hh * 64 + c4 * 4;
        const size_t po = (size_t)layer * 1024 + ch, pop = (size_t)layer * 1024 + chp;
        struct HelpIn { v2u r0, k0, v0, e0, a0, r1, k1, v1, e1, a1, k2, v2, e2, a2, k3; v4u gt; };
        HelpIn cur, nxt;
#define HELP_ROW(H, F_, RR, OFF, ARR, PITCH) (H).F_ = *(const v2u*)((ARR) + ((size_t)b * SEQ + (RR)) * (PITCH) + (OFF) + chp)
#define HELP_LOAD(H, PC, GC) do { \
            if ((PC) < NCH) { const int _t = (PC) * SC + 2 * pr; \
                HELP_ROW(H, r0, _t, 0, ZR, 3072); HELP_ROW(H, k0, _t, 1024, ZR, 3072); HELP_ROW(H, v0, _t, 2048, ZR, 3072); HELP_ROW(H, e0, _t, 0, EW, 1024); HELP_ROW(H, a0, _t, 0, AR, 1024); \
                HELP_ROW(H, r1, _t + 1, 0, ZR, 3072); HELP_ROW(H, k1, _t + 1, 1024, ZR, 3072); HELP_ROW(H, v1, _t + 1, 2048, ZR, 3072); HELP_ROW(H, e1, _t + 1, 0, EW, 1024); HELP_ROW(H, a1, _t + 1, 0, AR, 1024); \
                HELP_ROW(H, k2, _t + 2, 1024, ZR, 3072); HELP_ROW(H, v2, _t + 2, 2048, ZR, 3072); HELP_ROW(H, e2, _t + 2, 0, EW, 1024); HELP_ROW(H, a2, _t + 2, 0, AR, 1024); \
                HELP_ROW(H, k3, _t + 3, 1024, ZR, 3072); } \
            if ((GC) >= 0 && (GC) < NCH) { const size_t _row = (size_t)b * SEQ + (size_t)(GC) * SC + tl; (H).gt = *(const v4u*)(GT + _row * 1024 + ch); } } while (0)
#define UNP4(W) ((f32x4){bflo((W).x), bfhi((W).x), bflo((W).y), bfhi((W).y)})
#define EXP4(E) ((f32x4){__builtin_amdgcn_exp2f(-1.44269504f * (E).x), __builtin_amdgcn_exp2f(-1.44269504f * (E).y), __builtin_amdgcn_exp2f(-1.44269504f * (E).z), __builtin_amdgcn_exp2f(-1.44269504f * (E).w)})
#define DOT4(A, B) (((A).x * (B).x + (A).y * (B).y) + ((A).z * (B).z + (A).w * (B).w))
#define SUM16(X) sum16_ns(X)
#ifdef PROBE_SCAN
        unsigned long long ph_act = 0ull;
#endif
        HELP_LOAD(cur, 0, -2);
        for (int it = 0; it < NCH + 2; ++it) {
#ifdef PROBE_SCAN
            const unsigned long long ph0 = __builtin_amdgcn_s_memtime();
#endif
            HELP_LOAD(nxt, it + 1, it - 1);
            if (it >= 2) {
                const LAS float* buf = bufs + (it & 1) * SC_BUF; const LAS float* yb = sY + (it & 1) * SC_VEC;
                const size_t row = (size_t)b * SEQ + (size_t)(it - 2) * SC + tl; const int o = tl * 64 + c8 * 8;
                f32x4 y_[2], v_[2], g_[2];
#pragma unroll
                for (int i = 0; i < 2; ++i) { y_[i] = *(const LAS f32x4*)(yb + o + 4 * i); v_[i] = *(const LAS f32x4*)(buf + SC_VP + o + 4 * i); }
                const float bon = buf[SC_BON + tl * 8 + c8];
                unpk8(cur.gt, g_[0], g_[1]);
                const float s1 = ((y_[0].x + y_[0].y) + (y_[0].z + y_[0].w)) + ((y_[1].x + y_[1].y) + (y_[1].z + y_[1].w));
                const float mu = sum8(s1) * (1.f / 64.f);
                float s2 = 0.f;
#pragma unroll
                for (int i = 0; i < 2; ++i) { y_[i] = y_[i] - mu; const f32x4 q = y_[i] * y_[i]; s2 += (q.x + q.y) + (q.z + q.w); }
                const float rstd = __builtin_amdgcn_rsqf(sum8(s2) * (1.f / 64.f) + 64e-5f);
                f32x4 o_[2];
#pragma unroll
                for (int i = 0; i < 2; ++i) o_[i] = (y_[i] * rstd * *(const f32x4*)(a.in[14] + po + 4 * i) + *(const f32x4*)(a.in[15] + po + 4 * i) + bon * v_[i]) * g_[i];
                *(v4u*)(YA + row * 1024 + ch) = pk8(o_[0], o_[1]);
            }
            if (it < NCH) {
                LAS float* buf = bufs + (it & 1) * SC_BUF;
                const f32x4 pkk_ = *(const f32x4*)(a.in[11] + pop), pka_ = *(const f32x4*)(a.in[12] + pop), prk_ = *(const f32x4*)(a.in[13] + pop);
                const f32x4 zk0 = UNP4(cur.k0), zk1 = UNP4(cur.k1), zk2 = UNP4(cur.k2), zk3 = UNP4(cur.k3);
                f32x4 kn0 = zk0 * pkk_, kn1 = zk1 * pkk_, kn2 = zk2 * pkk_, kn3 = zk3 * pkk_;
                kn0 = kn0 * __builtin_amdgcn_rsqf(fmaxf(SUM16(DOT4(kn0, kn0)), 1e-24f)); kn1 = kn1 * __builtin_amdgcn_rsqf(fmaxf(SUM16(DOT4(kn1, kn1)), 1e-24f));
                kn2 = kn2 * __builtin_amdgcn_rsqf(fmaxf(SUM16(DOT4(kn2, kn2)), 1e-24f)); kn3 = kn3 * __builtin_amdgcn_rsqf(fmaxf(SUM16(DOT4(kn3, kn3)), 1e-24f));
                const f32x4 r0 = UNP4(cur.r0), r1 = UNP4(cur.r1), v0 = UNP4(cur.v0), v1 = UNP4(cur.v1), v2 = UNP4(cur.v2);
                const f32x4 ar0 = UNP4(cur.a0), ar1 = UNP4(cur.a1), ar2 = UNP4(cur.a2);
                const f32x4 e0 = UNP4(cur.e0), e1 = UNP4(cur.e1), e2 = UNP4(cur.e2);
                const f32x4 w0 = EXP4(e0), w1 = EXP4(e1), w2 = EXP4(e2);
                const f32x4 a1v = -kn1, a2v = -kn2, a3v = -kn3;
                const f32x4 b0 = kn0 * ar0, b1 = kn1 * ar1, b2 = kn2 * ar2;
                const f32x4 kp0 = zk0 * (1.f + (ar0 - 1.f) * pka_), kp1 = zk1 * (1.f + (ar1 - 1.f) * pka_), kp2 = zk2 * (1.f + (ar2 - 1.f) * pka_);
                const f32x4 W2 = w0 * w1, Bt = b0 * w1, Kt = kp0 * w1, x0v = a2v, x1v = w2 * a3v;
                const f32x4 X0 = W2 * x0v, X1 = W2 * x1v, X2 = w0 * r0, X3 = W2 * r1;
                *(LAS f32x4*)(buf + SC_WW + pr * 64 + c4 * 4) = W2;
                *(LAS f32x4*)(buf + SC_VP + (2 * pr) * 64 + c4 * 4) = v0; *(LAS f32x4*)(buf + SC_VP + (2 * pr + 1) * 64 + c4 * 4) = v1;
                { LAS f32x4* vq = (LAS f32x4*)(buf + SC_VQ + pr * 256 + c4 * 16);
                  vq[0] = (f32x4){v0.x, v1.x, v2.x, 0.f}; vq[1] = (f32x4){v0.y, v1.y, v2.y, 0.f}; vq[2] = (f32x4){v0.z, v1.z, v2.z, 0.f}; vq[3] = (f32x4){v0.w, v1.w, v2.w, 0.f}; }
                { LAS v2u* bkp = (LAS v2u*)(buf + SC_BK + pr * 128) + (((c4 & 3) * 4) * 4 + (c4 >> 2));
                  bkp[0] = (v2u){cvt_pk_bf16(Bt.x, Kt.x), cvt_pk_bf16(b1.x, kp1.x)}; bkp[4] = (v2u){cvt_pk_bf16(Bt.y, Kt.y), cvt_pk_bf16(b1.y, kp1.y)};
                  bkp[8] = (v2u){cvt_pk_bf16(Bt.z, Kt.z), cvt_pk_bf16(b1.z, kp1.z)}; bkp[12] = (v2u){cvt_pk_bf16(Bt.w, Kt.w), cvt_pk_bf16(b1.w, kp1.w)}; }
                { LAS unsigned char* xp = (LAS unsigned char*)(buf + SC_XA) + pr * 512 + (c4 >> 3) * 64 + (c4 & 3) * 16 + ((c4 >> 2) & 1) * 8;
                  *(LAS v2u*)xp = (v2u){cvt_pk_bf16(X0.x, X0.y), cvt_pk_bf16(X0.z, X0.w)}; *(LAS v2u*)(xp + 128) = (v2u){cvt_pk_bf16(X1.x, X1.y), cvt_pk_bf16(X1.z, X1.w)};
                  *(LAS v2u*)(xp + 256) = (v2u){cvt_pk_bf16(X2.x, X2.y), cvt_pk_bf16(X2.z, X2.w)}; *(LAS v2u*)(xp + 384) = (v2u){cvt_pk_bf16(X3.x, X3.y), cvt_pk_bf16(X3.z, X3.w)}; }
                const f32x4 ca = (f32x4){SUM16(DOT4(Bt, x0v)), SUM16(DOT4(Kt, x0v)), SUM16(DOT4(b1, x0v)), SUM16(DOT4(kp1, x0v))};
                const f32x4 cb = (f32x4){SUM16(DOT4(Bt, x1v)), SUM16(DOT4(Kt, x1v)), SUM16(DOT4(b1, x1v)), SUM16(DOT4(kp1, x1v))};
                const f32x4 cc = (f32x4){SUM16(DOT4(b2, a3v)), SUM16(DOT4(kp2, a3v)), SUM16(DOT4(b0, r0)), SUM16(DOT4(kp0, r0))};
                const f32x4 cd = (f32x4){SUM16(DOT4(Bt, r1)), SUM16(DOT4(Kt, r1)), SUM16(DOT4(b1, r1)), SUM16(DOT4(kp1, r1))};
                const float ci = SUM16(DOT4(kp0, a1v));
                const f32x4 z0 = r0 * kp0 * prk_, z1 = r1 * kp1 * prk_;
                const float bon0 = SUM16((z0.x + z0.y) + (z0.z + z0.w)), bon1 = SUM16((z1.x + z1.y) + (z1.z + z1.w));
                if (c4 == 0) { LAS f32x4* cp = (LAS f32x4*)(buf + SC_C + pr * 20); cp[0] = ca; cp[1] = cb; cp[2] = cc; cp[3] = cd; cp[4] = (f32x4){ci, 0.f, 0.f, 0.f}; }
                buf[SC_BON + (2 * pr) * 8 + (c4 >> 1)] = bon0; buf[SC_BON + (2 * pr + 1) * 8 + (c4 >> 1)] = bon1;
            }
            cur = nxt;
#ifdef PROBE_SCAN
            asm volatile("s_waitcnt vmcnt(0) lgkmcnt(0)" ::: "memory"); ph_act += __builtin_amdgcn_s_memtime() - ph0;
#endif
            __syncthreads();
        }
#ifdef PROBE_SCAN
        if (unit == 0 && layer == DEPTH - 1 && tid == 256) ((float*)(F.ws + WS_CTL))[2048 + 2] = rintf((float)ph_act / (float)(NCH + 2) * (1.f / 2000.f));
#endif
#undef HELP_LOAD
#undef HELP_ROW
#undef UNP4
#undef EXP4
#undef DOT4
#undef SUM16
    }
}

constexpr int TP = 136;
__device__ __forceinline__ void mma_128(const LAS bf16* sA, const LAS bf16* sBt, int wave, int lane, f32x4 (&acc)[4][2]) {
    const int wm = wave >> 2, wn = wave & 3, fr = lane & 15, fq = lane >> 4;
#pragma unroll
    for (int kk = 0; kk < 4; ++kk) {
        bf16x8 af[4], bf_[2];
#pragma unroll
        for (int mt = 0; mt < 4; ++mt) af[mt] = *(const LAS bf16x8*)(sA + (64 * wm + 16 * mt + fr) * TP + 32 * kk + 8 * fq);
#pragma unroll
        for (int nt = 0; nt < 2; ++nt) bf_[nt] = *(const LAS bf16x8*)(sBt + (32 * wn + 16 * nt + fr) * TP + 32 * kk + 8 * fq);
#pragma unroll
        for (int mt = 0; mt < 4; ++mt)
#pragma unroll
            for (int nt = 0; nt < 2; ++nt) acc[mt][nt] = __builtin_amdgcn_mfma_f32_16x16x32_bf16(bf_[nt], af[mt], acc[mt][nt], 0, 0, 0);
    }
}
__device__ __forceinline__ void gmlp_unit(Frame& F, const Args& a, int layer, int unit) {
    phase_ids(F);
    const size_t t0 = (size_t)unit * 128; const int tid = F.tid, lane = F.lane, wave = F.wave;
    LAS float* st = (LAS float*)F.lds; LAS bf16* sA = (LAS bf16*)(F.lds + 1024); LAS bf16* sB = (LAS bf16*)(F.lds + 1024 + 128 * TP * 2);
    bf16* GUV = (bf16*)(F.ws + WS_GUV); const bf16* GMW = (const bf16*)(F.ws + WS_DB + (size_t)(layer & 1) * DB_SET + DB_GMW);
    const float* lng = a.in[19] + (size_t)layer * 1024; const float* lnb = a.in[20] + (size_t)layer * 1024; const float* bsp = a.in[22] + (size_t)layer * 1024;
    for (int r = 0; r < 16; ++r) { const int tok = wave * 16 + r; const bf16* rowp = GUV + (t0 + tok) * 2048 + 1024;
        f32x4 x0, x1, x2, x3; unpk8(*(const v4u*)(rowp + lane * 8), x0, x1); unpk8(*(const v4u*)(rowp + 512 + lane * 8), x2, x3);
        const f32x4 sv = (x0 + x1) + (x2 + x3), qv = (x0 * x0 + x1 * x1) + (x2 * x2 + x3 * x3);
        const float s = wave_sum((sv.x + sv.y) + (sv.z + sv.w)), q = wave_sum((qv.x + qv.y) + (qv.z + qv.w));
        const float mean = s * (1.f / 1024.f), var = fmaxf(q * (1.f / 1024.f) - mean * mean, 0.f);
        if (lane == 0) { st[tok * 2] = mean; st[tok * 2 + 1] = 1.f / sqrtf(var + 1e-5f); } }
    __syncthreads();
    for (int g = 0; g < 8; ++g) {
#pragma unroll
        for (int i = 0; i < 4; ++i) { const int pc = tid + 512 * i, rr = pc >> 4, c16 = pc & 15;
            *(LAS v4u*)(sA + rr * TP + c16 * 8) = *(const v4u*)(GMW + (size_t)g * 16384 + rr * 128 + c16 * 8); }
        { const int p = tid & 127, oc0 = tid >> 7; const float mean = st[p * 2], rstd = st[p * 2 + 1];
#pragma unroll
          for (int i = 0; i < 4; ++i) { const int oc = oc0 + 4 * i, c0 = g * 128 + oc * 8;
              f32x4 x0, x1; unpk8(*(const v4u*)(GUV + (t0 + p) * 2048 + 1024 + c0), x0, x1);
              const f32x4 g0 = *(const f32x4*)(lng + c0), g1 = *(const f32x4*)(lng + c0 + 4), b0 = *(const f32x4*)(lnb + c0), b1 = *(const f32x4*)(lnb + c0 + 4);
              x0 = (x0 - mean) * rstd * g0 + b0; x1 = (x1 - mean) * rstd * g1 + b1;
              const v4u w = pk8(x0, x1);
              LAS bf16* d = sB + (oc * 8) * TP + p;
              d[0 * TP] = (bf16)(w.x & 0xffffu); d[1 * TP] = (bf16)(w.x >> 16); d[2 * TP] = (bf16)(w.y & 0xffffu); d[3 * TP] = (bf16)(w.y >> 16);
              d[4 * TP] = (bf16)(w.z & 0xffffu); d[5 * TP] = (bf16)(w.z >> 16); d[6 * TP] = (bf16)(w.w & 0xffffu); d[7 * TP] = (bf16)(w.w >> 16); } }
        __syncthreads();
        f32x4 acc[4][2];
#pragma unroll
        for (int mt = 0; mt < 4; ++mt)
#pragma unroll
            for (int nt = 0; nt < 2; ++nt) acc[mt][nt] = (f32x4){0.f, 0.f, 0.f, 0.f};
        mma_128(sA, sB, wave, lane, acc);
        { const int wm = wave >> 2, wn = wave & 3, fr = lane & 15, fq = lane >> 4;
#pragma unroll
          for (int mt = 0; mt < 4; ++mt) { const int tt = 64 * wm + 16 * mt + fr; const float bsv = bsp[g * 128 + tt];
#pragma unroll
              for (int nt = 0; nt < 2; ++nt) { const int c = g * 128 + 32 * wn + 16 * nt + 4 * fq;
                  const v2u uw = *(const v2u*)(GUV + (t0 + tt) * 2048 + c);
                  const f32x4 u4 = (f32x4){bflo(uw.x), bfhi(uw.x), bflo(uw.y), bfhi(uw.y)};
                  const f32x4 yb = u4 * (acc[mt][nt] + bsv);
                  v2u ow; ow.x = cvt_pk_bf16(yb.x, yb.y); ow.y = cvt_pk_bf16(yb.z, yb.w);
                  *(v2u*)(GUV + (t0 + tt) * 2048 + c) = ow; } } }
        __syncthreads();
    }
}

__device__ __forceinline__ unsigned fkey(float f) { const unsigned u = __builtin_bit_cast(unsigned, f); return (u & 0x80000000u) ? ~u : (u | 0x80000000u); }
__device__ __forceinline__ float kval(unsigned k, unsigned mask) { const unsigned u = k & mask; return __builtin_bit_cast(float, (u & 0x80000000u) ? (u ^ 0x80000000u) : ~u); }
__device__ __forceinline__ float swap32_add(float a, float b) { const auto r = __builtin_amdgcn_permlane32_swap(__builtin_bit_cast(unsigned, a), __builtin_bit_cast(unsigned, b), false, false);
    return __builtin_bit_cast(float, (unsigned)r[0]) + __builtin_bit_cast(float, (unsigned)r[1]); }
__device__ __forceinline__ float swap16_add(float a, float b) { const auto r = __builtin_amdgcn_permlane16_swap(__builtin_bit_cast(unsigned, a), __builtin_bit_cast(unsigned, b), false, false);
    return __builtin_bit_cast(float, (unsigned)r[0]) + __builtin_bit_cast(float, (unsigned)r[1]); }
__device__ __forceinline__ float row_sum16(float x) {
    x += __builtin_bit_cast(float, __builtin_amdgcn_update_dpp(0, __builtin_bit_cast(int, x), 0x128, 0xf, 0xf, false));
    x += __builtin_bit_cast(float, __builtin_amdgcn_update_dpp(0, __builtin_bit_cast(int, x), 0x124, 0xf, 0xf, false));
    x += __builtin_bit_cast(float, __builtin_amdgcn_update_dpp(0, __builtin_bit_cast(int, x), 0x122, 0xf, 0xf, false));
    x += __builtin_bit_cast(float, __builtin_amdgcn_update_dpp(0, __builtin_bit_cast(int, x), 0x121, 0xf, 0xf, false));
    return x; }
#define CE_DESC(a, b) do { const unsigned _h = max((a), (b)), _l = min((a), (b)); (a) = _h; (b) = _l; } while (0)
template <int OFF> __device__ __forceinline__ void bitonic_merge16(unsigned (&x)[32]) {
#pragma unroll
    for (int j = 8; j >= 1; j >>= 1)
#pragma unroll
        for (int i = 0; i < 16; ++i) { const int l = i ^ j; if (l > i) CE_DESC(x[OFF + i], x[OFF + l]); }
}
template <int OFF> __device__ __forceinline__ void bitonic_sort16(unsigned (&x)[32]) {
#pragma unroll
    for (int k = 2; k <= 16; k <<= 1)
#pragma unroll
        for (int j = k >> 1; j >= 1; j >>= 1)
#pragma unroll
            for (int i = 0; i < 16; ++i) { const int l = i ^ j; if (l > i) { if ((i & k) == 0 || k == 16) CE_DESC(x[OFF + i], x[OFF + l]); else CE_DESC(x[OFF + l], x[OFF + i]); } }
}
#ifndef REP_K
#define REP_K 1
#endif
#define TOP_INSERT(top, x) do { unsigned _x = (x); _Pragma("unroll") for (int _j = 0; _j < 16; ++_j) { const unsigned _h = max((top)[_j], _x); _x = min((top)[_j], _x); (top)[_j] = _h; } } while (0)
__device__ __forceinline__ void peer_token_end(Frame& F, const Args& a, int layer, bool last, bool final_half, size_t tok, int lane, const f32x2 (&out)[8], const f32x4 (&hpre)[4], const v4u (&gpre)[2]) {
    float* hp = F.h + tok * 1024 + 16 * lane;
    f32x4 hv[4], ge[4]; float s = 0.f;
    unpk8(gpre[0], ge[0], ge[1]); unpk8(gpre[1], ge[2], ge[3]);
    if (!final_half) {
        bf16* gp = (bf16*)(F.ws + WS_PW) + tok * 1024 + 16 * lane;
        *(v4u*)gp = pk8(ge[0] + (f32x4){out[0].x, out[0].y, out[1].x, out[1].y}, ge[1] + (f32x4){out[2].x, out[2].y, out[3].x, out[3].y});
        *(v4u*)(gp + 8) = pk8(ge[2] + (f32x4){out[4].x, out[4].y, out[5].x, out[5].y}, ge[3] + (f32x4){out[6].x, out[6].y, out[7].x, out[7].y});
        return; }
#pragma unroll
    for (int i = 0; i < 4; ++i) { hv[i] = hpre[i] + ge[i] + (f32x4){out[2 * i].x, out[2 * i].y, out[2 * i + 1].x, out[2 * i + 1].y};
        s += (hv[i].x * hv[i].x + hv[i].y * hv[i].y) + (hv[i].z * hv[i].z + hv[i].w * hv[i].w); }
    const float rstd = 1.f / sqrtf(wave_sum(s) * (1.f / D) + 1e-6f);
    const float* g = (last ? a.in[4] : a.in[2] + (size_t)(layer + 1) * 1024) + 16 * lane;
    f32x4 o[4];
#pragma unroll
    for (int i = 0; i < 4; ++i) o[i] = hv[i] * rstd * *(const f32x4*)(g + 4 * i);
    if (last) {
#ifdef PROBE_SCAN
        { const float pv = ((const float*)(F.ws + WS_CTL))[2048 + PROBE_SCAN - 1];
#pragma unroll
          for (int i = 0; i < 4; ++i) o[i] = o[i] + pv; }
#endif
#pragma unroll
        for (int i = 0; i < 4; ++i) *(f32x4*)(hp + 4 * i) = o[i];
    } else {
#pragma unroll
        for (int i = 0; i < 4; ++i) *(f32x4*)(hp + 4 * i) = hv[i];
        bf16* NX = (bf16*)(F.ws + WS_NX) + NXROW(tok) * 1024 + 16 * lane; const v4u w0 = pk8(o[0], o[1]), w1 = pk8(o[2], o[3]);
        *(v4u*)NX = w0; *(v4u*)(NX + 8) = w1;
    }
}
__device__ __forceinline__ void peer_unit(Frame& F, const Args& a, int layer, int unit, bool last) {
    phase_ids(F);
    const size_t t0 = (size_t)unit * 128; const int tid = F.tid, lane = F.lane, wave = F.wave, fr = lane & 15, fq = lane >> 4;
    LAS bf16* sKey = (LAS bf16*)F.lds;
    LAS unsigned* sLT = (LAS unsigned*)(F.lds + 2 * 128 * TP * 2) + wave * 512;
    const bf16* Q = (const bf16*)(F.ws + WS_Q); const bf16* KEYS = (const bf16*)(F.ws + WS_DB + (size_t)(layer & 1) * DB_SET + DB_KEYS); v2u* SEL = (v2u*)(F.ws + WS_SEL);
    const size_t trow = t0 + wave * 16 + fr;
    constexpr float KOFF = 32.f;
    v4u ktn[4]; bf16x8 qfn[4];
#define K_FETCH(J) do { _Pragma("unroll") for (int _i = 0; _i < 4; ++_i) { const int _pc = tid + 512 * _i, _rr = _pc >> 4, _c16 = _pc & 15; ktn[_i] = *(const v4u*)(KEYS + (size_t)(J) * 16384 + _rr * 128 + _c16 * 8); } \
        _Pragma("unroll") for (int _kk = 0; _kk < 4; ++_kk) qfn[_kk] = *(const bf16x8*)(Q + trow * 2048 + (J) * 128 + 32 * _kk + 8 * fq); } while (0)
#define K_STORE(J) do { _Pragma("unroll") for (int _i = 0; _i < 4; ++_i) { const int _pc = tid + 512 * _i, _rr = _pc >> 4, _c16 = _pc & 15; *(LAS v4u*)(sKey + ((J) & 1) * 128 * TP + _rr * TP + _c16 * 8) = ktn[_i]; } } while (0)
    for (int krep = 0; krep < REP_K; ++krep) {
    __syncthreads();
    K_FETCH(0); K_STORE(0);
    bf16x8 qf[4];
#pragma unroll
    for (int kk = 0; kk < 4; ++kk) qf[kk] = qfn[kk];
    __syncthreads();
    for (int hd = 0; hd < 8; ++hd) {
        for (int p = 0; p < 2; ++p) {
            const int jp = hd * 2 + p;
            if (jp + 1 < 16) K_FETCH(jp + 1);
            const LAS bf16* sKc = sKey + (jp & 1) * 128 * TP;
            f32x4 sc[8];
#pragma unroll
            for (int nt = 0; nt < 8; ++nt) sc[nt] = (f32x4){KOFF, KOFF, KOFF, KOFF};
#pragma unroll
            for (int kk = 0; kk < 4; ++kk)
#pragma unroll
                for (int nt = 0; nt < 8; ++nt) { const bf16x8 kf = *(const LAS bf16x8*)(sKc + (16 * nt + fr) * TP + 32 * kk + 8 * fq);
                    sc[nt] = __builtin_amdgcn_mfma_f32_16x16x32_bf16(kf, qf[kk], sc[nt], 0, 0, 0); }
            unsigned t[32];
#pragma unroll
            for (int nt = 0; nt < 8; ++nt)
#pragma unroll
                for (int rg = 0; rg < 4; ++rg) t[4 * nt + rg] = (__float_as_uint(sc[nt][rg]) & 0xFFFFFF80u) | (unsigned)(16 * nt + 4 * fq + rg);
            bitonic_sort16<0>(t); bitonic_sort16<16>(t);
#pragma unroll
            for (int j = 0; j < 16; ++j) t[j] = max(t[j], t[31 - j]);
            bitonic_merge16<0>(t);
#pragma unroll
            for (int rnd = 0; rnd < 2; ++rnd) {
#pragma unroll
                for (int j = 0; j < 16; ++j) t[16 + j] = rnd ? xor32_u(t[j], lane) : xor16_u(t[j], lane);
#pragma unroll
                for (int j = 0; j < 16; ++j) t[j] = max(t[j], t[31 - j]);
                bitonic_merge16<0>(t); }
#pragma unroll
            for (int j = 0; j < 16; ++j) sLT[fr * 32 + p * 16 + j] = t[j];
            if (jp + 1 < 16) { K_STORE(jp + 1);
#pragma unroll
                for (int kk = 0; kk < 4; ++kk) qf[kk] = qfn[kk]; }
            __syncthreads();
        }
        float v0[16], v1[16];
#pragma unroll
        for (int j = 0; j < 16; ++j) { v0[j] = __uint_as_float(sLT[fr * 32 + j] & 0xFFFFFF80u); v1[j] = __uint_as_float(sLT[fr * 32 + 16 + j] & 0xFFFFFF80u); }
        unsigned best[32];
#define CKEY(i, j) ((__float_as_uint(v0[i] + v1[j]) & 0xFFFFFF00u) | (unsigned)((i) * 16 + (j)))
#pragma unroll
        for (int j = 0; j < 16; ++j) best[j] = CKEY(0, j);
#pragma unroll
        for (int i = 1; i < 16; ++i) best[16 - i] = max(best[16 - i], CKEY(i, 0));
        bitonic_merge16<0>(best);
#pragma unroll
        for (int j = 1; j < 8; ++j) best[16 - j] = max(best[16 - j], CKEY(1, j));
        bitonic_merge16<0>(best);
#pragma unroll
        for (int i = 2; i < 8; ++i) best[17 - i] = max(best[17 - i], CKEY(i, 1));
        bitonic_merge16<0>(best);
        { unsigned r6[6] = {CKEY(2, 2), CKEY(2, 3), CKEY(2, 4), CKEY(3, 2), CKEY(3, 3), CKEY(4, 2)};
          CE_DESC(r6[0], r6[5]); CE_DESC(r6[1], r6[3]); CE_DESC(r6[2], r6[4]); CE_DESC(r6[1], r6[2]); CE_DESC(r6[3], r6[4]); CE_DESC(r6[0], r6[3]);
          CE_DESC(r6[2], r6[5]); CE_DESC(r6[0], r6[1]); CE_DESC(r6[2], r6[3]); CE_DESC(r6[4], r6[5]); CE_DESC(r6[1], r6[2]); CE_DESC(r6[3], r6[4]);
#pragma unroll
          for (int k = 0; k < 6; ++k) best[15 - k] = max(best[15 - k], r6[k]); }
        bitonic_merge16<0>(best);
#undef CKEY
        float ev[16], esum = 0.f; const float mx = __uint_as_float(best[0] & 0xFFFFFF00u);
#pragma unroll
        for (int k = 0; k < 16; ++k) { ev[k] = __builtin_amdgcn_exp2f((__uint_as_float(best[k] & 0xFFFFFF00u) - mx) * 1.44269504f); esum += ev[k]; }
        const float einv = 1.f / esum;
#pragma unroll
        for (int k = 0; k < 16; ++k) { const unsigned pos = best[k] & 255u;
            const unsigned i0 = sLT[fr * 32 + (pos >> 4)] & 127u, i1 = sLT[fr * 32 + 16 + (pos & 15u)] & 127u;
            if ((k >> 2) == fq) SEL[trow * 128 + hd * 16 + k] = (v2u){i0 * 128u + i1, __builtin_bit_cast(unsigned, ev[k] * einv)}; }
    }
    }
#undef K_FETCH
#undef K_STORE
    asm volatile("s_waitcnt vmcnt(0)" ::: "memory");
    __syncthreads();
    const bf16* N2 = (const bf16*)(F.ws + WS_N2); const unsigned char* U8 = (const unsigned char*)(F.ws + WS_DB + (size_t)(layer & 1) * DB_SET + DB_U); const unsigned char* V8 = (const unsigned char*)(F.ws + WS_DB + (size_t)(layer & 1) * DB_SET + DB_V);
    unsigned* SELW = (unsigned*)SEL;
    LAS unsigned* sIdx = (LAS unsigned*)(F.lds + 90112) + wave * 1024;
    LAS float* sCoef = (LAS float*)F.lds + wave * 2048;
    LAS unsigned* sSort = sLT;
    const size_t tokb = t0 + wave * 16;
    unsigned cnts = 0u;
    v4u se_pf = *(const v4u*)(SELW + tokb * 256 + 4 * lane);
    for (int it = 0; it < 16; ++it) {
        const v4u se = se_pf;
        if (it < 15) se_pf = *(const v4u*)(SELW + (tokb + it + 1) * 256 + 4 * lane);
        const unsigned b0 = se.x >> 12, b1 = se.z >> 12;
        unsigned pos0 = 0u, pos1 = 0u, base = 0u, pk = 0u;
#pragma unroll
        for (unsigned k = 0; k < 4; ++k) {
            const unsigned long long m0 = __builtin_amdgcn_ballot_w64(b0 == k), m1 = __builtin_amdgcn_ballot_w64(b1 == k);
            const unsigned below = __builtin_amdgcn_mbcnt_hi((unsigned)(m0 >> 32), __builtin_amdgcn_mbcnt_lo((unsigned)m0, 0u)) + __builtin_amdgcn_mbcnt_hi((unsigned)(m1 >> 32), __builtin_amdgcn_mbcnt_lo((unsigned)m1, 0u));
            if (b0 == k) pos0 = base + below;
            if (b1 == k) pos1 = base + below + (b0 == k ? 1u : 0u);
            base += (unsigned)__builtin_popcountll(m0) + (unsigned)__builtin_popcountll(m1);
            if (k < 3) pk |= base << (8 * k);
        }
#ifdef DBG_NOSORT
        pos0 = 2 * lane; pos1 = 2 * lane + 1;
#endif
        *(LAS v2u*)(sSort + 2 * pos0) = (v2u){se.x, se.y}; *(LAS v2u*)(sSort + 2 * pos1) = (v2u){se.z, se.w};
        asm volatile("" ::: "memory");
        const v2u so0 = *(const LAS v2u*)(sSort + 4 * lane), so1 = *(const LAS v2u*)(sSort + 4 * lane + 2); const v4u so = (v4u){so0.x, so0.y, so1.x, so1.y};
        asm volatile("" ::: "memory");
        sIdx[it * 64 + lane] = (so0.x & 0xffffu) | (so1.x << 16);
        (void)so;
        { const unsigned g0 = so0.y, g1 = so1.y; sCoef[it * 128 + 2 * lane] = __uint_as_float(g0); sCoef[it * 128 + 2 * lane + 1] = __uint_as_float(g1); }
        if (lane == it) cnts = pk;
    }
    asm volatile("s_waitcnt vmcnt(0) lgkmcnt(0)" ::: "memory");
#ifdef DBG_NOBUCKET
    cnts = 0u;
#endif
#define PL_LOAD(RB, TAB, SE, BB) do { _Pragma("unroll") for (int _q = 0; _q < 16; ++_q) { \
        const unsigned _pw = (unsigned)__builtin_amdgcn_readlane((int)(SE), (BB) * 8 + (_q >> 1)); const unsigned _idx = (_q & 1) ? (_pw >> 16) : (_pw & 0xffffu); \
        (RB)[_q] = *(const v4u*)((TAB) + (size_t)_idx * 1024 + 16 * lane); } } while (0)
#define PL_LOAD_U(RB, SE, BB) do { const int _src = ((BB) * 8 + ((lane & 15) >> 1)) * 4; \
        const unsigned _ix = (unsigned)__builtin_amdgcn_ds_bpermute(_src, (int)(SE).x), _iz = (unsigned)__builtin_amdgcn_ds_bpermute(_src, (int)(SE).z); \
        const unsigned char* _p = U8 + (size_t)((lane & 1) ? _iz : _ix) * 1024 + 32 * (lane >> 4); \
        _Pragma("unroll") for (int _j = 0; _j < 16; ++_j) (RB)[_j] = *(const v4u*)(_p + 128 * (_j >> 1) + 16 * (_j & 1)); } while (0)
#define PL_RANGE(T, P, NP, RLO, RHI, BLO, BHI) const unsigned _pk##T = (unsigned)__builtin_amdgcn_readlane((int)cnts, (T)); \
        const int _sp##T = min((int)((((_pk##T >> 8) & 255u) + 15u) & ~15u), 128);     \
        const int RLO = (P) == 0 ? 0 : _sp##T, RHI = (P) == 0 ? _sp##T : 128; \
        const int BLO = min(RLO >> 4, 7), BHI = max((RHI + 15) >> 4, BLO + 1)
#define PL_RANGE4(T, P, RLO, RHI, BLO, BHI) const unsigned _pk##T = (unsigned)__builtin_amdgcn_readlane((int)cnts, (T)); \
        const int _s1##T = min((int)(((_pk##T & 255u) + 15u) & ~15u), 128), _s2##T = min((int)((((_pk##T >> 8) & 255u) + 15u) & ~15u), 128), _s3##T = min((int)((((_pk##T >> 16) & 255u) + 15u) & ~15u), 128); \
        const int RLO = (P) == 0 ? 0 : (P) == 1 ? _s1##T : (P) == 2 ? _s2##T : _s3##T, RHI = (P) == 0 ? _s1##T : (P) == 1 ? _s2##T : (P) == 2 ? _s3##T : 128; \
        const int BLO = min(RLO >> 4, 7), BHI = max((RHI + 15) >> 4, BLO + 1)
    v4u ra[16], rb[16];
#ifndef DBG_U0
#define DBG_U0 0
#define DBG_V0 0
#endif
#ifndef UPASS
#define UPASS 2
#endif
#if UPASS == 4
#define U_RANGE(T, P, RLO, RHI, BLO, BHI) PL_RANGE4(T, P, RLO, RHI, BLO, BHI)
#else
#define U_RANGE(T, P, RLO, RHI, BLO, BHI) PL_RANGE(T, P, 2, RLO, RHI, BLO, BHI)
#endif
    for (int ps = DBG_U0; ps < UPASS; ++ps) {
        int lt = 0, lb, lbh; { U_RANGE(lt, ps, r0, r1, b0_, b1_); lb = b0_; lbh = b1_; (void)r0; (void)r1; }
        unsigned seL = sIdx[lane];
        long xlo = 0, xhi = 0; const bool dsel = ((lane >> 2) & 3) == (lane >> 4); v4u nraw0, nraw1, nnx0 = *(const v4u*)(N2 + tokb * 1024 + 16 * lane), nnx1 = *(const v4u*)(N2 + tokb * 1024 + 16 * lane + 8);
        int ct, cb, crl = 0, crh = 0, cbl = 0;
#define U_ADV() do { ++lb; if (lb >= lbh) { ++lt; if (lt < 16) { U_RANGE(lt, ps, _r0, _r1, _b0, _b1); lb = _b0; lbh = _b1; (void)_r0; (void)_r1; seL = sIdx[lt * 64 + lane]; } } } while (0)
#define U_COMPUTE(RB) do { \
            if (cb == cbl) { nraw0 = nnx0; nraw1 = nnx1; if (ct + 1 < 16) { nnx0 = *(const v4u*)(N2 + (tokb + ct + 1) * 1024 + 16 * lane); nnx1 = *(const v4u*)(N2 + (tokb + ct + 1) * 1024 + 16 * lane + 8); } \
                f32x4 x0, x1, x2, x3; unpk8(nraw0, x0, x1); unpk8(nraw1, x2, x3); x0 = x0 * 16.f; x1 = x1 * 16.f; x2 = x2 * 16.f; x3 = x3 * 16.f; \
                int _w0 = 0, _w1 = 0, _w2 = 0, _w3 = 0; \
                _w0 = __builtin_amdgcn_cvt_pk_fp8_f32(x0.x, x0.y, _w0, false); _w0 = __builtin_amdgcn_cvt_pk_fp8_f32(x0.z, x0.w, _w0, true); \
                _w1 = __builtin_amdgcn_cvt_pk_fp8_f32(x1.x, x1.y, _w1, false); _w1 = __builtin_amdgcn_cvt_pk_fp8_f32(x1.z, x1.w, _w1, true); \
                _w2 = __builtin_amdgcn_cvt_pk_fp8_f32(x2.x, x2.y, _w2, false); _w2 = __builtin_amdgcn_cvt_pk_fp8_f32(x2.z, x2.w, _w2, true); \
                _w3 = __builtin_amdgcn_cvt_pk_fp8_f32(x3.x, x3.y, _w3, false); _w3 = __builtin_amdgcn_cvt_pk_fp8_f32(x3.z, x3.w, _w3, true); \
                xlo = (long)(((unsigned long long)(unsigned)_w1 << 32) | (unsigned)_w0); xhi = (long)(((unsigned long long)(unsigned)_w3 << 32) | (unsigned)_w2); } \
            _Pragma("unroll") for (int _g = 0; _g < 2; ++_g) { float _p[8]; \
                _Pragma("unroll") for (int _q = 0; _q < 8; ++_q) { f32x4 _d = (f32x4){0.f, 0.f, 0.f, 0.f}; \
                    _d = __builtin_amdgcn_mfma_f32_16x16x32_fp8_fp8((long)(((unsigned long long)(RB)[8 * _g + _q].y << 32) | (RB)[8 * _g + _q].x), xlo, _d, 0, 0, 0); \
                    _d = __builtin_amdgcn_mfma_f32_16x16x32_fp8_fp8((long)(((unsigned long long)(RB)[8 * _g + _q].w << 32) | (RB)[8 * _g + _q].z), xhi, _d, 0, 0, 0); \
                    const float _sl = (lane & 2) ? ((lane & 1) ? _d.w : _d.z) : ((lane & 1) ? _d.y : _d.x); \
                    _p[_q] = dsel ? _sl : 0.f; }     \
                const float _s0 = swap32_add(_p[0], _p[4]), _s1 = swap32_add(_p[1], _p[5]), _s2 = swap32_add(_p[2], _p[6]), _s3 = swap32_add(_p[3], _p[7]); \
                float _t0 = row_sum16(swap16_add(_s0, _s2)), _t1 = row_sum16(swap16_add(_s1, _s3)); \
                _t0 = fgelu(_t0 * (1.f / 4096.f)) * (1.f / 64.f); _t1 = fgelu(_t1 * (1.f / 4096.f)) * (1.f / 64.f); \
                if ((lane & 15) == 0) { const int _r = lane >> 4, _e = cb * 16 + 8 * _g + 2 * (_r & 1) + 4 * (_r >> 1); LAS float* _c = sCoef + ct * 128 + _e; \
                    if (_e >= crl && _e < crh) _c[0] *= _t0; if (_e + 1 >= crl && _e + 1 < crh) _c[1] *= _t1; } } } while (0)
#define U_SETC() do { ct = lt; cb = lb; { U_RANGE(ct, ps, _r0, _r1, _b0, _b1); crl = _r0; crh = _r1; cbl = _b0; (void)_b1; } } while (0)
        PL_LOAD(ra, U8, seL, lb);
        U_SETC(); U_ADV();
        for (;;) {
            if (lt < 16) PL_LOAD(rb, U8, seL, lb);
            U_COMPUTE(ra);
            if (lt >= 16) break;
            U_SETC(); U_ADV();
            if (lt < 16) PL_LOAD(ra, U8, seL, lb);
            U_COMPUTE(rb);
            if (lt >= 16) break;
            U_SETC(); U_ADV();
        }
        asm volatile("s_waitcnt lgkmcnt(0)" ::: "memory");
        __syncthreads();
    }
#undef U_ADV
#undef U_COMPUTE
#undef U_SETC
#ifndef VPASS
#define VPASS 2
#endif
#if VPASS == 4
#define V_RANGE(T, P, RLO, RHI, BLO, BHI) PL_RANGE4(T, P, RLO, RHI, BLO, BHI)
#else
#define V_RANGE(T, P, RLO, RHI, BLO, BHI) PL_RANGE(T, P, 2, RLO, RHI, BLO, BHI)
#endif
    for (int ps = DBG_V0; ps < VPASS; ++ps) {
        int lt = 0, lb, lbh; { V_RANGE(lt, ps, r0, r1, b0_, b1_); lb = b0_; lbh = b1_; (void)r0; (void)r1; }
        unsigned seL = sIdx[lane];
        f32x2 out[8]; f32x4 hpre[4] = {(f32x4){0.f, 0.f, 0.f, 0.f}, (f32x4){0.f, 0.f, 0.f, 0.f}, (f32x4){0.f, 0.f, 0.f, 0.f}, (f32x4){0.f, 0.f, 0.f, 0.f}}, ac4[4]; v4u gpre[2] = {(v4u){0u, 0u, 0u, 0u}, (v4u){0u, 0u, 0u, 0u}}; const bf16* PWG = (const bf16*)(F.ws + WS_PW);
        const unsigned vmask = ((lane >> 4) == ((lane & 15) >> 2)) ? (0xFFu << (8 * (lane & 3))) : 0u;
        int ct, cb, crl = 0, crh = 0, cbl = 0, cbh = 0;
#define V_ADV() do { ++lb; if (lb >= lbh) { ++lt; if (lt < 16) { V_RANGE(lt, ps, _r0, _r1, _b0, _b1); lb = _b0; lbh = _b1; (void)_r0; (void)_r1; seL = sIdx[lt * 64 + lane]; } } } while (0)
#define V_SETC() do { ct = lt; cb = lb; { V_RANGE(ct, ps, _r0, _r1, _b0, _b1); crl = _r0; crh = _r1; cbl = _b0; cbh = _b1; } } while (0)
#ifndef REP_LV
#define REP_LV 1
#endif
#define V_COMPUTE(RB) do { \
            if (cb == cbl) { _Pragma("unroll") for (int _i = 0; _i < 4; ++_i) { ac4[_i] = (f32x4){0.f, 0.f, 0.f, 0.f}; if (ps == VPASS - 1) hpre[_i] = *(const f32x4*)(F.h + (tokb + ct) * 1024 + 16 * lane + 4 * _i); } \
                gpre[0] = *(const v4u*)(PWG + (tokb + ct) * 1024 + 16 * lane); gpre[1] = *(const v4u*)(PWG + (tokb + ct) * 1024 + 16 * lane + 8); }     \
            _Pragma("unroll") for (int _q = 0; _q < 16; ++_q) { const int _e = cb * 16 + _q; \
                float _c = sCoef[ct * 128 + _e]; _c = (_e >= crl && _e < crh) ? _c * 2048.f : 0.f; \
                int _w = __builtin_amdgcn_cvt_pk_fp8_f32(_c, _c, 0, false); _w = __builtin_amdgcn_cvt_pk_fp8_f32(_c, _c, _w, true); const unsigned _x = (unsigned)_w & vmask; \
                const long _ae = (long)(unsigned long long)_x, _ao = (long)((unsigned long long)_x << 32); \
                const long _bl = (long)(((unsigned long long)(RB)[_q].y << 32) | (RB)[_q].x), _bh = (long)(((unsigned long long)(RB)[_q].w << 32) | (RB)[_q].z); \
                ac4[0] = __builtin_amdgcn_mfma_f32_16x16x32_fp8_fp8(_ae, _bl, ac4[0], 0, 0, 0); ac4[1] = __builtin_amdgcn_mfma_f32_16x16x32_fp8_fp8(_ao, _bl, ac4[1], 0, 0, 0); \
                ac4[2] = __builtin_amdgcn_mfma_f32_16x16x32_fp8_fp8(_ae, _bh, ac4[2], 0, 0, 0); ac4[3] = __builtin_amdgcn_mfma_f32_16x16x32_fp8_fp8(_ao, _bh, ac4[3], 0, 0, 0); } \
            if (cb == cbh - 1) { _Pragma("unroll") for (int _i = 0; _i < 4; ++_i) { out[2 * _i] = (f32x2){ac4[_i].x, ac4[_i].y} * (1.f / 2048.f); out[2 * _i + 1] = (f32x2){ac4[_i].z, ac4[_i].w} * (1.f / 2048.f); } \
                peer_token_end(F, a, layer, last, ps == VPASS - 1, tokb + ct, lane, out, hpre, gpre); } } while (0)
        PL_LOAD(ra, V8, seL, lb);
        V_SETC(); V_ADV();
        for (;;) {
            if (lt < 16) PL_LOAD(rb, V8, seL, lb);
            V_COMPUTE(ra);
            if (lt >= 16) break;
            V_SETC(); V_ADV();
            if (lt < 16) PL_LOAD(ra, V8, seL, lb);
            V_COMPUTE(rb);
            if (lt >= 16) break;
            V_SETC(); V_ADV();
        }
        asm volatile("s_waitcnt vmcnt(0)" ::: "memory");
        __syncthreads();
    }
#undef V_ADV
#undef V_SETC
#undef V_COMPUTE
#undef PL_LOAD
#undef PL_RANGE
}


#ifndef ZSKIP
#define ZSKIP 0
#endif
#ifndef ZGA_ALIGN
#define ZGA_ALIGN true
#endif
#ifndef ZGA_SP2
#define ZGA_SP2 true
#endif
#ifndef WIN_ALIGN
#define WIN_ALIGN true
#endif
#ifndef WIN_SP2
#define WIN_SP2 true
#endif
#ifndef REP_E
#define REP_E 1
#endif
#ifndef REP_A
#define REP_A 1
#endif
#ifndef REP_B
#define REP_B 1
#endif
#ifndef REP_C
#define REP_C 1
#endif
#ifndef REP_D
#define REP_D 1
#endif
#ifndef REP_G
#define REP_G 1
#endif
#ifndef REP_I
#define REP_I 1
#endif
#ifndef REP_K
#define REP_K 1
#endif
__global__ void __launch_bounds__(NWAVES * 64, 2) trunk_fwd(Args args) {
    extern __shared__ __attribute__((aligned(16))) unsigned char lds[];
    Frame F;
    F.lds = (LAS unsigned char*)lds;
    F.tid = threadIdx.x; F.lane = F.tid & 63; F.wave = __builtin_amdgcn_readfirstlane(F.tid >> 6); F.wave0 = F.wave;
    F.G = gridDim.x; F.bx = blockIdx.x; F.ws = (GAS unsigned char*)args.ws; F.h = args.out;
    volatile LAS unsigned* MISC = (volatile LAS unsigned*)(F.lds + MISC_OFF);
    for (int u = F.tid; u < (LDS_BYTES - LDSCTL_OFF) / 4; u += NWAVES * 64) ((LAS unsigned*)(F.lds + LDSCTL_OFF))[u] = 0u;
    __syncthreads();
    unsigned* ctl = (unsigned*)(F.ws + WS_CTL);
    XcdBarrier bar = xcd_barrier_post(ctl + CW_BAR, MISC + 8);
    GAS unsigned char* ws = F.ws;
    LAS unsigned char* ring = (LAS unsigned char*)F.lds;

    for (int rep = 0; rep < REP_A; ++rep) { prep_phase(F, args, 0, F.bx, F.G, 1);
    xcd_barrier(bar, F.wave0); }
#define OPQ() GAS unsigned char* ws = F.ws; asm volatile("" : "+s"(ws)); GAS unsigned char* db = ws + WS_DB + (size_t)(layer & 1) * DB_SET; (void)db
    for (int layer = 0; layer < DEPTH; ++layer) {
        {   OPQ();
        for (int rep = 0; rep < REP_B; ++rep) {   if (rep) xcd_barrier(bar, F.wave0); pg8::Gemm g{(const bf16*)(ws + WS_NX), (const bf16*)(ws + WS_WIN), T, NZ - 256 * ZSPLIT, 2048, 1024, 16}; pg8::StaticOrder S; S.init(T, NZ - 256 * ZSPLIT, F.G, F.bx);
            pg8::EpiZ E{(bf16*)(ws + WS_ZRKV), (bf16*)(ws + WS_ZL), (bf16*)(ws + WS_GUV), (bf16*)(ws + WS_SG), layer == 0 ? (bf16*)(ws + WS_VF) : (bf16*)nullptr, 0};
            pg8::gemm_phase<pg8::EpiZ, pg8::StaticOrder, WIN_ALIGN, WIN_SP2>(ring, g, S, E, F.wave0); }
        }
        xcd_barrier(bar, F.wave0);
        {   OPQ();
        for (int rep = 0; rep < REP_C; ++rep) {   if (rep) xcd_barrier(bar, F.wave0); { pg8::Gemm g{(const bf16*)(ws + WS_ZL), (const bf16*)(ws + WS_LORA + (size_t)layer * LORA_BYTES), T, 2048, 128, 512}; pg8::StaticOrder S; S.init(T, 2048, F.G, F.bx);
            pg8::EpiLora E{(bf16*)(ws + WS_EW), (size_t)(WS_AR - WS_EW) / 2, args.in[6] + (size_t)layer * 1024, args.in[8] + (size_t)layer * 1024, 0};
            pg8::gemm_phase<pg8::EpiLora, pg8::StaticOrder, true, true>(ring, g, S, E, F.wave0); }
            { pg8::Gemm g{(const bf16*)(ws + WS_ZL) + 128, (const bf16*)(ws + WS_LORA + (size_t)layer * LORA_BYTES) + 2048 * 128, T, 1024, 128, 512}; pg8::StaticOrder S; S.init(T, 1024, F.G, F.bx);
            pg8::EpiLora E{(bf16*)(ws + WS_EW), (size_t)(WS_AR - WS_EW) / 2, args.in[6] + (size_t)layer * 1024, args.in[8] + (size_t)layer * 1024, 8};
            pg8::gemm_phase<pg8::EpiLora, pg8::StaticOrder, true, true>(ring, g, S, E, F.wave0); } }
        if (layer > 0) {
            pg8::Gemm g{(const bf16*)(ws + WS_ZL) + 256, (const bf16*)(ws + WS_MV + (size_t)(layer - 1) * MV_BYTES), T, 1024, 128, 512}; pg8::StaticOrder S; S.init(T, 1024, F.G, F.bx);
            pg8::EpiMv E{(bf16*)(ws + WS_ZRKV), (const bf16*)(ws + WS_VF), args.in[18] + (size_t)(layer - 1) * 1024};
            pg8::gemm_phase<pg8::EpiMv, pg8::StaticOrder, true, true>(ring, g, S, E, F.wave0); }
        }
        xcd_barrier(bar, F.wave0);
        {   OPQ();
        for (int rep = 0; rep < REP_D; ++rep) {   if (rep) xcd_barrier(bar, F.wave0); const int nsb = F.G / 2, nob = F.G - nsb;
            if (F.bx < nsb) { for (int u = F.bx; u < NB * 16; u += nsb) scan_unit(F, args, layer, u); }
            else { const int ob = F.bx - nsb;
                for (int pm = ob; pm < T / 256; pm += nob)
                    for (int rep2 = 0; rep2 < REP_E; ++rep2) { gmlp_unit(F, args, layer, 2 * pm); gmlp_unit(F, args, layer, 2 * pm + 1); }
                asm volatile("s_waitcnt vmcnt(0)" ::: "memory"); __syncthreads();
                {
                    pg8::Gemm g{(const bf16*)(ws + WS_GUV), (const bf16*)(db + DB_PBT), T, 1024, 1024, 2048}; pg8::PanelOrder S{ob, nob, T / 256, 4, 0};
                    pg8::EpiMerge<false> E{(const bf16*)(ws + WS_SG), (bf16*)(ws + WS_GUV) + 1024, (bf16*)nullptr};
                    pg8::gemm_phase<pg8::EpiMerge<false>, pg8::PanelOrder, true, true>(ring, g, S, E, F.wave0); }
                {
                    pg8::Gemm g{(const bf16*)(ws + WS_NX), (const bf16*)(ws + WS_WINB + (size_t)(layer & 1) * WINB_BYTES), T, 256 * ZSPLIT, 2048, 1024, 16}; pg8::StaticOrder S; S.init(T, 256 * ZSPLIT, nob, ob);
                    pg8::EpiZ E{(bf16*)(ws + WS_ZRKV), (bf16*)(ws + WS_ZL), (bf16*)(ws + WS_GUV), (bf16*)(ws + WS_SG), (bf16*)nullptr, 30 - ZSPLIT};
                    pg8::gemm_phase<pg8::EpiZ, pg8::StaticOrder, true, true>(ring, g, S, E, F.wave0); }
                {   pg8::Gemm g{(const bf16*)(db + DB_PB), (const bf16*)(db + DB_PLEW), T, 1024, 256, 256}; pg8::StaticOrder S; S.init(T, 1024, nob, ob);
                    pg8::EpiPlain E{(bf16*)(ws + WS_PW), 1024};
                    pg8::gemm_phase<pg8::EpiPlain, pg8::StaticOrder, true, true>(ring, g, S, E, F.wave0); }
                if (layer == 0) prep_phase(F, args, 0, ob, nob, 2);
                if (layer + 1 < DEPTH) prep_phase(F, args, layer + 1, ob, nob, 3); } }
        }
        xcd_barrier(bar, F.wave0);
        {   OPQ();
        for (int rep = 0; rep < REP_G; ++rep) {   if (rep) xcd_barrier(bar, F.wave0); pg8::Gemm g{(const bf16*)(ws + WS_G), (const bf16*)(db + DB_PA), T, 1024, 1024, 1024}; pg8::StaticOrder S; S.init(T, 1024, F.G, F.bx);
            pg8::EpiMerge<true> E{(const bf16*)(ws + WS_SG), (bf16*)(ws + WS_GUV) + 1024, (bf16*)(ws + WS_MG)};
            pg8::gemm_phase<pg8::EpiMerge<true>, pg8::StaticOrder, true, true>(ring, g, S, E, F.wave0); }
        }
        xcd_barrier(bar, F.wave0);
        {   OPQ();
        {   pg8::Gemm g{(const bf16*)(ws + WS_MG), (const bf16*)(db + DB_POUT), T, 1024, 1024, 1024}; pg8::StaticOrder S; S.init(T, 1024, F.G, F.bx);
            pg8::EpiResid E{F.h};
            pg8::gemm_phase<pg8::EpiResid, pg8::StaticOrder, true, true>(ring, g, S, E, F.wave0); }
        }
        xcd_barrier(bar, F.wave0);
        {   OPQ();
        for (int rep = 0; rep < REP_I; ++rep) {   if (rep) xcd_barrier(bar, F.wave0); phase_ids(F); const int gw = F.bx * NWAVES + F.wave, NGW = F.G * NWAVES; const float* g2 = args.in[3] + (size_t)layer * 1024;
            for (int m = gw; m < T / 2; m += NGW) norm_row_n2x2(F.h + (size_t)m * D, F.h + (size_t)(m + T / 2) * D, g2, (bf16*)(ws + WS_N2) + (size_t)m * D, (bf16*)(ws + WS_N2) + (size_t)(m + T / 2) * D, F.lane); }
        }
        xcd_barrier(bar, F.wave0);
        {   OPQ();
        {   pg8::Gemm g{(const bf16*)(ws + WS_N2), (const bf16*)(db + DB_WQG), T, 3072, 1024, 1024}; pg8::StaticOrder S; S.init(T, 3072, F.G, F.bx);
            pg8::EpiQG E{(bf16*)(ws + WS_Q), (bf16*)(ws + WS_PW), F.h};
            pg8::gemm_phase<pg8::EpiQG, pg8::StaticOrder, true, true>(ring, g, S, E, F.wave0); }
        }
        xcd_barrier(bar, F.wave0);
        {   OPQ();
        for (int u = F.bx; u < T / 128; u += F.G) peer_unit(F, args, layer, u, layer == DEPTH - 1);
        }
        if (layer + 1 < DEPTH) xcd_barrier(bar, F.wave0);
    }
}

extern "C" void kernel_launch(void* const* d_in, const int* in_sizes, int n_in, void* d_out, int out_size, void* d_ws, size_t ws_size, hipStream_t stream) {
    static int grid = 0;
    if (grid == 0) {
        if (n_in != 32 || out_size != T * D || ws_size < WS_END) { fprintf(stderr, "kernel_launch: unexpected sizes n_in %d out %d ws %zu (need %zu); nothing launched\n", n_in, out_size, ws_size, (size_t)WS_END); grid = -1; return; }
        int dev = 0, cus = 0, per_cu = 0;
        if (hipGetDevice(&dev) != hipSuccess || hipDeviceGetAttribute(&cus, hipDeviceAttributeMultiprocessorCount, dev) != hipSuccess) { grid = -1; return; }
        if (hipFuncSetAttribute((const void*)trunk_fwd, hipFuncAttributeMaxDynamicSharedMemorySize, LDS_BYTES) != hipSuccess) { fprintf(stderr, "kernel_launch: hipFuncSetAttribute failed\n"); grid = -1; return; }
        if (hipOccupancyMaxActiveBlocksPerMultiprocessor(&per_cu, (const void*)trunk_fwd, NWAVES * 64, LDS_BYTES) != hipSuccess || per_cu < 1)
            fprintf(stderr, "kernel_launch: note: occupancy query reports %d workgroups per CU\n", per_cu);
        (void)hipGetLastError();
        grid = cus;
    }
    if (grid < 0) return;
    (void)hipMemsetAsync((char*)d_ws + WS_CTL, 0, ZERO_BYTES, stream);
    (void)hipMemsetAsync((char*)d_ws + WIN_ZERO_OFF, 0, WIN_ZERO_BYTES, stream);
    Args a{};
    for (int i = 0; i < 32; ++i) a.in[i] = (const float*)d_in[i];
    a.out = (float*)d_out; a.ws = (unsigned char*)d_ws;
    hipLaunchKernelGGL(trunk_fwd, dim3(grid), dim3(NWAVES * 64), LDS_BYTES, stream, a);
    const hipError_t le = hipPeekAtLastError();
    if (le != hipSuccess) fprintf(stderr, "kernel_launch: launch failed: %s\n", hipGetErrorName(le));
}
```

```cpp
#include <hip/hip_runtime.h>
#include <cstdio>
#include <cstdint>
#define ZSPLIT 4
#define UPASS 4
#define VPASS 4
namespace pg8 {
#define PG8_LAS __attribute__((address_space(3)))
typedef unsigned short bf16_t;
typedef short bf16x8 __attribute__((ext_vector_type(8)));
typedef float f32x4 __attribute__((ext_vector_type(4)));
typedef unsigned u32x4 __attribute__((ext_vector_type(4)));
constexpr int BM = 256, BK = 64, HALF = 128, HTB = HALF * BK * 2  , STAGE_BYTES = 8 * HTB, NXCD = 8, WGM = 8;

__host__ __device__ __forceinline__ int lds_byte(int r, int c) { const int st = (r >> 4) * 2 + (c >> 5), rr = r & 15, cc = c & 31, ob = rr * 64 + cc * 2; return st * 1024 + (ob ^ (((ob >> 9) & 1) << 5)); }
__host__ __device__ __forceinline__ void stage_rc(int b, int& R, int& C) { const int st = b / 1024, sb = b % 1024, swz = sb ^ (((sb >> 9) & 1) << 5); R = (st >> 1) * 16 + swz / 64; C = (st & 1) * 32 + (swz % 64) / 2; }
__host__ __device__ __forceinline__ int perm32(int rho) { const int n = rho >> 4, i = rho & 15; return 8 * (i >> 2) + 4 * n + (i & 3); }

struct Unit { int pm, pn; };
struct Gemm { const bf16_t* A; const bf16_t* Bt; int M, N, K, lda; int abatch; };

struct StaticOrder {
    int nM, nN, nwg, G, c;
    __host__ __device__ void init(int M, int N, int G_, int c_) { nM = M / BM; nN = N / BM; nwg = nM * nN; G = G_; c = c_; }
    __host__ __device__ bool next(int i, Unit& u) const {
        const long L = (long)i * G + c; if (L >= nwg) return false;
        int wgid = (int)L; { const int q = nwg / NXCD, r = nwg % NXCD, xcd = wgid % NXCD, off = wgid / NXCD; wgid = (xcd < r ? xcd * (q + 1) : r * (q + 1) + (xcd - r) * q) + off; }
        const int nig = WGM * nN, gid = wgid / nig, fm = gid * WGM, gsz = (nM - fm) < WGM ? (nM - fm) : WGM;
        u.pm = fm + ((wgid % nig) % gsz); u.pn = (wgid % nig) / gsz; return true;
    }
    __device__ __forceinline__ void a_ready(const Unit&) const {}
    __device__ __forceinline__ void done(const Unit&) const {}
};
struct PanelOrder {
    int first, stride, nM, nN, pn0;
    __host__ __device__ bool next(int i, Unit& u) const { const int p = first + (i / nN) * stride; if (p >= nM) return false; u.pm = p; u.pn = pn0 + i % nN; return true; }
    __device__ __forceinline__ void a_ready(const Unit&) const {}
    __device__ __forceinline__ void done(const Unit&) const {}
};
__device__ __forceinline__ unsigned cvt_pk_bf16(float lo, float hi) { unsigned r; asm volatile("v_cvt_pk_bf16_f32 %0, %1, %2" : "=v"(r) : "v"(lo), "v"(hi)); return r; }

__device__ __forceinline__ float fsig(float x) { return __builtin_amdgcn_rcpf(1.f + __builtin_amdgcn_exp2f(-1.44269504f * x)); }
__device__ __forceinline__ float fgelu(float x) { return x * fsig(1.5957691216f * (x + 0.044715f * x * x * x)); }
__device__ __forceinline__ float bflo(unsigned w) { return __builtin_bit_cast(float, w << 16); }
__device__ __forceinline__ float bfhi(unsigned w) { return __builtin_bit_cast(float, w & 0xffff0000u); }
__device__ __forceinline__ void unpk8(const u32x4 w, f32x4& a, f32x4& b) { a = (f32x4){bflo(w.x), bfhi(w.x), bflo(w.y), bfhi(w.y)}; b = (f32x4){bflo(w.z), bfhi(w.z), bflo(w.w), bfhi(w.w)}; }
__device__ __forceinline__ u32x4 pk8(const f32x4 a, const f32x4 b) { u32x4 w; w.x = cvt_pk_bf16(a[0], a[1]); w.y = cvt_pk_bf16(a[2], a[3]); w.z = cvt_pk_bf16(b[0], b[1]); w.w = cvt_pk_bf16(b[2], b[3]); return w; }
__device__ __forceinline__ f32x4 act4(f32x4 v, int kind) {
    if (kind == 1) { v = (f32x4){fgelu(v[0]), fgelu(v[1]), fgelu(v[2]), fgelu(v[3])}; }
    else if (kind == 2) { v = (f32x4){fsig(v[0]), fsig(v[1]), fsig(v[2]), fsig(v[3])}; }
    else if (kind == 3) { v = (f32x4){2.f * fsig(2.f * v[0]) - 1.f, 2.f * fsig(2.f * v[1]) - 1.f, 2.f * fsig(2.f * v[2]) - 1.f, 2.f * fsig(2.f * v[3]) - 1.f}; }
    return v;
}
#define EPI_ROWS_BEGIN _Pragma("unroll") for (int ai = 0; ai < 2; ++ai) _Pragma("unroll") for (int m = 0; m < 4; ++m) { const size_t row = (size_t)(row0 + ai * HALF + m * 16);
#define EPI_ROWS_END }

struct EpiZ {
    static constexpr bool PERM = true, AFTER_DRAIN = false;
    bf16_t *zrkv, *zl, *guv, *sg, *vf; int pnoff;
    __device__ __forceinline__ void operator()(const f32x4 (&acc)[2][2][4][2], const Unit& u, int wr, int wc, int fr, int fq) const {
        const int pn = u.pn + pnoff, row0 = u.pm * BM + wr * 64 + fr;
        bf16_t* dst; int ld, colt, k0, k1;
        if (pn < 12)       { dst = zrkv; ld = 3072; colt = pn * 256;        k0 = 0; k1 = 0; }
        else if (pn == 12) { dst = zl;   ld = 512;  colt = 0;               k0 = (wc < 2) ? 3 : 0; k1 = 2; }
        else if (pn == 13) { dst = zl;   ld = 512;  colt = 256;             k0 = 0; k1 = 0; }
        else if (pn < 22)  { dst = guv;  ld = 2048; colt = (pn - 14) * 256; k0 = 1; k1 = 1; }
        else               { dst = sg;   ld = 2048; colt = ((pn - 18) & 7) * 256; k0 = 2; k1 = 2; }
        const int col0 = colt + wc * 32 + 8 * fq;
        const bool dovf = (vf != nullptr) && pn >= 8 && pn < 12;
        const int vcol0 = (pn - 8) * 256 + wc * 32 + 8 * fq;
        EPI_ROWS_BEGIN
            bf16_t* rowp = dst + row * ld + col0;
#pragma unroll
            for (int bj = 0; bj < 2; ++bj) { const int kind = bj ? k1 : k0;
                const u32x4 w = pk8(act4(acc[ai][bj][m][0], kind), act4(acc[ai][bj][m][1], kind));
                *(u32x4*)(rowp + bj * HALF) = w;
                if (dovf) *(u32x4*)(vf + row * 1024 + vcol0 + bj * HALF) = w; }
        EPI_ROWS_END
    }
};
struct EpiLora {
    static constexpr bool PERM = true, AFTER_DRAIN = false;
    bf16_t* ew; size_t stride; const float *w0, *a0; int pnoff;
    __device__ __forceinline__ void operator()(const f32x4 (&acc)[2][2][4][2], const Unit& u, int wr, int wc, int fr, int fq) const {
        const int pn = u.pn + pnoff, sel = pn >> 2, row0 = u.pm * BM + wr * 64 + fr, col0 = (pn & 3) * 256 + wc * 32 + 8 * fq;
        bf16_t* dst = ew + (size_t)sel * stride;
        const float* bp = sel == 0 ? w0 : a0;
        f32x4 bv[2][2];
#pragma unroll
        for (int bj = 0; bj < 2; ++bj)
#pragma unroll
            for (int n = 0; n < 2; ++n) bv[bj][n] = (sel < 2) ? *(const f32x4*)(bp + col0 + bj * HALF + 4 * n) : (f32x4){0.f, 0.f, 0.f, 0.f};
        EPI_ROWS_BEGIN
            bf16_t* rowp = dst + row * 1024 + col0;
#pragma unroll
            for (int bj = 0; bj < 2; ++bj) { f32x4 v0 = acc[ai][bj][m][0] + bv[bj][0], v1 = acc[ai][bj][m][1] + bv[bj][1];
                if (sel < 2) { v0 = act4(v0, 2); v1 = act4(v1, 2); }
                if (sel == 0) { v0 = v0 * 0.60653066f; v1 = v1 * 0.60653066f; }
                *(u32x4*)(rowp + bj * HALF) = pk8(v0, v1); }
        EPI_ROWS_END
    }
};
struct EpiMv {
    static constexpr bool PERM = true, AFTER_DRAIN = false;
    bf16_t* zrkv; const bf16_t* vf; const float* v0b;
    __device__ __forceinline__ void operator()(const f32x4 (&acc)[2][2][4][2], const Unit& u, int wr, int wc, int fr, int fq) const {
        const int row0 = u.pm * BM + wr * 64 + fr, col0 = u.pn * 256 + wc * 32 + 8 * fq;
        f32x4 bv[2][2];
#pragma unroll
        for (int bj = 0; bj < 2; ++bj)
#pragma unroll
            for (int n = 0; n < 2; ++n) bv[bj][n] = *(const f32x4*)(v0b + col0 + bj * HALF + 4 * n);
        EPI_ROWS_BEGIN
#pragma unroll
            for (int bj = 0; bj < 2; ++bj) { bf16_t* zp = zrkv + row * 3072 + 2048 + col0 + bj * HALF;
                f32x4 z0, z1, f0, f1; unpk8(*(const u32x4*)zp, z0, z1); unpk8(*(const u32x4*)(vf + row * 1024 + col0 + bj * HALF), f0, f1);
                const f32x4 m0 = act4(acc[ai][bj][m][0] + bv[bj][0], 2), m1 = act4(acc[ai][bj][m][1] + bv[bj][1], 2);
                *(u32x4*)zp = pk8(z0 + (f0 - z0) * m0, z1 + (f1 - z1) * m1); }
        EPI_ROWS_END
    }
};
struct EpiPlain {
    static constexpr bool PERM = true, AFTER_DRAIN = false;
    bf16_t* o; int ld;
    __device__ __forceinline__ void operator()(const f32x4 (&acc)[2][2][4][2], const Unit& u, int wr, int wc, int fr, int fq) const {
        const int row0 = u.pm * BM + wr * 64 + fr, col0 = u.pn * 256 + wc * 32 + 8 * fq;
        EPI_ROWS_BEGIN
#pragma unroll
            for (int bj = 0; bj < 2; ++bj) *(u32x4*)(o + row * ld + col0 + bj * HALF) = pk8(acc[ai][bj][m][0], acc[ai][bj][m][1]);
        EPI_ROWS_END
    }
};
template <bool SECOND> struct EpiMerge {
    static constexpr bool PERM = true, AFTER_DRAIN = false;
    const bf16_t* sg; bf16_t* m2; bf16_t* o;
    __device__ __forceinline__ void operator()(const f32x4 (&acc)[2][2][4][2], const Unit& u, int wr, int wc, int fr, int fq) const {
        const int row0 = u.pm * BM + wr * 64 + fr, col0 = u.pn * 256 + wc * 32 + 8 * fq;
#pragma unroll
        for (int ai = 0; ai < 2; ++ai) { u32x4 gv[4][2], pv[4][2];
#pragma unroll
            for (int m = 0; m < 4; ++m) { const size_t row = (size_t)(row0 + ai * HALF + m * 16);
#pragma unroll
                for (int bj = 0; bj < 2; ++bj) { const int c = col0 + bj * HALF; gv[m][bj] = *(const u32x4*)(sg + row * 2048 + (SECOND ? 0 : 1024) + c);
                    if (SECOND) pv[m][bj] = *(const u32x4*)(m2 + row * 2048 + c); } }
#pragma unroll
            for (int m = 0; m < 4; ++m) { const size_t row = (size_t)(row0 + ai * HALF + m * 16);
#pragma unroll
                for (int bj = 0; bj < 2; ++bj) { const int c = col0 + bj * HALF;
                    f32x4 g0, g1; unpk8(gv[m][bj], g0, g1);
                    f32x4 v0 = g0 * acc[ai][bj][m][0], v1 = g1 * acc[ai][bj][m][1];
                    if (SECOND) { f32x4 p0, p1; unpk8(pv[m][bj], p0, p1); v0 = v0 + p0; v1 = v1 + p1; *(u32x4*)(o + row * 1024 + c) = pk8(v0, v1); }
                    else *(u32x4*)(m2 + row * 2048 + c) = pk8(v0, v1); } } }
    }
};
struct EpiResid {
    static constexpr bool PERM = false, AFTER_DRAIN = false;
    float* h;
    __device__ __forceinline__ void operator()(const f32x4 (&acc)[2][2][4][2], const Unit& u, int wr, int wc, int fr, int fq) const {
        const int row0 = u.pm * BM + wr * 64 + fr, col0 = u.pn * 256 + wc * 32 + 4 * fq;
#pragma unroll
        for (int ai = 0; ai < 2; ++ai) { f32x4 hv[4][2][2];
#pragma unroll
            for (int m = 0; m < 4; ++m) { const float* rowp = h + (size_t)(row0 + ai * HALF + m * 16) * 1024 + col0;
#pragma unroll
                for (int bj = 0; bj < 2; ++bj)
#pragma unroll
                    for (int n = 0; n < 2; ++n) hv[m][bj][n] = *(const f32x4*)(rowp + bj * HALF + n * 16); }
#pragma unroll
            for (int m = 0; m < 4; ++m) { float* rowp = h + (size_t)(row0 + ai * HALF + m * 16) * 1024 + col0;
#pragma unroll
                for (int bj = 0; bj < 2; ++bj)
#pragma unroll
                    for (int n = 0; n < 2; ++n) *(f32x4*)(rowp + bj * HALF + n * 16) = hv[m][bj][n] + acc[ai][bj][m][n]; } }
    }
};
struct EpiQG {
    static constexpr bool PERM = true, AFTER_DRAIN = false;
    bf16_t* q; bf16_t* pw; float* h;
    __device__ __forceinline__ void operator()(const f32x4 (&acc)[2][2][4][2], const Unit& u, int wr, int wc, int fr, int fq) const {
        const int row0 = u.pm * BM + wr * 64 + fr;
        if (u.pn < 8) { const int col0 = u.pn * 256 + wc * 32 + 8 * fq;
            EPI_ROWS_BEGIN
#pragma unroll
                for (int bj = 0; bj < 2; ++bj) *(u32x4*)(q + row * 2048 + col0 + bj * HALF) = pk8(acc[ai][bj][m][0], acc[ai][bj][m][1]);
            EPI_ROWS_END
        } else { const int col0 = (u.pn - 8) * 256 + wc * 32 + 8 * fq;
#pragma unroll
            for (int ai = 0; ai < 2; ++ai)
#pragma unroll
            for (int mh = 0; mh < 2; ++mh) { u32x4 pwv[2][2];
#pragma unroll
                for (int m2_ = 0; m2_ < 2; ++m2_) { const size_t row = (size_t)(row0 + ai * HALF + (2 * mh + m2_) * 16);
#pragma unroll
                    for (int bj = 0; bj < 2; ++bj) { const int c = col0 + bj * HALF; pwv[m2_][bj] = *(const u32x4*)(pw + row * 1024 + c); } }
#pragma unroll
                for (int m2_ = 0; m2_ < 2; ++m2_) { const int m = 2 * mh + m2_; const size_t row = (size_t)(row0 + ai * HALF + m * 16);
#pragma unroll
                    for (int bj = 0; bj < 2; ++bj) { const int c = col0 + bj * HALF; f32x4 p0, p1; unpk8(pwv[m2_][bj], p0, p1);
                        *(u32x4*)(pw + row * 1024 + c) = pk8(p0 * act4(acc[ai][bj][m][0], 2), p1 * act4(acc[ai][bj][m][1], 2)); } } }
        }
    }
};
template <class Epi, class Sched, bool ALIGN_EPI = false, bool SP2 = false>
__device__ __forceinline__ void gemm_phase(PG8_LAS unsigned char* lds, const Gemm g, const Sched& S, const Epi& E, const int wave0) {
    int tidq; asm volatile("v_mbcnt_lo_u32_b32 %0, -1, 0\n\tv_mbcnt_hi_u32_b32 %0, -1, %0" : "=v"(tidq)); tidq += wave0 * 64;
    const int tid = tidq, wid = __builtin_amdgcn_readfirstlane(tid >> 6), lane = tid & 63, wr = wid >> 2, wc = wid & 3, fr = lane & 15, fq = lane >> 4;
    int Kq = g.K, ldaq = g.lda; const bf16_t* gA = g.A; const bf16_t* gB = g.Bt; asm volatile("" : "+s"(Kq), "+s"(ldaq), "+s"(gA), "+s"(gB));
    const int K = Kq, nt = K / BK;
    unsigned voffA[2], voffB[2];
#pragma unroll
    for (int i = 0; i < 2; ++i) { int R, C; stage_rc(tid * 16 + i * 8192, R, C); const int Rb = Epi::PERM ? ((R & ~31) + perm32(R & 31)) : R;
        voffA[i] = (unsigned)(R * ldaq + C) * 2u; voffB[i] = (unsigned)(Rb * K + C) * 2u; }
    const size_t kstep = (size_t)(BK * 2);
    const size_t hstepA = (size_t)HALF * ldaq * 2, hstepB = (size_t)HALF * K * 2;
    const size_t tstepA = 2 * hstepA, tstepB = 2 * hstepB;
    const unsigned ldsw = (unsigned)wid * 1024u;
    const int aoff = lds_byte(wr * 64 + fr, fq * 8), boff = lds_byte(wc * 32 + fr, fq * 8);
#define PG8_SA(b, h) (((b) * 2 + (h)) * HTB)
#define PG8_SB(b, h) ((4 + (b) * 2 + (h)) * HTB)
#define PG8_STAGE(bufoff, gbase, voff) do { _Pragma("unroll") for (int _i = 0; _i < 2; ++_i) \
        __builtin_amdgcn_global_load_lds((const unsigned*)((const char*)(gbase) + (voff)[_i]), (PG8_LAS unsigned*)(lds + (bufoff) + ldsw + _i * 8192), 16, 0, 0); } while (0)
#define PG8_LDA(dst, b, h) do { _Pragma("unroll") for (int m = 0; m < 4; ++m) _Pragma("unroll") for (int k = 0; k < 2; ++k) dst[m][k] = *(const PG8_LAS bf16x8*)(lds + PG8_SA(b, h) + aoff + m * 2048 + k * 1024); } while (0)
#define PG8_LDB(dst, b, h) do { _Pragma("unroll") for (int n = 0; n < 2; ++n) _Pragma("unroll") for (int k = 0; k < 2; ++k) dst[n][k] = *(const PG8_LAS bf16x8*)(lds + PG8_SB(b, h) + boff + n * 2048 + k * 1024); } while (0)
#define PG8_MMA(ai, bj, At, Bt) do { __builtin_amdgcn_s_setprio(1); _Pragma("unroll") for (int m = 0; m < 4; ++m) _Pragma("unroll") for (int n = 0; n < 2; ++n) _Pragma("unroll") for (int k = 0; k < 2; ++k) \
        acc[ai][bj][m][n] = __builtin_amdgcn_mfma_f32_16x16x32_bf16(Bt[n][k], At[m][k], acc[ai][bj][m][n], 0, 0, 0); __builtin_amdgcn_s_setprio(0); } while (0)
#define PG8_WAIT_V(n) asm volatile("s_waitcnt vmcnt(" #n ")" ::: "memory")
#define PG8_WAIT_L(n) asm volatile("s_waitcnt lgkmcnt(" #n ")" ::: "memory")
#define PG8_BAR __builtin_amdgcn_s_barrier()
#define PG8_SCHED __builtin_amdgcn_sched_barrier(0)
    Unit cur, nxt; int ui = 0;
    if (!S.next(0, cur)) return;
    f32x4 acc[2][2][4][2];
#pragma unroll
    for (int a = 0; a < 2; ++a)
#pragma unroll
        for (int b = 0; b < 2; ++b)
#pragma unroll
            for (int m = 0; m < 4; ++m)
#pragma unroll
                for (int n = 0; n < 2; ++n) acc[a][b][m][n] = (f32x4){0.f, 0.f, 0.f, 0.f};
    bf16x8 At[4][2], B0[2][2], B1[2][2];
    const size_t arow = g.abatch ? (size_t)ldaq * 2 : 0;
    const char* cA = (const char*)gA + (size_t)cur.pm * tstepA + (size_t)(cur.pm >> 4) * arow; const char* cB = (const char*)gB + (size_t)cur.pn * tstepB;
    S.a_ready(cur);
    if constexpr (SP2) {
        PG8_STAGE(PG8_SB(0, 0), cB, voffB); PG8_STAGE(PG8_SB(0, 1), cB + hstepB, voffB); PG8_STAGE(PG8_SA(0, 0), cA, voffA); PG8_STAGE(PG8_SA(0, 1), cA + hstepA, voffA);
        if (wr == 1) PG8_BAR;
        PG8_WAIT_V(2); PG8_BAR;
        PG8_STAGE(PG8_SB(1, 0), cB + kstep, voffB); PG8_STAGE(PG8_SA(1, 0), cA + kstep, voffA); PG8_STAGE(PG8_SB(1, 1), cB + hstepB + kstep, voffB);
        PG8_WAIT_V(6); PG8_BAR;
    } else {
        PG8_STAGE(PG8_SB(0, 0), cB, voffB); PG8_STAGE(PG8_SA(0, 0), cA, voffA); PG8_STAGE(PG8_SB(0, 1), cB + hstepB, voffB); PG8_STAGE(PG8_SA(0, 1), cA + hstepA, voffA);
        if (wr == 1) PG8_BAR;
        PG8_WAIT_V(4); PG8_BAR;
        PG8_STAGE(PG8_SB(1, 0), cB + kstep, voffB); PG8_STAGE(PG8_SA(1, 0), cA + kstep, voffA); PG8_STAGE(PG8_SB(1, 1), cB + hstepB + kstep, voffB);
        PG8_WAIT_V(6); PG8_BAR;
    }
    for (;;) {
        const bool has_next = S.next(ui + 1, nxt);
        const char* nA = has_next ? (const char*)gA + (size_t)nxt.pm * tstepA + (size_t)(nxt.pm >> 4) * arow : cA; const char* nB = has_next ? (const char*)gB + (size_t)nxt.pn * tstepB : cB;
        for (int t = 0; t < nt; t += 2) {
            const bool last = (t == nt - 2);
            const char* a1 = cA + (size_t)(t + 1) * kstep;
            const char* a2 = last ? nA : cA + (size_t)(t + 2) * kstep; const char* b2 = last ? nB : cB + (size_t)(t + 2) * kstep;
            const char* a3 = a2 + kstep; const char* b3 = b2 + kstep;
            if (last && has_next) S.a_ready(nxt);
            if constexpr (SP2) {
            PG8_LDB(B0, 0, 0); PG8_LDB(B1, 0, 1); PG8_SCHED; PG8_LDA(At, 0, 0); PG8_STAGE(PG8_SA(1, 1), a1 + hstepA, voffA);
            PG8_WAIT_V(8); PG8_WAIT_L(0); PG8_BAR; PG8_MMA(0, 0, At, B0); PG8_MMA(0, 1, At, B1); PG8_BAR; PG8_SCHED;
            PG8_LDA(At, 0, 1); PG8_STAGE(PG8_SB(0, 0), b2, voffB); PG8_STAGE(PG8_SB(0, 1), b2 + hstepB, voffB); PG8_STAGE(PG8_SA(0, 0), a2, voffA);
            PG8_WAIT_V(8); PG8_WAIT_L(0); PG8_BAR; PG8_MMA(1, 0, At, B0); PG8_MMA(1, 1, At, B1); PG8_BAR; PG8_SCHED;
            PG8_LDB(B0, 1, 0); PG8_LDB(B1, 1, 1); PG8_SCHED; PG8_LDA(At, 1, 0); PG8_STAGE(PG8_SA(0, 1), a2 + hstepA, voffA);
            PG8_WAIT_V(8); PG8_WAIT_L(0); PG8_BAR; PG8_MMA(0, 0, At, B0); PG8_MMA(0, 1, At, B1); PG8_BAR; PG8_SCHED;
            PG8_LDA(At, 1, 1); PG8_STAGE(PG8_SB(1, 0), b3, voffB); PG8_STAGE(PG8_SB(1, 1), b3 + hstepB, voffB); PG8_STAGE(PG8_SA(1, 0), a3, voffA);
            PG8_WAIT_V(8); PG8_WAIT_L(0); PG8_BAR; PG8_MMA(1, 0, At, B0); PG8_MMA(1, 1, At, B1); PG8_BAR; PG8_SCHED;
            } else {
            PG8_LDB(B0, 0, 0); PG8_SCHED; PG8_LDA(At, 0, 0); PG8_STAGE(PG8_SA(1, 1), a1 + hstepA, voffA);
            PG8_WAIT_L(8); PG8_BAR; PG8_WAIT_L(0); PG8_MMA(0, 0, At, B0); PG8_BAR; PG8_SCHED;
            PG8_LDB(B1, 0, 1); PG8_STAGE(PG8_SB(0, 0), b2, voffB);
            PG8_BAR; PG8_WAIT_L(0); PG8_MMA(0, 1, At, B1); PG8_BAR;
            PG8_LDA(At, 0, 1); PG8_STAGE(PG8_SA(0, 0), a2, voffA);
            PG8_BAR; PG8_WAIT_L(0); PG8_MMA(1, 0, At, B0); PG8_BAR; PG8_SCHED;
            PG8_STAGE(PG8_SB(0, 1), b2 + hstepB, voffB);
            PG8_WAIT_V(6); PG8_BAR; PG8_MMA(1, 1, At, B1); PG8_BAR;
            PG8_LDB(B0, 1, 0); PG8_SCHED; PG8_LDA(At, 1, 0); PG8_STAGE(PG8_SA(0, 1), a2 + hstepA, voffA);
            PG8_WAIT_L(8); PG8_BAR; PG8_WAIT_L(0); PG8_MMA(0, 0, At, B0); PG8_BAR; PG8_SCHED;
            PG8_LDB(B1, 1, 1); PG8_STAGE(PG8_SB(1, 0), b3, voffB);
            PG8_BAR; PG8_WAIT_L(0); PG8_MMA(0, 1, At, B1); PG8_BAR;
            PG8_LDA(At, 1, 1); PG8_STAGE(PG8_SA(1, 0), a3, voffA);
            PG8_BAR; PG8_WAIT_L(0); PG8_MMA(1, 0, At, B0); PG8_BAR; PG8_SCHED;
            PG8_STAGE(PG8_SB(1, 1), b3 + hstepB, voffB);
            PG8_WAIT_V(6); PG8_BAR; PG8_MMA(1, 1, At, B1); PG8_BAR;
            }
        }
        if constexpr (ALIGN_EPI) { if (wr == 0) PG8_BAR; }
        if constexpr (!Epi::AFTER_DRAIN) { E(acc, cur, wr, wc, fr, fq); S.done(cur); }
        if (!has_next) break;
#pragma unroll
        for (int a = 0; a < 2; ++a)
#pragma unroll
            for (int b = 0; b < 2; ++b)
#pragma unroll
                for (int m = 0; m < 4; ++m)
#pragma unroll
                    for (int n = 0; n < 2; ++n) acc[a][b][m][n] = (f32x4){0.f, 0.f, 0.f, 0.f};
        cur = nxt; cA = nA; cB = nB; ++ui;
        if constexpr (ALIGN_EPI) { if (wr == 1) PG8_BAR; }
    }
    PG8_WAIT_V(0);
    if constexpr (!ALIGN_EPI) { if (wr == 0) PG8_BAR; }
    PG8_BAR;
    if constexpr (Epi::AFTER_DRAIN) { E.fused(acc, cur, wr, wc, fr, fq, lds, wid, lane); S.done(cur); }
#undef PG8_SA
#undef PG8_SB
#undef PG8_STAGE
#undef PG8_LDA
#undef PG8_LDB
#undef PG8_MMA
#undef PG8_WAIT_V
#undef PG8_WAIT_L
#undef PG8_BAR
#undef PG8_SCHED
}
}

constexpr int NB = 8, SEQ = 4096, T = NB * SEQ, D = 1024, DEPTH = 4, NZ = 7680, NWAVES = 8;
constexpr int CIN = 7424;
constexpr size_t MiB = 1u << 20;
constexpr size_t WS_CTL = 0, WS_LORA = 1 * MiB, WS_MV = 7 * MiB, ZERO_BYTES = 9 * MiB;
constexpr size_t LORA_BYTES = 3072 * 256 * 2, MV_BYTES = 1024 * 256 * 2;
constexpr size_t WS_WIN = 10 * MiB;
constexpr size_t WS_DB = 40 * MiB, DB_SET = 62 * MiB;
constexpr size_t DB_PA = 0, DB_PBT = 2 * MiB, DB_POUT = 4 * MiB, DB_WQG = 6 * MiB, DB_KEYS = 12 * MiB, DB_GMW = 12 * MiB + 512 * 1024, DB_PLEW = 13 * MiB, DB_U = 14 * MiB, DB_V = 30 * MiB, DB_PB = 46 * MiB;
constexpr size_t WS_VF = 164 * MiB, WS_PW = 228 * MiB, WS_NX = 292 * MiB, WS_ZRKV = 420 * MiB, WS_ZL = 612 * MiB, WS_GUV = 644 * MiB, WS_SG = 772 * MiB;
constexpr size_t WS_EW = 900 * MiB, WS_AR = 964 * MiB, WS_G = 1028 * MiB, WS_WINB = 1092 * MiB, WINB_BYTES = 4 * MiB, WS_END = 1100 * MiB;
constexpr size_t WS_N8 = WS_ZL;
constexpr size_t WS_Q = WS_ZRKV, WS_SEL = WS_ZRKV + 128 * MiB, WS_MG = WS_AR, WS_N2 = WS_G;
constexpr size_t WIN_ZERO_OFF = WS_WIN + (size_t)3328 * 2048 * 2, WIN_ZERO_BYTES = (size_t)256 * 2048 * 2;
#ifndef ZSPLIT
#define ZSPLIT 2
#endif
constexpr int CW_BAR = 4096;
constexpr int RING_BYTES = 131072, LDSCTL_OFF = RING_BYTES, MISC_OFF = LDSCTL_OFF + 320, LDS_BYTES = 147456;

#define LAS __attribute__((address_space(3)))
#define GAS __attribute__((address_space(1)))
typedef unsigned short bf16;
typedef unsigned v4u __attribute__((ext_vector_type(4)));
typedef unsigned v2u __attribute__((ext_vector_type(2)));
typedef float f32x4 __attribute__((ext_vector_type(4)));
typedef float f32x2 __attribute__((ext_vector_type(2)));
typedef short bf16x8 __attribute__((ext_vector_type(8)));
using pg8::fsig; using pg8::fgelu; using pg8::bflo; using pg8::bfhi; using pg8::unpk8; using pg8::pk8; using pg8::cvt_pk_bf16;

#define XB_TMO      128
#define XB_XCNT(j)  (256  + 64 * (j))
#define XB_XSUB(j)  (1280 + 64 * (j))
#define XB_XGEN(j)  (2304 + 64 * (j))
#define XB_TOP      3328
#define XB_TOPGEN   3392
#define XCD_BAR_WORDS 3456
#define XB_SPIN_CAP (1u << 22)

__device__ __forceinline__ unsigned xb_ld(unsigned* p)              { return __hip_atomic_load(p, __ATOMIC_RELAXED, __HIP_MEMORY_SCOPE_AGENT); }
__device__ __forceinline__ unsigned xb_add(unsigned* p, unsigned v) { return __hip_atomic_fetch_add(p, v, __ATOMIC_RELAXED, __HIP_MEMORY_SCOPE_AGENT); }
__device__ __forceinline__ unsigned xb_xcc_id() { return (unsigned)__builtin_amdgcn_s_getreg((3 << 11) | 20) & 0xFu; }
#define XB_SPIN(cond, bar) do { unsigned _sp = 0; while (cond) { __builtin_amdgcn_s_sleep(1); \
    if ((++_sp & 255u) == 0u) { if (xb_ld(&(bar)[XB_TMO])) break; if (_sp > XB_SPIN_CAP) { atomicAdd(&(bar)[XB_TMO], 1u); break; } } } } while (0)

struct XcdBarrier { unsigned* bar; unsigned x; volatile LAS unsigned* st; };

__device__ __forceinline__ XcdBarrier xcd_barrier_post(unsigned* bar, volatile LAS unsigned* st) {
    XcdBarrier b; b.bar = bar; b.x = xb_xcc_id(); b.st = st;
    if (threadIdx.x == 0) (void)xb_add(&bar[XB_XCNT(b.x)], 1u);
    return b;
}
__device__ __forceinline__ void xcd_barrier_complete(unsigned* bar, unsigned x, unsigned& nloc, unsigned& nx) {
    const unsigned G = gridDim.x * gridDim.y * gridDim.z;
    unsigned sum, cnt, mine, sp = 0u;
    for (;;) {
        sum = 0u; cnt = 0u; mine = 0u;
#pragma unroll
        for (unsigned j = 0; j < 16; ++j) { const unsigned c = xb_ld(&bar[XB_XCNT(j)]); sum += c; cnt += (c > 0u) ? 1u : 0u; mine = (j == x) ? c : mine; }
        if (sum == G) break;
        __builtin_amdgcn_s_sleep(1);
        if ((++sp & 255u) == 0u) { if (xb_ld(&bar[XB_TMO])) break; if (sp > XB_SPIN_CAP) { atomicAdd(&bar[XB_TMO], 1u); break; } }
    }
    nloc = mine > 0u ? mine : 1u; nx = cnt > 0u ? cnt : 1u;
}
__device__ __forceinline__ int lane_id_now();
__device__ __forceinline__ void xcd_barrier(const XcdBarrier& b, const int wave0) {
    asm volatile("s_waitcnt vmcnt(0)" ::: "memory");
    __syncthreads();
    if (wave0 == 0 && lane_id_now() == 0) {
        unsigned* bar = b.bar;
        __builtin_amdgcn_s_waitcnt(0);
        unsigned nloc = b.st[0], nx = b.st[1];
        if (nloc == 0u) { xcd_barrier_complete(bar, b.x, nloc, nx); b.st[0] = nloc; b.st[1] = nx; }
        const unsigned old = xb_add(&bar[XB_XSUB(b.x)], 1u);
        const unsigned gen = old / nloc;
        if (old + 1u == (gen + 1u) * nloc) {
            __builtin_amdgcn_fence(__ATOMIC_RELEASE, "agent");
            asm volatile("s_waitcnt vmcnt(0)" ::: "memory");
            const unsigned og = xb_add(&bar[XB_TOP], 1u);
            const unsigned tg = og / nx;
            if (og + 1u == (tg + 1u) * nx) xb_add(&bar[XB_TOPGEN], 1u);
            else XB_SPIN(xb_ld(&bar[XB_TOPGEN]) == tg, bar);
            __builtin_amdgcn_fence(__ATOMIC_ACQUIRE, "agent");
            xb_add(&bar[XB_XGEN(b.x)], 1u);
            asm volatile("s_waitcnt vmcnt(0)" ::: "memory");
        } else {
            XB_SPIN(xb_ld(&bar[XB_XGEN(b.x)]) == gen, bar);
            __builtin_amdgcn_fence(__ATOMIC_ACQUIRE, "agent");
            asm volatile("s_waitcnt vmcnt(0)" ::: "memory");
        }
    }
    __syncthreads();
}

struct Args { const float* in[32]; float* out; unsigned char* ws; };
struct Frame {
    LAS unsigned char* lds;
    int tid, lane, wave, G, bx, wave0;
    GAS unsigned char* ws; float* h;
};
__device__ __forceinline__ int lane_id_now() { int l; asm volatile("v_mbcnt_lo_u32_b32 %0, -1, 0\n\tv_mbcnt_hi_u32_b32 %0, -1, %0" : "=v"(l)); return l; }
__device__ __forceinline__ void phase_ids(Frame& F) { const int l = lane_id_now(); F.lane = l; F.wave = F.wave0; F.tid = F.wave0 * 64 + l; GAS unsigned char* w = F.ws; asm volatile("" : "+s"(w)); F.ws = w; }
#define DPP_ADD(x, ctrl) ((x) + __builtin_bit_cast(float, __builtin_amdgcn_update_dpp(0, __builtin_bit_cast(int, (x)), (ctrl), 0xf, 0xf, false)))
__device__ __forceinline__ float sum8(float v) {
    v = DPP_ADD(v, 0xB1);
    v = DPP_ADD(v, 0x4E);
    v = DPP_ADD(v, 0x141);
    return v;
}
__device__ __forceinline__ float sum16(float v) { v = sum8(v); v = DPP_ADD(v, 0x140); return v; }
#define DPP_ADD_NS(x, ctrl) do { (x) = DPP_ADD((x), (ctrl)); asm("" : "+v"(x)); } while (0)
__device__ __forceinline__ float sum16_ns(float v) { DPP_ADD_NS(v, 0xB1); DPP_ADD_NS(v, 0x4E); DPP_ADD_NS(v, 0x141); DPP_ADD_NS(v, 0x140); return v; }
__device__ __forceinline__ float wave_sum(float v) {
    v = sum8(v);
    v = DPP_ADD(v, 0x140);
    const auto r = __builtin_amdgcn_permlane16_swap(__builtin_bit_cast(unsigned, v), __builtin_bit_cast(unsigned, v), false, false);
    v = __builtin_bit_cast(float, (unsigned)r[0]) + __builtin_bit_cast(float, (unsigned)r[1]);
    const auto q = __builtin_amdgcn_permlane32_swap(__builtin_bit_cast(unsigned, v), __builtin_bit_cast(unsigned, v), false, false);
    return __builtin_bit_cast(float, (unsigned)q[0]) + __builtin_bit_cast(float, (unsigned)q[1]);
}
__device__ __forceinline__ unsigned xor16_u(unsigned x, int lane) { const auto r = __builtin_amdgcn_permlane16_swap(x, x, false, false); return (lane & 16) ? (unsigned)r[0] : (unsigned)r[1]; }
__device__ __forceinline__ unsigned xor32_u(unsigned x, int lane) { const auto r = __builtin_amdgcn_permlane32_swap(x, x, false, false); return (lane & 32) ? (unsigned)r[0] : (unsigned)r[1]; }
__device__ __forceinline__ void tr_item(const float* W, int ldw, int ncols, bf16* WT, int ldt, int koff, int row_off, LAS float* scr, int item, int lane, int kx = 0) {
    const int nblk = ncols / 32, kb = item / nblk, nb = item % nblk, k0 = 64 * kb, n0 = 32 * nb;
#pragma unroll 8
    for (int i = 0; i < 32; ++i) { const int kk = 2 * i + (lane >> 5); scr[kk * 33 + (lane & 31)] = W[(size_t)(k0 + kk) * ldw + n0 + (lane & 31)]; }
    asm volatile("s_waitcnt lgkmcnt(0)" ::: "memory");
    const int c = lane & 7;
#pragma unroll
    for (int j = 0; j < 4; ++j) { const int n = (lane >> 3) + 8 * j; const LAS float* s = scr + (8 * c) * 33 + n;
        v4u o; o.x = cvt_pk_bf16(s[0 * 33], s[1 * 33]); o.y = cvt_pk_bf16(s[2 * 33], s[3 * 33]); o.z = cvt_pk_bf16(s[4 * 33], s[5 * 33]); o.w = cvt_pk_bf16(s[6 * 33], s[7 * 33]);
        *(v4u*)(WT + (size_t)(row_off + n0 + n) * ldt + ((koff + k0 + 8 * c) ^ kx)) = o; }
    asm volatile("s_waitcnt lgkmcnt(0)" ::: "memory");
}
__device__ __forceinline__ void cvt_chunk(const float* src, bf16* dst, size_t chunk, int lane) {
    const f32x4* s = (const f32x4*)(src + chunk * 512) + lane * 2; const f32x4 a = s[0], b = s[1];
    *(v4u*)(dst + chunk * 512 + lane * 8) = pk8(a, b);
}
__device__ __forceinline__ void cvt8_chunk(const float* src, unsigned char* dst, size_t chunk, int lane, float sc) {
    const f32x4* s = (const f32x4*)(src + chunk * 512) + lane * 2; const f32x4 a = s[0] * sc, b = s[1] * sc;
    int w0 = 0, w1 = 0;
    w0 = __builtin_amdgcn_cvt_pk_fp8_f32(a.x, a.y, w0, false); w0 = __builtin_amdgcn_cvt_pk_fp8_f32(a.z, a.w, w0, true);
    w1 = __builtin_amdgcn_cvt_pk_fp8_f32(b.x, b.y, w1, false); w1 = __builtin_amdgcn_cvt_pk_fp8_f32(b.z, b.w, w1, true);
    *(v2u*)(dst + chunk * 512 + lane * 8) = (v2u){(unsigned)w0, (unsigned)w1};
}
#define NXROW(t) ((size_t)(t) + ((size_t)(t) >> 12) + 1)
__device__ __forceinline__ void norm_row_nx(const float* hrow, float* hcopy, const float* g, bf16* NX, int t, int lane) {
    const f32x4* xr = (const f32x4*)hrow + lane; f32x4 v[4]; float s = 0.f;
#pragma unroll
    for (int j = 0; j < 4; ++j) { v[j] = xr[64 * j]; s += (v[j].x * v[j].x + v[j].y * v[j].y) + (v[j].z * v[j].z + v[j].w * v[j].w); }
    if (hcopy) {
#pragma unroll
        for (int j = 0; j < 4; ++j) ((f32x4*)hcopy)[lane + 64 * j] = v[j]; }
    const float rstd = 1.f / sqrtf(wave_sum(s) * (1.f / D) + 1e-6f);
#pragma unroll
    for (int j = 0; j < 4; ++j) { const f32x4 gv = ((const f32x4*)g)[lane + 64 * j]; const f32x4 o = v[j] * rstd * gv;
        v2u w; w.x = cvt_pk_bf16(o.x, o.y); w.y = cvt_pk_bf16(o.z, o.w);
        const int c = 4 * (lane + 64 * j);
        *(v2u*)(NX + NXROW(t) * 1024 + c) = w; }
}
__device__ __forceinline__ void norm_row_n2x2(const float* hrow0, const float* hrow1, const float* g, bf16* o0, bf16* o1, unsigned char* e0, unsigned char* e1, int lane) {
    const f32x4* x0 = (const f32x4*)hrow0 + lane; const f32x4* x1 = (const f32x4*)hrow1 + lane; f32x4 v[2][4]; float s0 = 0.f, s1 = 0.f;
#pragma unroll
    for (int j = 0; j < 4; ++j) { v[0][j] = x0[64 * j]; v[1][j] = x1[64 * j]; }
#pragma unroll
    for (int j = 0; j < 4; ++j) { s0 += (v[0][j].x * v[0][j].x + v[0][j].y * v[0][j].y) + (v[0][j].z * v[0][j].z + v[0][j].w * v[0][j].w);
                                  s1 += (v[1][j].x * v[1][j].x + v[1][j].y * v[1][j].y) + (v[1][j].z * v[1][j].z + v[1][j].w * v[1][j].w); }
    const float r0 = 1.f / sqrtf(wave_sum(s0) * (1.f / D) + 1e-6f), r1 = 1.f / sqrtf(wave_sum(s1) * (1.f / D) + 1e-6f);
#pragma unroll
    for (int j = 0; j < 4; ++j) { const f32x4 gv = ((const f32x4*)g)[lane + 64 * j]; const f32x4 a = v[0][j] * r0 * gv, b = v[1][j] * r1 * gv;
        *(v2u*)(o0 + 4 * (lane + 64 * j)) = (v2u){cvt_pk_bf16(a.x, a.y), cvt_pk_bf16(a.z, a.w)}; *(v2u*)(o1 + 4 * (lane + 64 * j)) = (v2u){cvt_pk_bf16(b.x, b.y), cvt_pk_bf16(b.z, b.w)};
        { const f32x4 a8 = a * 16.f, b8 = b * 16.f; int wa = 0, wb = 0;
          wa = __builtin_amdgcn_cvt_pk_fp8_f32(a8.x, a8.y, wa, false); wa = __builtin_amdgcn_cvt_pk_fp8_f32(a8.z, a8.w, wa, true); wb = __builtin_amdgcn_cvt_pk_fp8_f32(b8.x, b8.y, wb, false); wb = __builtin_amdgcn_cvt_pk_fp8_f32(b8.z, b8.w, wb, true);
          *(unsigned*)(e0 + 4 * (lane + 64 * j)) = (unsigned)wa; *(unsigned*)(e1 + 4 * (lane + 64 * j)) = (unsigned)wb; } }
}
__device__ __forceinline__ void prep_phase(Frame& F, const Args& a, int layer, int blk, int nblk_, int part) {
    phase_ids(F);
    LAS float* scr = (LAS float*)(F.lds + F.wave * 16384);
    const int gw = blk * NWAVES + F.wave, NGW = nblk_ * NWAVES, lane = F.lane;
    GAS unsigned char* ws = F.ws; GAS unsigned char* db = F.ws + WS_DB + (size_t)(layer & 1) * DB_SET;
    bf16* WIN = (bf16*)(ws + WS_WIN); bf16* LORA = (bf16*)(ws + WS_LORA + (size_t)layer * LORA_BYTES); bf16* MVT = (bf16*)(ws + WS_MV + (size_t)(layer > 0 ? layer - 1 : 0) * MV_BYTES);
    const float* w_in = a.in[5] + (size_t)layer * 2048 * CIN;
    const int mvn = layer > 0 ? 32 : 0;
    const int c1 = 32 * 104, c2a = 32 * 64, c2b = 32 * 32, c2c = 32 * (32 - 8 * ZSPLIT), c2d = 32 * 8 * ZSPLIT, c2 = c2a + 2 * c2b, c3 = mvn, c4 = 32, c5 = 32, c6 = 64, c7 = 512, c10 = 1024, c12 = 128;
    const int total = (part & 1) ? c1 + c2 + c3 + c4 + c5 + c6 + 3 * c7 + c10 + c7 + c12 : 0;
    for (int it = gw; it < total; it += NGW) {
        int r = it;
        if (r < c1) { tr_item(w_in, CIN, 3328, WIN, 2048, 0, 0, scr, r, lane, 1024); continue; } r -= c1;
        if (r < c2a) { tr_item(w_in + 3328, CIN, 2048, WIN, 2048, 0, 3584, scr, r, lane, 1024); continue; } r -= c2a;
        if (r < c2b) { tr_item(w_in + 6400, CIN, 1024, WIN, 2048, 0, 5632, scr, r, lane, 1024); continue; } r -= c2b;
        if (r < c2c) { tr_item(w_in + 5376, CIN, 1024 - 256 * ZSPLIT, WIN, 2048, 0, 6656, scr, r, lane, 1024); continue; } r -= c2c;
        if (r < c2d) { tr_item(w_in + 6400 - 256 * ZSPLIT, CIN, 256 * ZSPLIT, (bf16*)(ws + WS_WINB + (size_t)(layer & 1) * WINB_BYTES), 2048, 0, 0, scr, r, lane, 1024); continue; } r -= c2d;
        if (r < c3) { tr_item(a.in[16] + (size_t)(layer - 1) * 2048 * 32, 32, 32, WIN, 2048, 0, 3328, scr, r, lane, 1024); continue; } r -= c3;
        if (r < c4) { tr_item(a.in[7] + (size_t)layer * 64 * 1024, 1024, 1024, LORA, 128, 0, 0, scr, r, lane); continue; } r -= c4;
        if (r < c5) { tr_item(a.in[9] + (size_t)layer * 64 * 1024, 1024, 1024, LORA, 128, 64, 1024, scr, r, lane); continue; } r -= c5;
        if (r < c6) { tr_item(a.in[10] + (size_t)layer * 128 * 1024, 1024, 1024, LORA + 2048 * 128, 128, 0, 0, scr, r, lane); continue; } r -= c6;
        if (r < c7) { tr_item(a.in[23] + (size_t)layer * D * D, D, D, (bf16*)(db + DB_PA), D, 0, 0, scr, r, lane); continue; } r -= c7;
        if (r < c7) { tr_item(a.in[24] + (size_t)layer * D * D, D, D, (bf16*)(db + DB_PBT), D, 0, 0, scr, r, lane); continue; } r -= c7;
        if (r < c7) { tr_item(a.in[25] + (size_t)layer * D * D, D, D, (bf16*)(db + DB_POUT), D, 0, 0, scr, r, lane); continue; } r -= c7;
        if (r < c10) { tr_item(a.in[26] + (size_t)layer * D * 2048, 2048, 2048, (bf16*)(db + DB_WQG), D, 0, 0, scr, r, lane); continue; } r -= c10;
        if (r < c7) { tr_item(a.in[31] + (size_t)layer * D * D, D, D, (bf16*)(db + DB_WQG), D, 0, 2048, scr, r, lane); continue; } r -= c7;
        tr_item(a.in[30] + (size_t)layer * 256 * D, D, D, (bf16*)(db + DB_PLEW), 256, 0, 0, scr, r, lane);
    }
    if (layer > 0 && (part & 1)) {
        const float* w2 = a.in[17] + (size_t)(layer - 1) * 32 * 1024;
        for (int it = gw; it < 512; it += NGW) { const int e = it * 64 + lane, n = e >> 5, k = e & 31; MVT[n * 128 + k] = (bf16)(cvt_pk_bf16(w2[k * 1024 + n], 0.f) & 0xffffu); }
    }
    {
        const float* keys = a.in[27] + (size_t)layer * 262144; const float* ut = a.in[28] + (size_t)layer * 16777216; const float* vt = a.in[29] + (size_t)layer * 16777216;
        const float* pin = a.in[1] + (size_t)layer * T * 256; const float* gws = a.in[21] + (size_t)layer * 131072;
        const int n1 = (part & 1) ? 512 : 0, n2 = (part & 2) ? 32768 : 0, n4 = (part & 1) ? 16384 : 0, n5 = (part & 1) ? 256 : 0, ntot = n1 + 2 * n2 + n4 + n5;
        for (int it = gw; it < ntot; it += NGW) {
            int r = it;
            if (r < n2) { cvt8_chunk(ut, (unsigned char*)(db + DB_U), r, lane, 256.f); continue; } r -= n2;
            if (r < n2) { cvt8_chunk(vt, (unsigned char*)(db + DB_V), r, lane, 64.f); continue; } r -= n2;
            if (r < n4) { cvt_chunk(pin, (bf16*)(db + DB_PB), r, lane); continue; } r -= n4;
            if (r < n1) { cvt_chunk(keys, (bf16*)(db + DB_KEYS), r, lane); continue; } r -= n1;
            {
                const int e0 = r * 512 + lane * 8, tq = (e0 >> 7) & 127, p0 = e0 & 127;
                const f32x4* s = (const f32x4*)(gws + e0); f32x4 x0 = s[0], x1 = s[1];
#pragma unroll
                for (int j = 0; j < 4; ++j) { if (p0 + j > tq) x0[j] = 0.f; if (p0 + 4 + j > tq) x1[j] = 0.f; }
                *(v4u*)((bf16*)(db + DB_GMW) + e0) = pk8(x0, x1);
            }
        }
    }
    if (layer == 0 && (part & 1)) {
        if (gw < NB) *(v4u*)((bf16*)(ws + WS_NX) + (size_t)gw * (SEQ + 1) * 1024 + 8 * lane) = (v4u){0u, 0u, 0u, 0u}, *(v4u*)((bf16*)(ws + WS_NX) + (size_t)gw * (SEQ + 1) * 1024 + 512 + 8 * lane) = (v4u){0u, 0u, 0u, 0u};
        for (int m = gw; m < T; m += NGW) norm_row_nx(a.in[0] + (size_t)m * D, F.h + (size_t)m * D, a.in[2], (bf16*)(ws + WS_NX), m, lane);
    }
}

constexpr int SC = 32, NPR = SC / 2;
constexpr int SC_VEC = SC * 64;
constexpr int SC_WW = 0, SC_VQ = NPR * 64, SC_BK = SC_VQ + NPR * 256, SC_XA = SC_BK + NPR * 128, SC_C = SC_XA + NPR * 128, SC_VP = SC_C + NPR * 20, SC_BON = SC_VP + SC * 64, SC_BUF = SC_BON + SC * 8;
static_assert(SC_BUF % 4 == 0 && SC_C % 4 == 0 && (2 * SC_BUF + 2 * SC_VEC) * 4 + 64 <= 131072, "scan LDS map");
struct ScanOps { f32x4 w[4], vq, c[4]; v4u bk[2]; bf16x8 x[2]; };
__device__ __forceinline__ void scan_load2(ScanOps& o, const LAS float* buf, const LAS float* vqp, const LAS unsigned char* bkp, int bkstep, int p, int lane) {
    const int q = lane >> 4;
    const LAS float* wp = buf + SC_WW + p * 64 + q * 4;
#pragma unroll
    for (int i = 0; i < 4; ++i) o.w[i] = *(const LAS f32x4*)(wp + 16 * i);
    o.vq = *(const LAS f32x4*)(vqp + p * 256);
    o.bk[0] = *(const LAS v4u*)(bkp + p * bkstep); o.bk[1] = *(const LAS v4u*)(bkp + p * bkstep + 16);
    const LAS unsigned char* xp = (const LAS unsigned char*)(buf + SC_XA) + p * 512 + (lane & 3) * 128 + q * 16;
    o.x[0] = *(const LAS bf16x8*)xp; o.x[1] = *(const LAS bf16x8*)(xp + 64);
#pragma unroll
    for (int i = 0; i < 4; ++i) o.c[i] = *(const LAS f32x4*)(buf + SC_C + p * 20 + 4 * i);
}
__device__ __forceinline__ const char* uni_ptr(const char* p) { const unsigned long long a = (unsigned long long)p;
    const unsigned lo = (unsigned)__builtin_amdgcn_readfirstlane((int)(unsigned)a), hi = (unsigned)__builtin_amdgcn_readfirstlane((int)(unsigned)(a >> 32));
    return (const char*)(((unsigned long long)hi << 32) | lo); }
__device__ __forceinline__ float smul(float a, float b) { float r; asm("v_mul_f32 %0, %1, %2" : "=v"(r) : "v"(a), "v"(b)); return r; }
__device__ __forceinline__ void scan_pair(const ScanOps& o, f32x4 (&St)[4], float& sa0, float& sa1, v4u (&am)[4], v4u& bm, LAS float* ypt, int ystep, unsigned m16) {
    v4u s0, s1;
    s0.x = cvt_pk_bf16(St[0].x, St[0].y); s0.y = cvt_pk_bf16(St[0].z, St[0].w); s0.z = cvt_pk_bf16(St[1].x, St[1].y); s0.w = cvt_pk_bf16(St[1].z, St[1].w);
    s1.x = cvt_pk_bf16(St[2].x, St[2].y); s1.y = cvt_pk_bf16(St[2].z, St[2].w); s1.z = cvt_pk_bf16(St[3].x, St[3].y); s1.w = cvt_pk_bf16(St[3].z, St[3].w);
    f32x4 dv = (f32x4){0.f, 0.f, 0.f, 0.f};
    dv = __builtin_amdgcn_mfma_f32_16x16x32_bf16(o.x[0], __builtin_bit_cast(bf16x8, s0), dv, 0, 0, 0);
    dv = __builtin_amdgcn_mfma_f32_16x16x32_bf16(o.x[1], __builtin_bit_cast(bf16x8, s1), dv, 0, 0, 0);
    const float v0 = o.vq.x, v1 = o.vq.y, v2 = o.vq.z;
    typedef short s16x4 __attribute__((ext_vector_type(4)));
    const v2u bm2 = (v2u){cvt_pk_bf16(sa0, v0) & m16, cvt_pk_bf16(sa1, v1) & m16};
#pragma unroll
    for (int i = 0; i < 4; ++i) { const v2u a2 = (v2u){o.bk[i >> 1][(i & 1) * 2], o.bk[i >> 1][(i & 1) * 2 + 1]};
        St[i] = __builtin_amdgcn_mfma_f32_16x16x16bf16_1k(__builtin_bit_cast(s16x4, a2), __builtin_bit_cast(s16x4, bm2),
                                                        (f32x4){smul(St[i].x, o.w[i].x), smul(St[i].y, o.w[i].y), smul(St[i].z, o.w[i].z), smul(St[i].w, o.w[i].w)}, 0, 0, 0); }
    ypt[0]     = dv.z + sa0 * o.c[2].z + v0 * o.c[2].w;
    ypt[ystep] = dv.w + sa0 * o.c[3].x + v0 * o.c[3].y + sa1 * o.c[3].z + v1 * o.c[3].w;
    const float n0 = dv.x + sa0 * o.c[0].x + v0 * o.c[0].y + sa1 * o.c[0].z + v1 * o.c[0].w;
    const float n1 = dv.y + sa0 * o.c[1].x + v0 * o.c[1].y + sa1 * o.c[1].z + v1 * o.c[1].w + n0 * o.c[2].x + v2 * o.c[2].y;
    sa0 = n0; sa1 = n1;
}
__device__ __forceinline__ void scan_unit(Frame& F, const Args& a, int layer, int unit) {
    phase_ids(F);
    const int b = unit >> 4, hh = unit & 15, tid = F.tid, lane = F.lane, wave = F.wave;
    LAS float* bufs = (LAS float*)F.lds;
    LAS float* sY = bufs + 2 * SC_BUF;
    const bf16* ZR = (const bf16*)(F.ws + WS_ZRKV); const bf16* EW = (const bf16*)(F.ws + WS_EW); const bf16* AR = (const bf16*)(F.ws + WS_AR); const bf16* GT = (const bf16*)(F.ws + WS_G);
    bf16* YA = (bf16*)(F.ws + WS_G);
    constexpr int NCH = SEQ / SC;
    if (wave < 4) {
        f32x4 St[4]; v4u am[4], bm = (v4u){0u, 0u, 0u, 0u};
#pragma unroll
        for (int i = 0; i < 4; ++i) { St[i] = (f32x4){0.f, 0.f, 0.f, 0.f}; am[i] = (v4u){0u, 0u, 0u, 0u}; }
        float sa0 = 0.f, sa1 = 0.f;
        const unsigned m16 = lane < 16 ? 0xffffffffu : 0u;
        LAS unsigned char* zblk = (LAS unsigned char*)(sY + 2 * SC_VEC);
        if (tid < 8) ((LAS unsigned*)zblk)[tid] = 0u;
        const int bkstep = lane < 16 ? 512 : 0;
        for (int it = 0; it < NCH + 2; ++it) {
            if (it >= 1 && it <= NCH) {
                const LAS float* bufc = bufs + ((it - 1) & 1) * SC_BUF;
                const LAS float* vqp = bufc + SC_VQ + 4 * (wave * 16 + (lane & 15));
                const LAS unsigned char* bkp = lane < 16 ? (const LAS unsigned char*)(bufc + SC_BK) + lane * 32 : (const LAS unsigned char*)zblk;
                LAS float* yb = lane < 16 ? sY + ((it - 1) & 1) * SC_VEC + wave * 16 + lane : (LAS float*)(zblk + 32);
                const int ystep = lane < 16 ? 64 : 0;
                if (it == 1) { sa0 = 0.f; sa1 = vqp[0] * bufc[SC_C + 16]; }
                ScanOps o0, o1;
                scan_load2(o0, bufc, vqp, bkp, bkstep, 0, lane);
#pragma unroll 1
                for (int p = 0; p < NPR; p += 2) {
                    scan_load2(o1, bufc, vqp, bkp, bkstep, p + 1, lane);
                    scan_pair(o0, St, sa0, sa1, am, bm, yb + (2 * p) * ystep, ystep, m16);
                    if (p + 2 < NPR) scan_load2(o0, bufc, vqp, bkp, bkstep, p + 2, lane);
                    scan_pair(o1, St, sa0, sa1, am, bm, yb + (2 * p + 2) * ystep, ystep, m16);
                }
            }
            __syncthreads();
        }
    } else {
        const int ht = tid - 256, tl = ht >> 3, c8 = ht & 7, ch = hh * 64 + c8 * 8;
        const int pr = ht >> 4, c4 = ht & 15, chp = hh * 64 + c4 * 4;
        const size_t po = (size_t)layer * 1024 + ch, pop = (size_t)layer * 1024 + chp;
        struct HelpIn { v2u r0, k0, v0, e0, a0, r1, k1, v1, e1, a1, k2, v2, e2, a2, k3; v4u gt; };
        HelpIn cur, nxt;
#define HELP_ROW(H, F_, RR, OFF, ARR, PITCH) (H).F_ = *(const v2u*)((ARR) + ((size_t)b * SEQ + (RR)) * (PITCH) + (OFF) + chp)
#define HELP_LOAD(H, PC, GC) do { \
            if ((PC) < NCH) { const int _t = (PC) * SC + 2 * pr; \
                HELP_ROW(H, r0, _t, 0, ZR, 3072); HELP_ROW(H, k0, _t, 1024, ZR, 3072); HELP_ROW(H, v0, _t, 2048, ZR, 3072); HELP_ROW(H, e0, _t, 0, EW, 1024); HELP_ROW(H, a0, _t, 0, AR, 1024); \
                HELP_ROW(H, r1, _t + 1, 0, ZR, 3072); HELP_ROW(H, k1, _t + 1, 1024, ZR, 3072); HELP_ROW(H, v1, _t + 1, 2048, ZR, 3072); HELP_ROW(H, e1, _t + 1, 0, EW, 1024); HELP_ROW(H, a1, _t + 1, 0, AR, 1024); \
                HELP_ROW(H, k2, _t + 2, 1024, ZR, 3072); HELP_ROW(H, v2, _t + 2, 2048, ZR, 3072); HELP_ROW(H, e2, _t + 2, 0, EW, 1024); HELP_ROW(H, a2, _t + 2, 0, AR, 1024); \
                HELP_ROW(H, k3, _t + 3, 1024, ZR, 3072); } \
            if ((GC) >= 0 && (GC) < NCH) { const size_t _row = (size_t)b * SEQ + (size_t)(GC) * SC + tl; (H).gt = *(const v4u*)(GT + _row * 1024 + ch); } } while (0)
#define UNP4(W) ((f32x4){bflo((W).x), bfhi((W).x), bflo((W).y), bfhi((W).y)})
#define EXP4(E) ((f32x4){__builtin_amdgcn_exp2f(-1.44269504f * (E).x), __builtin_amdgcn_exp2f(-1.44269504f * (E).y), __builtin_amdgcn_exp2f(-1.44269504f * (E).z), __builtin_amdgcn_exp2f(-1.44269504f * (E).w)})
#define DOT4(A, B) (((A).x * (B).x + (A).y * (B).y) + ((A).z * (B).z + (A).w * (B).w))
#define SUM16(X) sum16_ns(X)
#ifdef PROBE_SCAN
        unsigned long long ph_act = 0ull;
#endif
        HELP_LOAD(cur, 0, -2);
        for (int it = 0; it < NCH + 2; ++it) {
#ifdef PROBE_SCAN
            const unsigned long long ph0 = __builtin_amdgcn_s_memtime();
#endif
            HELP_LOAD(nxt, it + 1, it - 1);
            if (it >= 2) {
                const LAS float* buf = bufs + (it & 1) * SC_BUF; const LAS float* yb = sY + (it & 1) * SC_VEC;
                const size_t row = (size_t)b * SEQ + (size_t)(it - 2) * SC + tl; const int o = tl * 64 + c8 * 8;
                f32x4 y_[2], v_[2], g_[2];
#pragma unroll
                for (int i = 0; i < 2; ++i) { y_[i] = *(const LAS f32x4*)(yb + o + 4 * i); v_[i] = *(const LAS f32x4*)(buf + SC_VP + o + 4 * i); }
                const float bon = buf[SC_BON + tl * 8 + c8];
                unpk8(cur.gt, g_[0], g_[1]);
                const float s1 = ((y_[0].x + y_[0].y) + (y_[0].z + y_[0].w)) + ((y_[1].x + y_[1].y) + (y_[1].z + y_[1].w));
                const float mu = sum8(s1) * (1.f / 64.f);
                float s2 = 0.f;
#pragma unroll
                for (int i = 0; i < 2; ++i) { y_[i] = y_[i] - mu; const f32x4 q = y_[i] * y_[i]; s2 += (q.x + q.y) + (q.z + q.w); }
                const float rstd = __builtin_amdgcn_rsqf(sum8(s2) * (1.f / 64.f) + 64e-5f);
                f32x4 o_[2];
#pragma unroll
                for (int i = 0; i < 2; ++i) o_[i] = (y_[i] * rstd * *(const f32x4*)(a.in[14] + po + 4 * i) + *(const f32x4*)(a.in[15] + po + 4 * i) + bon * v_[i]) * g_[i];
                *(v4u*)(YA + row * 1024 + ch) = pk8(o_[0], o_[1]);
            }
            if (it < NCH) {
                LAS float* buf = bufs + (it & 1) * SC_BUF;
                const f32x4 pkk_ = *(const f32x4*)(a.in[11] + pop), pka_ = *(const f32x4*)(a.in[12] + pop), prk_ = *(const f32x4*)(a.in[13] + pop);
                const f32x4 zk0 = UNP4(cur.k0), zk1 = UNP4(cur.k1), zk2 = UNP4(cur.k2), zk3 = UNP4(cur.k3);
                f32x4 kn0 = zk0 * pkk_, kn1 = zk1 * pkk_, kn2 = zk2 * pkk_, kn3 = zk3 * pkk_;
                kn0 = kn0 * __builtin_amdgcn_rsqf(fmaxf(SUM16(DOT4(kn0, kn0)), 1e-24f)); kn1 = kn1 * __builtin_amdgcn_rsqf(fmaxf(SUM16(DOT4(kn1, kn1)), 1e-24f));
                kn2 = kn2 * __builtin_amdgcn_rsqf(fmaxf(SUM16(DOT4(kn2, kn2)), 1e-24f)); kn3 = kn3 * __builtin_amdgcn_rsqf(fmaxf(SUM16(DOT4(kn3, kn3)), 1e-24f));
                const f32x4 r0 = UNP4(cur.r0), r1 = UNP4(cur.r1), v0 = UNP4(cur.v0), v1 = UNP4(cur.v1), v2 = UNP4(cur.v2);
                const f32x4 ar0 = UNP4(cur.a0), ar1 = UNP4(cur.a1), ar2 = UNP4(cur.a2);
                const f32x4 e0 = UNP4(cur.e0), e1 = UNP4(cur.e1), e2 = UNP4(cur.e2);
                const f32x4 w0 = EXP4(e0), w1 = EXP4(e1), w2 = EXP4(e2);
                const f32x4 a1v = -kn1, a2v = -kn2, a3v = -kn3;
                const f32x4 b0 = kn0 * ar0, b1 = kn1 * ar1, b2 = kn2 * ar2;
                const f32x4 kp0 = zk0 * (1.f + (ar0 - 1.f) * pka_), kp1 = zk1 * (1.f + (ar1 - 1.f) * pka_), kp2 = zk2 * (1.f + (ar2 - 1.f) * pka_);
                const f32x4 W2 = w0 * w1, Bt = b0 * w1, Kt = kp0 * w1, x0v = a2v, x1v = w2 * a3v;
                const f32x4 X0 = W2 * x0v, X1 = W2 * x1v, X2 = w0 * r0, X3 = W2 * r1;
                *(LAS f32x4*)(buf + SC_WW + pr * 64 + c4 * 4) = W2;
                *(LAS f32x4*)(buf + SC_VP + (2 * pr) * 64 + c4 * 4) = v0; *(LAS f32x4*)(buf + SC_VP + (2 * pr + 1) * 64 + c4 * 4) = v1;
                { LAS f32x4* vq = (LAS f32x4*)(buf + SC_VQ + pr * 256 + c4 * 16);
                  vq[0] = (f32x4){v0.x, v1.x, v2.x, 0.f}; vq[1] = (f32x4){v0.y, v1.y, v2.y, 0.f}; vq[2] = (f32x4){v0.z, v1.z, v2.z, 0.f}; vq[3] = (f32x4){v0.w, v1.w, v2.w, 0.f}; }
                { LAS v2u* bkp = (LAS v2u*)(buf + SC_BK + pr * 128) + (((c4 & 3) * 4) * 4 + (c4 >> 2));
                  bkp[0] = (v2u){cvt_pk_bf16(Bt.x, Kt.x), cvt_pk_bf16(b1.x, kp1.x)}; bkp[4] = (v2u){cvt_pk_bf16(Bt.y, Kt.y), cvt_pk_bf16(b1.y, kp1.y)};
                  bkp[8] = (v2u){cvt_pk_bf16(Bt.z, Kt.z), cvt_pk_bf16(b1.z, kp1.z)}; bkp[12] = (v2u){cvt_pk_bf16(Bt.w, Kt.w), cvt_pk_bf16(b1.w, kp1.w)}; }
                { LAS unsigned char* xp = (LAS unsigned char*)(buf + SC_XA) + pr * 512 + (c4 >> 3) * 64 + (c4 & 3) * 16 + ((c4 >> 2) & 1) * 8;
                  *(LAS v2u*)xp = (v2u){cvt_pk_bf16(X0.x, X0.y), cvt_pk_bf16(X0.z, X0.w)}; *(LAS v2u*)(xp + 128) = (v2u){cvt_pk_bf16(X1.x, X1.y), cvt_pk_bf16(X1.z, X1.w)};
                  *(LAS v2u*)(xp + 256) = (v2u){cvt_pk_bf16(X2.x, X2.y), cvt_pk_bf16(X2.z, X2.w)}; *(LAS v2u*)(xp + 384) = (v2u){cvt_pk_bf16(X3.x, X3.y), cvt_pk_bf16(X3.z, X3.w)}; }
                const f32x4 ca = (f32x4){SUM16(DOT4(Bt, x0v)), SUM16(DOT4(Kt, x0v)), SUM16(DOT4(b1, x0v)), SUM16(DOT4(kp1, x0v))};
                const f32x4 cb = (f32x4){SUM16(DOT4(Bt, x1v)), SUM16(DOT4(Kt, x1v)), SUM16(DOT4(b1, x1v)), SUM16(DOT4(kp1, x1v))};
                const f32x4 cc = (f32x4){SUM16(DOT4(b2, a3v)), SUM16(DOT4(kp2, a3v)), SUM16(DOT4(b0, r0)), SUM16(DOT4(kp0, r0))};
                const f32x4 cd = (f32x4){SUM16(DOT4(Bt, r1)), SUM16(DOT4(Kt, r1)), SUM16(DOT4(b1, r1)), SUM16(DOT4(kp1, r1))};
                const float ci = SUM16(DOT4(kp0, a1v));
                const f32x4 z0 = r0 * kp0 * prk_, z1 = r1 * kp1 * prk_;
                const float bon0 = SUM16((z0.x + z0.y) + (z0.z + z0.w)), bon1 = SUM16((z1.x + z1.y) + (z1.z + z1.w));
                if (c4 == 0) { LAS f32x4* cp = (LAS f32x4*)(buf + SC_C + pr * 20); cp[0] = ca; cp[1] = cb; cp[2] = cc; cp[3] = cd; cp[4] = (f32x4){ci, 0.f, 0.f, 0.f}; }
                buf[SC_BON + (2 * pr) * 8 + (c4 >> 1)] = bon0; buf[SC_BON + (2 * pr + 1) * 8 + (c4 >> 1)] = bon1;
            }
            cur = nxt;
#ifdef PROBE_SCAN
            asm volatile("s_waitcnt vmcnt(0) lgkmcnt(0)" ::: "memory"); ph_act += __builtin_amdgcn_s_memtime() - ph0;
#endif
            __syncthreads();
        }
#ifdef PROBE_SCAN
        if (unit == 0 && layer == DEPTH - 1 && tid == 256) ((float*)(F.ws + WS_CTL))[2048 + 2] = rintf((float)ph_act / (float)(NCH + 2) * (1.f / 2000.f));
#endif
#undef HELP_LOAD
#undef HELP_ROW
#undef UNP4
#undef EXP4
#undef DOT4
#undef SUM16
    }
}

constexpr int TP = 136;
__device__ __forceinline__ void mma_128(const LAS bf16* sA, const LAS bf16* sBt, int wave, int lane, f32x4 (&acc)[4][2]) {
    const int wm = wave >> 2, wn = wave & 3, fr = lane & 15, fq = lane >> 4;
#pragma unroll
    for (int kk = 0; kk < 4; ++kk) {
        bf16x8 af[4], bf_[2];
#pragma unroll
        for (int mt = 0; mt < 4; ++mt) af[mt] = *(const LAS bf16x8*)(sA + (64 * wm + 16 * mt + fr) * TP + 32 * kk + 8 * fq);
#pragma unroll
        for (int nt = 0; nt < 2; ++nt) bf_[nt] = *(const LAS bf16x8*)(sBt + (32 * wn + 16 * nt + fr) * TP + 32 * kk + 8 * fq);
#pragma unroll
        for (int mt = 0; mt < 4; ++mt)
#pragma unroll
            for (int nt = 0; nt < 2; ++nt) acc[mt][nt] = __builtin_amdgcn_mfma_f32_16x16x32_bf16(bf_[nt], af[mt], acc[mt][nt], 0, 0, 0);
    }
}
__device__ __forceinline__ void gmlp_unit(Frame& F, const Args& a, int layer, int unit) {
    phase_ids(F);
    const size_t t0 = (size_t)unit * 128; const int tid = F.tid, lane = F.lane, wave = F.wave;
    LAS float* st = (LAS float*)F.lds; LAS bf16* sA = (LAS bf16*)(F.lds + 1024); LAS bf16* sB = (LAS bf16*)(F.lds + 1024 + 128 * TP * 2);
    bf16* GUV = (bf16*)(F.ws + WS_GUV); const bf16* GMW = (const bf16*)(F.ws + WS_DB + (size_t)(layer & 1) * DB_SET + DB_GMW);
    const float* lng = a.in[19] + (size_t)layer * 1024; const float* lnb = a.in[20] + (size_t)layer * 1024; const float* bsp = a.in[22] + (size_t)layer * 1024;
    for (int r = 0; r < 16; ++r) { const int tok = wave * 16 + r; const bf16* rowp = GUV + (t0 + tok) * 2048 + 1024;
        f32x4 x0, x1, x2, x3; unpk8(*(const v4u*)(rowp + lane * 8), x0, x1); unpk8(*(const v4u*)(rowp + 512 + lane * 8), x2, x3);
        const f32x4 sv = (x0 + x1) + (x2 + x3), qv = (x0 * x0 + x1 * x1) + (x2 * x2 + x3 * x3);
        const float s = wave_sum((sv.x + sv.y) + (sv.z + sv.w)), q = wave_sum((qv.x + qv.y) + (qv.z + qv.w));
        const float mean = s * (1.f / 1024.f), var = fmaxf(q * (1.f / 1024.f) - mean * mean, 0.f);
        if (lane == 0) { st[tok * 2] = mean; st[tok * 2 + 1] = 1.f / sqrtf(var + 1e-5f); } }
    __syncthreads();
    for (int g = 0; g < 8; ++g) {
#pragma unroll
        for (int i = 0; i < 4; ++i) { const int pc = tid + 512 * i, rr = pc >> 4, c16 = pc & 15;
            *(LAS v4u*)(sA + rr * TP + c16 * 8) = *(const v4u*)(GMW + (size_t)g * 16384 + rr * 128 + c16 * 8); }
        { const int p = tid & 127, oc0 = tid >> 7; const float mean = st[p * 2], rstd = st[p * 2 + 1];
#pragma unroll
          for (int i = 0; i < 4; ++i) { const int oc = oc0 + 4 * i, c0 = g * 128 + oc * 8;
              f32x4 x0, x1; unpk8(*(const v4u*)(GUV + (t0 + p) * 2048 + 1024 + c0), x0, x1);
              const f32x4 g0 = *(const f32x4*)(lng + c0), g1 = *(const f32x4*)(lng + c0 + 4), b0 = *(const f32x4*)(lnb + c0), b1 = *(const f32x4*)(lnb + c0 + 4);
              x0 = (x0 - mean) * rstd * g0 + b0; x1 = (x1 - mean) * rstd * g1 + b1;
              const v4u w = pk8(x0, x1);
              LAS bf16* d = sB + (oc * 8) * TP + p;
              d[0 * TP] = (bf16)(w.x & 0xffffu); d[1 * TP] = (bf16)(w.x >> 16); d[2 * TP] = (bf16)(w.y & 0xffffu); d[3 * TP] = (bf16)(w.y >> 16);
              d[4 * TP] = (bf16)(w.z & 0xffffu); d[5 * TP] = (bf16)(w.z >> 16); d[6 * TP] = (bf16)(w.w & 0xffffu); d[7 * TP] = (bf16)(w.w >> 16); } }
        __syncthreads();
        f32x4 acc[4][2];
#pragma unroll
        for (int mt = 0; mt < 4; ++mt)
#pragma unroll
            for (int nt = 0; nt < 2; ++nt) acc[mt][nt] = (f32x4){0.f, 0.f, 0.f, 0.f};
        mma_128(sA, sB, wave, lane, acc);
        { const int wm = wave >> 2, wn = wave & 3, fr = lane & 15, fq = lane >> 4;
#pragma unroll
          for (int mt = 0; mt < 4; ++mt) { const int tt = 64 * wm + 16 * mt + fr; const float bsv = bsp[g * 128 + tt];
#pragma unroll
              for (int nt = 0; nt < 2; ++nt) { const int c = g * 128 + 32 * wn + 16 * nt + 4 * fq;
                  const v2u uw = *(const v2u*)(GUV + (t0 + tt) * 2048 + c);
                  const f32x4 u4 = (f32x4){bflo(uw.x), bfhi(uw.x), bflo(uw.y), bfhi(uw.y)};
                  const f32x4 yb = u4 * (acc[mt][nt] + bsv);
                  v2u ow; ow.x = cvt_pk_bf16(yb.x, yb.y); ow.y = cvt_pk_bf16(yb.z, yb.w);
                  *(v2u*)(GUV + (t0 + tt) * 2048 + c) = ow; } } }
        __syncthreads();
    }
}

__device__ __forceinline__ unsigned fkey(float f) { const unsigned u = __builtin_bit_cast(unsigned, f); return (u & 0x80000000u) ? ~u : (u | 0x80000000u); }
__device__ __forceinline__ float kval(unsigned k, unsigned mask) { const unsigned u = k & mask; return __builtin_bit_cast(float, (u & 0x80000000u) ? (u ^ 0x80000000u) : ~u); }
__device__ __forceinline__ float swap32_add(float a, float b) { const auto r = __builtin_amdgcn_permlane32_swap(__builtin_bit_cast(unsigned, a), __builtin_bit_cast(unsigned, b), false, false);
    return __builtin_bit_cast(float, (unsigned)r[0]) + __builtin_bit_cast(float, (unsigned)r[1]); }
__device__ __forceinline__ float swap16_add(float a, float b) { const auto r = __builtin_amdgcn_permlane16_swap(__builtin_bit_cast(unsigned, a), __builtin_bit_cast(unsigned, b), false, false);
    return __builtin_bit_cast(float, (unsigned)r[0]) + __builtin_bit_cast(float, (unsigned)r[1]); }
__device__ __forceinline__ float row_sum16(float x) {
    x += __builtin_bit_cast(float, __builtin_amdgcn_update_dpp(0, __builtin_bit_cast(int, x), 0x128, 0xf, 0xf, false));
    x += __builtin_bit_cast(float, __builtin_amdgcn_update_dpp(0, __builtin_bit_cast(int, x), 0x124, 0xf, 0xf, false));
    x += __builtin_bit_cast(float, __builtin_amdgcn_update_dpp(0, __builtin_bit_cast(int, x), 0x122, 0xf, 0xf, false));
    x += __builtin_bit_cast(float, __builtin_amdgcn_update_dpp(0, __builtin_bit_cast(int, x), 0x121, 0xf, 0xf, false));
    return x; }
#define CE_DESC(a, b) do { const unsigned _h = max((a), (b)), _l = min((a), (b)); (a) = _h; (b) = _l; } while (0)
template <int OFF> __device__ __forceinline__ void bitonic_merge16(unsigned (&x)[32]) {
#pragma unroll
    for (int j = 8; j >= 1; j >>= 1)
#pragma unroll
        for (int i = 0; i < 16; ++i) { const int l = i ^ j; if (l > i) CE_DESC(x[OFF + i], x[OFF + l]); }
}
template <int OFF> __device__ __forceinline__ void bitonic_sort16(unsigned (&x)[32]) {
#pragma unroll
    for (int k = 2; k <= 16; k <<= 1)
#pragma unroll
        for (int j = k >> 1; j >= 1; j >>= 1)
#pragma unroll
            for (int i = 0; i < 16; ++i) { const int l = i ^ j; if (l > i) { if ((i & k) == 0 || k == 16) CE_DESC(x[OFF + i], x[OFF + l]); else CE_DESC(x[OFF + l], x[OFF + i]); } }
}
#ifndef REP_K
#define REP_K 1
#endif
#define TOP_INSERT(top, x) do { unsigned _x = (x); _Pragma("unroll") for (int _j = 0; _j < 16; ++_j) { const unsigned _h = max((top)[_j], _x); _x = min((top)[_j], _x); (top)[_j] = _h; } } while (0)
__device__ __forceinline__ void peer_token_end(Frame& F, const Args& a, int layer, bool last, bool final_half, size_t tok, int lane, const f32x2 (&out)[8], const f32x4 (&hpre)[4], const v4u (&gpre)[2]) {
    float* hp = F.h + tok * 1024 + 16 * lane;
    f32x4 hv[4], ge[4]; float s = 0.f;
    unpk8(gpre[0], ge[0], ge[1]); unpk8(gpre[1], ge[2], ge[3]);
    if (!final_half) {
        bf16* gp = (bf16*)(F.ws + WS_PW) + tok * 1024 + 16 * lane;
        *(v4u*)gp = pk8(ge[0] + (f32x4){out[0].x, out[0].y, out[1].x, out[1].y}, ge[1] + (f32x4){out[2].x, out[2].y, out[3].x, out[3].y});
        *(v4u*)(gp + 8) = pk8(ge[2] + (f32x4){out[4].x, out[4].y, out[5].x, out[5].y}, ge[3] + (f32x4){out[6].x, out[6].y, out[7].x, out[7].y});
        return; }
#pragma unroll
    for (int i = 0; i < 4; ++i) { hv[i] = hpre[i] + ge[i] + (f32x4){out[2 * i].x, out[2 * i].y, out[2 * i + 1].x, out[2 * i + 1].y};
        s += (hv[i].x * hv[i].x + hv[i].y * hv[i].y) + (hv[i].z * hv[i].z + hv[i].w * hv[i].w); }
    const float rstd = 1.f / sqrtf(wave_sum(s) * (1.f / D) + 1e-6f);
    const float* g = (last ? a.in[4] : a.in[2] + (size_t)(layer + 1) * 1024) + 16 * lane;
    f32x4 o[4];
#pragma unroll
    for (int i = 0; i < 4; ++i) o[i] = hv[i] * rstd * *(const f32x4*)(g + 4 * i);
    if (last) {
#ifdef PROBE_SCAN
        { const float pv = ((const float*)(F.ws + WS_CTL))[2048 + PROBE_SCAN - 1];
#pragma unroll
          for (int i = 0; i < 4; ++i) o[i] = o[i] + pv; }
#endif
#pragma unroll
        for (int i = 0; i < 4; ++i) *(f32x4*)(hp + 4 * i) = o[i];
    } else {
#pragma unroll
        for (int i = 0; i < 4; ++i) *(f32x4*)(hp + 4 * i) = hv[i];
        bf16* NX = (bf16*)(F.ws + WS_NX) + NXROW(tok) * 1024 + 16 * lane; const v4u w0 = pk8(o[0], o[1]), w1 = pk8(o[2], o[3]);
        *(v4u*)NX = w0; *(v4u*)(NX + 8) = w1;
    }
}
__device__ __forceinline__ void peer_unit(Frame& F, const Args& a, int layer, int unit, bool last) {
    phase_ids(F);
    const size_t t0 = (size_t)unit * 128; const int tid = F.tid, lane = F.lane, wave = F.wave, fr = lane & 15, fq = lane >> 4;
    LAS bf16* sKey = (LAS bf16*)F.lds;
    LAS unsigned* sLT = (LAS unsigned*)(F.lds + 2 * 128 * TP * 2) + wave * 512;
    const bf16* Q = (const bf16*)(F.ws + WS_Q); const bf16* KEYS = (const bf16*)(F.ws + WS_DB + (size_t)(layer & 1) * DB_SET + DB_KEYS); v2u* SEL = (v2u*)(F.ws + WS_SEL);
    const size_t trow = t0 + wave * 16 + fr;
    constexpr float KOFF = 32.f;
    v4u ktn[4]; bf16x8 qfn[4];
#define K_FETCH(J) do { _Pragma("unroll") for (int _i = 0; _i < 4; ++_i) { const int _pc = tid + 512 * _i, _rr = _pc >> 4, _c16 = _pc & 15; ktn[_i] = *(const v4u*)(KEYS + (size_t)(J) * 16384 + _rr * 128 + _c16 * 8); } \
        _Pragma("unroll") for (int _kk = 0; _kk < 4; ++_kk) qfn[_kk] = *(const bf16x8*)(Q + trow * 2048 + (J) * 128 + 32 * _kk + 8 * fq); } while (0)
#define K_STORE(J) do { _Pragma("unroll") for (int _i = 0; _i < 4; ++_i) { const int _pc = tid + 512 * _i, _rr = _pc >> 4, _c16 = _pc & 15; *(LAS v4u*)(sKey + ((J) & 1) * 128 * TP + _rr * TP + _c16 * 8) = ktn[_i]; } } while (0)
    for (int krep = 0; krep < REP_K; ++krep) {
    __syncthreads();
    K_FETCH(0); K_STORE(0);
    bf16x8 qf[4];
#pragma unroll
    for (int kk = 0; kk < 4; ++kk) qf[kk] = qfn[kk];
    __syncthreads();
    for (int hd = 0; hd < 8; ++hd) {
        for (int p = 0; p < 2; ++p) {
            const int jp = hd * 2 + p;
            if (jp + 1 < 16) K_FETCH(jp + 1);
            const LAS bf16* sKc = sKey + (jp & 1) * 128 * TP;
            f32x4 sc[8];
#pragma unroll
            for (int nt = 0; nt < 8; ++nt) sc[nt] = (f32x4){KOFF, KOFF, KOFF, KOFF};
#pragma unroll
            for (int kk = 0; kk < 4; ++kk)
#pragma unroll
                for (int nt = 0; nt < 8; ++nt) { const bf16x8 kf = *(const LAS bf16x8*)(sKc + (16 * nt + fr) * TP + 32 * kk + 8 * fq);
                    sc[nt] = __builtin_amdgcn_mfma_f32_16x16x32_bf16(kf, qf[kk], sc[nt], 0, 0, 0); }
            unsigned t[32];
#pragma unroll
            for (int nt = 0; nt < 8; ++nt)
#pragma unroll
                for (int rg = 0; rg < 4; ++rg) t[4 * nt + rg] = (__float_as_uint(sc[nt][rg]) & 0xFFFFFF80u) | (unsigned)(16 * nt + 4 * fq + rg);
            bitonic_sort16<0>(t); bitonic_sort16<16>(t);
#pragma unroll
            for (int j = 0; j < 16; ++j) t[j] = max(t[j], t[31 - j]);
            bitonic_merge16<0>(t);
#pragma unroll
            for (int rnd = 0; rnd < 2; ++rnd) {
#pragma unroll
                for (int j = 0; j < 16; ++j) t[16 + j] = rnd ? xor32_u(t[j], lane) : xor16_u(t[j], lane);
#pragma unroll
                for (int j = 0; j < 16; ++j) t[j] = max(t[j], t[31 - j]);
                bitonic_merge16<0>(t); }
#pragma unroll
            for (int j = 0; j < 16; ++j) sLT[fr * 32 + p * 16 + j] = t[j];
            if (jp + 1 < 16) { K_STORE(jp + 1);
#pragma unroll
                for (int kk = 0; kk < 4; ++kk) qf[kk] = qfn[kk]; }
            __syncthreads();
        }
        float v0[16], v1[16];
#pragma unroll
        for (int j = 0; j < 16; ++j) { v0[j] = __uint_as_float(sLT[fr * 32 + j] & 0xFFFFFF80u); v1[j] = __uint_as_float(sLT[fr * 32 + 16 + j] & 0xFFFFFF80u); }
        unsigned best[32];
#define CKEY(i, j) ((__float_as_uint(v0[i] + v1[j]) & 0xFFFFFF00u) | (unsigned)((i) * 16 + (j)))
#pragma unroll
        for (int j = 0; j < 16; ++j) best[j] = CKEY(0, j);
#pragma unroll
        for (int i = 1; i < 16; ++i) best[16 - i] = max(best[16 - i], CKEY(i, 0));
        bitonic_merge16<0>(best);
#pragma unroll
        for (int j = 1; j < 8; ++j) best[16 - j] = max(best[16 - j], CKEY(1, j));
        bitonic_merge16<0>(best);
#pragma unroll
        for (int i = 2; i < 8; ++i) best[17 - i] = max(best[17 - i], CKEY(i, 1));
        bitonic_merge16<0>(best);
        { unsigned r6[6] = {CKEY(2, 2), CKEY(2, 3), CKEY(2, 4), CKEY(3, 2), CKEY(3, 3), CKEY(4, 2)};
          CE_DESC(r6[0], r6[5]); CE_DESC(r6[1], r6[3]); CE_DESC(r6[2], r6[4]); CE_DESC(r6[1], r6[2]); CE_DESC(r6[3], r6[4]); CE_DESC(r6[0], r6[3]);
          CE_DESC(r6[2], r6[5]); CE_DESC(r6[0], r6[1]); CE_DESC(r6[2], r6[3]); CE_DESC(r6[4], r6[5]); CE_DESC(r6[1], r6[2]); CE_DESC(r6[3], r6[4]);
#pragma unroll
          for (int k = 0; k < 6; ++k) best[15 - k] = max(best[15 - k], r6[k]); }
        bitonic_merge16<0>(best);
#undef CKEY
        float ev[16], esum = 0.f; const float mx = __uint_as_float(best[0] & 0xFFFFFF00u);
#pragma unroll
        for (int k = 0; k < 16; ++k) { ev[k] = __builtin_amdgcn_exp2f((__uint_as_float(best[k] & 0xFFFFFF00u) - mx) * 1.44269504f); esum += ev[k]; }
        const float einv = 1.f / esum;
#pragma unroll
        for (int k = 0; k < 16; ++k) { const unsigned pos = best[k] & 255u;
            const unsigned i0 = sLT[fr * 32 + (pos >> 4)] & 127u, i1 = sLT[fr * 32 + 16 + (pos & 15u)] & 127u;
            if ((k >> 2) == fq) SEL[trow * 128 + hd * 16 + k] = (v2u){i0 * 128u + i1, __builtin_bit_cast(unsigned, ev[k] * einv)}; }
    }
    }
#undef K_FETCH
#undef K_STORE
    asm volatile("s_waitcnt vmcnt(0)" ::: "memory");
    __syncthreads();
    const bf16* N2 = (const bf16*)(F.ws + WS_N2); const unsigned char* U8 = (const unsigned char*)(F.ws + WS_DB + (size_t)(layer & 1) * DB_SET + DB_U); const unsigned char* V8 = (const unsigned char*)(F.ws + WS_DB + (size_t)(layer & 1) * DB_SET + DB_V);
    unsigned* SELW = (unsigned*)SEL;
    LAS unsigned* sIdx = (LAS unsigned*)(F.lds + 90112) + wave * 1024;
    LAS float* sCoef = (LAS float*)F.lds + wave * 2048;
    LAS unsigned* sSort = sLT;
    const size_t tokb = t0 + wave * 16;
    unsigned cnts = 0u;
    v4u se_pf = *(const v4u*)(SELW + tokb * 256 + 4 * lane);
    for (int it = 0; it < 16; ++it) {
        const v4u se = se_pf;
        if (it < 15) se_pf = *(const v4u*)(SELW + (tokb + it + 1) * 256 + 4 * lane);
        const unsigned b0 = se.x >> 12, b1 = se.z >> 12;
        unsigned pos0 = 0u, pos1 = 0u, base = 0u, pk = 0u;
#pragma unroll
        for (unsigned k = 0; k < 4; ++k) {
            const unsigned long long m0 = __builtin_amdgcn_ballot_w64(b0 == k), m1 = __builtin_amdgcn_ballot_w64(b1 == k);
            const unsigned below = __builtin_amdgcn_mbcnt_hi((unsigned)(m0 >> 32), __builtin_amdgcn_mbcnt_lo((unsigned)m0, 0u)) + __builtin_amdgcn_mbcnt_hi((unsigned)(m1 >> 32), __builtin_amdgcn_mbcnt_lo((unsigned)m1, 0u));
            if (b0 == k) pos0 = base + below;
            if (b1 == k) pos1 = base + below + (b0 == k ? 1u : 0u);
            base += (unsigned)__builtin_popcountll(m0) + (unsigned)__builtin_popcountll(m1);
            if (k < 3) pk |= base << (8 * k);
        }
#ifdef DBG_NOSORT
        pos0 = 2 * lane; pos1 = 2 * lane + 1;
#endif
        *(LAS v2u*)(sSort + 2 * pos0) = (v2u){se.x, se.y}; *(LAS v2u*)(sSort + 2 * pos1) = (v2u){se.z, se.w};
        asm volatile("" ::: "memory");
        const v2u so0 = *(const LAS v2u*)(sSort + 4 * lane), so1 = *(const LAS v2u*)(sSort + 4 * lane + 2); const v4u so = (v4u){so0.x, so0.y, so1.x, so1.y};
        asm volatile("" ::: "memory");
        sIdx[it * 64 + lane] = (so0.x & 0xffffu) | (so1.x << 16);
        (void)so;
        { const unsigned g0 = so0.y, g1 = so1.y; sCoef[it * 128 + 2 * lane] = __uint_as_float(g0); sCoef[it * 128 + 2 * lane + 1] = __uint_as_float(g1); }
        if (lane == it) cnts = pk;
    }
    asm volatile("s_waitcnt vmcnt(0) lgkmcnt(0)" ::: "memory");
#ifdef DBG_NOBUCKET
    cnts = 0u;
#endif
#define PL_LOAD(RB, TAB, SE, BB) do { _Pragma("unroll") for (int _q = 0; _q < 16; ++_q) { \
        const unsigned _pw = (unsigned)__builtin_amdgcn_readlane((int)(SE), (BB) * 8 + (_q >> 1)); const unsigned _idx = (_q & 1) ? (_pw >> 16) : (_pw & 0xffffu); \
        (RB)[_q] = *(const v4u*)((TAB) + (size_t)_idx * 1024 + 16 * lane); } } while (0)
#define PL_LOAD_U(RB, SE, BB) do { const int _src = ((BB) * 8 + ((lane & 15) >> 1)) * 4; \
        const unsigned _ix = (unsigned)__builtin_amdgcn_ds_bpermute(_src, (int)(SE).x), _iz = (unsigned)__builtin_amdgcn_ds_bpermute(_src, (int)(SE).z); \
        const unsigned char* _p = U8 + (size_t)((lane & 1) ? _iz : _ix) * 1024 + 32 * (lane >> 4); \
        _Pragma("unroll") for (int _j = 0; _j < 16; ++_j) (RB)[_j] = *(const v4u*)(_p + 128 * (_j >> 1) + 16 * (_j & 1)); } while (0)
#define PL_RANGE(T, P, NP, RLO, RHI, BLO, BHI) const unsigned _pk##T = (unsigned)__builtin_amdgcn_readlane((int)cnts, (T)); \
        const int _sp##T = min((int)((((_pk##T >> 8) & 255u) + 15u) & ~15u), 128);     \
        const int RLO = (P) == 0 ? 0 : _sp##T, RHI = (P) == 0 ? _sp##T : 128; \
        const int BLO = min(RLO >> 4, 7), BHI = max((RHI + 15) >> 4, BLO + 1)
#define PL_RANGE4(T, P, RLO, RHI, BLO, BHI) const unsigned _pk##T = (unsigned)__builtin_amdgcn_readlane((int)cnts, (T)); \
        const int _s1##T = min((int)(((_pk##T & 255u) + 15u) & ~15u), 128), _s2##T = min((int)((((_pk##T >> 8) & 255u) + 15u) & ~15u), 128), _s3##T = min((int)((((_pk##T >> 16) & 255u) + 15u) & ~15u), 128); \
        const int RLO = (P) == 0 ? 0 : (P) == 1 ? _s1##T : (P) == 2 ? _s2##T : _s3##T, RHI = (P) == 0 ? _s1##T : (P) == 1 ? _s2##T : (P) == 2 ? _s3##T : 128; \
        const int BLO = min(RLO >> 4, 7), BHI = max((RHI + 15) >> 4, BLO + 1)
    v4u ra[16], rb[16];
#ifndef DBG_U0
#define DBG_U0 0
#define DBG_V0 0
#endif
#ifndef UPASS
#define UPASS 2
#endif
#if UPASS == 4
#define U_RANGE(T, P, RLO, RHI, BLO, BHI) PL_RANGE4(T, P, RLO, RHI, BLO, BHI)
#else
#define U_RANGE(T, P, RLO, RHI, BLO, BHI) PL_RANGE(T, P, 2, RLO, RHI, BLO, BHI)
#endif
    for (int ps = DBG_U0; ps < UPASS; ++ps) {
        int lt = 0, lb, lbh; { U_RANGE(lt, ps, r0, r1, b0_, b1_); lb = b0_; lbh = b1_; (void)r0; (void)r1; }
        unsigned seL = sIdx[lane];
        long xlo = 0, xhi = 0; const bool dsel = ((lane >> 2) & 3) == (lane >> 4); const unsigned char* N8 = (const unsigned char*)(F.ws + WS_N8); v4u nnx = *(const v4u*)(N8 + tokb * 1024 + 16 * lane);
        int ct, cb, crl = 0, crh = 0, cbl = 0;
#define U_ADV() do { ++lb; if (lb >= lbh) { ++lt; if (lt < 16) { U_RANGE(lt, ps, _r0, _r1, _b0, _b1); lb = _b0; lbh = _b1; (void)_r0; (void)_r1; seL = sIdx[lt * 64 + lane]; } } } while (0)
#define U_COMPUTE(RB) do { \
            if (cb == cbl) { xlo = (long)(((unsigned long long)nnx.y << 32) | nnx.x); xhi = (long)(((unsigned long long)nnx.w << 32) | nnx.z); if (ct + 1 < 16) nnx = *(const v4u*)(N8 + (tokb + ct + 1) * 1024 + 16 * lane); }     \
            _Pragma("unroll") for (int _g = 0; _g < 2; ++_g) { float _p[8]; \
                _Pragma("unroll") for (int _q = 0; _q < 8; ++_q) { f32x4 _d = (f32x4){0.f, 0.f, 0.f, 0.f}; \
                    _d = __builtin_amdgcn_mfma_f32_16x16x32_fp8_fp8((long)(((unsigned long long)(RB)[8 * _g + _q].y << 32) | (RB)[8 * _g + _q].x), xlo, _d, 0, 0, 0); \
                    _d = __builtin_amdgcn_mfma_f32_16x16x32_fp8_fp8((long)(((unsigned long long)(RB)[8 * _g + _q].w << 32) | (RB)[8 * _g + _q].z), xhi, _d, 0, 0, 0); \
                    const float _sl = (lane & 2) ? ((lane & 1) ? _d.w : _d.z) : ((lane & 1) ? _d.y : _d.x); \
                    _p[_q] = dsel ? _sl : 0.f; }     \
                const float _s0 = swap32_add(_p[0], _p[4]), _s1 = swap32_add(_p[1], _p[5]), _s2 = swap32_add(_p[2], _p[6]), _s3 = swap32_add(_p[3], _p[7]); \
                float _t0 = row_sum16(swap16_add(_s0, _s2)), _t1 = row_sum16(swap16_add(_s1, _s3)); \
                _t0 = fgelu(_t0 * (1.f / 4096.f)) * (1.f / 64.f); _t1 = fgelu(_t1 * (1.f / 4096.f)) * (1.f / 64.f); \
                if ((lane & 15) == 0) { const int _r = lane >> 4, _e = cb * 16 + 8 * _g + 2 * (_r & 1) + 4 * (_r >> 1); LAS float* _c = sCoef + ct * 128 + _e; \
                    if (_e >= crl && _e < crh) _c[0] *= _t0; if (_e + 1 >= crl && _e + 1 < crh) _c[1] *= _t1; } } } while (0)
#define U_SETC() do { ct = lt; cb = lb; { U_RANGE(ct, ps, _r0, _r1, _b0, _b1); crl = _r0; crh = _r1; cbl = _b0; (void)_b1; } } while (0)
        PL_LOAD(ra, U8, seL, lb);
        U_SETC(); U_ADV();
        for (;;) {
            if (lt < 16) PL_LOAD(rb, U8, seL, lb);
            U_COMPUTE(ra);
            if (lt >= 16) break;
            U_SETC(); U_ADV();
            if (lt < 16) PL_LOAD(ra, U8, seL, lb);
            U_COMPUTE(rb);
            if (lt >= 16) break;
            U_SETC(); U_ADV();
        }
        asm volatile("s_waitcnt lgkmcnt(0)" ::: "memory");
        __syncthreads();
    }
#undef U_ADV
#undef U_COMPUTE
#undef U_SETC
#ifndef VPASS
#define VPASS 2
#endif
#if VPASS == 4
#define V_RANGE(T, P, RLO, RHI, BLO, BHI) PL_RANGE4(T, P, RLO, RHI, BLO, BHI)
#else
#define V_RANGE(T, P, RLO, RHI, BLO, BHI) PL_RANGE(T, P, 2, RLO, RHI, BLO, BHI)
#endif
    for (int ps = DBG_V0; ps < VPASS; ++ps) {
        int lt = 0, lb, lbh; { V_RANGE(lt, ps, r0, r1, b0_, b1_); lb = b0_; lbh = b1_; (void)r0; (void)r1; }
        unsigned seL = sIdx[lane];
        f32x2 out[8]; f32x4 hpre[4] = {(f32x4){0.f, 0.f, 0.f, 0.f}, (f32x4){0.f, 0.f, 0.f, 0.f}, (f32x4){0.f, 0.f, 0.f, 0.f}, (f32x4){0.f, 0.f, 0.f, 0.f}}, ac4[4]; v4u gpre[2] = {(v4u){0u, 0u, 0u, 0u}, (v4u){0u, 0u, 0u, 0u}}; const bf16* PWG = (const bf16*)(F.ws + WS_PW);
        const unsigned vmask = ((lane >> 4) == ((lane & 15) >> 2)) ? (0xFFu << (8 * (lane & 3))) : 0u;
        int ct, cb, crl = 0, crh = 0, cbl = 0, cbh = 0;
#define V_ADV() do { ++lb; if (lb >= lbh) { ++lt; if (lt < 16) { V_RANGE(lt, ps, _r0, _r1, _b0, _b1); lb = _b0; lbh = _b1; (void)_r0; (void)_r1; seL = sIdx[lt * 64 + lane]; } } } while (0)
#define V_SETC() do { ct = lt; cb = lb; { V_RANGE(ct, ps, _r0, _r1, _b0, _b1); crl = _r0; crh = _r1; cbl = _b0; cbh = _b1; } } while (0)
#ifndef REP_LV
#define REP_LV 1
#endif
#define V_COMPUTE(RB) do { \
            if (cb == cbl) { _Pragma("unroll") for (int _i = 0; _i < 4; ++_i) { ac4[_i] = (f32x4){0.f, 0.f, 0.f, 0.f}; if (ps == VPASS - 1) hpre[_i] = *(const f32x4*)(F.h + (tokb + ct) * 1024 + 16 * lane + 4 * _i); } \
                gpre[0] = *(const v4u*)(PWG + (tokb + ct) * 1024 + 16 * lane); gpre[1] = *(const v4u*)(PWG + (tokb + ct) * 1024 + 16 * lane + 8); }     \
            _Pragma("unroll") for (int _q = 0; _q < 16; ++_q) { const int _e = cb * 16 + _q; \
                float _c = sCoef[ct * 128 + _e]; _c = (_e >= crl && _e < crh) ? _c * 2048.f : 0.f; \
                int _w = __builtin_amdgcn_cvt_pk_fp8_f32(_c, _c, 0, false); _w = __builtin_amdgcn_cvt_pk_fp8_f32(_c, _c, _w, true); const unsigned _x = (unsigned)_w & vmask; \
                const long _ae = (long)(unsigned long long)_x, _ao = (long)((unsigned long long)_x << 32); \
                const long _bl = (long)(((unsigned long long)(RB)[_q].y << 32) | (RB)[_q].x), _bh = (long)(((unsigned long long)(RB)[_q].w << 32) | (RB)[_q].z); \
                ac4[0] = __builtin_amdgcn_mfma_f32_16x16x32_fp8_fp8(_ae, _bl, ac4[0], 0, 0, 0); ac4[1] = __builtin_amdgcn_mfma_f32_16x16x32_fp8_fp8(_ao, _bl, ac4[1], 0, 0, 0); \
                ac4[2] = __builtin_amdgcn_mfma_f32_16x16x32_fp8_fp8(_ae, _bh, ac4[2], 0, 0, 0); ac4[3] = __builtin_amdgcn_mfma_f32_16x16x32_fp8_fp8(_ao, _bh, ac4[3], 0, 0, 0); } \
            if (cb == cbh - 1) { _Pragma("unroll") for (int _i = 0; _i < 4; ++_i) { out[2 * _i] = (f32x2){ac4[_i].x, ac4[_i].y} * (1.f / 2048.f); out[2 * _i + 1] = (f32x2){ac4[_i].z, ac4[_i].w} * (1.f / 2048.f); } \
                peer_token_end(F, a, layer, last, ps == VPASS - 1, tokb + ct, lane, out, hpre, gpre); } } while (0)
        PL_LOAD(ra, V8, seL, lb);
        V_SETC(); V_ADV();
        for (;;) {
            if (lt < 16) PL_LOAD(rb, V8, seL, lb);
            V_COMPUTE(ra);
            if (lt >= 16) break;
            V_SETC(); V_ADV();
            if (lt < 16) PL_LOAD(ra, V8, seL, lb);
            V_COMPUTE(rb);
            if (lt >= 16) break;
            V_SETC(); V_ADV();
        }
        asm volatile("s_waitcnt vmcnt(0)" ::: "memory");
        __syncthreads();
    }
#undef V_ADV
#undef V_SETC
#undef V_COMPUTE
#undef PL_LOAD
#undef PL_RANGE
}


#ifndef ZSKIP
#define ZSKIP 0
#endif
#ifndef ZGA_ALIGN
#define ZGA_ALIGN true
#endif
#ifndef ZGA_SP2
#define ZGA_SP2 true
#endif
#ifndef WIN_ALIGN
#define WIN_ALIGN true
#endif
#ifndef WIN_SP2
#define WIN_SP2 true
#endif
#ifndef REP_E
#define REP_E 1
#endif
#ifndef REP_A
#define REP_A 1
#endif
#ifndef REP_B
#define REP_B 1
#endif
#ifndef REP_C
#define REP_C 1
#endif
#ifndef REP_D
#define REP_D 1
#endif
#ifndef REP_G
#define REP_G 1
#endif
#ifndef REP_I
#define REP_I 1
#endif
#ifndef REP_K
#define REP_K 1
#endif
__global__ void __launch_bounds__(NWAVES * 64, 2) trunk_fwd(Args args) {
    extern __shared__ __attribute__((aligned(16))) unsigned char lds[];
    Frame F;
    F.lds = (LAS unsigned char*)lds;
    F.tid = threadIdx.x; F.lane = F.tid & 63; F.wave = __builtin_amdgcn_readfirstlane(F.tid >> 6); F.wave0 = F.wave;
    F.G = gridDim.x; F.bx = blockIdx.x; F.ws = (GAS unsigned char*)args.ws; F.h = args.out;
    volatile LAS unsigned* MISC = (volatile LAS unsigned*)(F.lds + MISC_OFF);
    for (int u = F.tid; u < (LDS_BYTES - LDSCTL_OFF) / 4; u += NWAVES * 64) ((LAS unsigned*)(F.lds + LDSCTL_OFF))[u] = 0u;
    __syncthreads();
    unsigned* ctl = (unsigned*)(F.ws + WS_CTL);
    XcdBarrier bar = xcd_barrier_post(ctl + CW_BAR, MISC + 8);
    GAS unsigned char* ws = F.ws;
    LAS unsigned char* ring = (LAS unsigned char*)F.lds;

    for (int rep = 0; rep < REP_A; ++rep) { prep_phase(F, args, 0, F.bx, F.G, 1);
    xcd_barrier(bar, F.wave0); }
#define OPQ() GAS unsigned char* ws = F.ws; asm volatile("" : "+s"(ws)); GAS unsigned char* db = ws + WS_DB + (size_t)(layer & 1) * DB_SET; (void)db
    for (int layer = 0; layer < DEPTH; ++layer) {
        {   OPQ();
        for (int rep = 0; rep < REP_B; ++rep) {   if (rep) xcd_barrier(bar, F.wave0); pg8::Gemm g{(const bf16*)(ws + WS_NX), (const bf16*)(ws + WS_WIN), T, NZ - 256 * ZSPLIT, 2048, 1024, 16}; pg8::StaticOrder S; S.init(T, NZ - 256 * ZSPLIT, F.G, F.bx);
            pg8::EpiZ E{(bf16*)(ws + WS_ZRKV), (bf16*)(ws + WS_ZL), (bf16*)(ws + WS_GUV), (bf16*)(ws + WS_SG), layer == 0 ? (bf16*)(ws + WS_VF) : (bf16*)nullptr, 0};
            pg8::gemm_phase<pg8::EpiZ, pg8::StaticOrder, WIN_ALIGN, WIN_SP2>(ring, g, S, E, F.wave0); }
        }
        xcd_barrier(bar, F.wave0);
        {   OPQ();
        for (int rep = 0; rep < REP_C; ++rep) {   if (rep) xcd_barrier(bar, F.wave0); { pg8::Gemm g{(const bf16*)(ws + WS_ZL), (const bf16*)(ws + WS_LORA + (size_t)layer * LORA_BYTES), T, 2048, 128, 512}; pg8::StaticOrder S; S.init(T, 2048, F.G, F.bx);
            pg8::EpiLora E{(bf16*)(ws + WS_EW), (size_t)(WS_AR - WS_EW) / 2, args.in[6] + (size_t)layer * 1024, args.in[8] + (size_t)layer * 1024, 0};
            pg8::gemm_phase<pg8::EpiLora, pg8::StaticOrder, true, true>(ring, g, S, E, F.wave0); }
            { pg8::Gemm g{(const bf16*)(ws + WS_ZL) + 128, (const bf16*)(ws + WS_LORA + (size_t)layer * LORA_BYTES) + 2048 * 128, T, 1024, 128, 512}; pg8::StaticOrder S; S.init(T, 1024, F.G, F.bx);
            pg8::EpiLora E{(bf16*)(ws + WS_EW), (size_t)(WS_AR - WS_EW) / 2, args.in[6] + (size_t)layer * 1024, args.in[8] + (size_t)layer * 1024, 8};
            pg8::gemm_phase<pg8::EpiLora, pg8::StaticOrder, true, true>(ring, g, S, E, F.wave0); } }
        if (layer > 0) {
            pg8::Gemm g{(const bf16*)(ws + WS_ZL) + 256, (const bf16*)(ws + WS_MV + (size_t)(layer - 1) * MV_BYTES), T, 1024, 128, 512}; pg8::StaticOrder S; S.init(T, 1024, F.G, F.bx);
            pg8::EpiMv E{(bf16*)(ws + WS_ZRKV), (const bf16*)(ws + WS_VF), args.in[18] + (size_t)(layer - 1) * 1024};
            pg8::gemm_phase<pg8::EpiMv, pg8::StaticOrder, true, true>(ring, g, S, E, F.wave0); }
        }
        xcd_barrier(bar, F.wave0);
        {   OPQ();
        for (int rep = 0; rep < REP_D; ++rep) {   if (rep) xcd_barrier(bar, F.wave0); const int nsb = F.G / 2, nob = F.G - nsb;
            if (F.bx < nsb) { for (int u = F.bx; u < NB * 16; u += nsb) scan_unit(F, args, layer, u); }
            else { const int ob = F.bx - nsb;
                for (int pm = ob; pm < T / 256; pm += nob)
                    for (int rep2 = 0; rep2 < REP_E; ++rep2) { gmlp_unit(F, args, layer, 2 * pm); gmlp_unit(F, args, layer, 2 * pm + 1); }
                asm volatile("s_waitcnt vmcnt(0)" ::: "memory"); __syncthreads();
                {
                    pg8::Gemm g{(const bf16*)(ws + WS_GUV), (const bf16*)(db + DB_PBT), T, 1024, 1024, 2048}; pg8::PanelOrder S{ob, nob, T / 256, 4, 0};
                    pg8::EpiMerge<false> E{(const bf16*)(ws + WS_SG), (bf16*)(ws + WS_GUV) + 1024, (bf16*)nullptr};
                    pg8::gemm_phase<pg8::EpiMerge<false>, pg8::PanelOrder, true, true>(ring, g, S, E, F.wave0); }
                {
                    pg8::Gemm g{(const bf16*)(ws + WS_NX), (const bf16*)(ws + WS_WINB + (size_t)(layer & 1) * WINB_BYTES), T, 256 * ZSPLIT, 2048, 1024, 16}; pg8::StaticOrder S; S.init(T, 256 * ZSPLIT, nob, ob);
                    pg8::EpiZ E{(bf16*)(ws + WS_ZRKV), (bf16*)(ws + WS_ZL), (bf16*)(ws + WS_GUV), (bf16*)(ws + WS_SG), (bf16*)nullptr, 30 - ZSPLIT};
                    pg8::gemm_phase<pg8::EpiZ, pg8::StaticOrder, true, true>(ring, g, S, E, F.wave0); }
                {   pg8::Gemm g{(const bf16*)(db + DB_PB), (const bf16*)(db + DB_PLEW), T, 1024, 256, 256}; pg8::StaticOrder S; S.init(T, 1024, nob, ob);
                    pg8::EpiPlain E{(bf16*)(ws + WS_PW), 1024};
                    pg8::gemm_phase<pg8::EpiPlain, pg8::StaticOrder, true, true>(ring, g, S, E, F.wave0); }
                if (layer == 0) prep_phase(F, args, 0, ob, nob, 2);
                if (layer + 1 < DEPTH) prep_phase(F, args, layer + 1, ob, nob, 3); } }
        }
        xcd_barrier(bar, F.wave0);
        {   OPQ();
        for (int rep = 0; rep < REP_G; ++rep) {   if (rep) xcd_barrier(bar, F.wave0); pg8::Gemm g{(const bf16*)(ws + WS_G), (const bf16*)(db + DB_PA), T, 1024, 1024, 1024}; pg8::StaticOrder S; S.init(T, 1024, F.G, F.bx);
            pg8::EpiMerge<true> E{(const bf16*)(ws + WS_SG), (bf16*)(ws + WS_GUV) + 1024, (bf16*)(ws + WS_MG)};
            pg8::gemm_phase<pg8::EpiMerge<true>, pg8::StaticOrder, true, true>(ring, g, S, E, F.wave0); }
        }
        xcd_barrier(bar, F.wave0);
        {   OPQ();
        {   pg8::Gemm g{(const bf16*)(ws + WS_MG), (const bf16*)(db + DB_POUT), T, 1024, 1024, 1024}; pg8::StaticOrder S; S.init(T, 1024, F.G, F.bx);
            pg8::EpiResid E{F.h};
            pg8::gemm_phase<pg8::EpiResid, pg8::StaticOrder, true, true>(ring, g, S, E, F.wave0); }
        }
        xcd_barrier(bar, F.wave0);
        {   OPQ();
        for (int rep = 0; rep < REP_I; ++rep) {   if (rep) xcd_barrier(bar, F.wave0); phase_ids(F); const int gw = F.bx * NWAVES + F.wave, NGW = F.G * NWAVES; const float* g2 = args.in[3] + (size_t)layer * 1024;
            for (int m = gw; m < T / 2; m += NGW) norm_row_n2x2(F.h + (size_t)m * D, F.h + (size_t)(m + T / 2) * D, g2, (bf16*)(ws + WS_N2) + (size_t)m * D, (bf16*)(ws + WS_N2) + (size_t)(m + T / 2) * D, (unsigned char*)(ws + WS_N8) + (size_t)m * D, (unsigned char*)(ws + WS_N8) + (size_t)(m + T / 2) * D, F.lane); }
        }
        xcd_barrier(bar, F.wave0);
        {   OPQ();
        {   pg8::Gemm g{(const bf16*)(ws + WS_N2), (const bf16*)(db + DB_WQG), T, 3072, 1024, 1024}; pg8::StaticOrder S; S.init(T, 3072, F.G, F.bx);
            pg8::EpiQG E{(bf16*)(ws + WS_Q), (bf16*)(ws + WS_PW), F.h};
            pg8::gemm_phase<pg8::EpiQG, pg8::StaticOrder, true, true>(ring, g, S, E, F.wave0); }
        }
        xcd_barrier(bar, F.wave0);
        {   OPQ();
        for (int u = F.bx; u < T / 128; u += F.G) peer_unit(F, args, layer, u, layer == DEPTH - 1);
        }
        if (layer + 1 < DEPTH) xcd_barrier(bar, F.wave0);
    }
}

extern "C" void kernel_launch(void* const* d_in, const int* in_sizes, int n_in, void* d_out, int out_size, void* d_ws, size_t ws_size, hipStream_t stream) {
    static int grid = 0;
    if (grid == 0) {
        if (n_in != 32 || out_size != T * D || ws_size < WS_END) { fprintf(stderr, "kernel_launch: unexpected sizes n_in %d out %d ws %zu (need %zu); nothing launched\n", n_in, out_size, ws_size, (size_t)WS_END); grid = -1; return; }
        int dev = 0, cus = 0, per_cu = 0;
        if (hipGetDevice(&dev) != hipSuccess || hipDeviceGetAttribute(&cus, hipDeviceAttributeMultiprocessorCount, dev) != hipSuccess) { grid = -1; return; }
        if (hipFuncSetAttribute((const void*)trunk_fwd, hipFuncAttributeMaxDynamicSharedMemorySize, LDS_BYTES) != hipSuccess) { fprintf(stderr, "kernel_launch: hipFuncSetAttribute failed\n"); grid = -1; return; }
        if (hipOccupancyMaxActiveBlocksPerMultiprocessor(&per_cu, (const void*)trunk_fwd, NWAVES * 64, LDS_BYTES) != hipSuccess || per_cu < 1)
            fprintf(stderr, "kernel_launch: note: occupancy query reports %d workgroups per CU\n", per_cu);
        (void)hipGetLastError();
        grid = cus;
    }
    if (grid < 0) return;
    (void)hipMemsetAsync((char*)d_ws + WS_CTL, 0, ZERO_BYTES, stream);
    (void)hipMemsetAsync((char*)d_ws + WIN_ZERO_OFF, 0, WIN_ZERO_BYTES, stream);
    Args a{};
    for (int i = 0; i < 32; ++i) a.in[i] = (const float*)d_in[i];
    a.out = (float*)d_out; a.ws = (unsigned char*)d_ws;
    hipLaunchKernelGGL(trunk_fwd, dim3(grid), dim3(NWAVES * 64), LDS_BYTES, stream, a);
    const hipError_t le = hipPeekAtLastError();
    if (le != hipSuccess) fprintf(stderr, "kernel_launch: launch failed: %s\n", hipGetErrorName(le));
}
```
